# Optimizing an MI355X kernel written in HIP

```python
import jax, jax.numpy as jnp
from jax import lax
import numpy as np

D_MODEL = 1024
BATCH = 8
SEQ = 8192
DEPTH = 1

CTX_LEN = 256
GRID_W = 64
LRU_WIDTH = 512
LRU_HEADS = 8
LRU_HEAD_DIM = LRU_WIDTH // LRU_HEADS
LRU_CONV_W = 4
LRU_CONV_LEFT = 2
LRU_C = 8.0
MLA_HEADS = 8
QK_NOPE_DIM = 64
QK_ROPE_DIM = 32
QK_HEAD_DIM = QK_NOPE_DIM + QK_ROPE_DIM
V_HEAD_DIM = 64
Q_LORA_RANK = 256
KV_LORA_RANK = 128
MLA_WIDTH = MLA_HEADS * V_HEAD_DIM
MLA_SCALE = QK_HEAD_DIM ** -0.5
ROPE_PAIRS_PER_AXIS = QK_ROPE_DIM // 4
ROPE_BASE = 10000.0
Q_BLOCK = 128
MIX_WIDTH = LRU_WIDTH + MLA_WIDTH
OFF_GATE = LRU_WIDTH
OFF_CQ = 2 * LRU_WIDTH
OFF_CKV = OFF_CQ + Q_LORA_RANK
OFF_KR = OFF_CKV + KV_LORA_RANK
IN_PROJ_WIDTH = OFF_KR + QK_ROPE_DIM
D_FF = 2816
FFN_CONV_W = 3
FFN_CONV_LEFT = 1
N_MOD = 6
NORM_EPS = 1e-6

kernel_name = "hybrid_rglru_mla_convffn_dit_layer"


def rms_norm(x, g):
    xf = x.astype(jnp.float32)
    y = xf * lax.rsqrt(jnp.mean(xf * xf, axis=-1, keepdims=True) + NORM_EPS)
    return (y * g.astype(jnp.float32)).astype(x.dtype)


def modulate(h, shift, scale):
    return h * (1 + scale) + shift


def dwconv(x, w, b, left):
    k_width = w.shape[0]
    n = x.shape[1]
    xp = jnp.pad(x, ((0, 0), (left, k_width - 1 - left), (0, 0)))
    out = b
    for k in range(k_width):
        out = out + xp[:, k:k + n] * w[k]
    return out


def axial_rope_tables(n_tokens, dtype):
    rows = n_tokens // GRID_W
    row = jnp.repeat(jnp.arange(rows, dtype=jnp.float32), GRID_W)
    col = jnp.tile(jnp.arange(GRID_W, dtype=jnp.float32), rows)
    inv_freq = ROPE_BASE ** (-jnp.arange(ROPE_PAIRS_PER_AXIS, dtype=jnp.float32) / ROPE_PAIRS_PER_AXIS)
    ang = jnp.concatenate([row[:, None] * inv_freq, col[:, None] * inv_freq], axis=-1)
    return jnp.cos(ang).astype(dtype), jnp.sin(ang).astype(dtype)


def axial_rope(x, cos, sin):
    p = ROPE_PAIRS_PER_AXIS
    xr1, xr2, xc1, xc2 = jnp.split(x, 4, axis=-1)
    cr, cc = cos[..., :p], cos[..., p:]
    sr, sc = sin[..., :p], sin[..., p:]
    return jnp.concatenate([xr1 * cr - xr2 * sr, xr2 * cr + xr1 * sr,
                            xc1 * cc - xc2 * sc, xc2 * cc + xc1 * sc], axis=-1)


def split_in_proj(p):
    return (p[..., :OFF_GATE], p[..., OFF_GATE:OFF_CQ], p[..., OFF_CQ:OFF_CKV],
            p[..., OFF_CKV:OFF_KR], p[..., OFF_KR:IN_PROJ_WIDTH])


def rglru_coeffs(xc, w_a, b_a, w_x, b_x, lam):
    bsz, n, _ = xc.shape
    xh = xc.reshape(bsz, n, LRU_HEADS, LRU_HEAD_DIM)
    r = jax.nn.sigmoid(jnp.einsum('blhi,hij->blhj', xh, w_a).reshape(bsz, n, LRU_WIDTH) + b_a)
    i = jax.nn.sigmoid(jnp.einsum('blhi,hij->blhj', xh, w_x).reshape(bsz, n, LRU_WIDTH) + b_x)
    log_a = -LRU_C * r.astype(jnp.float32) * jax.nn.softplus(-lam.astype(jnp.float32))
    a = jnp.exp(log_a)
    u = jnp.sqrt(-jnp.expm1(2 * log_a)) * (i * xc).astype(jnp.float32)
    return a, u


def linear_scan(a, u, h0, reverse):
    if reverse:
        a, u = jnp.flip(a, 1), jnp.flip(u, 1)
    combine = lambda l, r: (l[0] * r[0], r[0] * l[1] + r[1])
    a_cum, u_cum = lax.associative_scan(combine, (a, u), axis=1)
    h = u_cum if h0 is None else a_cum * h0[:, None, :] + u_cum
    return jnp.flip(h, 1) if reverse else h


def mla_keys_values(ckv, kr, g_kv, w_ukv, cos, sin):
    bsz, n, _ = ckv.shape
    kv = (rms_norm(ckv, g_kv) @ w_ukv).reshape(bsz, n, MLA_HEADS, QK_NOPE_DIM + V_HEAD_DIM)
    k_nope, v = kv[..., :QK_NOPE_DIM], kv[..., QK_NOPE_DIM:]
    if cos is not None:
        kr = axial_rope(kr, cos, sin)
    k_rope = jnp.broadcast_to(kr[:, :, None, :], (bsz, n, MLA_HEADS, QK_ROPE_DIM))
    return jnp.concatenate([k_nope, k_rope], axis=-1), v


def mla_queries(cq, g_q, w_uq, cos, sin):
    bsz, n, _ = cq.shape
    q = (rms_norm(cq, g_q) @ w_uq).reshape(bsz, n, MLA_HEADS, QK_HEAD_DIM)
    q_nope, q_rope = q[..., :QK_NOPE_DIM], q[..., QK_NOPE_DIM:]
    if cos is not None:
        q_rope = axial_rope(q_rope, cos, sin)
    return jnp.concatenate([q_nope, q_rope], axis=-1)


def softmax_attention(q, k, v):
    s = jnp.einsum('bqhd,bkhd->bhqk', q, k).astype(jnp.float32) * MLA_SCALE
    p = jax.nn.softmax(s, axis=-1).astype(v.dtype)
    return jnp.einsum('bhqk,bkhd->bqhd', p, v)


def token_mixers(h_lat, h_ctx, cos, sin, w_in, lru_conv_w, lru_conv_b, lru_w_a, lru_b_a,
                 lru_w_x, lru_b_x, lru_lambda, mla_g_q, mla_w_uq, mla_g_kv, mla_w_ukv, w_out,
                 with_ctx_out):
    bsz, n_lat, _ = h_lat.shape
    n_ctx = h_ctx.shape[1]
    xr_l, gr_l, cq_l, ckv_l, kr_l = split_in_proj(h_lat @ w_in)
    xr_c, gr_c, cq_c, ckv_c, kr_c = split_in_proj(h_ctx @ w_in)

    xcv_l = dwconv(xr_l, lru_conv_w, lru_conv_b, LRU_CONV_LEFT)
    xcv_c = dwconv(xr_c, lru_conv_w, lru_conv_b, LRU_CONV_LEFT)
    lat_states, ctx_states = [], []
    for d, reverse in enumerate((False, True)):
        params_d = (lru_w_a[d], lru_b_a[d], lru_w_x[d], lru_b_x[d], lru_lambda[d])
        a_c, u_c = rglru_coeffs(xcv_c, *params_d)
        h_c = linear_scan(a_c, u_c, None, reverse)
        h0 = h_c[:, 0] if reverse else h_c[:, -1]
        a_l, u_l = rglru_coeffs(xcv_l, *params_d)
        lat_states.append(linear_scan(a_l, u_l, h0, reverse))
        ctx_states.append(h_c)
    y_lru_l = (lat_states[0] + lat_states[1]).astype(h_lat.dtype) * jax.nn.gelu(gr_l)

    k_c, v_c = mla_keys_values(ckv_c, kr_c, mla_g_kv, mla_w_ukv, None, None)
    k_l, v_l = mla_keys_values(ckv_l, kr_l, mla_g_kv, mla_w_ukv, cos, sin)
    q_l = mla_queries(cq_l, mla_g_q, mla_w_uq, cos[:, None], sin[:, None])
    k_all = jnp.concatenate([k_c, k_l], axis=1)
    v_all = jnp.concatenate([v_c, v_l], axis=1)
    n_blocks = n_lat // Q_BLOCK
    q_blocks = q_l.reshape(bsz, n_blocks, Q_BLOCK, MLA_HEADS, QK_HEAD_DIM).swapaxes(0, 1)
    o_blocks = lax.map(lambda qb: softmax_attention(qb, k_all, v_all), q_blocks)
    y_mla_l = o_blocks.swapaxes(0, 1).reshape(bsz, n_lat, MLA_WIDTH)
    y_lat = jnp.concatenate([y_lru_l, y_mla_l], axis=-1) @ w_out
    if not with_ctx_out:
        return y_lat, None

    y_lru_c = (ctx_states[0] + ctx_states[1]).astype(h_ctx.dtype) * jax.nn.gelu(gr_c)
    q_c = mla_queries(cq_c, mla_g_q, mla_w_uq, None, None)
    y_mla_c = softmax_attention(q_c, k_c, v_c).reshape(bsz, n_ctx, MLA_WIDTH)
    y_ctx = jnp.concatenate([y_lru_c, y_mla_c], axis=-1) @ w_out
    return y_lat, y_ctx


def conv_ffn(h, w_up, conv_w, conv_b, w_down):
    up = dwconv(h @ w_up, conv_w, conv_b, FFN_CONV_LEFT)
    u, g = up[..., :D_FF], up[..., D_FF:]
    return (jax.nn.silu(g) * u) @ w_down


def setup_inputs(seed: int = 0) -> dict:
    key = jax.random.key(seed)
    ks = jax.random.split(key, 32)
    L = DEPTH
    f32 = jnp.float32

    def nrm(k, shape, scale):
        return jax.random.normal(k, shape, f32) * scale

    def gain(k, shape):
        return 1.0 + 0.1 * jax.random.normal(k, shape, f32)

    a8 = jax.random.uniform(ks[17], (L, 2, LRU_WIDTH), f32, minval=0.9, maxval=0.999)
    a_base = a8 ** (1.0 / LRU_C)
    lam = jnp.log(a_base) - jnp.log1p(-a_base)
    return {
        "x": nrm(ks[0], (BATCH, SEQ, D_MODEL), 1.0),
        "c": nrm(ks[1], (BATCH, D_MODEL), 1.0),
        "ctx": nrm(ks[2], (BATCH, CTX_LEN, D_MODEL), 1.0),
        "c_ctx": nrm(ks[3], (D_MODEL,), 1.0),
        "w_mod": nrm(ks[4], (L, D_MODEL, N_MOD * D_MODEL), D_MODEL ** -0.5),
        "b_mod": nrm(ks[5], (L, N_MOD * D_MODEL), 0.02),
        "g_pre_mix": gain(ks[6], (L, D_MODEL)),
        "g_post_mix": gain(ks[7], (L, D_MODEL)),
        "g_pre_ffn": gain(ks[8], (L, D_MODEL)),
        "g_post_ffn": gain(ks[9], (L, D_MODEL)),
        "w_in": nrm(ks[10], (L, D_MODEL, IN_PROJ_WIDTH), D_MODEL ** -0.5),
        "lru_conv_w": nrm(ks[11], (L, LRU_CONV_W, LRU_WIDTH), LRU_CONV_W ** -0.5),
        "lru_conv_b": nrm(ks[12], (L, LRU_WIDTH), 0.02),
        "lru_w_a": nrm(ks[13], (L, 2, LRU_HEADS, LRU_HEAD_DIM, LRU_HEAD_DIM), LRU_HEAD_DIM ** -0.5),
        "lru_b_a": nrm(ks[14], (L, 2, LRU_WIDTH), 0.1),
        "lru_w_x": nrm(ks[15], (L, 2, LRU_HEADS, LRU_HEAD_DIM, LRU_HEAD_DIM), LRU_HEAD_DIM ** -0.5),
        "lru_b_x": nrm(ks[16], (L, 2, LRU_WIDTH), 0.1),
        "lru_lambda": lam,
        "mla_g_q": gain(ks[18], (L, Q_LORA_RANK)),
        "mla_w_uq": nrm(ks[19], (L, Q_LORA_RANK, MLA_HEADS * QK_HEAD_DIM), Q_LORA_RANK ** -0.5),
        "mla_g_kv": gain(ks[20], (L, KV_LORA_RANK)),
        "mla_w_ukv": nrm(ks[21], (L, KV_LORA_RANK, MLA_HEADS * (QK_NOPE_DIM + V_HEAD_DIM)), KV_LORA_RANK ** -0.5),
        "w_out": nrm(ks[22], (L, MIX_WIDTH, D_MODEL), MIX_WIDTH ** -0.5),
        "ffn_w_up": nrm(ks[23], (L, D_MODEL, 2 * D_FF), D_MODEL ** -0.5),
        "ffn_conv_w": nrm(ks[24], (L, FFN_CONV_W, 2 * D_FF), FFN_CONV_W ** -0.5),
        "ffn_conv_b": nrm(ks[25], (L, 2 * D_FF), 0.02),
        "ffn_w_down": nrm(ks[26], (L, D_FF, D_MODEL), D_FF ** -0.5),
    }


def reference(x, c, ctx, c_ctx, w_mod, b_mod, g_pre_mix, g_post_mix, g_pre_ffn, g_post_ffn,
              w_in, lru_conv_w, lru_conv_b, lru_w_a, lru_b_a, lru_w_x, lru_b_x, lru_lambda,
              mla_g_q, mla_w_uq, mla_g_kv, mla_w_ukv, w_out, ffn_w_up, ffn_conv_w, ffn_conv_b,
              ffn_w_down):
    n_lat = x.shape[1]
    cos, sin = axial_rope_tables(n_lat, x.dtype)
    xc = ctx
    for l in range(DEPTH):
        last = l == DEPTH - 1
        mod_l = jax.nn.silu(c) @ w_mod[l] + b_mod[l]
        mod_c = jax.nn.silu(c_ctx) @ w_mod[l] + b_mod[l]
        sh1, sc1, gt1, sh2, sc2, gt2 = jnp.split(mod_l[:, None, :], N_MOD, axis=-1)
        csh1, csc1, cgt1, csh2, csc2, cgt2 = jnp.split(mod_c, N_MOD, axis=-1)

        h_l = modulate(rms_norm(x, g_pre_mix[l]), sh1, sc1)
        h_c = modulate(rms_norm(xc, g_pre_mix[l]), csh1, csc1)
        y_l, y_c = token_mixers(h_l, h_c, cos, sin, w_in[l], lru_conv_w[l], lru_conv_b[l],
                                lru_w_a[l], lru_b_a[l], lru_w_x[l], lru_b_x[l], lru_lambda[l],
                                mla_g_q[l], mla_w_uq[l], mla_g_kv[l], mla_w_ukv[l], w_out[l],
                                not last)
        x = x + gt1 * rms_norm(y_l, g_post_mix[l])
        f_l = conv_ffn(modulate(rms_norm(x, g_pre_ffn[l]), sh2, sc2),
                       ffn_w_up[l], ffn_conv_w[l], ffn_conv_b[l], ffn_w_down[l])
        x = x + gt2 * rms_norm(f_l, g_post_ffn[l])

        if not last:
            xc = xc + cgt1 * rms_norm(y_c, g_post_mix[l])
            f_c = conv_ffn(modulate(rms_norm(xc, g_pre_ffn[l]), csh2, csc2),
                           ffn_w_up[l], ffn_conv_w[l], ffn_conv_b[l], ffn_w_down[l])
            xc = xc + cgt2 * rms_norm(f_c, g_post_ffn[l])
    return x
```

```cpp
#include <hip/hip_runtime.h>
#include <hip/hip_cooperative_groups.h>
#include <cstdio>
#include <cstdint>
namespace cg = cooperative_groups;
#ifndef MK_COOP
#define MK_COOP 1
#endif
namespace pg8 {
#define PG8_LAS __attribute__((address_space(3)))
typedef unsigned short bf16_t;
typedef short bf16x8 __attribute__((ext_vector_type(8)));
typedef float f32x4 __attribute__((ext_vector_type(4)));
typedef unsigned u32x4 __attribute__((ext_vector_type(4)));
constexpr int BM = 256, BK = 64, HALF = 128, HTB = HALF * BK * 2  , STAGE_BYTES = 8 * HTB, NXCD = 8, WGM = 8;

__host__ __device__ __forceinline__ int lds_byte(int r, int c) { const int st = (r >> 4) * 2 + (c >> 5), rr = r & 15, cc = c & 31, ob = rr * 64 + cc * 2; return st * 1024 + (ob ^ (((ob >> 9) & 1) << 5)); }
__host__ __device__ __forceinline__ void stage_rc(int b, int& R, int& C) { const int st = b / 1024, sb = b % 1024, swz = sb ^ (((sb >> 9) & 1) << 5); R = (st >> 1) * 16 + swz / 64; C = (st & 1) * 32 + (swz % 64) / 2; }
__host__ __device__ __forceinline__ int perm32(int rho) { const int n = rho >> 4, i = rho & 15; return 8 * (i >> 2) + 4 * n + (i & 3); }

struct Unit { int pm, pn; };
struct Gemm { const bf16_t* A; const bf16_t* Bt; int M, N, K, lda, ldb; };

struct StaticOrder {
    int nM, nN, nwg, G, c;
    __host__ __device__ void init(int M, int N, int G_, int c_) { nM = M / BM; nN = N / BM; nwg = nM * nN; G = G_; c = c_; }
    __host__ __device__ bool next(int i, Unit& u) const {
        const long L = (long)i * G + c; if (L >= nwg) return false;
        int wgid = (int)L; { const int q = nwg / NXCD, r = nwg % NXCD, xcd = wgid % NXCD, off = wgid / NXCD; wgid = (xcd < r ? xcd * (q + 1) : r * (q + 1) + (xcd - r) * q) + off; }
        const int nig = WGM * nN, gid = wgid / nig, fm = gid * WGM, gsz = (nM - fm) < WGM ? (nM - fm) : WGM;
        u.pm = fm + ((wgid % nig) % gsz); u.pn = (wgid % nig) / gsz; return true;
    }
    __device__ __forceinline__ void a_ready(const Unit&) const {}
    __device__ __forceinline__ void done(const Unit&) const {}
};

__device__ __forceinline__ unsigned cvt_pk_bf16(float lo, float hi) { unsigned r; asm volatile("v_cvt_pk_bf16_f32 %0, %1, %2" : "=v"(r) : "v"(lo), "v"(hi)); return r; }
typedef float f32x2 __attribute__((ext_vector_type(2)));
__device__ __forceinline__ f32x2 gelu_pk(f32x2 v) {
    const f32x2 av = __builtin_elementwise_abs(v), d = av * 0.2316418882f + 1.0f;
    f32x2 t; t.x = __builtin_amdgcn_rcpf(d.x); t.y = __builtin_amdgcn_rcpf(d.y);
    f32x2 q = t * 0.5307027145f + (-0.7265760135f); q = q * t + 0.7107068705f; q = q * t + (-0.142248368f); q = q * t + 0.127414796f; q = q * t;
    const f32x2 s = (v * v) * (-0.72134752044f);
    f32x2 e; e.x = __builtin_amdgcn_exp2f(s.x); e.y = __builtin_amdgcn_exp2f(s.y);
    const f32x2 m = v * (q * e), r = v - m;
    f32x2 o; o.x = v.x < 0.f ? m.x : r.x; o.y = v.y < 0.f ? m.y : r.y; return o;
}

template <int ACT  > struct EpiBf16 {
    static constexpr bool PERM = true, AFTER_DRAIN = false; static_assert(ACT == 0 || ACT == 1, "EpiBf16: ACT is 0 (none) or 1 (gelu_pk)");
    bf16_t* O; int ldc; const float* bias; int split_cols; size_t split_stride; float scale0;
    __device__ __forceinline__ void operator()(const f32x4 (&acc)[2][2][4][2], const Unit& u, int wr, int wc, int fr, int fq) const {
        const int row0 = u.pm * BM + wr * 64 + fr; int colt = u.pn * BM; bf16_t* base = O;
        float sc = 1.f; if (split_cols) { const int t = colt / split_cols; base += (size_t)t * split_stride; colt -= t * split_cols; if (t == 0) sc = scale0; }
        const int col0 = colt + wc * 32 + 8 * fq, bcol0 = u.pn * BM + wc * 32 + 8 * fq;
        f32x4 bv[2][2];
#pragma unroll
        for (int bj = 0; bj < 2; ++bj)
#pragma unroll
            for (int n = 0; n < 2; ++n) bv[bj][n] = bias ? *(const f32x4*)(bias + bcol0 + bj * HALF + 4 * n) : (f32x4){0.f, 0.f, 0.f, 0.f};
#pragma unroll
        for (int ai = 0; ai < 2; ++ai)
#pragma unroll
            for (int m = 0; m < 4; ++m) { bf16_t* rowp = base + (size_t)(row0 + ai * HALF + m * 16) * ldc + col0;
#pragma unroll
                for (int bj = 0; bj < 2; ++bj) { f32x4 v0 = acc[ai][bj][m][0] + bv[bj][0], v1 = acc[ai][bj][m][1] + bv[bj][1];
                    if (ACT == 1) { f32x2 a = gelu_pk((f32x2){v0[0], v0[1]}), b = gelu_pk((f32x2){v0[2], v0[3]}), c = gelu_pk((f32x2){v1[0], v1[1]}), d = gelu_pk((f32x2){v1[2], v1[3]});
                        v0 = (f32x4){a.x, a.y, b.x, b.y}; v1 = (f32x4){c.x, c.y, d.x, d.y}; }
                    v0 = v0 * sc; v1 = v1 * sc; u32x4 w; w.x = cvt_pk_bf16(v0[0], v0[1]); w.y = cvt_pk_bf16(v0[2], v0[3]); w.z = cvt_pk_bf16(v1[0], v1[1]); w.w = cvt_pk_bf16(v1[2], v1[3]);
                    *(u32x4*)(rowp + bj * HALF) = w; } }
    }
};
template <class Epi, class Sched, bool ALIGN_EPI = false, bool SP2 = false>
__device__ __forceinline__ void gemm_phase(PG8_LAS unsigned char* lds, const Gemm g, const Sched& S, const Epi& E) {
    const int tid = threadIdx.x, wid = __builtin_amdgcn_readfirstlane(tid >> 6), lane = tid & 63, wr = wid >> 2, wc = wid & 3, fr = lane & 15, fq = lane >> 4;
    const int K = g.K, nt = K / BK;
    unsigned voffA[2], voffB[2];
#pragma unroll
    for (int i = 0; i < 2; ++i) { int R, C; stage_rc(tid * 16 + i * 8192, R, C); const int Rb = Epi::PERM ? ((R & ~31) + perm32(R & 31)) : R;
        voffA[i] = (unsigned)(R * g.lda + C) * 2u; voffB[i] = (unsigned)(Rb * g.ldb + C) * 2u; }
    const size_t kstep = (size_t)(BK * 2);
    const size_t hstepA = (size_t)HALF * g.lda * 2, hstepB = (size_t)HALF * g.ldb * 2;
    const size_t tstepA = 2 * hstepA, tstepB = 2 * hstepB;
    const unsigned ldsw = (unsigned)wid * 1024u;
    const int aoff = lds_byte(wr * 64 + fr, fq * 8), boff = lds_byte(wc * 32 + fr, fq * 8);
#define PG8_SA(b, h) (((b) * 2 + (h)) * HTB)
#define PG8_SB(b, h) ((4 + (b) * 2 + (h)) * HTB)
#define PG8_STAGE(bufoff, gbase, voff) do { _Pragma("unroll") for (int _i = 0; _i < 2; ++_i) \
        __builtin_amdgcn_global_load_lds((const unsigned*)((const char*)(gbase) + (voff)[_i]), (PG8_LAS unsigned*)(lds + (bufoff) + ldsw + _i * 8192), 16, 0, 0); } while (0)
#define PG8_LDA(dst, b, h) do { _Pragma("unroll") for (int m = 0; m < 4; ++m) _Pragma("unroll") for (int k = 0; k < 2; ++k) dst[m][k] = *(const PG8_LAS bf16x8*)(lds + PG8_SA(b, h) + aoff + m * 2048 + k * 1024); } while (0)
#define PG8_LDB(dst, b, h) do { _Pragma("unroll") for (int n = 0; n < 2; ++n) _Pragma("unroll") for (int k = 0; k < 2; ++k) dst[n][k] = *(const PG8_LAS bf16x8*)(lds + PG8_SB(b, h) + boff + n * 2048 + k * 1024); } while (0)
#define PG8_MMA(ai, bj, At, Bt) do { __builtin_amdgcn_s_setprio(1); _Pragma("unroll") for (int m = 0; m < 4; ++m) _Pragma("unroll") for (int n = 0; n < 2; ++n) _Pragma("unroll") for (int k = 0; k < 2; ++k) \
        acc[ai][bj][m][n] = __builtin_amdgcn_mfma_f32_16x16x32_bf16(Bt[n][k], At[m][k], acc[ai][bj][m][n], 0, 0, 0); __builtin_amdgcn_s_setprio(0); } while (0)
#define PG8_WAIT_V(n) asm volatile("s_waitcnt vmcnt(" #n ")" ::: "memory")
#define PG8_WAIT_L(n) asm volatile("s_waitcnt lgkmcnt(" #n ")" ::: "memory")
#define PG8_BAR __builtin_amdgcn_s_barrier()
#define PG8_SCHED __builtin_amdgcn_sched_barrier(0)
    Unit cur, nxt; int ui = 0;
    if (!S.next(0, cur)) return;
    f32x4 acc[2][2][4][2];
#pragma unroll
    for (int a = 0; a < 2; ++a)
#pragma unroll
        for (int b = 0; b < 2; ++b)
#pragma unroll
            for (int m = 0; m < 4; ++m)
#pragma unroll
                for (int n = 0; n < 2; ++n) acc[a][b][m][n] = (f32x4){0.f, 0.f, 0.f, 0.f};
    bf16x8 At[4][2], B0[2][2], B1[2][2];
    const char* cA = (const char*)g.A + (size_t)cur.pm * tstepA; const char* cB = (const char*)g.Bt + (size_t)cur.pn * tstepB;
    S.a_ready(cur);
    if constexpr (SP2) {
        PG8_STAGE(PG8_SB(0, 0), cB, voffB); PG8_STAGE(PG8_SB(0, 1), cB + hstepB, voffB); PG8_STAGE(PG8_SA(0, 0), cA, voffA); PG8_STAGE(PG8_SA(0, 1), cA + hstepA, voffA);
        if (wr == 1) PG8_BAR;
        PG8_WAIT_V(2); PG8_BAR;
        PG8_STAGE(PG8_SB(1, 0), cB + kstep, voffB); PG8_STAGE(PG8_SA(1, 0), cA + kstep, voffA); PG8_STAGE(PG8_SB(1, 1), cB + hstepB + kstep, voffB);
        PG8_WAIT_V(6); PG8_BAR;
    } else {
        PG8_STAGE(PG8_SB(0, 0), cB, voffB); PG8_STAGE(PG8_SA(0, 0), cA, voffA); PG8_STAGE(PG8_SB(0, 1), cB + hstepB, voffB); PG8_STAGE(PG8_SA(0, 1), cA + hstepA, voffA);
        if (wr == 1) PG8_BAR;
        PG8_WAIT_V(4); PG8_BAR;
        PG8_STAGE(PG8_SB(1, 0), cB + kstep, voffB); PG8_STAGE(PG8_SA(1, 0), cA + kstep, voffA); PG8_STAGE(PG8_SB(1, 1), cB + hstepB + kstep, voffB);
        PG8_WAIT_V(6); PG8_BAR;
    }
    for (;;) {
        const bool has_next = S.next(ui + 1, nxt);
        const char* nA = has_next ? (const char*)g.A + (size_t)nxt.pm * tstepA : cA; const char* nB = has_next ? (const char*)g.Bt + (size_t)nxt.pn * tstepB : cB;
        for (int t = 0; t < nt; t += 2) {
            const bool last = (t == nt - 2);
            const char* a1 = cA + (size_t)(t + 1) * kstep;
            const char* a2 = last ? nA : cA + (size_t)(t + 2) * kstep; const char* b2 = last ? nB : cB + (size_t)(t + 2) * kstep;
            const char* a3 = a2 + kstep; const char* b3 = b2 + kstep;
            if (last && has_next) S.a_ready(nxt);
            if constexpr (SP2) {
            PG8_LDB(B0, 0, 0); PG8_LDB(B1, 0, 1); PG8_SCHED; PG8_LDA(At, 0, 0); PG8_STAGE(PG8_SA(1, 1), a1 + hstepA, voffA);
            PG8_WAIT_V(8); PG8_WAIT_L(0); PG8_BAR; PG8_MMA(0, 0, At, B0); PG8_MMA(0, 1, At, B1); PG8_BAR; PG8_SCHED;
            PG8_LDA(At, 0, 1); PG8_STAGE(PG8_SB(0, 0), b2, voffB); PG8_STAGE(PG8_SB(0, 1), b2 + hstepB, voffB); PG8_STAGE(PG8_SA(0, 0), a2, voffA);
            PG8_WAIT_V(8); PG8_WAIT_L(0); PG8_BAR; PG8_MMA(1, 0, At, B0); PG8_MMA(1, 1, At, B1); PG8_BAR; PG8_SCHED;
            PG8_LDB(B0, 1, 0); PG8_LDB(B1, 1, 1); PG8_SCHED; PG8_LDA(At, 1, 0); PG8_STAGE(PG8_SA(0, 1), a2 + hstepA, voffA);
            PG8_WAIT_V(8); PG8_WAIT_L(0); PG8_BAR; PG8_MMA(0, 0, At, B0); PG8_MMA(0, 1, At, B1); PG8_BAR; PG8_SCHED;
            PG8_LDA(At, 1, 1); PG8_STAGE(PG8_SB(1, 0), b3, voffB); PG8_STAGE(PG8_SB(1, 1), b3 + hstepB, voffB); PG8_STAGE(PG8_SA(1, 0), a3, voffA);
            PG8_WAIT_V(8); PG8_WAIT_L(0); PG8_BAR; PG8_MMA(1, 0, At, B0); PG8_MMA(1, 1, At, B1); PG8_BAR; PG8_SCHED;
            } else {
            PG8_LDB(B0, 0, 0); PG8_SCHED; PG8_LDA(At, 0, 0); PG8_STAGE(PG8_SA(1, 1), a1 + hstepA, voffA);
            PG8_WAIT_L(8); PG8_BAR; PG8_WAIT_L(0); PG8_MMA(0, 0, At, B0); PG8_BAR; PG8_SCHED;
            PG8_LDB(B1, 0, 1); PG8_STAGE(PG8_SB(0, 0), b2, voffB);
            PG8_BAR; PG8_WAIT_L(0); PG8_MMA(0, 1, At, B1); PG8_BAR;
            PG8_LDA(At, 0, 1); PG8_STAGE(PG8_SA(0, 0), a2, voffA);
            PG8_BAR; PG8_WAIT_L(0); PG8_MMA(1, 0, At, B0); PG8_BAR; PG8_SCHED;
            PG8_STAGE(PG8_SB(0, 1), b2 + hstepB, voffB);
            PG8_WAIT_V(6); PG8_BAR; PG8_MMA(1, 1, At, B1); PG8_BAR;
            PG8_LDB(B0, 1, 0); PG8_SCHED; PG8_LDA(At, 1, 0); PG8_STAGE(PG8_SA(0, 1), a2 + hstepA, voffA);
            PG8_WAIT_L(8); PG8_BAR; PG8_WAIT_L(0); PG8_MMA(0, 0, At, B0); PG8_BAR; PG8_SCHED;
            PG8_LDB(B1, 1, 1); PG8_STAGE(PG8_SB(1, 0), b3, voffB);
            PG8_BAR; PG8_WAIT_L(0); PG8_MMA(0, 1, At, B1); PG8_BAR;
            PG8_LDA(At, 1, 1); PG8_STAGE(PG8_SA(1, 0), a3, voffA);
            PG8_BAR; PG8_WAIT_L(0); PG8_MMA(1, 0, At, B0); PG8_BAR; PG8_SCHED;
            PG8_STAGE(PG8_SB(1, 1), b3 + hstepB, voffB);
            PG8_WAIT_V(6); PG8_BAR; PG8_MMA(1, 1, At, B1); PG8_BAR;
            }
        }
        if constexpr (ALIGN_EPI) { if (wr == 0) PG8_BAR; }
        if constexpr (!Epi::AFTER_DRAIN) { E(acc, cur, wr, wc, fr, fq); S.done(cur); }
        if (!has_next) break;
#pragma unroll
        for (int a = 0; a < 2; ++a)
#pragma unroll
            for (int b = 0; b < 2; ++b)
#pragma unroll
                for (int m = 0; m < 4; ++m)
#pragma unroll
                    for (int n = 0; n < 2; ++n) acc[a][b][m][n] = (f32x4){0.f, 0.f, 0.f, 0.f};
        cur = nxt; cA = nA; cB = nB; ++ui;
        if constexpr (ALIGN_EPI) { if (wr == 1) PG8_BAR; }
    }
    PG8_WAIT_V(0);
    if constexpr (!ALIGN_EPI) { if (wr == 0) PG8_BAR; }
    PG8_BAR;
    if constexpr (Epi::AFTER_DRAIN) { E.fused(acc, cur, wr, wc, fr, fq, lds, wid, lane); S.done(cur); }
#undef PG8_SA
#undef PG8_SB
#undef PG8_STAGE
#undef PG8_LDA
#undef PG8_LDB
#undef PG8_MMA
#undef PG8_WAIT_V
#undef PG8_WAIT_L
#undef PG8_BAR
#undef PG8_SCHED
}
}
#define LAS __attribute__((address_space(3)))
typedef unsigned short bf16_t;
typedef short bf16x8 __attribute__((ext_vector_type(8)));
typedef short s16x4 __attribute__((ext_vector_type(4)));
typedef float f32x4 __attribute__((ext_vector_type(4)));
typedef float f32x16 __attribute__((ext_vector_type(16)));
typedef unsigned u32x4 __attribute__((ext_vector_type(4)));
typedef unsigned u32x2 __attribute__((ext_vector_type(2)));

constexpr int NB = 8, SEQ = 8192, DM = 1024, CTX = 256, MLAT = NB * SEQ, MCTX = NB * CTX, MALL = MLAT + MCTX;
constexpr int PW = 1536, KVLEN = CTX + SEQ, DFF = 2816, NMOD = 6 * DM;
constexpr int NCH = 32, CHL = 256;
constexpr float EPS = 1e-6f;
constexpr float QSCALE = 0.10206207261596575f * 1.4426950408889634f;
constexpr size_t MiB = 1u << 20;
constexpr size_t WS_CTL = 0, CTL_BYTES = 2 * MiB;
constexpr size_t WS_MOD = 64 * 1024, WS_SSQ = 512 * 1024, WS_SSKV = 1024 * 1024;
constexpr size_t WS_WIN = 2 * MiB, WS_WQ = 5 * MiB, WS_WKV = 6 * MiB, WS_WG = 7 * MiB, WS_WOUT = 8 * MiB, WS_WUP = 10 * MiB, WS_WDN = 21 * MiB;
constexpr size_t WS_AGG = 27 * MiB, WS_ROPE = 29 * MiB + 512 * 1024;
constexpr size_t WS_R1 = 30 * MiB;
constexpr size_t WS_R2 = 162 * MiB;
constexpr size_t WS_LU = 360 * MiB, WS_K = 624 * MiB, WS_V = 723 * MiB, WS_A2 = 789 * MiB;
constexpr size_t WS_UP = 360 * MiB, WS_G = 712 * MiB, WS_Q = 920 * MiB, WS_END = 1016 * MiB;
constexpr int LDS_BYTES = 139264;

__device__ __forceinline__ unsigned f2bf(float f) { unsigned u = __builtin_bit_cast(unsigned, f); return (u + 0x7fffu + ((u >> 16) & 1u)) >> 16; }
__device__ __forceinline__ unsigned pk2(float lo, float hi) { return f2bf(lo) | (f2bf(hi) << 16); }
__device__ __forceinline__ float bflo(unsigned w) { return __uint_as_float(w << 16); }
__device__ __forceinline__ float bfhi(unsigned w) { return __uint_as_float(w & 0xffff0000u); }
__device__ __forceinline__ float bf2f(bf16_t v) { return __uint_as_float((unsigned)v << 16); }
__device__ __forceinline__ int crow(int r, int hi) { return (r & 3) + 8 * (r >> 2) + 4 * hi; }
__device__ __forceinline__ float wave_sum(float v) {
#pragma unroll
    for (int o = 1; o < 64; o <<= 1) v += __shfl_xor(v, o);
    return v;
}
__device__ __forceinline__ float sigmoidf_(float x) { return 1.f / (1.f + __expf(-x)); }
#define LDS_WAIT() asm volatile("s_waitcnt lgkmcnt(0)" ::: "memory")

struct Args { const float* in[27]; float* out; unsigned char* ws; int ph_lo, ph_hi; };
__device__ __forceinline__ const float* argp(int i) {
    const __attribute__((address_space(4))) char* kp = (const __attribute__((address_space(4))) char*)__builtin_amdgcn_kernarg_segment_ptr();
    asm volatile("" : "+s"(kp));
    return *(const float* const __attribute__((address_space(4)))*)(kp + 8 * i);
}

template <int ID> __device__ __forceinline__ float wsrc(const float* p0, const float* p1, int n, int k) {
    if (ID == 0) return n < 1440 ? p0[(size_t)k * 1440 + n] : 0.f;
    if (ID == 1) return p0[k] * p1[(size_t)k * 768 + n];
    if (ID == 2) return k < 128 ? p0[k] * p1[(size_t)k * 1024 + n] : 0.f;
    if (ID == 3) { const int h = n >> 8, np = n & 255, mat = np >> 6, j = np & 63, dir = mat >> 1; const float* w = (mat & 1) ? p1 : p0; return w[(size_t)((dir * 8 + h) * 64 + k) * 64 + j]; }
    if (ID == 4) return p0[(size_t)k * 1024 + n];
    if (ID == 5) return p0[(size_t)k * 5632 + n];
    return p0[(size_t)k * 1024 + n];
}
template <int ID> __device__ __forceinline__ void prep_mat(const float* p0, const float* p1, bf16_t* dst, int N, int K, int gtid, int NT) {
    const int items = N * (K / 8);
    for (int it = gtid; it < items; it += NT) {
        const int n = it % N, k8 = it / N;
        u32x4 o;
        o.x = pk2(wsrc<ID>(p0, p1, n, 8 * k8 + 0), wsrc<ID>(p0, p1, n, 8 * k8 + 1)); o.y = pk2(wsrc<ID>(p0, p1, n, 8 * k8 + 2), wsrc<ID>(p0, p1, n, 8 * k8 + 3));
        o.z = pk2(wsrc<ID>(p0, p1, n, 8 * k8 + 4), wsrc<ID>(p0, p1, n, 8 * k8 + 5)); o.w = pk2(wsrc<ID>(p0, p1, n, 8 * k8 + 6), wsrc<ID>(p0, p1, n, 8 * k8 + 7));
        *(u32x4*)(dst + (size_t)n * K + 8 * k8) = o;
    }
}
__device__ __forceinline__ void mod_phase(const float* cvec, const float* cctx, const float* wmod, const float* bmod, float* mod, LAS float* scr, int gw, int NGW, int lane) {
    for (int task = gw; task < 96 * 16; task += NGW) {
        const int cgp = task % 96, kc = task / 96, n = cgp * 64 + lane, k0 = kc * 64;
#pragma unroll
        for (int r = 0; r < 9; ++r) { const float cv = r < 8 ? cvec[r * 1024 + k0 + lane] : cctx[k0 + lane]; scr[r * 64 + lane] = cv / (1.f + __expf(-cv)); }
        LDS_WAIT();
        float acc[9];
#pragma unroll
        for (int r = 0; r < 9; ++r) acc[r] = 0.f;
#pragma unroll 8
        for (int kk = 0; kk < 64; ++kk) { const float w = wmod[(size_t)(k0 + kk) * NMOD + n];
#pragma unroll
            for (int r = 0; r < 9; ++r) acc[r] += scr[r * 64 + kk] * w; }
        const float bias = kc == 0 ? bmod[n] : 0.f;
#pragma unroll
        for (int r = 0; r < 9; ++r) atomicAdd(mod + r * NMOD + n, acc[r] + bias);
        LDS_WAIT();
    }
}
__device__ __forceinline__ void p1_rows(const float* x, const float* ctx, const float* g, const float* mod, bf16_t* H, int gw, int NGW, int lane) {
    for (int m = gw; m < MALL; m += NGW) {
        const float* src = m < MLAT ? x + (size_t)m * DM : ctx + (size_t)(m - MLAT) * DM;
        const float* md = mod + (m < MLAT ? (m >> 13) : 8) * NMOD;
        f32x4 v[4]; float ss = 0.f;
#pragma unroll
        for (int j = 0; j < 4; ++j) { v[j] = *(const f32x4*)(src + 4 * lane + 256 * j); ss += v[j].x * v[j].x + v[j].y * v[j].y + v[j].z * v[j].z + v[j].w * v[j].w; }
        const float rs = rsqrtf(wave_sum(ss) * (1.f / DM) + EPS);
#pragma unroll
        for (int j = 0; j < 4; ++j) { const int k = 4 * lane + 256 * j;
            const f32x4 gg = *(const f32x4*)(g + k), sh = *(const f32x4*)(md + k), sc = *(const f32x4*)(md + DM + k);
            const f32x4 y = v[j] * rs * gg * (sc + 1.f) + sh;
            u32x2 o; o.x = pk2(y.x, y.y); o.y = pk2(y.z, y.w); *(u32x2*)(H + (size_t)m * DM + k) = o; }
    }
}
__device__ __forceinline__ void ss_phase(const bf16_t* P, float* ssq, float* sskv, int gw, int NGW, int lane) {
    for (int m = gw; m < MALL; m += NGW) {
        const u32x2 q = *(const u32x2*)(P + (size_t)m * PW + 1024 + 4 * lane); const unsigned k = *(const unsigned*)(P + (size_t)m * PW + 1280 + 2 * lane);
        float a = bflo(q.x) * bflo(q.x) + bfhi(q.x) * bfhi(q.x) + bflo(q.y) * bflo(q.y) + bfhi(q.y) * bfhi(q.y), c = bflo(k) * bflo(k) + bfhi(k) * bfhi(k);
        a = wave_sum(a); c = wave_sum(c);
        if (lane == 0) { ssq[m] = a; sskv[m] = c; }
    }
}
__device__ __forceinline__ void qpost_phase(const bf16_t* QR, const float* ssq, const float* RT, bf16_t* Q, int gtid, int NT) {
    for (int task = gtid; task < MLAT * 96; task += NT) {
        const int row = task / 96, c8 = task - row * 96, h = c8 / 12, dc = c8 - h * 12, b = row >> 13, s = row & 8191;
        const float sc = rsqrtf(ssq[row] * (1.f / 256.f) + EPS) * QSCALE;
        const u32x4 mine = *(const u32x4*)(QR + (size_t)row * 768 + 8 * c8);
        float v[8];
#pragma unroll
        for (int j = 0; j < 4; ++j) { v[2 * j] = bflo(mine[j]) * sc; v[2 * j + 1] = bfhi(mine[j]) * sc; }
        if (dc >= 8) { const int fq = dc - 8; const u32x4 oth = *(const u32x4*)(QR + (size_t)row * 768 + 8 * (c8 ^ 1));
            const float* rt = RT + (fq < 2 ? (s >> 6) : (s & 63)) * 16;
#pragma unroll
            for (int j = 0; j < 8; ++j) { const float pt = ((j & 1) ? bfhi(oth[j >> 1]) : bflo(oth[j >> 1])) * sc, cs = rt[2 * j], sn = rt[2 * j + 1];
                v[j] = (fq & 1) ? v[j] * cs + pt * sn : v[j] * cs - pt * sn; } }
        u32x4 w; w.x = pk2(v[0], v[1]); w.y = pk2(v[2], v[3]); w.z = pk2(v[4], v[5]); w.w = pk2(v[6], v[7]);
        *(u32x4*)(Q + ((size_t)((b * 8 + h) * SEQ + s)) * 96 + 8 * dc) = w;
    }
}
__device__ __forceinline__ void kvpost_phase(const bf16_t* KVR, const float* sskv, bf16_t* Kb, bf16_t* Vb, int gtid, int NT) {
    for (int task = gtid; task < MALL * 128; task += NT) {
        const int row = task >> 7, c8 = task & 127, h = c8 >> 4, dd = (c8 & 15) * 8; const bool lat = row < MLAT;
        const int b = lat ? (row >> 13) : ((row - MLAT) >> 8), pos = lat ? (CTX + (row & 8191)) : ((row - MLAT) & 255);
        const float rs = rsqrtf(sskv[row] * (1.f / 128.f) + EPS);
        const u32x4 mine = *(const u32x4*)(KVR + (size_t)row * 1024 + 8 * c8);
        u32x4 w;
#pragma unroll
        for (int j = 0; j < 4; ++j) w[j] = pk2(bflo(mine[j]) * rs, bfhi(mine[j]) * rs);
        const size_t kvrow = (size_t)(b * 8 + h) * KVLEN + pos;
        if (dd < 64) *(u32x4*)(Kb + kvrow * 96 + dd) = w; else *(u32x4*)(Vb + kvrow * 64 + (dd - 64)) = w;
    }
}
__device__ __forceinline__ void krope_phase(const bf16_t* P, bf16_t* Kb, const float* RT, int gtid, int NT) {
    for (int task = gtid; task < MALL * 4; task += NT) {
        const int row = task >> 2, fq = task & 3; const bool lat = row < MLAT;
        const int b = lat ? (row >> 13) : ((row - MLAT) >> 8), s = row & 8191, pos = lat ? (CTX + s) : ((row - MLAT) & 255);
        const u32x4 mine = *(const u32x4*)(P + (size_t)row * PW + 1408 + 8 * fq), oth = *(const u32x4*)(P + (size_t)row * PW + 1408 + 8 * (fq ^ 1));
        float v[8], pt[8];
#pragma unroll
        for (int j = 0; j < 4; ++j) { v[2 * j] = bflo(mine[j]); v[2 * j + 1] = bfhi(mine[j]); pt[2 * j] = bflo(oth[j]); pt[2 * j + 1] = bfhi(oth[j]); }
        if (lat) { const float* rt = RT + (fq < 2 ? (s >> 6) : (s & 63)) * 16;
#pragma unroll
            for (int j = 0; j < 8; ++j) { const float cs = rt[2 * j], sn = rt[2 * j + 1]; v[j] = (fq & 1) ? v[j] * cs + pt[j] * sn : v[j] * cs - pt[j] * sn; } }
        u32x4 w; w.x = pk2(v[0], v[1]); w.y = pk2(v[2], v[3]); w.z = pk2(v[4], v[5]); w.w = pk2(v[6], v[7]);
#pragma unroll
        for (int h = 0; h < 8; ++h) *(u32x4*)(Kb + ((size_t)(b * 8 + h) * KVLEN + pos) * 96 + 64 + 8 * fq) = w;
    }
}
#define MFMA32(a, b, c) __builtin_amdgcn_mfma_f32_32x32x16_bf16((a), (b), (c), 0, 0, 0)
__device__ __forceinline__ void gates_phase(const float* cw, const float* cb, const float* b_a, const float* b_x, const float* lam, LAS unsigned char* lds, const bf16_t* P, const bf16_t* Wg, unsigned* LU, int wave, int lane) {
    LAS bf16_t* xs = (LAS bf16_t*)(lds + wave * 4608);
    const int r32 = lane & 31, hi = lane >> 5;
    for (int unit = blockIdx.x; unit < (MALL / 256) * 8; unit += gridDim.x) {
        const int pm = unit >> 3, h = unit & 7, m0 = pm * 256 + wave * 32;
        const int s0 = m0 < MLAT ? (m0 & ~8191) : (MLAT + ((m0 - MLAT) & ~255)), slen = m0 < MLAT ? SEQ : CTX;
        {
            const int tok = lane >> 1, m = m0 + tok;
#pragma unroll
            for (int c8 = 0; c8 < 4; ++c8) { const int ch = (lane & 1) * 32 + c8 * 8, gch = h * 64 + ch;
                float acc[8];
                { const f32x4 b0 = *(const f32x4*)(cb + gch), b1 = *(const f32x4*)(cb + gch + 4);
                  acc[0] = b0.x; acc[1] = b0.y; acc[2] = b0.z; acc[3] = b0.w; acc[4] = b1.x; acc[5] = b1.y; acc[6] = b1.z; acc[7] = b1.w; }
#pragma unroll
                for (int k = 0; k < 4; ++k) { const int mm = m + k - 2;
                    if (mm >= s0 && mm < s0 + slen) { const u32x4 xv = *(const u32x4*)(P + (size_t)mm * PW + gch);
                        const f32x4 w0 = *(const f32x4*)(cw + k * 512 + gch), w1 = *(const f32x4*)(cw + k * 512 + gch + 4);
                        acc[0] += w0.x * bflo(xv.x); acc[1] += w0.y * bfhi(xv.x); acc[2] += w0.z * bflo(xv.y); acc[3] += w0.w * bfhi(xv.y);
                        acc[4] += w1.x * bflo(xv.z); acc[5] += w1.y * bfhi(xv.z); acc[6] += w1.z * bflo(xv.w); acc[7] += w1.w * bfhi(xv.w); } }
                u32x4 o; o.x = pk2(acc[0], acc[1]); o.y = pk2(acc[2], acc[3]); o.z = pk2(acc[4], acc[5]); o.w = pk2(acc[6], acc[7]);
                *(LAS u32x4*)(xs + tok * 72 + ch) = o; }
        }
        LDS_WAIT();
        bf16x8 afr[4];
#pragma unroll
        for (int ks = 0; ks < 4; ++ks) afr[ks] = *(const LAS bf16x8*)(xs + r32 * 72 + 16 * ks + 8 * hi);
#pragma unroll
        for (int jh = 0; jh < 2; ++jh) {
            f32x16 acc4[4];
#pragma unroll
            for (int q = 0; q < 4; ++q) {
#pragma unroll
                for (int i = 0; i < 16; ++i) acc4[q][i] = 0.f;
                const bf16_t* wrow = Wg + (size_t)(h * 256 + (2 * q + jh) * 32 + r32) * 64 + 8 * hi;
#pragma unroll
                for (int ks = 0; ks < 4; ++ks) { const bf16x8 bfr = *(const bf16x8*)(wrow + 16 * ks); acc4[q] = MFMA32(afr[ks], bfr, acc4[q]); }
            }
            const int ch = jh * 32 + r32, gch = h * 64 + ch;
            float ba[2], bx[2], sp[2];
#pragma unroll
            for (int d = 0; d < 2; ++d) { ba[d] = b_a[d * 512 + gch]; bx[d] = b_x[d * 512 + gch]; const float nl = -lam[d * 512 + gch];
                sp[d] = 8.f * (nl > 20.f ? nl : log1pf(__expf(nl))); }
#pragma unroll
            for (int i = 0; i < 16; ++i) { const int row = crow(i, hi); const float xv = bf2f(xs[row * 72 + ch]);
#pragma unroll
                for (int d = 0; d < 2; ++d) { const float r = sigmoidf_(acc4[2 * d][i] + ba[d]), ig = sigmoidf_(acc4[2 * d + 1][i] + bx[d]);
                    const float la = -r * sp[d]; const float uu = sqrtf(fmaxf(-expm1f(2.f * la), 0.f)) * (ig * xv);
                    LU[((size_t)(m0 + row) * 2 + d) * 512 + gch] = pk2(la * 1.4426950408889634f, uu); } }
        }
        LDS_WAIT();
    }
}
__device__ __forceinline__ void scan_agg(const unsigned* LU, float2* AGG, int gw, int NGW, int lane) {
    for (int task = gw; task < NB * 2 * (NCH + 1) * 8; task += NGW) {
        const int cgp = task & 7, c = (task >> 3) % (NCH + 1), d = (task / (8 * (NCH + 1))) & 1, b = task / (16 * (NCH + 1));
        const int ch = cgp * 64 + lane, row0 = c < NCH ? b * SEQ + c * CHL : MLAT + b * CTX;
        float A = 1.f, U = 0.f;
#pragma unroll 8
        for (int t = 0; t < CHL; ++t) { const int tt = d ? CHL - 1 - t : t; const unsigned w = LU[((size_t)(row0 + tt) * 2 + d) * 512 + ch];
            const float av = exp2f(bflo(w)); A *= av; U = av * U + bfhi(w); }
        AGG[(size_t)((b * 2 + d) * (NCH + 1) + c) * 512 + ch] = make_float2(A, U);
    }
}
__device__ __forceinline__ float gelu_tanh(float x) { const float t = tanhf(0.7978845608028654f * (x + 0.044715f * x * x * x)); return 0.5f * x * (1.f + t); }
__device__ __forceinline__ void scan_final(const unsigned* LU, const float2* AGG, const bf16_t* P, bf16_t* A2, int gw, int NGW, int lane) {
    for (int task = gw; task < NB * NCH * 8; task += NGW) {
        const int cgp = task & 7, c = (task >> 3) & (NCH - 1), b = task / (8 * NCH), ch = cgp * 64 + lane, row0 = b * SEQ + c * CHL;
        const float2* ag0 = AGG + (size_t)((b * 2 + 0) * (NCH + 1)) * 512 + ch; const float2* ag1 = AGG + (size_t)((b * 2 + 1) * (NCH + 1)) * 512 + ch;
        float hf = ag0[(size_t)NCH * 512].y;
        for (int cc = 0; cc < c; ++cc) { const float2 g = ag0[(size_t)cc * 512]; hf = g.x * hf + g.y; }
#pragma unroll 8
        for (int t = 0; t < CHL; ++t) { const unsigned w = LU[((size_t)(row0 + t) * 2 + 0) * 512 + ch]; hf = exp2f(bflo(w)) * hf + bfhi(w);
            A2[(size_t)(row0 + t) * DM + ch] = (bf16_t)f2bf(hf); }
        float hb = ag1[(size_t)NCH * 512].y;
        for (int cc = NCH - 1; cc > c; --cc) { const float2 g = ag1[(size_t)cc * 512]; hb = g.x * hb + g.y; }
#pragma unroll 8
        for (int t = CHL - 1; t >= 0; --t) { const unsigned w = LU[((size_t)(row0 + t) * 2 + 1) * 512 + ch]; hb = exp2f(bflo(w)) * hb + bfhi(w);
            const float f = bf2f(A2[(size_t)(row0 + t) * DM + ch]), gr = bf2f(P[(size_t)(row0 + t) * PW + 512 + ch]);
            A2[(size_t)(row0 + t) * DM + ch] = (bf16_t)f2bf((f + hb) * gelu_tanh(gr)); }
    }
}
constexpr int AT_KROW = 208, AT_KBUF = 64 * AT_KROW, AT_VROW = 144, AT_VBUF = 64 * AT_VROW, AT_VOFF = 2 * AT_KBUF;
__device__ __forceinline__ unsigned cvtpk(float lo, float hi) { typedef float f2 __attribute__((ext_vector_type(2))); typedef __bf16 b2 __attribute__((ext_vector_type(2))); f2 v = {lo, hi}; b2 r = __builtin_convertvector(v, b2); return __builtin_bit_cast(unsigned, r); }
__device__ __forceinline__ void attn_unit(LAS unsigned char* lds, const bf16_t* Q, const bf16_t* K, const bf16_t* V, bf16_t* A2, int b, int h, int qb, int tid, int wave, int lane) {
    const int r32 = lane & 31, hi = lane >> 5, q0 = qb * 256 + wave * 32;
    const bf16_t* Qp = Q + ((size_t)((b * 8 + h) * SEQ + q0 + r32)) * 96 + 8 * hi;
    bf16x8 qr[6];
#pragma unroll
    for (int d0 = 0; d0 < 6; ++d0) qr[d0] = *(const bf16x8*)(Qp + 16 * d0);
    const unsigned char* Kg = (const unsigned char*)(K + (size_t)(b * 8 + h) * KVLEN * 96);
    const unsigned char* Vg = (const unsigned char*)(V + (size_t)(b * 8 + h) * KVLEN * 64);
    const int kc1 = tid + 512; const bool k1 = kc1 < 768;
    const int kdst0 = (tid / 12) * AT_KROW + (tid % 12) * 16, kdst1 = (kc1 / 12) * AT_KROW + (kc1 % 12) * 16;
    const int vkv = tid & 63, vdc = tid >> 6;
    u32x4 kreg0, kreg1 = {0u, 0u, 0u, 0u}, vreg;
#define AT_LOAD(t) do { kreg0 = *(const u32x4*)(Kg + (size_t)(t) * 12288 + tid * 16); if (k1) kreg1 = *(const u32x4*)(Kg + (size_t)(t) * 12288 + kc1 * 16); \
        vreg = *(const u32x4*)(Vg + (size_t)(t) * 8192 + vkv * 128 + vdc * 16); } while (0)
#define AT_STORE(buf) do { *(LAS u32x4*)(lds + (buf) * AT_KBUF + kdst0) = kreg0; if (k1) *(LAS u32x4*)(lds + (buf) * AT_KBUF + kdst1) = kreg1; \
        LAS bf16_t* vt_ = (LAS bf16_t*)(lds + AT_VOFF + (buf) * AT_VBUF) + (8 * vdc) * (AT_VROW / 2) + vkv; \
        vt_[0 * (AT_VROW / 2)] = (bf16_t)(vreg.x & 0xffffu); vt_[1 * (AT_VROW / 2)] = (bf16_t)(vreg.x >> 16); vt_[2 * (AT_VROW / 2)] = (bf16_t)(vreg.y & 0xffffu); vt_[3 * (AT_VROW / 2)] = (bf16_t)(vreg.y >> 16); \
        vt_[4 * (AT_VROW / 2)] = (bf16_t)(vreg.z & 0xffffu); vt_[5 * (AT_VROW / 2)] = (bf16_t)(vreg.z >> 16); vt_[6 * (AT_VROW / 2)] = (bf16_t)(vreg.w & 0xffffu); vt_[7 * (AT_VROW / 2)] = (bf16_t)(vreg.w >> 16); } while (0)
    f32x16 o0, o1;
#pragma unroll
    for (int i = 0; i < 16; ++i) { o0[i] = 0.f; o1[i] = 0.f; }
    float mrun = -1e30f, lrun = 0.f;
    AT_LOAD(0); AT_STORE(0); __syncthreads();
    constexpr int NT_ = KVLEN / 64;
    for (int t = 0; t < NT_; ++t) {
        const int buf = t & 1;
        if (t + 1 < NT_) AT_LOAD(t + 1);
        const LAS unsigned char* kb = lds + buf * AT_KBUF + r32 * AT_KROW + hi * 16;
        f32x16 p0, p1;
#pragma unroll
        for (int i = 0; i < 16; ++i) { p0[i] = 0.f; p1[i] = 0.f; }
#pragma unroll
        for (int d0 = 0; d0 < 6; ++d0) { const bf16x8 a0 = *(const LAS bf16x8*)(kb + d0 * 32), a1 = *(const LAS bf16x8*)(kb + 32 * AT_KROW + d0 * 32);
            p0 = MFMA32(a0, qr[d0], p0); p1 = MFMA32(a1, qr[d0], p1); }
        float mx = fmaxf(p0[0], p1[0]);
#pragma unroll
        for (int i = 1; i < 16; ++i) mx = fmaxf(mx, fmaxf(p0[i], p1[i]));
        mx = fmaxf(mx, __shfl_xor(mx, 32));
        const float mnew = fmaxf(mrun, mx), alpha = exp2f(mrun - mnew); mrun = mnew;
        float ps = 0.f;
#pragma unroll
        for (int i = 0; i < 16; ++i) { p0[i] = exp2f(p0[i] - mnew); p1[i] = exp2f(p1[i] - mnew); ps += p0[i] + p1[i]; }
        lrun = lrun * alpha + ps;
#pragma unroll
        for (int i = 0; i < 16; ++i) { o0[i] *= alpha; o1[i] *= alpha; }
        u32x4 pw[4];
#pragma unroll
        for (int j = 0; j < 4; ++j) { pw[0][j] = cvtpk(p0[2 * j], p0[2 * j + 1]); pw[1][j] = cvtpk(p0[8 + 2 * j], p0[9 + 2 * j]); pw[2][j] = cvtpk(p1[2 * j], p1[2 * j + 1]); pw[3][j] = cvtpk(p1[8 + 2 * j], p1[9 + 2 * j]); }
        const LAS unsigned char* vb = lds + AT_VOFF + buf * AT_VBUF + r32 * AT_VROW + hi * 8;
#pragma unroll
        for (int ks = 0; ks < 4; ++ks) {
            const s16x4 lo0 = *(const LAS s16x4*)(vb + ks * 32), hi0 = *(const LAS s16x4*)(vb + ks * 32 + 16);
            const s16x4 lo1 = *(const LAS s16x4*)(vb + 32 * AT_VROW + ks * 32), hi1 = *(const LAS s16x4*)(vb + 32 * AT_VROW + ks * 32 + 16);
            const bf16x8 va0 = __builtin_shufflevector(lo0, hi0, 0, 1, 2, 3, 4, 5, 6, 7), va1 = __builtin_shufflevector(lo1, hi1, 0, 1, 2, 3, 4, 5, 6, 7);
            const bf16x8 pb = __builtin_bit_cast(bf16x8, pw[ks]);
            o0 = MFMA32(va0, pb, o0); o1 = MFMA32(va1, pb, o1);
        }
        if (t + 1 < NT_) AT_STORE(buf ^ 1);
        __syncthreads();
    }
    const float lt = lrun + __shfl_xor(lrun, 32), inv = 1.f / lt;
    bf16_t* op = A2 + (size_t)(b * SEQ + q0 + r32) * DM + 512 + h * 64 + 4 * hi;
#pragma unroll
    for (int g = 0; g < 4; ++g) {
        u32x2 w0, w1; w0.x = pk2(o0[4 * g] * inv, o0[4 * g + 1] * inv); w0.y = pk2(o0[4 * g + 2] * inv, o0[4 * g + 3] * inv);
        w1.x = pk2(o1[4 * g] * inv, o1[4 * g + 1] * inv); w1.y = pk2(o1[4 * g + 2] * inv, o1[4 * g + 3] * inv);
        *(u32x2*)(op + 8 * g) = w0; *(u32x2*)(op + 32 + 8 * g) = w1;
    }
#undef AT_LOAD
#undef AT_STORE
}
__device__ __forceinline__ void p7_rows(const float* x, const float* g_post, const float* g_pre, float* out, const float* mod, const bf16_t* Y, bf16_t* H2, int gw, int NGW, int lane) {
    for (int m = gw; m < MLAT; m += NGW) {
        const float* md = mod + (m >> 13) * NMOD;
        f32x4 y[4], x1[4]; float ss = 0.f;
#pragma unroll
        for (int j = 0; j < 4; ++j) { const u32x2 w = *(const u32x2*)(Y + (size_t)m * DM + 4 * lane + 256 * j);
            y[j] = (f32x4){bflo(w.x), bfhi(w.x), bflo(w.y), bfhi(w.y)}; ss += y[j].x * y[j].x + y[j].y * y[j].y + y[j].z * y[j].z + y[j].w * y[j].w; }
        const float rs = rsqrtf(wave_sum(ss) * (1.f / DM) + EPS); float s2 = 0.f;
#pragma unroll
        for (int j = 0; j < 4; ++j) { const int k = 4 * lane + 256 * j;
            const f32x4 xv = *(const f32x4*)(x + (size_t)m * DM + k), gg = *(const f32x4*)(g_post + k), gt = *(const f32x4*)(md + 2 * DM + k);
            x1[j] = xv + gt * (y[j] * rs * gg); *(f32x4*)(out + (size_t)m * DM + k) = x1[j];
            s2 += x1[j].x * x1[j].x + x1[j].y * x1[j].y + x1[j].z * x1[j].z + x1[j].w * x1[j].w; }
        const float rs2 = rsqrtf(wave_sum(s2) * (1.f / DM) + EPS);
#pragma unroll
        for (int j = 0; j < 4; ++j) { const int k = 4 * lane + 256 * j;
            const f32x4 gg = *(const f32x4*)(g_pre + k), sh = *(const f32x4*)(md + 3 * DM + k), sc = *(const f32x4*)(md + 4 * DM + k);
            const f32x4 hh = x1[j] * rs2 * gg * (sc + 1.f) + sh;
            u32x2 o; o.x = pk2(hh.x, hh.y); o.y = pk2(hh.z, hh.w); *(u32x2*)(H2 + (size_t)m * DM + k) = o; }
    }
}
__device__ __forceinline__ void p11_rows(const float* g_post, float* out, const float* mod, const bf16_t* Fb, int gw, int NGW, int lane) {
    for (int m = gw; m < MLAT; m += NGW) {
        const float* md = mod + (m >> 13) * NMOD;
        f32x4 y[4]; float ss = 0.f;
#pragma unroll
        for (int j = 0; j < 4; ++j) { const u32x2 w = *(const u32x2*)(Fb + (size_t)m * DM + 4 * lane + 256 * j);
            y[j] = (f32x4){bflo(w.x), bfhi(w.x), bflo(w.y), bfhi(w.y)}; ss += y[j].x * y[j].x + y[j].y * y[j].y + y[j].z * y[j].z + y[j].w * y[j].w; }
        const float rs = rsqrtf(wave_sum(ss) * (1.f / DM) + EPS);
#pragma unroll
        for (int j = 0; j < 4; ++j) { const int k = 4 * lane + 256 * j;
            const f32x4 xv = *(const f32x4*)(out + (size_t)m * DM + k), gg = *(const f32x4*)(g_post + k), gt = *(const f32x4*)(md + 5 * DM + k);
            *(f32x4*)(out + (size_t)m * DM + k) = xv + gt * (y[j] * rs * gg); }
    }
}
__device__ __forceinline__ void convgate_phase(const float* cw, const float* cb, const bf16_t* UP, bf16_t* G, int half, int gtid, int NT) {
    constexpr int JG = DFF / 8, RG = 16, NTASK = (MLAT / 2 / RG) * JG;
    for (int task = gtid; task < NTASK; task += NT) {
        const int jg = task % JG, rg = task / JG, j0 = jg * 8, r0 = rg * RG, m0 = half * (MLAT / 2) + r0;
        float wu[3][8], wg[3][8], bu[8], bg[8];
#pragma unroll
        for (int k = 0; k < 3; ++k)
#pragma unroll
            for (int i = 0; i < 8; ++i) { wu[k][i] = cw[k * 2 * DFF + j0 + i]; wg[k][i] = cw[k * 2 * DFF + DFF + j0 + i]; }
#pragma unroll
        for (int i = 0; i < 8; ++i) { bu[i] = cb[j0 + i]; bg[i] = cb[DFF + j0 + i]; }
        const bf16_t* up = UP + (size_t)r0 * (2 * DFF) + j0;
        u32x4 pu = {0u, 0u, 0u, 0u}, pg = {0u, 0u, 0u, 0u}, cu, cg_, nu, ng;
        if ((m0 & 8191) != 0) { pu = *(const u32x4*)(up - 2 * DFF); pg = *(const u32x4*)(up - 2 * DFF + DFF); }
        cu = *(const u32x4*)(up); cg_ = *(const u32x4*)(up + DFF);
#pragma unroll 4
        for (int r = 0; r < RG; ++r) {
            const bool nv = (r + 1 < RG) || (((m0 + RG) & 8191) != 0);
            if (nv) { nu = *(const u32x4*)(up + (size_t)(r + 1) * (2 * DFF)); ng = *(const u32x4*)(up + (size_t)(r + 1) * (2 * DFF) + DFF); } else { nu = (u32x4){0u, 0u, 0u, 0u}; ng = nu; }
            float o[8];
#pragma unroll
            for (int i = 0; i < 8; ++i) { const int w_ = i >> 1;
                const float p_u = (i & 1) ? bfhi(pu[w_]) : bflo(pu[w_]), c_u = (i & 1) ? bfhi(cu[w_]) : bflo(cu[w_]), n_u = (i & 1) ? bfhi(nu[w_]) : bflo(nu[w_]);
                const float p_g = (i & 1) ? bfhi(pg[w_]) : bflo(pg[w_]), c_g = (i & 1) ? bfhi(cg_[w_]) : bflo(cg_[w_]), n_g = (i & 1) ? bfhi(ng[w_]) : bflo(ng[w_]);
                const float uv = bu[i] + wu[0][i] * p_u + wu[1][i] * c_u + wu[2][i] * n_u, gv = bg[i] + wg[0][i] * p_g + wg[1][i] * c_g + wg[2][i] * n_g;
                o[i] = gv / (1.f + __expf(-gv)) * uv; }
            u32x4 w; w.x = pk2(o[0], o[1]); w.y = pk2(o[2], o[3]); w.z = pk2(o[4], o[5]); w.w = pk2(o[6], o[7]);
            *(u32x4*)(G + (size_t)(r0 + r) * DFF + j0) = w;
            pu = cu; pg = cg_; cu = nu; cg_ = ng;
        }
    }
}
constexpr int NPH = 17;
__global__ void __launch_bounds__(512, 2) fwd_kernel(Args a) {
    extern __shared__ __attribute__((aligned(16))) unsigned char lds_raw[];
    LAS unsigned char* lds = (LAS unsigned char*)lds_raw;
    const int lo = a.ph_lo, hi_ = a.ph_hi;
#if MK_COOP
    cg::grid_group grid = cg::this_grid();
#endif
    typedef pg8::EpiBf16<0> EpiB;
    constexpr int MH = MLAT / 2;
#pragma unroll 1
    for (int ph = lo; ph < hi_; ++ph) {
        int tid = threadIdx.x; asm volatile("" : "+v"(tid));
        int G = gridDim.x, bx = blockIdx.x; asm volatile("" : "+s"(G), "+s"(bx));
        const int lane = tid & 63, wave = __builtin_amdgcn_readfirstlane(tid >> 6);
        const int vcu = (G % 8 == 0) ? (bx % 8) * (G / 8) + bx / 8 : bx;
        const int gw = vcu * 8 + wave, NGW = G * 8, gtid = bx * 512 + tid, NTH = G * 512;
        unsigned char* ws = a.ws; asm volatile("" : "+s"(ws));
        float* mod = (float*)(ws + WS_MOD); float* ssq = (float*)(ws + WS_SSQ); float* sskv = (float*)(ws + WS_SSKV);
        bf16_t* Win = (bf16_t*)(ws + WS_WIN); bf16_t* Wq = (bf16_t*)(ws + WS_WQ); bf16_t* Wkv = (bf16_t*)(ws + WS_WKV); bf16_t* Wg = (bf16_t*)(ws + WS_WG);
        bf16_t* Wout = (bf16_t*)(ws + WS_WOUT); bf16_t* Wup = (bf16_t*)(ws + WS_WUP); bf16_t* Wdn = (bf16_t*)(ws + WS_WDN);
        float2* AGG = (float2*)(ws + WS_AGG); float* RT = (float*)(ws + WS_ROPE);
        bf16_t* H = (bf16_t*)(ws + WS_R1); bf16_t* KVR = H; bf16_t* H2 = H; bf16_t* Qb = (bf16_t*)(ws + WS_Q);
        bf16_t* P = (bf16_t*)(ws + WS_R2); bf16_t* Y = P; bf16_t* Fb = P;
        unsigned* LU = (unsigned*)(ws + WS_LU); bf16_t* Kb = (bf16_t*)(ws + WS_K); bf16_t* Vb = (bf16_t*)(ws + WS_V); bf16_t* A2 = (bf16_t*)(ws + WS_A2); bf16_t* QR = A2;
        bf16_t* UP = (bf16_t*)(ws + WS_UP); bf16_t* Gb = (bf16_t*)(ws + WS_G);
        float* outp = a.out; asm volatile("" : "+s"(outp));
        pg8::Gemm g{nullptr, nullptr, 0, 0, 0, 0, 0}; bf16_t* O = nullptr; int ldc = 0;
        switch (ph) {
            case 2:  g = pg8::Gemm{H, Win, MALL, PW, DM, DM, DM}; O = P; ldc = PW; break;
            case 4:  g = pg8::Gemm{P + 1024, Wq, MLAT, 768, 256, PW, 256}; O = QR; ldc = 768; break;
            case 5:  g = pg8::Gemm{P + 1280, Wkv, MALL, 1024, 256, PW, 256}; O = KVR; ldc = 1024; break;
            case 8:  g = pg8::Gemm{A2, Wout, MLAT, DM, DM, DM, DM}; O = Y; ldc = DM; break;
            case 10: g = pg8::Gemm{H2, Wup, MH, 2 * DFF, DM, DM, DM}; O = UP; ldc = 2 * DFF; break;
            case 13: g = pg8::Gemm{H2 + (size_t)MH * DM, Wup, MH, 2 * DFF, DM, DM, DM}; O = UP; ldc = 2 * DFF; break;
            case 12: g = pg8::Gemm{Gb, Wdn, MH, DM, DFF, DFF, DFF}; O = Fb; ldc = DM; break;
            case 15: g = pg8::Gemm{Gb, Wdn, MH, DM, DFF, DFF, DFF}; O = Fb + (size_t)MH * DM; ldc = DM; break;
            default: break;
        }
        if (g.A != nullptr) {
            pg8::StaticOrder S; S.init(g.M, g.N, G, bx); EpiB E{O, ldc, nullptr, 0, 0, 1.f};
            pg8::gemm_phase<EpiB, pg8::StaticOrder, true, true>(lds, g, S, E);
        }
#ifndef NGM
#define NGM 0x1ffff
#endif
#define NG(k) ((NGM >> (k)) & 1)
        else if (NG(0) && ph == 0) {
            prep_mat<0>(argp(10), nullptr, Win, 1536, 1024, gtid, NTH); prep_mat<1>(argp(18), argp(19), Wq, 768, 256, gtid, NTH); prep_mat<2>(argp(20), argp(21), Wkv, 1024, 256, gtid, NTH);
            prep_mat<3>(argp(13), argp(15), Wg, 2048, 64, gtid, NTH); prep_mat<4>(argp(22), nullptr, Wout, 1024, 1024, gtid, NTH); prep_mat<5>(argp(23), nullptr, Wup, 5632, 1024, gtid, NTH);
            prep_mat<6>(argp(26), nullptr, Wdn, 1024, 2816, gtid, NTH);
            if (gtid < 1024) { const int pos = gtid >> 3, j = gtid & 7; const float invf[8] = {1.f, 0.31622776601683794f, 0.1f, 0.031622776601683794f, 0.01f, 0.0031622776601683794f, 0.001f, 0.00031622776601683794f};
                const float ang = (float)pos * invf[j]; RT[2 * gtid] = cosf(ang); RT[2 * gtid + 1] = sinf(ang); }
            mod_phase(argp(1), argp(3), argp(4), argp(5), mod, (LAS float*)(lds + wave * 4096), gw, NGW, lane);
        } else if (NG(1) && ph == 1) {
            p1_rows(argp(0), argp(2), argp(6), mod, H, gw, NGW, lane);
        } else if (NG(3) && ph == 3) {
            gates_phase(argp(11), argp(12), argp(14), argp(16), argp(17), lds, P, Wg, LU, wave, lane);
            ss_phase(P, ssq, sskv, gw, NGW, lane);
        } else if (NG(6) && ph == 6) {
            scan_agg(LU, AGG, gw, NGW, lane); krope_phase(P, Kb, RT, gtid, NTH); qpost_phase(QR, ssq, RT, Qb, gtid, NTH); kvpost_phase(KVR, sskv, Kb, Vb, gtid, NTH);
        } else if (NG(7) && ph == 7) {
            scan_final(LU, AGG, P, A2, gw, NGW, lane);
            const int upb = (NB * 8 * 32 + G - 1) / G, u0 = vcu * upb, u1 = min(NB * 8 * 32, u0 + upb);
            __syncthreads();
            for (int unit = u0; unit < u1; ++unit) { const int bh = unit >> 5, qb = unit & 31; attn_unit(lds, Qb, Kb, Vb, A2, bh >> 3, bh & 7, qb, tid, wave, lane); }
        } else if (NG(9) && ph == 9) {
            p7_rows(argp(0), argp(7), argp(8), outp, mod, Y, H2, gw, NGW, lane);
        } else if (NG(11) && (ph == 11 || ph == 14)) {
            convgate_phase(argp(24), argp(25), UP, Gb, ph == 14 ? 1 : 0, gtid, NTH);
        } else if (NG(16) && ph == 16) {
            p11_rows(argp(9), outp, mod, Fb, gw, NGW, lane);
        }
        __syncthreads();
#if MK_COOP
        if (ph + 1 < hi_ && ph != 3 && ph != 4) grid.sync();
#endif
    }
}

extern "C" void kernel_launch(void* const* d_in, const int* in_sizes, int n_in, void* d_out, int out_size, void* d_ws, size_t ws_size, hipStream_t stream) {
    static int grid = 0;
    if (grid == 0) {
        if (n_in != 27 || out_size != MLAT * DM || ws_size < WS_END) { fprintf(stderr, "kernel_launch: unexpected shapes (n_in %d, out %d, ws %zu)\n", n_in, out_size, ws_size); grid = -1; return; }
        int dev = 0, cus = 0, per_cu = 0;
        if (hipGetDevice(&dev) != hipSuccess || hipDeviceGetAttribute(&cus, hipDeviceAttributeMultiprocessorCount, dev) != hipSuccess) { grid = -1; return; }
        if (hipFuncSetAttribute((const void*)fwd_kernel, hipFuncAttributeMaxDynamicSharedMemorySize, LDS_BYTES) != hipSuccess) { fprintf(stderr, "kernel_launch: hipFuncSetAttribute failed\n"); grid = -1; return; }
        if (hipOccupancyMaxActiveBlocksPerMultiprocessor(&per_cu, (const void*)fwd_kernel, 512, LDS_BYTES) != hipSuccess || per_cu < 1) { fprintf(stderr, "kernel_launch: occupancy query says %d\n", per_cu); }
        (void)hipGetLastError();
        grid = cus;
    }
    if (grid < 0) return;
    (void)hipMemsetAsync((char*)d_ws + WS_CTL, 0, CTL_BYTES, stream);
    Args a{};
    for (int i = 0; i < 27; ++i) a.in[i] = (const float*)d_in[i];
    a.out = (float*)d_out; a.ws = (unsigned char*)d_ws;
#if MK_COOP
    a.ph_lo = 0; a.ph_hi = NPH;
    void* args[] = {&a};
    hipError_t e = hipLaunchCooperativeKernel((const void*)fwd_kernel, dim3(grid), dim3(512), args, LDS_BYTES, stream);
    if (e != hipSuccess) fprintf(stderr, "kernel_launch: cooperative launch failed: %s (grid %d)\n", hipGetErrorString(e), grid);
#else
    for (int p = 0; p < NPH; ++p) { a.ph_lo = p; a.ph_hi = p + 1; hipLaunchKernelGGL(fwd_kernel, dim3(grid), dim3(512), LDS_BYTES, stream, a); }
#endif
}
```

```cpp
#include <hip/hip_runtime.h>
#include <hip/hip_cooperative_groups.h>
#include <cstdio>
#include <cstdint>
namespace cg = cooperative_groups;
#ifndef MK_COOP
#define MK_COOP 1
#endif
namespace pg8 {
#define PG8_LAS __attribute__((address_space(3)))
typedef unsigned short bf16_t;
typedef short bf16x8 __attribute__((ext_vector_type(8)));
typedef float f32x4 __attribute__((ext_vector_type(4)));
typedef unsigned u32x4 __attribute__((ext_vector_type(4)));
constexpr int BM = 256, BK = 64, HALF = 128, HTB = HALF * BK * 2  , STAGE_BYTES = 8 * HTB, NXCD = 8, WGM = 8;

__host__ __device__ __forceinline__ int lds_byte(int r, int c) { const int st = (r >> 4) * 2 + (c >> 5), rr = r & 15, cc = c & 31, ob = rr * 64 + cc * 2; return st * 1024 + (ob ^ (((ob >> 9) & 1) << 5)); }
__host__ __device__ __forceinline__ void stage_rc(int b, int& R, int& C) { const int st = b / 1024, sb = b % 1024, swz = sb ^ (((sb >> 9) & 1) << 5); R = (st >> 1) * 16 + swz / 64; C = (st & 1) * 32 + (swz % 64) / 2; }
__host__ __device__ __forceinline__ int perm32(int rho) { const int n = rho >> 4, i = rho & 15; return 8 * (i >> 2) + 4 * n + (i & 3); }

struct Unit { int pm, pn; };
struct Gemm { const bf16_t* A; const bf16_t* Bt; int M, N, K, lda, ldb; };

struct StaticOrder {
    int nM, nN, nwg, G, c;
    __host__ __device__ void init(int M, int N, int G_, int c_) { nM = M / BM; nN = N / BM; nwg = nM * nN; G = G_; c = c_; }
    __host__ __device__ bool next(int i, Unit& u) const {
        const long L = (long)i * G + c; if (L >= nwg) return false;
        int wgid = (int)L; { const int q = nwg / NXCD, r = nwg % NXCD, xcd = wgid % NXCD, off = wgid / NXCD; wgid = (xcd < r ? xcd * (q + 1) : r * (q + 1) + (xcd - r) * q) + off; }
        const int nig = WGM * nN, gid = wgid / nig, fm = gid * WGM, gsz = (nM - fm) < WGM ? (nM - fm) : WGM;
        u.pm = fm + ((wgid % nig) % gsz); u.pn = (wgid % nig) / gsz; return true;
    }
    __device__ __forceinline__ void a_ready(const Unit&) const {}
    __device__ __forceinline__ void done(const Unit&) const {}
};

__device__ __forceinline__ unsigned cvt_pk_bf16(float lo, float hi) { unsigned r; asm volatile("v_cvt_pk_bf16_f32 %0, %1, %2" : "=v"(r) : "v"(lo), "v"(hi)); return r; }
typedef float f32x2 __attribute__((ext_vector_type(2)));
__device__ __forceinline__ f32x2 gelu_pk(f32x2 v) {
    const f32x2 av = __builtin_elementwise_abs(v), d = av * 0.2316418882f + 1.0f;
    f32x2 t; t.x = __builtin_amdgcn_rcpf(d.x); t.y = __builtin_amdgcn_rcpf(d.y);
    f32x2 q = t * 0.5307027145f + (-0.7265760135f); q = q * t + 0.7107068705f; q = q * t + (-0.142248368f); q = q * t + 0.127414796f; q = q * t;
    const f32x2 s = (v * v) * (-0.72134752044f);
    f32x2 e; e.x = __builtin_amdgcn_exp2f(s.x); e.y = __builtin_amdgcn_exp2f(s.y);
    const f32x2 m = v * (q * e), r = v - m;
    f32x2 o; o.x = v.x < 0.f ? m.x : r.x; o.y = v.y < 0.f ? m.y : r.y; return o;
}

template <int ACT  > struct EpiBf16 {
    static constexpr bool PERM = true, AFTER_DRAIN = false; static_assert(ACT == 0 || ACT == 1, "EpiBf16: ACT is 0 (none) or 1 (gelu_pk)");
    bf16_t* O; int ldc; const float* bias; int split_cols; size_t split_stride; float scale0;
    __device__ __forceinline__ void operator()(const f32x4 (&acc)[2][2][4][2], const Unit& u, int wr, int wc, int fr, int fq) const {
        const int row0 = u.pm * BM + wr * 64 + fr; int colt = u.pn * BM; bf16_t* base = O;
        float sc = 1.f; if (split_cols) { const int t = colt / split_cols; base += (size_t)t * split_stride; colt -= t * split_cols; if (t == 0) sc = scale0; }
        const int col0 = colt + wc * 32 + 8 * fq, bcol0 = u.pn * BM + wc * 32 + 8 * fq;
        f32x4 bv[2][2];
#pragma unroll
        for (int bj = 0; bj < 2; ++bj)
#pragma unroll
            for (int n = 0; n < 2; ++n) bv[bj][n] = bias ? *(const f32x4*)(bias + bcol0 + bj * HALF + 4 * n) : (f32x4){0.f, 0.f, 0.f, 0.f};
#pragma unroll
        for (int ai = 0; ai < 2; ++ai)
#pragma unroll
            for (int m = 0; m < 4; ++m) { bf16_t* rowp = base + (size_t)(row0 + ai * HALF + m * 16) * ldc + col0;
#pragma unroll
                for (int bj = 0; bj < 2; ++bj) { f32x4 v0 = acc[ai][bj][m][0] + bv[bj][0], v1 = acc[ai][bj][m][1] + bv[bj][1];
                    if (ACT == 1) { f32x2 a = gelu_pk((f32x2){v0[0], v0[1]}), b = gelu_pk((f32x2){v0[2], v0[3]}), c = gelu_pk((f32x2){v1[0], v1[1]}), d = gelu_pk((f32x2){v1[2], v1[3]});
                        v0 = (f32x4){a.x, a.y, b.x, b.y}; v1 = (f32x4){c.x, c.y, d.x, d.y}; }
                    v0 = v0 * sc; v1 = v1 * sc; u32x4 w; w.x = cvt_pk_bf16(v0[0], v0[1]); w.y = cvt_pk_bf16(v0[2], v0[3]); w.z = cvt_pk_bf16(v1[0], v1[1]); w.w = cvt_pk_bf16(v1[2], v1[3]);
                    *(u32x4*)(rowp + bj * HALF) = w; } }
    }
};
template <class Epi, class Sched, bool ALIGN_EPI = false, bool SP2 = false>
__device__ __forceinline__ void gemm_phase(PG8_LAS unsigned char* lds, const Gemm g, const Sched& S, const Epi& E, const int tid) {
    const int wid = __builtin_amdgcn_readfirstlane(tid >> 6), lane = tid & 63, wr = wid >> 2, wc = wid & 3, fr = lane & 15, fq = lane >> 4;
    const int K = g.K, nt = K / BK;
    unsigned voffA[2], voffB[2];
#pragma unroll
    for (int i = 0; i < 2; ++i) { int R, C; stage_rc(tid * 16 + i * 8192, R, C); const int Rb = Epi::PERM ? ((R & ~31) + perm32(R & 31)) : R;
        voffA[i] = (unsigned)(R * g.lda + C) * 2u; voffB[i] = (unsigned)(Rb * g.ldb + C) * 2u; }
    const size_t kstep = (size_t)(BK * 2);
    const size_t hstepA = (size_t)HALF * g.lda * 2, hstepB = (size_t)HALF * g.ldb * 2;
    const size_t tstepA = 2 * hstepA, tstepB = 2 * hstepB;
    const unsigned ldsw = (unsigned)wid * 1024u;
    const int aoff = lds_byte(wr * 64 + fr, fq * 8), boff = lds_byte(wc * 32 + fr, fq * 8);
#define PG8_SA(b, h) (((b) * 2 + (h)) * HTB)
#define PG8_SB(b, h) ((4 + (b) * 2 + (h)) * HTB)
#define PG8_STAGE(bufoff, gbase, voff) do { _Pragma("unroll") for (int _i = 0; _i < 2; ++_i) \
        __builtin_amdgcn_global_load_lds((const unsigned*)((const char*)(gbase) + (voff)[_i]), (PG8_LAS unsigned*)(lds + (bufoff) + ldsw + _i * 8192), 16, 0, 0); } while (0)
#define PG8_LDA(dst, b, h) do { _Pragma("unroll") for (int m = 0; m < 4; ++m) _Pragma("unroll") for (int k = 0; k < 2; ++k) dst[m][k] = *(const PG8_LAS bf16x8*)(lds + PG8_SA(b, h) + aoff + m * 2048 + k * 1024); } while (0)
#define PG8_LDB(dst, b, h) do { _Pragma("unroll") for (int n = 0; n < 2; ++n) _Pragma("unroll") for (int k = 0; k < 2; ++k) dst[n][k] = *(const PG8_LAS bf16x8*)(lds + PG8_SB(b, h) + boff + n * 2048 + k * 1024); } while (0)
#define PG8_MMA(ai, bj, At, Bt) do { __builtin_amdgcn_s_setprio(1); _Pragma("unroll") for (int m = 0; m < 4; ++m) _Pragma("unroll") for (int n = 0; n < 2; ++n) _Pragma("unroll") for (int k = 0; k < 2; ++k) \
        acc[ai][bj][m][n] = __builtin_amdgcn_mfma_f32_16x16x32_bf16(Bt[n][k], At[m][k], acc[ai][bj][m][n], 0, 0, 0); __builtin_amdgcn_s_setprio(0); } while (0)
#define PG8_WAIT_V(n) asm volatile("s_waitcnt vmcnt(" #n ")" ::: "memory")
#define PG8_WAIT_L(n) asm volatile("s_waitcnt lgkmcnt(" #n ")" ::: "memory")
#define PG8_BAR __builtin_amdgcn_s_barrier()
#define PG8_SCHED __builtin_amdgcn_sched_barrier(0)
    Unit cur, nxt; int ui = 0;
    if (!S.next(0, cur)) return;
    f32x4 acc[2][2][4][2];
#pragma unroll
    for (int a = 0; a < 2; ++a)
#pragma unroll
        for (int b = 0; b < 2; ++b)
#pragma unroll
            for (int m = 0; m < 4; ++m)
#pragma unroll
                for (int n = 0; n < 2; ++n) acc[a][b][m][n] = (f32x4){0.f, 0.f, 0.f, 0.f};
    bf16x8 At[4][2], B0[2][2], B1[2][2];
    const char* cA = (const char*)g.A + (size_t)cur.pm * tstepA; const char* cB = (const char*)g.Bt + (size_t)cur.pn * tstepB;
    S.a_ready(cur);
    if constexpr (SP2) {
        PG8_STAGE(PG8_SB(0, 0), cB, voffB); PG8_STAGE(PG8_SB(0, 1), cB + hstepB, voffB); PG8_STAGE(PG8_SA(0, 0), cA, voffA); PG8_STAGE(PG8_SA(0, 1), cA + hstepA, voffA);
        if (wr == 1) PG8_BAR;
        PG8_WAIT_V(2); PG8_BAR;
        PG8_STAGE(PG8_SB(1, 0), cB + kstep, voffB); PG8_STAGE(PG8_SA(1, 0), cA + kstep, voffA); PG8_STAGE(PG8_SB(1, 1), cB + hstepB + kstep, voffB);
        PG8_WAIT_V(6); PG8_BAR;
    } else {
        PG8_STAGE(PG8_SB(0, 0), cB, voffB); PG8_STAGE(PG8_SA(0, 0), cA, voffA); PG8_STAGE(PG8_SB(0, 1), cB + hstepB, voffB); PG8_STAGE(PG8_SA(0, 1), cA + hstepA, voffA);
        if (wr == 1) PG8_BAR;
        PG8_WAIT_V(4); PG8_BAR;
        PG8_STAGE(PG8_SB(1, 0), cB + kstep, voffB); PG8_STAGE(PG8_SA(1, 0), cA + kstep, voffA); PG8_STAGE(PG8_SB(1, 1), cB + hstepB + kstep, voffB);
        PG8_WAIT_V(6); PG8_BAR;
    }
    for (;;) {
        const bool has_next = S.next(ui + 1, nxt);
        const char* nA = has_next ? (const char*)g.A + (size_t)nxt.pm * tstepA : cA; const char* nB = has_next ? (const char*)g.Bt + (size_t)nxt.pn * tstepB : cB;
        for (int t = 0; t < nt; t += 2) {
            const bool last = (t == nt - 2);
            const char* a1 = cA + (size_t)(t + 1) * kstep;
            const char* a2 = last ? nA : cA + (size_t)(t + 2) * kstep; const char* b2 = last ? nB : cB + (size_t)(t + 2) * kstep;
            const char* a3 = a2 + kstep; const char* b3 = b2 + kstep;
            if (last && has_next) S.a_ready(nxt);
            if constexpr (SP2) {
            PG8_LDB(B0, 0, 0); PG8_LDB(B1, 0, 1); PG8_SCHED; PG8_LDA(At, 0, 0); PG8_STAGE(PG8_SA(1, 1), a1 + hstepA, voffA);
            PG8_WAIT_V(8); PG8_WAIT_L(0); PG8_BAR; PG8_MMA(0, 0, At, B0); PG8_MMA(0, 1, At, B1); PG8_BAR; PG8_SCHED;
            PG8_LDA(At, 0, 1); PG8_STAGE(PG8_SB(0, 0), b2, voffB); PG8_STAGE(PG8_SB(0, 1), b2 + hstepB, voffB); PG8_STAGE(PG8_SA(0, 0), a2, voffA);
            PG8_WAIT_V(8); PG8_WAIT_L(0); PG8_BAR; PG8_MMA(1, 0, At, B0); PG8_MMA(1, 1, At, B1); PG8_BAR; PG8_SCHED;
            PG8_LDB(B0, 1, 0); PG8_LDB(B1, 1, 1); PG8_SCHED; PG8_LDA(At, 1, 0); PG8_STAGE(PG8_SA(0, 1), a2 + hstepA, voffA);
            PG8_WAIT_V(8); PG8_WAIT_L(0); PG8_BAR; PG8_MMA(0, 0, At, B0); PG8_MMA(0, 1, At, B1); PG8_BAR; PG8_SCHED;
            PG8_LDA(At, 1, 1); PG8_STAGE(PG8_SB(1, 0), b3, voffB); PG8_STAGE(PG8_SB(1, 1), b3 + hstepB, voffB); PG8_STAGE(PG8_SA(1, 0), a3, voffA);
            PG8_WAIT_V(8); PG8_WAIT_L(0); PG8_BAR; PG8_MMA(1, 0, At, B0); PG8_MMA(1, 1, At, B1); PG8_BAR; PG8_SCHED;
            } else {
            PG8_LDB(B0, 0, 0); PG8_SCHED; PG8_LDA(At, 0, 0); PG8_STAGE(PG8_SA(1, 1), a1 + hstepA, voffA);
            PG8_WAIT_L(8); PG8_BAR; PG8_WAIT_L(0); PG8_MMA(0, 0, At, B0); PG8_BAR; PG8_SCHED;
            PG8_LDB(B1, 0, 1); PG8_STAGE(PG8_SB(0, 0), b2, voffB);
            PG8_BAR; PG8_WAIT_L(0); PG8_MMA(0, 1, At, B1); PG8_BAR;
            PG8_LDA(At, 0, 1); PG8_STAGE(PG8_SA(0, 0), a2, voffA);
            PG8_BAR; PG8_WAIT_L(0); PG8_MMA(1, 0, At, B0); PG8_BAR; PG8_SCHED;
            PG8_STAGE(PG8_SB(0, 1), b2 + hstepB, voffB);
            PG8_WAIT_V(6); PG8_BAR; PG8_MMA(1, 1, At, B1); PG8_BAR;
            PG8_LDB(B0, 1, 0); PG8_SCHED; PG8_LDA(At, 1, 0); PG8_STAGE(PG8_SA(0, 1), a2 + hstepA, voffA);
            PG8_WAIT_L(8); PG8_BAR; PG8_WAIT_L(0); PG8_MMA(0, 0, At, B0); PG8_BAR; PG8_SCHED;
            PG8_LDB(B1, 1, 1); PG8_STAGE(PG8_SB(1, 0), b3, voffB);
            PG8_BAR; PG8_WAIT_L(0); PG8_MMA(0, 1, At, B1); PG8_BAR;
            PG8_LDA(At, 1, 1); PG8_STAGE(PG8_SA(1, 0), a3, voffA);
            PG8_BAR; PG8_WAIT_L(0); PG8_MMA(1, 0, At, B0); PG8_BAR; PG8_SCHED;
            PG8_STAGE(PG8_SB(1, 1), b3 + hstepB, voffB);
            PG8_WAIT_V(6); PG8_BAR; PG8_MMA(1, 1, At, B1); PG8_BAR;
            }
        }
        if constexpr (ALIGN_EPI) { if (wr == 0) PG8_BAR; }
        if constexpr (!Epi::AFTER_DRAIN) { E(acc, cur, wr, wc, fr, fq); S.done(cur); }
        if (!has_next) break;
#pragma unroll
        for (int a = 0; a < 2; ++a)
#pragma unroll
            for (int b = 0; b < 2; ++b)
#pragma unroll
                for (int m = 0; m < 4; ++m)
#pragma unroll
                    for (int n = 0; n < 2; ++n) acc[a][b][m][n] = (f32x4){0.f, 0.f, 0.f, 0.f};
        cur = nxt; cA = nA; cB = nB; ++ui;
        if constexpr (ALIGN_EPI) { if (wr == 1) PG8_BAR; }
    }
    PG8_WAIT_V(0);
    if constexpr (!ALIGN_EPI) { if (wr == 0) PG8_BAR; }
    PG8_BAR;
    if constexpr (Epi::AFTER_DRAIN) { E.fused(acc, cur, wr, wc, fr, fq, lds, wid, lane); S.done(cur); }
#undef PG8_SA
#undef PG8_SB
#undef PG8_STAGE
#undef PG8_LDA
#undef PG8_LDB
#undef PG8_MMA
#undef PG8_WAIT_V
#undef PG8_WAIT_L
#undef PG8_BAR
#undef PG8_SCHED
}
}
#define LAS __attribute__((address_space(3)))
typedef unsigned short bf16_t;
typedef short bf16x8 __attribute__((ext_vector_type(8)));
typedef short s16x4 __attribute__((ext_vector_type(4)));
typedef float f32x4 __attribute__((ext_vector_type(4)));
typedef float f32x16 __attribute__((ext_vector_type(16)));
typedef unsigned u32x4 __attribute__((ext_vector_type(4)));
typedef unsigned u32x2 __attribute__((ext_vector_type(2)));

constexpr int NB = 8, SEQ = 8192, DM = 1024, CTX = 256, MLAT = NB * SEQ, MCTX = NB * CTX, MALL = MLAT + MCTX;
constexpr int PW = 1536, KVLEN = CTX + SEQ, DFF = 2816, NMOD = 6 * DM;
constexpr int NCH = 32, CHL = 256;
constexpr float EPS = 1e-6f;
constexpr float QSCALE = 0.10206207261596575f * 1.4426950408889634f;
constexpr size_t MiB = 1u << 20;
constexpr size_t WS_CTL = 0, CTL_BYTES = 2 * MiB;
constexpr size_t WS_MOD = 64 * 1024, WS_SSQ = 512 * 1024, WS_SSKV = 1024 * 1024;
constexpr size_t WS_WIN = 2 * MiB, WS_WQ = 5 * MiB, WS_WKV = 6 * MiB, WS_WG = 7 * MiB, WS_WOUT = 8 * MiB, WS_WUP = 10 * MiB, WS_WDN = 21 * MiB;
constexpr size_t WS_AGG = 27 * MiB, WS_ROPE = 29 * MiB + 512 * 1024;
constexpr size_t WS_R1 = 30 * MiB;
constexpr size_t WS_R2 = 162 * MiB;
constexpr size_t WS_LU = 360 * MiB, WS_K = 624 * MiB, WS_V = 723 * MiB, WS_A2 = 789 * MiB;
constexpr size_t WS_UP = 360 * MiB, WS_G = 712 * MiB, WS_Q = 920 * MiB, WS_END = 1016 * MiB;
constexpr int LDS_BYTES = 139264;

__device__ __forceinline__ unsigned f2bf(float f) { unsigned u = __builtin_bit_cast(unsigned, f); return (u + 0x7fffu + ((u >> 16) & 1u)) >> 16; }
__device__ __forceinline__ unsigned pk2(float lo, float hi) { return f2bf(lo) | (f2bf(hi) << 16); }
__device__ __forceinline__ float bflo(unsigned w) { return __uint_as_float(w << 16); }
__device__ __forceinline__ float bfhi(unsigned w) { return __uint_as_float(w & 0xffff0000u); }
__device__ __forceinline__ float bf2f(bf16_t v) { return __uint_as_float((unsigned)v << 16); }
__device__ __forceinline__ int crow(int r, int hi) { return (r & 3) + 8 * (r >> 2) + 4 * hi; }
__device__ __forceinline__ float wave_sum(float v) {
#pragma unroll
    for (int o = 1; o < 64; o <<= 1) v += __shfl_xor(v, o);
    return v;
}
__device__ __forceinline__ float sigmoidf_(float x) { return 1.f / (1.f + __expf(-x)); }
#define LDS_WAIT() asm volatile("s_waitcnt lgkmcnt(0)" ::: "memory")

struct Args { const float* in[27]; float* out; unsigned char* ws; int ph_lo, ph_hi; };
__device__ __forceinline__ const float* argp(int i) {
    const __attribute__((address_space(4))) char* kp = (const __attribute__((address_space(4))) char*)__builtin_amdgcn_kernarg_segment_ptr();
    asm volatile("" : "+s"(kp));
    return *(const float* const __attribute__((address_space(4)))*)(kp + 8 * i);
}

template <int ID> __device__ __forceinline__ float wsrc(const float* p0, const float* p1, int n, int k) {
    if (ID == 0) return n < 1440 ? p0[(size_t)k * 1440 + n] : 0.f;
    if (ID == 1) return p0[k] * p1[(size_t)k * 768 + n];
    if (ID == 2) return k < 128 ? p0[k] * p1[(size_t)k * 1024 + n] : 0.f;
    if (ID == 3) { const int h = n >> 8, np = n & 255, mat = np >> 6, j = np & 63, dir = mat >> 1; const float* w = (mat & 1) ? p1 : p0; return w[(size_t)((dir * 8 + h) * 64 + k) * 64 + j]; }
    if (ID == 4) return p0[(size_t)k * 1024 + n];
    if (ID == 5) return p0[(size_t)k * 5632 + n];
    return p0[(size_t)k * 1024 + n];
}
template <int ID> __device__ __forceinline__ void prep_mat(const float* p0, const float* p1, bf16_t* dst, int N, int K, int gtid, int NT) {
    const int items = N * (K / 8);
    for (int it = gtid; it < items; it += NT) {
        const int n = it % N, k8 = it / N;
        u32x4 o;
        o.x = pk2(wsrc<ID>(p0, p1, n, 8 * k8 + 0), wsrc<ID>(p0, p1, n, 8 * k8 + 1)); o.y = pk2(wsrc<ID>(p0, p1, n, 8 * k8 + 2), wsrc<ID>(p0, p1, n, 8 * k8 + 3));
        o.z = pk2(wsrc<ID>(p0, p1, n, 8 * k8 + 4), wsrc<ID>(p0, p1, n, 8 * k8 + 5)); o.w = pk2(wsrc<ID>(p0, p1, n, 8 * k8 + 6), wsrc<ID>(p0, p1, n, 8 * k8 + 7));
        *(u32x4*)(dst + (size_t)n * K + 8 * k8) = o;
    }
}
__device__ __forceinline__ void mod_phase(const float* cvec, const float* cctx, const float* wmod, const float* bmod, float* mod, LAS float* scr, int gw, int NGW, int lane) {
    for (int task = gw; task < 96 * 16; task += NGW) {
        const int cgp = task % 96, kc = task / 96, n = cgp * 64 + lane, k0 = kc * 64;
#pragma unroll
        for (int r = 0; r < 9; ++r) { const float cv = r < 8 ? cvec[r * 1024 + k0 + lane] : cctx[k0 + lane]; scr[r * 64 + lane] = cv / (1.f + __expf(-cv)); }
        LDS_WAIT();
        float acc[9];
#pragma unroll
        for (int r = 0; r < 9; ++r) acc[r] = 0.f;
#pragma unroll 8
        for (int kk = 0; kk < 64; ++kk) { const float w = wmod[(size_t)(k0 + kk) * NMOD + n];
#pragma unroll
            for (int r = 0; r < 9; ++r) acc[r] += scr[r * 64 + kk] * w; }
        const float bias = kc == 0 ? bmod[n] : 0.f;
#pragma unroll
        for (int r = 0; r < 9; ++r) atomicAdd(mod + r * NMOD + n, acc[r] + bias);
        LDS_WAIT();
    }
}
__device__ __forceinline__ void p1_rows(const float* x, const float* ctx, const float* g, const float* mod, bf16_t* H, int gw, int NGW, int lane) {
    for (int m = gw; m < MALL; m += NGW) {
        const float* src = m < MLAT ? x + (size_t)m * DM : ctx + (size_t)(m - MLAT) * DM;
        const float* md = mod + (m < MLAT ? (m >> 13) : 8) * NMOD;
        f32x4 v[4]; float ss = 0.f;
#pragma unroll
        for (int j = 0; j < 4; ++j) { v[j] = *(const f32x4*)(src + 4 * lane + 256 * j); ss += v[j].x * v[j].x + v[j].y * v[j].y + v[j].z * v[j].z + v[j].w * v[j].w; }
        const float rs = rsqrtf(wave_sum(ss) * (1.f / DM) + EPS);
#pragma unroll
        for (int j = 0; j < 4; ++j) { const int k = 4 * lane + 256 * j;
            const f32x4 gg = *(const f32x4*)(g + k), sh = *(const f32x4*)(md + k), sc = *(const f32x4*)(md + DM + k);
            const f32x4 y = v[j] * rs * gg * (sc + 1.f) + sh;
            u32x2 o; o.x = pk2(y.x, y.y); o.y = pk2(y.z, y.w); *(u32x2*)(H + (size_t)m * DM + k) = o; }
    }
}
__device__ __forceinline__ void ss_phase(const bf16_t* P, float* ssq, float* sskv, int gw, int NGW, int lane) {
    for (int m = gw; m < MALL; m += NGW) {
        const u32x2 q = *(const u32x2*)(P + (size_t)m * PW + 1024 + 4 * lane); const unsigned k = *(const unsigned*)(P + (size_t)m * PW + 1280 + 2 * lane);
        float a = bflo(q.x) * bflo(q.x) + bfhi(q.x) * bfhi(q.x) + bflo(q.y) * bflo(q.y) + bfhi(q.y) * bfhi(q.y), c = bflo(k) * bflo(k) + bfhi(k) * bfhi(k);
        a = wave_sum(a); c = wave_sum(c);
        if (lane == 0) { ssq[m] = a; sskv[m] = c; }
    }
}
__device__ __forceinline__ void qpost_phase(const bf16_t* QR, const float* ssq, const float* RT, bf16_t* Q, int gtid, int NT) {
    for (int task = gtid; task < MLAT * 96; task += NT) {
        const int row = task / 96, c8 = task - row * 96, h = c8 / 12, dc = c8 - h * 12, b = row >> 13, s = row & 8191;
        const float sc = rsqrtf(ssq[row] * (1.f / 256.f) + EPS) * QSCALE;
        const u32x4 mine = *(const u32x4*)(QR + (size_t)row * 768 + 8 * c8);
        float v[8];
#pragma unroll
        for (int j = 0; j < 4; ++j) { v[2 * j] = bflo(mine[j]) * sc; v[2 * j + 1] = bfhi(mine[j]) * sc; }
        if (dc >= 8) { const int fq = dc - 8; const u32x4 oth = *(const u32x4*)(QR + (size_t)row * 768 + 8 * (c8 ^ 1));
            const float* rt = RT + (fq < 2 ? (s >> 6) : (s & 63)) * 16;
#pragma unroll
            for (int j = 0; j < 8; ++j) { const float pt = ((j & 1) ? bfhi(oth[j >> 1]) : bflo(oth[j >> 1])) * sc, cs = rt[2 * j], sn = rt[2 * j + 1];
                v[j] = (fq & 1) ? v[j] * cs + pt * sn : v[j] * cs - pt * sn; } }
        u32x4 w; w.x = pk2(v[0], v[1]); w.y = pk2(v[2], v[3]); w.z = pk2(v[4], v[5]); w.w = pk2(v[6], v[7]);
        *(u32x4*)(Q + ((size_t)((b * 8 + h) * SEQ + s)) * 96 + 8 * dc) = w;
    }
}
__device__ __forceinline__ void kvpost_phase(const bf16_t* KVR, const float* sskv, bf16_t* Kb, bf16_t* Vt, int gtid, int NT) {
    for (int task = gtid; task < MALL * 64; task += NT) {
        const int row = task >> 6, c = task & 63, h = c >> 3, dd = (c & 7) * 8; const bool lat = row < MLAT;
        const int b = lat ? (row >> 13) : ((row - MLAT) >> 8), pos = lat ? (CTX + (row & 8191)) : ((row - MLAT) & 255);
        const float rs = rsqrtf(sskv[row] * (1.f / 128.f) + EPS);
        const u32x4 mine = *(const u32x4*)(KVR + (size_t)row * 1024 + h * 128 + dd);
        u32x4 w;
#pragma unroll
        for (int j = 0; j < 4; ++j) w[j] = pk2(bflo(mine[j]) * rs, bfhi(mine[j]) * rs);
        *(u32x4*)(Kb + ((size_t)(b * 8 + h) * KVLEN + pos) * 96 + dd) = w;
    }
    for (int task = gtid; task < (MALL / 8) * 512; task += NT) {
        const int rg = task >> 9, hd = task & 511, h = hd >> 6, d = hd & 63, row0 = rg * 8; const bool lat = row0 < MLAT;
        const int b = lat ? (row0 >> 13) : ((row0 - MLAT) >> 8), pos0 = lat ? (CTX + (row0 & 8191)) : ((row0 - MLAT) & 255);
        float v[8];
#pragma unroll
        for (int i = 0; i < 8; ++i) v[i] = bf2f(KVR[(size_t)(row0 + i) * 1024 + h * 128 + 64 + d]) * rsqrtf(sskv[row0 + i] * (1.f / 128.f) + EPS);
        u32x4 w; w.x = pk2(v[0], v[1]); w.y = pk2(v[2], v[3]); w.z = pk2(v[4], v[5]); w.w = pk2(v[6], v[7]);
        *(u32x4*)(Vt + ((size_t)((b * 8 + h) * 64 + d)) * KVLEN + pos0) = w;
    }
}
__device__ __forceinline__ void krope_phase(const bf16_t* P, bf16_t* Kb, const float* RT, int gtid, int NT) {
    for (int task = gtid; task < MALL * 4; task += NT) {
        const int row = task >> 2, fq = task & 3; const bool lat = row < MLAT;
        const int b = lat ? (row >> 13) : ((row - MLAT) >> 8), s = row & 8191, pos = lat ? (CTX + s) : ((row - MLAT) & 255);
        const u32x4 mine = *(const u32x4*)(P + (size_t)row * PW + 1408 + 8 * fq), oth = *(const u32x4*)(P + (size_t)row * PW + 1408 + 8 * (fq ^ 1));
        float v[8], pt[8];
#pragma unroll
        for (int j = 0; j < 4; ++j) { v[2 * j] = bflo(mine[j]); v[2 * j + 1] = bfhi(mine[j]); pt[2 * j] = bflo(oth[j]); pt[2 * j + 1] = bfhi(oth[j]); }
        if (lat) { const float* rt = RT + (fq < 2 ? (s >> 6) : (s & 63)) * 16;
#pragma unroll
            for (int j = 0; j < 8; ++j) { const float cs = rt[2 * j], sn = rt[2 * j + 1]; v[j] = (fq & 1) ? v[j] * cs + pt[j] * sn : v[j] * cs - pt[j] * sn; } }
        u32x4 w; w.x = pk2(v[0], v[1]); w.y = pk2(v[2], v[3]); w.z = pk2(v[4], v[5]); w.w = pk2(v[6], v[7]);
#pragma unroll
        for (int h = 0; h < 8; ++h) *(u32x4*)(Kb + ((size_t)(b * 8 + h) * KVLEN + pos) * 96 + 64 + 8 * fq) = w;
    }
}
#define MFMA32(a, b, c) __builtin_amdgcn_mfma_f32_32x32x16_bf16((a), (b), (c), 0, 0, 0)
__device__ __forceinline__ void gates_phase(const float* cw, const float* cb, const float* b_a, const float* b_x, const float* lam, LAS unsigned char* lds, const bf16_t* P, const bf16_t* Wg, unsigned* LU, int wave, int lane) {
    LAS bf16_t* xs = (LAS bf16_t*)(lds + wave * 4608);
    const int r32 = lane & 31, hi = lane >> 5;
    for (int unit = blockIdx.x; unit < (MALL / 256) * 8; unit += gridDim.x) {
        const int pm = unit >> 3, h = unit & 7, m0 = pm * 256 + wave * 32;
        const int s0 = m0 < MLAT ? (m0 & ~8191) : (MLAT + ((m0 - MLAT) & ~255)), slen = m0 < MLAT ? SEQ : CTX;
        {
            const int tok = lane >> 1, m = m0 + tok;
#pragma unroll
            for (int c8 = 0; c8 < 4; ++c8) { const int ch = (lane & 1) * 32 + c8 * 8, gch = h * 64 + ch;
                float acc[8];
                { const f32x4 b0 = *(const f32x4*)(cb + gch), b1 = *(const f32x4*)(cb + gch + 4);
                  acc[0] = b0.x; acc[1] = b0.y; acc[2] = b0.z; acc[3] = b0.w; acc[4] = b1.x; acc[5] = b1.y; acc[6] = b1.z; acc[7] = b1.w; }
#pragma unroll
                for (int k = 0; k < 4; ++k) { const int mm = m + k - 2;
                    if (mm >= s0 && mm < s0 + slen) { const u32x4 xv = *(const u32x4*)(P + (size_t)mm * PW + gch);
                        const f32x4 w0 = *(const f32x4*)(cw + k * 512 + gch), w1 = *(const f32x4*)(cw + k * 512 + gch + 4);
                        acc[0] += w0.x * bflo(xv.x); acc[1] += w0.y * bfhi(xv.x); acc[2] += w0.z * bflo(xv.y); acc[3] += w0.w * bfhi(xv.y);
                        acc[4] += w1.x * bflo(xv.z); acc[5] += w1.y * bfhi(xv.z); acc[6] += w1.z * bflo(xv.w); acc[7] += w1.w * bfhi(xv.w); } }
                u32x4 o; o.x = pk2(acc[0], acc[1]); o.y = pk2(acc[2], acc[3]); o.z = pk2(acc[4], acc[5]); o.w = pk2(acc[6], acc[7]);
                *(LAS u32x4*)(xs + tok * 72 + ch) = o; }
        }
        LDS_WAIT();
        bf16x8 afr[4];
#pragma unroll
        for (int ks = 0; ks < 4; ++ks) afr[ks] = *(const LAS bf16x8*)(xs + r32 * 72 + 16 * ks + 8 * hi);
#pragma unroll
        for (int jh = 0; jh < 2; ++jh) {
            f32x16 acc4[4];
#pragma unroll
            for (int q = 0; q < 4; ++q) {
#pragma unroll
                for (int i = 0; i < 16; ++i) acc4[q][i] = 0.f;
                const bf16_t* wrow = Wg + (size_t)(h * 256 + (2 * q + jh) * 32 + r32) * 64 + 8 * hi;
#pragma unroll
                for (int ks = 0; ks < 4; ++ks) { const bf16x8 bfr = *(const bf16x8*)(wrow + 16 * ks); acc4[q] = MFMA32(afr[ks], bfr, acc4[q]); }
            }
            const int ch = jh * 32 + r32, gch = h * 64 + ch;
            float ba[2], bx[2], sp[2];
#pragma unroll
            for (int d = 0; d < 2; ++d) { ba[d] = b_a[d * 512 + gch]; bx[d] = b_x[d * 512 + gch]; const float nl = -lam[d * 512 + gch];
                sp[d] = 8.f * (nl > 20.f ? nl : log1pf(__expf(nl))); }
#pragma unroll
            for (int i = 0; i < 16; ++i) { const int row = crow(i, hi); const float xv = bf2f(xs[row * 72 + ch]);
#pragma unroll
                for (int d = 0; d < 2; ++d) { const float r = sigmoidf_(acc4[2 * d][i] + ba[d]), ig = sigmoidf_(acc4[2 * d + 1][i] + bx[d]);
                    const float la = -r * sp[d]; const float uu = sqrtf(fmaxf(-expm1f(2.f * la), 0.f)) * (ig * xv);
                    LU[((size_t)(m0 + row) * 2 + d) * 512 + gch] = pk2(la * 1.4426950408889634f, uu); } }
        }
        LDS_WAIT();
    }
}
__device__ __forceinline__ void scan_agg(const unsigned* LU, float2* AGG, int gw, int NGW, int lane) {
    for (int task = gw; task < NB * 2 * (NCH + 1) * 8; task += NGW) {
        const int cgp = task & 7, c = (task >> 3) % (NCH + 1), d = (task / (8 * (NCH + 1))) & 1, b = task / (16 * (NCH + 1));
        const int ch = cgp * 64 + lane, row0 = c < NCH ? b * SEQ + c * CHL : MLAT + b * CTX;
        float A = 1.f, U = 0.f;
#pragma unroll 8
        for (int t = 0; t < CHL; ++t) { const int tt = d ? CHL - 1 - t : t; const unsigned w = LU[((size_t)(row0 + tt) * 2 + d) * 512 + ch];
            const float av = exp2f(bflo(w)); A *= av; U = av * U + bfhi(w); }
        AGG[(size_t)((b * 2 + d) * (NCH + 1) + c) * 512 + ch] = make_float2(A, U);
    }
}
__device__ __forceinline__ float gelu_tanh(float x) { const float t = tanhf(0.7978845608028654f * (x + 0.044715f * x * x * x)); return 0.5f * x * (1.f + t); }
__device__ __forceinline__ void scan_final(const unsigned* LU, const float2* AGG, const bf16_t* P, bf16_t* A2, int gw, int NGW, int lane) {
    for (int task = gw; task < NB * NCH * 8; task += NGW) {
        const int cgp = task & 7, c = (task >> 3) & (NCH - 1), b = task / (8 * NCH), ch = cgp * 64 + lane, row0 = b * SEQ + c * CHL;
        const float2* ag0 = AGG + (size_t)((b * 2 + 0) * (NCH + 1)) * 512 + ch; const float2* ag1 = AGG + (size_t)((b * 2 + 1) * (NCH + 1)) * 512 + ch;
        float hf = ag0[(size_t)NCH * 512].y;
        for (int cc = 0; cc < c; ++cc) { const float2 g = ag0[(size_t)cc * 512]; hf = g.x * hf + g.y; }
#pragma unroll 8
        for (int t = 0; t < CHL; ++t) { const unsigned w = LU[((size_t)(row0 + t) * 2 + 0) * 512 + ch]; hf = exp2f(bflo(w)) * hf + bfhi(w);
            A2[(size_t)(row0 + t) * DM + ch] = (bf16_t)f2bf(hf); }
        float hb = ag1[(size_t)NCH * 512].y;
        for (int cc = NCH - 1; cc > c; --cc) { const float2 g = ag1[(size_t)cc * 512]; hb = g.x * hb + g.y; }
#pragma unroll 8
        for (int t = CHL - 1; t >= 0; --t) { const unsigned w = LU[((size_t)(row0 + t) * 2 + 1) * 512 + ch]; hb = exp2f(bflo(w)) * hb + bfhi(w);
            const float f = bf2f(A2[(size_t)(row0 + t) * DM + ch]), gr = bf2f(P[(size_t)(row0 + t) * PW + 512 + ch]);
            A2[(size_t)(row0 + t) * DM + ch] = (bf16_t)f2bf((f + hb) * gelu_tanh(gr)); }
    }
}
constexpr int AT_KROW = 208, AT_KBUF = 64 * AT_KROW, AT_VROW = 144, AT_VBUF = 64 * AT_VROW, AT_VOFF = 2 * AT_KBUF;
constexpr float AT_THR = 8.f;
__device__ __forceinline__ unsigned cvtpk(float lo, float hi) { typedef float f2 __attribute__((ext_vector_type(2))); typedef __bf16 b2 __attribute__((ext_vector_type(2))); f2 v = {lo, hi}; b2 r = __builtin_convertvector(v, b2); return __builtin_bit_cast(unsigned, r); }
#define AT_SOFTMAX(P, M, L, O0, O1, PW0, PW1) do { \
        float mx_ = fmaxf(fmaxf(P[0], P[1]), fmaxf(P[2], P[3])); \
        _Pragma("unroll") for (int i_ = 4; i_ < 16; i_ += 4) mx_ = fmaxf(fmaxf(mx_, P[i_]), fmaxf(fmaxf(P[i_ + 1], P[i_ + 2]), P[i_ + 3])); \
        mx_ = fmaxf(mx_, __shfl_xor(mx_, 32)); \
        if (__any(mx_ > M + AT_THR)) { const float mn_ = fmaxf(M, mx_), al_ = __builtin_amdgcn_exp2f(M - mn_); M = mn_; L *= al_; \
            _Pragma("unroll") for (int i_ = 0; i_ < 16; ++i_) { O0[i_] *= al_; O1[i_] *= al_; } } \
        float s_ = 0.f; \
        _Pragma("unroll") for (int i_ = 0; i_ < 16; ++i_) { P[i_] = __builtin_amdgcn_exp2f(P[i_] - M); s_ += P[i_]; } \
        L += s_; \
        _Pragma("unroll") for (int j_ = 0; j_ < 4; ++j_) { PW0[j_] = cvtpk(P[2 * j_], P[2 * j_ + 1]); PW1[j_] = cvtpk(P[8 + 2 * j_], P[9 + 2 * j_]); } } while (0)
__device__ __forceinline__ void attn_unit(LAS unsigned char* lds, const bf16_t* Q, const bf16_t* K, const bf16_t* Vt, bf16_t* A2, int b, int h, int qb, int tid, int wave, int lane) {
    const int r32 = lane & 31, hi = lane >> 5, q0 = qb * 512 + wave * 64;
    const bf16_t* Qp = Q + ((size_t)((b * 8 + h) * SEQ + q0 + r32)) * 96 + 8 * hi;
    bf16x8 qa[6], qc[6];
#pragma unroll
    for (int d0 = 0; d0 < 6; ++d0) { qa[d0] = *(const bf16x8*)(Qp + 16 * d0); qc[d0] = *(const bf16x8*)(Qp + 32 * 96 + 16 * d0); }
    const unsigned char* Kg = (const unsigned char*)(K + (size_t)(b * 8 + h) * KVLEN * 96);
    const bf16_t* Vg = Vt + (size_t)(b * 8 + h) * 64 * KVLEN;
    const int kc1 = tid + 512; const bool k1 = kc1 < 768;
    const int kdst0 = (tid / 12) * AT_KROW + (tid % 12) * 16, kdst1 = (kc1 / 12) * AT_KROW + (kc1 % 12) * 16;
    const int vd = tid >> 3, vc = tid & 7;
    const bf16_t* vsrc = Vg + (size_t)vd * KVLEN + vc * 8; const int vdst = AT_VOFF + vd * AT_VROW + vc * 16;
    u32x4 kreg0, kreg1 = {0u, 0u, 0u, 0u}, vreg;
#define AT_LOAD(t) do { kreg0 = *(const u32x4*)(Kg + (size_t)(t) * 12288 + tid * 16); if (k1) kreg1 = *(const u32x4*)(Kg + (size_t)(t) * 12288 + kc1 * 16); \
        vreg = *(const u32x4*)(vsrc + (t) * 64); } while (0)
#define AT_STORE(buf) do { *(LAS u32x4*)(lds + (buf) * AT_KBUF + kdst0) = kreg0; if (k1) *(LAS u32x4*)(lds + (buf) * AT_KBUF + kdst1) = kreg1; \
        *(LAS u32x4*)(lds + (buf) * AT_VBUF + vdst) = vreg; } while (0)
    f32x16 oA0, oA1, oB0, oB1;
#pragma unroll
    for (int i = 0; i < 16; ++i) { oA0[i] = 0.f; oA1[i] = 0.f; oB0[i] = 0.f; oB1[i] = 0.f; }
    float mA = -1e30f, mB = -1e30f, lA = 0.f, lB = 0.f;
    AT_LOAD(0); AT_STORE(0); __syncthreads();
    constexpr int NT_ = KVLEN / 64;
#pragma unroll 1
    for (int t = 0; t < NT_; ++t) {
        const int buf = t & 1;
        if (t + 1 < NT_) AT_LOAD(t + 1);
#pragma unroll
        for (int hh = 0; hh < 2; ++hh) {
            const LAS unsigned char* kb = lds + buf * AT_KBUF + (32 * hh + r32) * AT_KROW + hi * 16;
            f32x16 pA, pB;
#pragma unroll
            for (int i = 0; i < 16; ++i) { pA[i] = 0.f; pB[i] = 0.f; }
#pragma unroll
            for (int d0 = 0; d0 < 6; ++d0) { const bf16x8 a0 = *(const LAS bf16x8*)(kb + d0 * 32); pA = MFMA32(a0, qa[d0], pA); pB = MFMA32(a0, qc[d0], pB); }
            u32x4 pwA0, pwA1, pwB0, pwB1;
            AT_SOFTMAX(pA, mA, lA, oA0, oA1, pwA0, pwA1);
            AT_SOFTMAX(pB, mB, lB, oB0, oB1, pwB0, pwB1);
            const LAS unsigned char* vb = lds + AT_VOFF + buf * AT_VBUF + r32 * AT_VROW + hi * 8 + hh * 64;
#pragma unroll
            for (int ks = 0; ks < 2; ++ks) {
                const s16x4 lo0 = *(const LAS s16x4*)(vb + ks * 32), hi0 = *(const LAS s16x4*)(vb + ks * 32 + 16);
                const s16x4 lo1 = *(const LAS s16x4*)(vb + 32 * AT_VROW + ks * 32), hi1 = *(const LAS s16x4*)(vb + 32 * AT_VROW + ks * 32 + 16);
                const bf16x8 va0 = __builtin_shufflevector(lo0, hi0, 0, 1, 2, 3, 4, 5, 6, 7), va1 = __builtin_shufflevector(lo1, hi1, 0, 1, 2, 3, 4, 5, 6, 7);
                const bf16x8 pa = __builtin_bit_cast(bf16x8, ks ? pwA1 : pwA0), pb = __builtin_bit_cast(bf16x8, ks ? pwB1 : pwB0);
                oA0 = MFMA32(va0, pa, oA0); oA1 = MFMA32(va1, pa, oA1); oB0 = MFMA32(va0, pb, oB0); oB1 = MFMA32(va1, pb, oB1);
            }
        }
        if (t + 1 < NT_) AT_STORE(buf ^ 1);
        __syncthreads();
    }
    {   const float inv = 1.f / (lA + __shfl_xor(lA, 32));
        bf16_t* op = A2 + (size_t)(b * SEQ + q0 + r32) * DM + 512 + h * 64 + 4 * hi;
#pragma unroll
        for (int g = 0; g < 4; ++g) { u32x2 w0, w1; w0.x = pk2(oA0[4 * g] * inv, oA0[4 * g + 1] * inv); w0.y = pk2(oA0[4 * g + 2] * inv, oA0[4 * g + 3] * inv);
            w1.x = pk2(oA1[4 * g] * inv, oA1[4 * g + 1] * inv); w1.y = pk2(oA1[4 * g + 2] * inv, oA1[4 * g + 3] * inv);
            *(u32x2*)(op + 8 * g) = w0; *(u32x2*)(op + 32 + 8 * g) = w1; } }
    {   const float inv = 1.f / (lB + __shfl_xor(lB, 32));
        bf16_t* op = A2 + (size_t)(b * SEQ + q0 + 32 + r32) * DM + 512 + h * 64 + 4 * hi;
#pragma unroll
        for (int g = 0; g < 4; ++g) { u32x2 w0, w1; w0.x = pk2(oB0[4 * g] * inv, oB0[4 * g + 1] * inv); w0.y = pk2(oB0[4 * g + 2] * inv, oB0[4 * g + 3] * inv);
            w1.x = pk2(oB1[4 * g] * inv, oB1[4 * g + 1] * inv); w1.y = pk2(oB1[4 * g + 2] * inv, oB1[4 * g + 3] * inv);
            *(u32x2*)(op + 8 * g) = w0; *(u32x2*)(op + 32 + 8 * g) = w1; } }
#undef AT_LOAD
#undef AT_STORE
}
__device__ __forceinline__ void p7_rows(const float* x, const float* g_post, const float* g_pre, float* out, const float* mod, const bf16_t* Y, bf16_t* H2, int gw, int NGW, int lane) {
    for (int m = gw; m < MLAT; m += NGW) {
        const float* md = mod + (m >> 13) * NMOD;
        f32x4 y[4], x1[4]; float ss = 0.f;
#pragma unroll
        for (int j = 0; j < 4; ++j) { const u32x2 w = *(const u32x2*)(Y + (size_t)m * DM + 4 * lane + 256 * j);
            y[j] = (f32x4){bflo(w.x), bfhi(w.x), bflo(w.y), bfhi(w.y)}; ss += y[j].x * y[j].x + y[j].y * y[j].y + y[j].z * y[j].z + y[j].w * y[j].w; }
        const float rs = rsqrtf(wave_sum(ss) * (1.f / DM) + EPS); float s2 = 0.f;
#pragma unroll
        for (int j = 0; j < 4; ++j) { const int k = 4 * lane + 256 * j;
            const f32x4 xv = *(const f32x4*)(x + (size_t)m * DM + k), gg = *(const f32x4*)(g_post + k), gt = *(const f32x4*)(md + 2 * DM + k);
            x1[j] = xv + gt * (y[j] * rs * gg); *(f32x4*)(out + (size_t)m * DM + k) = x1[j];
            s2 += x1[j].x * x1[j].x + x1[j].y * x1[j].y + x1[j].z * x1[j].z + x1[j].w * x1[j].w; }
        const float rs2 = rsqrtf(wave_sum(s2) * (1.f / DM) + EPS);
#pragma unroll
        for (int j = 0; j < 4; ++j) { const int k = 4 * lane + 256 * j;
            const f32x4 gg = *(const f32x4*)(g_pre + k), sh = *(const f32x4*)(md + 3 * DM + k), sc = *(const f32x4*)(md + 4 * DM + k);
            const f32x4 hh = x1[j] * rs2 * gg * (sc + 1.f) + sh;
            u32x2 o; o.x = pk2(hh.x, hh.y); o.y = pk2(hh.z, hh.w); *(u32x2*)(H2 + (size_t)m * DM + k) = o; }
    }
}
__device__ __forceinline__ void p11_rows(const float* g_post, float* out, const float* mod, const bf16_t* Fb, int gw, int NGW, int lane) {
    for (int m = gw; m < MLAT; m += NGW) {
        const float* md = mod + (m >> 13) * NMOD;
        f32x4 y[4]; float ss = 0.f;
#pragma unroll
        for (int j = 0; j < 4; ++j) { const u32x2 w = *(const u32x2*)(Fb + (size_t)m * DM + 4 * lane + 256 * j);
            y[j] = (f32x4){bflo(w.x), bfhi(w.x), bflo(w.y), bfhi(w.y)}; ss += y[j].x * y[j].x + y[j].y * y[j].y + y[j].z * y[j].z + y[j].w * y[j].w; }
        const float rs = rsqrtf(wave_sum(ss) * (1.f / DM) + EPS);
#pragma unroll
        for (int j = 0; j < 4; ++j) { const int k = 4 * lane + 256 * j;
            const f32x4 xv = *(const f32x4*)(out + (size_t)m * DM + k), gg = *(const f32x4*)(g_post + k), gt = *(const f32x4*)(md + 5 * DM + k);
            *(f32x4*)(out + (size_t)m * DM + k) = xv + gt * (y[j] * rs * gg); }
    }
}
__device__ __forceinline__ void convgate_phase(const float* cw, const float* cb, const bf16_t* UP, bf16_t* G, int half, int gtid, int NT) {
    constexpr int JG = DFF / 8, RG = 16, NTASK = (MLAT / 2 / RG) * JG;
    for (int task = gtid; task < NTASK; task += NT) {
        const int jg = task % JG, rg = task / JG, j0 = jg * 8, r0 = rg * RG, m0 = half * (MLAT / 2) + r0;
        float wu[3][8], wg[3][8], bu[8], bg[8];
#pragma unroll
        for (int k = 0; k < 3; ++k)
#pragma unroll
            for (int i = 0; i < 8; ++i) { wu[k][i] = cw[k * 2 * DFF + j0 + i]; wg[k][i] = cw[k * 2 * DFF + DFF + j0 + i]; }
#pragma unroll
        for (int i = 0; i < 8; ++i) { bu[i] = cb[j0 + i]; bg[i] = cb[DFF + j0 + i]; }
        const bf16_t* up = UP + (size_t)r0 * (2 * DFF) + j0;
        u32x4 pu = {0u, 0u, 0u, 0u}, pg = {0u, 0u, 0u, 0u}, cu, cg_, nu, ng;
        if ((m0 & 8191) != 0) { pu = *(const u32x4*)(up - 2 * DFF); pg = *(const u32x4*)(up - 2 * DFF + DFF); }
        cu = *(const u32x4*)(up); cg_ = *(const u32x4*)(up + DFF);
#pragma unroll 4
        for (int r = 0; r < RG; ++r) {
            const bool nv = (r + 1 < RG) || (((m0 + RG) & 8191) != 0);
            if (nv) { nu = *(const u32x4*)(up + (size_t)(r + 1) * (2 * DFF)); ng = *(const u32x4*)(up + (size_t)(r + 1) * (2 * DFF) + DFF); } else { nu = (u32x4){0u, 0u, 0u, 0u}; ng = nu; }
            float o[8];
#pragma unroll
            for (int i = 0; i < 8; ++i) { const int w_ = i >> 1;
                const float p_u = (i & 1) ? bfhi(pu[w_]) : bflo(pu[w_]), c_u = (i & 1) ? bfhi(cu[w_]) : bflo(cu[w_]), n_u = (i & 1) ? bfhi(nu[w_]) : bflo(nu[w_]);
                const float p_g = (i & 1) ? bfhi(pg[w_]) : bflo(pg[w_]), c_g = (i & 1) ? bfhi(cg_[w_]) : bflo(cg_[w_]), n_g = (i & 1) ? bfhi(ng[w_]) : bflo(ng[w_]);
                const float uv = bu[i] + wu[0][i] * p_u + wu[1][i] * c_u + wu[2][i] * n_u, gv = bg[i] + wg[0][i] * p_g + wg[1][i] * c_g + wg[2][i] * n_g;
                o[i] = gv / (1.f + __expf(-gv)) * uv; }
            u32x4 w; w.x = pk2(o[0], o[1]); w.y = pk2(o[2], o[3]); w.z = pk2(o[4], o[5]); w.w = pk2(o[6], o[7]);
            *(u32x4*)(G + (size_t)(r0 + r) * DFF + j0) = w;
            pu = cu; pg = cg_; cu = nu; cg_ = ng;
        }
    }
}
constexpr int NPH = 17;
__global__ void __launch_bounds__(512, 2) fwd_kernel(Args a) {
    extern __shared__ __attribute__((aligned(16))) unsigned char lds_raw[];
    LAS unsigned char* lds = (LAS unsigned char*)lds_raw;
    const int lo = a.ph_lo, hi_ = a.ph_hi;
#if MK_COOP
    cg::grid_group grid = cg::this_grid();
#endif
    typedef pg8::EpiBf16<0> EpiB;
    constexpr int MH = MLAT / 2;
#ifndef REPMASK
#define REPMASK 0
#endif
    bool repeated = false;
#pragma unroll 1
    for (int ph = lo; ph < hi_; ++ph) {
        int tid = threadIdx.x; asm volatile("" : "+v"(tid));
        int G = gridDim.x, bx = blockIdx.x; asm volatile("" : "+s"(G), "+s"(bx));
        const int lane = tid & 63, wave = __builtin_amdgcn_readfirstlane(tid >> 6);
        const int vcu = (G % 8 == 0) ? (bx % 8) * (G / 8) + bx / 8 : bx;
        const int gw = vcu * 8 + wave, NGW = G * 8, gtid = bx * 512 + tid, NTH = G * 512;
        unsigned char* ws = a.ws; asm volatile("" : "+s"(ws));
        float* mod = (float*)(ws + WS_MOD); float* ssq = (float*)(ws + WS_SSQ); float* sskv = (float*)(ws + WS_SSKV);
        bf16_t* Win = (bf16_t*)(ws + WS_WIN); bf16_t* Wq = (bf16_t*)(ws + WS_WQ); bf16_t* Wkv = (bf16_t*)(ws + WS_WKV); bf16_t* Wg = (bf16_t*)(ws + WS_WG);
        bf16_t* Wout = (bf16_t*)(ws + WS_WOUT); bf16_t* Wup = (bf16_t*)(ws + WS_WUP); bf16_t* Wdn = (bf16_t*)(ws + WS_WDN);
        float2* AGG = (float2*)(ws + WS_AGG); float* RT = (float*)(ws + WS_ROPE);
        bf16_t* H = (bf16_t*)(ws + WS_R1); bf16_t* KVR = H; bf16_t* H2 = H; bf16_t* Qb = (bf16_t*)(ws + WS_Q);
        bf16_t* P = (bf16_t*)(ws + WS_R2); bf16_t* Y = P; bf16_t* Fb = P;
        unsigned* LU = (unsigned*)(ws + WS_LU); bf16_t* Kb = (bf16_t*)(ws + WS_K); bf16_t* Vb = (bf16_t*)(ws + WS_V); bf16_t* A2 = (bf16_t*)(ws + WS_A2); bf16_t* QR = A2;
        bf16_t* UP = (bf16_t*)(ws + WS_UP); bf16_t* Gb = (bf16_t*)(ws + WS_G);
        float* outp = a.out; asm volatile("" : "+s"(outp));
        pg8::Gemm g{nullptr, nullptr, 0, 0, 0, 0, 0}; bf16_t* O = nullptr; int ldc = 0;
        switch (ph) {
            case 2:  g = pg8::Gemm{H, Win, MALL, PW, DM, DM, DM}; O = P; ldc = PW; break;
            case 4:  g = pg8::Gemm{P + 1024, Wq, MLAT, 768, 256, PW, 256}; O = QR; ldc = 768; break;
            case 5:  g = pg8::Gemm{P + 1280, Wkv, MALL, 1024, 256, PW, 256}; O = KVR; ldc = 1024; break;
            case 8:  g = pg8::Gemm{A2, Wout, MLAT, DM, DM, DM, DM}; O = Y; ldc = DM; break;
            case 10: g = pg8::Gemm{H2, Wup, MH, 2 * DFF, DM, DM, DM}; O = UP; ldc = 2 * DFF; break;
            case 13: g = pg8::Gemm{H2 + (size_t)MH * DM, Wup, MH, 2 * DFF, DM, DM, DM}; O = UP; ldc = 2 * DFF; break;
            case 12: g = pg8::Gemm{Gb, Wdn, MH, DM, DFF, DFF, DFF}; O = Fb; ldc = DM; break;
            case 15: g = pg8::Gemm{Gb, Wdn, MH, DM, DFF, DFF, DFF}; O = Fb + (size_t)MH * DM; ldc = DM; break;
            default: break;
        }
        if (g.A != nullptr) {
            pg8::StaticOrder S; S.init(g.M, g.N, G, bx); EpiB E{O, ldc, nullptr, 0, 0, 1.f};
            pg8::gemm_phase<EpiB, pg8::StaticOrder, true, true>(lds, g, S, E, tid);
        }
#ifndef NGM
#define NGM 0x1ffff
#endif
#define NG(k) ((NGM >> (k)) & 1)
        else if (NG(0) && ph == 0) {
            prep_mat<0>(argp(10), nullptr, Win, 1536, 1024, gtid, NTH); prep_mat<1>(argp(18), argp(19), Wq, 768, 256, gtid, NTH); prep_mat<2>(argp(20), argp(21), Wkv, 1024, 256, gtid, NTH);
            prep_mat<3>(argp(13), argp(15), Wg, 2048, 64, gtid, NTH); prep_mat<4>(argp(22), nullptr, Wout, 1024, 1024, gtid, NTH); prep_mat<5>(argp(23), nullptr, Wup, 5632, 1024, gtid, NTH);
            prep_mat<6>(argp(26), nullptr, Wdn, 1024, 2816, gtid, NTH);
            if (gtid < 1024) { const int pos = gtid >> 3, j = gtid & 7; const float invf[8] = {1.f, 0.31622776601683794f, 0.1f, 0.031622776601683794f, 0.01f, 0.0031622776601683794f, 0.001f, 0.00031622776601683794f};
                const float ang = (float)pos * invf[j]; RT[2 * gtid] = cosf(ang); RT[2 * gtid + 1] = sinf(ang); }
            mod_phase(argp(1), argp(3), argp(4), argp(5), mod, (LAS float*)(lds + wave * 4096), gw, NGW, lane);
        } else if (NG(1) && ph == 1) {
            p1_rows(argp(0), argp(2), argp(6), mod, H, gw, NGW, lane);
        } else if (NG(3) && ph == 3) {
            gates_phase(argp(11), argp(12), argp(14), argp(16), argp(17), lds, P, Wg, LU, wave, lane);
            ss_phase(P, ssq, sskv, gw, NGW, lane);
        } else if (NG(6) && ph == 6) {
            scan_agg(LU, AGG, gw, NGW, lane); krope_phase(P, Kb, RT, gtid, NTH); qpost_phase(QR, ssq, RT, Qb, gtid, NTH); kvpost_phase(KVR, sskv, Kb, Vb, gtid, NTH);
        } else if (NG(7) && ph == 7) {
            scan_final(LU, AGG, P, A2, gw, NGW, lane);
            const int upb = (NB * 8 * 16 + G - 1) / G, u0 = vcu * upb, u1 = min(NB * 8 * 16, u0 + upb);
            __syncthreads();
            for (int unit = u0; unit < u1; ++unit) { const int bh = unit >> 4, qb = unit & 15; attn_unit(lds, Qb, Kb, Vb, A2, bh >> 3, bh & 7, qb, tid, wave, lane); }
        } else if (NG(9) && ph == 9) {
            p7_rows(argp(0), argp(7), argp(8), outp, mod, Y, H2, gw, NGW, lane);
        } else if (NG(11) && (ph == 11 || ph == 14)) {
            convgate_phase(argp(24), argp(25), UP, Gb, ph == 14 ? 1 : 0, gtid, NTH);
        } else if (NG(16) && ph == 16) {
            p11_rows(argp(9), outp, mod, Fb, gw, NGW, lane);
        }
        __syncthreads();
#if MK_COOP
        if (ph + 1 < hi_ && ph != 3 && ph != 4) grid.sync();
#endif
        if (REPMASK) { if (((REPMASK >> ph) & 1) && !repeated) { repeated = true; --ph; } else repeated = false; }
    }
}

extern "C" void kernel_launch(void* const* d_in, const int* in_sizes, int n_in, void* d_out, int out_size, void* d_ws, size_t ws_size, hipStream_t stream) {
    static int grid = 0;
    if (grid == 0) {
        if (n_in != 27 || out_size != MLAT * DM || ws_size < WS_END) { fprintf(stderr, "kernel_launch: unexpected shapes (n_in %d, out %d, ws %zu)\n", n_in, out_size, ws_size); grid = -1; return; }
        int dev = 0, cus = 0, per_cu = 0;
        if (hipGetDevice(&dev) != hipSuccess || hipDeviceGetAttribute(&cus, hipDeviceAttributeMultiprocessorCount, dev) != hipSuccess) { grid = -1; return; }
        if (hipFuncSetAttribute((const void*)fwd_kernel, hipFuncAttributeMaxDynamicSharedMemorySize, LDS_BYTES) != hipSuccess) { fprintf(stderr, "kernel_launch: hipFuncSetAttribute failed\n"); grid = -1; return; }
        if (hipOccupancyMaxActiveBlocksPerMultiprocessor(&per_cu, (const void*)fwd_kernel, 512, LDS_BYTES) != hipSuccess || per_cu < 1) { fprintf(stderr, "kernel_launch: occupancy query says %d\n", per_cu); }
        (void)hipGetLastError();
        grid = cus;
    }
    if (grid < 0) return;
    (void)hipMemsetAsync((char*)d_ws + WS_CTL, 0, CTL_BYTES, stream);
    Args a{};
    for (int i = 0; i < 27; ++i) a.in[i] = (const float*)d_in[i];
    a.out = (float*)d_out; a.ws = (unsigned char*)d_ws;
#if MK_COOP
    a.ph_lo = 0; a.ph_hi = NPH;
    void* args[] = {&a};
    hipError_t e = hipLaunchCooperativeKernel((const void*)fwd_kernel, dim3(grid), dim3(512), args, LDS_BYTES, stream);
    if (e != hipSuccess) fprintf(stderr, "kernel_launch: cooperative launch failed: %s (grid %d)\n", hipGetErrorString(e), grid);
#else
    for (int p = 0; p < NPH; ++p) { a.ph_lo = p; a.ph_hi = p + 1; hipLaunchKernelGGL(fwd_kernel, dim3(grid), dim3(512), LDS_BYTES, stream, a); }
#endif
}
```

```cpp
#include <hip/hip_runtime.h>
#include <hip/hip_cooperative_groups.h>
#include <cstdio>
#include <cstdint>
namespace cg = cooperative_groups;
#ifndef MK_COOP
#define MK_COOP 1
#endif
namespace pg8 {
#define PG8_LAS __attribute__((address_space(3)))
typedef unsigned short bf16_t;
typedef short bf16x8 __attribute__((ext_vector_type(8)));
typedef float f32x4 __attribute__((ext_vector_type(4)));
typedef unsigned u32x4 __attribute__((ext_vector_type(4)));
constexpr int BM = 256, BK = 64, HALF = 128, HTB = HALF * BK * 2  , STAGE_BYTES = 8 * HTB, NXCD = 8, WGM = 8;

__host__ __device__ __forceinline__ int lds_byte(int r, int c) { const int st = (r >> 4) * 2 + (c >> 5), rr = r & 15, cc = c & 31, ob = rr * 64 + cc * 2; return st * 1024 + (ob ^ (((ob >> 9) & 1) << 5)); }
__host__ __device__ __forceinline__ void stage_rc(int b, int& R, int& C) { const int st = b / 1024, sb = b % 1024, swz = sb ^ (((sb >> 9) & 1) << 5); R = (st >> 1) * 16 + swz / 64; C = (st & 1) * 32 + (swz % 64) / 2; }
__host__ __device__ __forceinline__ int perm32(int rho) { const int n = rho >> 4, i = rho & 15; return 8 * (i >> 2) + 4 * n + (i & 3); }

struct Unit { int pm, pn; };
struct Gemm { const bf16_t* A; const bf16_t* Bt; int M, N, K, lda, ldb; };

struct StaticOrder {
    int nM, nN, nwg, G, c;
    __host__ __device__ void init(int M, int N, int G_, int c_) { nM = M / BM; nN = N / BM; nwg = nM * nN; G = G_; c = c_; }
    __host__ __device__ bool next(int i, Unit& u) const {
        const long L = (long)i * G + c; if (L >= nwg) return false;
        int wgid = (int)L; { const int q = nwg / NXCD, r = nwg % NXCD, xcd = wgid % NXCD, off = wgid / NXCD; wgid = (xcd < r ? xcd * (q + 1) : r * (q + 1) + (xcd - r) * q) + off; }
        const int nig = WGM * nN, gid = wgid / nig, fm = gid * WGM, gsz = (nM - fm) < WGM ? (nM - fm) : WGM;
        u.pm = fm + ((wgid % nig) % gsz); u.pn = (wgid % nig) / gsz; return true;
    }
    __device__ __forceinline__ void a_ready(const Unit&) const {}
    __device__ __forceinline__ void done(const Unit&) const {}
};

__device__ __forceinline__ unsigned cvt_pk_bf16(float lo, float hi) { unsigned r; asm volatile("v_cvt_pk_bf16_f32 %0, %1, %2" : "=v"(r) : "v"(lo), "v"(hi)); return r; }
typedef float f32x2 __attribute__((ext_vector_type(2)));
__device__ __forceinline__ f32x2 gelu_pk(f32x2 v) {
    const f32x2 av = __builtin_elementwise_abs(v), d = av * 0.2316418882f + 1.0f;
    f32x2 t; t.x = __builtin_amdgcn_rcpf(d.x); t.y = __builtin_amdgcn_rcpf(d.y);
    f32x2 q = t * 0.5307027145f + (-0.7265760135f); q = q * t + 0.7107068705f; q = q * t + (-0.142248368f); q = q * t + 0.127414796f; q = q * t;
    const f32x2 s = (v * v) * (-0.72134752044f);
    f32x2 e; e.x = __builtin_amdgcn_exp2f(s.x); e.y = __builtin_amdgcn_exp2f(s.y);
    const f32x2 m = v * (q * e), r = v - m;
    f32x2 o; o.x = v.x < 0.f ? m.x : r.x; o.y = v.y < 0.f ? m.y : r.y; return o;
}

template <int ACT  > struct EpiBf16 {
    static constexpr bool PERM = true, AFTER_DRAIN = false; static_assert(ACT == 0 || ACT == 1, "EpiBf16: ACT is 0 (none) or 1 (gelu_pk)");
    bf16_t* O; int ldc; const float* bias; int split_cols; size_t split_stride; float scale0;
    __device__ __forceinline__ void operator()(const f32x4 (&acc)[2][2][4][2], const Unit& u, int wr, int wc, int fr, int fq) const {
        const int row0 = u.pm * BM + wr * 64 + fr; int colt = u.pn * BM; bf16_t* base = O;
        float sc = 1.f; if (split_cols) { const int t = colt / split_cols; base += (size_t)t * split_stride; colt -= t * split_cols; if (t == 0) sc = scale0; }
        const int col0 = colt + wc * 32 + 8 * fq, bcol0 = u.pn * BM + wc * 32 + 8 * fq;
        f32x4 bv[2][2];
#pragma unroll
        for (int bj = 0; bj < 2; ++bj)
#pragma unroll
            for (int n = 0; n < 2; ++n) bv[bj][n] = bias ? *(const f32x4*)(bias + bcol0 + bj * HALF + 4 * n) : (f32x4){0.f, 0.f, 0.f, 0.f};
#pragma unroll
        for (int ai = 0; ai < 2; ++ai)
#pragma unroll
            for (int m = 0; m < 4; ++m) { bf16_t* rowp = base + (size_t)(row0 + ai * HALF + m * 16) * ldc + col0;
#pragma unroll
                for (int bj = 0; bj < 2; ++bj) { f32x4 v0 = acc[ai][bj][m][0] + bv[bj][0], v1 = acc[ai][bj][m][1] + bv[bj][1];
                    if (ACT == 1) { f32x2 a = gelu_pk((f32x2){v0[0], v0[1]}), b = gelu_pk((f32x2){v0[2], v0[3]}), c = gelu_pk((f32x2){v1[0], v1[1]}), d = gelu_pk((f32x2){v1[2], v1[3]});
                        v0 = (f32x4){a.x, a.y, b.x, b.y}; v1 = (f32x4){c.x, c.y, d.x, d.y}; }
                    v0 = v0 * sc; v1 = v1 * sc; u32x4 w; w.x = cvt_pk_bf16(v0[0], v0[1]); w.y = cvt_pk_bf16(v0[2], v0[3]); w.z = cvt_pk_bf16(v1[0], v1[1]); w.w = cvt_pk_bf16(v1[2], v1[3]);
                    *(__attribute__((address_space(1))) u32x4*)(rowp + bj * HALF) = w; } }
    }
};
template <class Epi, class Sched, bool ALIGN_EPI = false, bool SP2 = false>
__device__ __forceinline__ void gemm_phase(PG8_LAS unsigned char* lds, const Gemm g, const Sched& S, const Epi& E, const int tid) {
    const int wid = __builtin_amdgcn_readfirstlane(tid >> 6), lane = tid & 63, wr = wid >> 2, wc = wid & 3, fr = lane & 15, fq = lane >> 4;
    const int K = g.K, nt = K / BK;
    unsigned voffA[2], voffB[2];
#pragma unroll
    for (int i = 0; i < 2; ++i) { int R, C; stage_rc(tid * 16 + i * 8192, R, C); const int Rb = Epi::PERM ? ((R & ~31) + perm32(R & 31)) : R;
        voffA[i] = (unsigned)(R * g.lda + C) * 2u; voffB[i] = (unsigned)(Rb * g.ldb + C) * 2u; }
    const size_t kstep = (size_t)(BK * 2);
    const size_t hstepA = (size_t)HALF * g.lda * 2, hstepB = (size_t)HALF * g.ldb * 2;
    const size_t tstepA = 2 * hstepA, tstepB = 2 * hstepB;
    const unsigned ldsw = (unsigned)wid * 1024u;
    const int aoff = lds_byte(wr * 64 + fr, fq * 8), boff = lds_byte(wc * 32 + fr, fq * 8);
#define PG8_SA(b, h) (((b) * 2 + (h)) * HTB)
#define PG8_SB(b, h) ((4 + (b) * 2 + (h)) * HTB)
#define PG8_STAGE(bufoff, gbase, voff) do { _Pragma("unroll") for (int _i = 0; _i < 2; ++_i) \
        __builtin_amdgcn_global_load_lds((const unsigned*)((const char*)(gbase) + (voff)[_i]), (PG8_LAS unsigned*)(lds + (bufoff) + ldsw + _i * 8192), 16, 0, 0); } while (0)
#define PG8_LDA(dst, b, h) do { _Pragma("unroll") for (int m = 0; m < 4; ++m) _Pragma("unroll") for (int k = 0; k < 2; ++k) dst[m][k] = *(const PG8_LAS bf16x8*)(lds + PG8_SA(b, h) + aoff + m * 2048 + k * 1024); } while (0)
#define PG8_LDB(dst, b, h) do { _Pragma("unroll") for (int n = 0; n < 2; ++n) _Pragma("unroll") for (int k = 0; k < 2; ++k) dst[n][k] = *(const PG8_LAS bf16x8*)(lds + PG8_SB(b, h) + boff + n * 2048 + k * 1024); } while (0)
#define PG8_MMA(ai, bj, At, Bt) do { __builtin_amdgcn_s_setprio(1); _Pragma("unroll") for (int m = 0; m < 4; ++m) _Pragma("unroll") for (int n = 0; n < 2; ++n) _Pragma("unroll") for (int k = 0; k < 2; ++k) \
        acc[ai][bj][m][n] = __builtin_amdgcn_mfma_f32_16x16x32_bf16(Bt[n][k], At[m][k], acc[ai][bj][m][n], 0, 0, 0); __builtin_amdgcn_s_setprio(0); } while (0)
#define PG8_WAIT_V(n) asm volatile("s_waitcnt vmcnt(" #n ")" ::: "memory")
#define PG8_WAIT_L(n) asm volatile("s_waitcnt lgkmcnt(" #n ")" ::: "memory")
#define PG8_BAR __builtin_amdgcn_s_barrier()
#define PG8_SCHED __builtin_amdgcn_sched_barrier(0)
    Unit cur, nxt; int ui = 0;
    if (!S.next(0, cur)) return;
    f32x4 acc[2][2][4][2];
#pragma unroll
    for (int a = 0; a < 2; ++a)
#pragma unroll
        for (int b = 0; b < 2; ++b)
#pragma unroll
            for (int m = 0; m < 4; ++m)
#pragma unroll
                for (int n = 0; n < 2; ++n) acc[a][b][m][n] = (f32x4){0.f, 0.f, 0.f, 0.f};
    bf16x8 At[4][2], B0[2][2], B1[2][2];
    const char* cA = (const char*)g.A + (size_t)cur.pm * tstepA; const char* cB = (const char*)g.Bt + (size_t)cur.pn * tstepB;
    S.a_ready(cur);
    if constexpr (SP2) {
        PG8_STAGE(PG8_SB(0, 0), cB, voffB); PG8_STAGE(PG8_SB(0, 1), cB + hstepB, voffB); PG8_STAGE(PG8_SA(0, 0), cA, voffA); PG8_STAGE(PG8_SA(0, 1), cA + hstepA, voffA);
        if (wr == 1) PG8_BAR;
        PG8_WAIT_V(2); PG8_BAR;
        PG8_STAGE(PG8_SB(1, 0), cB + kstep, voffB); PG8_STAGE(PG8_SA(1, 0), cA + kstep, voffA); PG8_STAGE(PG8_SB(1, 1), cB + hstepB + kstep, voffB);
        PG8_WAIT_V(6); PG8_BAR;
    } else {
        PG8_STAGE(PG8_SB(0, 0), cB, voffB); PG8_STAGE(PG8_SA(0, 0), cA, voffA); PG8_STAGE(PG8_SB(0, 1), cB + hstepB, voffB); PG8_STAGE(PG8_SA(0, 1), cA + hstepA, voffA);
        if (wr == 1) PG8_BAR;
        PG8_WAIT_V(4); PG8_BAR;
        PG8_STAGE(PG8_SB(1, 0), cB + kstep, voffB); PG8_STAGE(PG8_SA(1, 0), cA + kstep, voffA); PG8_STAGE(PG8_SB(1, 1), cB + hstepB + kstep, voffB);
        PG8_WAIT_V(6); PG8_BAR;
    }
    for (;;) {
        const bool has_next = S.next(ui + 1, nxt);
        const char* nA = has_next ? (const char*)g.A + (size_t)nxt.pm * tstepA : cA; const char* nB = has_next ? (const char*)g.Bt + (size_t)nxt.pn * tstepB : cB;
        for (int t = 0; t < nt; t += 2) {
            const bool last = (t == nt - 2);
            const char* a1 = cA + (size_t)(t + 1) * kstep;
            const char* a2 = last ? nA : cA + (size_t)(t + 2) * kstep; const char* b2 = last ? nB : cB + (size_t)(t + 2) * kstep;
            const char* a3 = a2 + kstep; const char* b3 = b2 + kstep;
            if (last && has_next) S.a_ready(nxt);
            if constexpr (SP2) {
            PG8_LDB(B0, 0, 0); PG8_LDB(B1, 0, 1); PG8_SCHED; PG8_LDA(At, 0, 0); PG8_STAGE(PG8_SA(1, 1), a1 + hstepA, voffA);
            PG8_WAIT_V(8); PG8_WAIT_L(0); PG8_BAR; PG8_MMA(0, 0, At, B0); PG8_MMA(0, 1, At, B1); PG8_BAR; PG8_SCHED;
            PG8_LDA(At, 0, 1); PG8_STAGE(PG8_SB(0, 0), b2, voffB); PG8_STAGE(PG8_SB(0, 1), b2 + hstepB, voffB); PG8_STAGE(PG8_SA(0, 0), a2, voffA);
            PG8_WAIT_V(8); PG8_WAIT_L(0); PG8_BAR; PG8_MMA(1, 0, At, B0); PG8_MMA(1, 1, At, B1); PG8_BAR; PG8_SCHED;
            PG8_LDB(B0, 1, 0); PG8_LDB(B1, 1, 1); PG8_SCHED; PG8_LDA(At, 1, 0); PG8_STAGE(PG8_SA(0, 1), a2 + hstepA, voffA);
            PG8_WAIT_V(8); PG8_WAIT_L(0); PG8_BAR; PG8_MMA(0, 0, At, B0); PG8_MMA(0, 1, At, B1); PG8_BAR; PG8_SCHED;
            PG8_LDA(At, 1, 1); PG8_STAGE(PG8_SB(1, 0), b3, voffB); PG8_STAGE(PG8_SB(1, 1), b3 + hstepB, voffB); PG8_STAGE(PG8_SA(1, 0), a3, voffA);
            PG8_WAIT_V(8); PG8_WAIT_L(0); PG8_BAR; PG8_MMA(1, 0, At, B0); PG8_MMA(1, 1, At, B1); PG8_BAR; PG8_SCHED;
            } else {
            PG8_LDB(B0, 0, 0); PG8_SCHED; PG8_LDA(At, 0, 0); PG8_STAGE(PG8_SA(1, 1), a1 + hstepA, voffA);
            PG8_WAIT_L(8); PG8_BAR; PG8_WAIT_L(0); PG8_MMA(0, 0, At, B0); PG8_BAR; PG8_SCHED;
            PG8_LDB(B1, 0, 1); PG8_STAGE(PG8_SB(0, 0), b2, voffB);
            PG8_BAR; PG8_WAIT_L(0); PG8_MMA(0, 1, At, B1); PG8_BAR;
            PG8_LDA(At, 0, 1); PG8_STAGE(PG8_SA(0, 0), a2, voffA);
            PG8_BAR; PG8_WAIT_L(0); PG8_MMA(1, 0, At, B0); PG8_BAR; PG8_SCHED;
            PG8_STAGE(PG8_SB(0, 1), b2 + hstepB, voffB);
            PG8_WAIT_V(6); PG8_BAR; PG8_MMA(1, 1, At, B1); PG8_BAR;
            PG8_LDB(B0, 1, 0); PG8_SCHED; PG8_LDA(At, 1, 0); PG8_STAGE(PG8_SA(0, 1), a2 + hstepA, voffA);
            PG8_WAIT_L(8); PG8_BAR; PG8_WAIT_L(0); PG8_MMA(0, 0, At, B0); PG8_BAR; PG8_SCHED;
            PG8_LDB(B1, 1, 1); PG8_STAGE(PG8_SB(1, 0), b3, voffB);
            PG8_BAR; PG8_WAIT_L(0); PG8_MMA(0, 1, At, B1); PG8_BAR;
            PG8_LDA(At, 1, 1); PG8_STAGE(PG8_SA(1, 0), a3, voffA);
            PG8_BAR; PG8_WAIT_L(0); PG8_MMA(1, 0, At, B0); PG8_BAR; PG8_SCHED;
            PG8_STAGE(PG8_SB(1, 1), b3 + hstepB, voffB);
            PG8_WAIT_V(6); PG8_BAR; PG8_MMA(1, 1, At, B1); PG8_BAR;
            }
        }
        if constexpr (ALIGN_EPI) { if (wr == 0) PG8_BAR; }
        if constexpr (!Epi::AFTER_DRAIN) { E(acc, cur, wr, wc, fr, fq); S.done(cur); }
        if (!has_next) break;
#pragma unroll
        for (int a = 0; a < 2; ++a)
#pragma unroll
            for (int b = 0; b < 2; ++b)
#pragma unroll
                for (int m = 0; m < 4; ++m)
#pragma unroll
                    for (int n = 0; n < 2; ++n) acc[a][b][m][n] = (f32x4){0.f, 0.f, 0.f, 0.f};
        cur = nxt; cA = nA; cB = nB; ++ui;
        if constexpr (ALIGN_EPI) { if (wr == 1) PG8_BAR; }
    }
    PG8_WAIT_V(0);
    if constexpr (!ALIGN_EPI) { if (wr == 0) PG8_BAR; }
    PG8_BAR;
    if constexpr (Epi::AFTER_DRAIN) { E.fused(acc, cur, wr, wc, fr, fq, lds, wid, lane); S.done(cur); }
#undef PG8_SA
#undef PG8_SB
#undef PG8_STAGE
#undef PG8_LDA
#undef PG8_LDB
#undef PG8_MMA
#undef PG8_WAIT_V
#undef PG8_WAIT_L
#undef PG8_BAR
#undef PG8_SCHED
}
}
#define LAS __attribute__((address_space(3)))
#define GAS __attribute__((address_space(1)))
typedef unsigned short bf16_t;
typedef short bf16x8 __attribute__((ext_vector_type(8)));
typedef short s16x4 __attribute__((ext_vector_type(4)));
typedef float f32x4 __attribute__((ext_vector_type(4)));
typedef float f32x16 __attribute__((ext_vector_type(16)));
typedef unsigned u32x4 __attribute__((ext_vector_type(4)));
typedef unsigned u32x2 __attribute__((ext_vector_type(2)));
typedef float f32x2 __attribute__((ext_vector_type(2)));

constexpr int NB = 8, SEQ = 8192, DM = 1024, CTX = 256, MLAT = NB * SEQ, MCTX = NB * CTX, MALL = MLAT + MCTX;
constexpr int PW = 1536, KVLEN = CTX + SEQ, DFF = 2816, NMOD = 6 * DM;
constexpr int NCH = 32, CHL = 256;
constexpr float EPS = 1e-6f;
constexpr float QSCALE = 0.10206207261596575f * 1.4426950408889634f;
constexpr size_t MiB = 1u << 20;
constexpr size_t WS_CTL = 0, CTL_BYTES = 2 * MiB;
constexpr size_t WS_MOD = 64 * 1024, WS_SSQ = 512 * 1024, WS_SSKV = 1024 * 1024;
constexpr size_t WS_WIN = 2 * MiB, WS_WQ = 5 * MiB, WS_WKV = 6 * MiB, WS_WG = 7 * MiB, WS_WOUT = 8 * MiB, WS_WUP = 10 * MiB, WS_WDN = 21 * MiB;
constexpr size_t WS_AGG = 27 * MiB, WS_ROPE = 29 * MiB + 512 * 1024;
constexpr size_t WS_R1 = 30 * MiB;
constexpr size_t WS_R2 = 162 * MiB;
constexpr size_t WS_LU = 360 * MiB, WS_K = 624 * MiB, WS_V = 723 * MiB, WS_A2 = 789 * MiB;
constexpr size_t WS_UP = 360 * MiB, WS_G = 712 * MiB, WS_Q = 920 * MiB, WS_END = 1016 * MiB;
constexpr int LDS_BYTES = 139264;

__device__ __forceinline__ unsigned f2bf(float f) { unsigned u = __builtin_bit_cast(unsigned, f); return (u + 0x7fffu + ((u >> 16) & 1u)) >> 16; }
__device__ __forceinline__ unsigned pk2(float lo, float hi) { return f2bf(lo) | (f2bf(hi) << 16); }
__device__ __forceinline__ float bflo(unsigned w) { return __uint_as_float(w << 16); }
__device__ __forceinline__ float bfhi(unsigned w) { return __uint_as_float(w & 0xffff0000u); }
__device__ __forceinline__ float bf2f(bf16_t v) { return __uint_as_float((unsigned)v << 16); }
__device__ __forceinline__ int crow(int r, int hi) { return (r & 3) + 8 * (r >> 2) + 4 * hi; }
__device__ __forceinline__ float wave_sum(float v) {
#pragma unroll
    for (int o = 1; o < 64; o <<= 1) v += __shfl_xor(v, o);
    return v;
}
__device__ __forceinline__ float sigmoidf_(float x) { return __builtin_amdgcn_rcpf(1.f + __builtin_amdgcn_exp2f(-1.4426950408889634f * x)); }
#define LDS_WAIT() asm volatile("s_waitcnt lgkmcnt(0)" ::: "memory")

struct Args { const float* in[27]; float* out; unsigned char* ws; int ph_lo, ph_hi; };
__device__ __forceinline__ const GAS float* argp(int i) {
    const __attribute__((address_space(4))) char* kp = (const __attribute__((address_space(4))) char*)__builtin_amdgcn_kernarg_segment_ptr();
    asm volatile("" : "+s"(kp));
    const float* p = *(const float* const __attribute__((address_space(4)))*)(kp + 8 * i);
    return (const GAS float*)p;
}

template <int ID> __device__ __forceinline__ float wsrc(const GAS float* p0, const GAS float* p1, int n, int k) {
    if (ID == 0) return n < 1440 ? p0[(size_t)k * 1440 + n] : 0.f;
    if (ID == 1) return p0[k] * p1[(size_t)k * 768 + n];
    if (ID == 2) return k < 128 ? p0[k] * p1[(size_t)k * 1024 + n] : 0.f;
    if (ID == 3) { const int h = n >> 8, np = n & 255, mat = np >> 6, j = np & 63, dir = mat >> 1; const GAS float* w = (mat & 1) ? p1 : p0; return w[(size_t)((dir * 8 + h) * 64 + k) * 64 + j]; }
    if (ID == 4) return p0[(size_t)k * 1024 + n];
    if (ID == 5) return p0[(size_t)k * 5632 + n];
    return p0[(size_t)k * 1024 + n];
}
template <int ID> __device__ __forceinline__ void prep_mat(const GAS float* p0, const GAS float* p1, GAS bf16_t* dst, int N, int K, int gtid, int NT) {
    const int items = N * (K / 8);
    for (int it = gtid; it < items; it += NT) {
        const int n = it % N, k8 = it / N;
        u32x4 o;
        o.x = pk2(wsrc<ID>(p0, p1, n, 8 * k8 + 0), wsrc<ID>(p0, p1, n, 8 * k8 + 1)); o.y = pk2(wsrc<ID>(p0, p1, n, 8 * k8 + 2), wsrc<ID>(p0, p1, n, 8 * k8 + 3));
        o.z = pk2(wsrc<ID>(p0, p1, n, 8 * k8 + 4), wsrc<ID>(p0, p1, n, 8 * k8 + 5)); o.w = pk2(wsrc<ID>(p0, p1, n, 8 * k8 + 6), wsrc<ID>(p0, p1, n, 8 * k8 + 7));
        *(GAS u32x4*)(dst + (size_t)n * K + 8 * k8) = o;
    }
}
__device__ __forceinline__ void mod_phase(const GAS float* cvec, const GAS float* cctx, const GAS float* wmod, const GAS float* bmod, GAS float* mod, LAS float* scr, int gw, int NGW, int lane) {
    for (int task = gw; task < 96 * 16; task += NGW) {
        const int cgp = task % 96, kc = task / 96, n = cgp * 64 + lane, k0 = kc * 64;
#pragma unroll
        for (int r = 0; r < 9; ++r) { const float cv = r < 8 ? cvec[r * 1024 + k0 + lane] : cctx[k0 + lane]; scr[r * 64 + lane] = cv / (1.f + __expf(-cv)); }
        LDS_WAIT();
        float acc[9];
#pragma unroll
        for (int r = 0; r < 9; ++r) acc[r] = 0.f;
#pragma unroll 8
        for (int kk = 0; kk < 64; ++kk) { const float w = wmod[(size_t)(k0 + kk) * NMOD + n];
#pragma unroll
            for (int r = 0; r < 9; ++r) acc[r] += scr[r * 64 + kk] * w; }
        const float bias = kc == 0 ? bmod[n] : 0.f;
#pragma unroll
        for (int r = 0; r < 9; ++r) atomicAdd((float*)(mod + r * NMOD + n), acc[r] + bias);
        LDS_WAIT();
    }
}
__device__ __forceinline__ void p1_rows(const GAS float* x, const GAS float* ctx, const GAS float* g, const GAS float* mod, GAS bf16_t* H, int gw, int NGW, int lane) {
    for (int m0 = 2 * gw; m0 < MALL; m0 += 2 * NGW) {
        f32x4 v[2][4]; float ss[2];
#pragma unroll
        for (int r = 0; r < 2; ++r) { const int m = m0 + r; const GAS float* src = m < MLAT ? x + (size_t)m * DM : ctx + (size_t)(m - MLAT) * DM; ss[r] = 0.f;
#pragma unroll
            for (int j = 0; j < 4; ++j) { v[r][j] = *(const GAS f32x4*)(src + 4 * lane + 256 * j); ss[r] += v[r][j].x * v[r][j].x + v[r][j].y * v[r][j].y + v[r][j].z * v[r][j].z + v[r][j].w * v[r][j].w; } }
#pragma unroll
        for (int r = 0; r < 2; ++r) { const int m = m0 + r; const GAS float* md = mod + (m < MLAT ? (m >> 13) : 8) * NMOD;
            const float rs = rsqrtf(wave_sum(ss[r]) * (1.f / DM) + EPS);
#pragma unroll
            for (int j = 0; j < 4; ++j) { const int k = 4 * lane + 256 * j;
                const f32x4 gg = *(const GAS f32x4*)(g + k), sh = *(const GAS f32x4*)(md + k), sc = *(const GAS f32x4*)(md + DM + k);
                const f32x4 y = v[r][j] * rs * gg * (sc + 1.f) + sh;
                u32x2 o; o.x = pk2(y.x, y.y); o.y = pk2(y.z, y.w); *(GAS u32x2*)(H + (size_t)m * DM + k) = o; } }
    }
}
__device__ __forceinline__ void ss_phase(const GAS bf16_t* P, GAS float* ssq, GAS float* sskv, int gw, int NGW, int lane) {
    for (int m = gw; m < MALL; m += NGW) {
        const u32x2 q = *(const GAS u32x2*)(P + (size_t)m * PW + 1024 + 4 * lane); const unsigned k = *(const GAS unsigned*)(P + (size_t)m * PW + 1280 + 2 * lane);
        float a = bflo(q.x) * bflo(q.x) + bfhi(q.x) * bfhi(q.x) + bflo(q.y) * bflo(q.y) + bfhi(q.y) * bfhi(q.y), c = bflo(k) * bflo(k) + bfhi(k) * bfhi(k);
        a = wave_sum(a); c = wave_sum(c);
        if (lane == 0) { ssq[m] = a; sskv[m] = c; }
    }
}
__device__ __forceinline__ void qpost_phase(const GAS bf16_t* QR, const GAS float* ssq, const GAS float* RT, GAS bf16_t* Q, int gtid, int NT) {
    for (int task = gtid; task < MLAT * 96; task += NT) {
        const int row = task / 96, c8 = task - row * 96, h = c8 / 12, dc = c8 - h * 12, b = row >> 13, s = row & 8191;
        const float sc = rsqrtf(ssq[row] * (1.f / 256.f) + EPS) * QSCALE;
        const u32x4 mine = *(const GAS u32x4*)(QR + (size_t)row * 768 + 8 * c8);
        float v[8];
#pragma unroll
        for (int j = 0; j < 4; ++j) { v[2 * j] = bflo(mine[j]) * sc; v[2 * j + 1] = bfhi(mine[j]) * sc; }
        if (dc >= 8) { const int fq = dc - 8; const u32x4 oth = *(const GAS u32x4*)(QR + (size_t)row * 768 + 8 * (c8 ^ 1));
            const GAS float* rt = RT + (fq < 2 ? (s >> 6) : (s & 63)) * 16;
#pragma unroll
            for (int j = 0; j < 8; ++j) { const float pt = ((j & 1) ? bfhi(oth[j >> 1]) : bflo(oth[j >> 1])) * sc, cs = rt[2 * j], sn = rt[2 * j + 1];
                v[j] = (fq & 1) ? v[j] * cs + pt * sn : v[j] * cs - pt * sn; } }
        u32x4 w; w.x = pk2(v[0], v[1]); w.y = pk2(v[2], v[3]); w.z = pk2(v[4], v[5]); w.w = pk2(v[6], v[7]);
        *(GAS u32x4*)(Q + ((size_t)((b * 8 + h) * SEQ + s)) * 96 + 8 * dc) = w;
    }
}
__device__ __forceinline__ void kvpost_phase(const GAS bf16_t* KVR, const GAS float* sskv, GAS bf16_t* Kb, GAS bf16_t* Vt, int gtid, int NT) {
    for (int task = gtid; task < MALL * 64; task += NT) {
        const int row = task >> 6, c = task & 63, h = c >> 3, dd = (c & 7) * 8; const bool lat = row < MLAT;
        const int b = lat ? (row >> 13) : ((row - MLAT) >> 8), pos = lat ? (CTX + (row & 8191)) : ((row - MLAT) & 255);
        const float rs = rsqrtf(sskv[row] * (1.f / 128.f) + EPS);
        const u32x4 mine = *(const GAS u32x4*)(KVR + (size_t)row * 1024 + h * 128 + dd);
        u32x4 w;
#pragma unroll
        for (int j = 0; j < 4; ++j) w[j] = pk2(bflo(mine[j]) * rs, bfhi(mine[j]) * rs);
        *(GAS u32x4*)(Kb + ((size_t)(b * 8 + h) * KVLEN + pos) * 96 + dd) = w;
    }
    for (int task = gtid; task < (MALL / 8) * 512; task += NT) {
        const int rg = task >> 9, hd = task & 511, h = hd >> 6, d = hd & 63, row0 = rg * 8; const bool lat = row0 < MLAT;
        const int b = lat ? (row0 >> 13) : ((row0 - MLAT) >> 8), pos0 = lat ? (CTX + (row0 & 8191)) : ((row0 - MLAT) & 255);
        float v[8];
#pragma unroll
        for (int i = 0; i < 8; ++i) v[i] = bf2f(KVR[(size_t)(row0 + i) * 1024 + h * 128 + 64 + d]) * rsqrtf(sskv[row0 + i] * (1.f / 128.f) + EPS);
        u32x4 w; w.x = pk2(v[0], v[1]); w.y = pk2(v[2], v[3]); w.z = pk2(v[4], v[5]); w.w = pk2(v[6], v[7]);
        *(GAS u32x4*)(Vt + ((size_t)((b * 8 + h) * 64 + d)) * KVLEN + pos0) = w;
    }
}
__device__ __forceinline__ void krope_phase(const GAS bf16_t* P, GAS bf16_t* Kb, const GAS float* RT, int gtid, int NT) {
    for (int task = gtid; task < MALL * 4; task += NT) {
        const int row = task >> 2, fq = task & 3; const bool lat = row < MLAT;
        const int b = lat ? (row >> 13) : ((row - MLAT) >> 8), s = row & 8191, pos = lat ? (CTX + s) : ((row - MLAT) & 255);
        const u32x4 mine = *(const GAS u32x4*)(P + (size_t)row * PW + 1408 + 8 * fq), oth = *(const GAS u32x4*)(P + (size_t)row * PW + 1408 + 8 * (fq ^ 1));
        float v[8], pt[8];
#pragma unroll
        for (int j = 0; j < 4; ++j) { v[2 * j] = bflo(mine[j]); v[2 * j + 1] = bfhi(mine[j]); pt[2 * j] = bflo(oth[j]); pt[2 * j + 1] = bfhi(oth[j]); }
        if (lat) { const GAS float* rt = RT + (fq < 2 ? (s >> 6) : (s & 63)) * 16;
#pragma unroll
            for (int j = 0; j < 8; ++j) { const float cs = rt[2 * j], sn = rt[2 * j + 1]; v[j] = (fq & 1) ? v[j] * cs + pt[j] * sn : v[j] * cs - pt[j] * sn; } }
        u32x4 w; w.x = pk2(v[0], v[1]); w.y = pk2(v[2], v[3]); w.z = pk2(v[4], v[5]); w.w = pk2(v[6], v[7]);
#pragma unroll
        for (int h = 0; h < 8; ++h) *(GAS u32x4*)(Kb + ((size_t)(b * 8 + h) * KVLEN + pos) * 96 + 64 + 8 * fq) = w;
    }
}
#define MFMA32(a, b, c) __builtin_amdgcn_mfma_f32_32x32x16_bf16((a), (b), (c), 0, 0, 0)
__device__ __forceinline__ void gates_phase(const GAS float* cw, const GAS float* cb, const GAS float* b_a, const GAS float* b_x, const GAS float* lam, LAS unsigned char* lds, const GAS bf16_t* P, const GAS bf16_t* Wg, GAS unsigned* LU, int wave, int lane) {
    LAS bf16_t* xs = (LAS bf16_t*)(lds + wave * 4608);
    const int r32 = lane & 31, hi = lane >> 5;
    for (int unit = blockIdx.x; unit < (MALL / 256) * 8; unit += gridDim.x) {
        const int pm = unit >> 3, h = unit & 7, m0 = pm * 256 + wave * 32;
        const int s0 = m0 < MLAT ? (m0 & ~8191) : (MLAT + ((m0 - MLAT) & ~255)), slen = m0 < MLAT ? SEQ : CTX;
        {
            const int tok = lane >> 1, m = m0 + tok;
#pragma unroll
            for (int c8 = 0; c8 < 4; ++c8) { const int ch = (lane & 1) * 32 + c8 * 8, gch = h * 64 + ch;
                float acc[8];
                { const f32x4 b0 = *(const GAS f32x4*)(cb + gch), b1 = *(const GAS f32x4*)(cb + gch + 4);
                  acc[0] = b0.x; acc[1] = b0.y; acc[2] = b0.z; acc[3] = b0.w; acc[4] = b1.x; acc[5] = b1.y; acc[6] = b1.z; acc[7] = b1.w; }
#pragma unroll
                for (int k = 0; k < 4; ++k) { const int mm = m + k - 2;
                    if (mm >= s0 && mm < s0 + slen) { const u32x4 xv = *(const GAS u32x4*)(P + (size_t)mm * PW + gch);
                        const f32x4 w0 = *(const GAS f32x4*)(cw + k * 512 + gch), w1 = *(const GAS f32x4*)(cw + k * 512 + gch + 4);
                        acc[0] += w0.x * bflo(xv.x); acc[1] += w0.y * bfhi(xv.x); acc[2] += w0.z * bflo(xv.y); acc[3] += w0.w * bfhi(xv.y);
                        acc[4] += w1.x * bflo(xv.z); acc[5] += w1.y * bfhi(xv.z); acc[6] += w1.z * bflo(xv.w); acc[7] += w1.w * bfhi(xv.w); } }
                u32x4 o; o.x = pk2(acc[0], acc[1]); o.y = pk2(acc[2], acc[3]); o.z = pk2(acc[4], acc[5]); o.w = pk2(acc[6], acc[7]);
                *(LAS u32x4*)(xs + tok * 72 + ch) = o; }
        }
        LDS_WAIT();
        bf16x8 afr[4];
#pragma unroll
        for (int ks = 0; ks < 4; ++ks) afr[ks] = *(const LAS bf16x8*)(xs + r32 * 72 + 16 * ks + 8 * hi);
#pragma unroll
        for (int jh = 0; jh < 2; ++jh) {
            f32x16 acc4[4];
#pragma unroll
            for (int q = 0; q < 4; ++q) {
#pragma unroll
                for (int i = 0; i < 16; ++i) acc4[q][i] = 0.f;
                const GAS bf16_t* wrow = Wg + (size_t)(h * 256 + (2 * q + jh) * 32 + r32) * 64 + 8 * hi;
#pragma unroll
                for (int ks = 0; ks < 4; ++ks) { const bf16x8 bfr = *(const GAS bf16x8*)(wrow + 16 * ks); acc4[q] = MFMA32(afr[ks], bfr, acc4[q]); }
            }
            const int ch = jh * 32 + r32, gch = h * 64 + ch;
            float ba[2], bx[2], sp[2];
#pragma unroll
            for (int d = 0; d < 2; ++d) { ba[d] = b_a[d * 512 + gch]; bx[d] = b_x[d * 512 + gch]; const float nl = -lam[d * 512 + gch];
                sp[d] = 8.f * 1.4426950408889634f * (nl > 20.f ? nl : log1pf(__expf(nl))); }
#pragma unroll
            for (int i = 0; i < 16; ++i) { const int row = crow(i, hi); const float xv = bf2f(xs[row * 72 + ch]);
#pragma unroll
                for (int d = 0; d < 2; ++d) { const float r = sigmoidf_(acc4[2 * d][i] + ba[d]), ig = sigmoidf_(acc4[2 * d + 1][i] + bx[d]);
                    const float la2 = -r * sp[d]; const float uu = __builtin_amdgcn_sqrtf(fmaxf(1.f - __builtin_amdgcn_exp2f(2.f * la2), 0.f)) * (ig * xv);
                    LU[((size_t)(m0 + row) * 2 + d) * 512 + gch] = pk2(la2, uu); } }
        }
        LDS_WAIT();
    }
}
__device__ __forceinline__ void scan_agg(const GAS unsigned* LU, GAS f32x2* AGG, int gw, int NGW, int lane) {
    for (int task = gw; task < NB * 2 * (NCH + 1) * 8; task += NGW) {
        const int cgp = task & 7, c = (task >> 3) % (NCH + 1), d = (task / (8 * (NCH + 1))) & 1, b = task / (16 * (NCH + 1));
        const int ch = cgp * 64 + lane, row0 = c < NCH ? b * SEQ + c * CHL : MLAT + b * CTX;
        float A = 1.f, U = 0.f;
#pragma unroll 16
        for (int t = 0; t < CHL; ++t) { const int tt = d ? CHL - 1 - t : t; const unsigned w = LU[((size_t)(row0 + tt) * 2 + d) * 512 + ch];
            const float av = __builtin_amdgcn_exp2f(bflo(w)); A *= av; U = av * U + bfhi(w); }
        AGG[(size_t)((b * 2 + d) * (NCH + 1) + c) * 512 + ch] = (f32x2){A, U};
    }
}
__device__ __forceinline__ float gelu_tanh(float x) { const float z = 0.7978845608028654f * (x + 0.044715f * x * x * x);
    return x * __builtin_amdgcn_rcpf(1.f + __builtin_amdgcn_exp2f(-2.8853900817779268f * z)); }
__device__ __forceinline__ void scan_final(const GAS unsigned* LU, const GAS f32x2* AGG, const GAS bf16_t* P, GAS bf16_t* A2, int gw, int NGW, int lane) {
    for (int task = gw; task < NB * NCH * 8; task += NGW) {
        const int cgp = task & 7, c = (task >> 3) & (NCH - 1), b = task / (8 * NCH), ch = cgp * 64 + lane, row0 = b * SEQ + c * CHL;
        const GAS f32x2* ag0 = AGG + (size_t)((b * 2 + 0) * (NCH + 1)) * 512 + ch; const GAS f32x2* ag1 = AGG + (size_t)((b * 2 + 1) * (NCH + 1)) * 512 + ch;
        float hf = ag0[(size_t)NCH * 512].y;
        for (int cc = 0; cc < c; ++cc) { const f32x2 g = ag0[(size_t)cc * 512]; hf = g.x * hf + g.y; }
#pragma unroll 8
        for (int t = 0; t < CHL; ++t) { const unsigned w = LU[((size_t)(row0 + t) * 2 + 0) * 512 + ch]; hf = __builtin_amdgcn_exp2f(bflo(w)) * hf + bfhi(w);
            A2[(size_t)(row0 + t) * DM + ch] = (bf16_t)f2bf(hf); }
        float hb = ag1[(size_t)NCH * 512].y;
        for (int cc = NCH - 1; cc > c; --cc) { const f32x2 g = ag1[(size_t)cc * 512]; hb = g.x * hb + g.y; }
#pragma unroll 8
        for (int t = CHL - 1; t >= 0; --t) { const unsigned w = LU[((size_t)(row0 + t) * 2 + 1) * 512 + ch]; hb = __builtin_amdgcn_exp2f(bflo(w)) * hb + bfhi(w);
            const float f = bf2f(A2[(size_t)(row0 + t) * DM + ch]), gr = bf2f(P[(size_t)(row0 + t) * PW + 512 + ch]);
            A2[(size_t)(row0 + t) * DM + ch] = (bf16_t)f2bf((f + hb) * gelu_tanh(gr)); }
    }
}
constexpr int AT_KROW = 208, AT_VROW = 144;
constexpr float AT_THR = 8.f;
__device__ __forceinline__ unsigned cvtpk(float lo, float hi) { typedef float f2 __attribute__((ext_vector_type(2))); typedef __bf16 b2 __attribute__((ext_vector_type(2))); f2 v = {lo, hi}; b2 r = __builtin_convertvector(v, b2); return __builtin_bit_cast(unsigned, r); }
#define AT_SOFTMAX(P, M, L, O0, O1, PW0, PW1) do { \
        float mx_ = fmaxf(fmaxf(P[0], P[1]), fmaxf(P[2], P[3])); \
        _Pragma("unroll") for (int i_ = 4; i_ < 16; i_ += 4) mx_ = fmaxf(fmaxf(mx_, P[i_]), fmaxf(fmaxf(P[i_ + 1], P[i_ + 2]), P[i_ + 3])); \
        mx_ = fmaxf(mx_, __shfl_xor(mx_, 32)); \
        if (__any(mx_ > M + AT_THR)) { const float mn_ = fmaxf(M, mx_), al_ = __builtin_amdgcn_exp2f(M - mn_); M = mn_; L *= al_; \
            _Pragma("unroll") for (int i_ = 0; i_ < 16; ++i_) { O0[i_] *= al_; O1[i_] *= al_; } } \
        float s_ = 0.f; \
        _Pragma("unroll") for (int i_ = 0; i_ < 16; ++i_) { P[i_] = __builtin_amdgcn_exp2f(P[i_] - M); s_ += P[i_]; } \
        L += s_; \
        _Pragma("unroll") for (int j_ = 0; j_ < 4; ++j_) { PW0[j_] = cvtpk(P[2 * j_], P[2 * j_ + 1]); PW1[j_] = cvtpk(P[8 + 2 * j_], P[9 + 2 * j_]); } } while (0)
__device__ __forceinline__ void glds16(const GAS void* gsrc, unsigned lds_dst) {
    unsigned keep;
    asm volatile("s_mov_b32 %0, m0\n\ts_mov_b32 m0, %2\n\ts_nop 0\n\tglobal_load_lds_dwordx4 %1, off\n\ts_mov_b32 m0, %0" : "=&s"(keep) : "v"(gsrc), "s"(lds_dst) : "memory");
}
constexpr int AT_SLOT = 22 * 1024, AT_VOFF = 13 * 1024, AT_NP = 22;
__device__ __forceinline__ void attn_unit(LAS unsigned char* lds, const GAS bf16_t* Q, const GAS bf16_t* K, const GAS bf16_t* Vt, GAS bf16_t* A2, int b, int h, int qb, int tid, int wave, int lane) {
    const int r32 = lane & 31, hi = lane >> 5, q0 = qb * 512 + wave * 64;
    const GAS bf16_t* Qp = Q + ((size_t)((b * 8 + h) * SEQ + q0 + r32)) * 96 + 8 * hi;
    bf16x8 qa[6], qc[6];
#pragma unroll
    for (int d0 = 0; d0 < 6; ++d0) { qa[d0] = *(const GAS bf16x8*)(Qp + 16 * d0); qc[d0] = *(const GAS bf16x8*)(Qp + 32 * 96 + 16 * d0); }
    const GAS unsigned char* Kg = (const GAS unsigned char*)(K + (size_t)(b * 8 + h) * KVLEN * 96);
    const GAS unsigned char* Vg = (const GAS unsigned char*)(Vt + (size_t)(b * 8 + h) * 64 * KVLEN);
    const unsigned ldsb = (unsigned)(size_t)lds;
    const GAS unsigned char* src[3]; int stride[3]; unsigned dsto[3];
#pragma unroll
    for (int k = 0; k < 3; ++k) { int j = wave + 8 * k; if (j >= AT_NP) j -= 8; const int id = j * 64 + lane;
        if (j < 13) { const int row = id / 13; int col = id - row * 13; if (col == 12) col = 0; src[k] = Kg + row * 192 + col * 16; stride[k] = 12288; }
        else { const int idv = id - 832, d = idv / 9; int c = idv - d * 9; if (c == 8) c = 0; src[k] = Vg + ((size_t)d * KVLEN + c * 8) * 2; stride[k] = 128; }
        dsto[k] = ldsb + j * 1024; }
#define AT_ISSUE(t, slot) do { _Pragma("unroll") for (int k_ = 0; k_ < 3; ++k_) glds16(src[k_] + (size_t)(t) * stride[k_], (unsigned)__builtin_amdgcn_readfirstlane(dsto[k_] + (slot) * AT_SLOT)); } while (0)
    f32x16 oA0, oA1, oB0, oB1;
#pragma unroll
    for (int i = 0; i < 16; ++i) { oA0[i] = 0.f; oA1[i] = 0.f; oB0[i] = 0.f; oB1[i] = 0.f; }
    float mA = -1e30f, mB = -1e30f, lA = 0.f, lB = 0.f;
    constexpr int NT_ = KVLEN / 64;
    AT_ISSUE(0, 0); AT_ISSUE(1, 1);
    int slot = 0, nslot = 2;
#pragma unroll 1
    for (int t = 0; t < NT_; ++t) {
        if (t + 1 < NT_) asm volatile("s_waitcnt vmcnt(3) lgkmcnt(0)\n\ts_barrier" ::: "memory"); else asm volatile("s_waitcnt vmcnt(0) lgkmcnt(0)\n\ts_barrier" ::: "memory");
        if (t + 2 < NT_) AT_ISSUE(t + 2, nslot);
        const LAS unsigned char* sb = lds + slot * AT_SLOT;
#pragma unroll
        for (int hh = 0; hh < 2; ++hh) {
            const LAS unsigned char* kb = sb + (32 * hh + r32) * AT_KROW + hi * 16;
            f32x16 pA, pB;
#pragma unroll
            for (int i = 0; i < 16; ++i) { pA[i] = 0.f; pB[i] = 0.f; }
#pragma unroll
            for (int d0 = 0; d0 < 6; ++d0) { const bf16x8 a0 = *(const LAS bf16x8*)(kb + d0 * 32); pA = MFMA32(a0, qa[d0], pA); pB = MFMA32(a0, qc[d0], pB); }
            u32x4 pwA0, pwA1, pwB0, pwB1;
            AT_SOFTMAX(pA, mA, lA, oA0, oA1, pwA0, pwA1);
            AT_SOFTMAX(pB, mB, lB, oB0, oB1, pwB0, pwB1);
            const LAS unsigned char* vb = sb + AT_VOFF + r32 * AT_VROW + hi * 8 + hh * 64;
#pragma unroll
            for (int ks = 0; ks < 2; ++ks) {
                const s16x4 lo0 = *(const LAS s16x4*)(vb + ks * 32), hi0 = *(const LAS s16x4*)(vb + ks * 32 + 16);
                const s16x4 lo1 = *(const LAS s16x4*)(vb + 32 * AT_VROW + ks * 32), hi1 = *(const LAS s16x4*)(vb + 32 * AT_VROW + ks * 32 + 16);
                const bf16x8 va0 = __builtin_shufflevector(lo0, hi0, 0, 1, 2, 3, 4, 5, 6, 7), va1 = __builtin_shufflevector(lo1, hi1, 0, 1, 2, 3, 4, 5, 6, 7);
                const bf16x8 pa = __builtin_bit_cast(bf16x8, ks ? pwA1 : pwA0), pb = __builtin_bit_cast(bf16x8, ks ? pwB1 : pwB0);
                oA0 = MFMA32(va0, pa, oA0); oA1 = MFMA32(va1, pa, oA1); oB0 = MFMA32(va0, pb, oB0); oB1 = MFMA32(va1, pb, oB1);
            }
        }
        slot = slot == 2 ? 0 : slot + 1; nslot = nslot == 2 ? 0 : nslot + 1;
    }
    asm volatile("s_waitcnt lgkmcnt(0)\n\ts_barrier" ::: "memory");
    {   const float inv = 1.f / (lA + __shfl_xor(lA, 32));
        GAS bf16_t* op = A2 + (size_t)(b * SEQ + q0 + r32) * DM + 512 + h * 64 + 4 * hi;
#pragma unroll
        for (int g = 0; g < 4; ++g) { u32x2 w0, w1; w0.x = pk2(oA0[4 * g] * inv, oA0[4 * g + 1] * inv); w0.y = pk2(oA0[4 * g + 2] * inv, oA0[4 * g + 3] * inv);
            w1.x = pk2(oA1[4 * g] * inv, oA1[4 * g + 1] * inv); w1.y = pk2(oA1[4 * g + 2] * inv, oA1[4 * g + 3] * inv);
            *(GAS u32x2*)(op + 8 * g) = w0; *(GAS u32x2*)(op + 32 + 8 * g) = w1; } }
    {   const float inv = 1.f / (lB + __shfl_xor(lB, 32));
        GAS bf16_t* op = A2 + (size_t)(b * SEQ + q0 + 32 + r32) * DM + 512 + h * 64 + 4 * hi;
#pragma unroll
        for (int g = 0; g < 4; ++g) { u32x2 w0, w1; w0.x = pk2(oB0[4 * g] * inv, oB0[4 * g + 1] * inv); w0.y = pk2(oB0[4 * g + 2] * inv, oB0[4 * g + 3] * inv);
            w1.x = pk2(oB1[4 * g] * inv, oB1[4 * g + 1] * inv); w1.y = pk2(oB1[4 * g + 2] * inv, oB1[4 * g + 3] * inv);
            *(GAS u32x2*)(op + 8 * g) = w0; *(GAS u32x2*)(op + 32 + 8 * g) = w1; } }
#undef AT_ISSUE
}
__device__ __forceinline__ void p7_rows(const GAS float* x, const GAS float* g_post, const GAS float* g_pre, GAS float* out, const GAS float* mod, const GAS bf16_t* Y, GAS bf16_t* H2, int gw, int NGW, int lane) {
    for (int m0 = 2 * gw; m0 < MLAT; m0 += 2 * NGW) {
        const GAS float* md = mod + (m0 >> 13) * NMOD;
        f32x4 y[2][4], xv[2][4]; float ss[2];
#pragma unroll
        for (int r = 0; r < 2; ++r) { ss[r] = 0.f;
#pragma unroll
            for (int j = 0; j < 4; ++j) { const u32x2 w = *(const GAS u32x2*)(Y + (size_t)(m0 + r) * DM + 4 * lane + 256 * j); xv[r][j] = *(const GAS f32x4*)(x + (size_t)(m0 + r) * DM + 4 * lane + 256 * j);
                y[r][j] = (f32x4){bflo(w.x), bfhi(w.x), bflo(w.y), bfhi(w.y)}; ss[r] += y[r][j].x * y[r][j].x + y[r][j].y * y[r][j].y + y[r][j].z * y[r][j].z + y[r][j].w * y[r][j].w; } }
#pragma unroll
        for (int r = 0; r < 2; ++r) { const int m = m0 + r;
            const float rs = rsqrtf(wave_sum(ss[r]) * (1.f / DM) + EPS); float s2 = 0.f;
#pragma unroll
            for (int j = 0; j < 4; ++j) { const int k = 4 * lane + 256 * j;
                const f32x4 gg = *(const GAS f32x4*)(g_post + k), gt = *(const GAS f32x4*)(md + 2 * DM + k);
                xv[r][j] = xv[r][j] + gt * (y[r][j] * rs * gg); *(GAS f32x4*)(out + (size_t)m * DM + k) = xv[r][j];
                s2 += xv[r][j].x * xv[r][j].x + xv[r][j].y * xv[r][j].y + xv[r][j].z * xv[r][j].z + xv[r][j].w * xv[r][j].w; }
            const float rs2 = rsqrtf(wave_sum(s2) * (1.f / DM) + EPS);
#pragma unroll
            for (int j = 0; j < 4; ++j) { const int k = 4 * lane + 256 * j;
                const f32x4 gg = *(const GAS f32x4*)(g_pre + k), sh = *(const GAS f32x4*)(md + 3 * DM + k), sc = *(const GAS f32x4*)(md + 4 * DM + k);
                const f32x4 hh = xv[r][j] * rs2 * gg * (sc + 1.f) + sh;
                u32x2 o; o.x = pk2(hh.x, hh.y); o.y = pk2(hh.z, hh.w); *(GAS u32x2*)(H2 + (size_t)m * DM + k) = o; } }
    }
}
__device__ __forceinline__ void p11_rows(const GAS float* g_post, GAS float* out, const GAS float* mod, const GAS bf16_t* Fb, int gw, int NGW, int lane) {
    for (int m0 = 2 * gw; m0 < MLAT; m0 += 2 * NGW) {
        const GAS float* md = mod + (m0 >> 13) * NMOD;
        f32x4 y[2][4], xv[2][4]; float ss[2];
#pragma unroll
        for (int r = 0; r < 2; ++r) { ss[r] = 0.f;
#pragma unroll
            for (int j = 0; j < 4; ++j) { const u32x2 w = *(const GAS u32x2*)(Fb + (size_t)(m0 + r) * DM + 4 * lane + 256 * j); xv[r][j] = *(const GAS f32x4*)(out + (size_t)(m0 + r) * DM + 4 * lane + 256 * j);
                y[r][j] = (f32x4){bflo(w.x), bfhi(w.x), bflo(w.y), bfhi(w.y)}; ss[r] += y[r][j].x * y[r][j].x + y[r][j].y * y[r][j].y + y[r][j].z * y[r][j].z + y[r][j].w * y[r][j].w; } }
#pragma unroll
        for (int r = 0; r < 2; ++r) { const float rs = rsqrtf(wave_sum(ss[r]) * (1.f / DM) + EPS);
#pragma unroll
            for (int j = 0; j < 4; ++j) { const int k = 4 * lane + 256 * j;
                const f32x4 gg = *(const GAS f32x4*)(g_post + k), gt = *(const GAS f32x4*)(md + 5 * DM + k);
                *(GAS f32x4*)(out + (size_t)(m0 + r) * DM + k) = xv[r][j] + gt * (y[r][j] * rs * gg); } }
    }
}
__device__ __forceinline__ void convgate_phase(const GAS float* cw, const GAS float* cb, const GAS bf16_t* UP, GAS bf16_t* G, int half, int gtid, int NT) {
    constexpr int JG = DFF / 8, RG = 32, NTASK = (MLAT / 2 / RG) * JG;
    for (int task = gtid; task < NTASK; task += NT) {
        const int jg = task % JG, rg = task / JG, j0 = jg * 8, r0 = rg * RG, m0 = half * (MLAT / 2) + r0;
        float wu[3][8], wg[3][8], bu[8], bg[8];
#pragma unroll
        for (int k = 0; k < 3; ++k)
#pragma unroll
            for (int i = 0; i < 8; ++i) { wu[k][i] = cw[k * 2 * DFF + j0 + i]; wg[k][i] = cw[k * 2 * DFF + DFF + j0 + i]; }
#pragma unroll
        for (int i = 0; i < 8; ++i) { bu[i] = cb[j0 + i]; bg[i] = cb[DFF + j0 + i]; }
        const GAS bf16_t* up = UP + (size_t)r0 * (2 * DFF) + j0;
        u32x4 pu = {0u, 0u, 0u, 0u}, pg = {0u, 0u, 0u, 0u}, cu, cg_, nu, ng;
        if ((m0 & 8191) != 0) { pu = *(const GAS u32x4*)(up - 2 * DFF); pg = *(const GAS u32x4*)(up - 2 * DFF + DFF); }
        cu = *(const GAS u32x4*)(up); cg_ = *(const GAS u32x4*)(up + DFF);
#pragma unroll 4
        for (int r = 0; r < RG; ++r) {
            const bool nv = (r + 1 < RG) || (((m0 + RG) & 8191) != 0);
            if (nv) { nu = *(const GAS u32x4*)(up + (size_t)(r + 1) * (2 * DFF)); ng = *(const GAS u32x4*)(up + (size_t)(r + 1) * (2 * DFF) + DFF); } else { nu = (u32x4){0u, 0u, 0u, 0u}; ng = nu; }
            float o[8];
#pragma unroll
            for (int i = 0; i < 8; ++i) { const int w_ = i >> 1;
                const float p_u = (i & 1) ? bfhi(pu[w_]) : bflo(pu[w_]), c_u = (i & 1) ? bfhi(cu[w_]) : bflo(cu[w_]), n_u = (i & 1) ? bfhi(nu[w_]) : bflo(nu[w_]);
                const float p_g = (i & 1) ? bfhi(pg[w_]) : bflo(pg[w_]), c_g = (i & 1) ? bfhi(cg_[w_]) : bflo(cg_[w_]), n_g = (i & 1) ? bfhi(ng[w_]) : bflo(ng[w_]);
                const float uv = bu[i] + wu[0][i] * p_u + wu[1][i] * c_u + wu[2][i] * n_u, gv = bg[i] + wg[0][i] * p_g + wg[1][i] * c_g + wg[2][i] * n_g;
                o[i] = gv * __builtin_amdgcn_rcpf(1.f + __builtin_amdgcn_exp2f(-1.4426950408889634f * gv)) * uv; }
            u32x4 w; w.x = pk2(o[0], o[1]); w.y = pk2(o[2], o[3]); w.z = pk2(o[4], o[5]); w.w = pk2(o[6], o[7]);
            *(GAS u32x4*)(G + (size_t)(r0 + r) * DFF + j0) = w;
            pu = cu; pg = cg_; cu = nu; cg_ = ng;
        }
    }
}
constexpr int NPH = 17;
__global__ void __launch_bounds__(512, 2) fwd_kernel(Args a) {
    extern __shared__ __attribute__((aligned(16))) unsigned char lds_raw[];
    LAS unsigned char* lds = (LAS unsigned char*)lds_raw;
    const int lo = a.ph_lo, hi_ = a.ph_hi;
#if MK_COOP
    cg::grid_group grid = cg::this_grid();
#endif
    typedef pg8::EpiBf16<0> EpiB;
    constexpr int MH = MLAT / 2;
#ifndef REPMASK
#define REPMASK 0
#endif
    bool repeated = false;
#pragma unroll 1
    for (int ph = lo; ph < hi_; ++ph) {
        int tid = threadIdx.x; asm volatile("" : "+v"(tid));
        int G = gridDim.x, bx = blockIdx.x; asm volatile("" : "+s"(G), "+s"(bx));
        const int lane = tid & 63, wave = __builtin_amdgcn_readfirstlane(tid >> 6);
        const int vcu = (G % 8 == 0) ? (bx % 8) * (G / 8) + bx / 8 : bx;
        const int gw = vcu * 8 + wave, NGW = G * 8, gtid = bx * 512 + tid, NTH = G * 512;
        unsigned char* ws_ = a.ws; asm volatile("" : "+s"(ws_)); GAS unsigned char* ws = (GAS unsigned char*)ws_;
        GAS float* mod = (GAS float*)(ws + WS_MOD); GAS float* ssq = (GAS float*)(ws + WS_SSQ); GAS float* sskv = (GAS float*)(ws + WS_SSKV);
        GAS bf16_t* Win = (GAS bf16_t*)(ws + WS_WIN); GAS bf16_t* Wq = (GAS bf16_t*)(ws + WS_WQ); GAS bf16_t* Wkv = (GAS bf16_t*)(ws + WS_WKV); GAS bf16_t* Wg = (GAS bf16_t*)(ws + WS_WG);
        GAS bf16_t* Wout = (GAS bf16_t*)(ws + WS_WOUT); GAS bf16_t* Wup = (GAS bf16_t*)(ws + WS_WUP); GAS bf16_t* Wdn = (GAS bf16_t*)(ws + WS_WDN);
        GAS f32x2* AGG = (GAS f32x2*)(ws + WS_AGG); GAS float* RT = (GAS float*)(ws + WS_ROPE);
        GAS bf16_t* H = (GAS bf16_t*)(ws + WS_R1); GAS bf16_t* KVR = H; GAS bf16_t* H2 = H; GAS bf16_t* Qb = (GAS bf16_t*)(ws + WS_Q);
        GAS bf16_t* P = (GAS bf16_t*)(ws + WS_R2); GAS bf16_t* Y = P; GAS bf16_t* Fb = P;
        GAS unsigned* LU = (GAS unsigned*)(ws + WS_LU); GAS bf16_t* Kb = (GAS bf16_t*)(ws + WS_K); GAS bf16_t* Vb = (GAS bf16_t*)(ws + WS_V); GAS bf16_t* A2 = (GAS bf16_t*)(ws + WS_A2); GAS bf16_t* QR = A2;
        GAS bf16_t* UP = (GAS bf16_t*)(ws + WS_UP); GAS bf16_t* Gb = (GAS bf16_t*)(ws + WS_G);
        float* outp_ = a.out; asm volatile("" : "+s"(outp_)); GAS float* outp = (GAS float*)outp_;
        pg8::Gemm g{nullptr, nullptr, 0, 0, 0, 0, 0}; GAS bf16_t* O = nullptr; int ldc = 0;
        switch (ph) {
            case 2:  g = pg8::Gemm{(const bf16_t*)(H), (const bf16_t*)(Win), MALL, PW, DM, DM, DM}; O = P; ldc = PW; break;
            case 4:  g = pg8::Gemm{(const bf16_t*)(P + 1024), (const bf16_t*)(Wq), MLAT, 768, 256, PW, 256}; O = QR; ldc = 768; break;
            case 5:  g = pg8::Gemm{(const bf16_t*)(P + 1280), (const bf16_t*)(Wkv), MALL, 1024, 256, PW, 256}; O = KVR; ldc = 1024; break;
            case 8:  g = pg8::Gemm{(const bf16_t*)(A2), (const bf16_t*)(Wout), MLAT, DM, DM, DM, DM}; O = Y; ldc = DM; break;
            case 10: g = pg8::Gemm{(const bf16_t*)(H2), (const bf16_t*)(Wup), MH, 2 * DFF, DM, DM, DM}; O = UP; ldc = 2 * DFF; break;
            case 13: g = pg8::Gemm{(const bf16_t*)(H2 + (size_t)MH * DM), (const bf16_t*)(Wup), MH, 2 * DFF, DM, DM, DM}; O = UP; ldc = 2 * DFF; break;
            case 12: g = pg8::Gemm{(const bf16_t*)(Gb), (const bf16_t*)(Wdn), MH, DM, DFF, DFF, DFF}; O = Fb; ldc = DM; break;
            case 15: g = pg8::Gemm{(const bf16_t*)(Gb), (const bf16_t*)(Wdn), MH, DM, DFF, DFF, DFF}; O = Fb + (size_t)MH * DM; ldc = DM; break;
            default: break;
        }
        if (g.A != nullptr) {
            pg8::StaticOrder S; S.init(g.M, g.N, G, bx); EpiB E{(bf16_t*)O, ldc, nullptr, 0, 0, 1.f};
            pg8::gemm_phase<EpiB, pg8::StaticOrder, true, true>(lds, g, S, E, tid);
        }
#ifndef NGM
#define NGM 0x1ffff
#endif
#define NG(k) ((NGM >> (k)) & 1)
        else if (NG(0) && ph == 0) {
            prep_mat<0>(argp(10), nullptr, Win, 1536, 1024, gtid, NTH); prep_mat<1>(argp(18), argp(19), Wq, 768, 256, gtid, NTH); prep_mat<2>(argp(20), argp(21), Wkv, 1024, 256, gtid, NTH);
            prep_mat<3>(argp(13), argp(15), Wg, 2048, 64, gtid, NTH); prep_mat<4>(argp(22), nullptr, Wout, 1024, 1024, gtid, NTH); prep_mat<5>(argp(23), nullptr, Wup, 5632, 1024, gtid, NTH);
            prep_mat<6>(argp(26), nullptr, Wdn, 1024, 2816, gtid, NTH);
            if (gtid < 1024) { const int pos = gtid >> 3, j = gtid & 7; const float invf[8] = {1.f, 0.31622776601683794f, 0.1f, 0.031622776601683794f, 0.01f, 0.0031622776601683794f, 0.001f, 0.00031622776601683794f};
                const float ang = (float)pos * invf[j]; RT[2 * gtid] = cosf(ang); RT[2 * gtid + 1] = sinf(ang); }
            mod_phase(argp(1), argp(3), argp(4), argp(5), mod, (LAS float*)(lds + wave * 4096), gw, NGW, lane);
        } else if (NG(1) && ph == 1) {
            p1_rows(argp(0), argp(2), argp(6), mod, H, gw, NGW, lane);
        } else if (NG(3) && ph == 3) {
            gates_phase(argp(11), argp(12), argp(14), argp(16), argp(17), lds, P, Wg, LU, wave, lane);
            ss_phase(P, ssq, sskv, gw, NGW, lane);
        } else if (NG(6) && ph == 6) {
            scan_agg(LU, AGG, gw, NGW, lane); krope_phase(P, Kb, RT, gtid, NTH); qpost_phase(QR, ssq, RT, Qb, gtid, NTH); kvpost_phase(KVR, sskv, Kb, Vb, gtid, NTH);
        } else if (NG(7) && ph == 7) {
            scan_final(LU, AGG, P, A2, gw, NGW, lane);
            const int upb = (NB * 8 * 16 + G - 1) / G, u0 = vcu * upb, u1 = min(NB * 8 * 16, u0 + upb);
            __syncthreads();
            for (int unit = u0; unit < u1; ++unit) { const int bh = unit >> 4, qb = unit & 15; attn_unit(lds, Qb, Kb, Vb, A2, bh >> 3, bh & 7, qb, tid, wave, lane); }
        } else if (NG(9) && ph == 9) {
            p7_rows(argp(0), argp(7), argp(8), outp, mod, Y, H2, gw, NGW, lane);
        } else if (NG(11) && (ph == 11 || ph == 14)) {
            convgate_phase(argp(24), argp(25), UP, Gb, ph == 14 ? 1 : 0, gtid, NTH);
        } else if (NG(16) && ph == 16) {
            p11_rows(argp(9), outp, mod, Fb, gw, NGW, lane);
        }
        __syncthreads();
#if MK_COOP
        if (ph + 1 < hi_ && ph != 3 && ph != 4) grid.sync();
#endif
        if (REPMASK) { if (((REPMASK >> ph) & 1) && !repeated) { repeated = true; --ph; } else repeated = false; }
    }
}

extern "C" void kernel_launch(void* const* d_in, const int* in_sizes, int n_in, void* d_out, int out_size, void* d_ws, size_t ws_size, hipStream_t stream) {
    static int grid = 0;
    if (grid == 0) {
        if (n_in != 27 || out_size != MLAT * DM || ws_size < WS_END) { fprintf(stderr, "kernel_launch: unexpected shapes (n_in %d, out %d, ws %zu)\n", n_in, out_size, ws_size); grid = -1; return; }
        int dev = 0, cus = 0, per_cu = 0;
        if (hipGetDevice(&dev) != hipSuccess || hipDeviceGetAttribute(&cus, hipDeviceAttributeMultiprocessorCount, dev) != hipSuccess) { grid = -1; return; }
        if (hipFuncSetAttribute((const void*)fwd_kernel, hipFuncAttributeMaxDynamicSharedMemorySize, LDS_BYTES) != hipSuccess) { fprintf(stderr, "kernel_launch: hipFuncSetAttribute failed\n"); grid = -1; return; }
        if (hipOccupancyMaxActiveBlocksPerMultiprocessor(&per_cu, (const void*)fwd_kernel, 512, LDS_BYTES) != hipSuccess || per_cu < 1) { fprintf(stderr, "kernel_launch: occupancy query says %d\n", per_cu); }
        (void)hipGetLastError();
        grid = cus;
    }
    if (grid < 0) return;
    (void)hipMemsetAsync((char*)d_ws + WS_CTL, 0, CTL_BYTES, stream);
    Args a{};
    for (int i = 0; i < 27; ++i) a.in[i] = (const float*)d_in[i];
    a.out = (float*)d_out; a.ws = (unsigned char*)d_ws;
#if MK_COOP
    a.ph_lo = 0; a.ph_hi = NPH;
    void* args[] = {&a};
    hipError_t e = hipLaunchCooperativeKernel((const void*)fwd_kernel, dim3(grid), dim3(512), args, LDS_BYTES, stream);
    if (e != hipSuccess) fprintf(stderr, "kernel_launch: cooperative launch failed: %s (grid %d)\n", hipGetErrorString(e), grid);
#else
    for (int p = 0; p < NPH; ++p) { a.ph_lo = p; a.ph_hi = p + 1; hipLaunchKernelGGL(fwd_kernel, dim3(grid), dim3(512), LDS_BYTES, stream, a); }
#endif
}
```

```cpp
#include <hip/hip_runtime.h>
#include <hip/hip_cooperative_groups.h>
#include <cstdio>
#include <cstdint>
namespace cg = cooperative_groups;
#ifndef MK_COOP
#define MK_COOP 1
#endif
namespace pg8 {
#define PG8_LAS __attribute__((address_space(3)))
typedef unsigned short bf16_t;
typedef short bf16x8 __attribute__((ext_vector_type(8)));
typedef float f32x4 __attribute__((ext_vector_type(4)));
typedef unsigned u32x4 __attribute__((ext_vector_type(4)));
constexpr int BM = 256, BK = 64, HALF = 128, HTB = HALF * BK * 2  , STAGE_BYTES = 8 * HTB, NXCD = 8, WGM = 8;

__host__ __device__ __forceinline__ int lds_byte(int r, int c) { const int st = (r >> 4) * 2 + (c >> 5), rr = r & 15, cc = c & 31, ob = rr * 64 + cc * 2; return st * 1024 + (ob ^ (((ob >> 9) & 1) << 5)); }
__host__ __device__ __forceinline__ void stage_rc(int b, int& R, int& C) { const int st = b / 1024, sb = b % 1024, swz = sb ^ (((sb >> 9) & 1) << 5); R = (st >> 1) * 16 + swz / 64; C = (st & 1) * 32 + (swz % 64) / 2; }
__host__ __device__ __forceinline__ int perm32(int rho) { const int n = rho >> 4, i = rho & 15; return 8 * (i >> 2) + 4 * n + (i & 3); }

struct Unit { int pm, pn; };
struct Gemm { const bf16_t* A; const bf16_t* Bt; int M, N, K, lda, ldb; };

struct StaticOrder {
    int nM, nN, nwg, G, c;
    __host__ __device__ void init(int M, int N, int G_, int c_) { nM = M / BM; nN = N / BM; nwg = nM * nN; G = G_; c = c_; }
    __host__ __device__ bool next(int i, Unit& u) const {
        const long L = (long)i * G + c; if (L >= nwg) return false;
        int wgid = (int)L; { const int q = nwg / NXCD, r = nwg % NXCD, xcd = wgid % NXCD, off = wgid / NXCD; wgid = (xcd < r ? xcd * (q + 1) : r * (q + 1) + (xcd - r) * q) + off; }
        const int nig = WGM * nN, gid = wgid / nig, fm = gid * WGM, gsz = (nM - fm) < WGM ? (nM - fm) : WGM;
        u.pm = fm + ((wgid % nig) % gsz); u.pn = (wgid % nig) / gsz; return true;
    }
    __device__ __forceinline__ void a_ready(const Unit&) const {}
    __device__ __forceinline__ void done(const Unit&) const {}
};

__device__ __forceinline__ unsigned cvt_pk_bf16(float lo, float hi) { unsigned r; asm volatile("v_cvt_pk_bf16_f32 %0, %1, %2" : "=v"(r) : "v"(lo), "v"(hi)); return r; }
typedef float f32x2 __attribute__((ext_vector_type(2)));
__device__ __forceinline__ f32x2 gelu_pk(f32x2 v) {
    const f32x2 av = __builtin_elementwise_abs(v), d = av * 0.2316418882f + 1.0f;
    f32x2 t; t.x = __builtin_amdgcn_rcpf(d.x); t.y = __builtin_amdgcn_rcpf(d.y);
    f32x2 q = t * 0.5307027145f + (-0.7265760135f); q = q * t + 0.7107068705f; q = q * t + (-0.142248368f); q = q * t + 0.127414796f; q = q * t;
    const f32x2 s = (v * v) * (-0.72134752044f);
    f32x2 e; e.x = __builtin_amdgcn_exp2f(s.x); e.y = __builtin_amdgcn_exp2f(s.y);
    const f32x2 m = v * (q * e), r = v - m;
    f32x2 o; o.x = v.x < 0.f ? m.x : r.x; o.y = v.y < 0.f ? m.y : r.y; return o;
}

template <int ACT  > struct EpiBf16 {
    static constexpr bool PERM = true, AFTER_DRAIN = false; static_assert(ACT == 0 || ACT == 1, "EpiBf16: ACT is 0 (none) or 1 (gelu_pk)");
    bf16_t* O; int ldc; const float* bias; int split_cols; size_t split_stride; float scale0;
    __device__ __forceinline__ void operator()(const f32x4 (&acc)[2][2][4][2], const Unit& u, int wr, int wc, int fr, int fq) const {
        const int row0 = u.pm * BM + wr * 64 + fr; int colt = u.pn * BM; bf16_t* base = O;
        float sc = 1.f; if (split_cols) { const int t = colt / split_cols; base += (size_t)t * split_stride; colt -= t * split_cols; if (t == 0) sc = scale0; }
        const int col0 = colt + wc * 32 + 8 * fq, bcol0 = u.pn * BM + wc * 32 + 8 * fq;
        f32x4 bv[2][2];
#pragma unroll
        for (int bj = 0; bj < 2; ++bj)
#pragma unroll
            for (int n = 0; n < 2; ++n) bv[bj][n] = bias ? *(const f32x4*)(bias + bcol0 + bj * HALF + 4 * n) : (f32x4){0.f, 0.f, 0.f, 0.f};
#pragma unroll
        for (int ai = 0; ai < 2; ++ai)
#pragma unroll
            for (int m = 0; m < 4; ++m) { bf16_t* rowp = base + (size_t)(row0 + ai * HALF + m * 16) * ldc + col0;
#pragma unroll
                for (int bj = 0; bj < 2; ++bj) { f32x4 v0 = acc[ai][bj][m][0] + bv[bj][0], v1 = acc[ai][bj][m][1] + bv[bj][1];
                    if (ACT == 1) { f32x2 a = gelu_pk((f32x2){v0[0], v0[1]}), b = gelu_pk((f32x2){v0[2], v0[3]}), c = gelu_pk((f32x2){v1[0], v1[1]}), d = gelu_pk((f32x2){v1[2], v1[3]});
                        v0 = (f32x4){a.x, a.y, b.x, b.y}; v1 = (f32x4){c.x, c.y, d.x, d.y}; }
                    v0 = v0 * sc; v1 = v1 * sc; u32x4 w; w.x = cvt_pk_bf16(v0[0], v0[1]); w.y = cvt_pk_bf16(v0[2], v0[3]); w.z = cvt_pk_bf16(v1[0], v1[1]); w.w = cvt_pk_bf16(v1[2], v1[3]);
                    *(__attribute__((address_space(1))) u32x4*)(rowp + bj * HALF) = w; } }
    }
};
template <class Epi, class Sched, bool ALIGN_EPI = false, bool SP2 = false>
__device__ __forceinline__ void gemm_phase(PG8_LAS unsigned char* lds, const Gemm g, const Sched& S, const Epi& E, const int tid) {
    const int wid = __builtin_amdgcn_readfirstlane(tid >> 6), lane = tid & 63, wr = wid >> 2, wc = wid & 3, fr = lane & 15, fq = lane >> 4;
    const int K = g.K, nt = K / BK;
    unsigned voffA[2], voffB[2];
#pragma unroll
    for (int i = 0; i < 2; ++i) { int R, C; stage_rc(tid * 16 + i * 8192, R, C); const int Rb = Epi::PERM ? ((R & ~31) + perm32(R & 31)) : R;
        voffA[i] = (unsigned)(R * g.lda + C) * 2u; voffB[i] = (unsigned)(Rb * g.ldb + C) * 2u; }
    const size_t kstep = (size_t)(BK * 2);
    const size_t hstepA = (size_t)HALF * g.lda * 2, hstepB = (size_t)HALF * g.ldb * 2;
    const size_t tstepA = 2 * hstepA, tstepB = 2 * hstepB;
    const unsigned ldsw = (unsigned)wid * 1024u;
    const int aoff = lds_byte(wr * 64 + fr, fq * 8), boff = lds_byte(wc * 32 + fr, fq * 8);
#define PG8_SA(b, h) (((b) * 2 + (h)) * HTB)
#define PG8_SB(b, h) ((4 + (b) * 2 + (h)) * HTB)
#define PG8_STAGE(bufoff, gbase, voff) do { _Pragma("unroll") for (int _i = 0; _i < 2; ++_i) \
        __builtin_amdgcn_global_load_lds((const unsigned*)((const char*)(gbase) + (voff)[_i]), (PG8_LAS unsigned*)(lds + (bufoff) + ldsw + _i * 8192), 16, 0, 0); } while (0)
#define PG8_LDA(dst, b, h) do { _Pragma("unroll") for (int m = 0; m < 4; ++m) _Pragma("unroll") for (int k = 0; k < 2; ++k) dst[m][k] = *(const PG8_LAS bf16x8*)(lds + PG8_SA(b, h) + aoff + m * 2048 + k * 1024); } while (0)
#define PG8_LDB(dst, b, h) do { _Pragma("unroll") for (int n = 0; n < 2; ++n) _Pragma("unroll") for (int k = 0; k < 2; ++k) dst[n][k] = *(const PG8_LAS bf16x8*)(lds + PG8_SB(b, h) + boff + n * 2048 + k * 1024); } while (0)
#define PG8_MMA(ai, bj, At, Bt) do { __builtin_amdgcn_s_setprio(1); _Pragma("unroll") for (int m = 0; m < 4; ++m) _Pragma("unroll") for (int n = 0; n < 2; ++n) _Pragma("unroll") for (int k = 0; k < 2; ++k) \
        acc[ai][bj][m][n] = __builtin_amdgcn_mfma_f32_16x16x32_bf16(Bt[n][k], At[m][k], acc[ai][bj][m][n], 0, 0, 0); __builtin_amdgcn_s_setprio(0); } while (0)
#define PG8_WAIT_V(n) asm volatile("s_waitcnt vmcnt(" #n ")" ::: "memory")
#define PG8_WAIT_L(n) asm volatile("s_waitcnt lgkmcnt(" #n ")" ::: "memory")
#define PG8_BAR __builtin_amdgcn_s_barrier()
#define PG8_SCHED __builtin_amdgcn_sched_barrier(0)
    Unit cur, nxt; int ui = 0;
    if (!S.next(0, cur)) return;
    f32x4 acc[2][2][4][2];
#pragma unroll
    for (int a = 0; a < 2; ++a)
#pragma unroll
        for (int b = 0; b < 2; ++b)
#pragma unroll
            for (int m = 0; m < 4; ++m)
#pragma unroll
                for (int n = 0; n < 2; ++n) acc[a][b][m][n] = (f32x4){0.f, 0.f, 0.f, 0.f};
    bf16x8 At[4][2], B0[2][2], B1[2][2];
    const char* cA = (const char*)g.A + (size_t)cur.pm * tstepA; const char* cB = (const char*)g.Bt + (size_t)cur.pn * tstepB;
    S.a_ready(cur);
    if constexpr (SP2) {
        PG8_STAGE(PG8_SB(0, 0), cB, voffB); PG8_STAGE(PG8_SB(0, 1), cB + hstepB, voffB); PG8_STAGE(PG8_SA(0, 0), cA, voffA); PG8_STAGE(PG8_SA(0, 1), cA + hstepA, voffA);
        if (wr == 1) PG8_BAR;
        PG8_WAIT_V(2); PG8_BAR;
        PG8_STAGE(PG8_SB(1, 0), cB + kstep, voffB); PG8_STAGE(PG8_SA(1, 0), cA + kstep, voffA); PG8_STAGE(PG8_SB(1, 1), cB + hstepB + kstep, voffB);
        PG8_WAIT_V(6); PG8_BAR;
    } else {
        PG8_STAGE(PG8_SB(0, 0), cB, voffB); PG8_STAGE(PG8_SA(0, 0), cA, voffA); PG8_STAGE(PG8_SB(0, 1), cB + hstepB, voffB); PG8_STAGE(PG8_SA(0, 1), cA + hstepA, voffA);
        if (wr == 1) PG8_BAR;
        PG8_WAIT_V(4); PG8_BAR;
        PG8_STAGE(PG8_SB(1, 0), cB + kstep, voffB); PG8_STAGE(PG8_SA(1, 0), cA + kstep, voffA); PG8_STAGE(PG8_SB(1, 1), cB + hstepB + kstep, voffB);
        PG8_WAIT_V(6); PG8_BAR;
    }
    for (;;) {
        const bool has_next = S.next(ui + 1, nxt);
        const char* nA = has_next ? (const char*)g.A + (size_t)nxt.pm * tstepA : cA; const char* nB = has_next ? (const char*)g.Bt + (size_t)nxt.pn * tstepB : cB;
        for (int t = 0; t < nt; t += 2) {
            const bool last = (t == nt - 2);
            const char* a1 = cA + (size_t)(t + 1) * kstep;
            const char* a2 = last ? nA : cA + (size_t)(t + 2) * kstep; const char* b2 = last ? nB : cB + (size_t)(t + 2) * kstep;
            const char* a3 = a2 + kstep; const char* b3 = b2 + kstep;
            if (last && has_next) S.a_ready(nxt);
            if constexpr (SP2) {
            PG8_LDB(B0, 0, 0); PG8_LDB(B1, 0, 1); PG8_SCHED; PG8_LDA(At, 0, 0); PG8_STAGE(PG8_SA(1, 1), a1 + hstepA, voffA);
            PG8_WAIT_V(8); PG8_WAIT_L(0); PG8_BAR; PG8_MMA(0, 0, At, B0); PG8_MMA(0, 1, At, B1); PG8_BAR; PG8_SCHED;
            PG8_LDA(At, 0, 1); PG8_STAGE(PG8_SB(0, 0), b2, voffB); PG8_STAGE(PG8_SB(0, 1), b2 + hstepB, voffB); PG8_STAGE(PG8_SA(0, 0), a2, voffA);
            PG8_WAIT_V(8); PG8_WAIT_L(0); PG8_BAR; PG8_MMA(1, 0, At, B0); PG8_MMA(1, 1, At, B1); PG8_BAR; PG8_SCHED;
            PG8_LDB(B0, 1, 0); PG8_LDB(B1, 1, 1); PG8_SCHED; PG8_LDA(At, 1, 0); PG8_STAGE(PG8_SA(0, 1), a2 + hstepA, voffA);
            PG8_WAIT_V(8); PG8_WAIT_L(0); PG8_BAR; PG8_MMA(0, 0, At, B0); PG8_MMA(0, 1, At, B1); PG8_BAR; PG8_SCHED;
            PG8_LDA(At, 1, 1); PG8_STAGE(PG8_SB(1, 0), b3, voffB); PG8_STAGE(PG8_SB(1, 1), b3 + hstepB, voffB); PG8_STAGE(PG8_SA(1, 0), a3, voffA);
            PG8_WAIT_V(8); PG8_WAIT_L(0); PG8_BAR; PG8_MMA(1, 0, At, B0); PG8_MMA(1, 1, At, B1); PG8_BAR; PG8_SCHED;
            } else {
            PG8_LDB(B0, 0, 0); PG8_SCHED; PG8_LDA(At, 0, 0); PG8_STAGE(PG8_SA(1, 1), a1 + hstepA, voffA);
            PG8_WAIT_L(8); PG8_BAR; PG8_WAIT_L(0); PG8_MMA(0, 0, At, B0); PG8_BAR; PG8_SCHED;
            PG8_LDB(B1, 0, 1); PG8_STAGE(PG8_SB(0, 0), b2, voffB);
            PG8_BAR; PG8_WAIT_L(0); PG8_MMA(0, 1, At, B1); PG8_BAR;
            PG8_LDA(At, 0, 1); PG8_STAGE(PG8_SA(0, 0), a2, voffA);
            PG8_BAR; PG8_WAIT_L(0); PG8_MMA(1, 0, At, B0); PG8_BAR; PG8_SCHED;
            PG8_STAGE(PG8_SB(0, 1), b2 + hstepB, voffB);
            PG8_WAIT_V(6); PG8_BAR; PG8_MMA(1, 1, At, B1); PG8_BAR;
            PG8_LDB(B0, 1, 0); PG8_SCHED; PG8_LDA(At, 1, 0); PG8_STAGE(PG8_SA(0, 1), a2 + hstepA, voffA);
            PG8_WAIT_L(8); PG8_BAR; PG8_WAIT_L(0); PG8_MMA(0, 0, At, B0); PG8_BAR; PG8_SCHED;
            PG8_LDB(B1, 1, 1); PG8_STAGE(PG8_SB(1, 0), b3, voffB);
            PG8_BAR; PG8_WAIT_L(0); PG8_MMA(0, 1, At, B1); PG8_BAR;
            PG8_LDA(At, 1, 1); PG8_STAGE(PG8_SA(1, 0), a3, voffA);
            PG8_BAR; PG8_WAIT_L(0); PG8_MMA(1, 0, At, B0); PG8_BAR; PG8_SCHED;
            PG8_STAGE(PG8_SB(1, 1), b3 + hstepB, voffB);
            PG8_WAIT_V(6); PG8_BAR; PG8_MMA(1, 1, At, B1); PG8_BAR;
            }
        }
        if constexpr (ALIGN_EPI) { if (wr == 0) PG8_BAR; }
        if constexpr (!Epi::AFTER_DRAIN) { E(acc, cur, wr, wc, fr, fq); S.done(cur); }
        if (!has_next) break;
#pragma unroll
        for (int a = 0; a < 2; ++a)
#pragma unroll
            for (int b = 0; b < 2; ++b)
#pragma unroll
                for (int m = 0; m < 4; ++m)
#pragma unroll
                    for (int n = 0; n < 2; ++n) acc[a][b][m][n] = (f32x4){0.f, 0.f, 0.f, 0.f};
        cur = nxt; cA = nA; cB = nB; ++ui;
        if constexpr (ALIGN_EPI) { if (wr == 1) PG8_BAR; }
    }
    PG8_WAIT_V(0);
    if constexpr (!ALIGN_EPI) { if (wr == 0) PG8_BAR; }
    PG8_BAR;
    if constexpr (Epi::AFTER_DRAIN) { E.fused(acc, cur, wr, wc, fr, fq, lds, wid, lane); S.done(cur); }
#undef PG8_SA
#undef PG8_SB
#undef PG8_STAGE
#undef PG8_LDA
#undef PG8_LDB
#undef PG8_MMA
#undef PG8_WAIT_V
#undef PG8_WAIT_L
#undef PG8_BAR
#undef PG8_SCHED
}
}
#define LAS __attribute__((address_space(3)))
#define GAS __attribute__((address_space(1)))
typedef unsigned short bf16_t;
typedef short bf16x8 __attribute__((ext_vector_type(8)));
typedef short s16x4 __attribute__((ext_vector_type(4)));
typedef float f32x4 __attribute__((ext_vector_type(4)));
typedef float f32x16 __attribute__((ext_vector_type(16)));
typedef unsigned u32x4 __attribute__((ext_vector_type(4)));
typedef unsigned u32x2 __attribute__((ext_vector_type(2)));
typedef float f32x2 __attribute__((ext_vector_type(2)));

constexpr int NB = 8, SEQ = 8192, DM = 1024, CTX = 256, MLAT = NB * SEQ, MCTX = NB * CTX, MALL = MLAT + MCTX;
constexpr int PW = 1536, KVLEN = CTX + SEQ, DFF = 2816, NMOD = 6 * DM;
constexpr int NCH = 32, CHL = 256;
constexpr float EPS = 1e-6f;
constexpr float QSCALE = 0.10206207261596575f * 1.4426950408889634f;
constexpr size_t MiB = 1u << 20;
constexpr size_t WS_CTL = 0, CTL_BYTES = 2 * MiB;
constexpr size_t WS_MOD = 64 * 1024, WS_SSQ = 512 * 1024, WS_SSKV = 1024 * 1024;
constexpr size_t WS_WIN = 2 * MiB, WS_WQ = 5 * MiB, WS_WKV = 6 * MiB, WS_WG = 7 * MiB, WS_WOUT = 8 * MiB, WS_WUP = 10 * MiB, WS_WDN = 21 * MiB;
constexpr size_t WS_AGG = 27 * MiB, WS_ROPE = 29 * MiB + 512 * 1024;
constexpr size_t WS_R1 = 30 * MiB;
constexpr size_t WS_R2 = 162 * MiB;
constexpr size_t WS_LU = 360 * MiB, WS_K = 624 * MiB, WS_V = 723 * MiB, WS_A2 = 789 * MiB;
constexpr size_t WS_UP = 360 * MiB, WS_G = 712 * MiB, WS_Q = 920 * MiB, WS_END = 1016 * MiB;
constexpr int LDS_BYTES = 139264;

__device__ __forceinline__ unsigned f2bf(float f) { unsigned u = __builtin_bit_cast(unsigned, f); return (u + 0x7fffu + ((u >> 16) & 1u)) >> 16; }
__device__ __forceinline__ unsigned pk2(float lo, float hi) { return f2bf(lo) | (f2bf(hi) << 16); }
__device__ __forceinline__ float bflo(unsigned w) { return __uint_as_float(w << 16); }
__device__ __forceinline__ float bfhi(unsigned w) { return __uint_as_float(w & 0xffff0000u); }
__device__ __forceinline__ float bf2f(bf16_t v) { return __uint_as_float((unsigned)v << 16); }
__device__ __forceinline__ int crow(int r, int hi) { return (r & 3) + 8 * (r >> 2) + 4 * hi; }
__device__ __forceinline__ float wave_sum(float v) {
#pragma unroll
    for (int o = 1; o < 64; o <<= 1) v += __shfl_xor(v, o);
    return v;
}
__device__ __forceinline__ float sigmoidf_(float x) { return __builtin_amdgcn_rcpf(1.f + __builtin_amdgcn_exp2f(-1.4426950408889634f * x)); }
#define LDS_WAIT() asm volatile("s_waitcnt lgkmcnt(0)" ::: "memory")

struct Args { const float* in[27]; float* out; unsigned char* ws; int ph_lo, ph_hi; };
__device__ __forceinline__ const GAS float* argp(int i) {
    const __attribute__((address_space(4))) char* kp = (const __attribute__((address_space(4))) char*)__builtin_amdgcn_kernarg_segment_ptr();
    asm volatile("" : "+s"(kp));
    const float* p = *(const float* const __attribute__((address_space(4)))*)(kp + 8 * i);
    return (const GAS float*)p;
}

template <int ID> __device__ __forceinline__ float wsrc(const GAS float* __restrict__ p0, const GAS float* __restrict__ p1, int n, int k) {
    if (ID == 0) return n < 1440 ? p0[(size_t)k * 1440 + n] : 0.f;
    if (ID == 1) return p0[k] * p1[(size_t)k * 768 + n];
    if (ID == 2) return k < 128 ? p0[k] * p1[(size_t)k * 1024 + n] : 0.f;
    if (ID == 3) { const int h = n >> 8, np = n & 255, mat = np >> 6, j = np & 63, dir = mat >> 1; const GAS float* w = (mat & 1) ? p1 : p0; return w[(size_t)((dir * 8 + h) * 64 + k) * 64 + j]; }
    if (ID == 4) return p0[(size_t)k * 1024 + n];
    if (ID == 5) return p0[(size_t)k * 5632 + n];
    return p0[(size_t)k * 1024 + n];
}
template <int ID> __device__ __forceinline__ void prep_mat(const GAS float* __restrict__ p0, const GAS float* __restrict__ p1, GAS bf16_t* __restrict__ dst, int N, int K, int gtid, int NT) {
    const int items = N * (K / 8);
    for (int it = gtid; it < items; it += NT) {
        const int n = it % N, k8 = it / N;
        u32x4 o;
        o.x = pk2(wsrc<ID>(p0, p1, n, 8 * k8 + 0), wsrc<ID>(p0, p1, n, 8 * k8 + 1)); o.y = pk2(wsrc<ID>(p0, p1, n, 8 * k8 + 2), wsrc<ID>(p0, p1, n, 8 * k8 + 3));
        o.z = pk2(wsrc<ID>(p0, p1, n, 8 * k8 + 4), wsrc<ID>(p0, p1, n, 8 * k8 + 5)); o.w = pk2(wsrc<ID>(p0, p1, n, 8 * k8 + 6), wsrc<ID>(p0, p1, n, 8 * k8 + 7));
        *(GAS u32x4*)(dst + (size_t)n * K + 8 * k8) = o;
    }
}
__device__ __forceinline__ void mod_phase(const GAS float* __restrict__ cvec, const GAS float* __restrict__ cctx, const GAS float* __restrict__ wmod, const GAS float* __restrict__ bmod, GAS float* __restrict__ mod, LAS float* scr, int gw, int NGW, int lane) {
    for (int task = gw; task < 96 * 16; task += NGW) {
        const int cgp = task % 96, kc = task / 96, n = cgp * 64 + lane, k0 = kc * 64;
#pragma unroll
        for (int r = 0; r < 9; ++r) { const float cv = r < 8 ? cvec[r * 1024 + k0 + lane] : cctx[k0 + lane]; scr[r * 64 + lane] = cv / (1.f + __expf(-cv)); }
        LDS_WAIT();
        float acc[9];
#pragma unroll
        for (int r = 0; r < 9; ++r) acc[r] = 0.f;
#pragma unroll 8
        for (int kk = 0; kk < 64; ++kk) { const float w = wmod[(size_t)(k0 + kk) * NMOD + n];
#pragma unroll
            for (int r = 0; r < 9; ++r) acc[r] += scr[r * 64 + kk] * w; }
        const float bias = kc == 0 ? bmod[n] : 0.f;
#pragma unroll
        for (int r = 0; r < 9; ++r) atomicAdd((float*)(mod + r * NMOD + n), acc[r] + bias);
        LDS_WAIT();
    }
}
__device__ __forceinline__ void p1_rows(const GAS float* __restrict__ x, const GAS float* __restrict__ ctx, const GAS float* __restrict__ g, const GAS float* __restrict__ mod, GAS bf16_t* __restrict__ H, int gw, int NGW, int lane) {
    for (int m0 = 2 * gw; m0 < MALL; m0 += 2 * NGW) {
        f32x4 v[2][4]; float ss[2];
#pragma unroll
        for (int r = 0; r < 2; ++r) { const int m = m0 + r; const GAS float* src = m < MLAT ? x + (size_t)m * DM : ctx + (size_t)(m - MLAT) * DM; ss[r] = 0.f;
#pragma unroll
            for (int j = 0; j < 4; ++j) { v[r][j] = *(const GAS f32x4*)(src + 4 * lane + 256 * j); ss[r] += v[r][j].x * v[r][j].x + v[r][j].y * v[r][j].y + v[r][j].z * v[r][j].z + v[r][j].w * v[r][j].w; } }
#pragma unroll
        for (int r = 0; r < 2; ++r) { const int m = m0 + r; const GAS float* md = mod + (m < MLAT ? (m >> 13) : 8) * NMOD;
            const float rs = rsqrtf(wave_sum(ss[r]) * (1.f / DM) + EPS);
#pragma unroll
            for (int j = 0; j < 4; ++j) { const int k = 4 * lane + 256 * j;
                const f32x4 gg = *(const GAS f32x4*)(g + k), sh = *(const GAS f32x4*)(md + k), sc = *(const GAS f32x4*)(md + DM + k);
                const f32x4 y = v[r][j] * rs * gg * (sc + 1.f) + sh;
                u32x2 o; o.x = pk2(y.x, y.y); o.y = pk2(y.z, y.w); *(GAS u32x2*)(H + (size_t)m * DM + k) = o; } }
    }
}
__device__ __forceinline__ void ss_phase(const GAS bf16_t* __restrict__ P, GAS float* __restrict__ ssq, GAS float* __restrict__ sskv, int gw, int NGW, int lane) {
#pragma unroll 4
    for (int m = gw; m < MALL; m += NGW) {
        const u32x2 q = *(const GAS u32x2*)(P + (size_t)m * PW + 1024 + 4 * lane); const unsigned k = *(const GAS unsigned*)(P + (size_t)m * PW + 1280 + 2 * lane);
        float a = bflo(q.x) * bflo(q.x) + bfhi(q.x) * bfhi(q.x) + bflo(q.y) * bflo(q.y) + bfhi(q.y) * bfhi(q.y), c = bflo(k) * bflo(k) + bfhi(k) * bfhi(k);
        a = wave_sum(a); c = wave_sum(c);
        if (lane == 0) { ssq[m] = a; sskv[m] = c; }
    }
}
__device__ __forceinline__ void qpost_phase(const GAS bf16_t* __restrict__ QR, const GAS float* __restrict__ ssq, const GAS float* __restrict__ RT, GAS bf16_t* __restrict__ Q, int gtid, int NT) {
#pragma unroll 4
    for (int task = gtid; task < MLAT * 96; task += NT) {
        const int row = task / 96, c8 = task - row * 96, h = c8 / 12, dc = c8 - h * 12, b = row >> 13, s = row & 8191;
        const float sc = rsqrtf(ssq[row] * (1.f / 256.f) + EPS) * QSCALE;
        const u32x4 mine = *(const GAS u32x4*)(QR + (size_t)row * 768 + 8 * c8);
        float v[8];
#pragma unroll
        for (int j = 0; j < 4; ++j) { v[2 * j] = bflo(mine[j]) * sc; v[2 * j + 1] = bfhi(mine[j]) * sc; }
        if (dc >= 8) { const int fq = dc - 8; const u32x4 oth = *(const GAS u32x4*)(QR + (size_t)row * 768 + 8 * (c8 ^ 1));
            const GAS float* rt = RT + (fq < 2 ? (s >> 6) : (s & 63)) * 16;
#pragma unroll
            for (int j = 0; j < 8; ++j) { const float pt = ((j & 1) ? bfhi(oth[j >> 1]) : bflo(oth[j >> 1])) * sc, cs = rt[2 * j], sn = rt[2 * j + 1];
                v[j] = (fq & 1) ? v[j] * cs + pt * sn : v[j] * cs - pt * sn; } }
        u32x4 w; w.x = pk2(v[0], v[1]); w.y = pk2(v[2], v[3]); w.z = pk2(v[4], v[5]); w.w = pk2(v[6], v[7]);
        *(GAS u32x4*)(Q + ((size_t)((b * 8 + h) * SEQ + s)) * 96 + 8 * dc) = w;
    }
}
__device__ __forceinline__ void kvpost_phase(const GAS bf16_t* __restrict__ KVR, const GAS float* __restrict__ sskv, GAS bf16_t* __restrict__ Kb, GAS bf16_t* __restrict__ Vt, int gtid, int NT) {
#pragma unroll 4
    for (int task = gtid; task < MALL * 64; task += NT) {
        const int row = task >> 6, c = task & 63, h = c >> 3, dd = (c & 7) * 8; const bool lat = row < MLAT;
        const int b = lat ? (row >> 13) : ((row - MLAT) >> 8), pos = lat ? (CTX + (row & 8191)) : ((row - MLAT) & 255);
        const float rs = rsqrtf(sskv[row] * (1.f / 128.f) + EPS);
        const u32x4 mine = *(const GAS u32x4*)(KVR + (size_t)row * 1024 + h * 128 + dd);
        u32x4 w;
#pragma unroll
        for (int j = 0; j < 4; ++j) w[j] = pk2(bflo(mine[j]) * rs, bfhi(mine[j]) * rs);
        *(GAS u32x4*)(Kb + ((size_t)(b * 8 + h) * KVLEN + pos) * 96 + dd) = w;
    }
#pragma unroll 2
    for (int task = gtid; task < (MALL / 8) * 512; task += NT) {
        const int rg = task >> 9, hd = task & 511, h = hd >> 6, d = hd & 63, row0 = rg * 8; const bool lat = row0 < MLAT;
        const int b = lat ? (row0 >> 13) : ((row0 - MLAT) >> 8), pos0 = lat ? (CTX + (row0 & 8191)) : ((row0 - MLAT) & 255);
        float v[8];
#pragma unroll
        for (int i = 0; i < 8; ++i) v[i] = bf2f(KVR[(size_t)(row0 + i) * 1024 + h * 128 + 64 + d]) * rsqrtf(sskv[row0 + i] * (1.f / 128.f) + EPS);
        u32x4 w; w.x = pk2(v[0], v[1]); w.y = pk2(v[2], v[3]); w.z = pk2(v[4], v[5]); w.w = pk2(v[6], v[7]);
        *(GAS u32x4*)(Vt + ((size_t)((b * 8 + h) * 64 + d)) * KVLEN + pos0) = w;
    }
}
__device__ __forceinline__ void krope_phase(const GAS bf16_t* __restrict__ P, GAS bf16_t* __restrict__ Kb, const GAS float* __restrict__ RT, int gtid, int NT) {
#pragma unroll 2
    for (int task = gtid; task < MALL * 4; task += NT) {
        const int row = task >> 2, fq = task & 3; const bool lat = row < MLAT;
        const int b = lat ? (row >> 13) : ((row - MLAT) >> 8), s = row & 8191, pos = lat ? (CTX + s) : ((row - MLAT) & 255);
        const u32x4 mine = *(const GAS u32x4*)(P + (size_t)row * PW + 1408 + 8 * fq), oth = *(const GAS u32x4*)(P + (size_t)row * PW + 1408 + 8 * (fq ^ 1));
        float v[8], pt[8];
#pragma unroll
        for (int j = 0; j < 4; ++j) { v[2 * j] = bflo(mine[j]); v[2 * j + 1] = bfhi(mine[j]); pt[2 * j] = bflo(oth[j]); pt[2 * j + 1] = bfhi(oth[j]); }
        if (lat) { const GAS float* rt = RT + (fq < 2 ? (s >> 6) : (s & 63)) * 16;
#pragma unroll
            for (int j = 0; j < 8; ++j) { const float cs = rt[2 * j], sn = rt[2 * j + 1]; v[j] = (fq & 1) ? v[j] * cs + pt[j] * sn : v[j] * cs - pt[j] * sn; } }
        u32x4 w; w.x = pk2(v[0], v[1]); w.y = pk2(v[2], v[3]); w.z = pk2(v[4], v[5]); w.w = pk2(v[6], v[7]);
#pragma unroll
        for (int h = 0; h < 8; ++h) *(GAS u32x4*)(Kb + ((size_t)(b * 8 + h) * KVLEN + pos) * 96 + 64 + 8 * fq) = w;
    }
}
#define MFMA32(a, b, c) __builtin_amdgcn_mfma_f32_32x32x16_bf16((a), (b), (c), 0, 0, 0)
__device__ __forceinline__ void gates_phase(const GAS float* __restrict__ cw, const GAS float* __restrict__ cb, const GAS float* __restrict__ b_a, const GAS float* __restrict__ b_x, const GAS float* __restrict__ lam, LAS unsigned char* lds, const GAS bf16_t* __restrict__ P, const GAS bf16_t* __restrict__ Wg, GAS unsigned* __restrict__ LU, int wave, int lane) {
    LAS bf16_t* xs = (LAS bf16_t*)(lds + wave * 4608);
    const int r32 = lane & 31, hi = lane >> 5;
    for (int unit = blockIdx.x; unit < (MALL / 256) * 8; unit += gridDim.x) {
        const int pm = unit >> 3, h = unit & 7, m0 = pm * 256 + wave * 32;
        const int s0 = m0 < MLAT ? (m0 & ~8191) : (MLAT + ((m0 - MLAT) & ~255)), slen = m0 < MLAT ? SEQ : CTX;
        {
            const int tok = lane >> 1, m = m0 + tok;
#pragma unroll
            for (int c8 = 0; c8 < 4; ++c8) { const int ch = (lane & 1) * 32 + c8 * 8, gch = h * 64 + ch;
                float acc[8];
                { const f32x4 b0 = *(const GAS f32x4*)(cb + gch), b1 = *(const GAS f32x4*)(cb + gch + 4);
                  acc[0] = b0.x; acc[1] = b0.y; acc[2] = b0.z; acc[3] = b0.w; acc[4] = b1.x; acc[5] = b1.y; acc[6] = b1.z; acc[7] = b1.w; }
#pragma unroll
                for (int k = 0; k < 4; ++k) { const int mm = m + k - 2;
                    if (mm >= s0 && mm < s0 + slen) { const u32x4 xv = *(const GAS u32x4*)(P + (size_t)mm * PW + gch);
                        const f32x4 w0 = *(const GAS f32x4*)(cw + k * 512 + gch), w1 = *(const GAS f32x4*)(cw + k * 512 + gch + 4);
                        acc[0] += w0.x * bflo(xv.x); acc[1] += w0.y * bfhi(xv.x); acc[2] += w0.z * bflo(xv.y); acc[3] += w0.w * bfhi(xv.y);
                        acc[4] += w1.x * bflo(xv.z); acc[5] += w1.y * bfhi(xv.z); acc[6] += w1.z * bflo(xv.w); acc[7] += w1.w * bfhi(xv.w); } }
                u32x4 o; o.x = pk2(acc[0], acc[1]); o.y = pk2(acc[2], acc[3]); o.z = pk2(acc[4], acc[5]); o.w = pk2(acc[6], acc[7]);
                *(LAS u32x4*)(xs + tok * 72 + ch) = o; }
        }
        LDS_WAIT();
        bf16x8 afr[4];
#pragma unroll
        for (int ks = 0; ks < 4; ++ks) afr[ks] = *(const LAS bf16x8*)(xs + r32 * 72 + 16 * ks + 8 * hi);
#pragma unroll
        for (int jh = 0; jh < 2; ++jh) {
            f32x16 acc4[4];
#pragma unroll
            for (int q = 0; q < 4; ++q) {
#pragma unroll
                for (int i = 0; i < 16; ++i) acc4[q][i] = 0.f;
                const GAS bf16_t* wrow = Wg + (size_t)(h * 256 + (2 * q + jh) * 32 + r32) * 64 + 8 * hi;
#pragma unroll
                for (int ks = 0; ks < 4; ++ks) { const bf16x8 bfr = *(const GAS bf16x8*)(wrow + 16 * ks); acc4[q] = MFMA32(afr[ks], bfr, acc4[q]); }
            }
            const int ch = jh * 32 + r32, gch = h * 64 + ch;
            float ba[2], bx[2], sp[2];
#pragma unroll
            for (int d = 0; d < 2; ++d) { ba[d] = b_a[d * 512 + gch]; bx[d] = b_x[d * 512 + gch]; const float nl = -lam[d * 512 + gch];
                sp[d] = 8.f * 1.4426950408889634f * (nl > 20.f ? nl : log1pf(__expf(nl))); }
#pragma unroll
            for (int i = 0; i < 16; ++i) { const int row = crow(i, hi); const float xv = bf2f(xs[row * 72 + ch]);
#pragma unroll
                for (int d = 0; d < 2; ++d) { const float r = sigmoidf_(acc4[2 * d][i] + ba[d]), ig = sigmoidf_(acc4[2 * d + 1][i] + bx[d]);
                    const float la2 = -r * sp[d]; const float uu = __builtin_amdgcn_sqrtf(fmaxf(1.f - __builtin_amdgcn_exp2f(2.f * la2), 0.f)) * (ig * xv);
                    LU[((size_t)(m0 + row) * 2 + d) * 512 + gch] = pk2(la2, uu); } }
        }
        LDS_WAIT();
    }
}
__device__ __forceinline__ void scan_agg(const GAS unsigned* __restrict__ LU, GAS f32x2* __restrict__ AGG, int gw, int NGW, int lane) {
    for (int task = gw; task < NB * 2 * (NCH + 1) * 8; task += NGW) {
        const int cgp = task & 7, c = (task >> 3) % (NCH + 1), d = (task / (8 * (NCH + 1))) & 1, b = task / (16 * (NCH + 1));
        const int ch = cgp * 64 + lane, row0 = c < NCH ? b * SEQ + c * CHL : MLAT + b * CTX;
        float A = 1.f, U = 0.f;
#pragma unroll 16
        for (int t = 0; t < CHL; ++t) { const int tt = d ? CHL - 1 - t : t; const unsigned w = LU[((size_t)(row0 + tt) * 2 + d) * 512 + ch];
            const float av = __builtin_amdgcn_exp2f(bflo(w)); A *= av; U = av * U + bfhi(w); }
        AGG[(size_t)((b * 2 + d) * (NCH + 1) + c) * 512 + ch] = (f32x2){A, U};
    }
}
__device__ __forceinline__ float gelu_tanh(float x) { const float z = 0.7978845608028654f * (x + 0.044715f * x * x * x);
    return x * __builtin_amdgcn_rcpf(1.f + __builtin_amdgcn_exp2f(-2.8853900817779268f * z)); }
__device__ __forceinline__ void scan_final(const GAS unsigned* __restrict__ LU, const GAS f32x2* __restrict__ AGG, const GAS bf16_t* __restrict__ P, GAS bf16_t* __restrict__ A2, int gw, int NGW, int lane) {
    constexpr int BT = 16;
    for (int task = gw; task < NB * NCH * 8; task += NGW) {
        const int cgp = task & 7, c = (task >> 3) & (NCH - 1), b = task / (8 * NCH), ch = cgp * 64 + lane, row0 = b * SEQ + c * CHL;
        const GAS f32x2* ag0 = AGG + (size_t)((b * 2 + 0) * (NCH + 1)) * 512 + ch; const GAS f32x2* ag1 = AGG + (size_t)((b * 2 + 1) * (NCH + 1)) * 512 + ch;
        float hf = ag0[(size_t)NCH * 512].y;
        for (int cc = 0; cc < c; ++cc) { const f32x2 g = ag0[(size_t)cc * 512]; hf = g.x * hf + g.y; }
        float hb = ag1[(size_t)NCH * 512].y;
        for (int cc = NCH - 1; cc > c; --cc) { const f32x2 g = ag1[(size_t)cc * 512]; hb = g.x * hb + g.y; }
#pragma unroll 1
        for (int t0 = 0; t0 < CHL; t0 += BT) { unsigned w[BT];
#pragma unroll
            for (int i = 0; i < BT; ++i) w[i] = LU[((size_t)(row0 + t0 + i) * 2 + 0) * 512 + ch];
#pragma unroll
            for (int i = 0; i < BT; ++i) { hf = __builtin_amdgcn_exp2f(bflo(w[i])) * hf + bfhi(w[i]); A2[(size_t)(row0 + t0 + i) * DM + ch] = (bf16_t)f2bf(hf); } }
#pragma unroll 1
        for (int t0 = CHL - BT; t0 >= 0; t0 -= BT) { unsigned w[BT]; bf16_t f[BT], gr[BT];
#pragma unroll
            for (int i = 0; i < BT; ++i) { w[i] = LU[((size_t)(row0 + t0 + i) * 2 + 1) * 512 + ch]; f[i] = A2[(size_t)(row0 + t0 + i) * DM + ch]; gr[i] = P[(size_t)(row0 + t0 + i) * PW + 512 + ch]; }
#pragma unroll
            for (int i = BT - 1; i >= 0; --i) { hb = __builtin_amdgcn_exp2f(bflo(w[i])) * hb + bfhi(w[i]);
                A2[(size_t)(row0 + t0 + i) * DM + ch] = (bf16_t)f2bf((bf2f(f[i]) + hb) * gelu_tanh(bf2f(gr[i]))); } }
    }
}
constexpr int AT_KROW = 208, AT_VROW = 144;
constexpr float AT_THR = 8.f;
__device__ __forceinline__ unsigned cvtpk(float lo, float hi) { typedef float f2 __attribute__((ext_vector_type(2))); typedef __bf16 b2 __attribute__((ext_vector_type(2))); f2 v = {lo, hi}; b2 r = __builtin_convertvector(v, b2); return __builtin_bit_cast(unsigned, r); }
#define AT_SOFTMAX(P, M, L, O0, O1, PW0, PW1) do { \
        float mx_ = fmaxf(fmaxf(P[0], P[1]), fmaxf(P[2], P[3])); \
        _Pragma("unroll") for (int i_ = 4; i_ < 16; i_ += 4) mx_ = fmaxf(fmaxf(mx_, P[i_]), fmaxf(fmaxf(P[i_ + 1], P[i_ + 2]), P[i_ + 3])); \
        mx_ = fmaxf(mx_, __shfl_xor(mx_, 32)); \
        if (__any(mx_ > M + AT_THR)) { const float mn_ = fmaxf(M, mx_), al_ = __builtin_amdgcn_exp2f(M - mn_); M = mn_; L *= al_; \
            _Pragma("unroll") for (int i_ = 0; i_ < 16; ++i_) { O0[i_] *= al_; O1[i_] *= al_; } } \
        float s_ = 0.f; \
        _Pragma("unroll") for (int i_ = 0; i_ < 16; ++i_) { P[i_] = __builtin_amdgcn_exp2f(P[i_] - M); s_ += P[i_]; } \
        L += s_; \
        _Pragma("unroll") for (int j_ = 0; j_ < 4; ++j_) { PW0[j_] = cvtpk(P[2 * j_], P[2 * j_ + 1]); PW1[j_] = cvtpk(P[8 + 2 * j_], P[9 + 2 * j_]); } } while (0)
__device__ __forceinline__ void glds16(const GAS void* gsrc, unsigned lds_dst) {
    unsigned keep;
    asm volatile("s_mov_b32 %0, m0\n\ts_mov_b32 m0, %2\n\ts_nop 0\n\tglobal_load_lds_dwordx4 %1, off\n\ts_mov_b32 m0, %0" : "=&s"(keep) : "v"(gsrc), "s"(lds_dst) : "memory");
}
constexpr int AT_SLOT = 22 * 1024, AT_VOFF = 13 * 1024, AT_NP = 22;
__device__ __forceinline__ void attn_unit(LAS unsigned char* lds, const GAS bf16_t* __restrict__ Q, const GAS bf16_t* __restrict__ K, const GAS bf16_t* __restrict__ Vt, GAS bf16_t* __restrict__ A2, int b, int h, int qb, int tid, int wave, int lane) {
    const int r32 = lane & 31, hi = lane >> 5, q0 = qb * 512 + wave * 64;
    const GAS bf16_t* Qp = Q + ((size_t)((b * 8 + h) * SEQ + q0 + r32)) * 96 + 8 * hi;
    bf16x8 qa[6], qc[6];
#pragma unroll
    for (int d0 = 0; d0 < 6; ++d0) { qa[d0] = *(const GAS bf16x8*)(Qp + 16 * d0); qc[d0] = *(const GAS bf16x8*)(Qp + 32 * 96 + 16 * d0); }
    const GAS unsigned char* Kg = (const GAS unsigned char*)(K + (size_t)(b * 8 + h) * KVLEN * 96);
    const GAS unsigned char* Vg = (const GAS unsigned char*)(Vt + (size_t)(b * 8 + h) * 64 * KVLEN);
    const unsigned ldsb = (unsigned)(size_t)lds;
    const GAS unsigned char* src[3]; int stride[3]; unsigned dsto[3];
#pragma unroll
    for (int k = 0; k < 3; ++k) { int j = wave + 8 * k; if (j >= AT_NP) j -= 8; const int id = j * 64 + lane;
        if (j < 13) { const int row = id / 13; int col = id - row * 13; if (col == 12) col = 0; src[k] = Kg + row * 192 + col * 16; stride[k] = 12288; }
        else { const int idv = id - 832, d = idv / 9; int c = idv - d * 9; if (c == 8) c = 0; src[k] = Vg + ((size_t)d * KVLEN + c * 8) * 2; stride[k] = 128; }
        dsto[k] = ldsb + j * 1024; }
#define AT_ISSUE(t, slot) do { _Pragma("unroll") for (int k_ = 0; k_ < 3; ++k_) glds16(src[k_] + (size_t)(t) * stride[k_], (unsigned)__builtin_amdgcn_readfirstlane(dsto[k_] + (slot) * AT_SLOT)); } while (0)
    f32x16 oA0, oA1, oB0, oB1;
#pragma unroll
    for (int i = 0; i < 16; ++i) { oA0[i] = 0.f; oA1[i] = 0.f; oB0[i] = 0.f; oB1[i] = 0.f; }
    float mA = -1e30f, mB = -1e30f, lA = 0.f, lB = 0.f;
    constexpr int NT_ = KVLEN / 64;
    AT_ISSUE(0, 0); AT_ISSUE(1, 1);
    int slot = 0, nslot = 2;
#pragma unroll 1
    for (int t = 0; t < NT_; ++t) {
        if (t + 1 < NT_) asm volatile("s_waitcnt vmcnt(3) lgkmcnt(0)\n\ts_barrier" ::: "memory"); else asm volatile("s_waitcnt vmcnt(0) lgkmcnt(0)\n\ts_barrier" ::: "memory");
        if (t + 2 < NT_) AT_ISSUE(t + 2, nslot);
        const LAS unsigned char* sb = lds + slot * AT_SLOT;
#pragma unroll
        for (int hh = 0; hh < 2; ++hh) {
            const LAS unsigned char* kb = sb + (32 * hh + r32) * AT_KROW + hi * 16;
            f32x16 pA, pB;
#pragma unroll
            for (int i = 0; i < 16; ++i) { pA[i] = 0.f; pB[i] = 0.f; }
#pragma unroll
            for (int d0 = 0; d0 < 6; ++d0) { const bf16x8 a0 = *(const LAS bf16x8*)(kb + d0 * 32); pA = MFMA32(a0, qa[d0], pA); pB = MFMA32(a0, qc[d0], pB); }
            u32x4 pwA0, pwA1, pwB0, pwB1;
            AT_SOFTMAX(pA, mA, lA, oA0, oA1, pwA0, pwA1);
            AT_SOFTMAX(pB, mB, lB, oB0, oB1, pwB0, pwB1);
            const LAS unsigned char* vb = sb + AT_VOFF + r32 * AT_VROW + hi * 8 + hh * 64;
#pragma unroll
            for (int ks = 0; ks < 2; ++ks) {
                const s16x4 lo0 = *(const LAS s16x4*)(vb + ks * 32), hi0 = *(const LAS s16x4*)(vb + ks * 32 + 16);
                const s16x4 lo1 = *(const LAS s16x4*)(vb + 32 * AT_VROW + ks * 32), hi1 = *(const LAS s16x4*)(vb + 32 * AT_VROW + ks * 32 + 16);
                const bf16x8 va0 = __builtin_shufflevector(lo0, hi0, 0, 1, 2, 3, 4, 5, 6, 7), va1 = __builtin_shufflevector(lo1, hi1, 0, 1, 2, 3, 4, 5, 6, 7);
                const bf16x8 pa = __builtin_bit_cast(bf16x8, ks ? pwA1 : pwA0), pb = __builtin_bit_cast(bf16x8, ks ? pwB1 : pwB0);
                oA0 = MFMA32(va0, pa, oA0); oA1 = MFMA32(va1, pa, oA1); oB0 = MFMA32(va0, pb, oB0); oB1 = MFMA32(va1, pb, oB1);
            }
        }
        slot = slot == 2 ? 0 : slot + 1; nslot = nslot == 2 ? 0 : nslot + 1;
    }
    asm volatile("s_waitcnt lgkmcnt(0)\n\ts_barrier" ::: "memory");
    {   const float inv = 1.f / (lA + __shfl_xor(lA, 32));
        GAS bf16_t* op = A2 + (size_t)(b * SEQ + q0 + r32) * DM + 512 + h * 64 + 4 * hi;
#pragma unroll
        for (int g = 0; g < 4; ++g) { u32x2 w0, w1; w0.x = pk2(oA0[4 * g] * inv, oA0[4 * g + 1] * inv); w0.y = pk2(oA0[4 * g + 2] * inv, oA0[4 * g + 3] * inv);
            w1.x = pk2(oA1[4 * g] * inv, oA1[4 * g + 1] * inv); w1.y = pk2(oA1[4 * g + 2] * inv, oA1[4 * g + 3] * inv);
            *(GAS u32x2*)(op + 8 * g) = w0; *(GAS u32x2*)(op + 32 + 8 * g) = w1; } }
    {   const float inv = 1.f / (lB + __shfl_xor(lB, 32));
        GAS bf16_t* op = A2 + (size_t)(b * SEQ + q0 + 32 + r32) * DM + 512 + h * 64 + 4 * hi;
#pragma unroll
        for (int g = 0; g < 4; ++g) { u32x2 w0, w1; w0.x = pk2(oB0[4 * g] * inv, oB0[4 * g + 1] * inv); w0.y = pk2(oB0[4 * g + 2] * inv, oB0[4 * g + 3] * inv);
            w1.x = pk2(oB1[4 * g] * inv, oB1[4 * g + 1] * inv); w1.y = pk2(oB1[4 * g + 2] * inv, oB1[4 * g + 3] * inv);
            *(GAS u32x2*)(op + 8 * g) = w0; *(GAS u32x2*)(op + 32 + 8 * g) = w1; } }
#undef AT_ISSUE
}
__device__ __forceinline__ void p7_rows(const GAS float* __restrict__ x, const GAS float* __restrict__ g_post, const GAS float* __restrict__ g_pre, GAS float* __restrict__ out, const GAS float* __restrict__ mod, const GAS bf16_t* __restrict__ Y, GAS bf16_t* __restrict__ H2, int gw, int NGW, int lane) {
    for (int m0 = 2 * gw; m0 < MLAT; m0 += 2 * NGW) {
        const GAS float* md = mod + (m0 >> 13) * NMOD;
        f32x4 y[2][4], xv[2][4]; float ss[2];
#pragma unroll
        for (int r = 0; r < 2; ++r) { ss[r] = 0.f;
#pragma unroll
            for (int j = 0; j < 4; ++j) { const u32x2 w = *(const GAS u32x2*)(Y + (size_t)(m0 + r) * DM + 4 * lane + 256 * j); xv[r][j] = *(const GAS f32x4*)(x + (size_t)(m0 + r) * DM + 4 * lane + 256 * j);
                y[r][j] = (f32x4){bflo(w.x), bfhi(w.x), bflo(w.y), bfhi(w.y)}; ss[r] += y[r][j].x * y[r][j].x + y[r][j].y * y[r][j].y + y[r][j].z * y[r][j].z + y[r][j].w * y[r][j].w; } }
#pragma unroll
        for (int r = 0; r < 2; ++r) { const int m = m0 + r;
            const float rs = rsqrtf(wave_sum(ss[r]) * (1.f / DM) + EPS); float s2 = 0.f;
#pragma unroll
            for (int j = 0; j < 4; ++j) { const int k = 4 * lane + 256 * j;
                const f32x4 gg = *(const GAS f32x4*)(g_post + k), gt = *(const GAS f32x4*)(md + 2 * DM + k);
                xv[r][j] = xv[r][j] + gt * (y[r][j] * rs * gg); *(GAS f32x4*)(out + (size_t)m * DM + k) = xv[r][j];
                s2 += xv[r][j].x * xv[r][j].x + xv[r][j].y * xv[r][j].y + xv[r][j].z * xv[r][j].z + xv[r][j].w * xv[r][j].w; }
            const float rs2 = rsqrtf(wave_sum(s2) * (1.f / DM) + EPS);
#pragma unroll
            for (int j = 0; j < 4; ++j) { const int k = 4 * lane + 256 * j;
                const f32x4 gg = *(const GAS f32x4*)(g_pre + k), sh = *(const GAS f32x4*)(md + 3 * DM + k), sc = *(const GAS f32x4*)(md + 4 * DM + k);
                const f32x4 hh = xv[r][j] * rs2 * gg * (sc + 1.f) + sh;
                u32x2 o; o.x = pk2(hh.x, hh.y); o.y = pk2(hh.z, hh.w); *(GAS u32x2*)(H2 + (size_t)m * DM + k) = o; } }
    }
}
__device__ __forceinline__ void p11_rows(const GAS float* __restrict__ g_post, GAS float* __restrict__ out, const GAS float* __restrict__ mod, const GAS bf16_t* __restrict__ Fb, int gw, int NGW, int lane) {
    for (int m0 = 2 * gw; m0 < MLAT; m0 += 2 * NGW) {
        const GAS float* md = mod + (m0 >> 13) * NMOD;
        f32x4 y[2][4], xv[2][4]; float ss[2];
#pragma unroll
        for (int r = 0; r < 2; ++r) { ss[r] = 0.f;
#pragma unroll
            for (int j = 0; j < 4; ++j) { const u32x2 w = *(const GAS u32x2*)(Fb + (size_t)(m0 + r) * DM + 4 * lane + 256 * j); xv[r][j] = *(const GAS f32x4*)(out + (size_t)(m0 + r) * DM + 4 * lane + 256 * j);
                y[r][j] = (f32x4){bflo(w.x), bfhi(w.x), bflo(w.y), bfhi(w.y)}; ss[r] += y[r][j].x * y[r][j].x + y[r][j].y * y[r][j].y + y[r][j].z * y[r][j].z + y[r][j].w * y[r][j].w; } }
#pragma unroll
        for (int r = 0; r < 2; ++r) { const float rs = rsqrtf(wave_sum(ss[r]) * (1.f / DM) + EPS);
#pragma unroll
            for (int j = 0; j < 4; ++j) { const int k = 4 * lane + 256 * j;
                const f32x4 gg = *(const GAS f32x4*)(g_post + k), gt = *(const GAS f32x4*)(md + 5 * DM + k);
                *(GAS f32x4*)(out + (size_t)(m0 + r) * DM + k) = xv[r][j] + gt * (y[r][j] * rs * gg); } }
    }
}
__device__ __forceinline__ void convgate_phase(const GAS float* __restrict__ cw, const GAS float* __restrict__ cb, const GAS bf16_t* __restrict__ UP, GAS bf16_t* __restrict__ G, int half, int gtid, int NT) {
    constexpr int JG = DFF / 8, RG = 32, NTASK = (MLAT / 2 / RG) * JG;
    for (int task = gtid; task < NTASK; task += NT) {
        const int jg = task % JG, rg = task / JG, j0 = jg * 8, r0 = rg * RG, m0 = half * (MLAT / 2) + r0;
        float wu[3][8], wg[3][8], bu[8], bg[8];
#pragma unroll
        for (int k = 0; k < 3; ++k)
#pragma unroll
            for (int i = 0; i < 8; ++i) { wu[k][i] = cw[k * 2 * DFF + j0 + i]; wg[k][i] = cw[k * 2 * DFF + DFF + j0 + i]; }
#pragma unroll
        for (int i = 0; i < 8; ++i) { bu[i] = cb[j0 + i]; bg[i] = cb[DFF + j0 + i]; }
        const GAS bf16_t* up = UP + (size_t)r0 * (2 * DFF) + j0;
        u32x4 pu = {0u, 0u, 0u, 0u}, pg = {0u, 0u, 0u, 0u}, cu, cg_, nu, ng;
        if ((m0 & 8191) != 0) { pu = *(const GAS u32x4*)(up - 2 * DFF); pg = *(const GAS u32x4*)(up - 2 * DFF + DFF); }
        cu = *(const GAS u32x4*)(up); cg_ = *(const GAS u32x4*)(up + DFF);
#pragma unroll 8
        for (int r = 0; r < RG; ++r) {
            const bool nv = (r + 1 < RG) || (((m0 + RG) & 8191) != 0);
            if (nv) { nu = *(const GAS u32x4*)(up + (size_t)(r + 1) * (2 * DFF)); ng = *(const GAS u32x4*)(up + (size_t)(r + 1) * (2 * DFF) + DFF); } else { nu = (u32x4){0u, 0u, 0u, 0u}; ng = nu; }
            float o[8];
#pragma unroll
            for (int i = 0; i < 8; ++i) { const int w_ = i >> 1;
                const float p_u = (i & 1) ? bfhi(pu[w_]) : bflo(pu[w_]), c_u = (i & 1) ? bfhi(cu[w_]) : bflo(cu[w_]), n_u = (i & 1) ? bfhi(nu[w_]) : bflo(nu[w_]);
                const float p_g = (i & 1) ? bfhi(pg[w_]) : bflo(pg[w_]), c_g = (i & 1) ? bfhi(cg_[w_]) : bflo(cg_[w_]), n_g = (i & 1) ? bfhi(ng[w_]) : bflo(ng[w_]);
                const float uv = bu[i] + wu[0][i] * p_u + wu[1][i] * c_u + wu[2][i] * n_u, gv = bg[i] + wg[0][i] * p_g + wg[1][i] * c_g + wg[2][i] * n_g;
                o[i] = gv * __builtin_amdgcn_rcpf(1.f + __builtin_amdgcn_exp2f(-1.4426950408889634f * gv)) * uv; }
            u32x4 w; w.x = pk2(o[0], o[1]); w.y = pk2(o[2], o[3]); w.z = pk2(o[4], o[5]); w.w = pk2(o[6], o[7]);
            *(GAS u32x4*)(G + (size_t)(r0 + r) * DFF + j0) = w;
            pu = cu; pg = cg_; cu = nu; cg_ = ng;
        }
    }
}
constexpr int NPH = 17;
__global__ void __launch_bounds__(512, 2) fwd_kernel(Args a) {
    extern __shared__ __attribute__((aligned(16))) unsigned char lds_raw[];
    LAS unsigned char* lds = (LAS unsigned char*)lds_raw;
    const int lo = a.ph_lo, hi_ = a.ph_hi;
#if MK_COOP
    cg::grid_group grid = cg::this_grid();
#endif
    typedef pg8::EpiBf16<0> EpiB;
    constexpr int MH = MLAT / 2;
#ifndef REPMASK
#define REPMASK 0
#endif
    bool repeated = false;
#pragma unroll 1
    for (int ph = lo; ph < hi_; ++ph) {
        int tid = threadIdx.x; asm volatile("" : "+v"(tid));
        int G = gridDim.x, bx = blockIdx.x; asm volatile("" : "+s"(G), "+s"(bx));
        const int lane = tid & 63, wave = __builtin_amdgcn_readfirstlane(tid >> 6);
        const int vcu = (G % 8 == 0) ? (bx % 8) * (G / 8) + bx / 8 : bx;
        const int gw = vcu * 8 + wave, NGW = G * 8, gtid = bx * 512 + tid, NTH = G * 512;
        unsigned char* ws_ = a.ws; asm volatile("" : "+s"(ws_)); GAS unsigned char* ws = (GAS unsigned char*)ws_;
        GAS float* mod = (GAS float*)(ws + WS_MOD); GAS float* ssq = (GAS float*)(ws + WS_SSQ); GAS float* sskv = (GAS float*)(ws + WS_SSKV);
        GAS bf16_t* Win = (GAS bf16_t*)(ws + WS_WIN); GAS bf16_t* Wq = (GAS bf16_t*)(ws + WS_WQ); GAS bf16_t* Wkv = (GAS bf16_t*)(ws + WS_WKV); GAS bf16_t* Wg = (GAS bf16_t*)(ws + WS_WG);
        GAS bf16_t* Wout = (GAS bf16_t*)(ws + WS_WOUT); GAS bf16_t* Wup = (GAS bf16_t*)(ws + WS_WUP); GAS bf16_t* Wdn = (GAS bf16_t*)(ws + WS_WDN);
        GAS f32x2* AGG = (GAS f32x2*)(ws + WS_AGG); GAS float* RT = (GAS float*)(ws + WS_ROPE);
        GAS bf16_t* H = (GAS bf16_t*)(ws + WS_R1); GAS bf16_t* KVR = H; GAS bf16_t* H2 = H; GAS bf16_t* Qb = (GAS bf16_t*)(ws + WS_Q);
        GAS bf16_t* P = (GAS bf16_t*)(ws + WS_R2); GAS bf16_t* Y = P; GAS bf16_t* Fb = P;
        GAS unsigned* LU = (GAS unsigned*)(ws + WS_LU); GAS bf16_t* Kb = (GAS bf16_t*)(ws + WS_K); GAS bf16_t* Vb = (GAS bf16_t*)(ws + WS_V); GAS bf16_t* A2 = (GAS bf16_t*)(ws + WS_A2); GAS bf16_t* QR = A2;
        GAS bf16_t* UP = (GAS bf16_t*)(ws + WS_UP); GAS bf16_t* Gb = (GAS bf16_t*)(ws + WS_G);
        float* outp_ = a.out; asm volatile("" : "+s"(outp_)); GAS float* outp = (GAS float*)outp_;
        pg8::Gemm g{nullptr, nullptr, 0, 0, 0, 0, 0}; GAS bf16_t* O = nullptr; int ldc = 0;
        switch (ph) {
            case 2:  g = pg8::Gemm{(const bf16_t*)(H), (const bf16_t*)(Win), MALL, PW, DM, DM, DM}; O = P; ldc = PW; break;
            case 4:  g = pg8::Gemm{(const bf16_t*)(P + 1024), (const bf16_t*)(Wq), MLAT, 768, 256, PW, 256}; O = QR; ldc = 768; break;
            case 5:  g = pg8::Gemm{(const bf16_t*)(P + 1280), (const bf16_t*)(Wkv), MALL, 1024, 256, PW, 256}; O = KVR; ldc = 1024; break;
            case 8:  g = pg8::Gemm{(const bf16_t*)(A2), (const bf16_t*)(Wout), MLAT, DM, DM, DM, DM}; O = Y; ldc = DM; break;
            case 10: g = pg8::Gemm{(const bf16_t*)(H2), (const bf16_t*)(Wup), MH, 2 * DFF, DM, DM, DM}; O = UP; ldc = 2 * DFF; break;
            case 13: g = pg8::Gemm{(const bf16_t*)(H2 + (size_t)MH * DM), (const bf16_t*)(Wup), MH, 2 * DFF, DM, DM, DM}; O = UP; ldc = 2 * DFF; break;
            case 12: g = pg8::Gemm{(const bf16_t*)(Gb), (const bf16_t*)(Wdn), MH, DM, DFF, DFF, DFF}; O = Fb; ldc = DM; break;
            case 15: g = pg8::Gemm{(const bf16_t*)(Gb), (const bf16_t*)(Wdn), MH, DM, DFF, DFF, DFF}; O = Fb + (size_t)MH * DM; ldc = DM; break;
            default: break;
        }
        if (g.A != nullptr) {
            pg8::StaticOrder S; S.init(g.M, g.N, G, bx); EpiB E{(bf16_t*)O, ldc, nullptr, 0, 0, 1.f};
            pg8::gemm_phase<EpiB, pg8::StaticOrder, true, true>(lds, g, S, E, tid);
        }
#ifndef NGM
#define NGM 0x1ffff
#endif
#define NG(k) ((NGM >> (k)) & 1)
        else if (NG(0) && ph == 0) {
            prep_mat<0>(argp(10), nullptr, Win, 1536, 1024, gtid, NTH); prep_mat<1>(argp(18), argp(19), Wq, 768, 256, gtid, NTH); prep_mat<2>(argp(20), argp(21), Wkv, 1024, 256, gtid, NTH);
            prep_mat<3>(argp(13), argp(15), Wg, 2048, 64, gtid, NTH); prep_mat<4>(argp(22), nullptr, Wout, 1024, 1024, gtid, NTH); prep_mat<5>(argp(23), nullptr, Wup, 5632, 1024, gtid, NTH);
            prep_mat<6>(argp(26), nullptr, Wdn, 1024, 2816, gtid, NTH);
            if (gtid < 1024) { const int pos = gtid >> 3, j = gtid & 7; const float invf[8] = {1.f, 0.31622776601683794f, 0.1f, 0.031622776601683794f, 0.01f, 0.0031622776601683794f, 0.001f, 0.00031622776601683794f};
                const float ang = (float)pos * invf[j]; RT[2 * gtid] = cosf(ang); RT[2 * gtid + 1] = sinf(ang); }
            mod_phase(argp(1), argp(3), argp(4), argp(5), mod, (LAS float*)(lds + wave * 4096), gw, NGW, lane);
        } else if (NG(1) && ph == 1) {
            p1_rows(argp(0), argp(2), argp(6), mod, H, gw, NGW, lane);
        } else if (NG(3) && ph == 3) {
            gates_phase(argp(11), argp(12), argp(14), argp(16), argp(17), lds, P, Wg, LU, wave, lane);
            ss_phase(P, ssq, sskv, gw, NGW, lane);
        } else if (NG(6) && ph == 6) {
            scan_agg(LU, AGG, gw, NGW, lane); krope_phase(P, Kb, RT, gtid, NTH); qpost_phase(QR, ssq, RT, Qb, gtid, NTH); kvpost_phase(KVR, sskv, Kb, Vb, gtid, NTH);
        } else if (NG(7) && ph == 7) {
            scan_final(LU, AGG, P, A2, gw, NGW, lane);
            const int upb = (NB * 8 * 16 + G - 1) / G, u0 = vcu * upb, u1 = min(NB * 8 * 16, u0 + upb);
            __syncthreads();
            for (int unit = u0; unit < u1; ++unit) { const int bh = unit >> 4, qb = unit & 15; attn_unit(lds, Qb, Kb, Vb, A2, bh >> 3, bh & 7, qb, tid, wave, lane); }
        } else if (NG(9) && ph == 9) {
            p7_rows(argp(0), argp(7), argp(8), outp, mod, Y, H2, gw, NGW, lane);
        } else if (NG(11) && (ph == 11 || ph == 14)) {
            convgate_phase(argp(24), argp(25), UP, Gb, ph == 14 ? 1 : 0, gtid, NTH);
        } else if (NG(16) && ph == 16) {
            p11_rows(argp(9), outp, mod, Fb, gw, NGW, lane);
        }
        __syncthreads();
#if MK_COOP
        if (ph + 1 < hi_ && ph != 3 && ph != 4) grid.sync();
#endif
        if (REPMASK) { if (((REPMASK >> ph) & 1) && !repeated) { repeated = true; --ph; } else repeated = false; }
    }
}

extern "C" void kernel_launch(void* const* d_in, const int* in_sizes, int n_in, void* d_out, int out_size, void* d_ws, size_t ws_size, hipStream_t stream) {
    static int grid = 0;
    if (grid == 0) {
        if (n_in != 27 || out_size != MLAT * DM || ws_size < WS_END) { fprintf(stderr, "kernel_launch: unexpected shapes (n_in %d, out %d, ws %zu)\n", n_in, out_size, ws_size); grid = -1; return; }
        int dev = 0, cus = 0, per_cu = 0;
        if (hipGetDevice(&dev) != hipSuccess || hipDeviceGetAttribute(&cus, hipDeviceAttributeMultiprocessorCount, dev) != hipSuccess) { grid = -1; return; }
        if (hipFuncSetAttribute((const void*)fwd_kernel, hipFuncAttributeMaxDynamicSharedMemorySize, LDS_BYTES) != hipSuccess) { fprintf(stderr, "kernel_launch: hipFuncSetAttribute failed\n"); grid = -1; return; }
        if (hipOccupancyMaxActiveBlocksPerMultiprocessor(&per_cu, (const void*)fwd_kernel, 512, LDS_BYTES) != hipSuccess || per_cu < 1) { fprintf(stderr, "kernel_launch: occupancy query says %d\n", per_cu); }
        (void)hipGetLastError();
        grid = cus;
    }
    if (grid < 0) return;
    (void)hipMemsetAsync((char*)d_ws + WS_CTL, 0, CTL_BYTES, stream);
    Args a{};
    for (int i = 0; i < 27; ++i) a.in[i] = (const float*)d_in[i];
    a.out = (float*)d_out; a.ws = (unsigned char*)d_ws;
#if MK_COOP
    a.ph_lo = 0; a.ph_hi = NPH;
    void* args[] = {&a};
    hipError_t e = hipLaunchCooperativeKernel((const void*)fwd_kernel, dim3(grid), dim3(512), args, LDS_BYTES, stream);
    if (e != hipSuccess) fprintf(stderr, "kernel_launch: cooperative launch failed: %s (grid %d)\n", hipGetErrorString(e), grid);
#else
    for (int p = 0; p < NPH; ++p) { a.ph_lo = p; a.ph_hi = p + 1; hipLaunchKernelGGL(fwd_kernel, dim3(grid), dim3(512), LDS_BYTES, stream, a); }
#endif
}
```

```cpp
#include <hip/hip_runtime.h>
#include <hip/hip_cooperative_groups.h>
#include <cstdio>
#include <cstdint>
namespace cg = cooperative_groups;
#ifndef MK_COOP
#define MK_COOP 1
#endif
namespace pg8 {
#define PG8_LAS __attribute__((address_space(3)))
typedef unsigned short bf16_t;
typedef short bf16x8 __attribute__((ext_vector_type(8)));
typedef float f32x4 __attribute__((ext_vector_type(4)));
typedef unsigned u32x4 __attribute__((ext_vector_type(4)));
constexpr int BM = 256, BK = 64, HALF = 128, HTB = HALF * BK * 2  , STAGE_BYTES = 8 * HTB, NXCD = 8, WGM = 8;

__host__ __device__ __forceinline__ int lds_byte(int r, int c) { const int st = (r >> 4) * 2 + (c >> 5), rr = r & 15, cc = c & 31, ob = rr * 64 + cc * 2; return st * 1024 + (ob ^ (((ob >> 9) & 1) << 5)); }
__host__ __device__ __forceinline__ void stage_rc(int b, int& R, int& C) { const int st = b / 1024, sb = b % 1024, swz = sb ^ (((sb >> 9) & 1) << 5); R = (st >> 1) * 16 + swz / 64; C = (st & 1) * 32 + (swz % 64) / 2; }
__host__ __device__ __forceinline__ int perm32(int rho) { const int n = rho >> 4, i = rho & 15; return 8 * (i >> 2) + 4 * n + (i & 3); }

struct Unit { int pm, pn; };
struct Gemm { const bf16_t* A; const bf16_t* Bt; int M, N, K, lda, ldb; };

struct StaticOrder {
    int nM, nN, nwg, G, c;
    __host__ __device__ void init(int M, int N, int G_, int c_) { nM = M / BM; nN = N / BM; nwg = nM * nN; G = G_; c = c_; }
    __host__ __device__ bool next(int i, Unit& u) const {
        const long L = (long)i * G + c; if (L >= nwg) return false;
        int wgid = (int)L; { const int q = nwg / NXCD, r = nwg % NXCD, xcd = wgid % NXCD, off = wgid / NXCD; wgid = (xcd < r ? xcd * (q + 1) : r * (q + 1) + (xcd - r) * q) + off; }
        const int nig = WGM * nN, gid = wgid / nig, fm = gid * WGM, gsz = (nM - fm) < WGM ? (nM - fm) : WGM;
        u.pm = fm + ((wgid % nig) % gsz); u.pn = (wgid % nig) / gsz; return true;
    }
    __device__ __forceinline__ void a_ready(const Unit&) const {}
    __device__ __forceinline__ void done(const Unit&) const {}
};

__device__ __forceinline__ unsigned cvt_pk_bf16(float lo, float hi) { unsigned r; asm volatile("v_cvt_pk_bf16_f32 %0, %1, %2" : "=v"(r) : "v"(lo), "v"(hi)); return r; }
typedef float f32x2 __attribute__((ext_vector_type(2)));
__device__ __forceinline__ f32x2 gelu_pk(f32x2 v) {
    const f32x2 av = __builtin_elementwise_abs(v), d = av * 0.2316418882f + 1.0f;
    f32x2 t; t.x = __builtin_amdgcn_rcpf(d.x); t.y = __builtin_amdgcn_rcpf(d.y);
    f32x2 q = t * 0.5307027145f + (-0.7265760135f); q = q * t + 0.7107068705f; q = q * t + (-0.142248368f); q = q * t + 0.127414796f; q = q * t;
    const f32x2 s = (v * v) * (-0.72134752044f);
    f32x2 e; e.x = __builtin_amdgcn_exp2f(s.x); e.y = __builtin_amdgcn_exp2f(s.y);
    const f32x2 m = v * (q * e), r = v - m;
    f32x2 o; o.x = v.x < 0.f ? m.x : r.x; o.y = v.y < 0.f ? m.y : r.y; return o;
}

template <int ACT  > struct EpiBf16 {
    static constexpr bool PERM = true, AFTER_DRAIN = false; static_assert(ACT == 0 || ACT == 1, "EpiBf16: ACT is 0 (none) or 1 (gelu_pk)");
    bf16_t* O; int ldc; const float* bias; int split_cols; size_t split_stride; float scale0;
    __device__ __forceinline__ void operator()(const f32x4 (&acc)[2][2][4][2], const Unit& u, int wr, int wc, int fr, int fq) const {
        const int row0 = u.pm * BM + wr * 64 + fr; int colt = u.pn * BM; bf16_t* base = O;
        float sc = 1.f; if (split_cols) { const int t = colt / split_cols; base += (size_t)t * split_stride; colt -= t * split_cols; if (t == 0) sc = scale0; }
        const int col0 = colt + wc * 32 + 8 * fq, bcol0 = u.pn * BM + wc * 32 + 8 * fq;
        f32x4 bv[2][2];
#pragma unroll
        for (int bj = 0; bj < 2; ++bj)
#pragma unroll
            for (int n = 0; n < 2; ++n) bv[bj][n] = bias ? *(const f32x4*)(bias + bcol0 + bj * HALF + 4 * n) : (f32x4){0.f, 0.f, 0.f, 0.f};
#pragma unroll
        for (int ai = 0; ai < 2; ++ai)
#pragma unroll
            for (int m = 0; m < 4; ++m) { bf16_t* rowp = base + (size_t)(row0 + ai * HALF + m * 16) * ldc + col0;
#pragma unroll
                for (int bj = 0; bj < 2; ++bj) { f32x4 v0 = acc[ai][bj][m][0] + bv[bj][0], v1 = acc[ai][bj][m][1] + bv[bj][1];
                    if (ACT == 1) { f32x2 a = gelu_pk((f32x2){v0[0], v0[1]}), b = gelu_pk((f32x2){v0[2], v0[3]}), c = gelu_pk((f32x2){v1[0], v1[1]}), d = gelu_pk((f32x2){v1[2], v1[3]});
                        v0 = (f32x4){a.x, a.y, b.x, b.y}; v1 = (f32x4){c.x, c.y, d.x, d.y}; }
                    v0 = v0 * sc; v1 = v1 * sc; u32x4 w; w.x = cvt_pk_bf16(v0[0], v0[1]); w.y = cvt_pk_bf16(v0[2], v0[3]); w.z = cvt_pk_bf16(v1[0], v1[1]); w.w = cvt_pk_bf16(v1[2], v1[3]);
                    *(__attribute__((address_space(1))) u32x4*)(rowp + bj * HALF) = w; } }
    }
};
template <class Epi, class Sched, bool ALIGN_EPI = false, bool SP2 = false>
__device__ __forceinline__ void gemm_phase(PG8_LAS unsigned char* lds, const Gemm g, const Sched& S, const Epi& E, const int tid) {
    const int wid = __builtin_amdgcn_readfirstlane(tid >> 6), lane = tid & 63, wr = wid >> 2, wc = wid & 3, fr = lane & 15, fq = lane >> 4;
    const int K = g.K, nt = K / BK;
    unsigned voffA[2], voffB[2];
#pragma unroll
    for (int i = 0; i < 2; ++i) { int R, C; stage_rc(tid * 16 + i * 8192, R, C); const int Rb = Epi::PERM ? ((R & ~31) + perm32(R & 31)) : R;
        voffA[i] = (unsigned)(R * g.lda + C) * 2u; voffB[i] = (unsigned)(Rb * g.ldb + C) * 2u; }
    const size_t kstep = (size_t)(BK * 2);
    const size_t hstepA = (size_t)HALF * g.lda * 2, hstepB = (size_t)HALF * g.ldb * 2;
    const size_t tstepA = 2 * hstepA, tstepB = 2 * hstepB;
    const unsigned ldsw = (unsigned)wid * 1024u;
    const int aoff = lds_byte(wr * 64 + fr, fq * 8), boff = lds_byte(wc * 32 + fr, fq * 8);
#define PG8_SA(b, h) (((b) * 2 + (h)) * HTB)
#define PG8_SB(b, h) ((4 + (b) * 2 + (h)) * HTB)
#define PG8_STAGE(bufoff, gbase, voff) do { _Pragma("unroll") for (int _i = 0; _i < 2; ++_i) \
        __builtin_amdgcn_global_load_lds((const unsigned*)((const char*)(gbase) + (voff)[_i]), (PG8_LAS unsigned*)(lds + (bufoff) + ldsw + _i * 8192), 16, 0, 0); } while (0)
#define PG8_LDA(dst, b, h) do { _Pragma("unroll") for (int m = 0; m < 4; ++m) _Pragma("unroll") for (int k = 0; k < 2; ++k) dst[m][k] = *(const PG8_LAS bf16x8*)(lds + PG8_SA(b, h) + aoff + m * 2048 + k * 1024); } while (0)
#define PG8_LDB(dst, b, h) do { _Pragma("unroll") for (int n = 0; n < 2; ++n) _Pragma("unroll") for (int k = 0; k < 2; ++k) dst[n][k] = *(const PG8_LAS bf16x8*)(lds + PG8_SB(b, h) + boff + n * 2048 + k * 1024); } while (0)
#define PG8_MMA(ai, bj, At, Bt) do { __builtin_amdgcn_s_setprio(1); _Pragma("unroll") for (int m = 0; m < 4; ++m) _Pragma("unroll") for (int n = 0; n < 2; ++n) _Pragma("unroll") for (int k = 0; k < 2; ++k) \
        acc[ai][bj][m][n] = __builtin_amdgcn_mfma_f32_16x16x32_bf16(Bt[n][k], At[m][k], acc[ai][bj][m][n], 0, 0, 0); __builtin_amdgcn_s_setprio(0); } while (0)
#define PG8_WAIT_V(n) asm volatile("s_waitcnt vmcnt(" #n ")" ::: "memory")
#define PG8_WAIT_L(n) asm volatile("s_waitcnt lgkmcnt(" #n ")" ::: "memory")
#define PG8_BAR __builtin_amdgcn_s_barrier()
#define PG8_SCHED __builtin_amdgcn_sched_barrier(0)
    Unit cur, nxt; int ui = 0;
    if (!S.next(0, cur)) return;
    f32x4 acc[2][2][4][2];
#pragma unroll
    for (int a = 0; a < 2; ++a)
#pragma unroll
        for (int b = 0; b < 2; ++b)
#pragma unroll
            for (int m = 0; m < 4; ++m)
#pragma unroll
                for (int n = 0; n < 2; ++n) acc[a][b][m][n] = (f32x4){0.f, 0.f, 0.f, 0.f};
    bf16x8 At[4][2], B0[2][2], B1[2][2];
    const char* cA = (const char*)g.A + (size_t)cur.pm * tstepA; const char* cB = (const char*)g.Bt + (size_t)cur.pn * tstepB;
    S.a_ready(cur);
    if constexpr (SP2) {
        PG8_STAGE(PG8_SB(0, 0), cB, voffB); PG8_STAGE(PG8_SB(0, 1), cB + hstepB, voffB); PG8_STAGE(PG8_SA(0, 0), cA, voffA); PG8_STAGE(PG8_SA(0, 1), cA + hstepA, voffA);
        if (wr == 1) PG8_BAR;
        PG8_WAIT_V(2); PG8_BAR;
        PG8_STAGE(PG8_SB(1, 0), cB + kstep, voffB); PG8_STAGE(PG8_SA(1, 0), cA + kstep, voffA); PG8_STAGE(PG8_SB(1, 1), cB + hstepB + kstep, voffB);
        PG8_WAIT_V(6); PG8_BAR;
    } else {
        PG8_STAGE(PG8_SB(0, 0), cB, voffB); PG8_STAGE(PG8_SA(0, 0), cA, voffA); PG8_STAGE(PG8_SB(0, 1), cB + hstepB, voffB); PG8_STAGE(PG8_SA(0, 1), cA + hstepA, voffA);
        if (wr == 1) PG8_BAR;
        PG8_WAIT_V(4); PG8_BAR;
        PG8_STAGE(PG8_SB(1, 0), cB + kstep, voffB); PG8_STAGE(PG8_SA(1, 0), cA + kstep, voffA); PG8_STAGE(PG8_SB(1, 1), cB + hstepB + kstep, voffB);
        PG8_WAIT_V(6); PG8_BAR;
    }
    for (;;) {
        const bool has_next = S.next(ui + 1, nxt);
        const char* nA = has_next ? (const char*)g.A + (size_t)nxt.pm * tstepA : cA; const char* nB = has_next ? (const char*)g.Bt + (size_t)nxt.pn * tstepB : cB;
        for (int t = 0; t < nt; t += 2) {
            const bool last = (t == nt - 2);
            const char* a1 = cA + (size_t)(t + 1) * kstep;
            const char* a2 = last ? nA : cA + (size_t)(t + 2) * kstep; const char* b2 = last ? nB : cB + (size_t)(t + 2) * kstep;
            const char* a3 = a2 + kstep; const char* b3 = b2 + kstep;
            if (last && has_next) S.a_ready(nxt);
            if constexpr (SP2) {
            PG8_LDB(B0, 0, 0); PG8_LDB(B1, 0, 1); PG8_SCHED; PG8_LDA(At, 0, 0); PG8_STAGE(PG8_SA(1, 1), a1 + hstepA, voffA);
            PG8_WAIT_V(8); PG8_WAIT_L(0); PG8_BAR; PG8_MMA(0, 0, At, B0); PG8_MMA(0, 1, At, B1); PG8_BAR; PG8_SCHED;
            PG8_LDA(At, 0, 1); PG8_STAGE(PG8_SB(0, 0), b2, voffB); PG8_STAGE(PG8_SB(0, 1), b2 + hstepB, voffB); PG8_STAGE(PG8_SA(0, 0), a2, voffA);
            PG8_WAIT_V(8); PG8_WAIT_L(0); PG8_BAR; PG8_MMA(1, 0, At, B0); PG8_MMA(1, 1, At, B1); PG8_BAR; PG8_SCHED;
            PG8_LDB(B0, 1, 0); PG8_LDB(B1, 1, 1); PG8_SCHED; PG8_LDA(At, 1, 0); PG8_STAGE(PG8_SA(0, 1), a2 + hstepA, voffA);
            PG8_WAIT_V(8); PG8_WAIT_L(0); PG8_BAR; PG8_MMA(0, 0, At, B0); PG8_MMA(0, 1, At, B1); PG8_BAR; PG8_SCHED;
            PG8_LDA(At, 1, 1); PG8_STAGE(PG8_SB(1, 0), b3, voffB); PG8_STAGE(PG8_SB(1, 1), b3 + hstepB, voffB); PG8_STAGE(PG8_SA(1, 0), a3, voffA);
            PG8_WAIT_V(8); PG8_WAIT_L(0); PG8_BAR; PG8_MMA(1, 0, At, B0); PG8_MMA(1, 1, At, B1); PG8_BAR; PG8_SCHED;
            } else {
            PG8_LDB(B0, 0, 0); PG8_SCHED; PG8_LDA(At, 0, 0); PG8_STAGE(PG8_SA(1, 1), a1 + hstepA, voffA);
            PG8_WAIT_L(8); PG8_BAR; PG8_WAIT_L(0); PG8_MMA(0, 0, At, B0); PG8_BAR; PG8_SCHED;
            PG8_LDB(B1, 0, 1); PG8_STAGE(PG8_SB(0, 0), b2, voffB);
            PG8_BAR; PG8_WAIT_L(0); PG8_MMA(0, 1, At, B1); PG8_BAR;
            PG8_LDA(At, 0, 1); PG8_STAGE(PG8_SA(0, 0), a2, voffA);
            PG8_BAR; PG8_WAIT_L(0); PG8_MMA(1, 0, At, B0); PG8_BAR; PG8_SCHED;
            PG8_STAGE(PG8_SB(0, 1), b2 + hstepB, voffB);
            PG8_WAIT_V(6); PG8_BAR; PG8_MMA(1, 1, At, B1); PG8_BAR;
            PG8_LDB(B0, 1, 0); PG8_SCHED; PG8_LDA(At, 1, 0); PG8_STAGE(PG8_SA(0, 1), a2 + hstepA, voffA);
            PG8_WAIT_L(8); PG8_BAR; PG8_WAIT_L(0); PG8_MMA(0, 0, At, B0); PG8_BAR; PG8_SCHED;
            PG8_LDB(B1, 1, 1); PG8_STAGE(PG8_SB(1, 0), b3, voffB);
            PG8_BAR; PG8_WAIT_L(0); PG8_MMA(0, 1, At, B1); PG8_BAR;
            PG8_LDA(At, 1, 1); PG8_STAGE(PG8_SA(1, 0), a3, voffA);
            PG8_BAR; PG8_WAIT_L(0); PG8_MMA(1, 0, At, B0); PG8_BAR; PG8_SCHED;
            PG8_STAGE(PG8_SB(1, 1), b3 + hstepB, voffB);
            PG8_WAIT_V(6); PG8_BAR; PG8_MMA(1, 1, At, B1); PG8_BAR;
            }
        }
        if constexpr (ALIGN_EPI) { if (wr == 0) PG8_BAR; }
        if constexpr (!Epi::AFTER_DRAIN) { E(acc, cur, wr, wc, fr, fq); S.done(cur); }
        if (!has_next) break;
#pragma unroll
        for (int a = 0; a < 2; ++a)
#pragma unroll
            for (int b = 0; b < 2; ++b)
#pragma unroll
                for (int m = 0; m < 4; ++m)
#pragma unroll
                    for (int n = 0; n < 2; ++n) acc[a][b][m][n] = (f32x4){0.f, 0.f, 0.f, 0.f};
        cur = nxt; cA = nA; cB = nB; ++ui;
        if constexpr (ALIGN_EPI) { if (wr == 1) PG8_BAR; }
    }
    PG8_WAIT_V(0);
    if constexpr (!ALIGN_EPI) { if (wr == 0) PG8_BAR; }
    PG8_BAR;
    if constexpr (Epi::AFTER_DRAIN) { E.fused(acc, cur, wr, wc, fr, fq, lds, wid, lane); S.done(cur); }
#undef PG8_SA
#undef PG8_SB
#undef PG8_STAGE
#undef PG8_LDA
#undef PG8_LDB
#undef PG8_MMA
#undef PG8_WAIT_V
#undef PG8_WAIT_L
#undef PG8_BAR
#undef PG8_SCHED
}
}
#define LAS __attribute__((address_space(3)))
#define GAS __attribute__((address_space(1)))
typedef unsigned short bf16_t;
typedef short bf16x8 __attribute__((ext_vector_type(8)));
typedef short s16x4 __attribute__((ext_vector_type(4)));
typedef float f32x4 __attribute__((ext_vector_type(4)));
typedef float f32x16 __attribute__((ext_vector_type(16)));
typedef unsigned u32x4 __attribute__((ext_vector_type(4)));
typedef unsigned u32x2 __attribute__((ext_vector_type(2)));
typedef float f32x2 __attribute__((ext_vector_type(2)));

constexpr int NB = 8, SEQ = 8192, DM = 1024, CTX = 256, MLAT = NB * SEQ, MCTX = NB * CTX, MALL = MLAT + MCTX;
constexpr int PW = 1536, KVLEN = CTX + SEQ, DFF = 2816, NMOD = 6 * DM;
constexpr int NCH = 32, CHL = 256;
constexpr float EPS = 1e-6f;
constexpr float QSCALE = 0.10206207261596575f * 1.4426950408889634f;
constexpr size_t MiB = 1u << 20;
constexpr size_t WS_CTL = 0, CTL_BYTES = 2 * MiB;
constexpr size_t WS_MOD = 64 * 1024, WS_SSQ = 512 * 1024, WS_SSKV = 1024 * 1024;
constexpr size_t WS_WIN = 2 * MiB, WS_WQ = 5 * MiB, WS_WKV = 6 * MiB, WS_WG = 7 * MiB, WS_WOUT = 8 * MiB, WS_WUP = 10 * MiB, WS_WDN = 21 * MiB;
constexpr size_t WS_AGG = 27 * MiB, WS_ROPE = 29 * MiB + 512 * 1024;
constexpr size_t WS_R1 = 30 * MiB;
constexpr size_t WS_R2 = 162 * MiB;
constexpr size_t WS_LU = 360 * MiB, WS_K = 624 * MiB, WS_V = 723 * MiB, WS_A2 = 789 * MiB;
constexpr size_t WS_UP = 360 * MiB, WS_G = 712 * MiB, WS_Q = 920 * MiB, WS_END = 1016 * MiB;
constexpr int LDS_BYTES = 139264;

__device__ __forceinline__ unsigned f2bf(float f) { unsigned u = __builtin_bit_cast(unsigned, f); return (u + 0x7fffu + ((u >> 16) & 1u)) >> 16; }
__device__ __forceinline__ unsigned pk2(float lo, float hi) { return f2bf(lo) | (f2bf(hi) << 16); }
__device__ __forceinline__ float bflo(unsigned w) { return __uint_as_float(w << 16); }
__device__ __forceinline__ float bfhi(unsigned w) { return __uint_as_float(w & 0xffff0000u); }
__device__ __forceinline__ float bf2f(bf16_t v) { return __uint_as_float((unsigned)v << 16); }
__device__ __forceinline__ int crow(int r, int hi) { return (r & 3) + 8 * (r >> 2) + 4 * hi; }
__device__ __forceinline__ float wave_sum(float v) {
#pragma unroll
    for (int o = 1; o < 64; o <<= 1) v += __shfl_xor(v, o);
    return v;
}
__device__ __forceinline__ float sigmoidf_(float x) { return __builtin_amdgcn_rcpf(1.f + __builtin_amdgcn_exp2f(-1.4426950408889634f * x)); }
#define LDS_WAIT() asm volatile("s_waitcnt lgkmcnt(0)" ::: "memory")

struct Args { const float* in[27]; float* out; unsigned char* ws; int ph_lo, ph_hi; };
__device__ __forceinline__ const GAS float* argp(int i) {
    const __attribute__((address_space(4))) char* kp = (const __attribute__((address_space(4))) char*)__builtin_amdgcn_kernarg_segment_ptr();
    asm volatile("" : "+s"(kp));
    const float* p = *(const float* const __attribute__((address_space(4)))*)(kp + 8 * i);
    return (const GAS float*)p;
}

template <int ID> __device__ __forceinline__ float wsrc(const GAS float* __restrict__ p0, const GAS float* __restrict__ p1, int n, int k) {
    if (ID == 0) return n < 1440 ? p0[(size_t)k * 1440 + n] : 0.f;
    if (ID == 1) return p0[k] * p1[(size_t)k * 768 + n];
    if (ID == 2) return k < 128 ? p0[k] * p1[(size_t)k * 1024 + n] : 0.f;
    if (ID == 3) { const int h = n >> 8, np = n & 255, mat = np >> 6, j = np & 63, dir = mat >> 1; const GAS float* w = (mat & 1) ? p1 : p0; return w[(size_t)((dir * 8 + h) * 64 + k) * 64 + j]; }
    if (ID == 4) return p0[(size_t)k * 1024 + n];
    if (ID == 5) return p0[(size_t)k * 5632 + n];
    return p0[(size_t)k * 1024 + n];
}
template <int ID> __device__ __forceinline__ void prep_mat(const GAS float* __restrict__ p0, const GAS float* __restrict__ p1, GAS bf16_t* __restrict__ dst, int N, int K, int gtid, int NT) {
    const int items = N * (K / 8);
    for (int it = gtid; it < items; it += NT) {
        const int n = it % N, k8 = it / N;
        u32x4 o;
        o.x = pk2(wsrc<ID>(p0, p1, n, 8 * k8 + 0), wsrc<ID>(p0, p1, n, 8 * k8 + 1)); o.y = pk2(wsrc<ID>(p0, p1, n, 8 * k8 + 2), wsrc<ID>(p0, p1, n, 8 * k8 + 3));
        o.z = pk2(wsrc<ID>(p0, p1, n, 8 * k8 + 4), wsrc<ID>(p0, p1, n, 8 * k8 + 5)); o.w = pk2(wsrc<ID>(p0, p1, n, 8 * k8 + 6), wsrc<ID>(p0, p1, n, 8 * k8 + 7));
        *(GAS u32x4*)(dst + (size_t)n * K + 8 * k8) = o;
    }
}
__device__ __forceinline__ void mod_phase(const GAS float* __restrict__ cvec, const GAS float* __restrict__ cctx, const GAS float* __restrict__ wmod, const GAS float* __restrict__ bmod, GAS float* __restrict__ mod, LAS float* scr, int gw, int NGW, int lane) {
    for (int task = gw; task < 96 * 16; task += NGW) {
        const int cgp = task % 96, kc = task / 96, n = cgp * 64 + lane, k0 = kc * 64;
#pragma unroll
        for (int r = 0; r < 9; ++r) { const float cv = r < 8 ? cvec[r * 1024 + k0 + lane] : cctx[k0 + lane]; scr[r * 64 + lane] = cv / (1.f + __expf(-cv)); }
        LDS_WAIT();
        float acc[9];
#pragma unroll
        for (int r = 0; r < 9; ++r) acc[r] = 0.f;
#pragma unroll 8
        for (int kk = 0; kk < 64; ++kk) { const float w = wmod[(size_t)(k0 + kk) * NMOD + n];
#pragma unroll
            for (int r = 0; r < 9; ++r) acc[r] += scr[r * 64 + kk] * w; }
        const float bias = kc == 0 ? bmod[n] : 0.f;
#pragma unroll
        for (int r = 0; r < 9; ++r) atomicAdd((float*)(mod + r * NMOD + n), acc[r] + bias);
        LDS_WAIT();
    }
}
__device__ __forceinline__ void p1_rows(const GAS float* __restrict__ x, const GAS float* __restrict__ ctx, const GAS float* __restrict__ g, const GAS float* __restrict__ mod, GAS bf16_t* __restrict__ H, int gw, int NGW, int lane) {
    for (int m0 = 2 * gw; m0 < MALL; m0 += 2 * NGW) {
        f32x4 v[2][4]; float ss[2];
#pragma unroll
        for (int r = 0; r < 2; ++r) { const int m = m0 + r; const GAS float* src = m < MLAT ? x + (size_t)m * DM : ctx + (size_t)(m - MLAT) * DM; ss[r] = 0.f;
#pragma unroll
            for (int j = 0; j < 4; ++j) { v[r][j] = *(const GAS f32x4*)(src + 4 * lane + 256 * j); ss[r] += v[r][j].x * v[r][j].x + v[r][j].y * v[r][j].y + v[r][j].z * v[r][j].z + v[r][j].w * v[r][j].w; } }
#pragma unroll
        for (int r = 0; r < 2; ++r) { const int m = m0 + r; const GAS float* md = mod + (m < MLAT ? (m >> 13) : 8) * NMOD;
            const float rs = rsqrtf(wave_sum(ss[r]) * (1.f / DM) + EPS);
#pragma unroll
            for (int j = 0; j < 4; ++j) { const int k = 4 * lane + 256 * j;
                const f32x4 gg = *(const GAS f32x4*)(g + k), sh = *(const GAS f32x4*)(md + k), sc = *(const GAS f32x4*)(md + DM + k);
                const f32x4 y = v[r][j] * rs * gg * (sc + 1.f) + sh;
                u32x2 o; o.x = pk2(y.x, y.y); o.y = pk2(y.z, y.w); *(GAS u32x2*)(H + (size_t)m * DM + k) = o; } }
    }
}
__device__ __forceinline__ void ss_phase(const GAS bf16_t* __restrict__ P, GAS float* __restrict__ ssq, GAS float* __restrict__ sskv, int gw, int NGW, int lane) {
#pragma unroll 4
    for (int m = gw; m < MALL; m += NGW) {
        const u32x2 q = *(const GAS u32x2*)(P + (size_t)m * PW + 1024 + 4 * lane); const unsigned k = *(const GAS unsigned*)(P + (size_t)m * PW + 1280 + 2 * lane);
        float a = bflo(q.x) * bflo(q.x) + bfhi(q.x) * bfhi(q.x) + bflo(q.y) * bflo(q.y) + bfhi(q.y) * bfhi(q.y), c = bflo(k) * bflo(k) + bfhi(k) * bfhi(k);
        a = wave_sum(a); c = wave_sum(c);
        if (lane == 0) { ssq[m] = a; sskv[m] = c; }
    }
}
__device__ __forceinline__ void qpost_phase(const GAS bf16_t* __restrict__ QR, const GAS float* __restrict__ ssq, const GAS float* __restrict__ RT, GAS bf16_t* __restrict__ Q, int gtid, int NT) {
#pragma unroll 4
    for (int task = gtid; task < MLAT * 96; task += NT) {
        const int row = task / 96, c8 = task - row * 96, h = c8 / 12, dc = c8 - h * 12, b = row >> 13, s = row & 8191;
        const float sc = rsqrtf(ssq[row] * (1.f / 256.f) + EPS) * QSCALE;
        const u32x4 mine = *(const GAS u32x4*)(QR + (size_t)row * 768 + 8 * c8);
        float v[8];
#pragma unroll
        for (int j = 0; j < 4; ++j) { v[2 * j] = bflo(mine[j]) * sc; v[2 * j + 1] = bfhi(mine[j]) * sc; }
        if (dc >= 8) { const int fq = dc - 8; const u32x4 oth = *(const GAS u32x4*)(QR + (size_t)row * 768 + 8 * (c8 ^ 1));
            const GAS float* rt = RT + (fq < 2 ? (s >> 6) : (s & 63)) * 16;
#pragma unroll
            for (int j = 0; j < 8; ++j) { const float pt = ((j & 1) ? bfhi(oth[j >> 1]) : bflo(oth[j >> 1])) * sc, cs = rt[2 * j], sn = rt[2 * j + 1];
                v[j] = (fq & 1) ? v[j] * cs + pt * sn : v[j] * cs - pt * sn; } }
        u32x4 w; w.x = pk2(v[0], v[1]); w.y = pk2(v[2], v[3]); w.z = pk2(v[4], v[5]); w.w = pk2(v[6], v[7]);
        *(GAS u32x4*)(Q + ((size_t)((b * 8 + h) * SEQ + s)) * 96 + 8 * dc) = w;
    }
}
__device__ __forceinline__ void kvpost_phase(const GAS bf16_t* __restrict__ KVR, const GAS float* __restrict__ sskv, GAS bf16_t* __restrict__ Kb, GAS bf16_t* __restrict__ Vt, int gtid, int NT) {
#pragma unroll 4
    for (int task = gtid; task < MALL * 64; task += NT) {
        const int row = task >> 6, c = task & 63, h = c >> 3, dd = (c & 7) * 8; const bool lat = row < MLAT;
        const int b = lat ? (row >> 13) : ((row - MLAT) >> 8), pos = lat ? (CTX + (row & 8191)) : ((row - MLAT) & 255);
        const float rs = rsqrtf(sskv[row] * (1.f / 128.f) + EPS);
        const u32x4 mine = *(const GAS u32x4*)(KVR + (size_t)row * 1024 + h * 128 + dd);
        u32x4 w;
#pragma unroll
        for (int j = 0; j < 4; ++j) w[j] = pk2(bflo(mine[j]) * rs, bfhi(mine[j]) * rs);
        *(GAS u32x4*)(Kb + ((size_t)(b * 8 + h) * KVLEN + pos) * 96 + dd) = w;
    }
#pragma unroll 2
    for (int task = gtid; task < (MALL / 8) * 512; task += NT) {
        const int pg = task & 7, dd = (task >> 3) & 7, rest = task >> 6, hd8 = rest & 63, rb = rest >> 6, h = hd8 >> 3, d = (hd8 & 7) * 8 + dd, row0 = rb * 64 + pg * 8; const bool lat = row0 < MLAT;
        const int b = lat ? (row0 >> 13) : ((row0 - MLAT) >> 8), pos0 = lat ? (CTX + (row0 & 8191)) : ((row0 - MLAT) & 255);
        float v[8];
#pragma unroll
        for (int i = 0; i < 8; ++i) v[i] = bf2f(KVR[(size_t)(row0 + i) * 1024 + h * 128 + 64 + d]) * rsqrtf(sskv[row0 + i] * (1.f / 128.f) + EPS);
        u32x4 w; w.x = pk2(v[0], v[1]); w.y = pk2(v[2], v[3]); w.z = pk2(v[4], v[5]); w.w = pk2(v[6], v[7]);
        *(GAS u32x4*)(Vt + ((size_t)((b * 8 + h) * 64 + d)) * KVLEN + pos0) = w;
    }
}
__device__ __forceinline__ void krope_phase(const GAS bf16_t* __restrict__ P, GAS bf16_t* __restrict__ Kb, const GAS float* __restrict__ RT, int gtid, int NT) {
#pragma unroll 2
    for (int task = gtid; task < MALL * 4; task += NT) {
        const int row = task >> 2, fq = task & 3; const bool lat = row < MLAT;
        const int b = lat ? (row >> 13) : ((row - MLAT) >> 8), s = row & 8191, pos = lat ? (CTX + s) : ((row - MLAT) & 255);
        const u32x4 mine = *(const GAS u32x4*)(P + (size_t)row * PW + 1408 + 8 * fq), oth = *(const GAS u32x4*)(P + (size_t)row * PW + 1408 + 8 * (fq ^ 1));
        float v[8], pt[8];
#pragma unroll
        for (int j = 0; j < 4; ++j) { v[2 * j] = bflo(mine[j]); v[2 * j + 1] = bfhi(mine[j]); pt[2 * j] = bflo(oth[j]); pt[2 * j + 1] = bfhi(oth[j]); }
        if (lat) { const GAS float* rt = RT + (fq < 2 ? (s >> 6) : (s & 63)) * 16;
#pragma unroll
            for (int j = 0; j < 8; ++j) { const float cs = rt[2 * j], sn = rt[2 * j + 1]; v[j] = (fq & 1) ? v[j] * cs + pt[j] * sn : v[j] * cs - pt[j] * sn; } }
        u32x4 w; w.x = pk2(v[0], v[1]); w.y = pk2(v[2], v[3]); w.z = pk2(v[4], v[5]); w.w = pk2(v[6], v[7]);
#pragma unroll
        for (int h = 0; h < 8; ++h) *(GAS u32x4*)(Kb + ((size_t)(b * 8 + h) * KVLEN + pos) * 96 + 64 + 8 * fq) = w;
    }
}
#define MFMA32(a, b, c) __builtin_amdgcn_mfma_f32_32x32x16_bf16((a), (b), (c), 0, 0, 0)
__device__ __forceinline__ void gates_phase(const GAS float* __restrict__ cw, const GAS float* __restrict__ cb, const GAS float* __restrict__ b_a, const GAS float* __restrict__ b_x, const GAS float* __restrict__ lam, LAS unsigned char* lds, const GAS bf16_t* __restrict__ P, const GAS bf16_t* __restrict__ Wg, GAS unsigned* __restrict__ LU, GAS f32x2* __restrict__ AGG, int tid, int wave, int lane) {
    LAS bf16_t* xs = (LAS bf16_t*)(lds + wave * 4608);
    LAS f32x2* wagg = (LAS f32x2*)(lds + 8 * 4608);
    const int r32 = lane & 31, hi = lane >> 5;
    for (int unit = blockIdx.x; unit < (MALL / 256) * 8; unit += gridDim.x) {
        const int pm = unit >> 3, h = unit & 7, m0 = pm * 256 + wave * 32;
        const int s0 = m0 < MLAT ? (m0 & ~8191) : (MLAT + ((m0 - MLAT) & ~255)), slen = m0 < MLAT ? SEQ : CTX;
        {
            const int tok = lane >> 1, m = m0 + tok;
#pragma unroll
            for (int c8 = 0; c8 < 4; ++c8) { const int ch = (lane & 1) * 32 + c8 * 8, gch = h * 64 + ch;
                float acc[8];
                { const f32x4 b0 = *(const GAS f32x4*)(cb + gch), b1 = *(const GAS f32x4*)(cb + gch + 4);
                  acc[0] = b0.x; acc[1] = b0.y; acc[2] = b0.z; acc[3] = b0.w; acc[4] = b1.x; acc[5] = b1.y; acc[6] = b1.z; acc[7] = b1.w; }
#pragma unroll
                for (int k = 0; k < 4; ++k) { const int mm = m + k - 2;
                    if (mm >= s0 && mm < s0 + slen) { const u32x4 xv = *(const GAS u32x4*)(P + (size_t)mm * PW + gch);
                        const f32x4 w0 = *(const GAS f32x4*)(cw + k * 512 + gch), w1 = *(const GAS f32x4*)(cw + k * 512 + gch + 4);
                        acc[0] += w0.x * bflo(xv.x); acc[1] += w0.y * bfhi(xv.x); acc[2] += w0.z * bflo(xv.y); acc[3] += w0.w * bfhi(xv.y);
                        acc[4] += w1.x * bflo(xv.z); acc[5] += w1.y * bfhi(xv.z); acc[6] += w1.z * bflo(xv.w); acc[7] += w1.w * bfhi(xv.w); } }
                u32x4 o; o.x = pk2(acc[0], acc[1]); o.y = pk2(acc[2], acc[3]); o.z = pk2(acc[4], acc[5]); o.w = pk2(acc[6], acc[7]);
                *(LAS u32x4*)(xs + tok * 72 + ch) = o; }
        }
        LDS_WAIT();
        bf16x8 afr[4];
#pragma unroll
        for (int ks = 0; ks < 4; ++ks) afr[ks] = *(const LAS bf16x8*)(xs + r32 * 72 + 16 * ks + 8 * hi);
#pragma unroll
        for (int jh = 0; jh < 2; ++jh) {
            f32x16 acc4[4];
#pragma unroll
            for (int q = 0; q < 4; ++q) {
#pragma unroll
                for (int i = 0; i < 16; ++i) acc4[q][i] = 0.f;
                const GAS bf16_t* wrow = Wg + (size_t)(h * 256 + (2 * q + jh) * 32 + r32) * 64 + 8 * hi;
#pragma unroll
                for (int ks = 0; ks < 4; ++ks) { const bf16x8 bfr = *(const GAS bf16x8*)(wrow + 16 * ks); acc4[q] = MFMA32(afr[ks], bfr, acc4[q]); }
            }
            const int ch = jh * 32 + r32, gch = h * 64 + ch;
            float ba[2], bx[2], sp[2];
#pragma unroll
            for (int d = 0; d < 2; ++d) { ba[d] = b_a[d * 512 + gch]; bx[d] = b_x[d * 512 + gch]; const float nl = -lam[d * 512 + gch];
                sp[d] = 8.f * 1.4426950408889634f * (nl > 20.f ? nl : log1pf(__expf(nl))); }
            unsigned wv[16][2];
#pragma unroll
            for (int i = 0; i < 16; ++i) { const int row = crow(i, hi); const float xv = bf2f(xs[row * 72 + ch]);
#pragma unroll
                for (int d = 0; d < 2; ++d) { const float r = sigmoidf_(acc4[2 * d][i] + ba[d]), ig = sigmoidf_(acc4[2 * d + 1][i] + bx[d]);
                    const float la2 = -r * sp[d]; const float uu = __builtin_amdgcn_sqrtf(fmaxf(1.f - __builtin_amdgcn_exp2f(2.f * la2), 0.f)) * (ig * xv);
                    wv[i][d] = pk2(la2, uu);
                    LU[((size_t)(m0 + row) * 2 + d) * 512 + gch] = wv[i][d]; } }
#pragma unroll
            for (int d = 0; d < 2; ++d) {
                float Ar[4], Ur[4];
#pragma unroll
                for (int g = 0; g < 4; ++g) { float A = 1.f, U = 0.f;
#pragma unroll
                    for (int jj = 0; jj < 4; ++jj) { const int j = d ? 3 - jj : jj; const unsigned w = wv[4 * g + j][d]; const float av = __builtin_amdgcn_exp2f(bflo(w)); A *= av; U = av * U + bfhi(w); }
                    Ar[g] = A; Ur[g] = U; }
                float A = 1.f, U = 0.f;
#pragma unroll
                for (int gg = 0; gg < 4; ++gg) { const int g = d ? 3 - gg : gg;
                    const float Ao = __shfl_xor(Ar[g], 32), Uo = __shfl_xor(Ur[g], 32);
                    if (d == 0) { U = Ar[g] * U + Ur[g]; A *= Ar[g]; U = Ao * U + Uo; A *= Ao; }
                    else        { U = Ao * U + Uo; A *= Ao; U = Ar[g] * U + Ur[g]; A *= Ar[g]; } }
                if (hi == 0) wagg[(wave * 2 + d) * 64 + ch] = (f32x2){A, U};
            }
        }
        LDS_WAIT();
        __syncthreads();
        if (tid < 128) {
            const int d = tid >> 6, ch = tid & 63; float A = 1.f, U = 0.f;
#pragma unroll
            for (int ww = 0; ww < 8; ++ww) { const int w = d ? 7 - ww : ww; const f32x2 g = wagg[(w * 2 + d) * 64 + ch]; U = g.x * U + g.y; A *= g.x; }
            const int b = pm < MLAT / 256 ? (pm >> 5) : (pm - MLAT / 256), c = pm < MLAT / 256 ? (pm & 31) : NCH;
            AGG[(size_t)((b * 2 + d) * (NCH + 1) + c) * 512 + h * 64 + ch] = (f32x2){A, U};
        }
        __syncthreads();
    }
}
__device__ __forceinline__ void scan_agg(const GAS unsigned* __restrict__ LU, GAS f32x2* __restrict__ AGG, int gw, int NGW, int lane) {
    for (int task = gw; task < NB * 2 * (NCH + 1) * 8; task += NGW) {
        const int cgp = task & 7, c = (task >> 3) % (NCH + 1), d = (task / (8 * (NCH + 1))) & 1, b = task / (16 * (NCH + 1));
        const int ch = cgp * 64 + lane, row0 = c < NCH ? b * SEQ + c * CHL : MLAT + b * CTX;
        float A = 1.f, U = 0.f;
#pragma unroll 16
        for (int t = 0; t < CHL; ++t) { const int tt = d ? CHL - 1 - t : t; const unsigned w = LU[((size_t)(row0 + tt) * 2 + d) * 512 + ch];
            const float av = __builtin_amdgcn_exp2f(bflo(w)); A *= av; U = av * U + bfhi(w); }
        AGG[(size_t)((b * 2 + d) * (NCH + 1) + c) * 512 + ch] = (f32x2){A, U};
    }
}
__device__ __forceinline__ float gelu_tanh(float x) { const float z = 0.7978845608028654f * (x + 0.044715f * x * x * x);
    return x * __builtin_amdgcn_rcpf(1.f + __builtin_amdgcn_exp2f(-2.8853900817779268f * z)); }
__device__ __forceinline__ void scan_final(const GAS unsigned* __restrict__ LU, const GAS f32x2* __restrict__ AGG, const GAS bf16_t* __restrict__ P, GAS bf16_t* __restrict__ A2, int gw, int NGW, int lane) {
    constexpr int BT = 16;
    for (int task = gw; task < NB * NCH * 8; task += NGW) {
        const int cgp = task & 7, c = (task >> 3) & (NCH - 1), b = task / (8 * NCH), ch = cgp * 64 + lane, row0 = b * SEQ + c * CHL;
        const GAS f32x2* ag0 = AGG + (size_t)((b * 2 + 0) * (NCH + 1)) * 512 + ch; const GAS f32x2* ag1 = AGG + (size_t)((b * 2 + 1) * (NCH + 1)) * 512 + ch;
        float hf = ag0[(size_t)NCH * 512].y;
        for (int cc = 0; cc < c; ++cc) { const f32x2 g = ag0[(size_t)cc * 512]; hf = g.x * hf + g.y; }
        float hb = ag1[(size_t)NCH * 512].y;
        for (int cc = NCH - 1; cc > c; --cc) { const f32x2 g = ag1[(size_t)cc * 512]; hb = g.x * hb + g.y; }
#pragma unroll 1
        for (int t0 = 0; t0 < CHL; t0 += BT) { unsigned w[BT];
#pragma unroll
            for (int i = 0; i < BT; ++i) w[i] = LU[((size_t)(row0 + t0 + i) * 2 + 0) * 512 + ch];
#pragma unroll
            for (int i = 0; i < BT; ++i) { hf = __builtin_amdgcn_exp2f(bflo(w[i])) * hf + bfhi(w[i]); A2[(size_t)(row0 + t0 + i) * DM + ch] = (bf16_t)f2bf(hf); } }
#pragma unroll 1
        for (int t0 = CHL - BT; t0 >= 0; t0 -= BT) { unsigned w[BT]; bf16_t f[BT], gr[BT];
#pragma unroll
            for (int i = 0; i < BT; ++i) { w[i] = LU[((size_t)(row0 + t0 + i) * 2 + 1) * 512 + ch]; f[i] = A2[(size_t)(row0 + t0 + i) * DM + ch]; gr[i] = P[(size_t)(row0 + t0 + i) * PW + 512 + ch]; }
#pragma unroll
            for (int i = BT - 1; i >= 0; --i) { hb = __builtin_amdgcn_exp2f(bflo(w[i])) * hb + bfhi(w[i]);
                A2[(size_t)(row0 + t0 + i) * DM + ch] = (bf16_t)f2bf((bf2f(f[i]) + hb) * gelu_tanh(bf2f(gr[i]))); } }
    }
}
constexpr int AT_KROW = 208, AT_VROW = 144;
constexpr float AT_THR = 8.f;
__device__ __forceinline__ unsigned cvtpk(float lo, float hi) { typedef float f2 __attribute__((ext_vector_type(2))); typedef __bf16 b2 __attribute__((ext_vector_type(2))); f2 v = {lo, hi}; b2 r = __builtin_convertvector(v, b2); return __builtin_bit_cast(unsigned, r); }
#define AT_SOFTMAX(P, M, L, O0, O1, PW0, PW1) do { \
        float mx_ = fmaxf(fmaxf(P[0], P[1]), fmaxf(P[2], P[3])); \
        _Pragma("unroll") for (int i_ = 4; i_ < 16; i_ += 4) mx_ = fmaxf(fmaxf(mx_, P[i_]), fmaxf(fmaxf(P[i_ + 1], P[i_ + 2]), P[i_ + 3])); \
        mx_ = fmaxf(mx_, __shfl_xor(mx_, 32)); \
        if (__any(mx_ > M + AT_THR)) { const float mn_ = fmaxf(M, mx_), al_ = __builtin_amdgcn_exp2f(M - mn_); M = mn_; L *= al_; \
            _Pragma("unroll") for (int i_ = 0; i_ < 16; ++i_) { O0[i_] *= al_; O1[i_] *= al_; } } \
        float s_ = 0.f; \
        _Pragma("unroll") for (int i_ = 0; i_ < 16; ++i_) { P[i_] = __builtin_amdgcn_exp2f(P[i_] - M); s_ += P[i_]; } \
        L += s_; \
        _Pragma("unroll") for (int j_ = 0; j_ < 4; ++j_) { PW0[j_] = cvtpk(P[2 * j_], P[2 * j_ + 1]); PW1[j_] = cvtpk(P[8 + 2 * j_], P[9 + 2 * j_]); } } while (0)
__device__ __forceinline__ void glds16(const GAS void* gsrc, unsigned lds_dst) {
    unsigned keep;
    asm volatile("s_mov_b32 %0, m0\n\ts_mov_b32 m0, %2\n\ts_nop 0\n\tglobal_load_lds_dwordx4 %1, off\n\ts_mov_b32 m0, %0" : "=&s"(keep) : "v"(gsrc), "s"(lds_dst) : "memory");
}
constexpr int AT_SLOT = 22 * 1024, AT_VOFF = 13 * 1024, AT_NP = 22;
__device__ __forceinline__ void attn_unit(LAS unsigned char* lds, const GAS bf16_t* __restrict__ QR, const GAS float* __restrict__ ssq, const GAS float* __restrict__ RT, const GAS bf16_t* __restrict__ K, const GAS bf16_t* __restrict__ Vt, GAS bf16_t* __restrict__ A2, int b, int h, int qb, int tid, int wave, int lane) {
    const int r32 = lane & 31, hi = lane >> 5, q0 = qb * 512 + wave * 64, r32s = (r32 & ~12) | ((r32 & 4) << 1) | ((r32 & 8) >> 1);
    bf16x8 qa[6], qc[6];
#pragma unroll
    for (int sub = 0; sub < 2; ++sub) {
        const int s = q0 + 32 * sub + r32, row = b * SEQ + s;
        const GAS bf16_t* Qp = QR + (size_t)row * 768 + h * 96 + 8 * hi;
        const float sc = rsqrtf(ssq[row] * (1.f / 256.f) + EPS) * QSCALE;
#pragma unroll
        for (int d0 = 0; d0 < 6; ++d0) {
            const u32x4 raw = *(const GAS u32x4*)(Qp + 16 * d0);
            float v[8];
#pragma unroll
            for (int j = 0; j < 4; ++j) { v[2 * j] = bflo(raw[j]) * sc; v[2 * j + 1] = bfhi(raw[j]) * sc; }
            if (d0 >= 4) { const GAS float* rt = RT + (d0 == 4 ? (s >> 6) : (s & 63)) * 16;
#pragma unroll
                for (int j = 0; j < 8; ++j) { const float pt = __shfl_xor(v[j], 32), cs = rt[2 * j], sn = rt[2 * j + 1]; v[j] = hi ? v[j] * cs + pt * sn : v[j] * cs - pt * sn; } }
            u32x4 w; w.x = pk2(v[0], v[1]); w.y = pk2(v[2], v[3]); w.z = pk2(v[4], v[5]); w.w = pk2(v[6], v[7]);
            if (sub == 0) qa[d0] = __builtin_bit_cast(bf16x8, w); else qc[d0] = __builtin_bit_cast(bf16x8, w);
        }
    }
    const GAS unsigned char* Kg = (const GAS unsigned char*)(K + (size_t)(b * 8 + h) * KVLEN * 96);
    const GAS unsigned char* Vg = (const GAS unsigned char*)(Vt + (size_t)(b * 8 + h) * 64 * KVLEN);
    const unsigned ldsb = (unsigned)(size_t)lds;
    const GAS unsigned char* src[3]; int stride[3]; unsigned dsto[3];
#pragma unroll
    for (int k = 0; k < 3; ++k) { int j = wave + 8 * k; if (j >= AT_NP) j -= 8; const int id = j * 64 + lane;
        if (j < 13) { const int row = id / 13; int col = id - row * 13; if (col == 12) col = 0; src[k] = Kg + row * 192 + col * 16; stride[k] = 12288; }
        else { const int idv = id - 832, d = idv / 9; int c = idv - d * 9; if (c == 8) c = 0; src[k] = Vg + ((size_t)d * KVLEN + c * 8) * 2; stride[k] = 128; }
        dsto[k] = ldsb + j * 1024; }
#define AT_ISSUE(t, slot) do { _Pragma("unroll") for (int k_ = 0; k_ < 3; ++k_) glds16(src[k_] + (size_t)(t) * stride[k_], (unsigned)__builtin_amdgcn_readfirstlane(dsto[k_] + (slot) * AT_SLOT)); } while (0)
    f32x16 oA0, oA1, oB0, oB1;
#pragma unroll
    for (int i = 0; i < 16; ++i) { oA0[i] = 0.f; oA1[i] = 0.f; oB0[i] = 0.f; oB1[i] = 0.f; }
    float mA = -1e30f, mB = -1e30f, lA = 0.f, lB = 0.f;
    constexpr int NT_ = KVLEN / 64;
    AT_ISSUE(0, 0); AT_ISSUE(1, 1);
    int slot = 0, nslot = 2;
#pragma unroll 1
    for (int t = 0; t < NT_; ++t) {
        if (t + 1 < NT_) asm volatile("s_waitcnt vmcnt(3) lgkmcnt(0)\n\ts_barrier" ::: "memory"); else asm volatile("s_waitcnt vmcnt(0) lgkmcnt(0)\n\ts_barrier" ::: "memory");
        if (t + 2 < NT_) AT_ISSUE(t + 2, nslot);
        const LAS unsigned char* sb = lds + slot * AT_SLOT;
#pragma unroll
        for (int hh = 0; hh < 2; ++hh) {
            const LAS unsigned char* kb = sb + (32 * hh + r32s) * AT_KROW + hi * 16;
            f32x16 pA, pB;
#pragma unroll
            for (int i = 0; i < 16; ++i) { pA[i] = 0.f; pB[i] = 0.f; }
#pragma unroll
            for (int d0 = 0; d0 < 6; ++d0) { const bf16x8 a0 = *(const LAS bf16x8*)(kb + d0 * 32); pA = MFMA32(a0, qa[d0], pA); pB = MFMA32(a0, qc[d0], pB); }
            u32x4 pwA0, pwA1, pwB0, pwB1;
            AT_SOFTMAX(pA, mA, lA, oA0, oA1, pwA0, pwA1);
            AT_SOFTMAX(pB, mB, lB, oB0, oB1, pwB0, pwB1);
            const LAS unsigned char* vb = sb + AT_VOFF + r32 * AT_VROW + hi * 16 + hh * 64;
#pragma unroll
            for (int ks = 0; ks < 2; ++ks) {
                const bf16x8 va0 = *(const LAS bf16x8*)(vb + ks * 32), va1 = *(const LAS bf16x8*)(vb + 32 * AT_VROW + ks * 32);
                const bf16x8 pa = __builtin_bit_cast(bf16x8, ks ? pwA1 : pwA0), pb = __builtin_bit_cast(bf16x8, ks ? pwB1 : pwB0);
                oA0 = MFMA32(va0, pa, oA0); oA1 = MFMA32(va1, pa, oA1); oB0 = MFMA32(va0, pb, oB0); oB1 = MFMA32(va1, pb, oB1);
            }
        }
        slot = slot == 2 ? 0 : slot + 1; nslot = nslot == 2 ? 0 : nslot + 1;
    }
    asm volatile("s_waitcnt lgkmcnt(0)\n\ts_barrier" ::: "memory");
    {   const float inv = 1.f / (lA + __shfl_xor(lA, 32));
        GAS bf16_t* op = A2 + (size_t)(b * SEQ + q0 + r32) * DM + 512 + h * 64 + 4 * hi;
#pragma unroll
        for (int g = 0; g < 4; ++g) { u32x2 w0, w1; w0.x = pk2(oA0[4 * g] * inv, oA0[4 * g + 1] * inv); w0.y = pk2(oA0[4 * g + 2] * inv, oA0[4 * g + 3] * inv);
            w1.x = pk2(oA1[4 * g] * inv, oA1[4 * g + 1] * inv); w1.y = pk2(oA1[4 * g + 2] * inv, oA1[4 * g + 3] * inv);
            *(GAS u32x2*)(op + 8 * g) = w0; *(GAS u32x2*)(op + 32 + 8 * g) = w1; } }
    {   const float inv = 1.f / (lB + __shfl_xor(lB, 32));
        GAS bf16_t* op = A2 + (size_t)(b * SEQ + q0 + 32 + r32) * DM + 512 + h * 64 + 4 * hi;
#pragma unroll
        for (int g = 0; g < 4; ++g) { u32x2 w0, w1; w0.x = pk2(oB0[4 * g] * inv, oB0[4 * g + 1] * inv); w0.y = pk2(oB0[4 * g + 2] * inv, oB0[4 * g + 3] * inv);
            w1.x = pk2(oB1[4 * g] * inv, oB1[4 * g + 1] * inv); w1.y = pk2(oB1[4 * g + 2] * inv, oB1[4 * g + 3] * inv);
            *(GAS u32x2*)(op + 8 * g) = w0; *(GAS u32x2*)(op + 32 + 8 * g) = w1; } }
#undef AT_ISSUE
}
__device__ __forceinline__ void p7_rows(const GAS float* __restrict__ x, const GAS float* __restrict__ g_post, const GAS float* __restrict__ g_pre, GAS float* __restrict__ out, const GAS float* __restrict__ mod, const GAS bf16_t* __restrict__ Y, GAS bf16_t* __restrict__ H2, int gw, int NGW, int lane) {
    for (int m0 = 2 * gw; m0 < MLAT; m0 += 2 * NGW) {
        const GAS float* md = mod + (m0 >> 13) * NMOD;
        f32x4 y[2][4], xv[2][4]; float ss[2];
#pragma unroll
        for (int r = 0; r < 2; ++r) { ss[r] = 0.f;
#pragma unroll
            for (int j = 0; j < 4; ++j) { const u32x2 w = *(const GAS u32x2*)(Y + (size_t)(m0 + r) * DM + 4 * lane + 256 * j); xv[r][j] = *(const GAS f32x4*)(x + (size_t)(m0 + r) * DM + 4 * lane + 256 * j);
                y[r][j] = (f32x4){bflo(w.x), bfhi(w.x), bflo(w.y), bfhi(w.y)}; ss[r] += y[r][j].x * y[r][j].x + y[r][j].y * y[r][j].y + y[r][j].z * y[r][j].z + y[r][j].w * y[r][j].w; } }
#pragma unroll
        for (int r = 0; r < 2; ++r) { const int m = m0 + r;
            const float rs = rsqrtf(wave_sum(ss[r]) * (1.f / DM) + EPS); float s2 = 0.f;
#pragma unroll
            for (int j = 0; j < 4; ++j) { const int k = 4 * lane + 256 * j;
                const f32x4 gg = *(const GAS f32x4*)(g_post + k), gt = *(const GAS f32x4*)(md + 2 * DM + k);
                xv[r][j] = xv[r][j] + gt * (y[r][j] * rs * gg); *(GAS f32x4*)(out + (size_t)m * DM + k) = xv[r][j];
                s2 += xv[r][j].x * xv[r][j].x + xv[r][j].y * xv[r][j].y + xv[r][j].z * xv[r][j].z + xv[r][j].w * xv[r][j].w; }
            const float rs2 = rsqrtf(wave_sum(s2) * (1.f / DM) + EPS);
#pragma unroll
            for (int j = 0; j < 4; ++j) { const int k = 4 * lane + 256 * j;
                const f32x4 gg = *(const GAS f32x4*)(g_pre + k), sh = *(const GAS f32x4*)(md + 3 * DM + k), sc = *(const GAS f32x4*)(md + 4 * DM + k);
                const f32x4 hh = xv[r][j] * rs2 * gg * (sc + 1.f) + sh;
                u32x2 o; o.x = pk2(hh.x, hh.y); o.y = pk2(hh.z, hh.w); *(GAS u32x2*)(H2 + (size_t)m * DM + k) = o; } }
    }
}
__device__ __forceinline__ void p11_rows(const GAS float* __restrict__ g_post, GAS float* __restrict__ out, const GAS float* __restrict__ mod, const GAS bf16_t* __restrict__ Fb, int gw, int NGW, int lane) {
    for (int m0 = 2 * gw; m0 < MLAT; m0 += 2 * NGW) {
        const GAS float* md = mod + (m0 >> 13) * NMOD;
        f32x4 y[2][4], xv[2][4]; float ss[2];
#pragma unroll
        for (int r = 0; r < 2; ++r) { ss[r] = 0.f;
#pragma unroll
            for (int j = 0; j < 4; ++j) { const u32x2 w = *(const GAS u32x2*)(Fb + (size_t)(m0 + r) * DM + 4 * lane + 256 * j); xv[r][j] = *(const GAS f32x4*)(out + (size_t)(m0 + r) * DM + 4 * lane + 256 * j);
                y[r][j] = (f32x4){bflo(w.x), bfhi(w.x), bflo(w.y), bfhi(w.y)}; ss[r] += y[r][j].x * y[r][j].x + y[r][j].y * y[r][j].y + y[r][j].z * y[r][j].z + y[r][j].w * y[r][j].w; } }
#pragma unroll
        for (int r = 0; r < 2; ++r) { const float rs = rsqrtf(wave_sum(ss[r]) * (1.f / DM) + EPS);
#pragma unroll
            for (int j = 0; j < 4; ++j) { const int k = 4 * lane + 256 * j;
                const f32x4 gg = *(const GAS f32x4*)(g_post + k), gt = *(const GAS f32x4*)(md + 5 * DM + k);
                *(GAS f32x4*)(out + (size_t)(m0 + r) * DM + k) = xv[r][j] + gt * (y[r][j] * rs * gg); } }
    }
}
__device__ __forceinline__ void convgate_phase(const GAS float* __restrict__ cw, const GAS float* __restrict__ cb, const GAS bf16_t* __restrict__ UP, GAS bf16_t* __restrict__ G, int half, int gtid, int NT) {
    constexpr int JG = DFF / 8, RG = 32, NTASK = (MLAT / 2 / RG) * JG;
    for (int task = gtid; task < NTASK; task += NT) {
        const int jg = task % JG, rg = task / JG, j0 = jg * 8, r0 = rg * RG, m0 = half * (MLAT / 2) + r0;
        float wu[3][8], wg[3][8], bu[8], bg[8];
#pragma unroll
        for (int k = 0; k < 3; ++k)
#pragma unroll
            for (int i = 0; i < 8; ++i) { wu[k][i] = cw[k * 2 * DFF + j0 + i]; wg[k][i] = cw[k * 2 * DFF + DFF + j0 + i]; }
#pragma unroll
        for (int i = 0; i < 8; ++i) { bu[i] = cb[j0 + i]; bg[i] = cb[DFF + j0 + i]; }
        const GAS bf16_t* up = UP + (size_t)r0 * (2 * DFF) + j0;
        u32x4 pu = {0u, 0u, 0u, 0u}, pg = {0u, 0u, 0u, 0u}, cu, cg_, nu, ng;
        if ((m0 & 8191) != 0) { pu = *(const GAS u32x4*)(up - 2 * DFF); pg = *(const GAS u32x4*)(up - 2 * DFF + DFF); }
        cu = *(const GAS u32x4*)(up); cg_ = *(const GAS u32x4*)(up + DFF);
#pragma unroll 8
        for (int r = 0; r < RG; ++r) {
            const bool nv = (r + 1 < RG) || (((m0 + RG) & 8191) != 0);
            if (nv) { nu = *(const GAS u32x4*)(up + (size_t)(r + 1) * (2 * DFF)); ng = *(const GAS u32x4*)(up + (size_t)(r + 1) * (2 * DFF) + DFF); } else { nu = (u32x4){0u, 0u, 0u, 0u}; ng = nu; }
            float o[8];
#pragma unroll
            for (int i = 0; i < 8; ++i) { const int w_ = i >> 1;
                const float p_u = (i & 1) ? bfhi(pu[w_]) : bflo(pu[w_]), c_u = (i & 1) ? bfhi(cu[w_]) : bflo(cu[w_]), n_u = (i & 1) ? bfhi(nu[w_]) : bflo(nu[w_]);
                const float p_g = (i & 1) ? bfhi(pg[w_]) : bflo(pg[w_]), c_g = (i & 1) ? bfhi(cg_[w_]) : bflo(cg_[w_]), n_g = (i & 1) ? bfhi(ng[w_]) : bflo(ng[w_]);
                const float uv = bu[i] + wu[0][i] * p_u + wu[1][i] * c_u + wu[2][i] * n_u, gv = bg[i] + wg[0][i] * p_g + wg[1][i] * c_g + wg[2][i] * n_g;
                o[i] = gv * __builtin_amdgcn_rcpf(1.f + __builtin_amdgcn_exp2f(-1.4426950408889634f * gv)) * uv; }
            u32x4 w; w.x = pk2(o[0], o[1]); w.y = pk2(o[2], o[3]); w.z = pk2(o[4], o[5]); w.w = pk2(o[6], o[7]);
            *(GAS u32x4*)(G + (size_t)(r0 + r) * DFF + j0) = w;
            pu = cu; pg = cg_; cu = nu; cg_ = ng;
        }
    }
}
constexpr int NPH = 17;
__global__ void __launch_bounds__(512, 2) fwd_kernel(Args a) {
    extern __shared__ __attribute__((aligned(16))) unsigned char lds_raw[];
    LAS unsigned char* lds = (LAS unsigned char*)lds_raw;
    const int lo = a.ph_lo, hi_ = a.ph_hi;
#if MK_COOP
    cg::grid_group grid = cg::this_grid();
#endif
    typedef pg8::EpiBf16<0> EpiB;
    constexpr int MH = MLAT / 2;
#ifndef REPMASK
#define REPMASK 0
#endif
    bool repeated = false;
#pragma unroll 1
    for (int ph = lo; ph < hi_; ++ph) {
        int tid = threadIdx.x; asm volatile("" : "+v"(tid));
        int G = gridDim.x, bx = blockIdx.x; asm volatile("" : "+s"(G), "+s"(bx));
        const int lane = tid & 63, wave = __builtin_amdgcn_readfirstlane(tid >> 6);
        const int vcu = (G % 8 == 0) ? (bx % 8) * (G / 8) + bx / 8 : bx;
        const int gw = vcu * 8 + wave, NGW = G * 8, gtid = bx * 512 + tid, NTH = G * 512;
        unsigned char* ws_ = a.ws; asm volatile("" : "+s"(ws_)); GAS unsigned char* ws = (GAS unsigned char*)ws_;
        GAS float* mod = (GAS float*)(ws + WS_MOD); GAS float* ssq = (GAS float*)(ws + WS_SSQ); GAS float* sskv = (GAS float*)(ws + WS_SSKV);
        GAS bf16_t* Win = (GAS bf16_t*)(ws + WS_WIN); GAS bf16_t* Wq = (GAS bf16_t*)(ws + WS_WQ); GAS bf16_t* Wkv = (GAS bf16_t*)(ws + WS_WKV); GAS bf16_t* Wg = (GAS bf16_t*)(ws + WS_WG);
        GAS bf16_t* Wout = (GAS bf16_t*)(ws + WS_WOUT); GAS bf16_t* Wup = (GAS bf16_t*)(ws + WS_WUP); GAS bf16_t* Wdn = (GAS bf16_t*)(ws + WS_WDN);
        GAS f32x2* AGG = (GAS f32x2*)(ws + WS_AGG); GAS float* RT = (GAS float*)(ws + WS_ROPE);
        GAS bf16_t* H = (GAS bf16_t*)(ws + WS_R1); GAS bf16_t* KVR = H; GAS bf16_t* H2 = H; GAS bf16_t* QR = (GAS bf16_t*)(ws + WS_Q);
        GAS bf16_t* P = (GAS bf16_t*)(ws + WS_R2); GAS bf16_t* Y = P; GAS bf16_t* Fb = P;
        GAS unsigned* LU = (GAS unsigned*)(ws + WS_LU); GAS bf16_t* Kb = (GAS bf16_t*)(ws + WS_K); GAS bf16_t* Vb = (GAS bf16_t*)(ws + WS_V); GAS bf16_t* A2 = (GAS bf16_t*)(ws + WS_A2);
        GAS bf16_t* UP = (GAS bf16_t*)(ws + WS_UP); GAS bf16_t* Gb = (GAS bf16_t*)(ws + WS_G);
        float* outp_ = a.out; asm volatile("" : "+s"(outp_)); GAS float* outp = (GAS float*)outp_;
        pg8::Gemm g{nullptr, nullptr, 0, 0, 0, 0, 0}; GAS bf16_t* O = nullptr; int ldc = 0;
        switch (ph) {
            case 2:  g = pg8::Gemm{(const bf16_t*)(H), (const bf16_t*)(Win), MALL, PW, DM, DM, DM}; O = P; ldc = PW; break;
            case 4:  g = pg8::Gemm{(const bf16_t*)(P + 1024), (const bf16_t*)(Wq), MLAT, 768, 256, PW, 256}; O = QR; ldc = 768; break;
            case 5:  g = pg8::Gemm{(const bf16_t*)(P + 1280), (const bf16_t*)(Wkv), MALL, 1024, 256, PW, 256}; O = KVR; ldc = 1024; break;
            case 8:  g = pg8::Gemm{(const bf16_t*)(A2), (const bf16_t*)(Wout), MLAT, DM, DM, DM, DM}; O = Y; ldc = DM; break;
            case 10: g = pg8::Gemm{(const bf16_t*)(H2), (const bf16_t*)(Wup), MH, 2 * DFF, DM, DM, DM}; O = UP; ldc = 2 * DFF; break;
            case 13: g = pg8::Gemm{(const bf16_t*)(H2 + (size_t)MH * DM), (const bf16_t*)(Wup), MH, 2 * DFF, DM, DM, DM}; O = UP; ldc = 2 * DFF; break;
            case 12: g = pg8::Gemm{(const bf16_t*)(Gb), (const bf16_t*)(Wdn), MH, DM, DFF, DFF, DFF}; O = Fb; ldc = DM; break;
            case 15: g = pg8::Gemm{(const bf16_t*)(Gb), (const bf16_t*)(Wdn), MH, DM, DFF, DFF, DFF}; O = Fb + (size_t)MH * DM; ldc = DM; break;
            default: break;
        }
        if (g.A != nullptr) {
            pg8::StaticOrder S; S.init(g.M, g.N, G, bx); EpiB E{(bf16_t*)O, ldc, nullptr, 0, 0, 1.f};
            pg8::gemm_phase<EpiB, pg8::StaticOrder, true, true>(lds, g, S, E, tid);
        }
#ifndef NGM
#define NGM 0x1ffff
#endif
#define NG(k) ((NGM >> (k)) & 1)
        else if (NG(0) && ph == 0) {
            prep_mat<0>(argp(10), nullptr, Win, 1536, 1024, gtid, NTH); prep_mat<1>(argp(18), argp(19), Wq, 768, 256, gtid, NTH); prep_mat<2>(argp(20), argp(21), Wkv, 1024, 256, gtid, NTH);
            prep_mat<3>(argp(13), argp(15), Wg, 2048, 64, gtid, NTH); prep_mat<4>(argp(22), nullptr, Wout, 1024, 1024, gtid, NTH); prep_mat<5>(argp(23), nullptr, Wup, 5632, 1024, gtid, NTH);
            prep_mat<6>(argp(26), nullptr, Wdn, 1024, 2816, gtid, NTH);
            if (gtid < 1024) { const int pos = gtid >> 3, j = gtid & 7; const float invf[8] = {1.f, 0.31622776601683794f, 0.1f, 0.031622776601683794f, 0.01f, 0.0031622776601683794f, 0.001f, 0.00031622776601683794f};
                const float ang = (float)pos * invf[j]; RT[2 * gtid] = cosf(ang); RT[2 * gtid + 1] = sinf(ang); }
            mod_phase(argp(1), argp(3), argp(4), argp(5), mod, (LAS float*)(lds + wave * 4096), gw, NGW, lane);
        } else if (NG(1) && ph == 1) {
            p1_rows(argp(0), argp(2), argp(6), mod, H, gw, NGW, lane);
        } else if (NG(3) && ph == 3) {
            gates_phase(argp(11), argp(12), argp(14), argp(16), argp(17), lds, P, Wg, LU, AGG, tid, wave, lane);
            ss_phase(P, ssq, sskv, gw, NGW, lane);
        } else if (NG(6) && ph == 6) {
            krope_phase(P, Kb, RT, gtid, NTH); kvpost_phase(KVR, sskv, Kb, Vb, gtid, NTH);
#ifdef REP6
            if (REP6 & 1) { __syncthreads(); scan_agg(LU, AGG, gw, NGW, lane); }
            if (REP6 & 2) { __syncthreads(); krope_phase(P, Kb, RT, gtid, NTH); }
            if (REP6 & 4) { __syncthreads(); }
            if (REP6 & 8) { __syncthreads(); kvpost_phase(KVR, sskv, Kb, Vb, gtid, NTH); }
#endif
        } else if (NG(7) && ph == 7) {
            scan_final(LU, AGG, P, A2, gw, NGW, lane);
#ifdef REP7
            __syncthreads(); scan_final(LU, AGG, P, A2, gw, NGW, lane);
#endif
            const int upb = (NB * 8 * 16 + G - 1) / G, u0 = vcu * upb, u1 = min(NB * 8 * 16, u0 + upb);
            __syncthreads();
            for (int unit = u0; unit < u1; ++unit) { const int bh = unit >> 4, qb = unit & 15; attn_unit(lds, QR, ssq, RT, Kb, Vb, A2, bh >> 3, bh & 7, qb, tid, wave, lane); }
        } else if (NG(9) && ph == 9) {
            p7_rows(argp(0), argp(7), argp(8), outp, mod, Y, H2, gw, NGW, lane);
        } else if (NG(11) && (ph == 11 || ph == 14)) {
            convgate_phase(argp(24), argp(25), UP, Gb, ph == 14 ? 1 : 0, gtid, NTH);
        } else if (NG(16) && ph == 16) {
            p11_rows(argp(9), outp, mod, Fb, gw, NGW, lane);
        }
        __syncthreads();
#if MK_COOP
        if (ph + 1 < hi_ && ph != 3 && ph != 4) grid.sync();
#endif
        if (REPMASK) { if (((REPMASK >> ph) & 1) && !repeated) { repeated = true; --ph; } else repeated = false; }
    }
}

extern "C" void kernel_launch(void* const* d_in, const int* in_sizes, int n_in, void* d_out, int out_size, void* d_ws, size_t ws_size, hipStream_t stream) {
    static int grid = 0;
    if (grid == 0) {
        if (n_in != 27 || out_size != MLAT * DM || ws_size < WS_END) { fprintf(stderr, "kernel_launch: unexpected shapes (n_in %d, out %d, ws %zu)\n", n_in, out_size, ws_size); grid = -1; return; }
        int dev = 0, cus = 0, per_cu = 0;
        if (hipGetDevice(&dev) != hipSuccess || hipDeviceGetAttribute(&cus, hipDeviceAttributeMultiprocessorCount, dev) != hipSuccess) { grid = -1; return; }
        if (hipFuncSetAttribute((const void*)fwd_kernel, hipFuncAttributeMaxDynamicSharedMemorySize, LDS_BYTES) != hipSuccess) { fprintf(stderr, "kernel_launch: hipFuncSetAttribute failed\n"); grid = -1; return; }
        if (hipOccupancyMaxActiveBlocksPerMultiprocessor(&per_cu, (const void*)fwd_kernel, 512, LDS_BYTES) != hipSuccess || per_cu < 1) { fprintf(stderr, "kernel_launch: occupancy query says %d\n", per_cu); }
        (void)hipGetLastError();
        grid = cus;
    }
    if (grid < 0) return;
    (void)hipMemsetAsync((char*)d_ws + WS_CTL, 0, CTL_BYTES, stream);
    Args a{};
    for (int i = 0; i < 27; ++i) a.in[i] = (const float*)d_in[i];
    a.out = (float*)d_out; a.ws = (unsigned char*)d_ws;
#if MK_COOP
    a.ph_lo = 0; a.ph_hi = NPH;
    void* args[] = {&a};
    hipError_t e = hipLaunchCooperativeKernel((const void*)fwd_kernel, dim3(grid), dim3(512), args, LDS_BYTES, stream);
    if (e != hipSuccess) fprintf(stderr, "kernel_launch: cooperative launch failed: %s (grid %d)\n", hipGetErrorString(e), grid);
#else
    for (int p = 0; p < NPH; ++p) { a.ph_lo = p; a.ph_hi = p + 1; hipLaunchKernelGGL(fwd_kernel, dim3(grid), dim3(512), LDS_BYTES, stream, a); }
#endif
}
```

```cpp
#include <hip/hip_runtime.h>
#include <hip/hip_cooperative_groups.h>
#include <cstdio>
#include <cstdint>
namespace cg = cooperative_groups;
#ifndef MK_COOP
#define MK_COOP 1
#endif
namespace pg8 {
#define PG8_LAS __attribute__((address_space(3)))
typedef unsigned short bf16_t;
typedef short bf16x8 __attribute__((ext_vector_type(8)));
typedef float f32x4 __attribute__((ext_vector_type(4)));
typedef unsigned u32x4 __attribute__((ext_vector_type(4)));
constexpr int BM = 256, BK = 64, HALF = 128, HTB = HALF * BK * 2  , STAGE_BYTES = 8 * HTB, NXCD = 8, WGM = 8;

__host__ __device__ __forceinline__ int lds_byte(int r, int c) { const int st = (r >> 4) * 2 + (c >> 5), rr = r & 15, cc = c & 31, ob = rr * 64 + cc * 2; return st * 1024 + (ob ^ (((ob >> 9) & 1) << 5)); }
__host__ __device__ __forceinline__ void stage_rc(int b, int& R, int& C) { const int st = b / 1024, sb = b % 1024, swz = sb ^ (((sb >> 9) & 1) << 5); R = (st >> 1) * 16 + swz / 64; C = (st & 1) * 32 + (swz % 64) / 2; }
__host__ __device__ __forceinline__ int perm32(int rho) { const int n = rho >> 4, i = rho & 15; return 8 * (i >> 2) + 4 * n + (i & 3); }

struct Unit { int pm, pn; };
struct Gemm { const bf16_t* A; const bf16_t* Bt; int M, N, K, lda, ldb; };

struct StaticOrder {
    int nM, nN, nwg, G, c;
    __host__ __device__ void init(int M, int N, int G_, int c_) { nM = M / BM; nN = N / BM; nwg = nM * nN; G = G_; c = c_; }
    __host__ __device__ bool next(int i, Unit& u) const {
        const long L = (long)i * G + c; if (L >= nwg) return false;
        int wgid = (int)L; { const int q = nwg / NXCD, r = nwg % NXCD, xcd = wgid % NXCD, off = wgid / NXCD; wgid = (xcd < r ? xcd * (q + 1) : r * (q + 1) + (xcd - r) * q) + off; }
        const int nig = WGM * nN, gid = wgid / nig, fm = gid * WGM, gsz = (nM - fm) < WGM ? (nM - fm) : WGM;
        u.pm = fm + ((wgid % nig) % gsz); u.pn = (wgid % nig) / gsz; return true;
    }
    __device__ __forceinline__ void a_ready(const Unit&) const {}
    __device__ __forceinline__ void done(const Unit&) const {}
};

__device__ __forceinline__ unsigned cvt_pk_bf16(float lo, float hi) { unsigned r; asm volatile("v_cvt_pk_bf16_f32 %0, %1, %2" : "=v"(r) : "v"(lo), "v"(hi)); return r; }
typedef float f32x2 __attribute__((ext_vector_type(2)));
__device__ __forceinline__ f32x2 gelu_pk(f32x2 v) {
    const f32x2 av = __builtin_elementwise_abs(v), d = av * 0.2316418882f + 1.0f;
    f32x2 t; t.x = __builtin_amdgcn_rcpf(d.x); t.y = __builtin_amdgcn_rcpf(d.y);
    f32x2 q = t * 0.5307027145f + (-0.7265760135f); q = q * t + 0.7107068705f; q = q * t + (-0.142248368f); q = q * t + 0.127414796f; q = q * t;
    const f32x2 s = (v * v) * (-0.72134752044f);
    f32x2 e; e.x = __builtin_amdgcn_exp2f(s.x); e.y = __builtin_amdgcn_exp2f(s.y);
    const f32x2 m = v * (q * e), r = v - m;
    f32x2 o; o.x = v.x < 0.f ? m.x : r.x; o.y = v.y < 0.f ? m.y : r.y; return o;
}

template <int ACT  > struct EpiBf16 {
    static constexpr bool PERM = true, AFTER_DRAIN = false; static_assert(ACT == 0 || ACT == 1, "EpiBf16: ACT is 0 (none) or 1 (gelu_pk)");
    bf16_t* O; int ldc; const float* bias; int split_cols; size_t split_stride; float scale0;
    __device__ __forceinline__ void operator()(const f32x4 (&acc)[2][2][4][2], const Unit& u, int wr, int wc, int fr, int fq) const {
        const int row0 = u.pm * BM + wr * 64 + fr; int colt = u.pn * BM; bf16_t* base = O;
        float sc = 1.f; if (split_cols) { const int t = colt / split_cols; base += (size_t)t * split_stride; colt -= t * split_cols; if (t == 0) sc = scale0; }
        const int col0 = colt + wc * 32 + 8 * fq, bcol0 = u.pn * BM + wc * 32 + 8 * fq;
        f32x4 bv[2][2];
#pragma unroll
        for (int bj = 0; bj < 2; ++bj)
#pragma unroll
            for (int n = 0; n < 2; ++n) bv[bj][n] = bias ? *(const f32x4*)(bias + bcol0 + bj * HALF + 4 * n) : (f32x4){0.f, 0.f, 0.f, 0.f};
#pragma unroll
        for (int ai = 0; ai < 2; ++ai)
#pragma unroll
            for (int m = 0; m < 4; ++m) { bf16_t* rowp = base + (size_t)(row0 + ai * HALF + m * 16) * ldc + col0;
#pragma unroll
                for (int bj = 0; bj < 2; ++bj) { f32x4 v0 = acc[ai][bj][m][0] + bv[bj][0], v1 = acc[ai][bj][m][1] + bv[bj][1];
                    if (ACT == 1) { f32x2 a = gelu_pk((f32x2){v0[0], v0[1]}), b = gelu_pk((f32x2){v0[2], v0[3]}), c = gelu_pk((f32x2){v1[0], v1[1]}), d = gelu_pk((f32x2){v1[2], v1[3]});
                        v0 = (f32x4){a.x, a.y, b.x, b.y}; v1 = (f32x4){c.x, c.y, d.x, d.y}; }
                    v0 = v0 * sc; v1 = v1 * sc; u32x4 w; w.x = cvt_pk_bf16(v0[0], v0[1]); w.y = cvt_pk_bf16(v0[2], v0[3]); w.z = cvt_pk_bf16(v1[0], v1[1]); w.w = cvt_pk_bf16(v1[2], v1[3]);
                    *(__attribute__((address_space(1))) u32x4*)(rowp + bj * HALF) = w; } }
    }
};
template <class Epi, class Sched, bool ALIGN_EPI = false, bool SP2 = false>
__device__ __forceinline__ void gemm_phase(PG8_LAS unsigned char* lds, const Gemm g, const Sched& S, const Epi& E, const int tid) {
    const int wid = __builtin_amdgcn_readfirstlane(tid >> 6), lane = tid & 63, wr = wid >> 2, wc = wid & 3, fr = lane & 15, fq = lane >> 4;
    const int K = g.K, nt = K / BK;
    unsigned voffA[2], voffB[2];
#pragma unroll
    for (int i = 0; i < 2; ++i) { int R, C; stage_rc(tid * 16 + i * 8192, R, C); const int Rb = Epi::PERM ? ((R & ~31) + perm32(R & 31)) : R;
        voffA[i] = (unsigned)(R * g.lda + C) * 2u; voffB[i] = (unsigned)(Rb * g.ldb + C) * 2u; }
    const size_t kstep = (size_t)(BK * 2);
    const size_t hstepA = (size_t)HALF * g.lda * 2, hstepB = (size_t)HALF * g.ldb * 2;
    const size_t tstepA = 2 * hstepA, tstepB = 2 * hstepB;
    const unsigned ldsw = (unsigned)wid * 1024u;
    const int aoff = lds_byte(wr * 64 + fr, fq * 8), boff = lds_byte(wc * 32 + fr, fq * 8);
#define PG8_SA(b, h) (((b) * 2 + (h)) * HTB)
#define PG8_SB(b, h) ((4 + (b) * 2 + (h)) * HTB)
#define PG8_STAGE(bufoff, gbase, voff) do { _Pragma("unroll") for (int _i = 0; _i < 2; ++_i) \
        __builtin_amdgcn_global_load_lds((const unsigned*)((const char*)(gbase) + (voff)[_i]), (PG8_LAS unsigned*)(lds + (bufoff) + ldsw + _i * 8192), 16, 0, 0); } while (0)
#define PG8_LDA(dst, b, h) do { _Pragma("unroll") for (int m = 0; m < 4; ++m) _Pragma("unroll") for (int k = 0; k < 2; ++k) dst[m][k] = *(const PG8_LAS bf16x8*)(lds + PG8_SA(b, h) + aoff + m * 2048 + k * 1024); } while (0)
#define PG8_LDB(dst, b, h) do { _Pragma("unroll") for (int n = 0; n < 2; ++n) _Pragma("unroll") for (int k = 0; k < 2; ++k) dst[n][k] = *(const PG8_LAS bf16x8*)(lds + PG8_SB(b, h) + boff + n * 2048 + k * 1024); } while (0)
#define PG8_MMA(ai, bj, At, Bt) do { __builtin_amdgcn_s_setprio(1); _Pragma("unroll") for (int m = 0; m < 4; ++m) _Pragma("unroll") for (int n = 0; n < 2; ++n) _Pragma("unroll") for (int k = 0; k < 2; ++k) \
        acc[ai][bj][m][n] = __builtin_amdgcn_mfma_f32_16x16x32_bf16(Bt[n][k], At[m][k], acc[ai][bj][m][n], 0, 0, 0); __builtin_amdgcn_s_setprio(0); } while (0)
#define PG8_WAIT_V(n) asm volatile("s_waitcnt vmcnt(" #n ")" ::: "memory")
#define PG8_WAIT_L(n) asm volatile("s_waitcnt lgkmcnt(" #n ")" ::: "memory")
#define PG8_BAR __builtin_amdgcn_s_barrier()
#define PG8_SCHED __builtin_amdgcn_sched_barrier(0)
    Unit cur, nxt; int ui = 0;
    if (!S.next(0, cur)) return;
    f32x4 acc[2][2][4][2];
#pragma unroll
    for (int a = 0; a < 2; ++a)
#pragma unroll
        for (int b = 0; b < 2; ++b)
#pragma unroll
            for (int m = 0; m < 4; ++m)
#pragma unroll
                for (int n = 0; n < 2; ++n) acc[a][b][m][n] = (f32x4){0.f, 0.f, 0.f, 0.f};
    bf16x8 At[4][2], B0[2][2], B1[2][2];
    const char* cA = (const char*)g.A + (size_t)cur.pm * tstepA; const char* cB = (const char*)g.Bt + (size_t)cur.pn * tstepB;
    S.a_ready(cur);
    if constexpr (SP2) {
        PG8_STAGE(PG8_SB(0, 0), cB, voffB); PG8_STAGE(PG8_SB(0, 1), cB + hstepB, voffB); PG8_STAGE(PG8_SA(0, 0), cA, voffA); PG8_STAGE(PG8_SA(0, 1), cA + hstepA, voffA);
        if (wr == 1) PG8_BAR;
        PG8_WAIT_V(2); PG8_BAR;
        PG8_STAGE(PG8_SB(1, 0), cB + kstep, voffB); PG8_STAGE(PG8_SA(1, 0), cA + kstep, voffA); PG8_STAGE(PG8_SB(1, 1), cB + hstepB + kstep, voffB);
        PG8_WAIT_V(6); PG8_BAR;
    } else {
        PG8_STAGE(PG8_SB(0, 0), cB, voffB); PG8_STAGE(PG8_SA(0, 0), cA, voffA); PG8_STAGE(PG8_SB(0, 1), cB + hstepB, voffB); PG8_STAGE(PG8_SA(0, 1), cA + hstepA, voffA);
        if (wr == 1) PG8_BAR;
        PG8_WAIT_V(4); PG8_BAR;
        PG8_STAGE(PG8_SB(1, 0), cB + kstep, voffB); PG8_STAGE(PG8_SA(1, 0), cA + kstep, voffA); PG8_STAGE(PG8_SB(1, 1), cB + hstepB + kstep, voffB);
        PG8_WAIT_V(6); PG8_BAR;
    }
    for (;;) {
        const bool has_next = S.next(ui + 1, nxt);
        const char* nA = has_next ? (const char*)g.A + (size_t)nxt.pm * tstepA : cA; const char* nB = has_next ? (const char*)g.Bt + (size_t)nxt.pn * tstepB : cB;
        for (int t = 0; t < nt; t += 2) {
            const bool last = (t == nt - 2);
            const char* a1 = cA + (size_t)(t + 1) * kstep;
            const char* a2 = last ? nA : cA + (size_t)(t + 2) * kstep; const char* b2 = last ? nB : cB + (size_t)(t + 2) * kstep;
            const char* a3 = a2 + kstep; const char* b3 = b2 + kstep;
            if (last && has_next) S.a_ready(nxt);
            if constexpr (SP2) {
            PG8_LDB(B0, 0, 0); PG8_LDB(B1, 0, 1); PG8_SCHED; PG8_LDA(At, 0, 0); PG8_STAGE(PG8_SA(1, 1), a1 + hstepA, voffA);
            PG8_WAIT_V(8); PG8_WAIT_L(0); PG8_BAR; PG8_MMA(0, 0, At, B0); PG8_MMA(0, 1, At, B1); PG8_BAR; PG8_SCHED;
            PG8_LDA(At, 0, 1); PG8_STAGE(PG8_SB(0, 0), b2, voffB); PG8_STAGE(PG8_SB(0, 1), b2 + hstepB, voffB); PG8_STAGE(PG8_SA(0, 0), a2, voffA);
            PG8_WAIT_V(8); PG8_WAIT_L(0); PG8_BAR; PG8_MMA(1, 0, At, B0); PG8_MMA(1, 1, At, B1); PG8_BAR; PG8_SCHED;
            PG8_LDB(B0, 1, 0); PG8_LDB(B1, 1, 1); PG8_SCHED; PG8_LDA(At, 1, 0); PG8_STAGE(PG8_SA(0, 1), a2 + hstepA, voffA);
            PG8_WAIT_V(8); PG8_WAIT_L(0); PG8_BAR; PG8_MMA(0, 0, At, B0); PG8_MMA(0, 1, At, B1); PG8_BAR; PG8_SCHED;
            PG8_LDA(At, 1, 1); PG8_STAGE(PG8_SB(1, 0), b3, voffB); PG8_STAGE(PG8_SB(1, 1), b3 + hstepB, voffB); PG8_STAGE(PG8_SA(1, 0), a3, voffA);
            PG8_WAIT_V(8); PG8_WAIT_L(0); PG8_BAR; PG8_MMA(1, 0, At, B0); PG8_MMA(1, 1, At, B1); PG8_BAR; PG8_SCHED;
            } else {
            PG8_LDB(B0, 0, 0); PG8_SCHED; PG8_LDA(At, 0, 0); PG8_STAGE(PG8_SA(1, 1), a1 + hstepA, voffA);
            PG8_WAIT_L(8); PG8_BAR; PG8_WAIT_L(0); PG8_MMA(0, 0, At, B0); PG8_BAR; PG8_SCHED;
            PG8_LDB(B1, 0, 1); PG8_STAGE(PG8_SB(0, 0), b2, voffB);
            PG8_BAR; PG8_WAIT_L(0); PG8_MMA(0, 1, At, B1); PG8_BAR;
            PG8_LDA(At, 0, 1); PG8_STAGE(PG8_SA(0, 0), a2, voffA);
            PG8_BAR; PG8_WAIT_L(0); PG8_MMA(1, 0, At, B0); PG8_BAR; PG8_SCHED;
            PG8_STAGE(PG8_SB(0, 1), b2 + hstepB, voffB);
            PG8_WAIT_V(6); PG8_BAR; PG8_MMA(1, 1, At, B1); PG8_BAR;
            PG8_LDB(B0, 1, 0); PG8_SCHED; PG8_LDA(At, 1, 0); PG8_STAGE(PG8_SA(0, 1), a2 + hstepA, voffA);
            PG8_WAIT_L(8); PG8_BAR; PG8_WAIT_L(0); PG8_MMA(0, 0, At, B0); PG8_BAR; PG8_SCHED;
            PG8_LDB(B1, 1, 1); PG8_STAGE(PG8_SB(1, 0), b3, voffB);
            PG8_BAR; PG8_WAIT_L(0); PG8_MMA(0, 1, At, B1); PG8_BAR;
            PG8_LDA(At, 1, 1); PG8_STAGE(PG8_SA(1, 0), a3, voffA);
            PG8_BAR; PG8_WAIT_L(0); PG8_MMA(1, 0, At, B0); PG8_BAR; PG8_SCHED;
            PG8_STAGE(PG8_SB(1, 1), b3 + hstepB, voffB);
            PG8_WAIT_V(6); PG8_BAR; PG8_MMA(1, 1, At, B1); PG8_BAR;
            }
        }
        if constexpr (ALIGN_EPI) { if (wr == 0) PG8_BAR; }
        if constexpr (!Epi::AFTER_DRAIN) { E(acc, cur, wr, wc, fr, fq); S.done(cur); }
        if (!has_next) break;
#pragma unroll
        for (int a = 0; a < 2; ++a)
#pragma unroll
            for (int b = 0; b < 2; ++b)
#pragma unroll
                for (int m = 0; m < 4; ++m)
#pragma unroll
                    for (int n = 0; n < 2; ++n) acc[a][b][m][n] = (f32x4){0.f, 0.f, 0.f, 0.f};
        cur = nxt; cA = nA; cB = nB; ++ui;
        if constexpr (ALIGN_EPI) { if (wr == 1) PG8_BAR; }
    }
    PG8_WAIT_V(0);
    if constexpr (!ALIGN_EPI) { if (wr == 0) PG8_BAR; }
    PG8_BAR;
    if constexpr (Epi::AFTER_DRAIN) { E.fused(acc, cur, wr, wc, fr, fq, lds, wid, lane); S.done(cur); }
#undef PG8_SA
#undef PG8_SB
#undef PG8_STAGE
#undef PG8_LDA
#undef PG8_LDB
#undef PG8_MMA
#undef PG8_WAIT_V
#undef PG8_WAIT_L
#undef PG8_BAR
#undef PG8_SCHED
}
}
#define LAS __attribute__((address_space(3)))
#define GAS __attribute__((address_space(1)))
typedef unsigned short bf16_t;
typedef short bf16x8 __attribute__((ext_vector_type(8)));
typedef short s16x4 __attribute__((ext_vector_type(4)));
typedef float f32x4 __attribute__((ext_vector_type(4)));
typedef float f32x16 __attribute__((ext_vector_type(16)));
typedef unsigned u32x4 __attribute__((ext_vector_type(4)));
typedef unsigned u32x2 __attribute__((ext_vector_type(2)));
typedef float f32x2 __attribute__((ext_vector_type(2)));

constexpr int NB = 8, SEQ = 8192, DM = 1024, CTX = 256, MLAT = NB * SEQ, MCTX = NB * CTX, MALL = MLAT + MCTX;
constexpr int PW = 1536, KVLEN = CTX + SEQ, DFF = 2816, NMOD = 6 * DM;
constexpr int NCH = 32, CHL = 256;
constexpr float EPS = 1e-6f;
constexpr float QSCALE = 0.10206207261596575f * 1.4426950408889634f;
constexpr size_t MiB = 1u << 20;
constexpr size_t WS_CTL = 0, CTL_BYTES = 2 * MiB;
constexpr size_t WS_MOD = 64 * 1024, WS_SSQ = 512 * 1024, WS_SSKV = 1024 * 1024, WS_BAR = 1600 * 1024;
constexpr size_t WS_WIN = 2 * MiB, WS_WQ = 5 * MiB, WS_WKV = 6 * MiB, WS_WG = 7 * MiB, WS_WOUT = 8 * MiB, WS_WUP = 10 * MiB, WS_WDN = 21 * MiB;
constexpr size_t WS_AGG = 27 * MiB, WS_ROPE = 29 * MiB + 512 * 1024;
constexpr size_t WS_R1 = 30 * MiB;
constexpr size_t WS_R2 = 162 * MiB;
constexpr size_t WS_LU = 360 * MiB, WS_K = 624 * MiB, WS_V = 723 * MiB, WS_A2 = 789 * MiB;
constexpr size_t WS_UP = 360 * MiB, WS_G = 712 * MiB, WS_Q = 920 * MiB, WS_END = 1016 * MiB;
constexpr int LDS_BYTES = 139264;
constexpr int LDS_MISC = 131072 + 64;

__device__ __forceinline__ unsigned f2bf(float f) { unsigned u = __builtin_bit_cast(unsigned, f); return (u + 0x7fffu + ((u >> 16) & 1u)) >> 16; }
__device__ __forceinline__ unsigned pk2(float lo, float hi) { return f2bf(lo) | (f2bf(hi) << 16); }
__device__ __forceinline__ float bflo(unsigned w) { return __uint_as_float(w << 16); }
__device__ __forceinline__ float bfhi(unsigned w) { return __uint_as_float(w & 0xffff0000u); }
__device__ __forceinline__ float bf2f(bf16_t v) { return __uint_as_float((unsigned)v << 16); }
__device__ __forceinline__ int crow(int r, int hi) { return (r & 3) + 8 * (r >> 2) + 4 * hi; }
__device__ __forceinline__ float wave_sum(float v) {
#pragma unroll
    for (int o = 1; o < 64; o <<= 1) v += __shfl_xor(v, o);
    return v;
}
__device__ __forceinline__ float sigmoidf_(float x) { return __builtin_amdgcn_rcpf(1.f + __builtin_amdgcn_exp2f(-1.4426950408889634f * x)); }
#define LDS_WAIT() asm volatile("s_waitcnt lgkmcnt(0)" ::: "memory")
#define XB_TMO      128
#define XB_XCNT(j)  (256  + 64 * (j))
#define XB_XSUB(j)  (1280 + 64 * (j))
#define XB_XGEN(j)  (2304 + 64 * (j))
#define XB_TOP      3328
#define XB_TOPGEN   3392
#define XCD_BAR_WORDS 3456
#define XB_SPIN_CAP (1u << 18)

__device__ __forceinline__ unsigned xb_ld(unsigned* p)              { return __hip_atomic_load(p, __ATOMIC_RELAXED, __HIP_MEMORY_SCOPE_AGENT); }
__device__ __forceinline__ unsigned xb_add(unsigned* p, unsigned v) { return __hip_atomic_fetch_add(p, v, __ATOMIC_RELAXED, __HIP_MEMORY_SCOPE_AGENT); }
__device__ __forceinline__ unsigned xb_xcc_id() { return (unsigned)__builtin_amdgcn_s_getreg((3 << 11) | 20) & 0xFu; }
#define XB_SPIN(cond, bar) do { unsigned _sp = 0; while (cond) { __builtin_amdgcn_s_sleep(1); \
    if ((++_sp & 255u) == 0u) { if (xb_ld(&(bar)[XB_TMO])) break; if (_sp > XB_SPIN_CAP) { atomicAdd(&(bar)[XB_TMO], 1u); break; } } } } while (0)

struct XcdBarrier {
    unsigned* bar; unsigned x;
    volatile LAS unsigned* st;
};

__device__ __forceinline__ XcdBarrier xcd_barrier_post(unsigned* bar, volatile LAS unsigned* st) {
    XcdBarrier b; b.bar = bar; b.x = xb_xcc_id(); b.st = st;
    if (threadIdx.x == 0) (void)xb_add(&bar[XB_XCNT(b.x)], 1u);
    return b;
}
__device__ __forceinline__ void xcd_barrier_complete(unsigned* bar, unsigned x, unsigned& nloc, unsigned& nx) {
    const unsigned G = gridDim.x * gridDim.y * gridDim.z;
    unsigned sum, cnt, mine, sp = 0u;
    for (;;) {
        sum = 0u; cnt = 0u; mine = 0u;
#pragma unroll
        for (unsigned j = 0; j < 16; ++j) { const unsigned c = xb_ld(&bar[XB_XCNT(j)]); sum += c; cnt += (c > 0u) ? 1u : 0u; mine = (j == x) ? c : mine; }
        if (sum == G) break;
        __builtin_amdgcn_s_sleep(1);
        if ((++sp & 255u) == 0u) { if (xb_ld(&bar[XB_TMO])) break; if (sp > XB_SPIN_CAP) { atomicAdd(&bar[XB_TMO], 1u); break; } }
    }
    nloc = mine > 0u ? mine : 1u; nx = cnt > 0u ? cnt : 1u;
}

__device__ __forceinline__ void xcd_barrier(const XcdBarrier& b) {
    asm volatile("s_waitcnt vmcnt(0)" ::: "memory");
    __syncthreads();
    if (threadIdx.x == 0) {
        unsigned* bar = b.bar;
        __builtin_amdgcn_s_waitcnt(0);
        unsigned nloc = b.st[0], nx = b.st[1];
        if (nloc == 0u) { xcd_barrier_complete(bar, b.x, nloc, nx); b.st[0] = nloc; b.st[1] = nx; }
        const unsigned old = xb_add(&bar[XB_XSUB(b.x)], 1u);
        const unsigned gen = old / nloc;
        if (old + 1u == (gen + 1u) * nloc) {
            __builtin_amdgcn_fence(__ATOMIC_RELEASE, "agent");
            asm volatile("s_waitcnt vmcnt(0)" ::: "memory");
            const unsigned og = xb_add(&bar[XB_TOP], 1u);
            const unsigned tg = og / nx;
            if (og + 1u == (tg + 1u) * nx) xb_add(&bar[XB_TOPGEN], 1u);
            else XB_SPIN(xb_ld(&bar[XB_TOPGEN]) == tg, bar);
            __builtin_amdgcn_fence(__ATOMIC_ACQUIRE, "agent");
            xb_add(&bar[XB_XGEN(b.x)], 1u);
            asm volatile("s_waitcnt vmcnt(0)" ::: "memory");
        } else {
            XB_SPIN(xb_ld(&bar[XB_XGEN(b.x)]) == gen, bar);
            __builtin_amdgcn_fence(__ATOMIC_ACQUIRE, "agent");
            asm volatile("s_waitcnt vmcnt(0)" ::: "memory");
        }
    }
    __syncthreads();
}


struct Args { const float* in[27]; float* out; unsigned char* ws; int ph_lo, ph_hi; };
__device__ __forceinline__ const GAS float* argp(int i) {
    const __attribute__((address_space(4))) char* kp = (const __attribute__((address_space(4))) char*)__builtin_amdgcn_kernarg_segment_ptr();
    asm volatile("" : "+s"(kp));
    const float* p = *(const float* const __attribute__((address_space(4)))*)(kp + 8 * i);
    return (const GAS float*)p;
}

template <int ID> __device__ __forceinline__ float wsrc(const GAS float* __restrict__ p0, const GAS float* __restrict__ p1, int n, int k) {
    if (ID == 0) return n < 1440 ? p0[(size_t)k * 1440 + n] : 0.f;
    if (ID == 1) return p0[k] * p1[(size_t)k * 768 + n];
    if (ID == 2) return k < 128 ? p0[k] * p1[(size_t)k * 1024 + n] : 0.f;
    if (ID == 3) { const int h = n >> 8, np = n & 255, mat = np >> 6, j = np & 63, dir = mat >> 1; const GAS float* w = (mat & 1) ? p1 : p0; return w[(size_t)((dir * 8 + h) * 64 + k) * 64 + j]; }
    if (ID == 4) return p0[(size_t)k * 1024 + n];
    if (ID == 5) return p0[(size_t)k * 5632 + n];
    return p0[(size_t)k * 1024 + n];
}
template <int ID> __device__ __forceinline__ void prep_mat(const GAS float* __restrict__ p0, const GAS float* __restrict__ p1, GAS bf16_t* __restrict__ dst, int N, int K, int gtid, int NT) {
    const int items = N * (K / 8);
    for (int it = gtid; it < items; it += NT) {
        const int n = it % N, k8 = it / N;
        u32x4 o;
        o.x = pk2(wsrc<ID>(p0, p1, n, 8 * k8 + 0), wsrc<ID>(p0, p1, n, 8 * k8 + 1)); o.y = pk2(wsrc<ID>(p0, p1, n, 8 * k8 + 2), wsrc<ID>(p0, p1, n, 8 * k8 + 3));
        o.z = pk2(wsrc<ID>(p0, p1, n, 8 * k8 + 4), wsrc<ID>(p0, p1, n, 8 * k8 + 5)); o.w = pk2(wsrc<ID>(p0, p1, n, 8 * k8 + 6), wsrc<ID>(p0, p1, n, 8 * k8 + 7));
        *(GAS u32x4*)(dst + (size_t)n * K + 8 * k8) = o;
    }
}
__device__ __forceinline__ void mod_phase(const GAS float* __restrict__ cvec, const GAS float* __restrict__ cctx, const GAS float* __restrict__ wmod, const GAS float* __restrict__ bmod, GAS float* __restrict__ mod, LAS float* scr, int gw, int NGW, int lane) {
    for (int task = gw; task < 96 * 16; task += NGW) {
        const int cgp = task % 96, kc = task / 96, n = cgp * 64 + lane, k0 = kc * 64;
#pragma unroll
        for (int r = 0; r < 9; ++r) { const float cv = r < 8 ? cvec[r * 1024 + k0 + lane] : cctx[k0 + lane]; scr[r * 64 + lane] = cv / (1.f + __expf(-cv)); }
        LDS_WAIT();
        float acc[9];
#pragma unroll
        for (int r = 0; r < 9; ++r) acc[r] = 0.f;
#pragma unroll 8
        for (int kk = 0; kk < 64; ++kk) { const float w = wmod[(size_t)(k0 + kk) * NMOD + n];
#pragma unroll
            for (int r = 0; r < 9; ++r) acc[r] += scr[r * 64 + kk] * w; }
        const float bias = kc == 0 ? bmod[n] : 0.f;
#pragma unroll
        for (int r = 0; r < 9; ++r) atomicAdd((float*)(mod + r * NMOD + n), acc[r] + bias);
        LDS_WAIT();
    }
}
__device__ __forceinline__ void p1_rows(const GAS float* __restrict__ x, const GAS float* __restrict__ ctx, const GAS float* __restrict__ g, const GAS float* __restrict__ mod, GAS bf16_t* __restrict__ H, int gw, int NGW, int lane) {
    for (int m0 = 2 * gw; m0 < MALL; m0 += 2 * NGW) {
        f32x4 v[2][4]; float ss[2];
#pragma unroll
        for (int r = 0; r < 2; ++r) { const int m = m0 + r; const GAS float* src = m < MLAT ? x + (size_t)m * DM : ctx + (size_t)(m - MLAT) * DM; ss[r] = 0.f;
#pragma unroll
            for (int j = 0; j < 4; ++j) { v[r][j] = *(const GAS f32x4*)(src + 4 * lane + 256 * j); ss[r] += v[r][j].x * v[r][j].x + v[r][j].y * v[r][j].y + v[r][j].z * v[r][j].z + v[r][j].w * v[r][j].w; } }
#pragma unroll
        for (int r = 0; r < 2; ++r) { const int m = m0 + r; const GAS float* md = mod + (m < MLAT ? (m >> 13) : 8) * NMOD;
            const float rs = rsqrtf(wave_sum(ss[r]) * (1.f / DM) + EPS);
#pragma unroll
            for (int j = 0; j < 4; ++j) { const int k = 4 * lane + 256 * j;
                const f32x4 gg = *(const GAS f32x4*)(g + k), sh = *(const GAS f32x4*)(md + k), sc = *(const GAS f32x4*)(md + DM + k);
                const f32x4 y = v[r][j] * rs * gg * (sc + 1.f) + sh;
                u32x2 o; o.x = pk2(y.x, y.y); o.y = pk2(y.z, y.w); *(GAS u32x2*)(H + (size_t)m * DM + k) = o; } }
    }
}
__device__ __forceinline__ void ss_phase(const GAS bf16_t* __restrict__ P, GAS float* __restrict__ ssq, GAS float* __restrict__ sskv, int gw, int NGW, int lane) {
#pragma unroll 4
    for (int m = gw; m < MALL; m += NGW) {
        const u32x2 q = *(const GAS u32x2*)(P + (size_t)m * PW + 1024 + 4 * lane); const unsigned k = *(const GAS unsigned*)(P + (size_t)m * PW + 1280 + 2 * lane);
        float a = bflo(q.x) * bflo(q.x) + bfhi(q.x) * bfhi(q.x) + bflo(q.y) * bflo(q.y) + bfhi(q.y) * bfhi(q.y), c = bflo(k) * bflo(k) + bfhi(k) * bfhi(k);
        a = wave_sum(a); c = wave_sum(c);
        if (lane == 0) { ssq[m] = a; sskv[m] = c; }
    }
}
__device__ __forceinline__ void qpost_phase(const GAS bf16_t* __restrict__ QR, const GAS float* __restrict__ ssq, const GAS float* __restrict__ RT, GAS bf16_t* __restrict__ Q, int gtid, int NT) {
#pragma unroll 4
    for (int task = gtid; task < MLAT * 96; task += NT) {
        const int row = task / 96, c8 = task - row * 96, h = c8 / 12, dc = c8 - h * 12, b = row >> 13, s = row & 8191;
        const float sc = rsqrtf(ssq[row] * (1.f / 256.f) + EPS) * QSCALE;
        const u32x4 mine = *(const GAS u32x4*)(QR + (size_t)row * 768 + 8 * c8);
        float v[8];
#pragma unroll
        for (int j = 0; j < 4; ++j) { v[2 * j] = bflo(mine[j]) * sc; v[2 * j + 1] = bfhi(mine[j]) * sc; }
        if (dc >= 8) { const int fq = dc - 8; const u32x4 oth = *(const GAS u32x4*)(QR + (size_t)row * 768 + 8 * (c8 ^ 1));
            const GAS float* rt = RT + (fq < 2 ? (s >> 6) : (s & 63)) * 16;
#pragma unroll
            for (int j = 0; j < 8; ++j) { const float pt = ((j & 1) ? bfhi(oth[j >> 1]) : bflo(oth[j >> 1])) * sc, cs = rt[2 * j], sn = rt[2 * j + 1];
                v[j] = (fq & 1) ? v[j] * cs + pt * sn : v[j] * cs - pt * sn; } }
        u32x4 w; w.x = pk2(v[0], v[1]); w.y = pk2(v[2], v[3]); w.z = pk2(v[4], v[5]); w.w = pk2(v[6], v[7]);
        *(GAS u32x4*)(Q + ((size_t)((b * 8 + h) * SEQ + s)) * 96 + 8 * dc) = w;
    }
}
__device__ __forceinline__ void kvpost_phase(const GAS bf16_t* __restrict__ KVR, const GAS float* __restrict__ sskv, GAS bf16_t* __restrict__ Kb, GAS bf16_t* __restrict__ Vt, int gtid, int NT) {
#pragma unroll 4
    for (int task = gtid; task < MALL * 64; task += NT) {
        const int row = task >> 6, c = task & 63, h = c >> 3, dd = (c & 7) * 8; const bool lat = row < MLAT;
        const int b = lat ? (row >> 13) : ((row - MLAT) >> 8), pos = lat ? (CTX + (row & 8191)) : ((row - MLAT) & 255);
        const float rs = rsqrtf(sskv[row] * (1.f / 128.f) + EPS);
        const u32x4 mine = *(const GAS u32x4*)(KVR + (size_t)row * 1024 + h * 128 + dd);
        u32x4 w;
#pragma unroll
        for (int j = 0; j < 4; ++j) w[j] = pk2(bflo(mine[j]) * rs, bfhi(mine[j]) * rs);
        *(GAS u32x4*)(Kb + ((size_t)(b * 8 + h) * KVLEN + pos) * 96 + dd) = w;
    }
#pragma unroll 2
    for (int task = gtid; task < (MALL / 8) * 512; task += NT) {
        const int pg = task & 7, dd = (task >> 3) & 7, rest = task >> 6, hd8 = rest & 63, rb = rest >> 6, h = hd8 >> 3, d = (hd8 & 7) * 8 + dd, row0 = rb * 64 + pg * 8; const bool lat = row0 < MLAT;
        const int b = lat ? (row0 >> 13) : ((row0 - MLAT) >> 8), pos0 = lat ? (CTX + (row0 & 8191)) : ((row0 - MLAT) & 255);
        float v[8];
#pragma unroll
        for (int i = 0; i < 8; ++i) v[i] = bf2f(KVR[(size_t)(row0 + i) * 1024 + h * 128 + 64 + d]) * rsqrtf(sskv[row0 + i] * (1.f / 128.f) + EPS);
        u32x4 w; w.x = pk2(v[0], v[1]); w.y = pk2(v[2], v[3]); w.z = pk2(v[4], v[5]); w.w = pk2(v[6], v[7]);
        *(GAS u32x4*)(Vt + ((size_t)((b * 8 + h) * 64 + d)) * KVLEN + pos0) = w;
    }
}
__device__ __forceinline__ void krope_phase(const GAS bf16_t* __restrict__ P, GAS bf16_t* __restrict__ Kb, const GAS float* __restrict__ RT, int gtid, int NT) {
#pragma unroll 2
    for (int task = gtid; task < MALL * 4; task += NT) {
        const int row = task >> 2, fq = task & 3; const bool lat = row < MLAT;
        const int b = lat ? (row >> 13) : ((row - MLAT) >> 8), s = row & 8191, pos = lat ? (CTX + s) : ((row - MLAT) & 255);
        const u32x4 mine = *(const GAS u32x4*)(P + (size_t)row * PW + 1408 + 8 * fq), oth = *(const GAS u32x4*)(P + (size_t)row * PW + 1408 + 8 * (fq ^ 1));
        float v[8], pt[8];
#pragma unroll
        for (int j = 0; j < 4; ++j) { v[2 * j] = bflo(mine[j]); v[2 * j + 1] = bfhi(mine[j]); pt[2 * j] = bflo(oth[j]); pt[2 * j + 1] = bfhi(oth[j]); }
        if (lat) { const GAS float* rt = RT + (fq < 2 ? (s >> 6) : (s & 63)) * 16;
#pragma unroll
            for (int j = 0; j < 8; ++j) { const float cs = rt[2 * j], sn = rt[2 * j + 1]; v[j] = (fq & 1) ? v[j] * cs + pt[j] * sn : v[j] * cs - pt[j] * sn; } }
        u32x4 w; w.x = pk2(v[0], v[1]); w.y = pk2(v[2], v[3]); w.z = pk2(v[4], v[5]); w.w = pk2(v[6], v[7]);
#pragma unroll
        for (int h = 0; h < 8; ++h) *(GAS u32x4*)(Kb + ((size_t)(b * 8 + h) * KVLEN + pos) * 96 + 64 + 8 * fq) = w;
    }
}
#define MFMA32(a, b, c) __builtin_amdgcn_mfma_f32_32x32x16_bf16((a), (b), (c), 0, 0, 0)
__device__ __forceinline__ void gates_phase(const GAS float* __restrict__ cw, const GAS float* __restrict__ cb, const GAS float* __restrict__ b_a, const GAS float* __restrict__ b_x, const GAS float* __restrict__ lam, LAS unsigned char* lds, const GAS bf16_t* __restrict__ P, const GAS bf16_t* __restrict__ Wg, GAS unsigned* __restrict__ LU, GAS f32x2* __restrict__ AGG, int tid, int wave, int lane) {
    LAS bf16_t* xs = (LAS bf16_t*)(lds + wave * 4608);
    LAS f32x2* wagg = (LAS f32x2*)(lds + 8 * 4608);
    const int r32 = lane & 31, hi = lane >> 5;
    for (int unit = blockIdx.x; unit < (MALL / 256) * 8; unit += gridDim.x) {
        const int pm = unit >> 3, h = unit & 7, m0 = pm * 256 + wave * 32;
        const int s0 = m0 < MLAT ? (m0 & ~8191) : (MLAT + ((m0 - MLAT) & ~255)), slen = m0 < MLAT ? SEQ : CTX;
        {
            const int tok = lane >> 1, m = m0 + tok;
#pragma unroll
            for (int c8 = 0; c8 < 4; ++c8) { const int ch = (lane & 1) * 32 + c8 * 8, gch = h * 64 + ch;
                float acc[8];
                { const f32x4 b0 = *(const GAS f32x4*)(cb + gch), b1 = *(const GAS f32x4*)(cb + gch + 4);
                  acc[0] = b0.x; acc[1] = b0.y; acc[2] = b0.z; acc[3] = b0.w; acc[4] = b1.x; acc[5] = b1.y; acc[6] = b1.z; acc[7] = b1.w; }
#pragma unroll
                for (int k = 0; k < 4; ++k) { const int mm = m + k - 2;
                    if (mm >= s0 && mm < s0 + slen) { const u32x4 xv = *(const GAS u32x4*)(P + (size_t)mm * PW + gch);
                        const f32x4 w0 = *(const GAS f32x4*)(cw + k * 512 + gch), w1 = *(const GAS f32x4*)(cw + k * 512 + gch + 4);
                        acc[0] += w0.x * bflo(xv.x); acc[1] += w0.y * bfhi(xv.x); acc[2] += w0.z * bflo(xv.y); acc[3] += w0.w * bfhi(xv.y);
                        acc[4] += w1.x * bflo(xv.z); acc[5] += w1.y * bfhi(xv.z); acc[6] += w1.z * bflo(xv.w); acc[7] += w1.w * bfhi(xv.w); } }
                u32x4 o; o.x = pk2(acc[0], acc[1]); o.y = pk2(acc[2], acc[3]); o.z = pk2(acc[4], acc[5]); o.w = pk2(acc[6], acc[7]);
                *(LAS u32x4*)(xs + tok * 72 + ch) = o; }
        }
        LDS_WAIT();
        bf16x8 afr[4];
#pragma unroll
        for (int ks = 0; ks < 4; ++ks) afr[ks] = *(const LAS bf16x8*)(xs + r32 * 72 + 16 * ks + 8 * hi);
#pragma unroll
        for (int jh = 0; jh < 2; ++jh) {
            f32x16 acc4[4];
#pragma unroll
            for (int q = 0; q < 4; ++q) {
#pragma unroll
                for (int i = 0; i < 16; ++i) acc4[q][i] = 0.f;
                const GAS bf16_t* wrow = Wg + (size_t)(h * 256 + (2 * q + jh) * 32 + r32) * 64 + 8 * hi;
#pragma unroll
                for (int ks = 0; ks < 4; ++ks) { const bf16x8 bfr = *(const GAS bf16x8*)(wrow + 16 * ks); acc4[q] = MFMA32(afr[ks], bfr, acc4[q]); }
            }
            const int ch = jh * 32 + r32, gch = h * 64 + ch;
            float ba[2], bx[2], sp[2];
#pragma unroll
            for (int d = 0; d < 2; ++d) { ba[d] = b_a[d * 512 + gch]; bx[d] = b_x[d * 512 + gch]; const float nl = -lam[d * 512 + gch];
                sp[d] = 8.f * 1.4426950408889634f * (nl > 20.f ? nl : log1pf(__expf(nl))); }
            unsigned wv[16][2];
#pragma unroll
            for (int i = 0; i < 16; ++i) { const int row = crow(i, hi); const float xv = bf2f(xs[row * 72 + ch]);
#pragma unroll
                for (int d = 0; d < 2; ++d) { const float r = sigmoidf_(acc4[2 * d][i] + ba[d]), ig = sigmoidf_(acc4[2 * d + 1][i] + bx[d]);
                    const float la2 = -r * sp[d]; const float uu = __builtin_amdgcn_sqrtf(fmaxf(1.f - __builtin_amdgcn_exp2f(2.f * la2), 0.f)) * (ig * xv);
                    wv[i][d] = pk2(la2, uu);
                    LU[((size_t)(m0 + row) * 2 + d) * 512 + gch] = wv[i][d]; } }
#pragma unroll
            for (int d = 0; d < 2; ++d) {
                float Ar[4], Ur[4];
#pragma unroll
                for (int g = 0; g < 4; ++g) { float A = 1.f, U = 0.f;
#pragma unroll
                    for (int jj = 0; jj < 4; ++jj) { const int j = d ? 3 - jj : jj; const unsigned w = wv[4 * g + j][d]; const float av = __builtin_amdgcn_exp2f(bflo(w)); A *= av; U = av * U + bfhi(w); }
                    Ar[g] = A; Ur[g] = U; }
                float A = 1.f, U = 0.f;
#pragma unroll
                for (int gg = 0; gg < 4; ++gg) { const int g = d ? 3 - gg : gg;
                    const float Ao = __shfl_xor(Ar[g], 32), Uo = __shfl_xor(Ur[g], 32);
                    if (d == 0) { U = Ar[g] * U + Ur[g]; A *= Ar[g]; U = Ao * U + Uo; A *= Ao; }
                    else        { U = Ao * U + Uo; A *= Ao; U = Ar[g] * U + Ur[g]; A *= Ar[g]; } }
                if (hi == 0) wagg[(wave * 2 + d) * 64 + ch] = (f32x2){A, U};
            }
        }
        LDS_WAIT();
        __syncthreads();
        if (tid < 128) {
            const int d = tid >> 6, ch = tid & 63; float A = 1.f, U = 0.f;
#pragma unroll
            for (int ww = 0; ww < 8; ++ww) { const int w = d ? 7 - ww : ww; const f32x2 g = wagg[(w * 2 + d) * 64 + ch]; U = g.x * U + g.y; A *= g.x; }
            const int b = pm < MLAT / 256 ? (pm >> 5) : (pm - MLAT / 256), c = pm < MLAT / 256 ? (pm & 31) : NCH;
            AGG[(size_t)((b * 2 + d) * (NCH + 1) + c) * 512 + h * 64 + ch] = (f32x2){A, U};
        }
        __syncthreads();
    }
}
__device__ __forceinline__ void scan_agg(const GAS unsigned* __restrict__ LU, GAS f32x2* __restrict__ AGG, int gw, int NGW, int lane) {
    for (int task = gw; task < NB * 2 * (NCH + 1) * 8; task += NGW) {
        const int cgp = task & 7, c = (task >> 3) % (NCH + 1), d = (task / (8 * (NCH + 1))) & 1, b = task / (16 * (NCH + 1));
        const int ch = cgp * 64 + lane, row0 = c < NCH ? b * SEQ + c * CHL : MLAT + b * CTX;
        float A = 1.f, U = 0.f;
#pragma unroll 16
        for (int t = 0; t < CHL; ++t) { const int tt = d ? CHL - 1 - t : t; const unsigned w = LU[((size_t)(row0 + tt) * 2 + d) * 512 + ch];
            const float av = __builtin_amdgcn_exp2f(bflo(w)); A *= av; U = av * U + bfhi(w); }
        AGG[(size_t)((b * 2 + d) * (NCH + 1) + c) * 512 + ch] = (f32x2){A, U};
    }
}
__device__ __forceinline__ float gelu_tanh(float x) { const float z = 0.7978845608028654f * (x + 0.044715f * x * x * x);
    return x * __builtin_amdgcn_rcpf(1.f + __builtin_amdgcn_exp2f(-2.8853900817779268f * z)); }
__device__ __forceinline__ void scan_final(const GAS unsigned* __restrict__ LU, const GAS f32x2* __restrict__ AGG, const GAS bf16_t* __restrict__ P, GAS bf16_t* __restrict__ A2, int gw, int NGW, int lane) {
    constexpr int BT = 16;
    for (int task = gw; task < NB * NCH * 8; task += NGW) {
        const int cgp = task & 7, c = (task >> 3) & (NCH - 1), b = task / (8 * NCH), ch = cgp * 64 + lane, row0 = b * SEQ + c * CHL;
        const GAS f32x2* ag0 = AGG + (size_t)((b * 2 + 0) * (NCH + 1)) * 512 + ch; const GAS f32x2* ag1 = AGG + (size_t)((b * 2 + 1) * (NCH + 1)) * 512 + ch;
        float hf = ag0[(size_t)NCH * 512].y;
        for (int cc = 0; cc < c; ++cc) { const f32x2 g = ag0[(size_t)cc * 512]; hf = g.x * hf + g.y; }
        float hb = ag1[(size_t)NCH * 512].y;
        for (int cc = NCH - 1; cc > c; --cc) { const f32x2 g = ag1[(size_t)cc * 512]; hb = g.x * hb + g.y; }
#pragma unroll 1
        for (int t0 = 0; t0 < CHL; t0 += BT) { unsigned w[BT];
#pragma unroll
            for (int i = 0; i < BT; ++i) w[i] = LU[((size_t)(row0 + t0 + i) * 2 + 0) * 512 + ch];
#pragma unroll
            for (int i = 0; i < BT; ++i) { hf = __builtin_amdgcn_exp2f(bflo(w[i])) * hf + bfhi(w[i]); A2[(size_t)(row0 + t0 + i) * DM + ch] = (bf16_t)f2bf(hf); } }
#pragma unroll 1
        for (int t0 = CHL - BT; t0 >= 0; t0 -= BT) { unsigned w[BT]; bf16_t f[BT], gr[BT];
#pragma unroll
            for (int i = 0; i < BT; ++i) { w[i] = LU[((size_t)(row0 + t0 + i) * 2 + 1) * 512 + ch]; f[i] = A2[(size_t)(row0 + t0 + i) * DM + ch]; gr[i] = P[(size_t)(row0 + t0 + i) * PW + 512 + ch]; }
#pragma unroll
            for (int i = BT - 1; i >= 0; --i) { hb = __builtin_amdgcn_exp2f(bflo(w[i])) * hb + bfhi(w[i]);
                A2[(size_t)(row0 + t0 + i) * DM + ch] = (bf16_t)f2bf((bf2f(f[i]) + hb) * gelu_tanh(bf2f(gr[i]))); } }
    }
}
constexpr int AT_KROW = 208, AT_VROW = 144;
constexpr float AT_THR = 8.f;
__device__ __forceinline__ unsigned cvtpk(float lo, float hi) { typedef float f2 __attribute__((ext_vector_type(2))); typedef __bf16 b2 __attribute__((ext_vector_type(2))); f2 v = {lo, hi}; b2 r = __builtin_convertvector(v, b2); return __builtin_bit_cast(unsigned, r); }
#define AT_SOFTMAX(P, M, L, O0, O1, PW0, PW1) do { \
        float mx_ = fmaxf(fmaxf(P[0], P[1]), fmaxf(P[2], P[3])); \
        _Pragma("unroll") for (int i_ = 4; i_ < 16; i_ += 4) mx_ = fmaxf(fmaxf(mx_, P[i_]), fmaxf(fmaxf(P[i_ + 1], P[i_ + 2]), P[i_ + 3])); \
        mx_ = fmaxf(mx_, __shfl_xor(mx_, 32)); \
        if (__any(mx_ > M + AT_THR)) { const float mn_ = fmaxf(M, mx_), al_ = __builtin_amdgcn_exp2f(M - mn_); M = mn_; L *= al_; \
            _Pragma("unroll") for (int i_ = 0; i_ < 16; ++i_) { O0[i_] *= al_; O1[i_] *= al_; } } \
        float s_ = 0.f; \
        _Pragma("unroll") for (int i_ = 0; i_ < 16; ++i_) { P[i_] = __builtin_amdgcn_exp2f(P[i_] - M); s_ += P[i_]; } \
        L += s_; \
        _Pragma("unroll") for (int j_ = 0; j_ < 4; ++j_) { PW0[j_] = cvtpk(P[2 * j_], P[2 * j_ + 1]); PW1[j_] = cvtpk(P[8 + 2 * j_], P[9 + 2 * j_]); } } while (0)
__device__ __forceinline__ void glds16(const GAS void* gsrc, unsigned lds_dst) {
    unsigned keep;
    asm volatile("s_mov_b32 %0, m0\n\ts_mov_b32 m0, %2\n\ts_nop 0\n\tglobal_load_lds_dwordx4 %1, off\n\ts_mov_b32 m0, %0" : "=&s"(keep) : "v"(gsrc), "s"(lds_dst) : "memory");
}
constexpr int AT_SLOT = 22 * 1024, AT_VOFF = 13 * 1024, AT_NP = 22;
__device__ __forceinline__ void attn_unit(LAS unsigned char* lds, const GAS bf16_t* __restrict__ QR, const GAS float* __restrict__ ssq, const GAS float* __restrict__ RT, const GAS bf16_t* __restrict__ K, const GAS bf16_t* __restrict__ Vt, GAS bf16_t* __restrict__ A2, int b, int h, int qb, int tid, int wave, int lane) {
    const int r32 = lane & 31, hi = lane >> 5, q0 = qb * 512 + wave * 64, r32s = (r32 & ~12) | ((r32 & 4) << 1) | ((r32 & 8) >> 1);
    bf16x8 qa[6], qc[6];
#pragma unroll
    for (int sub = 0; sub < 2; ++sub) {
        const int s = q0 + 32 * sub + r32, row = b * SEQ + s;
        const GAS bf16_t* Qp = QR + (size_t)row * 768 + h * 96 + 8 * hi;
        const float sc = rsqrtf(ssq[row] * (1.f / 256.f) + EPS) * QSCALE;
#pragma unroll
        for (int d0 = 0; d0 < 6; ++d0) {
            const u32x4 raw = *(const GAS u32x4*)(Qp + 16 * d0);
            float v[8];
#pragma unroll
            for (int j = 0; j < 4; ++j) { v[2 * j] = bflo(raw[j]) * sc; v[2 * j + 1] = bfhi(raw[j]) * sc; }
            if (d0 >= 4) { const GAS float* rt = RT + (d0 == 4 ? (s >> 6) : (s & 63)) * 16;
#pragma unroll
                for (int j = 0; j < 8; ++j) { const float pt = __shfl_xor(v[j], 32), cs = rt[2 * j], sn = rt[2 * j + 1]; v[j] = hi ? v[j] * cs + pt * sn : v[j] * cs - pt * sn; } }
            u32x4 w; w.x = pk2(v[0], v[1]); w.y = pk2(v[2], v[3]); w.z = pk2(v[4], v[5]); w.w = pk2(v[6], v[7]);
            if (sub == 0) qa[d0] = __builtin_bit_cast(bf16x8, w); else qc[d0] = __builtin_bit_cast(bf16x8, w);
        }
    }
    const GAS unsigned char* Kg = (const GAS unsigned char*)(K + (size_t)(b * 8 + h) * KVLEN * 96);
    const GAS unsigned char* Vg = (const GAS unsigned char*)(Vt + (size_t)(b * 8 + h) * 64 * KVLEN);
    const unsigned ldsb = (unsigned)(size_t)lds;
    const GAS unsigned char* src[3]; int stride[3]; unsigned dsto[3];
#pragma unroll
    for (int k = 0; k < 3; ++k) { int j = wave + 8 * k; if (j >= AT_NP) j -= 8; const int id = j * 64 + lane;
        if (j < 13) { const int row = id / 13; int col = id - row * 13; if (col == 12) col = 0; src[k] = Kg + row * 192 + col * 16; stride[k] = 12288; }
        else { const int idv = id - 832, d = idv / 9; int c = idv - d * 9; if (c == 8) c = 0; src[k] = Vg + ((size_t)d * KVLEN + c * 8) * 2; stride[k] = 128; }
        dsto[k] = ldsb + j * 1024; }
#define AT_ISSUE(t, slot) do { _Pragma("unroll") for (int k_ = 0; k_ < 3; ++k_) glds16(src[k_] + (size_t)(t) * stride[k_], (unsigned)__builtin_amdgcn_readfirstlane(dsto[k_] + (slot) * AT_SLOT)); } while (0)
    f32x16 oA0, oA1, oB0, oB1;
#pragma unroll
    for (int i = 0; i < 16; ++i) { oA0[i] = 0.f; oA1[i] = 0.f; oB0[i] = 0.f; oB1[i] = 0.f; }
    float mA = -1e30f, mB = -1e30f, lA = 0.f, lB = 0.f;
    constexpr int NT_ = KVLEN / 64;
    AT_ISSUE(0, 0); AT_ISSUE(1, 1);
    int slot = 0, nslot = 2;
#pragma unroll 1
    for (int t = 0; t < NT_; ++t) {
        if (t + 1 < NT_) asm volatile("s_waitcnt vmcnt(3) lgkmcnt(0)\n\ts_barrier" ::: "memory"); else asm volatile("s_waitcnt vmcnt(0) lgkmcnt(0)\n\ts_barrier" ::: "memory");
        if (t + 2 < NT_) AT_ISSUE(t + 2, nslot);
        const LAS unsigned char* sb = lds + slot * AT_SLOT;
#pragma unroll
        for (int hh = 0; hh < 2; ++hh) {
            const LAS unsigned char* kb = sb + (32 * hh + r32s) * AT_KROW + hi * 16;
            f32x16 pA, pB;
#pragma unroll
            for (int i = 0; i < 16; ++i) { pA[i] = 0.f; pB[i] = 0.f; }
#pragma unroll
            for (int d0 = 0; d0 < 6; ++d0) { const bf16x8 a0 = *(const LAS bf16x8*)(kb + d0 * 32); pA = MFMA32(a0, qa[d0], pA); pB = MFMA32(a0, qc[d0], pB); }
            u32x4 pwA0, pwA1, pwB0, pwB1;
            AT_SOFTMAX(pA, mA, lA, oA0, oA1, pwA0, pwA1);
            AT_SOFTMAX(pB, mB, lB, oB0, oB1, pwB0, pwB1);
            const LAS unsigned char* vb = sb + AT_VOFF + r32 * AT_VROW + hi * 16 + hh * 64;
#pragma unroll
            for (int ks = 0; ks < 2; ++ks) {
                const bf16x8 va0 = *(const LAS bf16x8*)(vb + ks * 32), va1 = *(const LAS bf16x8*)(vb + 32 * AT_VROW + ks * 32);
                const bf16x8 pa = __builtin_bit_cast(bf16x8, ks ? pwA1 : pwA0), pb = __builtin_bit_cast(bf16x8, ks ? pwB1 : pwB0);
                oA0 = MFMA32(va0, pa, oA0); oA1 = MFMA32(va1, pa, oA1); oB0 = MFMA32(va0, pb, oB0); oB1 = MFMA32(va1, pb, oB1);
            }
        }
        slot = slot == 2 ? 0 : slot + 1; nslot = nslot == 2 ? 0 : nslot + 1;
    }
    asm volatile("s_waitcnt lgkmcnt(0)\n\ts_barrier" ::: "memory");
    {   const float inv = 1.f / (lA + __shfl_xor(lA, 32));
        GAS bf16_t* op = A2 + (size_t)(b * SEQ + q0 + r32) * DM + 512 + h * 64 + 4 * hi;
#pragma unroll
        for (int g = 0; g < 4; ++g) { u32x2 w0, w1; w0.x = pk2(oA0[4 * g] * inv, oA0[4 * g + 1] * inv); w0.y = pk2(oA0[4 * g + 2] * inv, oA0[4 * g + 3] * inv);
            w1.x = pk2(oA1[4 * g] * inv, oA1[4 * g + 1] * inv); w1.y = pk2(oA1[4 * g + 2] * inv, oA1[4 * g + 3] * inv);
            *(GAS u32x2*)(op + 8 * g) = w0; *(GAS u32x2*)(op + 32 + 8 * g) = w1; } }
    {   const float inv = 1.f / (lB + __shfl_xor(lB, 32));
        GAS bf16_t* op = A2 + (size_t)(b * SEQ + q0 + 32 + r32) * DM + 512 + h * 64 + 4 * hi;
#pragma unroll
        for (int g = 0; g < 4; ++g) { u32x2 w0, w1; w0.x = pk2(oB0[4 * g] * inv, oB0[4 * g + 1] * inv); w0.y = pk2(oB0[4 * g + 2] * inv, oB0[4 * g + 3] * inv);
            w1.x = pk2(oB1[4 * g] * inv, oB1[4 * g + 1] * inv); w1.y = pk2(oB1[4 * g + 2] * inv, oB1[4 * g + 3] * inv);
            *(GAS u32x2*)(op + 8 * g) = w0; *(GAS u32x2*)(op + 32 + 8 * g) = w1; } }
#undef AT_ISSUE
}
__device__ __forceinline__ void p7_rows(const GAS float* __restrict__ x, const GAS float* __restrict__ g_post, const GAS float* __restrict__ g_pre, GAS float* __restrict__ out, const GAS float* __restrict__ mod, const GAS bf16_t* __restrict__ Y, GAS bf16_t* __restrict__ H2, int gw, int NGW, int lane) {
    for (int m0 = 2 * gw; m0 < MLAT; m0 += 2 * NGW) {
        const GAS float* md = mod + (m0 >> 13) * NMOD;
        f32x4 y[2][4], xv[2][4]; float ss[2];
#pragma unroll
        for (int r = 0; r < 2; ++r) { ss[r] = 0.f;
#pragma unroll
            for (int j = 0; j < 4; ++j) { const u32x2 w = *(const GAS u32x2*)(Y + (size_t)(m0 + r) * DM + 4 * lane + 256 * j); xv[r][j] = *(const GAS f32x4*)(x + (size_t)(m0 + r) * DM + 4 * lane + 256 * j);
                y[r][j] = (f32x4){bflo(w.x), bfhi(w.x), bflo(w.y), bfhi(w.y)}; ss[r] += y[r][j].x * y[r][j].x + y[r][j].y * y[r][j].y + y[r][j].z * y[r][j].z + y[r][j].w * y[r][j].w; } }
#pragma unroll
        for (int r = 0; r < 2; ++r) { const int m = m0 + r;
            const float rs = rsqrtf(wave_sum(ss[r]) * (1.f / DM) + EPS); float s2 = 0.f;
#pragma unroll
            for (int j = 0; j < 4; ++j) { const int k = 4 * lane + 256 * j;
                const f32x4 gg = *(const GAS f32x4*)(g_post + k), gt = *(const GAS f32x4*)(md + 2 * DM + k);
                xv[r][j] = xv[r][j] + gt * (y[r][j] * rs * gg); *(GAS f32x4*)(out + (size_t)m * DM + k) = xv[r][j];
                s2 += xv[r][j].x * xv[r][j].x + xv[r][j].y * xv[r][j].y + xv[r][j].z * xv[r][j].z + xv[r][j].w * xv[r][j].w; }
            const float rs2 = rsqrtf(wave_sum(s2) * (1.f / DM) + EPS);
#pragma unroll
            for (int j = 0; j < 4; ++j) { const int k = 4 * lane + 256 * j;
                const f32x4 gg = *(const GAS f32x4*)(g_pre + k), sh = *(const GAS f32x4*)(md + 3 * DM + k), sc = *(const GAS f32x4*)(md + 4 * DM + k);
                const f32x4 hh = xv[r][j] * rs2 * gg * (sc + 1.f) + sh;
                u32x2 o; o.x = pk2(hh.x, hh.y); o.y = pk2(hh.z, hh.w); *(GAS u32x2*)(H2 + (size_t)m * DM + k) = o; } }
    }
}
__device__ __forceinline__ void p11_rows(const GAS float* __restrict__ g_post, GAS float* __restrict__ out, const GAS float* __restrict__ mod, const GAS bf16_t* __restrict__ Fb, int gw, int NGW, int lane) {
    for (int m0 = 2 * gw; m0 < MLAT; m0 += 2 * NGW) {
        const GAS float* md = mod + (m0 >> 13) * NMOD;
        f32x4 y[2][4], xv[2][4]; float ss[2];
#pragma unroll
        for (int r = 0; r < 2; ++r) { ss[r] = 0.f;
#pragma unroll
            for (int j = 0; j < 4; ++j) { const u32x2 w = *(const GAS u32x2*)(Fb + (size_t)(m0 + r) * DM + 4 * lane + 256 * j); xv[r][j] = *(const GAS f32x4*)(out + (size_t)(m0 + r) * DM + 4 * lane + 256 * j);
                y[r][j] = (f32x4){bflo(w.x), bfhi(w.x), bflo(w.y), bfhi(w.y)}; ss[r] += y[r][j].x * y[r][j].x + y[r][j].y * y[r][j].y + y[r][j].z * y[r][j].z + y[r][j].w * y[r][j].w; } }
#pragma unroll
        for (int r = 0; r < 2; ++r) { const float rs = rsqrtf(wave_sum(ss[r]) * (1.f / DM) + EPS);
#pragma unroll
            for (int j = 0; j < 4; ++j) { const int k = 4 * lane + 256 * j;
                const f32x4 gg = *(const GAS f32x4*)(g_post + k), gt = *(const GAS f32x4*)(md + 5 * DM + k);
                *(GAS f32x4*)(out + (size_t)(m0 + r) * DM + k) = xv[r][j] + gt * (y[r][j] * rs * gg); } }
    }
}
__device__ __forceinline__ void convgate_phase(const GAS float* __restrict__ cw, const GAS float* __restrict__ cb, const GAS bf16_t* __restrict__ UP, GAS bf16_t* __restrict__ G, int half, int gtid, int NT) {
    constexpr int JG = DFF / 8, RG = 32, NTASK = (MLAT / 2 / RG) * JG;
    for (int task = gtid; task < NTASK; task += NT) {
        const int jg = task % JG, rg = task / JG, j0 = jg * 8, r0 = rg * RG, m0 = half * (MLAT / 2) + r0;
        float wu[3][8], wg[3][8], bu[8], bg[8];
#pragma unroll
        for (int k = 0; k < 3; ++k)
#pragma unroll
            for (int i = 0; i < 8; ++i) { wu[k][i] = cw[k * 2 * DFF + j0 + i]; wg[k][i] = cw[k * 2 * DFF + DFF + j0 + i]; }
#pragma unroll
        for (int i = 0; i < 8; ++i) { bu[i] = cb[j0 + i]; bg[i] = cb[DFF + j0 + i]; }
        const GAS bf16_t* up = UP + (size_t)r0 * (2 * DFF) + j0;
        u32x4 pu = {0u, 0u, 0u, 0u}, pg = {0u, 0u, 0u, 0u}, cu, cg_, nu, ng;
        if ((m0 & 8191) != 0) { pu = *(const GAS u32x4*)(up - 2 * DFF); pg = *(const GAS u32x4*)(up - 2 * DFF + DFF); }
        cu = *(const GAS u32x4*)(up); cg_ = *(const GAS u32x4*)(up + DFF);
#pragma unroll 8
        for (int r = 0; r < RG; ++r) {
            const bool nv = (r + 1 < RG) || (((m0 + RG) & 8191) != 0);
            if (nv) { nu = *(const GAS u32x4*)(up + (size_t)(r + 1) * (2 * DFF)); ng = *(const GAS u32x4*)(up + (size_t)(r + 1) * (2 * DFF) + DFF); } else { nu = (u32x4){0u, 0u, 0u, 0u}; ng = nu; }
            float o[8];
#pragma unroll
            for (int i = 0; i < 8; ++i) { const int w_ = i >> 1;
                const float p_u = (i & 1) ? bfhi(pu[w_]) : bflo(pu[w_]), c_u = (i & 1) ? bfhi(cu[w_]) : bflo(cu[w_]), n_u = (i & 1) ? bfhi(nu[w_]) : bflo(nu[w_]);
                const float p_g = (i & 1) ? bfhi(pg[w_]) : bflo(pg[w_]), c_g = (i & 1) ? bfhi(cg_[w_]) : bflo(cg_[w_]), n_g = (i & 1) ? bfhi(ng[w_]) : bflo(ng[w_]);
                const float uv = bu[i] + wu[0][i] * p_u + wu[1][i] * c_u + wu[2][i] * n_u, gv = bg[i] + wg[0][i] * p_g + wg[1][i] * c_g + wg[2][i] * n_g;
                o[i] = gv * __builtin_amdgcn_rcpf(1.f + __builtin_amdgcn_exp2f(-1.4426950408889634f * gv)) * uv; }
            u32x4 w; w.x = pk2(o[0], o[1]); w.y = pk2(o[2], o[3]); w.z = pk2(o[4], o[5]); w.w = pk2(o[6], o[7]);
            *(GAS u32x4*)(G + (size_t)(r0 + r) * DFF + j0) = w;
            pu = cu; pg = cg_; cu = nu; cg_ = ng;
        }
    }
}
constexpr int NPH = 17;
__global__ void __launch_bounds__(512, 2) fwd_kernel(Args a) {
    extern __shared__ __attribute__((aligned(16))) unsigned char lds_raw[];
    LAS unsigned char* lds = (LAS unsigned char*)lds_raw;
    const int lo = a.ph_lo, hi_ = a.ph_hi;
    {
        volatile LAS unsigned* st0 = (volatile LAS unsigned*)(lds + LDS_MISC);
        if (threadIdx.x < 2) st0[threadIdx.x] = 0u;
        __syncthreads();
        (void)xcd_barrier_post((unsigned*)(a.ws + WS_BAR), st0);
    }
#if MK_COOP
    cg::grid_group grid = cg::this_grid();
#endif
    typedef pg8::EpiBf16<0> EpiB;
    constexpr int MH = MLAT / 2;
#ifndef REPMASK
#define REPMASK 0
#endif
    bool repeated = false;
#pragma unroll 1
    for (int ph = lo; ph < hi_; ++ph) {
        int tid = threadIdx.x; asm volatile("" : "+v"(tid));
        int G = gridDim.x, bx = blockIdx.x; asm volatile("" : "+s"(G), "+s"(bx));
        const int lane = tid & 63, wave = __builtin_amdgcn_readfirstlane(tid >> 6);
        const int vcu = (G % 8 == 0) ? (bx % 8) * (G / 8) + bx / 8 : bx;
        const int gw = vcu * 8 + wave, NGW = G * 8, gtid = bx * 512 + tid, NTH = G * 512;
        unsigned char* ws_ = a.ws; asm volatile("" : "+s"(ws_)); GAS unsigned char* ws = (GAS unsigned char*)ws_;
        GAS float* mod = (GAS float*)(ws + WS_MOD); GAS float* ssq = (GAS float*)(ws + WS_SSQ); GAS float* sskv = (GAS float*)(ws + WS_SSKV);
        GAS bf16_t* Win = (GAS bf16_t*)(ws + WS_WIN); GAS bf16_t* Wq = (GAS bf16_t*)(ws + WS_WQ); GAS bf16_t* Wkv = (GAS bf16_t*)(ws + WS_WKV); GAS bf16_t* Wg = (GAS bf16_t*)(ws + WS_WG);
        GAS bf16_t* Wout = (GAS bf16_t*)(ws + WS_WOUT); GAS bf16_t* Wup = (GAS bf16_t*)(ws + WS_WUP); GAS bf16_t* Wdn = (GAS bf16_t*)(ws + WS_WDN);
        GAS f32x2* AGG = (GAS f32x2*)(ws + WS_AGG); GAS float* RT = (GAS float*)(ws + WS_ROPE);
        GAS bf16_t* H = (GAS bf16_t*)(ws + WS_R1); GAS bf16_t* KVR = H; GAS bf16_t* H2 = H; GAS bf16_t* QR = (GAS bf16_t*)(ws + WS_Q);
        GAS bf16_t* P = (GAS bf16_t*)(ws + WS_R2); GAS bf16_t* Y = P; GAS bf16_t* Fb = P;
        GAS unsigned* LU = (GAS unsigned*)(ws + WS_LU); GAS bf16_t* Kb = (GAS bf16_t*)(ws + WS_K); GAS bf16_t* Vb = (GAS bf16_t*)(ws + WS_V); GAS bf16_t* A2 = (GAS bf16_t*)(ws + WS_A2);
        GAS bf16_t* UP = (GAS bf16_t*)(ws + WS_UP); GAS bf16_t* Gb = (GAS bf16_t*)(ws + WS_G);
        float* outp_ = a.out; asm volatile("" : "+s"(outp_)); GAS float* outp = (GAS float*)outp_;
        pg8::Gemm g{nullptr, nullptr, 0, 0, 0, 0, 0}; GAS bf16_t* O = nullptr; int ldc = 0;
        switch (ph) {
            case 2:  g = pg8::Gemm{(const bf16_t*)(H), (const bf16_t*)(Win), MALL, PW, DM, DM, DM}; O = P; ldc = PW; break;
            case 4:  g = pg8::Gemm{(const bf16_t*)(P + 1024), (const bf16_t*)(Wq), MLAT, 768, 256, PW, 256}; O = QR; ldc = 768; break;
            case 5:  g = pg8::Gemm{(const bf16_t*)(P + 1280), (const bf16_t*)(Wkv), MALL, 1024, 256, PW, 256}; O = KVR; ldc = 1024; break;
            case 8:  g = pg8::Gemm{(const bf16_t*)(A2), (const bf16_t*)(Wout), MLAT, DM, DM, DM, DM}; O = Y; ldc = DM; break;
            case 10: g = pg8::Gemm{(const bf16_t*)(H2), (const bf16_t*)(Wup), MH, 2 * DFF, DM, DM, DM}; O = UP; ldc = 2 * DFF; break;
            case 13: g = pg8::Gemm{(const bf16_t*)(H2 + (size_t)MH * DM), (const bf16_t*)(Wup), MH, 2 * DFF, DM, DM, DM}; O = UP; ldc = 2 * DFF; break;
            case 12: g = pg8::Gemm{(const bf16_t*)(Gb), (const bf16_t*)(Wdn), MH, DM, DFF, DFF, DFF}; O = Fb; ldc = DM; break;
            case 15: g = pg8::Gemm{(const bf16_t*)(Gb), (const bf16_t*)(Wdn), MH, DM, DFF, DFF, DFF}; O = Fb + (size_t)MH * DM; ldc = DM; break;
            default: break;
        }
        if (g.A != nullptr) {
            pg8::StaticOrder S; S.init(g.M, g.N, G, bx); EpiB E{(bf16_t*)O, ldc, nullptr, 0, 0, 1.f};
            pg8::gemm_phase<EpiB, pg8::StaticOrder, true, true>(lds, g, S, E, tid);
        }
#ifndef NGM
#define NGM 0x1ffff
#endif
#define NG(k) ((NGM >> (k)) & 1)
        else if (NG(0) && ph == 0) {
            prep_mat<0>(argp(10), nullptr, Win, 1536, 1024, gtid, NTH); prep_mat<1>(argp(18), argp(19), Wq, 768, 256, gtid, NTH); prep_mat<2>(argp(20), argp(21), Wkv, 1024, 256, gtid, NTH);
            prep_mat<3>(argp(13), argp(15), Wg, 2048, 64, gtid, NTH); prep_mat<4>(argp(22), nullptr, Wout, 1024, 1024, gtid, NTH); prep_mat<5>(argp(23), nullptr, Wup, 5632, 1024, gtid, NTH);
            prep_mat<6>(argp(26), nullptr, Wdn, 1024, 2816, gtid, NTH);
            if (gtid < 1024) { const int pos = gtid >> 3, j = gtid & 7; const float invf[8] = {1.f, 0.31622776601683794f, 0.1f, 0.031622776601683794f, 0.01f, 0.0031622776601683794f, 0.001f, 0.00031622776601683794f};
                const float ang = (float)pos * invf[j]; RT[2 * gtid] = cosf(ang); RT[2 * gtid + 1] = sinf(ang); }
            mod_phase(argp(1), argp(3), argp(4), argp(5), mod, (LAS float*)(lds + wave * 4096), gw, NGW, lane);
        } else if (NG(1) && ph == 1) {
            p1_rows(argp(0), argp(2), argp(6), mod, H, gw, NGW, lane);
        } else if (NG(3) && ph == 3) {
            gates_phase(argp(11), argp(12), argp(14), argp(16), argp(17), lds, P, Wg, LU, AGG, tid, wave, lane);
            ss_phase(P, ssq, sskv, gw, NGW, lane);
        } else if (NG(6) && ph == 6) {
            krope_phase(P, Kb, RT, gtid, NTH); kvpost_phase(KVR, sskv, Kb, Vb, gtid, NTH);
#ifdef REP6
            if (REP6 & 1) { __syncthreads(); scan_agg(LU, AGG, gw, NGW, lane); }
            if (REP6 & 2) { __syncthreads(); krope_phase(P, Kb, RT, gtid, NTH); }
            if (REP6 & 4) { __syncthreads(); }
            if (REP6 & 8) { __syncthreads(); kvpost_phase(KVR, sskv, Kb, Vb, gtid, NTH); }
#endif
        } else if (NG(7) && ph == 7) {
            scan_final(LU, AGG, P, A2, gw, NGW, lane);
#ifdef REP7
            __syncthreads(); scan_final(LU, AGG, P, A2, gw, NGW, lane);
#endif
            const int upb = (NB * 8 * 16 + G - 1) / G, u0 = vcu * upb, u1 = min(NB * 8 * 16, u0 + upb);
            __syncthreads();
            for (int unit = u0; unit < u1; ++unit) { const int bh = unit >> 4, qb = unit & 15; attn_unit(lds, QR, ssq, RT, Kb, Vb, A2, bh >> 3, bh & 7, qb, tid, wave, lane); }
        } else if (NG(9) && ph == 9) {
            p7_rows(argp(0), argp(7), argp(8), outp, mod, Y, H2, gw, NGW, lane);
        } else if (NG(11) && (ph == 11 || ph == 14)) {
            convgate_phase(argp(24), argp(25), UP, Gb, ph == 14 ? 1 : 0, gtid, NTH);
        } else if (NG(16) && ph == 16) {
            p11_rows(argp(9), outp, mod, Fb, gw, NGW, lane);
        }
        __syncthreads();
#if MK_COOP
        if (ph + 1 < hi_ && ph != 3 && ph != 4) {
            if (ph == 0) grid.sync();
            else { XcdBarrier xb; xb.bar = (unsigned*)(ws_ + WS_BAR); xb.x = xb_xcc_id(); xb.st = (volatile LAS unsigned*)(lds + LDS_MISC); xcd_barrier(xb); }
        }
#endif
        if (REPMASK) { if (((REPMASK >> ph) & 1) && !repeated) { repeated = true; --ph; } else repeated = false; }
    }
}

extern "C" void kernel_launch(void* const* d_in, const int* in_sizes, int n_in, void* d_out, int out_size, void* d_ws, size_t ws_size, hipStream_t stream) {
    static int grid = 0;
    if (grid == 0) {
        if (n_in != 27 || out_size != MLAT * DM || ws_size < WS_END) { fprintf(stderr, "kernel_launch: unexpected shapes (n_in %d, out %d, ws %zu)\n", n_in, out_size, ws_size); grid = -1; return; }
        int dev = 0, cus = 0, per_cu = 0;
        if (hipGetDevice(&dev) != hipSuccess || hipDeviceGetAttribute(&cus, hipDeviceAttributeMultiprocessorCount, dev) != hipSuccess) { grid = -1; return; }
        if (hipFuncSetAttribute((const void*)fwd_kernel, hipFuncAttributeMaxDynamicSharedMemorySize, LDS_BYTES) != hipSuccess) { fprintf(stderr, "kernel_launch: hipFuncSetAttribute failed\n"); grid = -1; return; }
        if (hipOccupancyMaxActiveBlocksPerMultiprocessor(&per_cu, (const void*)fwd_kernel, 512, LDS_BYTES) != hipSuccess || per_cu < 1) { fprintf(stderr, "kernel_launch: occupancy query says %d\n", per_cu); }
        (void)hipGetLastError();
        grid = cus;
    }
    if (grid < 0) return;
    (void)hipMemsetAsync((char*)d_ws + WS_CTL, 0, CTL_BYTES, stream);
    Args a{};
    for (int i = 0; i < 27; ++i) a.in[i] = (const float*)d_in[i];
    a.out = (float*)d_out; a.ws = (unsigned char*)d_ws;
#if MK_COOP
    a.ph_lo = 0; a.ph_hi = NPH;
    void* args[] = {&a};
    hipError_t e = hipLaunchCooperativeKernel((const void*)fwd_kernel, dim3(grid), dim3(512), args, LDS_BYTES, stream);
    if (e != hipSuccess) fprintf(stderr, "kernel_launch: cooperative launch failed: %s (grid %d)\n", hipGetErrorString(e), grid);
#else
    for (int p = 0; p < NPH; ++p) { a.ph_lo = p; a.ph_hi = p + 1; hipLaunchKernelGGL(fwd_kernel, dim3(grid), dim3(512), LDS_BYTES, stream, a); }
#endif
}
```

```cpp
#include <hip/hip_runtime.h>
#include <hip/hip_cooperative_groups.h>
#include <cstdio>
#include <cstdint>
namespace cg = cooperative_groups;
#ifndef MK_COOP
#define MK_COOP 1
#endif
namespace pg8 {
#define PG8_LAS __attribute__((address_space(3)))
typedef unsigned short bf16_t;
typedef short bf16x8 __attribute__((ext_vector_type(8)));
typedef float f32x4 __attribute__((ext_vector_type(4)));
typedef unsigned u32x4 __attribute__((ext_vector_type(4)));
constexpr int BM = 256, BK = 64, HALF = 128, HTB = HALF * BK * 2  , STAGE_BYTES = 8 * HTB, NXCD = 8, WGM = 8;

__host__ __device__ __forceinline__ int lds_byte(int r, int c) { const int st = (r >> 4) * 2 + (c >> 5), rr = r & 15, cc = c & 31, ob = rr * 64 + cc * 2; return st * 1024 + (ob ^ (((ob >> 9) & 1) << 5)); }
__host__ __device__ __forceinline__ void stage_rc(int b, int& R, int& C) { const int st = b / 1024, sb = b % 1024, swz = sb ^ (((sb >> 9) & 1) << 5); R = (st >> 1) * 16 + swz / 64; C = (st & 1) * 32 + (swz % 64) / 2; }
__host__ __device__ __forceinline__ int perm32(int rho) { const int n = rho >> 4, i = rho & 15; return 8 * (i >> 2) + 4 * n + (i & 3); }

struct Unit { int pm, pn; };
struct Gemm { const bf16_t* A; const bf16_t* Bt; int M, N, K, lda, ldb; };

struct StaticOrder {
    int nM, nN, nwg, G, c;
    __host__ __device__ void init(int M, int N, int G_, int c_) { nM = M / BM; nN = N / BM; nwg = nM * nN; G = G_; c = c_; }
    __host__ __device__ bool next(int i, Unit& u) const {
        const long L = (long)i * G + c; if (L >= nwg) return false;
        int wgid = (int)L; { const int q = nwg / NXCD, r = nwg % NXCD, xcd = wgid % NXCD, off = wgid / NXCD; wgid = (xcd < r ? xcd * (q + 1) : r * (q + 1) + (xcd - r) * q) + off; }
        const int nig = WGM * nN, gid = wgid / nig, fm = gid * WGM, gsz = (nM - fm) < WGM ? (nM - fm) : WGM;
        u.pm = fm + ((wgid % nig) % gsz); u.pn = (wgid % nig) / gsz; return true;
    }
    __device__ __forceinline__ void a_ready(const Unit&) const {}
    __device__ __forceinline__ void done(const Unit&) const {}
};

__device__ __forceinline__ unsigned cvt_pk_bf16(float lo, float hi) { unsigned r; asm volatile("v_cvt_pk_bf16_f32 %0, %1, %2" : "=v"(r) : "v"(lo), "v"(hi)); return r; }
typedef float f32x2 __attribute__((ext_vector_type(2)));
__device__ __forceinline__ f32x2 gelu_pk(f32x2 v) {
    const f32x2 av = __builtin_elementwise_abs(v), d = av * 0.2316418882f + 1.0f;
    f32x2 t; t.x = __builtin_amdgcn_rcpf(d.x); t.y = __builtin_amdgcn_rcpf(d.y);
    f32x2 q = t * 0.5307027145f + (-0.7265760135f); q = q * t + 0.7107068705f; q = q * t + (-0.142248368f); q = q * t + 0.127414796f; q = q * t;
    const f32x2 s = (v * v) * (-0.72134752044f);
    f32x2 e; e.x = __builtin_amdgcn_exp2f(s.x); e.y = __builtin_amdgcn_exp2f(s.y);
    const f32x2 m = v * (q * e), r = v - m;
    f32x2 o; o.x = v.x < 0.f ? m.x : r.x; o.y = v.y < 0.f ? m.y : r.y; return o;
}

template <int ACT  > struct EpiBf16 {
    static constexpr bool PERM = true, AFTER_DRAIN = false; static_assert(ACT == 0 || ACT == 1, "EpiBf16: ACT is 0 (none) or 1 (gelu_pk)");
    bf16_t* O; int ldc; const float* bias; int split_cols; size_t split_stride; float scale0;
    __device__ __forceinline__ void operator()(const f32x4 (&acc)[2][2][4][2], const Unit& u, int wr, int wc, int fr, int fq) const {
        const int row0 = u.pm * BM + wr * 64 + fr; int colt = u.pn * BM; bf16_t* base = O;
        float sc = 1.f; if (split_cols) { const int t = colt / split_cols; base += (size_t)t * split_stride; colt -= t * split_cols; if (t == 0) sc = scale0; }
        const int col0 = colt + wc * 32 + 8 * fq, bcol0 = u.pn * BM + wc * 32 + 8 * fq;
        f32x4 bv[2][2];
#pragma unroll
        for (int bj = 0; bj < 2; ++bj)
#pragma unroll
            for (int n = 0; n < 2; ++n) bv[bj][n] = bias ? *(const f32x4*)(bias + bcol0 + bj * HALF + 4 * n) : (f32x4){0.f, 0.f, 0.f, 0.f};
#pragma unroll
        for (int ai = 0; ai < 2; ++ai)
#pragma unroll
            for (int m = 0; m < 4; ++m) { bf16_t* rowp = base + (size_t)(row0 + ai * HALF + m * 16) * ldc + col0;
#pragma unroll
                for (int bj = 0; bj < 2; ++bj) { f32x4 v0 = acc[ai][bj][m][0] + bv[bj][0], v1 = acc[ai][bj][m][1] + bv[bj][1];
                    if (ACT == 1) { f32x2 a = gelu_pk((f32x2){v0[0], v0[1]}), b = gelu_pk((f32x2){v0[2], v0[3]}), c = gelu_pk((f32x2){v1[0], v1[1]}), d = gelu_pk((f32x2){v1[2], v1[3]});
                        v0 = (f32x4){a.x, a.y, b.x, b.y}; v1 = (f32x4){c.x, c.y, d.x, d.y}; }
                    v0 = v0 * sc; v1 = v1 * sc; u32x4 w; w.x = cvt_pk_bf16(v0[0], v0[1]); w.y = cvt_pk_bf16(v0[2], v0[3]); w.z = cvt_pk_bf16(v1[0], v1[1]); w.w = cvt_pk_bf16(v1[2], v1[3]);
                    *(__attribute__((address_space(1))) u32x4*)(rowp + bj * HALF) = w; } }
    }
};
template <class Epi, class Sched, bool ALIGN_EPI = false, bool SP2 = false>
__device__ __forceinline__ void gemm_phase(PG8_LAS unsigned char* lds, const Gemm g, const Sched& S, const Epi& E, const int tid) {
    const int wid = __builtin_amdgcn_readfirstlane(tid >> 6), lane = tid & 63, wr = wid >> 2, wc = wid & 3, fr = lane & 15, fq = lane >> 4;
    const int K = g.K, nt = K / BK;
    unsigned voffA[2], voffB[2];
#pragma unroll
    for (int i = 0; i < 2; ++i) { int R, C; stage_rc(tid * 16 + i * 8192, R, C); const int Rb = Epi::PERM ? ((R & ~31) + perm32(R & 31)) : R;
        voffA[i] = (unsigned)(R * g.lda + C) * 2u; voffB[i] = (unsigned)(Rb * g.ldb + C) * 2u; }
    const size_t kstep = (size_t)(BK * 2);
    const size_t hstepA = (size_t)HALF * g.lda * 2, hstepB = (size_t)HALF * g.ldb * 2;
    const size_t tstepA = 2 * hstepA, tstepB = 2 * hstepB;
    const unsigned ldsw = (unsigned)wid * 1024u;
    const int aoff = lds_byte(wr * 64 + fr, fq * 8), boff = lds_byte(wc * 32 + fr, fq * 8);
#define PG8_SA(b, h) (((b) * 2 + (h)) * HTB)
#define PG8_SB(b, h) ((4 + (b) * 2 + (h)) * HTB)
#define PG8_STAGE(bufoff, gbase, voff) do { _Pragma("unroll") for (int _i = 0; _i < 2; ++_i) \
        __builtin_amdgcn_global_load_lds((const unsigned*)((const char*)(gbase) + (voff)[_i]), (PG8_LAS unsigned*)(lds + (bufoff) + ldsw + _i * 8192), 16, 0, 0); } while (0)
#define PG8_LDA(dst, b, h) do { _Pragma("unroll") for (int m = 0; m < 4; ++m) _Pragma("unroll") for (int k = 0; k < 2; ++k) dst[m][k] = *(const PG8_LAS bf16x8*)(lds + PG8_SA(b, h) + aoff + m * 2048 + k * 1024); } while (0)
#define PG8_LDB(dst, b, h) do { _Pragma("unroll") for (int n = 0; n < 2; ++n) _Pragma("unroll") for (int k = 0; k < 2; ++k) dst[n][k] = *(const PG8_LAS bf16x8*)(lds + PG8_SB(b, h) + boff + n * 2048 + k * 1024); } while (0)
#define PG8_MMA(ai, bj, At, Bt) do { __builtin_amdgcn_s_setprio(1); _Pragma("unroll") for (int m = 0; m < 4; ++m) _Pragma("unroll") for (int n = 0; n < 2; ++n) _Pragma("unroll") for (int k = 0; k < 2; ++k) \
        acc[ai][bj][m][n] = __builtin_amdgcn_mfma_f32_16x16x32_bf16(Bt[n][k], At[m][k], acc[ai][bj][m][n], 0, 0, 0); __builtin_amdgcn_s_setprio(0); } while (0)
#define PG8_WAIT_V(n) asm volatile("s_waitcnt vmcnt(" #n ")" ::: "memory")
#define PG8_WAIT_L(n) asm volatile("s_waitcnt lgkmcnt(" #n ")" ::: "memory")
#define PG8_BAR __builtin_amdgcn_s_barrier()
#define PG8_SCHED __builtin_amdgcn_sched_barrier(0)
    Unit cur, nxt; int ui = 0;
    if (!S.next(0, cur)) return;
    f32x4 acc[2][2][4][2];
#pragma unroll
    for (int a = 0; a < 2; ++a)
#pragma unroll
        for (int b = 0; b < 2; ++b)
#pragma unroll
            for (int m = 0; m < 4; ++m)
#pragma unroll
                for (int n = 0; n < 2; ++n) acc[a][b][m][n] = (f32x4){0.f, 0.f, 0.f, 0.f};
    bf16x8 At[4][2], B0[2][2], B1[2][2];
    const char* cA = (const char*)g.A + (size_t)cur.pm * tstepA; const char* cB = (const char*)g.Bt + (size_t)cur.pn * tstepB;
    S.a_ready(cur);
    if constexpr (SP2) {
        PG8_STAGE(PG8_SB(0, 0), cB, voffB); PG8_STAGE(PG8_SB(0, 1), cB + hstepB, voffB); PG8_STAGE(PG8_SA(0, 0), cA, voffA); PG8_STAGE(PG8_SA(0, 1), cA + hstepA, voffA);
        if (wr == 1) PG8_BAR;
        PG8_WAIT_V(2); PG8_BAR;
        PG8_STAGE(PG8_SB(1, 0), cB + kstep, voffB); PG8_STAGE(PG8_SA(1, 0), cA + kstep, voffA); PG8_STAGE(PG8_SB(1, 1), cB + hstepB + kstep, voffB);
        PG8_WAIT_V(6); PG8_BAR;
    } else {
        PG8_STAGE(PG8_SB(0, 0), cB, voffB); PG8_STAGE(PG8_SA(0, 0), cA, voffA); PG8_STAGE(PG8_SB(0, 1), cB + hstepB, voffB); PG8_STAGE(PG8_SA(0, 1), cA + hstepA, voffA);
        if (wr == 1) PG8_BAR;
        PG8_WAIT_V(4); PG8_BAR;
        PG8_STAGE(PG8_SB(1, 0), cB + kstep, voffB); PG8_STAGE(PG8_SA(1, 0), cA + kstep, voffA); PG8_STAGE(PG8_SB(1, 1), cB + hstepB + kstep, voffB);
        PG8_WAIT_V(6); PG8_BAR;
    }
    for (;;) {
        const bool has_next = S.next(ui + 1, nxt);
        const char* nA = has_next ? (const char*)g.A + (size_t)nxt.pm * tstepA : cA; const char* nB = has_next ? (const char*)g.Bt + (size_t)nxt.pn * tstepB : cB;
        for (int t = 0; t < nt; t += 2) {
            const bool last = (t == nt - 2);
            const char* a1 = cA + (size_t)(t + 1) * kstep;
            const char* a2 = last ? nA : cA + (size_t)(t + 2) * kstep; const char* b2 = last ? nB : cB + (size_t)(t + 2) * kstep;
            const char* a3 = a2 + kstep; const char* b3 = b2 + kstep;
            if (last && has_next) S.a_ready(nxt);
            if constexpr (SP2) {
            PG8_LDB(B0, 0, 0); PG8_LDB(B1, 0, 1); PG8_SCHED; PG8_LDA(At, 0, 0); PG8_STAGE(PG8_SA(1, 1), a1 + hstepA, voffA);
            PG8_WAIT_V(8); PG8_WAIT_L(0); PG8_BAR; PG8_MMA(0, 0, At, B0); PG8_MMA(0, 1, At, B1); PG8_BAR; PG8_SCHED;
            PG8_LDA(At, 0, 1); PG8_STAGE(PG8_SB(0, 0), b2, voffB); PG8_STAGE(PG8_SB(0, 1), b2 + hstepB, voffB); PG8_STAGE(PG8_SA(0, 0), a2, voffA);
            PG8_WAIT_V(8); PG8_WAIT_L(0); PG8_BAR; PG8_MMA(1, 0, At, B0); PG8_MMA(1, 1, At, B1); PG8_BAR; PG8_SCHED;
            PG8_LDB(B0, 1, 0); PG8_LDB(B1, 1, 1); PG8_SCHED; PG8_LDA(At, 1, 0); PG8_STAGE(PG8_SA(0, 1), a2 + hstepA, voffA);
            PG8_WAIT_V(8); PG8_WAIT_L(0); PG8_BAR; PG8_MMA(0, 0, At, B0); PG8_MMA(0, 1, At, B1); PG8_BAR; PG8_SCHED;
            PG8_LDA(At, 1, 1); PG8_STAGE(PG8_SB(1, 0), b3, voffB); PG8_STAGE(PG8_SB(1, 1), b3 + hstepB, voffB); PG8_STAGE(PG8_SA(1, 0), a3, voffA);
            PG8_WAIT_V(8); PG8_WAIT_L(0); PG8_BAR; PG8_MMA(1, 0, At, B0); PG8_MMA(1, 1, At, B1); PG8_BAR; PG8_SCHED;
            } else {
            PG8_LDB(B0, 0, 0); PG8_SCHED; PG8_LDA(At, 0, 0); PG8_STAGE(PG8_SA(1, 1), a1 + hstepA, voffA);
            PG8_WAIT_L(8); PG8_BAR; PG8_WAIT_L(0); PG8_MMA(0, 0, At, B0); PG8_BAR; PG8_SCHED;
            PG8_LDB(B1, 0, 1); PG8_STAGE(PG8_SB(0, 0), b2, voffB);
            PG8_BAR; PG8_WAIT_L(0); PG8_MMA(0, 1, At, B1); PG8_BAR;
            PG8_LDA(At, 0, 1); PG8_STAGE(PG8_SA(0, 0), a2, voffA);
            PG8_BAR; PG8_WAIT_L(0); PG8_MMA(1, 0, At, B0); PG8_BAR; PG8_SCHED;
            PG8_STAGE(PG8_SB(0, 1), b2 + hstepB, voffB);
            PG8_WAIT_V(6); PG8_BAR; PG8_MMA(1, 1, At, B1); PG8_BAR;
            PG8_LDB(B0, 1, 0); PG8_SCHED; PG8_LDA(At, 1, 0); PG8_STAGE(PG8_SA(0, 1), a2 + hstepA, voffA);
            PG8_WAIT_L(8); PG8_BAR; PG8_WAIT_L(0); PG8_MMA(0, 0, At, B0); PG8_BAR; PG8_SCHED;
            PG8_LDB(B1, 1, 1); PG8_STAGE(PG8_SB(1, 0), b3, voffB);
            PG8_BAR; PG8_WAIT_L(0); PG8_MMA(0, 1, At, B1); PG8_BAR;
            PG8_LDA(At, 1, 1); PG8_STAGE(PG8_SA(1, 0), a3, voffA);
            PG8_BAR; PG8_WAIT_L(0); PG8_MMA(1, 0, At, B0); PG8_BAR; PG8_SCHED;
            PG8_STAGE(PG8_SB(1, 1), b3 + hstepB, voffB);
            PG8_WAIT_V(6); PG8_BAR; PG8_MMA(1, 1, At, B1); PG8_BAR;
            }
        }
        if constexpr (ALIGN_EPI) { if (wr == 0) PG8_BAR; }
        if constexpr (!Epi::AFTER_DRAIN) { E(acc, cur, wr, wc, fr, fq); S.done(cur); }
        if (!has_next) break;
#pragma unroll
        for (int a = 0; a < 2; ++a)
#pragma unroll
            for (int b = 0; b < 2; ++b)
#pragma unroll
                for (int m = 0; m < 4; ++m)
#pragma unroll
                    for (int n = 0; n < 2; ++n) acc[a][b][m][n] = (f32x4){0.f, 0.f, 0.f, 0.f};
        cur = nxt; cA = nA; cB = nB; ++ui;
        if constexpr (ALIGN_EPI) { if (wr == 1) PG8_BAR; }
    }
    PG8_WAIT_V(0);
    if constexpr (!ALIGN_EPI) { if (wr == 0) PG8_BAR; }
    PG8_BAR;
    if constexpr (Epi::AFTER_DRAIN) { E.fused(acc, cur, wr, wc, fr, fq, lds, wid, lane); S.done(cur); }
#undef PG8_SA
#undef PG8_SB
#undef PG8_STAGE
#undef PG8_LDA
#undef PG8_LDB
#undef PG8_MMA
#undef PG8_WAIT_V
#undef PG8_WAIT_L
#undef PG8_BAR
#undef PG8_SCHED
}
}
#define LAS __attribute__((address_space(3)))
#define GAS __attribute__((address_space(1)))
typedef unsigned short bf16_t;
typedef short bf16x8 __attribute__((ext_vector_type(8)));
typedef short s16x4 __attribute__((ext_vector_type(4)));
typedef float f32x4 __attribute__((ext_vector_type(4)));
typedef float f32x16 __attribute__((ext_vector_type(16)));
typedef unsigned u32x4 __attribute__((ext_vector_type(4)));
typedef unsigned u32x2 __attribute__((ext_vector_type(2)));
typedef float f32x2 __attribute__((ext_vector_type(2)));

constexpr int NB = 8, SEQ = 8192, DM = 1024, CTX = 256, MLAT = NB * SEQ, MCTX = NB * CTX, MALL = MLAT + MCTX;
constexpr int PW = 1536, KVLEN = CTX + SEQ, DFF = 2816, NMOD = 6 * DM;
constexpr int NCH = 32, CHL = 256;
constexpr float EPS = 1e-6f;
constexpr float QSCALE = 0.10206207261596575f * 1.4426950408889634f;
constexpr size_t MiB = 1u << 20;
constexpr size_t WS_CTL = 0, CTL_BYTES = 2 * MiB;
constexpr size_t WS_MOD = 64 * 1024, WS_SSQ = 512 * 1024, WS_SSKV = 1024 * 1024, WS_BAR = 1600 * 1024;
constexpr size_t WS_WIN = 2 * MiB, WS_WQ = 5 * MiB, WS_WKV = 6 * MiB, WS_WG = 7 * MiB, WS_WOUT = 8 * MiB, WS_WUP = 10 * MiB, WS_WDN = 21 * MiB;
constexpr size_t WS_AGG = 27 * MiB, WS_ROPE = 29 * MiB + 512 * 1024;
constexpr size_t WS_R1 = 30 * MiB;
constexpr size_t WS_R2 = 162 * MiB;
constexpr size_t WS_LU = 360 * MiB, WS_K = 624 * MiB, WS_V = 723 * MiB, WS_A2 = 789 * MiB;
constexpr size_t WS_UP = 360 * MiB, WS_G = 712 * MiB, WS_Q = 920 * MiB, WS_END = 1016 * MiB;
constexpr int LDS_BYTES = 139264;
constexpr int LDS_MISC = 131072 + 64;

__device__ __forceinline__ unsigned f2bf(float f) { unsigned u = __builtin_bit_cast(unsigned, f); return (u + 0x7fffu + ((u >> 16) & 1u)) >> 16; }
__device__ __forceinline__ unsigned cvtpk(float lo, float hi) { typedef float f2 __attribute__((ext_vector_type(2))); typedef __bf16 b2 __attribute__((ext_vector_type(2))); f2 v = {lo, hi}; b2 r = __builtin_convertvector(v, b2); return __builtin_bit_cast(unsigned, r); }
__device__ __forceinline__ unsigned pk2(float lo, float hi) { return cvtpk(lo, hi); }
__device__ __forceinline__ float bflo(unsigned w) { return __uint_as_float(w << 16); }
__device__ __forceinline__ float bfhi(unsigned w) { return __uint_as_float(w & 0xffff0000u); }
__device__ __forceinline__ float bf2f(bf16_t v) { return __uint_as_float((unsigned)v << 16); }
__device__ __forceinline__ int crow(int r, int hi) { return (r & 3) + 8 * (r >> 2) + 4 * hi; }
__device__ __forceinline__ float wave_sum(float v) {
#pragma unroll
    for (int o = 1; o < 64; o <<= 1) v += __shfl_xor(v, o);
    return v;
}
__device__ __forceinline__ float sigmoidf_(float x) { return __builtin_amdgcn_rcpf(1.f + __builtin_amdgcn_exp2f(-1.4426950408889634f * x)); }
#define LDS_WAIT() asm volatile("s_waitcnt lgkmcnt(0)" ::: "memory")
#define XB_TMO      128
#define XB_XCNT(j)  (256  + 64 * (j))
#define XB_XSUB(j)  (1280 + 64 * (j))
#define XB_XGEN(j)  (2304 + 64 * (j))
#define XB_TOP      3328
#define XB_TOPGEN   3392
#define XCD_BAR_WORDS 3456
#define XB_SPIN_CAP (1u << 18)

__device__ __forceinline__ unsigned xb_ld(unsigned* p)              { return __hip_atomic_load(p, __ATOMIC_RELAXED, __HIP_MEMORY_SCOPE_AGENT); }
__device__ __forceinline__ unsigned xb_add(unsigned* p, unsigned v) { return __hip_atomic_fetch_add(p, v, __ATOMIC_RELAXED, __HIP_MEMORY_SCOPE_AGENT); }
__device__ __forceinline__ unsigned xb_xcc_id() { return (unsigned)__builtin_amdgcn_s_getreg((3 << 11) | 20) & 0xFu; }
#define XB_SPIN(cond, bar) do { unsigned _sp = 0; while (cond) { __builtin_amdgcn_s_sleep(1); \
    if ((++_sp & 255u) == 0u) { if (xb_ld(&(bar)[XB_TMO])) break; if (_sp > XB_SPIN_CAP) { atomicAdd(&(bar)[XB_TMO], 1u); break; } } } } while (0)

struct XcdBarrier {
    unsigned* bar; unsigned x;
    volatile LAS unsigned* st;
};

__device__ __forceinline__ XcdBarrier xcd_barrier_post(unsigned* bar, volatile LAS unsigned* st) {
    XcdBarrier b; b.bar = bar; b.x = xb_xcc_id(); b.st = st;
    if (threadIdx.x == 0) (void)xb_add(&bar[XB_XCNT(b.x)], 1u);
    return b;
}
__device__ __forceinline__ void xcd_barrier_complete(unsigned* bar, unsigned x, unsigned& nloc, unsigned& nx) {
    const unsigned G = gridDim.x * gridDim.y * gridDim.z;
    unsigned sum, cnt, mine, sp = 0u;
    for (;;) {
        sum = 0u; cnt = 0u; mine = 0u;
#pragma unroll
        for (unsigned j = 0; j < 16; ++j) { const unsigned c = xb_ld(&bar[XB_XCNT(j)]); sum += c; cnt += (c > 0u) ? 1u : 0u; mine = (j == x) ? c : mine; }
        if (sum == G) break;
        __builtin_amdgcn_s_sleep(1);
        if ((++sp & 255u) == 0u) { if (xb_ld(&bar[XB_TMO])) break; if (sp > XB_SPIN_CAP) { atomicAdd(&bar[XB_TMO], 1u); break; } }
    }
    nloc = mine > 0u ? mine : 1u; nx = cnt > 0u ? cnt : 1u;
}

__device__ __forceinline__ void xcd_barrier(const XcdBarrier& b) {
    asm volatile("s_waitcnt vmcnt(0)" ::: "memory");
    __syncthreads();
    if (threadIdx.x == 0) {
        unsigned* bar = b.bar;
        __builtin_amdgcn_s_waitcnt(0);
        unsigned nloc = b.st[0], nx = b.st[1];
        if (nloc == 0u) { xcd_barrier_complete(bar, b.x, nloc, nx); b.st[0] = nloc; b.st[1] = nx; }
        const unsigned old = xb_add(&bar[XB_XSUB(b.x)], 1u);
        const unsigned gen = old / nloc;
        if (old + 1u == (gen + 1u) * nloc) {
            __builtin_amdgcn_fence(__ATOMIC_RELEASE, "agent");
            asm volatile("s_waitcnt vmcnt(0)" ::: "memory");
            const unsigned og = xb_add(&bar[XB_TOP], 1u);
            const unsigned tg = og / nx;
            if (og + 1u == (tg + 1u) * nx) xb_add(&bar[XB_TOPGEN], 1u);
            else XB_SPIN(xb_ld(&bar[XB_TOPGEN]) == tg, bar);
            __builtin_amdgcn_fence(__ATOMIC_ACQUIRE, "agent");
            xb_add(&bar[XB_XGEN(b.x)], 1u);
            asm volatile("s_waitcnt vmcnt(0)" ::: "memory");
        } else {
            XB_SPIN(xb_ld(&bar[XB_XGEN(b.x)]) == gen, bar);
            __builtin_amdgcn_fence(__ATOMIC_ACQUIRE, "agent");
            asm volatile("s_waitcnt vmcnt(0)" ::: "memory");
        }
    }
    __syncthreads();
}


struct Args { const float* in[27]; float* out; unsigned char* ws; int ph_lo, ph_hi; };
__device__ __forceinline__ const GAS float* argp(int i) {
    const __attribute__((address_space(4))) char* kp = (const __attribute__((address_space(4))) char*)__builtin_amdgcn_kernarg_segment_ptr();
    asm volatile("" : "+s"(kp));
    const float* p = *(const float* const __attribute__((address_space(4)))*)(kp + 8 * i);
    return (const GAS float*)p;
}

template <int ID> __device__ __forceinline__ float wsrc(const GAS float* __restrict__ p0, const GAS float* __restrict__ p1, int n, int k) {
    if (ID == 0) return n < 1440 ? p0[(size_t)k * 1440 + n] : 0.f;
    if (ID == 1) return p0[k] * p1[(size_t)k * 768 + n];
    if (ID == 2) return k < 128 ? p0[k] * p1[(size_t)k * 1024 + n] : 0.f;
    if (ID == 3) { const int h = n >> 8, np = n & 255, mat = np >> 6, j = np & 63, dir = mat >> 1; const GAS float* w = (mat & 1) ? p1 : p0; return w[(size_t)((dir * 8 + h) * 64 + k) * 64 + j]; }
    if (ID == 4) return p0[(size_t)k * 1024 + n];
    if (ID == 5) return p0[(size_t)k * 5632 + n];
    return p0[(size_t)k * 1024 + n];
}
template <int ID> __device__ __forceinline__ void prep_mat(const GAS float* __restrict__ p0, const GAS float* __restrict__ p1, GAS bf16_t* __restrict__ dst, int N, int K, int gtid, int NT) {
    const int items = N * (K / 8);
    for (int it = gtid; it < items; it += NT) {
        const int n = it % N, k8 = it / N;
        u32x4 o;
        o.x = pk2(wsrc<ID>(p0, p1, n, 8 * k8 + 0), wsrc<ID>(p0, p1, n, 8 * k8 + 1)); o.y = pk2(wsrc<ID>(p0, p1, n, 8 * k8 + 2), wsrc<ID>(p0, p1, n, 8 * k8 + 3));
        o.z = pk2(wsrc<ID>(p0, p1, n, 8 * k8 + 4), wsrc<ID>(p0, p1, n, 8 * k8 + 5)); o.w = pk2(wsrc<ID>(p0, p1, n, 8 * k8 + 6), wsrc<ID>(p0, p1, n, 8 * k8 + 7));
        *(GAS u32x4*)(dst + (size_t)n * K + 8 * k8) = o;
    }
}
__device__ __forceinline__ void mod_phase(const GAS float* __restrict__ cvec, const GAS float* __restrict__ cctx, const GAS float* __restrict__ wmod, const GAS float* __restrict__ bmod, GAS float* __restrict__ mod, LAS float* scr, int gw, int NGW, int lane) {
    for (int task = gw; task < 96 * 16; task += NGW) {
        const int cgp = task % 96, kc = task / 96, n = cgp * 64 + lane, k0 = kc * 64;
#pragma unroll
        for (int r = 0; r < 9; ++r) { const float cv = r < 8 ? cvec[r * 1024 + k0 + lane] : cctx[k0 + lane]; scr[r * 64 + lane] = cv / (1.f + __expf(-cv)); }
        LDS_WAIT();
        float acc[9];
#pragma unroll
        for (int r = 0; r < 9; ++r) acc[r] = 0.f;
#pragma unroll 8
        for (int kk = 0; kk < 64; ++kk) { const float w = wmod[(size_t)(k0 + kk) * NMOD + n];
#pragma unroll
            for (int r = 0; r < 9; ++r) acc[r] += scr[r * 64 + kk] * w; }
        const float bias = kc == 0 ? bmod[n] : 0.f;
#pragma unroll
        for (int r = 0; r < 9; ++r) atomicAdd((float*)(mod + r * NMOD + n), acc[r] + bias);
        LDS_WAIT();
    }
}
__device__ __forceinline__ void p1_rows(const GAS float* __restrict__ x, const GAS float* __restrict__ ctx, const GAS float* __restrict__ g, const GAS float* __restrict__ mod, GAS bf16_t* __restrict__ H, int gw, int NGW, int lane) {
    for (int m0 = 2 * gw; m0 < MALL; m0 += 2 * NGW) {
        f32x4 v[2][4]; float ss[2];
#pragma unroll
        for (int r = 0; r < 2; ++r) { const int m = m0 + r; const GAS float* src = m < MLAT ? x + (size_t)m * DM : ctx + (size_t)(m - MLAT) * DM; ss[r] = 0.f;
#pragma unroll
            for (int j = 0; j < 4; ++j) { v[r][j] = *(const GAS f32x4*)(src + 4 * lane + 256 * j); ss[r] += v[r][j].x * v[r][j].x + v[r][j].y * v[r][j].y + v[r][j].z * v[r][j].z + v[r][j].w * v[r][j].w; } }
#pragma unroll
        for (int r = 0; r < 2; ++r) { const int m = m0 + r; const GAS float* md = mod + (m < MLAT ? (m >> 13) : 8) * NMOD;
            const float rs = rsqrtf(wave_sum(ss[r]) * (1.f / DM) + EPS);
#pragma unroll
            for (int j = 0; j < 4; ++j) { const int k = 4 * lane + 256 * j;
                const f32x4 gg = *(const GAS f32x4*)(g + k), sh = *(const GAS f32x4*)(md + k), sc = *(const GAS f32x4*)(md + DM + k);
                const f32x4 y = v[r][j] * rs * gg * (sc + 1.f) + sh;
                u32x2 o; o.x = pk2(y.x, y.y); o.y = pk2(y.z, y.w); *(GAS u32x2*)(H + (size_t)m * DM + k) = o; } }
    }
}
__device__ __forceinline__ void ss_phase(const GAS bf16_t* __restrict__ P, GAS float* __restrict__ ssq, GAS float* __restrict__ sskv, int gw, int NGW, int lane) {
#pragma unroll 4
    for (int m = gw; m < MALL; m += NGW) {
        const u32x2 q = *(const GAS u32x2*)(P + (size_t)m * PW + 1024 + 4 * lane); const unsigned k = *(const GAS unsigned*)(P + (size_t)m * PW + 1280 + 2 * lane);
        float a = bflo(q.x) * bflo(q.x) + bfhi(q.x) * bfhi(q.x) + bflo(q.y) * bflo(q.y) + bfhi(q.y) * bfhi(q.y), c = bflo(k) * bflo(k) + bfhi(k) * bfhi(k);
        a = wave_sum(a); c = wave_sum(c);
        if (lane == 0) { ssq[m] = a; sskv[m] = c; }
    }
}
__device__ __forceinline__ void qpost_phase(const GAS bf16_t* __restrict__ QR, const GAS float* __restrict__ ssq, const GAS float* __restrict__ RT, GAS bf16_t* __restrict__ Q, int gtid, int NT) {
#pragma unroll 4
    for (int task = gtid; task < MLAT * 96; task += NT) {
        const int row = task / 96, c8 = task - row * 96, h = c8 / 12, dc = c8 - h * 12, b = row >> 13, s = row & 8191;
        const float sc = rsqrtf(ssq[row] * (1.f / 256.f) + EPS) * QSCALE;
        const u32x4 mine = *(const GAS u32x4*)(QR + (size_t)row * 768 + 8 * c8);
        float v[8];
#pragma unroll
        for (int j = 0; j < 4; ++j) { v[2 * j] = bflo(mine[j]) * sc; v[2 * j + 1] = bfhi(mine[j]) * sc; }
        if (dc >= 8) { const int fq = dc - 8; const u32x4 oth = *(const GAS u32x4*)(QR + (size_t)row * 768 + 8 * (c8 ^ 1));
            const GAS float* rt = RT + (fq < 2 ? (s >> 6) : (s & 63)) * 16;
#pragma unroll
            for (int j = 0; j < 8; ++j) { const float pt = ((j & 1) ? bfhi(oth[j >> 1]) : bflo(oth[j >> 1])) * sc, cs = rt[2 * j], sn = rt[2 * j + 1];
                v[j] = (fq & 1) ? v[j] * cs + pt * sn : v[j] * cs - pt * sn; } }
        u32x4 w; w.x = pk2(v[0], v[1]); w.y = pk2(v[2], v[3]); w.z = pk2(v[4], v[5]); w.w = pk2(v[6], v[7]);
        *(GAS u32x4*)(Q + ((size_t)((b * 8 + h) * SEQ + s)) * 96 + 8 * dc) = w;
    }
}
__device__ __forceinline__ void kvpost_phase(const GAS bf16_t* __restrict__ KVR, const GAS float* __restrict__ sskv, GAS bf16_t* __restrict__ Kb, GAS bf16_t* __restrict__ Vt, int gtid, int NT) {
#pragma unroll 4
    for (int task = gtid; task < MALL * 64; task += NT) {
        const int row = task >> 6, c = task & 63, h = c >> 3, dd = (c & 7) * 8; const bool lat = row < MLAT;
        const int b = lat ? (row >> 13) : ((row - MLAT) >> 8), pos = lat ? (CTX + (row & 8191)) : ((row - MLAT) & 255);
        const float rs = rsqrtf(sskv[row] * (1.f / 128.f) + EPS);
        const u32x4 mine = *(const GAS u32x4*)(KVR + (size_t)row * 1024 + h * 128 + dd);
        u32x4 w;
#pragma unroll
        for (int j = 0; j < 4; ++j) w[j] = pk2(bflo(mine[j]) * rs, bfhi(mine[j]) * rs);
        *(GAS u32x4*)(Kb + ((size_t)(b * 8 + h) * KVLEN + pos) * 96 + dd) = w;
    }
#pragma unroll 2
    for (int task = gtid; task < (MALL / 8) * 512; task += NT) {
        const int pg = task & 7, dd = (task >> 3) & 7, rest = task >> 6, hd8 = rest & 63, rb = rest >> 6, h = hd8 >> 3, d = (hd8 & 7) * 8 + dd, row0 = rb * 64 + pg * 8; const bool lat = row0 < MLAT;
        const int b = lat ? (row0 >> 13) : ((row0 - MLAT) >> 8), pos0 = lat ? (CTX + (row0 & 8191)) : ((row0 - MLAT) & 255);
        float v[8];
#pragma unroll
        for (int i = 0; i < 8; ++i) v[i] = bf2f(KVR[(size_t)(row0 + i) * 1024 + h * 128 + 64 + d]) * rsqrtf(sskv[row0 + i] * (1.f / 128.f) + EPS);
        u32x4 w; w.x = pk2(v[0], v[1]); w.y = pk2(v[2], v[3]); w.z = pk2(v[4], v[5]); w.w = pk2(v[6], v[7]);
        *(GAS u32x4*)(Vt + ((size_t)((b * 8 + h) * 64 + d)) * KVLEN + pos0) = w;
    }
}
__device__ __forceinline__ void krope_phase(const GAS bf16_t* __restrict__ P, GAS bf16_t* __restrict__ Kb, const GAS float* __restrict__ RT, int gtid, int NT) {
#pragma unroll 2
    for (int task = gtid; task < MALL * 4; task += NT) {
        const int row = task >> 2, fq = task & 3; const bool lat = row < MLAT;
        const int b = lat ? (row >> 13) : ((row - MLAT) >> 8), s = row & 8191, pos = lat ? (CTX + s) : ((row - MLAT) & 255);
        const u32x4 mine = *(const GAS u32x4*)(P + (size_t)row * PW + 1408 + 8 * fq), oth = *(const GAS u32x4*)(P + (size_t)row * PW + 1408 + 8 * (fq ^ 1));
        float v[8], pt[8];
#pragma unroll
        for (int j = 0; j < 4; ++j) { v[2 * j] = bflo(mine[j]); v[2 * j + 1] = bfhi(mine[j]); pt[2 * j] = bflo(oth[j]); pt[2 * j + 1] = bfhi(oth[j]); }
        if (lat) { const GAS float* rt = RT + (fq < 2 ? (s >> 6) : (s & 63)) * 16;
#pragma unroll
            for (int j = 0; j < 8; ++j) { const float cs = rt[2 * j], sn = rt[2 * j + 1]; v[j] = (fq & 1) ? v[j] * cs + pt[j] * sn : v[j] * cs - pt[j] * sn; } }
        u32x4 w; w.x = pk2(v[0], v[1]); w.y = pk2(v[2], v[3]); w.z = pk2(v[4], v[5]); w.w = pk2(v[6], v[7]);
#pragma unroll
        for (int h = 0; h < 8; ++h) *(GAS u32x4*)(Kb + ((size_t)(b * 8 + h) * KVLEN + pos) * 96 + 64 + 8 * fq) = w;
    }
}
#define MFMA32(a, b, c) __builtin_amdgcn_mfma_f32_32x32x16_bf16((a), (b), (c), 0, 0, 0)
__device__ __forceinline__ void gates_phase(const GAS float* __restrict__ cw, const GAS float* __restrict__ cb, const GAS float* __restrict__ b_a, const GAS float* __restrict__ b_x, const GAS float* __restrict__ lam, LAS unsigned char* lds, const GAS bf16_t* __restrict__ P, const GAS bf16_t* __restrict__ Wg, GAS unsigned* __restrict__ LU, GAS f32x2* __restrict__ AGG, int tid, int wave, int lane) {
    LAS bf16_t* xs = (LAS bf16_t*)(lds + wave * 4608);
    LAS f32x2* wagg = (LAS f32x2*)(lds + 8 * 4608);
    const int r32 = lane & 31, hi = lane >> 5;
    for (int unit = blockIdx.x; unit < (MALL / 256) * 8; unit += gridDim.x) {
        const int pm = unit >> 3, h = unit & 7, m0 = pm * 256 + wave * 32;
        const int s0 = m0 < MLAT ? (m0 & ~8191) : (MLAT + ((m0 - MLAT) & ~255)), slen = m0 < MLAT ? SEQ : CTX;
        {
            const int tok = lane >> 1, m = m0 + tok;
#pragma unroll
            for (int c8 = 0; c8 < 4; ++c8) { const int ch = (lane & 1) * 32 + c8 * 8, gch = h * 64 + ch;
                float acc[8];
                { const f32x4 b0 = *(const GAS f32x4*)(cb + gch), b1 = *(const GAS f32x4*)(cb + gch + 4);
                  acc[0] = b0.x; acc[1] = b0.y; acc[2] = b0.z; acc[3] = b0.w; acc[4] = b1.x; acc[5] = b1.y; acc[6] = b1.z; acc[7] = b1.w; }
#pragma unroll
                for (int k = 0; k < 4; ++k) { const int mm = m + k - 2;
                    if (mm >= s0 && mm < s0 + slen) { const u32x4 xv = *(const GAS u32x4*)(P + (size_t)mm * PW + gch);
                        const f32x4 w0 = *(const GAS f32x4*)(cw + k * 512 + gch), w1 = *(const GAS f32x4*)(cw + k * 512 + gch + 4);
                        acc[0] += w0.x * bflo(xv.x); acc[1] += w0.y * bfhi(xv.x); acc[2] += w0.z * bflo(xv.y); acc[3] += w0.w * bfhi(xv.y);
                        acc[4] += w1.x * bflo(xv.z); acc[5] += w1.y * bfhi(xv.z); acc[6] += w1.z * bflo(xv.w); acc[7] += w1.w * bfhi(xv.w); } }
                u32x4 o; o.x = pk2(acc[0], acc[1]); o.y = pk2(acc[2], acc[3]); o.z = pk2(acc[4], acc[5]); o.w = pk2(acc[6], acc[7]);
                *(LAS u32x4*)(xs + tok * 72 + ch) = o; }
        }
        LDS_WAIT();
        bf16x8 afr[4];
#pragma unroll
        for (int ks = 0; ks < 4; ++ks) afr[ks] = *(const LAS bf16x8*)(xs + r32 * 72 + 16 * ks + 8 * hi);
#pragma unroll
        for (int jh = 0; jh < 2; ++jh) {
            f32x16 acc4[4];
#pragma unroll
            for (int q = 0; q < 4; ++q) {
#pragma unroll
                for (int i = 0; i < 16; ++i) acc4[q][i] = 0.f;
                const GAS bf16_t* wrow = Wg + (size_t)(h * 256 + (2 * q + jh) * 32 + r32) * 64 + 8 * hi;
#pragma unroll
                for (int ks = 0; ks < 4; ++ks) { const bf16x8 bfr = *(const GAS bf16x8*)(wrow + 16 * ks); acc4[q] = MFMA32(afr[ks], bfr, acc4[q]); }
            }
            const int ch = jh * 32 + r32, gch = h * 64 + ch;
            float ba[2], bx[2], sp[2];
#pragma unroll
            for (int d = 0; d < 2; ++d) { ba[d] = b_a[d * 512 + gch]; bx[d] = b_x[d * 512 + gch]; const float nl = -lam[d * 512 + gch];
                sp[d] = 8.f * 1.4426950408889634f * (nl > 20.f ? nl : log1pf(__expf(nl))); }
            unsigned wv[16][2];
#pragma unroll
            for (int i = 0; i < 16; ++i) { const int row = crow(i, hi); const float xv = bf2f(xs[row * 72 + ch]);
#pragma unroll
                for (int d = 0; d < 2; ++d) { const float r = sigmoidf_(acc4[2 * d][i] + ba[d]), ig = sigmoidf_(acc4[2 * d + 1][i] + bx[d]);
                    const float la2 = -r * sp[d]; const float uu = __builtin_amdgcn_sqrtf(fmaxf(1.f - __builtin_amdgcn_exp2f(2.f * la2), 0.f)) * (ig * xv);
                    wv[i][d] = pk2(la2, uu);
                    LU[((size_t)(m0 + row) * 2 + d) * 512 + gch] = wv[i][d]; } }
#pragma unroll
            for (int d = 0; d < 2; ++d) {
                float Ar[4], Ur[4];
#pragma unroll
                for (int g = 0; g < 4; ++g) { float A = 1.f, U = 0.f;
#pragma unroll
                    for (int jj = 0; jj < 4; ++jj) { const int j = d ? 3 - jj : jj; const unsigned w = wv[4 * g + j][d]; const float av = __builtin_amdgcn_exp2f(bflo(w)); A *= av; U = av * U + bfhi(w); }
                    Ar[g] = A; Ur[g] = U; }
                float A = 1.f, U = 0.f;
#pragma unroll
                for (int gg = 0; gg < 4; ++gg) { const int g = d ? 3 - gg : gg;
                    const float Ao = __shfl_xor(Ar[g], 32), Uo = __shfl_xor(Ur[g], 32);
                    if (d == 0) { U = Ar[g] * U + Ur[g]; A *= Ar[g]; U = Ao * U + Uo; A *= Ao; }
                    else        { U = Ao * U + Uo; A *= Ao; U = Ar[g] * U + Ur[g]; A *= Ar[g]; } }
                if (hi == 0) wagg[(wave * 2 + d) * 64 + ch] = (f32x2){A, U};
            }
        }
        LDS_WAIT();
        __syncthreads();
        if (tid < 128) {
            const int d = tid >> 6, ch = tid & 63; float A = 1.f, U = 0.f;
#pragma unroll
            for (int ww = 0; ww < 8; ++ww) { const int w = d ? 7 - ww : ww; const f32x2 g = wagg[(w * 2 + d) * 64 + ch]; U = g.x * U + g.y; A *= g.x; }
            const int b = pm < MLAT / 256 ? (pm >> 5) : (pm - MLAT / 256), c = pm < MLAT / 256 ? (pm & 31) : NCH;
            AGG[(size_t)((b * 2 + d) * (NCH + 1) + c) * 512 + h * 64 + ch] = (f32x2){A, U};
        }
        __syncthreads();
    }
}
__device__ __forceinline__ void scan_agg(const GAS unsigned* __restrict__ LU, GAS f32x2* __restrict__ AGG, int gw, int NGW, int lane) {
    for (int task = gw; task < NB * 2 * (NCH + 1) * 8; task += NGW) {
        const int cgp = task & 7, c = (task >> 3) % (NCH + 1), d = (task / (8 * (NCH + 1))) & 1, b = task / (16 * (NCH + 1));
        const int ch = cgp * 64 + lane, row0 = c < NCH ? b * SEQ + c * CHL : MLAT + b * CTX;
        float A = 1.f, U = 0.f;
#pragma unroll 16
        for (int t = 0; t < CHL; ++t) { const int tt = d ? CHL - 1 - t : t; const unsigned w = LU[((size_t)(row0 + tt) * 2 + d) * 512 + ch];
            const float av = __builtin_amdgcn_exp2f(bflo(w)); A *= av; U = av * U + bfhi(w); }
        AGG[(size_t)((b * 2 + d) * (NCH + 1) + c) * 512 + ch] = (f32x2){A, U};
    }
}
__device__ __forceinline__ float gelu_tanh(float x) { const float z = 0.7978845608028654f * (x + 0.044715f * x * x * x);
    return x * __builtin_amdgcn_rcpf(1.f + __builtin_amdgcn_exp2f(-2.8853900817779268f * z)); }
__device__ __forceinline__ void scan_final(const GAS unsigned* __restrict__ LU, const GAS f32x2* __restrict__ AGG, const GAS bf16_t* __restrict__ P, GAS bf16_t* __restrict__ A2, int gw, int NGW, int lane) {
    constexpr int BT = 16;
    for (int task = gw; task < NB * NCH * 8; task += NGW) {
        const int cgp = task & 7, c = (task >> 3) & (NCH - 1), b = task / (8 * NCH), ch = cgp * 64 + lane, row0 = b * SEQ + c * CHL;
        const GAS f32x2* ag0 = AGG + (size_t)((b * 2 + 0) * (NCH + 1)) * 512 + ch; const GAS f32x2* ag1 = AGG + (size_t)((b * 2 + 1) * (NCH + 1)) * 512 + ch;
        unsigned w[BT], wn[BT];
#pragma unroll
        for (int i = 0; i < BT; ++i) w[i] = LU[((size_t)(row0 + i) * 2 + 0) * 512 + ch];
        float hf = ag0[(size_t)NCH * 512].y;
        for (int cc = 0; cc < c; ++cc) { const f32x2 g = ag0[(size_t)cc * 512]; hf = g.x * hf + g.y; }
        float hb = ag1[(size_t)NCH * 512].y;
        for (int cc = NCH - 1; cc > c; --cc) { const f32x2 g = ag1[(size_t)cc * 512]; hb = g.x * hb + g.y; }
#pragma unroll 1
        for (int t0 = 0; t0 < CHL; t0 += BT) {
            if (t0 + BT < CHL) {
#pragma unroll
                for (int i = 0; i < BT; ++i) wn[i] = LU[((size_t)(row0 + t0 + BT + i) * 2 + 0) * 512 + ch]; }
#pragma unroll
            for (int i = 0; i < BT; ++i) { hf = __builtin_amdgcn_exp2f(bflo(w[i])) * hf + bfhi(w[i]); A2[(size_t)(row0 + t0 + i) * DM + ch] = (bf16_t)f2bf(hf); }
#pragma unroll
            for (int i = 0; i < BT; ++i) w[i] = wn[i]; }
        bf16_t gr[BT], grn[BT];
#pragma unroll
        for (int i = 0; i < BT; ++i) { w[i] = LU[((size_t)(row0 + CHL - BT + i) * 2 + 1) * 512 + ch]; gr[i] = P[(size_t)(row0 + CHL - BT + i) * PW + 512 + ch]; }
#pragma unroll 1
        for (int t0 = CHL - BT; t0 >= 0; t0 -= BT) { bf16_t f[BT];
#pragma unroll
            for (int i = 0; i < BT; ++i) f[i] = A2[(size_t)(row0 + t0 + i) * DM + ch];
            if (t0 >= BT) {
#pragma unroll
                for (int i = 0; i < BT; ++i) { wn[i] = LU[((size_t)(row0 + t0 - BT + i) * 2 + 1) * 512 + ch]; grn[i] = P[(size_t)(row0 + t0 - BT + i) * PW + 512 + ch]; } }
#pragma unroll
            for (int i = BT - 1; i >= 0; --i) { hb = __builtin_amdgcn_exp2f(bflo(w[i])) * hb + bfhi(w[i]);
                A2[(size_t)(row0 + t0 + i) * DM + ch] = (bf16_t)f2bf((bf2f(f[i]) + hb) * gelu_tanh(bf2f(gr[i]))); }
#pragma unroll
            for (int i = 0; i < BT; ++i) { w[i] = wn[i]; gr[i] = grn[i]; } }
    }
}
constexpr int AT_KROW = 208, AT_VROW = 144;
constexpr float AT_THR = 8.f;
#define AT_SOFTMAX(P, M, L, O0, O1, PW0, PW1) do { \
        float mx_ = fmaxf(fmaxf(P[0], P[1]), fmaxf(P[2], P[3])); \
        _Pragma("unroll") for (int i_ = 4; i_ < 16; i_ += 4) mx_ = fmaxf(fmaxf(mx_, P[i_]), fmaxf(fmaxf(P[i_ + 1], P[i_ + 2]), P[i_ + 3])); \
        mx_ = fmaxf(mx_, __shfl_xor(mx_, 32)); \
        if (__any(mx_ > M + AT_THR)) { const float mn_ = fmaxf(M, mx_), al_ = __builtin_amdgcn_exp2f(M - mn_); M = mn_; L *= al_; \
            _Pragma("unroll") for (int i_ = 0; i_ < 16; ++i_) { O0[i_] *= al_; O1[i_] *= al_; } } \
        float s_ = 0.f; \
        _Pragma("unroll") for (int i_ = 0; i_ < 16; ++i_) { P[i_] = __builtin_amdgcn_exp2f(P[i_] - M); s_ += P[i_]; } \
        L += s_; \
        _Pragma("unroll") for (int j_ = 0; j_ < 4; ++j_) { PW0[j_] = cvtpk(P[2 * j_], P[2 * j_ + 1]); PW1[j_] = cvtpk(P[8 + 2 * j_], P[9 + 2 * j_]); } } while (0)
__device__ __forceinline__ void glds16(const GAS void* gsrc, unsigned lds_dst) {
    unsigned keep;
    asm volatile("s_mov_b32 %0, m0\n\ts_mov_b32 m0, %2\n\ts_nop 0\n\tglobal_load_lds_dwordx4 %1, off\n\ts_mov_b32 m0, %0" : "=&s"(keep) : "v"(gsrc), "s"(lds_dst) : "memory");
}
constexpr int AT_SLOT = 22 * 1024, AT_VOFF = 13 * 1024, AT_NP = 22;
__device__ __forceinline__ void attn_unit(LAS unsigned char* lds, const GAS bf16_t* __restrict__ QR, const GAS float* __restrict__ ssq, const GAS float* __restrict__ RT, const GAS bf16_t* __restrict__ K, const GAS bf16_t* __restrict__ Vt, GAS bf16_t* __restrict__ A2, int b, int h, int qb, int tid, int wave, int lane) {
    const int r32 = lane & 31, hi = lane >> 5, q0 = qb * 512 + wave * 64, r32s = (r32 & ~12) | ((r32 & 4) << 1) | ((r32 & 8) >> 1);
    bf16x8 qa[6], qc[6];
#pragma unroll
    for (int sub = 0; sub < 2; ++sub) {
        const int s = q0 + 32 * sub + r32, row = b * SEQ + s;
        const GAS bf16_t* Qp = QR + (size_t)row * 768 + h * 96 + 8 * hi;
        const float sc = rsqrtf(ssq[row] * (1.f / 256.f) + EPS) * QSCALE;
#pragma unroll
        for (int d0 = 0; d0 < 6; ++d0) {
            const u32x4 raw = *(const GAS u32x4*)(Qp + 16 * d0);
            float v[8];
#pragma unroll
            for (int j = 0; j < 4; ++j) { v[2 * j] = bflo(raw[j]) * sc; v[2 * j + 1] = bfhi(raw[j]) * sc; }
            if (d0 >= 4) { const GAS float* rt = RT + (d0 == 4 ? (s >> 6) : (s & 63)) * 16;
#pragma unroll
                for (int j = 0; j < 8; ++j) { const float pt = __shfl_xor(v[j], 32), cs = rt[2 * j], sn = rt[2 * j + 1]; v[j] = hi ? v[j] * cs + pt * sn : v[j] * cs - pt * sn; } }
            u32x4 w; w.x = pk2(v[0], v[1]); w.y = pk2(v[2], v[3]); w.z = pk2(v[4], v[5]); w.w = pk2(v[6], v[7]);
            if (sub == 0) qa[d0] = __builtin_bit_cast(bf16x8, w); else qc[d0] = __builtin_bit_cast(bf16x8, w);
        }
    }
    const GAS unsigned char* Kg = (const GAS unsigned char*)(K + (size_t)(b * 8 + h) * KVLEN * 96);
    const GAS unsigned char* Vg = (const GAS unsigned char*)(Vt + (size_t)(b * 8 + h) * 64 * KVLEN);
    const unsigned ldsb = (unsigned)(size_t)lds;
    const GAS unsigned char* src[3]; int stride[3]; unsigned dsto[3];
#pragma unroll
    for (int k = 0; k < 3; ++k) { int j = wave + 8 * k; if (j >= AT_NP) j -= 8; const int id = j * 64 + lane;
        if (j < 13) { const int row = id / 13; int col = id - row * 13; if (col == 12) col = 0; src[k] = Kg + row * 192 + col * 16; stride[k] = 12288; }
        else { const int idv = id - 832, d = idv / 9; int c = idv - d * 9; if (c == 8) c = 0; src[k] = Vg + ((size_t)d * KVLEN + c * 8) * 2; stride[k] = 128; }
        dsto[k] = ldsb + j * 1024; }
#define AT_ISSUE(t, slot) do { _Pragma("unroll") for (int k_ = 0; k_ < 3; ++k_) glds16(src[k_] + (size_t)(t) * stride[k_], (unsigned)__builtin_amdgcn_readfirstlane(dsto[k_] + (slot) * AT_SLOT)); } while (0)
    f32x16 oA0, oA1, oB0, oB1;
#pragma unroll
    for (int i = 0; i < 16; ++i) { oA0[i] = 0.f; oA1[i] = 0.f; oB0[i] = 0.f; oB1[i] = 0.f; }
    float mA = -1e30f, mB = -1e30f, lA = 0.f, lB = 0.f;
    constexpr int NT_ = KVLEN / 64;
    AT_ISSUE(0, 0); AT_ISSUE(1, 1);
    int slot = 0, nslot = 2;
#pragma unroll 1
    for (int t = 0; t < NT_; ++t) {
        if (t + 1 < NT_) asm volatile("s_waitcnt vmcnt(3) lgkmcnt(0)\n\ts_barrier" ::: "memory"); else asm volatile("s_waitcnt vmcnt(0) lgkmcnt(0)\n\ts_barrier" ::: "memory");
        if (t + 2 < NT_) AT_ISSUE(t + 2, nslot);
        const LAS unsigned char* sb = lds + slot * AT_SLOT;
#pragma unroll
        for (int hh = 0; hh < 2; ++hh) {
            const LAS unsigned char* kb = sb + (32 * hh + r32s) * AT_KROW + hi * 16;
            f32x16 pA, pB;
#pragma unroll
            for (int i = 0; i < 16; ++i) { pA[i] = 0.f; pB[i] = 0.f; }
#pragma unroll
            for (int d0 = 0; d0 < 6; ++d0) { const bf16x8 a0 = *(const LAS bf16x8*)(kb + d0 * 32); pA = MFMA32(a0, qa[d0], pA); pB = MFMA32(a0, qc[d0], pB); }
            u32x4 pwA0, pwA1, pwB0, pwB1;
            AT_SOFTMAX(pA, mA, lA, oA0, oA1, pwA0, pwA1);
            AT_SOFTMAX(pB, mB, lB, oB0, oB1, pwB0, pwB1);
            const LAS unsigned char* vb = sb + AT_VOFF + r32 * AT_VROW + hi * 16 + hh * 64;
#pragma unroll
            for (int ks = 0; ks < 2; ++ks) {
                const bf16x8 va0 = *(const LAS bf16x8*)(vb + ks * 32), va1 = *(const LAS bf16x8*)(vb + 32 * AT_VROW + ks * 32);
                const bf16x8 pa = __builtin_bit_cast(bf16x8, ks ? pwA1 : pwA0), pb = __builtin_bit_cast(bf16x8, ks ? pwB1 : pwB0);
                oA0 = MFMA32(va0, pa, oA0); oA1 = MFMA32(va1, pa, oA1); oB0 = MFMA32(va0, pb, oB0); oB1 = MFMA32(va1, pb, oB1);
            }
        }
        slot = slot == 2 ? 0 : slot + 1; nslot = nslot == 2 ? 0 : nslot + 1;
    }
    asm volatile("s_waitcnt lgkmcnt(0)\n\ts_barrier" ::: "memory");
    {   const float inv = 1.f / (lA + __shfl_xor(lA, 32));
        GAS bf16_t* op = A2 + (size_t)(b * SEQ + q0 + r32) * DM + 512 + h * 64 + 4 * hi;
#pragma unroll
        for (int g = 0; g < 4; ++g) { u32x2 w0, w1; w0.x = pk2(oA0[4 * g] * inv, oA0[4 * g + 1] * inv); w0.y = pk2(oA0[4 * g + 2] * inv, oA0[4 * g + 3] * inv);
            w1.x = pk2(oA1[4 * g] * inv, oA1[4 * g + 1] * inv); w1.y = pk2(oA1[4 * g + 2] * inv, oA1[4 * g + 3] * inv);
            *(GAS u32x2*)(op + 8 * g) = w0; *(GAS u32x2*)(op + 32 + 8 * g) = w1; } }
    {   const float inv = 1.f / (lB + __shfl_xor(lB, 32));
        GAS bf16_t* op = A2 + (size_t)(b * SEQ + q0 + 32 + r32) * DM + 512 + h * 64 + 4 * hi;
#pragma unroll
        for (int g = 0; g < 4; ++g) { u32x2 w0, w1; w0.x = pk2(oB0[4 * g] * inv, oB0[4 * g + 1] * inv); w0.y = pk2(oB0[4 * g + 2] * inv, oB0[4 * g + 3] * inv);
            w1.x = pk2(oB1[4 * g] * inv, oB1[4 * g + 1] * inv); w1.y = pk2(oB1[4 * g + 2] * inv, oB1[4 * g + 3] * inv);
            *(GAS u32x2*)(op + 8 * g) = w0; *(GAS u32x2*)(op + 32 + 8 * g) = w1; } }
#undef AT_ISSUE
}
__device__ __forceinline__ void p7_rows(const GAS float* __restrict__ x, const GAS float* __restrict__ g_post, const GAS float* __restrict__ g_pre, GAS float* __restrict__ out, const GAS float* __restrict__ mod, const GAS bf16_t* __restrict__ Y, GAS bf16_t* __restrict__ H2, int gw, int NGW, int lane) {
    for (int m0 = 2 * gw; m0 < MLAT; m0 += 2 * NGW) {
        const GAS float* md = mod + (m0 >> 13) * NMOD;
        f32x4 y[2][4], xv[2][4]; float ss[2];
#pragma unroll
        for (int r = 0; r < 2; ++r) { ss[r] = 0.f;
#pragma unroll
            for (int j = 0; j < 4; ++j) { const u32x2 w = *(const GAS u32x2*)(Y + (size_t)(m0 + r) * DM + 4 * lane + 256 * j); xv[r][j] = *(const GAS f32x4*)(x + (size_t)(m0 + r) * DM + 4 * lane + 256 * j);
                y[r][j] = (f32x4){bflo(w.x), bfhi(w.x), bflo(w.y), bfhi(w.y)}; ss[r] += y[r][j].x * y[r][j].x + y[r][j].y * y[r][j].y + y[r][j].z * y[r][j].z + y[r][j].w * y[r][j].w; } }
#pragma unroll
        for (int r = 0; r < 2; ++r) { const int m = m0 + r;
            const float rs = rsqrtf(wave_sum(ss[r]) * (1.f / DM) + EPS); float s2 = 0.f;
#pragma unroll
            for (int j = 0; j < 4; ++j) { const int k = 4 * lane + 256 * j;
                const f32x4 gg = *(const GAS f32x4*)(g_post + k), gt = *(const GAS f32x4*)(md + 2 * DM + k);
                xv[r][j] = xv[r][j] + gt * (y[r][j] * rs * gg); *(GAS f32x4*)(out + (size_t)m * DM + k) = xv[r][j];
                s2 += xv[r][j].x * xv[r][j].x + xv[r][j].y * xv[r][j].y + xv[r][j].z * xv[r][j].z + xv[r][j].w * xv[r][j].w; }
            const float rs2 = rsqrtf(wave_sum(s2) * (1.f / DM) + EPS);
#pragma unroll
            for (int j = 0; j < 4; ++j) { const int k = 4 * lane + 256 * j;
                const f32x4 gg = *(const GAS f32x4*)(g_pre + k), sh = *(const GAS f32x4*)(md + 3 * DM + k), sc = *(const GAS f32x4*)(md + 4 * DM + k);
                const f32x4 hh = xv[r][j] * rs2 * gg * (sc + 1.f) + sh;
                u32x2 o; o.x = pk2(hh.x, hh.y); o.y = pk2(hh.z, hh.w); *(GAS u32x2*)(H2 + (size_t)m * DM + k) = o; } }
    }
}
__device__ __forceinline__ void p11_rows(const GAS float* __restrict__ g_post, GAS float* __restrict__ out, const GAS float* __restrict__ mod, const GAS bf16_t* __restrict__ Fb, int gw, int NGW, int lane) {
    for (int m0 = 2 * gw; m0 < MLAT; m0 += 2 * NGW) {
        const GAS float* md = mod + (m0 >> 13) * NMOD;
        f32x4 y[2][4], xv[2][4]; float ss[2];
#pragma unroll
        for (int r = 0; r < 2; ++r) { ss[r] = 0.f;
#pragma unroll
            for (int j = 0; j < 4; ++j) { const u32x2 w = *(const GAS u32x2*)(Fb + (size_t)(m0 + r) * DM + 4 * lane + 256 * j); xv[r][j] = *(const GAS f32x4*)(out + (size_t)(m0 + r) * DM + 4 * lane + 256 * j);
                y[r][j] = (f32x4){bflo(w.x), bfhi(w.x), bflo(w.y), bfhi(w.y)}; ss[r] += y[r][j].x * y[r][j].x + y[r][j].y * y[r][j].y + y[r][j].z * y[r][j].z + y[r][j].w * y[r][j].w; } }
#pragma unroll
        for (int r = 0; r < 2; ++r) { const float rs = rsqrtf(wave_sum(ss[r]) * (1.f / DM) + EPS);
#pragma unroll
            for (int j = 0; j < 4; ++j) { const int k = 4 * lane + 256 * j;
                const f32x4 gg = *(const GAS f32x4*)(g_post + k), gt = *(const GAS f32x4*)(md + 5 * DM + k);
                *(GAS f32x4*)(out + (size_t)(m0 + r) * DM + k) = xv[r][j] + gt * (y[r][j] * rs * gg); } }
    }
}
__device__ __forceinline__ void convgate_phase(const GAS float* __restrict__ cw, const GAS float* __restrict__ cb, const GAS bf16_t* __restrict__ UP, GAS bf16_t* __restrict__ G, int half, int gtid, int NT) {
    constexpr int JG = DFF / 8, RG = 32, NTASK = (MLAT / 2 / RG) * JG;
    for (int task = gtid; task < NTASK; task += NT) {
        const int jg = task % JG, rg = task / JG, j0 = jg * 8, r0 = rg * RG, m0 = half * (MLAT / 2) + r0;
        float wu[3][8], wg[3][8], bu[8], bg[8];
#pragma unroll
        for (int k = 0; k < 3; ++k)
#pragma unroll
            for (int i = 0; i < 8; ++i) { wu[k][i] = cw[k * 2 * DFF + j0 + i]; wg[k][i] = cw[k * 2 * DFF + DFF + j0 + i]; }
#pragma unroll
        for (int i = 0; i < 8; ++i) { bu[i] = cb[j0 + i]; bg[i] = cb[DFF + j0 + i]; }
        const GAS bf16_t* up = UP + (size_t)r0 * (2 * DFF) + j0;
        u32x4 pu = {0u, 0u, 0u, 0u}, pg = {0u, 0u, 0u, 0u}, cu, cg_, nu, ng;
        if ((m0 & 8191) != 0) { pu = *(const GAS u32x4*)(up - 2 * DFF); pg = *(const GAS u32x4*)(up - 2 * DFF + DFF); }
        cu = *(const GAS u32x4*)(up); cg_ = *(const GAS u32x4*)(up + DFF);
#pragma unroll 8
        for (int r = 0; r < RG; ++r) {
            const bool nv = (r + 1 < RG) || (((m0 + RG) & 8191) != 0);
            if (nv) { nu = *(const GAS u32x4*)(up + (size_t)(r + 1) * (2 * DFF)); ng = *(const GAS u32x4*)(up + (size_t)(r + 1) * (2 * DFF) + DFF); } else { nu = (u32x4){0u, 0u, 0u, 0u}; ng = nu; }
            float o[8];
#pragma unroll
            for (int i = 0; i < 8; ++i) { const int w_ = i >> 1;
                const float p_u = (i & 1) ? bfhi(pu[w_]) : bflo(pu[w_]), c_u = (i & 1) ? bfhi(cu[w_]) : bflo(cu[w_]), n_u = (i & 1) ? bfhi(nu[w_]) : bflo(nu[w_]);
                const float p_g = (i & 1) ? bfhi(pg[w_]) : bflo(pg[w_]), c_g = (i & 1) ? bfhi(cg_[w_]) : bflo(cg_[w_]), n_g = (i & 1) ? bfhi(ng[w_]) : bflo(ng[w_]);
                const float uv = bu[i] + wu[0][i] * p_u + wu[1][i] * c_u + wu[2][i] * n_u, gv = bg[i] + wg[0][i] * p_g + wg[1][i] * c_g + wg[2][i] * n_g;
                o[i] = gv * __builtin_amdgcn_rcpf(1.f + __builtin_amdgcn_exp2f(-1.4426950408889634f * gv)) * uv; }
            u32x4 w; w.x = pk2(o[0], o[1]); w.y = pk2(o[2], o[3]); w.z = pk2(o[4], o[5]); w.w = pk2(o[6], o[7]);
            *(GAS u32x4*)(G + (size_t)(r0 + r) * DFF + j0) = w;
            pu = cu; pg = cg_; cu = nu; cg_ = ng;
        }
    }
}
constexpr int NPH = 17;
__global__ void __launch_bounds__(512, 2) fwd_kernel(Args a) {
    extern __shared__ __attribute__((aligned(16))) unsigned char lds_raw[];
    LAS unsigned char* lds = (LAS unsigned char*)lds_raw;
    const int lo = a.ph_lo, hi_ = a.ph_hi;
    {
        volatile LAS unsigned* st0 = (volatile LAS unsigned*)(lds + LDS_MISC);
        if (threadIdx.x < 2) st0[threadIdx.x] = 0u;
        __syncthreads();
        (void)xcd_barrier_post((unsigned*)(a.ws + WS_BAR), st0);
    }
#if MK_COOP
    cg::grid_group grid = cg::this_grid();
#endif
    typedef pg8::EpiBf16<0> EpiB;
    constexpr int MH = MLAT / 2;
#ifndef REPMASK
#define REPMASK 0
#endif
    bool repeated = false;
#pragma unroll 1
    for (int ph = lo; ph < hi_; ++ph) {
        int tid = threadIdx.x; asm volatile("" : "+v"(tid));
        int G = gridDim.x, bx = blockIdx.x; asm volatile("" : "+s"(G), "+s"(bx));
        const int lane = tid & 63, wave = __builtin_amdgcn_readfirstlane(tid >> 6);
        const int vcu = (G % 8 == 0) ? (bx % 8) * (G / 8) + bx / 8 : bx;
        const int gw = vcu * 8 + wave, NGW = G * 8, gtid = bx * 512 + tid, NTH = G * 512;
        unsigned char* ws_ = a.ws; asm volatile("" : "+s"(ws_)); GAS unsigned char* ws = (GAS unsigned char*)ws_;
        GAS float* mod = (GAS float*)(ws + WS_MOD); GAS float* ssq = (GAS float*)(ws + WS_SSQ); GAS float* sskv = (GAS float*)(ws + WS_SSKV);
        GAS bf16_t* Win = (GAS bf16_t*)(ws + WS_WIN); GAS bf16_t* Wq = (GAS bf16_t*)(ws + WS_WQ); GAS bf16_t* Wkv = (GAS bf16_t*)(ws + WS_WKV); GAS bf16_t* Wg = (GAS bf16_t*)(ws + WS_WG);
        GAS bf16_t* Wout = (GAS bf16_t*)(ws + WS_WOUT); GAS bf16_t* Wup = (GAS bf16_t*)(ws + WS_WUP); GAS bf16_t* Wdn = (GAS bf16_t*)(ws + WS_WDN);
        GAS f32x2* AGG = (GAS f32x2*)(ws + WS_AGG); GAS float* RT = (GAS float*)(ws + WS_ROPE);
        GAS bf16_t* H = (GAS bf16_t*)(ws + WS_R1); GAS bf16_t* KVR = H; GAS bf16_t* H2 = H; GAS bf16_t* QR = (GAS bf16_t*)(ws + WS_Q);
        GAS bf16_t* P = (GAS bf16_t*)(ws + WS_R2); GAS bf16_t* Y = P; GAS bf16_t* Fb = P;
        GAS unsigned* LU = (GAS unsigned*)(ws + WS_LU); GAS bf16_t* Kb = (GAS bf16_t*)(ws + WS_K); GAS bf16_t* Vb = (GAS bf16_t*)(ws + WS_V); GAS bf16_t* A2 = (GAS bf16_t*)(ws + WS_A2);
        GAS bf16_t* UP = (GAS bf16_t*)(ws + WS_UP); GAS bf16_t* Gb = (GAS bf16_t*)(ws + WS_G);
        float* outp_ = a.out; asm volatile("" : "+s"(outp_)); GAS float* outp = (GAS float*)outp_;
        pg8::Gemm g{nullptr, nullptr, 0, 0, 0, 0, 0}; GAS bf16_t* O = nullptr; int ldc = 0;
        switch (ph) {
            case 2:  g = pg8::Gemm{(const bf16_t*)(H), (const bf16_t*)(Win), MALL, PW, DM, DM, DM}; O = P; ldc = PW; break;
            case 4:  g = pg8::Gemm{(const bf16_t*)(P + 1024), (const bf16_t*)(Wq), MLAT, 768, 256, PW, 256}; O = QR; ldc = 768; break;
            case 5:  g = pg8::Gemm{(const bf16_t*)(P + 1280), (const bf16_t*)(Wkv), MALL, 1024, 256, PW, 256}; O = KVR; ldc = 1024; break;
            case 8:  g = pg8::Gemm{(const bf16_t*)(A2), (const bf16_t*)(Wout), MLAT, DM, DM, DM, DM}; O = Y; ldc = DM; break;
            case 10: g = pg8::Gemm{(const bf16_t*)(H2), (const bf16_t*)(Wup), MH, 2 * DFF, DM, DM, DM}; O = UP; ldc = 2 * DFF; break;
            case 13: g = pg8::Gemm{(const bf16_t*)(H2 + (size_t)MH * DM), (const bf16_t*)(Wup), MH, 2 * DFF, DM, DM, DM}; O = UP; ldc = 2 * DFF; break;
            case 12: g = pg8::Gemm{(const bf16_t*)(Gb), (const bf16_t*)(Wdn), MH, DM, DFF, DFF, DFF}; O = Fb; ldc = DM; break;
            case 15: g = pg8::Gemm{(const bf16_t*)(Gb), (const bf16_t*)(Wdn), MH, DM, DFF, DFF, DFF}; O = Fb + (size_t)MH * DM; ldc = DM; break;
            default: break;
        }
        if (g.A != nullptr) {
            pg8::StaticOrder S; S.init(g.M, g.N, G, bx); EpiB E{(bf16_t*)O, ldc, nullptr, 0, 0, 1.f};
            pg8::gemm_phase<EpiB, pg8::StaticOrder, true, true>(lds, g, S, E, tid);
        }
#ifndef NGM
#define NGM 0x1ffff
#endif
#define NG(k) ((NGM >> (k)) & 1)
        else if (NG(0) && ph == 0) {
            prep_mat<0>(argp(10), nullptr, Win, 1536, 1024, gtid, NTH); prep_mat<1>(argp(18), argp(19), Wq, 768, 256, gtid, NTH); prep_mat<2>(argp(20), argp(21), Wkv, 1024, 256, gtid, NTH);
            prep_mat<3>(argp(13), argp(15), Wg, 2048, 64, gtid, NTH); prep_mat<4>(argp(22), nullptr, Wout, 1024, 1024, gtid, NTH); prep_mat<5>(argp(23), nullptr, Wup, 5632, 1024, gtid, NTH);
            prep_mat<6>(argp(26), nullptr, Wdn, 1024, 2816, gtid, NTH);
            if (gtid < 1024) { const int pos = gtid >> 3, j = gtid & 7; const float invf[8] = {1.f, 0.31622776601683794f, 0.1f, 0.031622776601683794f, 0.01f, 0.0031622776601683794f, 0.001f, 0.00031622776601683794f};
                const float ang = (float)pos * invf[j]; RT[2 * gtid] = cosf(ang); RT[2 * gtid + 1] = sinf(ang); }
            mod_phase(argp(1), argp(3), argp(4), argp(5), mod, (LAS float*)(lds + wave * 4096), gw, NGW, lane);
        } else if (NG(1) && ph == 1) {
            p1_rows(argp(0), argp(2), argp(6), mod, H, gw, NGW, lane);
        } else if (NG(3) && ph == 3) {
            gates_phase(argp(11), argp(12), argp(14), argp(16), argp(17), lds, P, Wg, LU, AGG, tid, wave, lane);
            ss_phase(P, ssq, sskv, gw, NGW, lane);
        } else if (NG(6) && ph == 6) {
            krope_phase(P, Kb, RT, gtid, NTH); kvpost_phase(KVR, sskv, Kb, Vb, gtid, NTH);
#ifdef REP6
            if (REP6 & 1) { __syncthreads(); scan_agg(LU, AGG, gw, NGW, lane); }
            if (REP6 & 2) { __syncthreads(); krope_phase(P, Kb, RT, gtid, NTH); }
            if (REP6 & 4) { __syncthreads(); }
            if (REP6 & 8) { __syncthreads(); kvpost_phase(KVR, sskv, Kb, Vb, gtid, NTH); }
#endif
        } else if (NG(7) && ph == 7) {
            scan_final(LU, AGG, P, A2, gw, NGW, lane);
#ifdef REP7
            __syncthreads(); scan_final(LU, AGG, P, A2, gw, NGW, lane);
#endif
            const int upb = (NB * 8 * 16 + G - 1) / G, u0 = vcu * upb, u1 = min(NB * 8 * 16, u0 + upb);
            __syncthreads();
            for (int unit = u0; unit < u1; ++unit) { const int bh = unit >> 4, qb = unit & 15; attn_unit(lds, QR, ssq, RT, Kb, Vb, A2, bh >> 3, bh & 7, qb, tid, wave, lane); }
        } else if (NG(9) && ph == 9) {
            p7_rows(argp(0), argp(7), argp(8), outp, mod, Y, H2, gw, NGW, lane);
        } else if (NG(11) && (ph == 11 || ph == 14)) {
            convgate_phase(argp(24), argp(25), UP, Gb, ph == 14 ? 1 : 0, gtid, NTH);
        } else if (NG(16) && ph == 16) {
            p11_rows(argp(9), outp, mod, Fb, gw, NGW, lane);
        }
        __syncthreads();
#if MK_COOP
        if (ph + 1 < hi_ && ph != 3 && ph != 4 && ph != 12) {
            if (ph == 0) grid.sync();
            else { XcdBarrier xb; xb.bar = (unsigned*)(ws_ + WS_BAR); xb.x = xb_xcc_id(); xb.st = (volatile LAS unsigned*)(lds + LDS_MISC); xcd_barrier(xb); }
        }
#endif
        if (REPMASK) { if (((REPMASK >> ph) & 1) && !repeated) { repeated = true; --ph; } else repeated = false; }
    }
}

extern "C" void kernel_launch(void* const* d_in, const int* in_sizes, int n_in, void* d_out, int out_size, void* d_ws, size_t ws_size, hipStream_t stream) {
    static int grid = 0;
    if (grid == 0) {
        if (n_in != 27 || out_size != MLAT * DM || ws_size < WS_END) { fprintf(stderr, "kernel_launch: unexpected shapes (n_in %d, out %d, ws %zu)\n", n_in, out_size, ws_size); grid = -1; return; }
        int dev = 0, cus = 0, per_cu = 0;
        if (hipGetDevice(&dev) != hipSuccess || hipDeviceGetAttribute(&cus, hipDeviceAttributeMultiprocessorCount, dev) != hipSuccess) { grid = -1; return; }
        if (hipFuncSetAttribute((const void*)fwd_kernel, hipFuncAttributeMaxDynamicSharedMemorySize, LDS_BYTES) != hipSuccess) { fprintf(stderr, "kernel_launch: hipFuncSetAttribute failed\n"); grid = -1; return; }
        if (hipOccupancyMaxActiveBlocksPerMultiprocessor(&per_cu, (const void*)fwd_kernel, 512, LDS_BYTES) != hipSuccess || per_cu < 1) { fprintf(stderr, "kernel_launch: occupancy query says %d\n", per_cu); }
        (void)hipGetLastError();
        grid = cus;
    }
    if (grid < 0) return;
    (void)hipMemsetAsync((char*)d_ws + WS_CTL, 0, CTL_BYTES, stream);
    Args a{};
    for (int i = 0; i < 27; ++i) a.in[i] = (const float*)d_in[i];
    a.out = (float*)d_out; a.ws = (unsigned char*)d_ws;
#if MK_COOP
    a.ph_lo = 0; a.ph_hi = NPH;
    void* args[] = {&a};
    hipError_t e = hipLaunchCooperativeKernel((const void*)fwd_kernel, dim3(grid), dim3(512), args, LDS_BYTES, stream);
    if (e != hipSuccess) fprintf(stderr, "kernel_launch: cooperative launch failed: %s (grid %d)\n", hipGetErrorString(e), grid);
#else
    for (int p = 0; p < NPH; ++p) { a.ph_lo = p; a.ph_hi = p + 1; hipLaunchKernelGGL(fwd_kernel, dim3(grid), dim3(512), LDS_BYTES, stream, a); }
#endif
}
```

```cpp
#include <hip/hip_runtime.h>
#include <hip/hip_cooperative_groups.h>
#include <cstdio>
#include <cstdint>
namespace cg = cooperative_groups;
#ifndef MK_COOP
#define MK_COOP 1
#endif
namespace pg8 {
#define PG8_LAS __attribute__((address_space(3)))
typedef unsigned short bf16_t;
typedef short bf16x8 __attribute__((ext_vector_type(8)));
typedef float f32x4 __attribute__((ext_vector_type(4)));
typedef unsigned u32x4 __attribute__((ext_vector_type(4)));
constexpr int BM = 256, BK = 64, HALF = 128, HTB = HALF * BK * 2  , STAGE_BYTES = 8 * HTB, NXCD = 8, WGM = 8;

__host__ __device__ __forceinline__ int lds_byte(int r, int c) { const int st = (r >> 4) * 2 + (c >> 5), rr = r & 15, cc = c & 31, ob = rr * 64 + cc * 2; return st * 1024 + (ob ^ (((ob >> 9) & 1) << 5)); }
__host__ __device__ __forceinline__ void stage_rc(int b, int& R, int& C) { const int st = b / 1024, sb = b % 1024, swz = sb ^ (((sb >> 9) & 1) << 5); R = (st >> 1) * 16 + swz / 64; C = (st & 1) * 32 + (swz % 64) / 2; }
__host__ __device__ __forceinline__ int perm32(int rho) { const int n = rho >> 4, i = rho & 15; return 8 * (i >> 2) + 4 * n + (i & 3); }

struct Unit { int pm, pn; };
struct Gemm { const bf16_t* A; const bf16_t* Bt; int M, N, K, lda, ldb; };

struct StaticOrder {
    int nM, nN, nwg, G, c;
    __host__ __device__ void init(int M, int N, int G_, int c_) { nM = M / BM; nN = N / BM; nwg = nM * nN; G = G_; c = c_; }
    __host__ __device__ bool next(int i, Unit& u) const {
        const long L = (long)i * G + c; if (L >= nwg) return false;
        int wgid = (int)L; { const int q = nwg / NXCD, r = nwg % NXCD, xcd = wgid % NXCD, off = wgid / NXCD; wgid = (xcd < r ? xcd * (q + 1) : r * (q + 1) + (xcd - r) * q) + off; }
        const int nig = WGM * nN, gid = wgid / nig, fm = gid * WGM, gsz = (nM - fm) < WGM ? (nM - fm) : WGM;
        u.pm = fm + ((wgid % nig) % gsz); u.pn = (wgid % nig) / gsz; return true;
    }
    __device__ __forceinline__ void a_ready(const Unit&) const {}
    __device__ __forceinline__ void done(const Unit&) const {}
};

__device__ __forceinline__ unsigned cvt_pk_bf16(float lo, float hi) { unsigned r; asm volatile("v_cvt_pk_bf16_f32 %0, %1, %2" : "=v"(r) : "v"(lo), "v"(hi)); return r; }
typedef float f32x2 __attribute__((ext_vector_type(2)));
__device__ __forceinline__ f32x2 gelu_pk(f32x2 v) {
    const f32x2 av = __builtin_elementwise_abs(v), d = av * 0.2316418882f + 1.0f;
    f32x2 t; t.x = __builtin_amdgcn_rcpf(d.x); t.y = __builtin_amdgcn_rcpf(d.y);
    f32x2 q = t * 0.5307027145f + (-0.7265760135f); q = q * t + 0.7107068705f; q = q * t + (-0.142248368f); q = q * t + 0.127414796f; q = q * t;
    const f32x2 s = (v * v) * (-0.72134752044f);
    f32x2 e; e.x = __builtin_amdgcn_exp2f(s.x); e.y = __builtin_amdgcn_exp2f(s.y);
    const f32x2 m = v * (q * e), r = v - m;
    f32x2 o; o.x = v.x < 0.f ? m.x : r.x; o.y = v.y < 0.f ? m.y : r.y; return o;
}

template <int ACT  > struct EpiBf16 {
    static constexpr bool PERM = true, AFTER_DRAIN = false; static_assert(ACT == 0 || ACT == 1, "EpiBf16: ACT is 0 (none) or 1 (gelu_pk)");
    bf16_t* O; int ldc; const float* bias; int split_cols; size_t split_stride; float scale0;
    __device__ __forceinline__ void operator()(const f32x4 (&acc)[2][2][4][2], const Unit& u, int wr, int wc, int fr, int fq) const {
        const int row0 = u.pm * BM + wr * 64 + fr; int colt = u.pn * BM; bf16_t* base = O;
        float sc = 1.f; if (split_cols) { const int t = colt / split_cols; base += (size_t)t * split_stride; colt -= t * split_cols; if (t == 0) sc = scale0; }
        const int col0 = colt + wc * 32 + 8 * fq, bcol0 = u.pn * BM + wc * 32 + 8 * fq;
        f32x4 bv[2][2];
#pragma unroll
        for (int bj = 0; bj < 2; ++bj)
#pragma unroll
            for (int n = 0; n < 2; ++n) bv[bj][n] = bias ? *(const f32x4*)(bias + bcol0 + bj * HALF + 4 * n) : (f32x4){0.f, 0.f, 0.f, 0.f};
#pragma unroll
        for (int ai = 0; ai < 2; ++ai)
#pragma unroll
            for (int m = 0; m < 4; ++m) { bf16_t* rowp = base + (size_t)(row0 + ai * HALF + m * 16) * ldc + col0;
#pragma unroll
                for (int bj = 0; bj < 2; ++bj) { f32x4 v0 = acc[ai][bj][m][0] + bv[bj][0], v1 = acc[ai][bj][m][1] + bv[bj][1];
                    if (ACT == 1) { f32x2 a = gelu_pk((f32x2){v0[0], v0[1]}), b = gelu_pk((f32x2){v0[2], v0[3]}), c = gelu_pk((f32x2){v1[0], v1[1]}), d = gelu_pk((f32x2){v1[2], v1[3]});
                        v0 = (f32x4){a.x, a.y, b.x, b.y}; v1 = (f32x4){c.x, c.y, d.x, d.y}; }
                    v0 = v0 * sc; v1 = v1 * sc; u32x4 w; w.x = cvt_pk_bf16(v0[0], v0[1]); w.y = cvt_pk_bf16(v0[2], v0[3]); w.z = cvt_pk_bf16(v1[0], v1[1]); w.w = cvt_pk_bf16(v1[2], v1[3]);
                    *(__attribute__((address_space(1))) u32x4*)(rowp + bj * HALF) = w; } }
    }
};
template <class Epi, class Sched, bool ALIGN_EPI = false, bool SP2 = false>
__device__ __forceinline__ void gemm_phase(PG8_LAS unsigned char* lds, const Gemm g, const Sched& S, const Epi& E, const int tid) {
    const int wid = __builtin_amdgcn_readfirstlane(tid >> 6), lane = tid & 63, wr = wid >> 2, wc = wid & 3, fr = lane & 15, fq = lane >> 4;
    const int K = g.K, nt = K / BK;
    unsigned voffA[2], voffB[2];
#pragma unroll
    for (int i = 0; i < 2; ++i) { int R, C; stage_rc(tid * 16 + i * 8192, R, C); const int Rb = Epi::PERM ? ((R & ~31) + perm32(R & 31)) : R;
        voffA[i] = (unsigned)(R * g.lda + C) * 2u; voffB[i] = (unsigned)(Rb * g.ldb + C) * 2u; }
    const size_t kstep = (size_t)(BK * 2);
    const size_t hstepA = (size_t)HALF * g.lda * 2, hstepB = (size_t)HALF * g.ldb * 2;
    const size_t tstepA = 2 * hstepA, tstepB = 2 * hstepB;
    const unsigned ldsw = (unsigned)wid * 1024u;
    const int aoff = lds_byte(wr * 64 + fr, fq * 8), boff = lds_byte(wc * 32 + fr, fq * 8);
#define PG8_SA(b, h) (((b) * 2 + (h)) * HTB)
#define PG8_SB(b, h) ((4 + (b) * 2 + (h)) * HTB)
#define PG8_STAGE(bufoff, gbase, voff) do { _Pragma("unroll") for (int _i = 0; _i < 2; ++_i) \
        __builtin_amdgcn_global_load_lds((const unsigned*)((const char*)(gbase) + (voff)[_i]), (PG8_LAS unsigned*)(lds + (bufoff) + ldsw + _i * 8192), 16, 0, 0); } while (0)
#define PG8_LDA(dst, b, h) do { _Pragma("unroll") for (int m = 0; m < 4; ++m) _Pragma("unroll") for (int k = 0; k < 2; ++k) dst[m][k] = *(const PG8_LAS bf16x8*)(lds + PG8_SA(b, h) + aoff + m * 2048 + k * 1024); } while (0)
#define PG8_LDB(dst, b, h) do { _Pragma("unroll") for (int n = 0; n < 2; ++n) _Pragma("unroll") for (int k = 0; k < 2; ++k) dst[n][k] = *(const PG8_LAS bf16x8*)(lds + PG8_SB(b, h) + boff + n * 2048 + k * 1024); } while (0)
#define PG8_MMA(ai, bj, At, Bt) do { __builtin_amdgcn_s_setprio(1); _Pragma("unroll") for (int m = 0; m < 4; ++m) _Pragma("unroll") for (int n = 0; n < 2; ++n) _Pragma("unroll") for (int k = 0; k < 2; ++k) \
        acc[ai][bj][m][n] = __builtin_amdgcn_mfma_f32_16x16x32_bf16(Bt[n][k], At[m][k], acc[ai][bj][m][n], 0, 0, 0); __builtin_amdgcn_s_setprio(0); } while (0)
#define PG8_WAIT_V(n) asm volatile("s_waitcnt vmcnt(" #n ")" ::: "memory")
#define PG8_WAIT_L(n) asm volatile("s_waitcnt lgkmcnt(" #n ")" ::: "memory")
#define PG8_BAR __builtin_amdgcn_s_barrier()
#define PG8_SCHED __builtin_amdgcn_sched_barrier(0)
    Unit cur, nxt; int ui = 0;
    if (!S.next(0, cur)) return;
    f32x4 acc[2][2][4][2];
#pragma unroll
    for (int a = 0; a < 2; ++a)
#pragma unroll
        for (int b = 0; b < 2; ++b)
#pragma unroll
            for (int m = 0; m < 4; ++m)
#pragma unroll
                for (int n = 0; n < 2; ++n) acc[a][b][m][n] = (f32x4){0.f, 0.f, 0.f, 0.f};
    bf16x8 At[4][2], B0[2][2], B1[2][2];
    const char* cA = (const char*)g.A + (size_t)cur.pm * tstepA; const char* cB = (const char*)g.Bt + (size_t)cur.pn * tstepB;
    S.a_ready(cur);
    if constexpr (SP2) {
        PG8_STAGE(PG8_SB(0, 0), cB, voffB); PG8_STAGE(PG8_SB(0, 1), cB + hstepB, voffB); PG8_STAGE(PG8_SA(0, 0), cA, voffA); PG8_STAGE(PG8_SA(0, 1), cA + hstepA, voffA);
        if (wr == 1) PG8_BAR;
        PG8_WAIT_V(2); PG8_BAR;
        PG8_STAGE(PG8_SB(1, 0), cB + kstep, voffB); PG8_STAGE(PG8_SA(1, 0), cA + kstep, voffA); PG8_STAGE(PG8_SB(1, 1), cB + hstepB + kstep, voffB);
        PG8_WAIT_V(6); PG8_BAR;
    } else {
        PG8_STAGE(PG8_SB(0, 0), cB, voffB); PG8_STAGE(PG8_SA(0, 0), cA, voffA); PG8_STAGE(PG8_SB(0, 1), cB + hstepB, voffB); PG8_STAGE(PG8_SA(0, 1), cA + hstepA, voffA);
        if (wr == 1) PG8_BAR;
        PG8_WAIT_V(4); PG8_BAR;
        PG8_STAGE(PG8_SB(1, 0), cB + kstep, voffB); PG8_STAGE(PG8_SA(1, 0), cA + kstep, voffA); PG8_STAGE(PG8_SB(1, 1), cB + hstepB + kstep, voffB);
        PG8_WAIT_V(6); PG8_BAR;
    }
    for (;;) {
        const bool has_next = S.next(ui + 1, nxt);
        const char* nA = has_next ? (const char*)g.A + (size_t)nxt.pm * tstepA : cA; const char* nB = has_next ? (const char*)g.Bt + (size_t)nxt.pn * tstepB : cB;
        for (int t = 0; t < nt; t += 2) {
            const bool last = (t == nt - 2);
            const char* a1 = cA + (size_t)(t + 1) * kstep;
            const char* a2 = last ? nA : cA + (size_t)(t + 2) * kstep; const char* b2 = last ? nB : cB + (size_t)(t + 2) * kstep;
            const char* a3 = a2 + kstep; const char* b3 = b2 + kstep;
            if (last && has_next) S.a_ready(nxt);
            if constexpr (SP2) {
            PG8_LDB(B0, 0, 0); PG8_LDB(B1, 0, 1); PG8_SCHED; PG8_LDA(At, 0, 0); PG8_STAGE(PG8_SA(1, 1), a1 + hstepA, voffA);
            PG8_WAIT_V(8); PG8_WAIT_L(0); PG8_BAR; PG8_MMA(0, 0, At, B0); PG8_MMA(0, 1, At, B1); PG8_BAR; PG8_SCHED;
            PG8_LDA(At, 0, 1); PG8_STAGE(PG8_SB(0, 0), b2, voffB); PG8_STAGE(PG8_SB(0, 1), b2 + hstepB, voffB); PG8_STAGE(PG8_SA(0, 0), a2, voffA);
            PG8_WAIT_V(8); PG8_WAIT_L(0); PG8_BAR; PG8_MMA(1, 0, At, B0); PG8_MMA(1, 1, At, B1); PG8_BAR; PG8_SCHED;
            PG8_LDB(B0, 1, 0); PG8_LDB(B1, 1, 1); PG8_SCHED; PG8_LDA(At, 1, 0); PG8_STAGE(PG8_SA(0, 1), a2 + hstepA, voffA);
            PG8_WAIT_V(8); PG8_WAIT_L(0); PG8_BAR; PG8_MMA(0, 0, At, B0); PG8_MMA(0, 1, At, B1); PG8_BAR; PG8_SCHED;
            PG8_LDA(At, 1, 1); PG8_STAGE(PG8_SB(1, 0), b3, voffB); PG8_STAGE(PG8_SB(1, 1), b3 + hstepB, voffB); PG8_STAGE(PG8_SA(1, 0), a3, voffA);
            PG8_WAIT_V(8); PG8_WAIT_L(0); PG8_BAR; PG8_MMA(1, 0, At, B0); PG8_MMA(1, 1, At, B1); PG8_BAR; PG8_SCHED;
            } else {
            PG8_LDB(B0, 0, 0); PG8_SCHED; PG8_LDA(At, 0, 0); PG8_STAGE(PG8_SA(1, 1), a1 + hstepA, voffA);
            PG8_WAIT_L(8); PG8_BAR; PG8_WAIT_L(0); PG8_MMA(0, 0, At, B0); PG8_BAR; PG8_SCHED;
            PG8_LDB(B1, 0, 1); PG8_STAGE(PG8_SB(0, 0), b2, voffB);
            PG8_BAR; PG8_WAIT_L(0); PG8_MMA(0, 1, At, B1); PG8_BAR;
            PG8_LDA(At, 0, 1); PG8_STAGE(PG8_SA(0, 0), a2, voffA);
            PG8_BAR; PG8_WAIT_L(0); PG8_MMA(1, 0, At, B0); PG8_BAR; PG8_SCHED;
            PG8_STAGE(PG8_SB(0, 1), b2 + hstepB, voffB);
            PG8_WAIT_V(6); PG8_BAR; PG8_MMA(1, 1, At, B1); PG8_BAR;
            PG8_LDB(B0, 1, 0); PG8_SCHED; PG8_LDA(At, 1, 0); PG8_STAGE(PG8_SA(0, 1), a2 + hstepA, voffA);
            PG8_WAIT_L(8); PG8_BAR; PG8_WAIT_L(0); PG8_MMA(0, 0, At, B0); PG8_BAR; PG8_SCHED;
            PG8_LDB(B1, 1, 1); PG8_STAGE(PG8_SB(1, 0), b3, voffB);
            PG8_BAR; PG8_WAIT_L(0); PG8_MMA(0, 1, At, B1); PG8_BAR;
            PG8_LDA(At, 1, 1); PG8_STAGE(PG8_SA(1, 0), a3, voffA);
            PG8_BAR; PG8_WAIT_L(0); PG8_MMA(1, 0, At, B0); PG8_BAR; PG8_SCHED;
            PG8_STAGE(PG8_SB(1, 1), b3 + hstepB, voffB);
            PG8_WAIT_V(6); PG8_BAR; PG8_MMA(1, 1, At, B1); PG8_BAR;
            }
        }
        if constexpr (ALIGN_EPI) { if (wr == 0) PG8_BAR; }
        if constexpr (!Epi::AFTER_DRAIN) { E(acc, cur, wr, wc, fr, fq); S.done(cur); }
        if (!has_next) break;
#pragma unroll
        for (int a = 0; a < 2; ++a)
#pragma unroll
            for (int b = 0; b < 2; ++b)
#pragma unroll
                for (int m = 0; m < 4; ++m)
#pragma unroll
                    for (int n = 0; n < 2; ++n) acc[a][b][m][n] = (f32x4){0.f, 0.f, 0.f, 0.f};
        cur = nxt; cA = nA; cB = nB; ++ui;
        if constexpr (ALIGN_EPI) { if (wr == 1) PG8_BAR; }
    }
    PG8_WAIT_V(0);
    if constexpr (!ALIGN_EPI) { if (wr == 0) PG8_BAR; }
    PG8_BAR;
    if constexpr (Epi::AFTER_DRAIN) { E.fused(acc, cur, wr, wc, fr, fq, lds, wid, lane); S.done(cur); }
#undef PG8_SA
#undef PG8_SB
#undef PG8_STAGE
#undef PG8_LDA
#undef PG8_LDB
#undef PG8_MMA
#undef PG8_WAIT_V
#undef PG8_WAIT_L
#undef PG8_BAR
#undef PG8_SCHED
}
}
#define LAS __attribute__((address_space(3)))
#define GAS __attribute__((address_space(1)))
typedef unsigned short bf16_t;
typedef short bf16x8 __attribute__((ext_vector_type(8)));
typedef short s16x4 __attribute__((ext_vector_type(4)));
typedef float f32x4 __attribute__((ext_vector_type(4)));
typedef float f32x16 __attribute__((ext_vector_type(16)));
typedef unsigned u32x4 __attribute__((ext_vector_type(4)));
typedef unsigned u32x2 __attribute__((ext_vector_type(2)));
typedef float f32x2 __attribute__((ext_vector_type(2)));

constexpr int NB = 8, SEQ = 8192, DM = 1024, CTX = 256, MLAT = NB * SEQ, MCTX = NB * CTX, MALL = MLAT + MCTX;
constexpr int PW = 1536, KVLEN = CTX + SEQ, DFF = 2816, NMOD = 6 * DM;
constexpr int NCH = 32, CHL = 256;
constexpr float EPS = 1e-6f;
constexpr float QSCALE = 0.10206207261596575f * 1.4426950408889634f;
constexpr size_t MiB = 1u << 20;
constexpr size_t WS_CTL = 0, CTL_BYTES = 2 * MiB;
constexpr size_t WS_MOD = 64 * 1024, WS_SSQ = 512 * 1024, WS_SSKV = 1024 * 1024, WS_BAR = 1600 * 1024;
constexpr size_t WS_WIN = 2 * MiB, WS_WQ = 5 * MiB, WS_WKV = 6 * MiB, WS_WG = 7 * MiB, WS_WOUT = 8 * MiB, WS_WUP = 10 * MiB, WS_WDN = 21 * MiB;
constexpr size_t WS_AGG = 27 * MiB, WS_ROPE = 29 * MiB + 512 * 1024;
constexpr size_t WS_R1 = 30 * MiB;
constexpr size_t WS_R2 = 162 * MiB;
constexpr size_t WS_LU = 360 * MiB, WS_K = 624 * MiB, WS_V = 723 * MiB, WS_A2 = 789 * MiB;
constexpr size_t WS_UP = 360 * MiB, WS_G = 712 * MiB, WS_Q = 920 * MiB, WS_END = 1016 * MiB;
constexpr int LDS_BYTES = 139264;
constexpr int LDS_MISC = 131072 + 64;

__device__ __forceinline__ unsigned f2bf(float f) { unsigned u = __builtin_bit_cast(unsigned, f); return (u + 0x7fffu + ((u >> 16) & 1u)) >> 16; }
__device__ __forceinline__ unsigned cvtpk(float lo, float hi) { typedef float f2 __attribute__((ext_vector_type(2))); typedef __bf16 b2 __attribute__((ext_vector_type(2))); f2 v = {lo, hi}; b2 r = __builtin_convertvector(v, b2); return __builtin_bit_cast(unsigned, r); }
__device__ __forceinline__ unsigned pk2(float lo, float hi) { return cvtpk(lo, hi); }
__device__ __forceinline__ float bflo(unsigned w) { return __uint_as_float(w << 16); }
__device__ __forceinline__ float bfhi(unsigned w) { return __uint_as_float(w & 0xffff0000u); }
__device__ __forceinline__ float bf2f(bf16_t v) { return __uint_as_float((unsigned)v << 16); }
__device__ __forceinline__ int crow(int r, int hi) { return (r & 3) + 8 * (r >> 2) + 4 * hi; }
__device__ __forceinline__ float wave_sum(float v) {
#pragma unroll
    for (int o = 1; o < 64; o <<= 1) v += __shfl_xor(v, o);
    return v;
}
__device__ __forceinline__ float sigmoidf_(float x) { return __builtin_amdgcn_rcpf(1.f + __builtin_amdgcn_exp2f(-1.4426950408889634f * x)); }
#define LDS_WAIT() asm volatile("s_waitcnt lgkmcnt(0)" ::: "memory")
#define XB_TMO      128
#define XB_XCNT(j)  (256  + 64 * (j))
#define XB_XSUB(j)  (1280 + 64 * (j))
#define XB_XGEN(j)  (2304 + 64 * (j))
#define XB_TOP      3328
#define XB_TOPGEN   3392
#define XCD_BAR_WORDS 3456
#define XB_SPIN_CAP (1u << 18)

__device__ __forceinline__ unsigned xb_ld(unsigned* p)              { return __hip_atomic_load(p, __ATOMIC_RELAXED, __HIP_MEMORY_SCOPE_AGENT); }
__device__ __forceinline__ unsigned xb_add(unsigned* p, unsigned v) { return __hip_atomic_fetch_add(p, v, __ATOMIC_RELAXED, __HIP_MEMORY_SCOPE_AGENT); }
__device__ __forceinline__ unsigned xb_xcc_id() { return (unsigned)__builtin_amdgcn_s_getreg((3 << 11) | 20) & 0xFu; }
#define XB_SPIN(cond, bar) do { unsigned _sp = 0; while (cond) { __builtin_amdgcn_s_sleep(1); \
    if ((++_sp & 255u) == 0u) { if (xb_ld(&(bar)[XB_TMO])) break; if (_sp > XB_SPIN_CAP) { atomicAdd(&(bar)[XB_TMO], 1u); break; } } } } while (0)

struct XcdBarrier {
    unsigned* bar; unsigned x;
    volatile LAS unsigned* st;
};

__device__ __forceinline__ XcdBarrier xcd_barrier_post(unsigned* bar, volatile LAS unsigned* st) {
    XcdBarrier b; b.bar = bar; b.x = xb_xcc_id(); b.st = st;
    if (threadIdx.x == 0) (void)xb_add(&bar[XB_XCNT(b.x)], 1u);
    return b;
}
__device__ __forceinline__ void xcd_barrier_complete(unsigned* bar, unsigned x, unsigned& nloc, unsigned& nx) {
    const unsigned G = gridDim.x * gridDim.y * gridDim.z;
    unsigned sum, cnt, mine, sp = 0u;
    for (;;) {
        sum = 0u; cnt = 0u; mine = 0u;
#pragma unroll
        for (unsigned j = 0; j < 16; ++j) { const unsigned c = xb_ld(&bar[XB_XCNT(j)]); sum += c; cnt += (c > 0u) ? 1u : 0u; mine = (j == x) ? c : mine; }
        if (sum == G) break;
        __builtin_amdgcn_s_sleep(1);
        if ((++sp & 255u) == 0u) { if (xb_ld(&bar[XB_TMO])) break; if (sp > XB_SPIN_CAP) { atomicAdd(&bar[XB_TMO], 1u); break; } }
    }
    nloc = mine > 0u ? mine : 1u; nx = cnt > 0u ? cnt : 1u;
}

__device__ __forceinline__ void xcd_barrier(const XcdBarrier& b) {
    asm volatile("s_waitcnt vmcnt(0)" ::: "memory");
    __syncthreads();
    if (threadIdx.x == 0) {
        unsigned* bar = b.bar;
        __builtin_amdgcn_s_waitcnt(0);
        unsigned nloc = b.st[0], nx = b.st[1];
        if (nloc == 0u) { xcd_barrier_complete(bar, b.x, nloc, nx); b.st[0] = nloc; b.st[1] = nx; }
        const unsigned old = xb_add(&bar[XB_XSUB(b.x)], 1u);
        const unsigned gen = old / nloc;
        if (old + 1u == (gen + 1u) * nloc) {
            __builtin_amdgcn_fence(__ATOMIC_RELEASE, "agent");
            asm volatile("s_waitcnt vmcnt(0)" ::: "memory");
            const unsigned og = xb_add(&bar[XB_TOP], 1u);
            const unsigned tg = og / nx;
            if (og + 1u == (tg + 1u) * nx) xb_add(&bar[XB_TOPGEN], 1u);
            else XB_SPIN(xb_ld(&bar[XB_TOPGEN]) == tg, bar);
            __builtin_amdgcn_fence(__ATOMIC_ACQUIRE, "agent");
            xb_add(&bar[XB_XGEN(b.x)], 1u);
            asm volatile("s_waitcnt vmcnt(0)" ::: "memory");
        } else {
            XB_SPIN(xb_ld(&bar[XB_XGEN(b.x)]) == gen, bar);
            __builtin_amdgcn_fence(__ATOMIC_ACQUIRE, "agent");
            asm volatile("s_waitcnt vmcnt(0)" ::: "memory");
        }
    }
    __syncthreads();
}


struct Args { const float* in[27]; float* out; unsigned char* ws; int ph_lo, ph_hi; };
__device__ __forceinline__ const GAS float* argp(int i) {
    const __attribute__((address_space(4))) char* kp = (const __attribute__((address_space(4))) char*)__builtin_amdgcn_kernarg_segment_ptr();
    asm volatile("" : "+s"(kp));
    const float* p = *(const float* const __attribute__((address_space(4)))*)(kp + 8 * i);
    return (const GAS float*)p;
}

template <int ID> __device__ __forceinline__ float wsrc(const GAS float* __restrict__ p0, const GAS float* __restrict__ p1, int n, int k) {
    if (ID == 0) return n < 1440 ? p0[(size_t)k * 1440 + n] : 0.f;
    if (ID == 1) return p0[k] * p1[(size_t)k * 768 + n];
    if (ID == 2) return k < 128 ? p0[k] * p1[(size_t)k * 1024 + n] : 0.f;
    if (ID == 3) { const int h = n >> 8, np = n & 255, mat = np >> 6, j = np & 63, dir = mat >> 1; const GAS float* w = (mat & 1) ? p1 : p0; return w[(size_t)((dir * 8 + h) * 64 + k) * 64 + j]; }
    if (ID == 4) return p0[(size_t)k * 1024 + n];
    if (ID == 5) return p0[(size_t)k * 5632 + n];
    return p0[(size_t)k * 1024 + n];
}
template <int ID> __device__ __forceinline__ void prep_mat(const GAS float* __restrict__ p0, const GAS float* __restrict__ p1, GAS bf16_t* __restrict__ dst, int N, int K, int gtid, int NT) {
    const int items = N * (K / 8);
    for (int it = gtid; it < items; it += NT) {
        const int n = it % N, k8 = it / N;
        u32x4 o;
        o.x = pk2(wsrc<ID>(p0, p1, n, 8 * k8 + 0), wsrc<ID>(p0, p1, n, 8 * k8 + 1)); o.y = pk2(wsrc<ID>(p0, p1, n, 8 * k8 + 2), wsrc<ID>(p0, p1, n, 8 * k8 + 3));
        o.z = pk2(wsrc<ID>(p0, p1, n, 8 * k8 + 4), wsrc<ID>(p0, p1, n, 8 * k8 + 5)); o.w = pk2(wsrc<ID>(p0, p1, n, 8 * k8 + 6), wsrc<ID>(p0, p1, n, 8 * k8 + 7));
        *(GAS u32x4*)(dst + (size_t)n * K + 8 * k8) = o;
    }
}
__device__ __forceinline__ void mod_phase(const GAS float* __restrict__ cvec, const GAS float* __restrict__ cctx, const GAS float* __restrict__ wmod, const GAS float* __restrict__ bmod, GAS float* __restrict__ mod, LAS float* scr, int gw, int NGW, int lane) {
    for (int task = gw; task < 96 * 16; task += NGW) {
        const int cgp = task % 96, kc = task / 96, n = cgp * 64 + lane, k0 = kc * 64;
#pragma unroll
        for (int r = 0; r < 9; ++r) { const float cv = r < 8 ? cvec[r * 1024 + k0 + lane] : cctx[k0 + lane]; scr[r * 64 + lane] = cv / (1.f + __expf(-cv)); }
        LDS_WAIT();
        float acc[9];
#pragma unroll
        for (int r = 0; r < 9; ++r) acc[r] = 0.f;
#pragma unroll 8
        for (int kk = 0; kk < 64; ++kk) { const float w = wmod[(size_t)(k0 + kk) * NMOD + n];
#pragma unroll
            for (int r = 0; r < 9; ++r) acc[r] += scr[r * 64 + kk] * w; }
        const float bias = kc == 0 ? bmod[n] : 0.f;
#pragma unroll
        for (int r = 0; r < 9; ++r) atomicAdd((float*)(mod + r * NMOD + n), acc[r] + bias);
        LDS_WAIT();
    }
}
__device__ __forceinline__ void p1_rows(const GAS float* __restrict__ x, const GAS float* __restrict__ ctx, const GAS float* __restrict__ g, const GAS float* __restrict__ mod, GAS bf16_t* __restrict__ H, int gw, int NGW, int lane) {
    for (int m0 = 2 * gw; m0 < MALL; m0 += 2 * NGW) {
        f32x4 v[2][4]; float ss[2];
#pragma unroll
        for (int r = 0; r < 2; ++r) { const int m = m0 + r; const GAS float* src = m < MLAT ? x + (size_t)m * DM : ctx + (size_t)(m - MLAT) * DM; ss[r] = 0.f;
#pragma unroll
            for (int j = 0; j < 4; ++j) { v[r][j] = *(const GAS f32x4*)(src + 4 * lane + 256 * j); ss[r] += v[r][j].x * v[r][j].x + v[r][j].y * v[r][j].y + v[r][j].z * v[r][j].z + v[r][j].w * v[r][j].w; } }
#pragma unroll
        for (int r = 0; r < 2; ++r) { const int m = m0 + r; const GAS float* md = mod + (m < MLAT ? (m >> 13) : 8) * NMOD;
            const float rs = rsqrtf(wave_sum(ss[r]) * (1.f / DM) + EPS);
#pragma unroll
            for (int j = 0; j < 4; ++j) { const int k = 4 * lane + 256 * j;
                const f32x4 gg = *(const GAS f32x4*)(g + k), sh = *(const GAS f32x4*)(md + k), sc = *(const GAS f32x4*)(md + DM + k);
                const f32x4 y = v[r][j] * rs * gg * (sc + 1.f) + sh;
                u32x2 o; o.x = pk2(y.x, y.y); o.y = pk2(y.z, y.w); *(GAS u32x2*)(H + (size_t)m * DM + k) = o; } }
    }
}
__device__ __forceinline__ void ss_phase(const GAS bf16_t* __restrict__ P, GAS float* __restrict__ ssq, GAS float* __restrict__ sskv, int gw, int NGW, int lane) {
#pragma unroll 4
    for (int m = gw; m < MALL; m += NGW) {
        const u32x2 q = *(const GAS u32x2*)(P + (size_t)m * PW + 1024 + 4 * lane); const unsigned k = *(const GAS unsigned*)(P + (size_t)m * PW + 1280 + 2 * lane);
        float a = bflo(q.x) * bflo(q.x) + bfhi(q.x) * bfhi(q.x) + bflo(q.y) * bflo(q.y) + bfhi(q.y) * bfhi(q.y), c = bflo(k) * bflo(k) + bfhi(k) * bfhi(k);
        a = wave_sum(a); c = wave_sum(c);
        if (lane == 0) { ssq[m] = a; sskv[m] = c; }
    }
}
__device__ __forceinline__ void qpost_phase(const GAS bf16_t* __restrict__ QR, const GAS float* __restrict__ ssq, const GAS float* __restrict__ RT, GAS bf16_t* __restrict__ Q, int gtid, int NT) {
#pragma unroll 4
    for (int task = gtid; task < MLAT * 96; task += NT) {
        const int row = task / 96, c8 = task - row * 96, h = c8 / 12, dc = c8 - h * 12, b = row >> 13, s = row & 8191;
        const float sc = rsqrtf(ssq[row] * (1.f / 256.f) + EPS) * QSCALE;
        const u32x4 mine = *(const GAS u32x4*)(QR + (size_t)row * 768 + 8 * c8);
        float v[8];
#pragma unroll
        for (int j = 0; j < 4; ++j) { v[2 * j] = bflo(mine[j]) * sc; v[2 * j + 1] = bfhi(mine[j]) * sc; }
        if (dc >= 8) { const int fq = dc - 8; const u32x4 oth = *(const GAS u32x4*)(QR + (size_t)row * 768 + 8 * (c8 ^ 1));
            const GAS float* rt = RT + (fq < 2 ? (s >> 6) : (s & 63)) * 16;
#pragma unroll
            for (int j = 0; j < 8; ++j) { const float pt = ((j & 1) ? bfhi(oth[j >> 1]) : bflo(oth[j >> 1])) * sc, cs = rt[2 * j], sn = rt[2 * j + 1];
                v[j] = (fq & 1) ? v[j] * cs + pt * sn : v[j] * cs - pt * sn; } }
        u32x4 w; w.x = pk2(v[0], v[1]); w.y = pk2(v[2], v[3]); w.z = pk2(v[4], v[5]); w.w = pk2(v[6], v[7]);
        *(GAS u32x4*)(Q + ((size_t)((b * 8 + h) * SEQ + s)) * 96 + 8 * dc) = w;
    }
}
__device__ __forceinline__ void kvpost_phase(const GAS bf16_t* __restrict__ KVR, const GAS float* __restrict__ sskv, GAS bf16_t* __restrict__ Kb, GAS bf16_t* __restrict__ Vt, int gtid, int NT) {
#pragma unroll 4
    for (int task = gtid; task < MALL * 64; task += NT) {
        const int row = task >> 6, c = task & 63, h = c >> 3, dd = (c & 7) * 8; const bool lat = row < MLAT;
        const int b = lat ? (row >> 13) : ((row - MLAT) >> 8), pos = lat ? (CTX + (row & 8191)) : ((row - MLAT) & 255);
        const float rs = rsqrtf(sskv[row] * (1.f / 128.f) + EPS);
        const u32x4 mine = *(const GAS u32x4*)(KVR + (size_t)row * 1024 + h * 128 + dd);
        u32x4 w;
#pragma unroll
        for (int j = 0; j < 4; ++j) w[j] = pk2(bflo(mine[j]) * rs, bfhi(mine[j]) * rs);
        *(GAS u32x4*)(Kb + ((size_t)(b * 8 + h) * KVLEN + pos) * 96 + dd) = w;
    }
#pragma unroll 2
    for (int task = gtid; task < (MALL / 8) * 512; task += NT) {
        const int pg = task & 7, dd = (task >> 3) & 7, rest = task >> 6, hd8 = rest & 63, rb = rest >> 6, h = hd8 >> 3, d = (hd8 & 7) * 8 + dd, row0 = rb * 64 + pg * 8; const bool lat = row0 < MLAT;
        const int b = lat ? (row0 >> 13) : ((row0 - MLAT) >> 8), pos0 = lat ? (CTX + (row0 & 8191)) : ((row0 - MLAT) & 255);
        float v[8];
#pragma unroll
        for (int i = 0; i < 8; ++i) v[i] = bf2f(KVR[(size_t)(row0 + i) * 1024 + h * 128 + 64 + d]) * rsqrtf(sskv[row0 + i] * (1.f / 128.f) + EPS);
        u32x4 w; w.x = pk2(v[0], v[1]); w.y = pk2(v[2], v[3]); w.z = pk2(v[4], v[5]); w.w = pk2(v[6], v[7]);
        *(GAS u32x4*)(Vt + ((size_t)((b * 8 + h) * 64 + d)) * KVLEN + pos0) = w;
    }
}
__device__ __forceinline__ void krope_phase(const GAS bf16_t* __restrict__ P, GAS bf16_t* __restrict__ Kb, const GAS float* __restrict__ RT, int gtid, int NT) {
#pragma unroll 2
    for (int task = gtid; task < MALL * 4; task += NT) {
        const int row = task >> 2, fq = task & 3; const bool lat = row < MLAT;
        const int b = lat ? (row >> 13) : ((row - MLAT) >> 8), s = row & 8191, pos = lat ? (CTX + s) : ((row - MLAT) & 255);
        const u32x4 mine = *(const GAS u32x4*)(P + (size_t)row * PW + 1408 + 8 * fq), oth = *(const GAS u32x4*)(P + (size_t)row * PW + 1408 + 8 * (fq ^ 1));
        float v[8], pt[8];
#pragma unroll
        for (int j = 0; j < 4; ++j) { v[2 * j] = bflo(mine[j]); v[2 * j + 1] = bfhi(mine[j]); pt[2 * j] = bflo(oth[j]); pt[2 * j + 1] = bfhi(oth[j]); }
        if (lat) { const GAS float* rt = RT + (fq < 2 ? (s >> 6) : (s & 63)) * 16;
#pragma unroll
            for (int j = 0; j < 8; ++j) { const float cs = rt[2 * j], sn = rt[2 * j + 1]; v[j] = (fq & 1) ? v[j] * cs + pt[j] * sn : v[j] * cs - pt[j] * sn; } }
        u32x4 w; w.x = pk2(v[0], v[1]); w.y = pk2(v[2], v[3]); w.z = pk2(v[4], v[5]); w.w = pk2(v[6], v[7]);
#pragma unroll
        for (int h = 0; h < 8; ++h) *(GAS u32x4*)(Kb + ((size_t)(b * 8 + h) * KVLEN + pos) * 96 + 64 + 8 * fq) = w;
    }
}
#define MFMA32(a, b, c) __builtin_amdgcn_mfma_f32_32x32x16_bf16((a), (b), (c), 0, 0, 0)
__device__ __forceinline__ void gates_phase(const GAS float* __restrict__ cw, const GAS float* __restrict__ cb, const GAS float* __restrict__ b_a, const GAS float* __restrict__ b_x, const GAS float* __restrict__ lam, LAS unsigned char* lds, const GAS bf16_t* __restrict__ P, const GAS bf16_t* __restrict__ Wg, GAS unsigned* __restrict__ LU, GAS f32x2* __restrict__ AGG, int tid, int wave, int lane) {
    LAS bf16_t* xs = (LAS bf16_t*)(lds + wave * 4608);
    LAS f32x2* wagg = (LAS f32x2*)(lds + 8 * 4608);
    const int r32 = lane & 31, hi = lane >> 5;
    for (int unit = blockIdx.x; unit < (MALL / 256) * 8; unit += gridDim.x) {
        const int pm = unit >> 3, h = unit & 7, m0 = pm * 256 + wave * 32;
        const int s0 = m0 < MLAT ? (m0 & ~8191) : (MLAT + ((m0 - MLAT) & ~255)), slen = m0 < MLAT ? SEQ : CTX;
        {
            const int tok = lane >> 1, m = m0 + tok;
#pragma unroll
            for (int c8 = 0; c8 < 4; ++c8) { const int ch = (lane & 1) * 32 + c8 * 8, gch = h * 64 + ch;
                float acc[8];
                { const f32x4 b0 = *(const GAS f32x4*)(cb + gch), b1 = *(const GAS f32x4*)(cb + gch + 4);
                  acc[0] = b0.x; acc[1] = b0.y; acc[2] = b0.z; acc[3] = b0.w; acc[4] = b1.x; acc[5] = b1.y; acc[6] = b1.z; acc[7] = b1.w; }
#pragma unroll
                for (int k = 0; k < 4; ++k) { const int mm = m + k - 2;
                    if (mm >= s0 && mm < s0 + slen) { const u32x4 xv = *(const GAS u32x4*)(P + (size_t)mm * PW + gch);
                        const f32x4 w0 = *(const GAS f32x4*)(cw + k * 512 + gch), w1 = *(const GAS f32x4*)(cw + k * 512 + gch + 4);
                        acc[0] += w0.x * bflo(xv.x); acc[1] += w0.y * bfhi(xv.x); acc[2] += w0.z * bflo(xv.y); acc[3] += w0.w * bfhi(xv.y);
                        acc[4] += w1.x * bflo(xv.z); acc[5] += w1.y * bfhi(xv.z); acc[6] += w1.z * bflo(xv.w); acc[7] += w1.w * bfhi(xv.w); } }
                u32x4 o; o.x = pk2(acc[0], acc[1]); o.y = pk2(acc[2], acc[3]); o.z = pk2(acc[4], acc[5]); o.w = pk2(acc[6], acc[7]);
                *(LAS u32x4*)(xs + tok * 72 + ch) = o; }
        }
        LDS_WAIT();
        bf16x8 afr[4];
#pragma unroll
        for (int ks = 0; ks < 4; ++ks) afr[ks] = *(const LAS bf16x8*)(xs + r32 * 72 + 16 * ks + 8 * hi);
#pragma unroll
        for (int jh = 0; jh < 2; ++jh) {
            f32x16 acc4[4];
#pragma unroll
            for (int q = 0; q < 4; ++q) {
#pragma unroll
                for (int i = 0; i < 16; ++i) acc4[q][i] = 0.f;
                const GAS bf16_t* wrow = Wg + (size_t)(h * 256 + (2 * q + jh) * 32 + r32) * 64 + 8 * hi;
#pragma unroll
                for (int ks = 0; ks < 4; ++ks) { const bf16x8 bfr = *(const GAS bf16x8*)(wrow + 16 * ks); acc4[q] = MFMA32(afr[ks], bfr, acc4[q]); }
            }
            const int ch = jh * 32 + r32, gch = h * 64 + ch;
            float ba[2], bx[2], sp[2];
#pragma unroll
            for (int d = 0; d < 2; ++d) { ba[d] = b_a[d * 512 + gch]; bx[d] = b_x[d * 512 + gch]; const float nl = -lam[d * 512 + gch];
                sp[d] = 8.f * 1.4426950408889634f * (nl > 20.f ? nl : log1pf(__expf(nl))); }
            unsigned wv[16][2];
#pragma unroll
            for (int i = 0; i < 16; ++i) { const int row = crow(i, hi); const float xv = bf2f(xs[row * 72 + ch]);
#pragma unroll
                for (int d = 0; d < 2; ++d) { const float r = sigmoidf_(acc4[2 * d][i] + ba[d]), ig = sigmoidf_(acc4[2 * d + 1][i] + bx[d]);
                    const float la2 = -r * sp[d]; const float uu = __builtin_amdgcn_sqrtf(fmaxf(1.f - __builtin_amdgcn_exp2f(2.f * la2), 0.f)) * (ig * xv);
                    wv[i][d] = pk2(la2, uu);
                    LU[((size_t)(m0 + row) * 2 + d) * 512 + gch] = wv[i][d]; } }
#pragma unroll
            for (int d = 0; d < 2; ++d) {
                float Ar[4], Ur[4];
#pragma unroll
                for (int g = 0; g < 4; ++g) { float A = 1.f, U = 0.f;
#pragma unroll
                    for (int jj = 0; jj < 4; ++jj) { const int j = d ? 3 - jj : jj; const unsigned w = wv[4 * g + j][d]; const float av = __builtin_amdgcn_exp2f(bflo(w)); A *= av; U = av * U + bfhi(w); }
                    Ar[g] = A; Ur[g] = U; }
                float A = 1.f, U = 0.f;
#pragma unroll
                for (int gg = 0; gg < 4; ++gg) { const int g = d ? 3 - gg : gg;
                    const float Ao = __shfl_xor(Ar[g], 32), Uo = __shfl_xor(Ur[g], 32);
                    if (d == 0) { U = Ar[g] * U + Ur[g]; A *= Ar[g]; U = Ao * U + Uo; A *= Ao; }
                    else        { U = Ao * U + Uo; A *= Ao; U = Ar[g] * U + Ur[g]; A *= Ar[g]; } }
                if (hi == 0) wagg[(wave * 2 + d) * 64 + ch] = (f32x2){A, U};
            }
        }
        LDS_WAIT();
        __syncthreads();
        if (tid < 128) {
            const int d = tid >> 6, ch = tid & 63; float A = 1.f, U = 0.f;
#pragma unroll
            for (int ww = 0; ww < 8; ++ww) { const int w = d ? 7 - ww : ww; const f32x2 g = wagg[(w * 2 + d) * 64 + ch]; U = g.x * U + g.y; A *= g.x; }
            const int b = pm < MLAT / 256 ? (pm >> 5) : (pm - MLAT / 256), c = pm < MLAT / 256 ? (pm & 31) : NCH;
            AGG[(size_t)((b * 2 + d) * (NCH + 1) + c) * 512 + h * 64 + ch] = (f32x2){A, U};
        }
        __syncthreads();
    }
}
__device__ __forceinline__ void scan_agg(const GAS unsigned* __restrict__ LU, GAS f32x2* __restrict__ AGG, int gw, int NGW, int lane) {
    for (int task = gw; task < NB * 2 * (NCH + 1) * 8; task += NGW) {
        const int cgp = task & 7, c = (task >> 3) % (NCH + 1), d = (task / (8 * (NCH + 1))) & 1, b = task / (16 * (NCH + 1));
        const int ch = cgp * 64 + lane, row0 = c < NCH ? b * SEQ + c * CHL : MLAT + b * CTX;
        float A = 1.f, U = 0.f;
#pragma unroll 16
        for (int t = 0; t < CHL; ++t) { const int tt = d ? CHL - 1 - t : t; const unsigned w = LU[((size_t)(row0 + tt) * 2 + d) * 512 + ch];
            const float av = __builtin_amdgcn_exp2f(bflo(w)); A *= av; U = av * U + bfhi(w); }
        AGG[(size_t)((b * 2 + d) * (NCH + 1) + c) * 512 + ch] = (f32x2){A, U};
    }
}
__device__ __forceinline__ float gelu_tanh(float x) { const float z = 0.7978845608028654f * (x + 0.044715f * x * x * x);
    return x * __builtin_amdgcn_rcpf(1.f + __builtin_amdgcn_exp2f(-2.8853900817779268f * z)); }
__device__ __forceinline__ void scan_final(const GAS unsigned* __restrict__ LU, const GAS f32x2* __restrict__ AGG, const GAS bf16_t* __restrict__ P, GAS bf16_t* __restrict__ A2, int gw, int NGW, int lane) {
    constexpr int BT = 16;
    for (int task = gw; task < NB * NCH * 8; task += NGW) {
        const int cgp = task & 7, c = (task >> 3) & (NCH - 1), b = task / (8 * NCH), ch = cgp * 64 + lane, row0 = b * SEQ + c * CHL;
        const GAS f32x2* ag0 = AGG + (size_t)((b * 2 + 0) * (NCH + 1)) * 512 + ch; const GAS f32x2* ag1 = AGG + (size_t)((b * 2 + 1) * (NCH + 1)) * 512 + ch;
        unsigned w[BT], wn[BT];
#pragma unroll
        for (int i = 0; i < BT; ++i) w[i] = LU[((size_t)(row0 + i) * 2 + 0) * 512 + ch];
        float hf = ag0[(size_t)NCH * 512].y;
        for (int cc = 0; cc < c; ++cc) { const f32x2 g = ag0[(size_t)cc * 512]; hf = g.x * hf + g.y; }
        float hb = ag1[(size_t)NCH * 512].y;
        for (int cc = NCH - 1; cc > c; --cc) { const f32x2 g = ag1[(size_t)cc * 512]; hb = g.x * hb + g.y; }
#pragma unroll 1
        for (int t0 = 0; t0 < CHL; t0 += BT) {
            if (t0 + BT < CHL) {
#pragma unroll
                for (int i = 0; i < BT; ++i) wn[i] = LU[((size_t)(row0 + t0 + BT + i) * 2 + 0) * 512 + ch]; }
#pragma unroll
            for (int i = 0; i < BT; ++i) { hf = __builtin_amdgcn_exp2f(bflo(w[i])) * hf + bfhi(w[i]); A2[(size_t)(row0 + t0 + i) * DM + ch] = (bf16_t)f2bf(hf); }
#pragma unroll
            for (int i = 0; i < BT; ++i) w[i] = wn[i]; }
        bf16_t gr[BT], grn[BT];
#pragma unroll
        for (int i = 0; i < BT; ++i) { w[i] = LU[((size_t)(row0 + CHL - BT + i) * 2 + 1) * 512 + ch]; gr[i] = P[(size_t)(row0 + CHL - BT + i) * PW + 512 + ch]; }
#pragma unroll 1
        for (int t0 = CHL - BT; t0 >= 0; t0 -= BT) { bf16_t f[BT];
#pragma unroll
            for (int i = 0; i < BT; ++i) f[i] = A2[(size_t)(row0 + t0 + i) * DM + ch];
            if (t0 >= BT) {
#pragma unroll
                for (int i = 0; i < BT; ++i) { wn[i] = LU[((size_t)(row0 + t0 - BT + i) * 2 + 1) * 512 + ch]; grn[i] = P[(size_t)(row0 + t0 - BT + i) * PW + 512 + ch]; } }
#pragma unroll
            for (int i = BT - 1; i >= 0; --i) { hb = __builtin_amdgcn_exp2f(bflo(w[i])) * hb + bfhi(w[i]);
                A2[(size_t)(row0 + t0 + i) * DM + ch] = (bf16_t)f2bf((bf2f(f[i]) + hb) * gelu_tanh(bf2f(gr[i]))); }
#pragma unroll
            for (int i = 0; i < BT; ++i) { w[i] = wn[i]; gr[i] = grn[i]; } }
    }
}
constexpr int AT_KROW = 208, AT_VROW = 144;
constexpr float AT_THR = 8.f;
#define AT_LMAX(P, MX) do { MX = fmaxf(fmaxf(P[0], P[1]), fmaxf(P[2], P[3])); \
        _Pragma("unroll") for (int i_ = 4; i_ < 16; i_ += 4) MX = fmaxf(fmaxf(MX, P[i_]), fmaxf(fmaxf(P[i_ + 1], P[i_ + 2]), P[i_ + 3])); } while (0)
#define AT_SOFTMAX(P, MX, M, L, O0, O1, PW0, PW1) do { \
        if (__any(MX > M + AT_THR)) { const float mn_ = fmaxf(M, MX), al_ = __builtin_amdgcn_exp2f(M - mn_); M = mn_; L *= al_; \
            _Pragma("unroll") for (int i_ = 0; i_ < 16; ++i_) { O0[i_] *= al_; O1[i_] *= al_; } } \
        float s_ = 0.f; \
        _Pragma("unroll") for (int i_ = 0; i_ < 16; ++i_) { P[i_] = __builtin_amdgcn_exp2f(P[i_] - M); s_ += P[i_]; } \
        L += s_; \
        _Pragma("unroll") for (int j_ = 0; j_ < 4; ++j_) { PW0[j_] = cvtpk(P[2 * j_], P[2 * j_ + 1]); PW1[j_] = cvtpk(P[8 + 2 * j_], P[9 + 2 * j_]); } } while (0)
__device__ __forceinline__ void glds16(const GAS void* gsrc, unsigned lds_dst) {
    unsigned keep;
    asm volatile("s_mov_b32 %0, m0\n\ts_mov_b32 m0, %2\n\ts_nop 0\n\tglobal_load_lds_dwordx4 %1, off\n\ts_mov_b32 m0, %0" : "=&s"(keep) : "v"(gsrc), "s"(lds_dst) : "memory");
}
constexpr int AT_SLOT = 22 * 1024, AT_VOFF = 13 * 1024, AT_NP = 22;
__device__ __forceinline__ void attn_unit(LAS unsigned char* lds, const GAS bf16_t* __restrict__ QR, const GAS float* __restrict__ ssq, const GAS float* __restrict__ RT, const GAS bf16_t* __restrict__ K, const GAS bf16_t* __restrict__ Vt, GAS bf16_t* __restrict__ A2, int b, int h, int qb, int tid, int wave, int lane) {
    const int r32 = lane & 31, hi = lane >> 5, q0 = qb * 512 + wave * 64, r32s = (r32 & ~12) | ((r32 & 4) << 1) | ((r32 & 8) >> 1);
    bf16x8 qa[6], qc[6];
#pragma unroll
    for (int sub = 0; sub < 2; ++sub) {
        const int s = q0 + 32 * sub + r32, row = b * SEQ + s;
        const GAS bf16_t* Qp = QR + (size_t)row * 768 + h * 96 + 8 * hi;
        const float sc = rsqrtf(ssq[row] * (1.f / 256.f) + EPS) * QSCALE;
#pragma unroll
        for (int d0 = 0; d0 < 6; ++d0) {
            const u32x4 raw = *(const GAS u32x4*)(Qp + 16 * d0);
            float v[8];
#pragma unroll
            for (int j = 0; j < 4; ++j) { v[2 * j] = bflo(raw[j]) * sc; v[2 * j + 1] = bfhi(raw[j]) * sc; }
            if (d0 >= 4) { const GAS float* rt = RT + (d0 == 4 ? (s >> 6) : (s & 63)) * 16;
#pragma unroll
                for (int j = 0; j < 8; ++j) { const float pt = __shfl_xor(v[j], 32), cs = rt[2 * j], sn = rt[2 * j + 1]; v[j] = hi ? v[j] * cs + pt * sn : v[j] * cs - pt * sn; } }
            u32x4 w; w.x = pk2(v[0], v[1]); w.y = pk2(v[2], v[3]); w.z = pk2(v[4], v[5]); w.w = pk2(v[6], v[7]);
            if (sub == 0) qa[d0] = __builtin_bit_cast(bf16x8, w); else qc[d0] = __builtin_bit_cast(bf16x8, w);
        }
    }
    const GAS unsigned char* Kg = (const GAS unsigned char*)(K + (size_t)(b * 8 + h) * KVLEN * 96);
    const GAS unsigned char* Vg = (const GAS unsigned char*)(Vt + (size_t)(b * 8 + h) * 64 * KVLEN);
    const unsigned ldsb = (unsigned)(size_t)lds;
    const GAS unsigned char* src[3]; int stride[3]; unsigned dsto[3];
#pragma unroll
    for (int k = 0; k < 3; ++k) { int j = wave + 8 * k; if (j >= AT_NP) j -= 8; const int id = j * 64 + lane;
        if (j < 13) { const int row = id / 13; int col = id - row * 13; if (col == 12) col = 0; src[k] = Kg + row * 192 + col * 16; stride[k] = 12288; }
        else { const int idv = id - 832, d = idv / 9; int c = idv - d * 9; if (c == 8) c = 0; src[k] = Vg + ((size_t)d * KVLEN + c * 8) * 2; stride[k] = 128; }
        dsto[k] = ldsb + j * 1024; }
#define AT_ISSUE(t, slot) do { _Pragma("unroll") for (int k_ = 0; k_ < 3; ++k_) glds16(src[k_] + (size_t)(t) * stride[k_], (unsigned)__builtin_amdgcn_readfirstlane(dsto[k_] + (slot) * AT_SLOT)); } while (0)
    f32x16 oA0, oA1, oB0, oB1;
#pragma unroll
    for (int i = 0; i < 16; ++i) { oA0[i] = 0.f; oA1[i] = 0.f; oB0[i] = 0.f; oB1[i] = 0.f; }
    float mA = -1e30f, mB = -1e30f, lA = 0.f, lB = 0.f;
    constexpr int NT_ = KVLEN / 64;
    AT_ISSUE(0, 0); AT_ISSUE(1, 1);
    int slot = 0, nslot = 2;
#pragma unroll 1
    for (int t = 0; t < NT_; ++t) {
        if (t + 1 < NT_) asm volatile("s_waitcnt vmcnt(3) lgkmcnt(0)\n\ts_barrier" ::: "memory"); else asm volatile("s_waitcnt vmcnt(0) lgkmcnt(0)\n\ts_barrier" ::: "memory");
        if (t + 2 < NT_) AT_ISSUE(t + 2, nslot);
        const LAS unsigned char* sb = lds + slot * AT_SLOT;
#pragma unroll
        for (int hh = 0; hh < 2; ++hh) {
            const LAS unsigned char* kb = sb + (32 * hh + r32s) * AT_KROW + hi * 16;
            f32x16 pA, pB;
#pragma unroll
            for (int i = 0; i < 16; ++i) { pA[i] = 0.f; pB[i] = 0.f; }
#pragma unroll
            for (int d0 = 0; d0 < 6; ++d0) { const bf16x8 a0 = *(const LAS bf16x8*)(kb + d0 * 32); pA = MFMA32(a0, qa[d0], pA); pB = MFMA32(a0, qc[d0], pB); }
            u32x4 pwA0, pwA1, pwB0, pwB1;
            float mxA, mxB; AT_LMAX(pA, mxA); AT_LMAX(pB, mxB);
            { const float oa = __shfl_xor(mxA, 32), ob = __shfl_xor(mxB, 32); mxA = fmaxf(mxA, oa); mxB = fmaxf(mxB, ob); }
            AT_SOFTMAX(pA, mxA, mA, lA, oA0, oA1, pwA0, pwA1);
            AT_SOFTMAX(pB, mxB, mB, lB, oB0, oB1, pwB0, pwB1);
            const LAS unsigned char* vb = sb + AT_VOFF + r32 * AT_VROW + hi * 16 + hh * 64;
#pragma unroll
            for (int ks = 0; ks < 2; ++ks) {
                const bf16x8 va0 = *(const LAS bf16x8*)(vb + ks * 32), va1 = *(const LAS bf16x8*)(vb + 32 * AT_VROW + ks * 32);
                const bf16x8 pa = __builtin_bit_cast(bf16x8, ks ? pwA1 : pwA0), pb = __builtin_bit_cast(bf16x8, ks ? pwB1 : pwB0);
                oA0 = MFMA32(va0, pa, oA0); oA1 = MFMA32(va1, pa, oA1); oB0 = MFMA32(va0, pb, oB0); oB1 = MFMA32(va1, pb, oB1);
            }
        }
        slot = slot == 2 ? 0 : slot + 1; nslot = nslot == 2 ? 0 : nslot + 1;
    }
    asm volatile("s_waitcnt lgkmcnt(0)\n\ts_barrier" ::: "memory");
    {   const float inv = 1.f / (lA + __shfl_xor(lA, 32));
        GAS bf16_t* op = A2 + (size_t)(b * SEQ + q0 + r32) * DM + 512 + h * 64 + 4 * hi;
#pragma unroll
        for (int g = 0; g < 4; ++g) { u32x2 w0, w1; w0.x = pk2(oA0[4 * g] * inv, oA0[4 * g + 1] * inv); w0.y = pk2(oA0[4 * g + 2] * inv, oA0[4 * g + 3] * inv);
            w1.x = pk2(oA1[4 * g] * inv, oA1[4 * g + 1] * inv); w1.y = pk2(oA1[4 * g + 2] * inv, oA1[4 * g + 3] * inv);
            *(GAS u32x2*)(op + 8 * g) = w0; *(GAS u32x2*)(op + 32 + 8 * g) = w1; } }
    {   const float inv = 1.f / (lB + __shfl_xor(lB, 32));
        GAS bf16_t* op = A2 + (size_t)(b * SEQ + q0 + 32 + r32) * DM + 512 + h * 64 + 4 * hi;
#pragma unroll
        for (int g = 0; g < 4; ++g) { u32x2 w0, w1; w0.x = pk2(oB0[4 * g] * inv, oB0[4 * g + 1] * inv); w0.y = pk2(oB0[4 * g + 2] * inv, oB0[4 * g + 3] * inv);
            w1.x = pk2(oB1[4 * g] * inv, oB1[4 * g + 1] * inv); w1.y = pk2(oB1[4 * g + 2] * inv, oB1[4 * g + 3] * inv);
            *(GAS u32x2*)(op + 8 * g) = w0; *(GAS u32x2*)(op + 32 + 8 * g) = w1; } }
#undef AT_ISSUE
}
__device__ __forceinline__ void p7_rows(const GAS float* __restrict__ x, const GAS float* __restrict__ g_post, const GAS float* __restrict__ g_pre, GAS float* __restrict__ out, const GAS float* __restrict__ mod, const GAS bf16_t* __restrict__ Y, GAS bf16_t* __restrict__ H2, int gw, int NGW, int lane) {
    for (int m0 = 2 * gw; m0 < MLAT; m0 += 2 * NGW) {
        const GAS float* md = mod + (m0 >> 13) * NMOD;
        f32x4 y[2][4], xv[2][4]; float ss[2];
#pragma unroll
        for (int r = 0; r < 2; ++r) { ss[r] = 0.f;
#pragma unroll
            for (int j = 0; j < 4; ++j) { const u32x2 w = *(const GAS u32x2*)(Y + (size_t)(m0 + r) * DM + 4 * lane + 256 * j); xv[r][j] = *(const GAS f32x4*)(x + (size_t)(m0 + r) * DM + 4 * lane + 256 * j);
                y[r][j] = (f32x4){bflo(w.x), bfhi(w.x), bflo(w.y), bfhi(w.y)}; ss[r] += y[r][j].x * y[r][j].x + y[r][j].y * y[r][j].y + y[r][j].z * y[r][j].z + y[r][j].w * y[r][j].w; } }
#pragma unroll
        for (int r = 0; r < 2; ++r) { const int m = m0 + r;
            const float rs = rsqrtf(wave_sum(ss[r]) * (1.f / DM) + EPS); float s2 = 0.f;
#pragma unroll
            for (int j = 0; j < 4; ++j) { const int k = 4 * lane + 256 * j;
                const f32x4 gg = *(const GAS f32x4*)(g_post + k), gt = *(const GAS f32x4*)(md + 2 * DM + k);
                xv[r][j] = xv[r][j] + gt * (y[r][j] * rs * gg); *(GAS f32x4*)(out + (size_t)m * DM + k) = xv[r][j];
                s2 += xv[r][j].x * xv[r][j].x + xv[r][j].y * xv[r][j].y + xv[r][j].z * xv[r][j].z + xv[r][j].w * xv[r][j].w; }
            const float rs2 = rsqrtf(wave_sum(s2) * (1.f / DM) + EPS);
#pragma unroll
            for (int j = 0; j < 4; ++j) { const int k = 4 * lane + 256 * j;
                const f32x4 gg = *(const GAS f32x4*)(g_pre + k), sh = *(const GAS f32x4*)(md + 3 * DM + k), sc = *(const GAS f32x4*)(md + 4 * DM + k);
                const f32x4 hh = xv[r][j] * rs2 * gg * (sc + 1.f) + sh;
                u32x2 o; o.x = pk2(hh.x, hh.y); o.y = pk2(hh.z, hh.w); *(GAS u32x2*)(H2 + (size_t)m * DM + k) = o; } }
    }
}
__device__ __forceinline__ void p11_rows(const GAS float* __restrict__ g_post, GAS float* __restrict__ out, const GAS float* __restrict__ mod, const GAS bf16_t* __restrict__ Fb, int gw, int NGW, int lane) {
    for (int m0 = 2 * gw; m0 < MLAT; m0 += 2 * NGW) {
        const GAS float* md = mod + (m0 >> 13) * NMOD;
        f32x4 y[2][4], xv[2][4]; float ss[2];
#pragma unroll
        for (int r = 0; r < 2; ++r) { ss[r] = 0.f;
#pragma unroll
            for (int j = 0; j < 4; ++j) { const u32x2 w = *(const GAS u32x2*)(Fb + (size_t)(m0 + r) * DM + 4 * lane + 256 * j); xv[r][j] = *(const GAS f32x4*)(out + (size_t)(m0 + r) * DM + 4 * lane + 256 * j);
                y[r][j] = (f32x4){bflo(w.x), bfhi(w.x), bflo(w.y), bfhi(w.y)}; ss[r] += y[r][j].x * y[r][j].x + y[r][j].y * y[r][j].y + y[r][j].z * y[r][j].z + y[r][j].w * y[r][j].w; } }
#pragma unroll
        for (int r = 0; r < 2; ++r) { const float rs = rsqrtf(wave_sum(ss[r]) * (1.f / DM) + EPS);
#pragma unroll
            for (int j = 0; j < 4; ++j) { const int k = 4 * lane + 256 * j;
                const f32x4 gg = *(const GAS f32x4*)(g_post + k), gt = *(const GAS f32x4*)(md + 5 * DM + k);
                *(GAS f32x4*)(out + (size_t)(m0 + r) * DM + k) = xv[r][j] + gt * (y[r][j] * rs * gg); } }
    }
}
__device__ __forceinline__ void convgate_phase(const GAS float* __restrict__ cw, const GAS float* __restrict__ cb, const GAS bf16_t* __restrict__ UP, GAS bf16_t* __restrict__ G, int half, int gtid, int NT) {
    constexpr int JG = DFF / 8, RG = 32, NTASK = (MLAT / 2 / RG) * JG;
    for (int task = gtid; task < NTASK; task += NT) {
        const int jg = task % JG, rg = task / JG, j0 = jg * 8, r0 = rg * RG, m0 = half * (MLAT / 2) + r0;
        float wu[3][8], wg[3][8], bu[8], bg[8];
#pragma unroll
        for (int k = 0; k < 3; ++k)
#pragma unroll
            for (int i = 0; i < 8; ++i) { wu[k][i] = cw[k * 2 * DFF + j0 + i]; wg[k][i] = cw[k * 2 * DFF + DFF + j0 + i]; }
#pragma unroll
        for (int i = 0; i < 8; ++i) { bu[i] = cb[j0 + i]; bg[i] = cb[DFF + j0 + i]; }
        const GAS bf16_t* up = UP + (size_t)r0 * (2 * DFF) + j0;
        u32x4 pu = {0u, 0u, 0u, 0u}, pg = {0u, 0u, 0u, 0u}, cu, cg_, nu, ng;
        if ((m0 & 8191) != 0) { pu = *(const GAS u32x4*)(up - 2 * DFF); pg = *(const GAS u32x4*)(up - 2 * DFF + DFF); }
        cu = *(const GAS u32x4*)(up); cg_ = *(const GAS u32x4*)(up + DFF);
#pragma unroll 8
        for (int r = 0; r < RG; ++r) {
            const bool nv = (r + 1 < RG) || (((m0 + RG) & 8191) != 0);
            if (nv) { nu = *(const GAS u32x4*)(up + (size_t)(r + 1) * (2 * DFF)); ng = *(const GAS u32x4*)(up + (size_t)(r + 1) * (2 * DFF) + DFF); } else { nu = (u32x4){0u, 0u, 0u, 0u}; ng = nu; }
            float o[8];
#pragma unroll
            for (int i = 0; i < 8; ++i) { const int w_ = i >> 1;
                const float p_u = (i & 1) ? bfhi(pu[w_]) : bflo(pu[w_]), c_u = (i & 1) ? bfhi(cu[w_]) : bflo(cu[w_]), n_u = (i & 1) ? bfhi(nu[w_]) : bflo(nu[w_]);
                const float p_g = (i & 1) ? bfhi(pg[w_]) : bflo(pg[w_]), c_g = (i & 1) ? bfhi(cg_[w_]) : bflo(cg_[w_]), n_g = (i & 1) ? bfhi(ng[w_]) : bflo(ng[w_]);
                const float uv = bu[i] + wu[0][i] * p_u + wu[1][i] * c_u + wu[2][i] * n_u, gv = bg[i] + wg[0][i] * p_g + wg[1][i] * c_g + wg[2][i] * n_g;
                o[i] = gv * __builtin_amdgcn_rcpf(1.f + __builtin_amdgcn_exp2f(-1.4426950408889634f * gv)) * uv; }
            u32x4 w; w.x = pk2(o[0], o[1]); w.y = pk2(o[2], o[3]); w.z = pk2(o[4], o[5]); w.w = pk2(o[6], o[7]);
            *(GAS u32x4*)(G + (size_t)(r0 + r) * DFF + j0) = w;
            pu = cu; pg = cg_; cu = nu; cg_ = ng;
        }
    }
}
constexpr int NPH = 17;
__global__ void __launch_bounds__(512, 2) fwd_kernel(Args a) {
    extern __shared__ __attribute__((aligned(16))) unsigned char lds_raw[];
    LAS unsigned char* lds = (LAS unsigned char*)lds_raw;
    const int lo = a.ph_lo, hi_ = a.ph_hi;
    {
        volatile LAS unsigned* st0 = (volatile LAS unsigned*)(lds + LDS_MISC);
        if (threadIdx.x < 2) st0[threadIdx.x] = 0u;
        __syncthreads();
        (void)xcd_barrier_post((unsigned*)(a.ws + WS_BAR), st0);
    }
#if MK_COOP
    cg::grid_group grid = cg::this_grid();
#endif
    typedef pg8::EpiBf16<0> EpiB;
    constexpr int MH = MLAT / 2;
#ifndef REPMASK
#define REPMASK 0
#endif
    bool repeated = false;
#pragma unroll 1
    for (int ph = lo; ph < hi_; ++ph) {
        int tid = threadIdx.x; asm volatile("" : "+v"(tid));
        int G = gridDim.x, bx = blockIdx.x; asm volatile("" : "+s"(G), "+s"(bx));
        const int lane = tid & 63, wave = __builtin_amdgcn_readfirstlane(tid >> 6);
        const int vcu = (G % 8 == 0) ? (bx % 8) * (G / 8) + bx / 8 : bx;
        const int gw = vcu * 8 + wave, NGW = G * 8, gtid = bx * 512 + tid, NTH = G * 512;
        unsigned char* ws_ = a.ws; asm volatile("" : "+s"(ws_)); GAS unsigned char* ws = (GAS unsigned char*)ws_;
        GAS float* mod = (GAS float*)(ws + WS_MOD); GAS float* ssq = (GAS float*)(ws + WS_SSQ); GAS float* sskv = (GAS float*)(ws + WS_SSKV);
        GAS bf16_t* Win = (GAS bf16_t*)(ws + WS_WIN); GAS bf16_t* Wq = (GAS bf16_t*)(ws + WS_WQ); GAS bf16_t* Wkv = (GAS bf16_t*)(ws + WS_WKV); GAS bf16_t* Wg = (GAS bf16_t*)(ws + WS_WG);
        GAS bf16_t* Wout = (GAS bf16_t*)(ws + WS_WOUT); GAS bf16_t* Wup = (GAS bf16_t*)(ws + WS_WUP); GAS bf16_t* Wdn = (GAS bf16_t*)(ws + WS_WDN);
        GAS f32x2* AGG = (GAS f32x2*)(ws + WS_AGG); GAS float* RT = (GAS float*)(ws + WS_ROPE);
        GAS bf16_t* H = (GAS bf16_t*)(ws + WS_R1); GAS bf16_t* KVR = H; GAS bf16_t* H2 = H; GAS bf16_t* QR = (GAS bf16_t*)(ws + WS_Q);
        GAS bf16_t* P = (GAS bf16_t*)(ws + WS_R2); GAS bf16_t* Y = P; GAS bf16_t* Fb = P;
        GAS unsigned* LU = (GAS unsigned*)(ws + WS_LU); GAS bf16_t* Kb = (GAS bf16_t*)(ws + WS_K); GAS bf16_t* Vb = (GAS bf16_t*)(ws + WS_V); GAS bf16_t* A2 = (GAS bf16_t*)(ws + WS_A2);
        GAS bf16_t* UP = (GAS bf16_t*)(ws + WS_UP); GAS bf16_t* Gb = (GAS bf16_t*)(ws + WS_G);
        float* outp_ = a.out; asm volatile("" : "+s"(outp_)); GAS float* outp = (GAS float*)outp_;
        pg8::Gemm g{nullptr, nullptr, 0, 0, 0, 0, 0}; GAS bf16_t* O = nullptr; int ldc = 0;
        switch (ph) {
            case 2:  g = pg8::Gemm{(const bf16_t*)(H), (const bf16_t*)(Win), MALL, PW, DM, DM, DM}; O = P; ldc = PW; break;
            case 4:  g = pg8::Gemm{(const bf16_t*)(P + 1024), (const bf16_t*)(Wq), MLAT, 768, 256, PW, 256}; O = QR; ldc = 768; break;
            case 5:  g = pg8::Gemm{(const bf16_t*)(P + 1280), (const bf16_t*)(Wkv), MALL, 1024, 256, PW, 256}; O = KVR; ldc = 1024; break;
            case 8:  g = pg8::Gemm{(const bf16_t*)(A2), (const bf16_t*)(Wout), MLAT, DM, DM, DM, DM}; O = Y; ldc = DM; break;
            case 10: g = pg8::Gemm{(const bf16_t*)(H2), (const bf16_t*)(Wup), MH, 2 * DFF, DM, DM, DM}; O = UP; ldc = 2 * DFF; break;
            case 13: g = pg8::Gemm{(const bf16_t*)(H2 + (size_t)MH * DM), (const bf16_t*)(Wup), MH, 2 * DFF, DM, DM, DM}; O = UP; ldc = 2 * DFF; break;
            case 12: g = pg8::Gemm{(const bf16_t*)(Gb), (const bf16_t*)(Wdn), MH, DM, DFF, DFF, DFF}; O = Fb; ldc = DM; break;
            case 15: g = pg8::Gemm{(const bf16_t*)(Gb), (const bf16_t*)(Wdn), MH, DM, DFF, DFF, DFF}; O = Fb + (size_t)MH * DM; ldc = DM; break;
            default: break;
        }
        if (g.A != nullptr) {
            pg8::StaticOrder S; S.init(g.M, g.N, G, bx); EpiB E{(bf16_t*)O, ldc, nullptr, 0, 0, 1.f};
            pg8::gemm_phase<EpiB, pg8::StaticOrder, true, true>(lds, g, S, E, tid);
        }
#ifndef NGM
#define NGM 0x1ffff
#endif
#define NG(k) ((NGM >> (k)) & 1)
        else if (NG(0) && ph == 0) {
            prep_mat<0>(argp(10), nullptr, Win, 1536, 1024, gtid, NTH); prep_mat<1>(argp(18), argp(19), Wq, 768, 256, gtid, NTH); prep_mat<2>(argp(20), argp(21), Wkv, 1024, 256, gtid, NTH);
            prep_mat<3>(argp(13), argp(15), Wg, 2048, 64, gtid, NTH); prep_mat<4>(argp(22), nullptr, Wout, 1024, 1024, gtid, NTH); prep_mat<5>(argp(23), nullptr, Wup, 5632, 1024, gtid, NTH);
            prep_mat<6>(argp(26), nullptr, Wdn, 1024, 2816, gtid, NTH);
            if (gtid < 1024) { const int pos = gtid >> 3, j = gtid & 7; const float invf[8] = {1.f, 0.31622776601683794f, 0.1f, 0.031622776601683794f, 0.01f, 0.0031622776601683794f, 0.001f, 0.00031622776601683794f};
                const float ang = (float)pos * invf[j]; RT[2 * gtid] = cosf(ang); RT[2 * gtid + 1] = sinf(ang); }
            mod_phase(argp(1), argp(3), argp(4), argp(5), mod, (LAS float*)(lds + wave * 4096), gw, NGW, lane);
        } else if (NG(1) && ph == 1) {
            p1_rows(argp(0), argp(2), argp(6), mod, H, gw, NGW, lane);
        } else if (NG(3) && ph == 3) {
            gates_phase(argp(11), argp(12), argp(14), argp(16), argp(17), lds, P, Wg, LU, AGG, tid, wave, lane);
            ss_phase(P, ssq, sskv, gw, NGW, lane);
        } else if (NG(6) && ph == 6) {
            krope_phase(P, Kb, RT, gtid, NTH); kvpost_phase(KVR, sskv, Kb, Vb, gtid, NTH);
#ifdef REP6
            if (REP6 & 1) { __syncthreads(); scan_agg(LU, AGG, gw, NGW, lane); }
            if (REP6 & 2) { __syncthreads(); krope_phase(P, Kb, RT, gtid, NTH); }
            if (REP6 & 4) { __syncthreads(); }
            if (REP6 & 8) { __syncthreads(); kvpost_phase(KVR, sskv, Kb, Vb, gtid, NTH); }
#endif
        } else if (NG(7) && ph == 7) {
            scan_final(LU, AGG, P, A2, gw, NGW, lane);
#ifdef REP7
            __syncthreads(); scan_final(LU, AGG, P, A2, gw, NGW, lane);
#endif
            const int upb = (NB * 8 * 16 + G - 1) / G, u0 = vcu * upb, u1 = min(NB * 8 * 16, u0 + upb);
            __syncthreads();
            for (int unit = u0; unit < u1; ++unit) { const int bh = unit >> 4, qb = unit & 15; attn_unit(lds, QR, ssq, RT, Kb, Vb, A2, bh >> 3, bh & 7, qb, tid, wave, lane); }
        } else if (NG(9) && ph == 9) {
            p7_rows(argp(0), argp(7), argp(8), outp, mod, Y, H2, gw, NGW, lane);
        } else if (NG(11) && (ph == 11 || ph == 14)) {
            convgate_phase(argp(24), argp(25), UP, Gb, ph == 14 ? 1 : 0, gtid, NTH);
        } else if (NG(16) && ph == 16) {
            p11_rows(argp(9), outp, mod, Fb, gw, NGW, lane);
        }
        __syncthreads();
#if MK_COOP
        if (ph + 1 < hi_ && ph != 3 && ph != 4 && ph != 12) {
            if (ph == 0) grid.sync();
            else { XcdBarrier xb; xb.bar = (unsigned*)(ws_ + WS_BAR); xb.x = xb_xcc_id(); xb.st = (volatile LAS unsigned*)(lds + LDS_MISC); xcd_barrier(xb); }
        }
#endif
        if (REPMASK) { if (((REPMASK >> ph) & 1) && !repeated) { repeated = true; --ph; } else repeated = false; }
    }
}

extern "C" void kernel_launch(void* const* d_in, const int* in_sizes, int n_in, void* d_out, int out_size, void* d_ws, size_t ws_size, hipStream_t stream) {
    static int grid = 0;
    if (grid == 0) {
        if (n_in != 27 || out_size != MLAT * DM || ws_size < WS_END) { fprintf(stderr, "kernel_launch: unexpected shapes (n_in %d, out %d, ws %zu)\n", n_in, out_size, ws_size); grid = -1; return; }
        int dev = 0, cus = 0, per_cu = 0;
        if (hipGetDevice(&dev) != hipSuccess || hipDeviceGetAttribute(&cus, hipDeviceAttributeMultiprocessorCount, dev) != hipSuccess) { grid = -1; return; }
        if (hipFuncSetAttribute((const void*)fwd_kernel, hipFuncAttributeMaxDynamicSharedMemorySize, LDS_BYTES) != hipSuccess) { fprintf(stderr, "kernel_launch: hipFuncSetAttribute failed\n"); grid = -1; return; }
        if (hipOccupancyMaxActiveBlocksPerMultiprocessor(&per_cu, (const void*)fwd_kernel, 512, LDS_BYTES) != hipSuccess || per_cu < 1) { fprintf(stderr, "kernel_launch: occupancy query says %d\n", per_cu); }
        (void)hipGetLastError();
        grid = cus;
    }
    if (grid < 0) return;
    (void)hipMemsetAsync((char*)d_ws + WS_CTL, 0, CTL_BYTES, stream);
    Args a{};
    for (int i = 0; i < 27; ++i) a.in[i] = (const float*)d_in[i];
    a.out = (float*)d_out; a.ws = (unsigned char*)d_ws;
#if MK_COOP
    a.ph_lo = 0; a.ph_hi = NPH;
    void* args[] = {&a};
    hipError_t e = hipLaunchCooperativeKernel((const void*)fwd_kernel, dim3(grid), dim3(512), args, LDS_BYTES, stream);
    if (e != hipSuccess) fprintf(stderr, "kernel_launch: cooperative launch failed: %s (grid %d)\n", hipGetErrorString(e), grid);
#else
    for (int p = 0; p < NPH; ++p) { a.ph_lo = p; a.ph_hi = p + 1; hipLaunchKernelGGL(fwd_kernel, dim3(grid), dim3(512), LDS_BYTES, stream, a); }
#endif
}
```

```cpp
#include <hip/hip_runtime.h>
#include <hip/hip_cooperative_groups.h>
#include <cstdio>
#include <cstdint>
namespace cg = cooperative_groups;
#ifndef MK_COOP
#define MK_COOP 1
#endif
namespace pg8 {
#define PG8_LAS __attribute__((address_space(3)))
typedef unsigned short bf16_t;
typedef short bf16x8 __attribute__((ext_vector_type(8)));
typedef float f32x4 __attribute__((ext_vector_type(4)));
typedef unsigned u32x4 __attribute__((ext_vector_type(4)));
constexpr int BM = 256, BK = 64, HALF = 128, HTB = HALF * BK * 2  , STAGE_BYTES = 8 * HTB, NXCD = 8, WGM = 8;

__host__ __device__ __forceinline__ int lds_byte(int r, int c) { const int st = (r >> 4) * 2 + (c >> 5), rr = r & 15, cc = c & 31, ob = rr * 64 + cc * 2; return st * 1024 + (ob ^ (((ob >> 9) & 1) << 5)); }
__host__ __device__ __forceinline__ void stage_rc(int b, int& R, int& C) { const int st = b / 1024, sb = b % 1024, swz = sb ^ (((sb >> 9) & 1) << 5); R = (st >> 1) * 16 + swz / 64; C = (st & 1) * 32 + (swz % 64) / 2; }
__host__ __device__ __forceinline__ int perm32(int rho) { const int n = rho >> 4, i = rho & 15; return 8 * (i >> 2) + 4 * n + (i & 3); }

struct Unit { int pm, pn; };
struct Gemm { const bf16_t* A; const bf16_t* Bt; int M, N, K, lda, ldb; };

struct StaticOrder {
    int nM, nN, nwg, G, c;
    __host__ __device__ void init(int M, int N, int G_, int c_) { nM = M / BM; nN = N / BM; nwg = nM * nN; G = G_; c = c_; }
    __host__ __device__ bool next(int i, Unit& u) const {
        const long L = (long)i * G + c; if (L >= nwg) return false;
        int wgid = (int)L; { const int q = nwg / NXCD, r = nwg % NXCD, xcd = wgid % NXCD, off = wgid / NXCD; wgid = (xcd < r ? xcd * (q + 1) : r * (q + 1) + (xcd - r) * q) + off; }
        const int nig = WGM * nN, gid = wgid / nig, fm = gid * WGM, gsz = (nM - fm) < WGM ? (nM - fm) : WGM;
        u.pm = fm + ((wgid % nig) % gsz); u.pn = (wgid % nig) / gsz; return true;
    }
    __device__ __forceinline__ void a_ready(const Unit&) const {}
    __device__ __forceinline__ void done(const Unit&) const {}
};

__device__ __forceinline__ unsigned cvt_pk_bf16(float lo, float hi) { unsigned r; asm volatile("v_cvt_pk_bf16_f32 %0, %1, %2" : "=v"(r) : "v"(lo), "v"(hi)); return r; }
typedef float f32x2 __attribute__((ext_vector_type(2)));
__device__ __forceinline__ f32x2 gelu_pk(f32x2 v) {
    const f32x2 av = __builtin_elementwise_abs(v), d = av * 0.2316418882f + 1.0f;
    f32x2 t; t.x = __builtin_amdgcn_rcpf(d.x); t.y = __builtin_amdgcn_rcpf(d.y);
    f32x2 q = t * 0.5307027145f + (-0.7265760135f); q = q * t + 0.7107068705f; q = q * t + (-0.142248368f); q = q * t + 0.127414796f; q = q * t;
    const f32x2 s = (v * v) * (-0.72134752044f);
    f32x2 e; e.x = __builtin_amdgcn_exp2f(s.x); e.y = __builtin_amdgcn_exp2f(s.y);
    const f32x2 m = v * (q * e), r = v - m;
    f32x2 o; o.x = v.x < 0.f ? m.x : r.x; o.y = v.y < 0.f ? m.y : r.y; return o;
}

template <int ACT  > struct EpiBf16 {
    static constexpr bool PERM = true, AFTER_DRAIN = false; static_assert(ACT == 0 || ACT == 1, "EpiBf16: ACT is 0 (none) or 1 (gelu_pk)");
    bf16_t* O; int ldc; const float* bias; int split_cols; size_t split_stride; float scale0;
    __device__ __forceinline__ void operator()(const f32x4 (&acc)[2][2][4][2], const Unit& u, int wr, int wc, int fr, int fq) const {
        const int row0 = u.pm * BM + wr * 64 + fr; int colt = u.pn * BM; bf16_t* base = O;
        float sc = 1.f; if (split_cols) { const int t = colt / split_cols; base += (size_t)t * split_stride; colt -= t * split_cols; if (t == 0) sc = scale0; }
        const int col0 = colt + wc * 32 + 8 * fq, bcol0 = u.pn * BM + wc * 32 + 8 * fq;
        f32x4 bv[2][2];
#pragma unroll
        for (int bj = 0; bj < 2; ++bj)
#pragma unroll
            for (int n = 0; n < 2; ++n) bv[bj][n] = bias ? *(const f32x4*)(bias + bcol0 + bj * HALF + 4 * n) : (f32x4){0.f, 0.f, 0.f, 0.f};
#pragma unroll
        for (int ai = 0; ai < 2; ++ai)
#pragma unroll
            for (int m = 0; m < 4; ++m) { bf16_t* rowp = base + (size_t)(row0 + ai * HALF + m * 16) * ldc + col0;
#pragma unroll
                for (int bj = 0; bj < 2; ++bj) { f32x4 v0 = acc[ai][bj][m][0] + bv[bj][0], v1 = acc[ai][bj][m][1] + bv[bj][1];
                    if (ACT == 1) { f32x2 a = gelu_pk((f32x2){v0[0], v0[1]}), b = gelu_pk((f32x2){v0[2], v0[3]}), c = gelu_pk((f32x2){v1[0], v1[1]}), d = gelu_pk((f32x2){v1[2], v1[3]});
                        v0 = (f32x4){a.x, a.y, b.x, b.y}; v1 = (f32x4){c.x, c.y, d.x, d.y}; }
                    v0 = v0 * sc; v1 = v1 * sc; u32x4 w; w.x = cvt_pk_bf16(v0[0], v0[1]); w.y = cvt_pk_bf16(v0[2], v0[3]); w.z = cvt_pk_bf16(v1[0], v1[1]); w.w = cvt_pk_bf16(v1[2], v1[3]);
                    *(__attribute__((address_space(1))) u32x4*)(rowp + bj * HALF) = w; } }
    }
};
template <class Epi, class Sched, bool ALIGN_EPI = false, bool SP2 = false>
__device__ __forceinline__ void gemm_phase(PG8_LAS unsigned char* lds, const Gemm g, const Sched& S, const Epi& E, const int tid) {
    const int wid = __builtin_amdgcn_readfirstlane(tid >> 6), lane = tid & 63, wr = wid >> 2, wc = wid & 3, fr = lane & 15, fq = lane >> 4;
    const int K = g.K, nt = K / BK;
    unsigned voffA[2], voffB[2];
#pragma unroll
    for (int i = 0; i < 2; ++i) { int R, C; stage_rc(tid * 16 + i * 8192, R, C); const int Rb = Epi::PERM ? ((R & ~31) + perm32(R & 31)) : R;
        voffA[i] = (unsigned)(R * g.lda + C) * 2u; voffB[i] = (unsigned)(Rb * g.ldb + C) * 2u; }
    const size_t kstep = (size_t)(BK * 2);
    const size_t hstepA = (size_t)HALF * g.lda * 2, hstepB = (size_t)HALF * g.ldb * 2;
    const size_t tstepA = 2 * hstepA, tstepB = 2 * hstepB;
    const unsigned ldsw = (unsigned)wid * 1024u;
    const int aoff = lds_byte(wr * 64 + fr, fq * 8), boff = lds_byte(wc * 32 + fr, fq * 8);
#define PG8_SA(b, h) (((b) * 2 + (h)) * HTB)
#define PG8_SB(b, h) ((4 + (b) * 2 + (h)) * HTB)
#define PG8_STAGE(bufoff, gbase, voff) do { _Pragma("unroll") for (int _i = 0; _i < 2; ++_i) \
        __builtin_amdgcn_global_load_lds((const unsigned*)((const char*)(gbase) + (voff)[_i]), (PG8_LAS unsigned*)(lds + (bufoff) + ldsw + _i * 8192), 16, 0, 0); } while (0)
#define PG8_LDA(dst, b, h) do { _Pragma("unroll") for (int m = 0; m < 4; ++m) _Pragma("unroll") for (int k = 0; k < 2; ++k) dst[m][k] = *(const PG8_LAS bf16x8*)(lds + PG8_SA(b, h) + aoff + m * 2048 + k * 1024); } while (0)
#define PG8_LDB(dst, b, h) do { _Pragma("unroll") for (int n = 0; n < 2; ++n) _Pragma("unroll") for (int k = 0; k < 2; ++k) dst[n][k] = *(const PG8_LAS bf16x8*)(lds + PG8_SB(b, h) + boff + n * 2048 + k * 1024); } while (0)
#define PG8_MMA(ai, bj, At, Bt) do { __builtin_amdgcn_s_setprio(1); _Pragma("unroll") for (int m = 0; m < 4; ++m) _Pragma("unroll") for (int n = 0; n < 2; ++n) _Pragma("unroll") for (int k = 0; k < 2; ++k) \
        acc[ai][bj][m][n] = __builtin_amdgcn_mfma_f32_16x16x32_bf16(Bt[n][k], At[m][k], acc[ai][bj][m][n], 0, 0, 0); __builtin_amdgcn_s_setprio(0); } while (0)
#define PG8_WAIT_V(n) asm volatile("s_waitcnt vmcnt(" #n ")" ::: "memory")
#define PG8_WAIT_L(n) asm volatile("s_waitcnt lgkmcnt(" #n ")" ::: "memory")
#define PG8_BAR __builtin_amdgcn_s_barrier()
#define PG8_SCHED __builtin_amdgcn_sched_barrier(0)
    Unit cur, nxt; int ui = 0;
    if (!S.next(0, cur)) return;
    f32x4 acc[2][2][4][2];
#pragma unroll
    for (int a = 0; a < 2; ++a)
#pragma unroll
        for (int b = 0; b < 2; ++b)
#pragma unroll
            for (int m = 0; m < 4; ++m)
#pragma unroll
                for (int n = 0; n < 2; ++n) acc[a][b][m][n] = (f32x4){0.f, 0.f, 0.f, 0.f};
    bf16x8 At[4][2], B0[2][2], B1[2][2];
    const char* cA = (const char*)g.A + (size_t)cur.pm * tstepA; const char* cB = (const char*)g.Bt + (size_t)cur.pn * tstepB;
    S.a_ready(cur);
    if constexpr (SP2) {
        PG8_STAGE(PG8_SB(0, 0), cB, voffB); PG8_STAGE(PG8_SB(0, 1), cB + hstepB, voffB); PG8_STAGE(PG8_SA(0, 0), cA, voffA); PG8_STAGE(PG8_SA(0, 1), cA + hstepA, voffA);
        if (wr == 1) PG8_BAR;
        PG8_WAIT_V(2); PG8_BAR;
        PG8_STAGE(PG8_SB(1, 0), cB + kstep, voffB); PG8_STAGE(PG8_SA(1, 0), cA + kstep, voffA); PG8_STAGE(PG8_SB(1, 1), cB + hstepB + kstep, voffB);
        PG8_WAIT_V(6); PG8_BAR;
    } else {
        PG8_STAGE(PG8_SB(0, 0), cB, voffB); PG8_STAGE(PG8_SA(0, 0), cA, voffA); PG8_STAGE(PG8_SB(0, 1), cB + hstepB, voffB); PG8_STAGE(PG8_SA(0, 1), cA + hstepA, voffA);
        if (wr == 1) PG8_BAR;
        PG8_WAIT_V(4); PG8_BAR;
        PG8_STAGE(PG8_SB(1, 0), cB + kstep, voffB); PG8_STAGE(PG8_SA(1, 0), cA + kstep, voffA); PG8_STAGE(PG8_SB(1, 1), cB + hstepB + kstep, voffB);
        PG8_WAIT_V(6); PG8_BAR;
    }
    for (;;) {
        const bool has_next = S.next(ui + 1, nxt);
        const char* nA = has_next ? (const char*)g.A + (size_t)nxt.pm * tstepA : cA; const char* nB = has_next ? (const char*)g.Bt + (size_t)nxt.pn * tstepB : cB;
        for (int t = 0; t < nt; t += 2) {
            const bool last = (t == nt - 2);
            const char* a1 = cA + (size_t)(t + 1) * kstep;
            const char* a2 = last ? nA : cA + (size_t)(t + 2) * kstep; const char* b2 = last ? nB : cB + (size_t)(t + 2) * kstep;
            const char* a3 = a2 + kstep; const char* b3 = b2 + kstep;
            if (last && has_next) S.a_ready(nxt);
            if constexpr (SP2) {
            PG8_LDB(B0, 0, 0); PG8_LDB(B1, 0, 1); PG8_SCHED; PG8_LDA(At, 0, 0); PG8_STAGE(PG8_SA(1, 1), a1 + hstepA, voffA);
            PG8_WAIT_V(8); PG8_WAIT_L(0); PG8_BAR; PG8_MMA(0, 0, At, B0); PG8_MMA(0, 1, At, B1); PG8_BAR; PG8_SCHED;
            PG8_LDA(At, 0, 1); PG8_STAGE(PG8_SB(0, 0), b2, voffB); PG8_STAGE(PG8_SB(0, 1), b2 + hstepB, voffB); PG8_STAGE(PG8_SA(0, 0), a2, voffA);
            PG8_WAIT_V(8); PG8_WAIT_L(0); PG8_BAR; PG8_MMA(1, 0, At, B0); PG8_MMA(1, 1, At, B1); PG8_BAR; PG8_SCHED;
            PG8_LDB(B0, 1, 0); PG8_LDB(B1, 1, 1); PG8_SCHED; PG8_LDA(At, 1, 0); PG8_STAGE(PG8_SA(0, 1), a2 + hstepA, voffA);
            PG8_WAIT_V(8); PG8_WAIT_L(0); PG8_BAR; PG8_MMA(0, 0, At, B0); PG8_MMA(0, 1, At, B1); PG8_BAR; PG8_SCHED;
            PG8_LDA(At, 1, 1); PG8_STAGE(PG8_SB(1, 0), b3, voffB); PG8_STAGE(PG8_SB(1, 1), b3 + hstepB, voffB); PG8_STAGE(PG8_SA(1, 0), a3, voffA);
            PG8_WAIT_V(8); PG8_WAIT_L(0); PG8_BAR; PG8_MMA(1, 0, At, B0); PG8_MMA(1, 1, At, B1); PG8_BAR; PG8_SCHED;
            } else {
            PG8_LDB(B0, 0, 0); PG8_SCHED; PG8_LDA(At, 0, 0); PG8_STAGE(PG8_SA(1, 1), a1 + hstepA, voffA);
            PG8_WAIT_L(8); PG8_BAR; PG8_WAIT_L(0); PG8_MMA(0, 0, At, B0); PG8_BAR; PG8_SCHED;
            PG8_LDB(B1, 0, 1); PG8_STAGE(PG8_SB(0, 0), b2, voffB);
            PG8_BAR; PG8_WAIT_L(0); PG8_MMA(0, 1, At, B1); PG8_BAR;
            PG8_LDA(At, 0, 1); PG8_STAGE(PG8_SA(0, 0), a2, voffA);
            PG8_BAR; PG8_WAIT_L(0); PG8_MMA(1, 0, At, B0); PG8_BAR; PG8_SCHED;
            PG8_STAGE(PG8_SB(0, 1), b2 + hstepB, voffB);
            PG8_WAIT_V(6); PG8_BAR; PG8_MMA(1, 1, At, B1); PG8_BAR;
            PG8_LDB(B0, 1, 0); PG8_SCHED; PG8_LDA(At, 1, 0); PG8_STAGE(PG8_SA(0, 1), a2 + hstepA, voffA);
            PG8_WAIT_L(8); PG8_BAR; PG8_WAIT_L(0); PG8_MMA(0, 0, At, B0); PG8_BAR; PG8_SCHED;
            PG8_LDB(B1, 1, 1); PG8_STAGE(PG8_SB(1, 0), b3, voffB);
            PG8_BAR; PG8_WAIT_L(0); PG8_MMA(0, 1, At, B1); PG8_BAR;
            PG8_LDA(At, 1, 1); PG8_STAGE(PG8_SA(1, 0), a3, voffA);
            PG8_BAR; PG8_WAIT_L(0); PG8_MMA(1, 0, At, B0); PG8_BAR; PG8_SCHED;
            PG8_STAGE(PG8_SB(1, 1), b3 + hstepB, voffB);
            PG8_WAIT_V(6); PG8_BAR; PG8_MMA(1, 1, At, B1); PG8_BAR;
            }
        }
        if constexpr (ALIGN_EPI) { if (wr == 0) PG8_BAR; }
        if constexpr (!Epi::AFTER_DRAIN) { E(acc, cur, wr, wc, fr, fq); S.done(cur); }
        if (!has_next) break;
#pragma unroll
        for (int a = 0; a < 2; ++a)
#pragma unroll
            for (int b = 0; b < 2; ++b)
#pragma unroll
                for (int m = 0; m < 4; ++m)
#pragma unroll
                    for (int n = 0; n < 2; ++n) acc[a][b][m][n] = (f32x4){0.f, 0.f, 0.f, 0.f};
        cur = nxt; cA = nA; cB = nB; ++ui;
        if constexpr (ALIGN_EPI) { if (wr == 1) PG8_BAR; }
    }
    PG8_WAIT_V(0);
    if constexpr (!ALIGN_EPI) { if (wr == 0) PG8_BAR; }
    PG8_BAR;
    if constexpr (Epi::AFTER_DRAIN) { E.fused(acc, cur, wr, wc, fr, fq, lds, wid, lane); S.done(cur); }
#undef PG8_SA
#undef PG8_SB
#undef PG8_STAGE
#undef PG8_LDA
#undef PG8_LDB
#undef PG8_MMA
#undef PG8_WAIT_V
#undef PG8_WAIT_L
#undef PG8_BAR
#undef PG8_SCHED
}
}
#define LAS __attribute__((address_space(3)))
#define GAS __attribute__((address_space(1)))
typedef unsigned short bf16_t;
typedef short bf16x8 __attribute__((ext_vector_type(8)));
typedef short s16x4 __attribute__((ext_vector_type(4)));
typedef float f32x4 __attribute__((ext_vector_type(4)));
typedef float f32x16 __attribute__((ext_vector_type(16)));
typedef unsigned u32x4 __attribute__((ext_vector_type(4)));
typedef unsigned u32x2 __attribute__((ext_vector_type(2)));
typedef float f32x2 __attribute__((ext_vector_type(2)));

constexpr int NB = 8, SEQ = 8192, DM = 1024, CTX = 256, MLAT = NB * SEQ, MCTX = NB * CTX, MALL = MLAT + MCTX;
constexpr int PW = 1536, KVLEN = CTX + SEQ, DFF = 2816, NMOD = 6 * DM;
constexpr int NCH = 32, CHL = 256;
constexpr float EPS = 1e-6f;
constexpr float QSCALE = 0.10206207261596575f * 1.4426950408889634f;
constexpr size_t MiB = 1u << 20;
constexpr size_t WS_CTL = 0, CTL_BYTES = 2 * MiB;
constexpr size_t WS_MOD = 64 * 1024, WS_SSQ = 512 * 1024, WS_SSKV = 1024 * 1024, WS_BAR = 1600 * 1024;
constexpr size_t WS_WIN = 2 * MiB, WS_WQ = 5 * MiB, WS_WKV = 6 * MiB, WS_WG = 7 * MiB, WS_WOUT = 8 * MiB, WS_WUP = 10 * MiB, WS_WDN = 21 * MiB;
constexpr size_t WS_AGG = 27 * MiB, WS_ROPE = 29 * MiB + 512 * 1024;
constexpr size_t WS_R1 = 30 * MiB;
constexpr size_t WS_R2 = 162 * MiB;
constexpr size_t WS_LU = 360 * MiB, WS_K = 624 * MiB, WS_V = 723 * MiB, WS_A2 = 789 * MiB;
constexpr size_t WS_UP = 360 * MiB, WS_G = 712 * MiB, WS_Q = 920 * MiB, WS_END = 1016 * MiB;
constexpr int LDS_BYTES = 139264;
constexpr int LDS_MISC = 131072 + 64;

__device__ __forceinline__ unsigned f2bf(float f) { unsigned u = __builtin_bit_cast(unsigned, f); return (u + 0x7fffu + ((u >> 16) & 1u)) >> 16; }
__device__ __forceinline__ unsigned cvtpk(float lo, float hi) { typedef float f2 __attribute__((ext_vector_type(2))); typedef __bf16 b2 __attribute__((ext_vector_type(2))); f2 v = {lo, hi}; b2 r = __builtin_convertvector(v, b2); return __builtin_bit_cast(unsigned, r); }
__device__ __forceinline__ unsigned pk2(float lo, float hi) { return cvtpk(lo, hi); }
__device__ __forceinline__ float bflo(unsigned w) { return __uint_as_float(w << 16); }
__device__ __forceinline__ float bfhi(unsigned w) { return __uint_as_float(w & 0xffff0000u); }
__device__ __forceinline__ float bf2f(bf16_t v) { return __uint_as_float((unsigned)v << 16); }
__device__ __forceinline__ int crow(int r, int hi) { return (r & 3) + 8 * (r >> 2) + 4 * hi; }
__device__ __forceinline__ float wave_sum(float v) {
#pragma unroll
    for (int o = 1; o < 64; o <<= 1) v += __shfl_xor(v, o);
    return v;
}
__device__ __forceinline__ float sigmoidf_(float x) { return __builtin_amdgcn_rcpf(1.f + __builtin_amdgcn_exp2f(-1.4426950408889634f * x)); }
#define LDS_WAIT() asm volatile("s_waitcnt lgkmcnt(0)" ::: "memory")
#define XB_TMO      128
#define XB_XCNT(j)  (256  + 64 * (j))
#define XB_XSUB(j)  (1280 + 64 * (j))
#define XB_XGEN(j)  (2304 + 64 * (j))
#define XB_TOP      3328
#define XB_TOPGEN   3392
#define XCD_BAR_WORDS 3456
#define XB_SPIN_CAP (1u << 18)

__device__ __forceinline__ unsigned xb_ld(unsigned* p)              { return __hip_atomic_load(p, __ATOMIC_RELAXED, __HIP_MEMORY_SCOPE_AGENT); }
__device__ __forceinline__ unsigned xb_add(unsigned* p, unsigned v) { return __hip_atomic_fetch_add(p, v, __ATOMIC_RELAXED, __HIP_MEMORY_SCOPE_AGENT); }
__device__ __forceinline__ unsigned xb_xcc_id() { return (unsigned)__builtin_amdgcn_s_getreg((3 << 11) | 20) & 0xFu; }
#define XB_SPIN(cond, bar) do { unsigned _sp = 0; while (cond) { __builtin_amdgcn_s_sleep(1); \
    if ((++_sp & 255u) == 0u) { if (xb_ld(&(bar)[XB_TMO])) break; if (_sp > XB_SPIN_CAP) { atomicAdd(&(bar)[XB_TMO], 1u); break; } } } } while (0)

struct XcdBarrier {
    unsigned* bar; unsigned x;
    volatile LAS unsigned* st;
};

__device__ __forceinline__ XcdBarrier xcd_barrier_post(unsigned* bar, volatile LAS unsigned* st) {
    XcdBarrier b; b.bar = bar; b.x = xb_xcc_id(); b.st = st;
    if (threadIdx.x == 0) (void)xb_add(&bar[XB_XCNT(b.x)], 1u);
    return b;
}
__device__ __forceinline__ void xcd_barrier_complete(unsigned* bar, unsigned x, unsigned& nloc, unsigned& nx) {
    const unsigned G = gridDim.x * gridDim.y * gridDim.z;
    unsigned sum, cnt, mine, sp = 0u;
    for (;;) {
        sum = 0u; cnt = 0u; mine = 0u;
#pragma unroll
        for (unsigned j = 0; j < 16; ++j) { const unsigned c = xb_ld(&bar[XB_XCNT(j)]); sum += c; cnt += (c > 0u) ? 1u : 0u; mine = (j == x) ? c : mine; }
        if (sum == G) break;
        __builtin_amdgcn_s_sleep(1);
        if ((++sp & 255u) == 0u) { if (xb_ld(&bar[XB_TMO])) break; if (sp > XB_SPIN_CAP) { atomicAdd(&bar[XB_TMO], 1u); break; } }
    }
    nloc = mine > 0u ? mine : 1u; nx = cnt > 0u ? cnt : 1u;
}

__device__ __forceinline__ void xcd_barrier(const XcdBarrier& b) {
    asm volatile("s_waitcnt vmcnt(0)" ::: "memory");
    __syncthreads();
    if (threadIdx.x == 0) {
        unsigned* bar = b.bar;
        __builtin_amdgcn_s_waitcnt(0);
        unsigned nloc = b.st[0], nx = b.st[1];
        if (nloc == 0u) { xcd_barrier_complete(bar, b.x, nloc, nx); b.st[0] = nloc; b.st[1] = nx; }
        const unsigned old = xb_add(&bar[XB_XSUB(b.x)], 1u);
        const unsigned gen = old / nloc;
        if (old + 1u == (gen + 1u) * nloc) {
            __builtin_amdgcn_fence(__ATOMIC_RELEASE, "agent");
            asm volatile("s_waitcnt vmcnt(0)" ::: "memory");
            const unsigned og = xb_add(&bar[XB_TOP], 1u);
            const unsigned tg = og / nx;
            if (og + 1u == (tg + 1u) * nx) xb_add(&bar[XB_TOPGEN], 1u);
            else XB_SPIN(xb_ld(&bar[XB_TOPGEN]) == tg, bar);
            __builtin_amdgcn_fence(__ATOMIC_ACQUIRE, "agent");
            xb_add(&bar[XB_XGEN(b.x)], 1u);
            asm volatile("s_waitcnt vmcnt(0)" ::: "memory");
        } else {
            XB_SPIN(xb_ld(&bar[XB_XGEN(b.x)]) == gen, bar);
            __builtin_amdgcn_fence(__ATOMIC_ACQUIRE, "agent");
            asm volatile("s_waitcnt vmcnt(0)" ::: "memory");
        }
    }
    __syncthreads();
}


struct Args { const float* in[27]; float* out; unsigned char* ws; int ph_lo, ph_hi; };
__device__ __forceinline__ const GAS float* argp(int i) {
    const __attribute__((address_space(4))) char* kp = (const __attribute__((address_space(4))) char*)__builtin_amdgcn_kernarg_segment_ptr();
    asm volatile("" : "+s"(kp));
    const float* p = *(const float* const __attribute__((address_space(4)))*)(kp + 8 * i);
    return (const GAS float*)p;
}

template <int ID> __device__ __forceinline__ float wsrc(const GAS float* __restrict__ p0, const GAS float* __restrict__ p1, int n, int k) {
    if (ID == 0) return n < 1440 ? p0[(size_t)k * 1440 + n] : 0.f;
    if (ID == 1) return p0[k] * p1[(size_t)k * 768 + n];
    if (ID == 2) return k < 128 ? p0[k] * p1[(size_t)k * 1024 + n] : 0.f;
    if (ID == 3) { const int h = n >> 8, np = n & 255, mat = np >> 6, j = np & 63, dir = mat >> 1; const GAS float* w = (mat & 1) ? p1 : p0; return w[(size_t)((dir * 8 + h) * 64 + k) * 64 + j]; }
    if (ID == 4) return p0[(size_t)k * 1024 + n];
    if (ID == 5) return p0[(size_t)k * 5632 + n];
    return p0[(size_t)k * 1024 + n];
}
template <int ID> __device__ __forceinline__ void prep_mat(const GAS float* __restrict__ p0, const GAS float* __restrict__ p1, GAS bf16_t* __restrict__ dst, int N, int K, int gtid, int NT) {
    const int items = N * (K / 8);
    for (int it = gtid; it < items; it += NT) {
        const int n = it % N, k8 = it / N;
        u32x4 o;
        o.x = pk2(wsrc<ID>(p0, p1, n, 8 * k8 + 0), wsrc<ID>(p0, p1, n, 8 * k8 + 1)); o.y = pk2(wsrc<ID>(p0, p1, n, 8 * k8 + 2), wsrc<ID>(p0, p1, n, 8 * k8 + 3));
        o.z = pk2(wsrc<ID>(p0, p1, n, 8 * k8 + 4), wsrc<ID>(p0, p1, n, 8 * k8 + 5)); o.w = pk2(wsrc<ID>(p0, p1, n, 8 * k8 + 6), wsrc<ID>(p0, p1, n, 8 * k8 + 7));
        *(GAS u32x4*)(dst + (size_t)n * K + 8 * k8) = o;
    }
}
__device__ __forceinline__ void mod_phase(const GAS float* __restrict__ cvec, const GAS float* __restrict__ cctx, const GAS float* __restrict__ wmod, const GAS float* __restrict__ bmod, GAS float* __restrict__ mod, LAS float* scr, int gw, int NGW, int lane) {
    for (int task = gw; task < 96 * 16; task += NGW) {
        const int cgp = task % 96, kc = task / 96, n = cgp * 64 + lane, k0 = kc * 64;
#pragma unroll
        for (int r = 0; r < 9; ++r) { const float cv = r < 8 ? cvec[r * 1024 + k0 + lane] : cctx[k0 + lane]; scr[r * 64 + lane] = cv / (1.f + __expf(-cv)); }
        LDS_WAIT();
        float acc[9];
#pragma unroll
        for (int r = 0; r < 9; ++r) acc[r] = 0.f;
#pragma unroll 8
        for (int kk = 0; kk < 64; ++kk) { const float w = wmod[(size_t)(k0 + kk) * NMOD + n];
#pragma unroll
            for (int r = 0; r < 9; ++r) acc[r] += scr[r * 64 + kk] * w; }
        const float bias = kc == 0 ? bmod[n] : 0.f;
#pragma unroll
        for (int r = 0; r < 9; ++r) atomicAdd((float*)(mod + r * NMOD + n), acc[r] + bias);
        LDS_WAIT();
    }
}
__device__ __forceinline__ void p1_rows(const GAS float* __restrict__ x, const GAS float* __restrict__ ctx, const GAS float* __restrict__ g, const GAS float* __restrict__ mod, GAS bf16_t* __restrict__ H, int gw, int NGW, int lane) {
    for (int m0 = 2 * gw; m0 < MALL; m0 += 2 * NGW) {
        f32x4 v[2][4]; float ss[2];
#pragma unroll
        for (int r = 0; r < 2; ++r) { const int m = m0 + r; const GAS float* src = m < MLAT ? x + (size_t)m * DM : ctx + (size_t)(m - MLAT) * DM; ss[r] = 0.f;
#pragma unroll
            for (int j = 0; j < 4; ++j) { v[r][j] = *(const GAS f32x4*)(src + 4 * lane + 256 * j); ss[r] += v[r][j].x * v[r][j].x + v[r][j].y * v[r][j].y + v[r][j].z * v[r][j].z + v[r][j].w * v[r][j].w; } }
#pragma unroll
        for (int r = 0; r < 2; ++r) { const int m = m0 + r; const GAS float* md = mod + (m < MLAT ? (m >> 13) : 8) * NMOD;
            const float rs = rsqrtf(wave_sum(ss[r]) * (1.f / DM) + EPS);
#pragma unroll
            for (int j = 0; j < 4; ++j) { const int k = 4 * lane + 256 * j;
                const f32x4 gg = *(const GAS f32x4*)(g + k), sh = *(const GAS f32x4*)(md + k), sc = *(const GAS f32x4*)(md + DM + k);
                const f32x4 y = v[r][j] * rs * gg * (sc + 1.f) + sh;
                u32x2 o; o.x = pk2(y.x, y.y); o.y = pk2(y.z, y.w); *(GAS u32x2*)(H + (size_t)m * DM + k) = o; } }
    }
}
__device__ __forceinline__ void ss_phase(const GAS bf16_t* __restrict__ P, GAS float* __restrict__ ssq, GAS float* __restrict__ sskv, int gw, int NGW, int lane) {
#pragma unroll 4
    for (int m = gw; m < MALL; m += NGW) {
        const u32x2 q = *(const GAS u32x2*)(P + (size_t)m * PW + 1024 + 4 * lane); const unsigned k = *(const GAS unsigned*)(P + (size_t)m * PW + 1280 + 2 * lane);
        float a = bflo(q.x) * bflo(q.x) + bfhi(q.x) * bfhi(q.x) + bflo(q.y) * bflo(q.y) + bfhi(q.y) * bfhi(q.y), c = bflo(k) * bflo(k) + bfhi(k) * bfhi(k);
        a = wave_sum(a); c = wave_sum(c);
        if (lane == 0) { ssq[m] = a; sskv[m] = c; }
    }
}
__device__ __forceinline__ void qpost_phase(const GAS bf16_t* __restrict__ QR, const GAS float* __restrict__ ssq, const GAS float* __restrict__ RT, GAS bf16_t* __restrict__ Q, int gtid, int NT) {
#pragma unroll 4
    for (int task = gtid; task < MLAT * 96; task += NT) {
        const int row = task / 96, c8 = task - row * 96, h = c8 / 12, dc = c8 - h * 12, b = row >> 13, s = row & 8191;
        const float sc = rsqrtf(ssq[row] * (1.f / 256.f) + EPS) * QSCALE;
        const u32x4 mine = *(const GAS u32x4*)(QR + (size_t)row * 768 + 8 * c8);
        float v[8];
#pragma unroll
        for (int j = 0; j < 4; ++j) { v[2 * j] = bflo(mine[j]) * sc; v[2 * j + 1] = bfhi(mine[j]) * sc; }
        if (dc >= 8) { const int fq = dc - 8; const u32x4 oth = *(const GAS u32x4*)(QR + (size_t)row * 768 + 8 * (c8 ^ 1));
            const GAS float* rt = RT + (fq < 2 ? (s >> 6) : (s & 63)) * 16;
#pragma unroll
            for (int j = 0; j < 8; ++j) { const float pt = ((j & 1) ? bfhi(oth[j >> 1]) : bflo(oth[j >> 1])) * sc, cs = rt[2 * j], sn = rt[2 * j + 1];
                v[j] = (fq & 1) ? v[j] * cs + pt * sn : v[j] * cs - pt * sn; } }
        u32x4 w; w.x = pk2(v[0], v[1]); w.y = pk2(v[2], v[3]); w.z = pk2(v[4], v[5]); w.w = pk2(v[6], v[7]);
        *(GAS u32x4*)(Q + ((size_t)((b * 8 + h) * SEQ + s)) * 96 + 8 * dc) = w;
    }
}
__device__ __forceinline__ void kvpost_phase(const GAS bf16_t* __restrict__ KVR, const GAS float* __restrict__ sskv, GAS bf16_t* __restrict__ Kb, GAS bf16_t* __restrict__ Vt, int gtid, int NT) {
#pragma unroll 4
    for (int task = gtid; task < MALL * 64; task += NT) {
        const int row = task >> 6, c = task & 63, h = c >> 3, dd = (c & 7) * 8; const bool lat = row < MLAT;
        const int b = lat ? (row >> 13) : ((row - MLAT) >> 8), pos = lat ? (CTX + (row & 8191)) : ((row - MLAT) & 255);
        const float rs = rsqrtf(sskv[row] * (1.f / 128.f) + EPS);
        const u32x4 mine = *(const GAS u32x4*)(KVR + (size_t)row * 1024 + h * 128 + dd);
        u32x4 w;
#pragma unroll
        for (int j = 0; j < 4; ++j) w[j] = pk2(bflo(mine[j]) * rs, bfhi(mine[j]) * rs);
        *(GAS u32x4*)(Kb + ((size_t)(b * 8 + h) * KVLEN + pos) * 96 + dd) = w;
    }
#pragma unroll 2
    for (int task = gtid; task < (MALL / 8) * 512; task += NT) {
        const int pg = task & 7, dd = (task >> 3) & 7, rest = task >> 6, hd8 = rest & 63, rb = rest >> 6, h = hd8 >> 3, d = (hd8 & 7) * 8 + dd, row0 = rb * 64 + pg * 8; const bool lat = row0 < MLAT;
        const int b = lat ? (row0 >> 13) : ((row0 - MLAT) >> 8), pos0 = lat ? (CTX + (row0 & 8191)) : ((row0 - MLAT) & 255);
        float v[8];
#pragma unroll
        for (int i = 0; i < 8; ++i) v[i] = bf2f(KVR[(size_t)(row0 + i) * 1024 + h * 128 + 64 + d]) * rsqrtf(sskv[row0 + i] * (1.f / 128.f) + EPS);
        u32x4 w; w.x = pk2(v[0], v[1]); w.y = pk2(v[2], v[3]); w.z = pk2(v[4], v[5]); w.w = pk2(v[6], v[7]);
        *(GAS u32x4*)(Vt + ((size_t)((b * 8 + h) * 64 + d)) * KVLEN + pos0) = w;
    }
}
__device__ __forceinline__ void krope_phase(const GAS bf16_t* __restrict__ P, GAS bf16_t* __restrict__ Kb, const GAS float* __restrict__ RT, int gtid, int NT) {
#pragma unroll 2
    for (int task = gtid; task < MALL * 4; task += NT) {
        const int row = task >> 2, fq = task & 3; const bool lat = row < MLAT;
        const int b = lat ? (row >> 13) : ((row - MLAT) >> 8), s = row & 8191, pos = lat ? (CTX + s) : ((row - MLAT) & 255);
        const u32x4 mine = *(const GAS u32x4*)(P + (size_t)row * PW + 1408 + 8 * fq), oth = *(const GAS u32x4*)(P + (size_t)row * PW + 1408 + 8 * (fq ^ 1));
        float v[8], pt[8];
#pragma unroll
        for (int j = 0; j < 4; ++j) { v[2 * j] = bflo(mine[j]); v[2 * j + 1] = bfhi(mine[j]); pt[2 * j] = bflo(oth[j]); pt[2 * j + 1] = bfhi(oth[j]); }
        if (lat) { const GAS float* rt = RT + (fq < 2 ? (s >> 6) : (s & 63)) * 16;
#pragma unroll
            for (int j = 0; j < 8; ++j) { const float cs = rt[2 * j], sn = rt[2 * j + 1]; v[j] = (fq & 1) ? v[j] * cs + pt[j] * sn : v[j] * cs - pt[j] * sn; } }
        u32x4 w; w.x = pk2(v[0], v[1]); w.y = pk2(v[2], v[3]); w.z = pk2(v[4], v[5]); w.w = pk2(v[6], v[7]);
#pragma unroll
        for (int h = 0; h < 8; ++h) *(GAS u32x4*)(Kb + ((size_t)(b * 8 + h) * KVLEN + pos) * 96 + 64 + 8 * fq) = w;
    }
}
#define MFMA32(a, b, c) __builtin_amdgcn_mfma_f32_32x32x16_bf16((a), (b), (c), 0, 0, 0)
__device__ __forceinline__ void gates_phase(const GAS float* __restrict__ cw, const GAS float* __restrict__ cb, const GAS float* __restrict__ b_a, const GAS float* __restrict__ b_x, const GAS float* __restrict__ lam, LAS unsigned char* lds, const GAS bf16_t* __restrict__ P, const GAS bf16_t* __restrict__ Wg, GAS unsigned* __restrict__ LU, GAS f32x2* __restrict__ AGG, int tid, int wave, int lane) {
    LAS bf16_t* xs = (LAS bf16_t*)(lds + wave * 4608);
    LAS f32x2* wagg = (LAS f32x2*)(lds + 8 * 4608);
    const int r32 = lane & 31, hi = lane >> 5;
    for (int unit = blockIdx.x; unit < (MALL / 256) * 8; unit += gridDim.x) {
        const int pm = unit >> 3, h = unit & 7, m0 = pm * 256 + wave * 32;
        const int s0 = m0 < MLAT ? (m0 & ~8191) : (MLAT + ((m0 - MLAT) & ~255)), slen = m0 < MLAT ? SEQ : CTX;
        {
            const int tok = lane >> 1, m = m0 + tok;
#pragma unroll
            for (int c8 = 0; c8 < 4; ++c8) { const int ch = (lane & 1) * 32 + c8 * 8, gch = h * 64 + ch;
                float acc[8];
                { const f32x4 b0 = *(const GAS f32x4*)(cb + gch), b1 = *(const GAS f32x4*)(cb + gch + 4);
                  acc[0] = b0.x; acc[1] = b0.y; acc[2] = b0.z; acc[3] = b0.w; acc[4] = b1.x; acc[5] = b1.y; acc[6] = b1.z; acc[7] = b1.w; }
#pragma unroll
                for (int k = 0; k < 4; ++k) { const int mm = m + k - 2;
                    if (mm >= s0 && mm < s0 + slen) { const u32x4 xv = *(const GAS u32x4*)(P + (size_t)mm * PW + gch);
                        const f32x4 w0 = *(const GAS f32x4*)(cw + k * 512 + gch), w1 = *(const GAS f32x4*)(cw + k * 512 + gch + 4);
                        acc[0] += w0.x * bflo(xv.x); acc[1] += w0.y * bfhi(xv.x); acc[2] += w0.z * bflo(xv.y); acc[3] += w0.w * bfhi(xv.y);
                        acc[4] += w1.x * bflo(xv.z); acc[5] += w1.y * bfhi(xv.z); acc[6] += w1.z * bflo(xv.w); acc[7] += w1.w * bfhi(xv.w); } }
                u32x4 o; o.x = pk2(acc[0], acc[1]); o.y = pk2(acc[2], acc[3]); o.z = pk2(acc[4], acc[5]); o.w = pk2(acc[6], acc[7]);
                *(LAS u32x4*)(xs + tok * 72 + ch) = o; }
        }
        LDS_WAIT();
        bf16x8 afr[4];
#pragma unroll
        for (int ks = 0; ks < 4; ++ks) afr[ks] = *(const LAS bf16x8*)(xs + r32 * 72 + 16 * ks + 8 * hi);
#pragma unroll
        for (int jh = 0; jh < 2; ++jh) {
            f32x16 acc4[4];
#pragma unroll
            for (int q = 0; q < 4; ++q) {
#pragma unroll
                for (int i = 0; i < 16; ++i) acc4[q][i] = 0.f;
                const GAS bf16_t* wrow = Wg + (size_t)(h * 256 + (2 * q + jh) * 32 + r32) * 64 + 8 * hi;
#pragma unroll
                for (int ks = 0; ks < 4; ++ks) { const bf16x8 bfr = *(const GAS bf16x8*)(wrow + 16 * ks); acc4[q] = MFMA32(afr[ks], bfr, acc4[q]); }
            }
            const int ch = jh * 32 + r32, gch = h * 64 + ch;
            float ba[2], bx[2], sp[2];
#pragma unroll
            for (int d = 0; d < 2; ++d) { ba[d] = b_a[d * 512 + gch]; bx[d] = b_x[d * 512 + gch]; sp[d] = lam[d * 512 + gch]; }
            unsigned wv[16][2]; float avs[16][2];
#pragma unroll
            for (int i = 0; i < 16; ++i) { const int row = crow(i, hi); const float xv = bf2f(xs[row * 72 + ch]);
#pragma unroll
                for (int d = 0; d < 2; ++d) { const float r = sigmoidf_(acc4[2 * d][i] + ba[d]), ig = sigmoidf_(acc4[2 * d + 1][i] + bx[d]);
                    const float la2 = bflo(f2bf(-r * sp[d])), av = __builtin_amdgcn_exp2f(la2); avs[i][d] = av;
                    const float uu = __builtin_amdgcn_sqrtf(fmaxf(1.f - av * av, 0.f)) * (ig * xv);
                    wv[i][d] = pk2(la2, uu);
                    LU[((size_t)(m0 + row) * 2 + d) * 512 + gch] = wv[i][d]; } }
#pragma unroll
            for (int d = 0; d < 2; ++d) {
                float Ar[4], Ur[4];
#pragma unroll
                for (int g = 0; g < 4; ++g) { float A = 1.f, U = 0.f;
#pragma unroll
                    for (int jj = 0; jj < 4; ++jj) { const int j = d ? 3 - jj : jj; const unsigned w = wv[4 * g + j][d]; const float av = avs[4 * g + j][d]; A *= av; U = av * U + bfhi(w); }
                    Ar[g] = A; Ur[g] = U; }
                float A = 1.f, U = 0.f;
#pragma unroll
                for (int gg = 0; gg < 4; ++gg) { const int g = d ? 3 - gg : gg;
                    const float Ao = __shfl_xor(Ar[g], 32), Uo = __shfl_xor(Ur[g], 32);
                    if (d == 0) { U = Ar[g] * U + Ur[g]; A *= Ar[g]; U = Ao * U + Uo; A *= Ao; }
                    else        { U = Ao * U + Uo; A *= Ao; U = Ar[g] * U + Ur[g]; A *= Ar[g]; } }
                if (hi == 0) wagg[(wave * 2 + d) * 64 + ch] = (f32x2){A, U};
            }
        }
        LDS_WAIT();
        __syncthreads();
        if (tid < 128) {
            const int d = tid >> 6, ch = tid & 63; float A = 1.f, U = 0.f;
#pragma unroll
            for (int ww = 0; ww < 8; ++ww) { const int w = d ? 7 - ww : ww; const f32x2 g = wagg[(w * 2 + d) * 64 + ch]; U = g.x * U + g.y; A *= g.x; }
            const int b = pm < MLAT / 256 ? (pm >> 5) : (pm - MLAT / 256), c = pm < MLAT / 256 ? (pm & 31) : NCH;
            AGG[(size_t)((b * 2 + d) * (NCH + 1) + c) * 512 + h * 64 + ch] = (f32x2){A, U};
        }
        __syncthreads();
    }
}
__device__ __forceinline__ void scan_agg(const GAS unsigned* __restrict__ LU, GAS f32x2* __restrict__ AGG, int gw, int NGW, int lane) {
    for (int task = gw; task < NB * 2 * (NCH + 1) * 8; task += NGW) {
        const int cgp = task & 7, c = (task >> 3) % (NCH + 1), d = (task / (8 * (NCH + 1))) & 1, b = task / (16 * (NCH + 1));
        const int ch = cgp * 64 + lane, row0 = c < NCH ? b * SEQ + c * CHL : MLAT + b * CTX;
        float A = 1.f, U = 0.f;
#pragma unroll 16
        for (int t = 0; t < CHL; ++t) { const int tt = d ? CHL - 1 - t : t; const unsigned w = LU[((size_t)(row0 + tt) * 2 + d) * 512 + ch];
            const float av = __builtin_amdgcn_exp2f(bflo(w)); A *= av; U = av * U + bfhi(w); }
        AGG[(size_t)((b * 2 + d) * (NCH + 1) + c) * 512 + ch] = (f32x2){A, U};
    }
}
__device__ __forceinline__ float gelu_tanh(float x) { const float z = 0.7978845608028654f * (x + 0.044715f * x * x * x);
    return x * __builtin_amdgcn_rcpf(1.f + __builtin_amdgcn_exp2f(-2.8853900817779268f * z)); }
__device__ __forceinline__ void scan_final(const GAS unsigned* __restrict__ LU, const GAS f32x2* __restrict__ AGG, const GAS bf16_t* __restrict__ P, GAS bf16_t* __restrict__ A2, int gw, int NGW, int lane) {
    constexpr int BT = 16;
    for (int task = gw; task < NB * NCH * 8; task += NGW) {
        const int cgp = task & 7, c = (task >> 3) & (NCH - 1), b = task / (8 * NCH), ch = cgp * 64 + lane, row0 = b * SEQ + c * CHL;
        const GAS f32x2* ag0 = AGG + (size_t)((b * 2 + 0) * (NCH + 1)) * 512 + ch; const GAS f32x2* ag1 = AGG + (size_t)((b * 2 + 1) * (NCH + 1)) * 512 + ch;
        unsigned w[BT], wn[BT];
#pragma unroll
        for (int i = 0; i < BT; ++i) w[i] = LU[((size_t)(row0 + i) * 2 + 0) * 512 + ch];
        float hf = ag0[(size_t)NCH * 512].y;
        for (int cc = 0; cc < c; ++cc) { const f32x2 g = ag0[(size_t)cc * 512]; hf = g.x * hf + g.y; }
        float hb = ag1[(size_t)NCH * 512].y;
        for (int cc = NCH - 1; cc > c; --cc) { const f32x2 g = ag1[(size_t)cc * 512]; hb = g.x * hb + g.y; }
#pragma unroll 1
        for (int t0 = 0; t0 < CHL; t0 += BT) {
            if (t0 + BT < CHL) {
#pragma unroll
                for (int i = 0; i < BT; ++i) wn[i] = LU[((size_t)(row0 + t0 + BT + i) * 2 + 0) * 512 + ch]; }
#pragma unroll
            for (int i = 0; i < BT; ++i) { hf = __builtin_amdgcn_exp2f(bflo(w[i])) * hf + bfhi(w[i]); A2[(size_t)(row0 + t0 + i) * DM + ch] = (bf16_t)f2bf(hf); }
#pragma unroll
            for (int i = 0; i < BT; ++i) w[i] = wn[i]; }
        bf16_t gr[BT], grn[BT];
#pragma unroll
        for (int i = 0; i < BT; ++i) { w[i] = LU[((size_t)(row0 + CHL - BT + i) * 2 + 1) * 512 + ch]; gr[i] = P[(size_t)(row0 + CHL - BT + i) * PW + 512 + ch]; }
#pragma unroll 1
        for (int t0 = CHL - BT; t0 >= 0; t0 -= BT) { bf16_t f[BT];
#pragma unroll
            for (int i = 0; i < BT; ++i) f[i] = A2[(size_t)(row0 + t0 + i) * DM + ch];
            if (t0 >= BT) {
#pragma unroll
                for (int i = 0; i < BT; ++i) { wn[i] = LU[((size_t)(row0 + t0 - BT + i) * 2 + 1) * 512 + ch]; grn[i] = P[(size_t)(row0 + t0 - BT + i) * PW + 512 + ch]; } }
#pragma unroll
            for (int i = BT - 1; i >= 0; --i) { hb = __builtin_amdgcn_exp2f(bflo(w[i])) * hb + bfhi(w[i]);
                A2[(size_t)(row0 + t0 + i) * DM + ch] = (bf16_t)f2bf((bf2f(f[i]) + hb) * gelu_tanh(bf2f(gr[i]))); }
#pragma unroll
            for (int i = 0; i < BT; ++i) { w[i] = wn[i]; gr[i] = grn[i]; } }
    }
}
constexpr int AT_KROW = 208, AT_VROW = 144;
constexpr float AT_THR = 8.f;
#define AT_LMAX(P, MX) do { MX = fmaxf(fmaxf(P[0], P[1]), fmaxf(P[2], P[3])); \
        _Pragma("unroll") for (int i_ = 4; i_ < 16; i_ += 4) MX = fmaxf(fmaxf(MX, P[i_]), fmaxf(fmaxf(P[i_ + 1], P[i_ + 2]), P[i_ + 3])); } while (0)
#define AT_SOFTMAX(P, MX, M, L, O0, O1, PW0, PW1) do { \
        if (__any(MX > M + AT_THR)) { const float mn_ = fmaxf(M, MX), al_ = __builtin_amdgcn_exp2f(M - mn_); M = mn_; L *= al_; \
            _Pragma("unroll") for (int i_ = 0; i_ < 16; ++i_) { O0[i_] *= al_; O1[i_] *= al_; } } \
        float s_ = 0.f; \
        _Pragma("unroll") for (int i_ = 0; i_ < 16; ++i_) { P[i_] = __builtin_amdgcn_exp2f(P[i_] - M); s_ += P[i_]; } \
        L += s_; \
        _Pragma("unroll") for (int j_ = 0; j_ < 4; ++j_) { PW0[j_] = cvtpk(P[2 * j_], P[2 * j_ + 1]); PW1[j_] = cvtpk(P[8 + 2 * j_], P[9 + 2 * j_]); } } while (0)
__device__ __forceinline__ void glds16(const GAS void* gsrc, unsigned lds_dst) {
    unsigned keep;
    asm volatile("s_mov_b32 %0, m0\n\ts_mov_b32 m0, %2\n\ts_nop 0\n\tglobal_load_lds_dwordx4 %1, off\n\ts_mov_b32 m0, %0" : "=&s"(keep) : "v"(gsrc), "s"(lds_dst) : "memory");
}
constexpr int AT_SLOT = 22 * 1024, AT_VOFF = 13 * 1024, AT_NP = 22;
__device__ __forceinline__ void attn_unit(LAS unsigned char* lds, const GAS bf16_t* __restrict__ QR, const GAS float* __restrict__ ssq, const GAS float* __restrict__ RT, const GAS bf16_t* __restrict__ K, const GAS bf16_t* __restrict__ Vt, GAS bf16_t* __restrict__ A2, int b, int h, int qb, int tid, int wave, int lane) {
    const int r32 = lane & 31, hi = lane >> 5, q0 = qb * 512 + wave * 64, r32s = (r32 & ~12) | ((r32 & 4) << 1) | ((r32 & 8) >> 1);
    bf16x8 qa[6], qc[6];
#pragma unroll
    for (int sub = 0; sub < 2; ++sub) {
        const int s = q0 + 32 * sub + r32, row = b * SEQ + s;
        const GAS bf16_t* Qp = QR + (size_t)row * 768 + h * 96 + 8 * hi;
        const float sc = rsqrtf(ssq[row] * (1.f / 256.f) + EPS) * QSCALE;
#pragma unroll
        for (int d0 = 0; d0 < 6; ++d0) {
            const u32x4 raw = *(const GAS u32x4*)(Qp + 16 * d0);
            float v[8];
#pragma unroll
            for (int j = 0; j < 4; ++j) { v[2 * j] = bflo(raw[j]) * sc; v[2 * j + 1] = bfhi(raw[j]) * sc; }
            if (d0 >= 4) { const GAS float* rt = RT + (d0 == 4 ? (s >> 6) : (s & 63)) * 16;
#pragma unroll
                for (int j = 0; j < 8; ++j) { const float pt = __shfl_xor(v[j], 32), cs = rt[2 * j], sn = rt[2 * j + 1]; v[j] = hi ? v[j] * cs + pt * sn : v[j] * cs - pt * sn; } }
            u32x4 w; w.x = pk2(v[0], v[1]); w.y = pk2(v[2], v[3]); w.z = pk2(v[4], v[5]); w.w = pk2(v[6], v[7]);
            if (sub == 0) qa[d0] = __builtin_bit_cast(bf16x8, w); else qc[d0] = __builtin_bit_cast(bf16x8, w);
        }
    }
    const GAS unsigned char* Kg = (const GAS unsigned char*)(K + (size_t)(b * 8 + h) * KVLEN * 96);
    const GAS unsigned char* Vg = (const GAS unsigned char*)(Vt + (size_t)(b * 8 + h) * 64 * KVLEN);
    const unsigned ldsb = (unsigned)(size_t)lds;
    const GAS unsigned char* src[3]; int stride[3]; unsigned dsto[3];
#pragma unroll
    for (int k = 0; k < 3; ++k) { int j = wave + 8 * k; if (j >= AT_NP) j -= 8; const int id = j * 64 + lane;
        if (j < 13) { const int row = id / 13; int col = id - row * 13; if (col == 12) col = 0; src[k] = Kg + row * 192 + col * 16; stride[k] = 12288; }
        else { const int idv = id - 832, d = idv / 9; int c = idv - d * 9; if (c == 8) c = 0; src[k] = Vg + ((size_t)d * KVLEN + c * 8) * 2; stride[k] = 128; }
        dsto[k] = ldsb + j * 1024; }
#define AT_ISSUE(t, slot) do { _Pragma("unroll") for (int k_ = 0; k_ < 3; ++k_) glds16(src[k_] + (size_t)(t) * stride[k_], (unsigned)__builtin_amdgcn_readfirstlane(dsto[k_] + (slot) * AT_SLOT)); } while (0)
    f32x16 oA0, oA1, oB0, oB1;
#pragma unroll
    for (int i = 0; i < 16; ++i) { oA0[i] = 0.f; oA1[i] = 0.f; oB0[i] = 0.f; oB1[i] = 0.f; }
    float mA = -1e30f, mB = -1e30f, lA = 0.f, lB = 0.f;
    constexpr int NT_ = KVLEN / 64;
    AT_ISSUE(0, 0); AT_ISSUE(1, 1);
    int slot = 0, nslot = 2;
#pragma unroll 1
    for (int t = 0; t < NT_; ++t) {
        if (t + 1 < NT_) asm volatile("s_waitcnt vmcnt(3) lgkmcnt(0)\n\ts_barrier" ::: "memory"); else asm volatile("s_waitcnt vmcnt(0) lgkmcnt(0)\n\ts_barrier" ::: "memory");
        if (t + 2 < NT_) AT_ISSUE(t + 2, nslot);
        const LAS unsigned char* sb = lds + slot * AT_SLOT;
#pragma unroll
        for (int hh = 0; hh < 2; ++hh) {
            const LAS unsigned char* kb = sb + (32 * hh + r32s) * AT_KROW + hi * 16;
            f32x16 pA, pB;
#pragma unroll
            for (int i = 0; i < 16; ++i) { pA[i] = 0.f; pB[i] = 0.f; }
#pragma unroll
            for (int d0 = 0; d0 < 6; ++d0) { const bf16x8 a0 = *(const LAS bf16x8*)(kb + d0 * 32); pA = MFMA32(a0, qa[d0], pA); pB = MFMA32(a0, qc[d0], pB); }
            u32x4 pwA0, pwA1, pwB0, pwB1;
            float mxA, mxB; AT_LMAX(pA, mxA); AT_LMAX(pB, mxB);
            { const float oa = __shfl_xor(mxA, 32), ob = __shfl_xor(mxB, 32); mxA = fmaxf(mxA, oa); mxB = fmaxf(mxB, ob); }
            AT_SOFTMAX(pA, mxA, mA, lA, oA0, oA1, pwA0, pwA1);
            AT_SOFTMAX(pB, mxB, mB, lB, oB0, oB1, pwB0, pwB1);
            const LAS unsigned char* vb = sb + AT_VOFF + r32 * AT_VROW + hi * 16 + hh * 64;
#pragma unroll
            for (int ks = 0; ks < 2; ++ks) {
                const bf16x8 va0 = *(const LAS bf16x8*)(vb + ks * 32), va1 = *(const LAS bf16x8*)(vb + 32 * AT_VROW + ks * 32);
                const bf16x8 pa = __builtin_bit_cast(bf16x8, ks ? pwA1 : pwA0), pb = __builtin_bit_cast(bf16x8, ks ? pwB1 : pwB0);
                oA0 = MFMA32(va0, pa, oA0); oA1 = MFMA32(va1, pa, oA1); oB0 = MFMA32(va0, pb, oB0); oB1 = MFMA32(va1, pb, oB1);
            }
        }
        slot = slot == 2 ? 0 : slot + 1; nslot = nslot == 2 ? 0 : nslot + 1;
    }
    asm volatile("s_waitcnt lgkmcnt(0)\n\ts_barrier" ::: "memory");
    {   const float inv = 1.f / (lA + __shfl_xor(lA, 32));
        GAS bf16_t* op = A2 + (size_t)(b * SEQ + q0 + r32) * DM + 512 + h * 64 + 4 * hi;
#pragma unroll
        for (int g = 0; g < 4; ++g) { u32x2 w0, w1; w0.x = pk2(oA0[4 * g] * inv, oA0[4 * g + 1] * inv); w0.y = pk2(oA0[4 * g + 2] * inv, oA0[4 * g + 3] * inv);
            w1.x = pk2(oA1[4 * g] * inv, oA1[4 * g + 1] * inv); w1.y = pk2(oA1[4 * g + 2] * inv, oA1[4 * g + 3] * inv);
            *(GAS u32x2*)(op + 8 * g) = w0; *(GAS u32x2*)(op + 32 + 8 * g) = w1; } }
    {   const float inv = 1.f / (lB + __shfl_xor(lB, 32));
        GAS bf16_t* op = A2 + (size_t)(b * SEQ + q0 + 32 + r32) * DM + 512 + h * 64 + 4 * hi;
#pragma unroll
        for (int g = 0; g < 4; ++g) { u32x2 w0, w1; w0.x = pk2(oB0[4 * g] * inv, oB0[4 * g + 1] * inv); w0.y = pk2(oB0[4 * g + 2] * inv, oB0[4 * g + 3] * inv);
            w1.x = pk2(oB1[4 * g] * inv, oB1[4 * g + 1] * inv); w1.y = pk2(oB1[4 * g + 2] * inv, oB1[4 * g + 3] * inv);
            *(GAS u32x2*)(op + 8 * g) = w0; *(GAS u32x2*)(op + 32 + 8 * g) = w1; } }
#undef AT_ISSUE
}
__device__ __forceinline__ void p7_rows(const GAS float* __restrict__ x, const GAS float* __restrict__ g_post, const GAS float* __restrict__ g_pre, GAS float* __restrict__ out, const GAS float* __restrict__ mod, const GAS bf16_t* __restrict__ Y, GAS bf16_t* __restrict__ H2, int gw, int NGW, int lane) {
    for (int m0 = 2 * gw; m0 < MLAT; m0 += 2 * NGW) {
        const GAS float* md = mod + (m0 >> 13) * NMOD;
        f32x4 y[2][4], xv[2][4]; float ss[2];
#pragma unroll
        for (int r = 0; r < 2; ++r) { ss[r] = 0.f;
#pragma unroll
            for (int j = 0; j < 4; ++j) { const u32x2 w = *(const GAS u32x2*)(Y + (size_t)(m0 + r) * DM + 4 * lane + 256 * j); xv[r][j] = *(const GAS f32x4*)(x + (size_t)(m0 + r) * DM + 4 * lane + 256 * j);
                y[r][j] = (f32x4){bflo(w.x), bfhi(w.x), bflo(w.y), bfhi(w.y)}; ss[r] += y[r][j].x * y[r][j].x + y[r][j].y * y[r][j].y + y[r][j].z * y[r][j].z + y[r][j].w * y[r][j].w; } }
#pragma unroll
        for (int r = 0; r < 2; ++r) { const int m = m0 + r;
            const float rs = rsqrtf(wave_sum(ss[r]) * (1.f / DM) + EPS); float s2 = 0.f;
#pragma unroll
            for (int j = 0; j < 4; ++j) { const int k = 4 * lane + 256 * j;
                const f32x4 gg = *(const GAS f32x4*)(g_post + k), gt = *(const GAS f32x4*)(md + 2 * DM + k);
                xv[r][j] = xv[r][j] + gt * (y[r][j] * rs * gg); *(GAS f32x4*)(out + (size_t)m * DM + k) = xv[r][j];
                s2 += xv[r][j].x * xv[r][j].x + xv[r][j].y * xv[r][j].y + xv[r][j].z * xv[r][j].z + xv[r][j].w * xv[r][j].w; }
            const float rs2 = rsqrtf(wave_sum(s2) * (1.f / DM) + EPS);
#pragma unroll
            for (int j = 0; j < 4; ++j) { const int k = 4 * lane + 256 * j;
                const f32x4 gg = *(const GAS f32x4*)(g_pre + k), sh = *(const GAS f32x4*)(md + 3 * DM + k), sc = *(const GAS f32x4*)(md + 4 * DM + k);
                const f32x4 hh = xv[r][j] * rs2 * gg * (sc + 1.f) + sh;
                u32x2 o; o.x = pk2(hh.x, hh.y); o.y = pk2(hh.z, hh.w); *(GAS u32x2*)(H2 + (size_t)m * DM + k) = o; } }
    }
}
__device__ __forceinline__ void p11_rows(const GAS float* __restrict__ g_post, GAS float* __restrict__ out, const GAS float* __restrict__ mod, const GAS bf16_t* __restrict__ Fb, int gw, int NGW, int lane) {
    for (int m0 = 2 * gw; m0 < MLAT; m0 += 2 * NGW) {
        const GAS float* md = mod + (m0 >> 13) * NMOD;
        f32x4 y[2][4], xv[2][4]; float ss[2];
#pragma unroll
        for (int r = 0; r < 2; ++r) { ss[r] = 0.f;
#pragma unroll
            for (int j = 0; j < 4; ++j) { const u32x2 w = *(const GAS u32x2*)(Fb + (size_t)(m0 + r) * DM + 4 * lane + 256 * j); xv[r][j] = *(const GAS f32x4*)(out + (size_t)(m0 + r) * DM + 4 * lane + 256 * j);
                y[r][j] = (f32x4){bflo(w.x), bfhi(w.x), bflo(w.y), bfhi(w.y)}; ss[r] += y[r][j].x * y[r][j].x + y[r][j].y * y[r][j].y + y[r][j].z * y[r][j].z + y[r][j].w * y[r][j].w; } }
#pragma unroll
        for (int r = 0; r < 2; ++r) { const float rs = rsqrtf(wave_sum(ss[r]) * (1.f / DM) + EPS);
#pragma unroll
            for (int j = 0; j < 4; ++j) { const int k = 4 * lane + 256 * j;
                const f32x4 gg = *(const GAS f32x4*)(g_post + k), gt = *(const GAS f32x4*)(md + 5 * DM + k);
                *(GAS f32x4*)(out + (size_t)(m0 + r) * DM + k) = xv[r][j] + gt * (y[r][j] * rs * gg); } }
    }
}
__device__ __forceinline__ void convgate_phase(const GAS float* __restrict__ cw, const GAS float* __restrict__ cb, const GAS bf16_t* __restrict__ UP, GAS bf16_t* __restrict__ G, int half, int gtid, int NT) {
    constexpr int JG = DFF / 8, RG = 32, NTASK = (MLAT / 2 / RG) * JG;
    for (int task = gtid; task < NTASK; task += NT) {
        const int jg = task % JG, rg = task / JG, j0 = jg * 8, r0 = rg * RG, m0 = half * (MLAT / 2) + r0;
        float wu[3][8], wg[3][8], bu[8], bg[8];
#pragma unroll
        for (int k = 0; k < 3; ++k)
#pragma unroll
            for (int i = 0; i < 8; ++i) { wu[k][i] = cw[k * 2 * DFF + j0 + i]; wg[k][i] = cw[k * 2 * DFF + DFF + j0 + i]; }
#pragma unroll
        for (int i = 0; i < 8; ++i) { bu[i] = cb[j0 + i]; bg[i] = cb[DFF + j0 + i]; }
        const GAS bf16_t* up = UP + (size_t)r0 * (2 * DFF) + j0;
        u32x4 pu = {0u, 0u, 0u, 0u}, pg = {0u, 0u, 0u, 0u}, cu, cg_, nu, ng;
        if ((m0 & 8191) != 0) { pu = *(const GAS u32x4*)(up - 2 * DFF); pg = *(const GAS u32x4*)(up - 2 * DFF + DFF); }
        cu = *(const GAS u32x4*)(up); cg_ = *(const GAS u32x4*)(up + DFF);
#pragma unroll 8
        for (int r = 0; r < RG; ++r) {
            const bool nv = (r + 1 < RG) || (((m0 + RG) & 8191) != 0);
            if (nv) { nu = *(const GAS u32x4*)(up + (size_t)(r + 1) * (2 * DFF)); ng = *(const GAS u32x4*)(up + (size_t)(r + 1) * (2 * DFF) + DFF); } else { nu = (u32x4){0u, 0u, 0u, 0u}; ng = nu; }
            float o[8];
#pragma unroll
            for (int i = 0; i < 8; ++i) { const int w_ = i >> 1;
                const float p_u = (i & 1) ? bfhi(pu[w_]) : bflo(pu[w_]), c_u = (i & 1) ? bfhi(cu[w_]) : bflo(cu[w_]), n_u = (i & 1) ? bfhi(nu[w_]) : bflo(nu[w_]);
                const float p_g = (i & 1) ? bfhi(pg[w_]) : bflo(pg[w_]), c_g = (i & 1) ? bfhi(cg_[w_]) : bflo(cg_[w_]), n_g = (i & 1) ? bfhi(ng[w_]) : bflo(ng[w_]);
                const float uv = bu[i] + wu[0][i] * p_u + wu[1][i] * c_u + wu[2][i] * n_u, gv = bg[i] + wg[0][i] * p_g + wg[1][i] * c_g + wg[2][i] * n_g;
                o[i] = gv * __builtin_amdgcn_rcpf(1.f + __builtin_amdgcn_exp2f(-1.4426950408889634f * gv)) * uv; }
            u32x4 w; w.x = pk2(o[0], o[1]); w.y = pk2(o[2], o[3]); w.z = pk2(o[4], o[5]); w.w = pk2(o[6], o[7]);
            *(GAS u32x4*)(G + (size_t)(r0 + r) * DFF + j0) = w;
            pu = cu; pg = cg_; cu = nu; cg_ = ng;
        }
    }
}
constexpr int NPH = 17;
__global__ void __launch_bounds__(512, 2) fwd_kernel(Args a) {
    extern __shared__ __attribute__((aligned(16))) unsigned char lds_raw[];
    LAS unsigned char* lds = (LAS unsigned char*)lds_raw;
    const int lo = a.ph_lo, hi_ = a.ph_hi;
    {
        volatile LAS unsigned* st0 = (volatile LAS unsigned*)(lds + LDS_MISC);
        if (threadIdx.x < 2) st0[threadIdx.x] = 0u;
        __syncthreads();
        (void)xcd_barrier_post((unsigned*)(a.ws + WS_BAR), st0);
    }
#if MK_COOP
    cg::grid_group grid = cg::this_grid();
#endif
    typedef pg8::EpiBf16<0> EpiB;
    constexpr int MH = MLAT / 2;
#ifndef REPMASK
#define REPMASK 0
#endif
    bool repeated = false;
#pragma unroll 1
    for (int ph = lo; ph < hi_; ++ph) {
        int tid = threadIdx.x; asm volatile("" : "+v"(tid));
        int G = gridDim.x, bx = blockIdx.x; asm volatile("" : "+s"(G), "+s"(bx));
        const int lane = tid & 63, wave = __builtin_amdgcn_readfirstlane(tid >> 6);
        const int vcu = (G % 8 == 0) ? (bx % 8) * (G / 8) + bx / 8 : bx;
        const int gw = vcu * 8 + wave, NGW = G * 8, gtid = bx * 512 + tid, NTH = G * 512;
        unsigned char* ws_ = a.ws; asm volatile("" : "+s"(ws_)); GAS unsigned char* ws = (GAS unsigned char*)ws_;
        GAS float* mod = (GAS float*)(ws + WS_MOD); GAS float* ssq = (GAS float*)(ws + WS_SSQ); GAS float* sskv = (GAS float*)(ws + WS_SSKV);
        GAS bf16_t* Win = (GAS bf16_t*)(ws + WS_WIN); GAS bf16_t* Wq = (GAS bf16_t*)(ws + WS_WQ); GAS bf16_t* Wkv = (GAS bf16_t*)(ws + WS_WKV); GAS bf16_t* Wg = (GAS bf16_t*)(ws + WS_WG);
        GAS bf16_t* Wout = (GAS bf16_t*)(ws + WS_WOUT); GAS bf16_t* Wup = (GAS bf16_t*)(ws + WS_WUP); GAS bf16_t* Wdn = (GAS bf16_t*)(ws + WS_WDN);
        GAS f32x2* AGG = (GAS f32x2*)(ws + WS_AGG); GAS float* RT = (GAS float*)(ws + WS_ROPE);
        GAS bf16_t* H = (GAS bf16_t*)(ws + WS_R1); GAS bf16_t* KVR = H; GAS bf16_t* H2 = H; GAS bf16_t* QR = (GAS bf16_t*)(ws + WS_Q);
        GAS bf16_t* P = (GAS bf16_t*)(ws + WS_R2); GAS bf16_t* Y = P; GAS bf16_t* Fb = P;
        GAS unsigned* LU = (GAS unsigned*)(ws + WS_LU); GAS bf16_t* Kb = (GAS bf16_t*)(ws + WS_K); GAS bf16_t* Vb = (GAS bf16_t*)(ws + WS_V); GAS bf16_t* A2 = (GAS bf16_t*)(ws + WS_A2);
        GAS bf16_t* UP = (GAS bf16_t*)(ws + WS_UP); GAS bf16_t* Gb = (GAS bf16_t*)(ws + WS_G);
        float* outp_ = a.out; asm volatile("" : "+s"(outp_)); GAS float* outp = (GAS float*)outp_;
        pg8::Gemm g{nullptr, nullptr, 0, 0, 0, 0, 0}; GAS bf16_t* O = nullptr; int ldc = 0;
        switch (ph) {
            case 2:  g = pg8::Gemm{(const bf16_t*)(H), (const bf16_t*)(Win), MALL, PW, DM, DM, DM}; O = P; ldc = PW; break;
            case 4:  g = pg8::Gemm{(const bf16_t*)(P + 1024), (const bf16_t*)(Wq), MLAT, 768, 256, PW, 256}; O = QR; ldc = 768; break;
            case 5:  g = pg8::Gemm{(const bf16_t*)(P + 1280), (const bf16_t*)(Wkv), MALL, 1024, 256, PW, 256}; O = KVR; ldc = 1024; break;
            case 8:  g = pg8::Gemm{(const bf16_t*)(A2), (const bf16_t*)(Wout), MLAT, DM, DM, DM, DM}; O = Y; ldc = DM; break;
            case 10: g = pg8::Gemm{(const bf16_t*)(H2), (const bf16_t*)(Wup), MH, 2 * DFF, DM, DM, DM}; O = UP; ldc = 2 * DFF; break;
            case 13: g = pg8::Gemm{(const bf16_t*)(H2 + (size_t)MH * DM), (const bf16_t*)(Wup), MH, 2 * DFF, DM, DM, DM}; O = UP; ldc = 2 * DFF; break;
            case 12: g = pg8::Gemm{(const bf16_t*)(Gb), (const bf16_t*)(Wdn), MH, DM, DFF, DFF, DFF}; O = Fb; ldc = DM; break;
            case 15: g = pg8::Gemm{(const bf16_t*)(Gb), (const bf16_t*)(Wdn), MH, DM, DFF, DFF, DFF}; O = Fb + (size_t)MH * DM; ldc = DM; break;
            default: break;
        }
        if (g.A != nullptr) {
            pg8::StaticOrder S; S.init(g.M, g.N, G, bx); EpiB E{(bf16_t*)O, ldc, nullptr, 0, 0, 1.f};
            pg8::gemm_phase<EpiB, pg8::StaticOrder, true, true>(lds, g, S, E, tid);
        }
#ifndef NGM
#define NGM 0x1ffff
#endif
#define NG(k) ((NGM >> (k)) & 1)
        else if (NG(0) && ph == 0) {
            prep_mat<0>(argp(10), nullptr, Win, 1536, 1024, gtid, NTH); prep_mat<1>(argp(18), argp(19), Wq, 768, 256, gtid, NTH); prep_mat<2>(argp(20), argp(21), Wkv, 1024, 256, gtid, NTH);
            prep_mat<3>(argp(13), argp(15), Wg, 2048, 64, gtid, NTH); prep_mat<4>(argp(22), nullptr, Wout, 1024, 1024, gtid, NTH); prep_mat<5>(argp(23), nullptr, Wup, 5632, 1024, gtid, NTH);
            prep_mat<6>(argp(26), nullptr, Wdn, 1024, 2816, gtid, NTH);
            if (gtid < 1024) { const float nl = -argp(17)[gtid]; RT[2048 + gtid] = 8.f * 1.4426950408889634f * (nl > 20.f ? nl : log1pf(__expf(nl))); }
            if (gtid < 1024) { const int pos = gtid >> 3, j = gtid & 7; const float invf[8] = {1.f, 0.31622776601683794f, 0.1f, 0.031622776601683794f, 0.01f, 0.0031622776601683794f, 0.001f, 0.00031622776601683794f};
                const float ang = (float)pos * invf[j]; RT[2 * gtid] = cosf(ang); RT[2 * gtid + 1] = sinf(ang); }
            mod_phase(argp(1), argp(3), argp(4), argp(5), mod, (LAS float*)(lds + wave * 4096), gw, NGW, lane);
        } else if (NG(1) && ph == 1) {
            p1_rows(argp(0), argp(2), argp(6), mod, H, gw, NGW, lane);
        } else if (NG(3) && ph == 3) {
            gates_phase(argp(11), argp(12), argp(14), argp(16), (const GAS float*)(RT + 2048), lds, P, Wg, LU, AGG, tid, wave, lane);
            ss_phase(P, ssq, sskv, gw, NGW, lane);
        } else if (NG(6) && ph == 6) {
            krope_phase(P, Kb, RT, gtid, NTH); kvpost_phase(KVR, sskv, Kb, Vb, gtid, NTH);
#ifdef REP6
            if (REP6 & 1) { __syncthreads(); scan_agg(LU, AGG, gw, NGW, lane); }
            if (REP6 & 2) { __syncthreads(); krope_phase(P, Kb, RT, gtid, NTH); }
            if (REP6 & 4) { __syncthreads(); }
            if (REP6 & 8) { __syncthreads(); kvpost_phase(KVR, sskv, Kb, Vb, gtid, NTH); }
#endif
        } else if (NG(7) && ph == 7) {
            scan_final(LU, AGG, P, A2, gw, NGW, lane);
#ifdef REP7
            __syncthreads(); scan_final(LU, AGG, P, A2, gw, NGW, lane);
#endif
            const int upb = (NB * 8 * 16 + G - 1) / G, u0 = vcu * upb, u1 = min(NB * 8 * 16, u0 + upb);
            __syncthreads();
            for (int unit = u0; unit < u1; ++unit) { const int bh = unit >> 4, qb = unit & 15; attn_unit(lds, QR, ssq, RT, Kb, Vb, A2, bh >> 3, bh & 7, qb, tid, wave, lane); }
        } else if (NG(9) && ph == 9) {
            p7_rows(argp(0), argp(7), argp(8), outp, mod, Y, H2, gw, NGW, lane);
        } else if (NG(11) && (ph == 11 || ph == 14)) {
            convgate_phase(argp(24), argp(25), UP, Gb, ph == 14 ? 1 : 0, gtid, NTH);
        } else if (NG(16) && ph == 16) {
            p11_rows(argp(9), outp, mod, Fb, gw, NGW, lane);
        }
        __syncthreads();
#if MK_COOP
        if (ph + 1 < hi_ && ph != 3 && ph != 4 && ph != 12) {
            if (ph == 0) grid.sync();
            else { XcdBarrier xb; xb.bar = (unsigned*)(ws_ + WS_BAR); xb.x = xb_xcc_id(); xb.st = (volatile LAS unsigned*)(lds + LDS_MISC); xcd_barrier(xb); }
        }
#endif
        if (REPMASK) { if (((REPMASK >> ph) & 1) && !repeated) { repeated = true; --ph; } else repeated = false; }
    }
}

extern "C" void kernel_launch(void* const* d_in, const int* in_sizes, int n_in, void* d_out, int out_size, void* d_ws, size_t ws_size, hipStream_t stream) {
    static int grid = 0;
    if (grid == 0) {
        if (n_in != 27 || out_size != MLAT * DM || ws_size < WS_END) { fprintf(stderr, "kernel_launch: unexpected shapes (n_in %d, out %d, ws %zu)\n", n_in, out_size, ws_size); grid = -1; return; }
        int dev = 0, cus = 0, per_cu = 0;
        if (hipGetDevice(&dev) != hipSuccess || hipDeviceGetAttribute(&cus, hipDeviceAttributeMultiprocessorCount, dev) != hipSuccess) { grid = -1; return; }
        if (hipFuncSetAttribute((const void*)fwd_kernel, hipFuncAttributeMaxDynamicSharedMemorySize, LDS_BYTES) != hipSuccess) { fprintf(stderr, "kernel_launch: hipFuncSetAttribute failed\n"); grid = -1; return; }
        if (hipOccupancyMaxActiveBlocksPerMultiprocessor(&per_cu, (const void*)fwd_kernel, 512, LDS_BYTES) != hipSuccess || per_cu < 1) { fprintf(stderr, "kernel_launch: occupancy query says %d\n", per_cu); }
        (void)hipGetLastError();
        grid = cus;
    }
    if (grid < 0) return;
    (void)hipMemsetAsync((char*)d_ws + WS_CTL, 0, CTL_BYTES, stream);
    Args a{};
    for (int i = 0; i < 27; ++i) a.in[i] = (const float*)d_in[i];
    a.out = (float*)d_out; a.ws = (unsigned char*)d_ws;
#if MK_COOP
    a.ph_lo = 0; a.ph_hi = NPH;
    void* args[] = {&a};
    hipError_t e = hipLaunchCooperativeKernel((const void*)fwd_kernel, dim3(grid), dim3(512), args, LDS_BYTES, stream);
    if (e != hipSuccess) fprintf(stderr, "kernel_launch: cooperative launch failed: %s (grid %d)\n", hipGetErrorString(e), grid);
#else
    for (int p = 0; p < NPH; ++p) { a.ph_lo = p; a.ph_hi = p + 1; hipLaunchKernelGGL(fwd_kernel, dim3(grid), dim3(512), LDS_BYTES, stream, a); }
#endif
}
```

```cpp
#include <hip/hip_runtime.h>
#include <hip/hip_cooperative_groups.h>
#include <cstdio>
#include <cstdint>
namespace cg = cooperative_groups;
#ifndef MK_COOP
#define MK_COOP 1
#endif
namespace pg8 {
#define PG8_LAS __attribute__((address_space(3)))
typedef unsigned short bf16_t;
typedef short bf16x8 __attribute__((ext_vector_type(8)));
typedef float f32x4 __attribute__((ext_vector_type(4)));
typedef unsigned u32x4 __attribute__((ext_vector_type(4)));
constexpr int BM = 256, BK = 64, HALF = 128, HTB = HALF * BK * 2  , STAGE_BYTES = 8 * HTB, NXCD = 8, WGM = 8;

__host__ __device__ __forceinline__ int lds_byte(int r, int c) { const int st = (r >> 4) * 2 + (c >> 5), rr = r & 15, cc = c & 31, ob = rr * 64 + cc * 2; return st * 1024 + (ob ^ (((ob >> 9) & 1) << 5)); }
__host__ __device__ __forceinline__ void stage_rc(int b, int& R, int& C) { const int st = b / 1024, sb = b % 1024, swz = sb ^ (((sb >> 9) & 1) << 5); R = (st >> 1) * 16 + swz / 64; C = (st & 1) * 32 + (swz % 64) / 2; }
__host__ __device__ __forceinline__ int perm32(int rho) { const int n = rho >> 4, i = rho & 15; return 8 * (i >> 2) + 4 * n + (i & 3); }

struct Unit { int pm, pn; };
struct Gemm { const bf16_t* A; const bf16_t* Bt; int M, N, K, lda, ldb; };

struct StaticOrder {
    int nM, nN, nwg, G, c;
    __host__ __device__ void init(int M, int N, int G_, int c_) { nM = M / BM; nN = N / BM; nwg = nM * nN; G = G_; c = c_; }
    __host__ __device__ bool next(int i, Unit& u) const {
        const long L = (long)i * G + c; if (L >= nwg) return false;
        int wgid = (int)L; { const int q = nwg / NXCD, r = nwg % NXCD, xcd = wgid % NXCD, off = wgid / NXCD; wgid = (xcd < r ? xcd * (q + 1) : r * (q + 1) + (xcd - r) * q) + off; }
        const int nig = WGM * nN, gid = wgid / nig, fm = gid * WGM, gsz = (nM - fm) < WGM ? (nM - fm) : WGM;
        u.pm = fm + ((wgid % nig) % gsz); u.pn = (wgid % nig) / gsz; return true;
    }
    __device__ __forceinline__ void a_ready(const Unit&) const {}
    __device__ __forceinline__ void done(const Unit&) const {}
};

__device__ __forceinline__ unsigned cvt_pk_bf16(float lo, float hi) { unsigned r; asm volatile("v_cvt_pk_bf16_f32 %0, %1, %2" : "=v"(r) : "v"(lo), "v"(hi)); return r; }
typedef float f32x2 __attribute__((ext_vector_type(2)));
__device__ __forceinline__ f32x2 gelu_pk(f32x2 v) {
    const f32x2 av = __builtin_elementwise_abs(v), d = av * 0.2316418882f + 1.0f;
    f32x2 t; t.x = __builtin_amdgcn_rcpf(d.x); t.y = __builtin_amdgcn_rcpf(d.y);
    f32x2 q = t * 0.5307027145f + (-0.7265760135f); q = q * t + 0.7107068705f; q = q * t + (-0.142248368f); q = q * t + 0.127414796f; q = q * t;
    const f32x2 s = (v * v) * (-0.72134752044f);
    f32x2 e; e.x = __builtin_amdgcn_exp2f(s.x); e.y = __builtin_amdgcn_exp2f(s.y);
    const f32x2 m = v * (q * e), r = v - m;
    f32x2 o; o.x = v.x < 0.f ? m.x : r.x; o.y = v.y < 0.f ? m.y : r.y; return o;
}

template <int ACT  > struct EpiBf16 {
    static constexpr bool PERM = true, AFTER_DRAIN = false; static_assert(ACT == 0 || ACT == 1, "EpiBf16: ACT is 0 (none) or 1 (gelu_pk)");
    bf16_t* O; int ldc; const float* bias; int split_cols; size_t split_stride; float scale0;
    __device__ __forceinline__ void operator()(const f32x4 (&acc)[2][2][4][2], const Unit& u, int wr, int wc, int fr, int fq) const {
        const int row0 = u.pm * BM + wr * 64 + fr; int colt = u.pn * BM; bf16_t* base = O;
        float sc = 1.f; if (split_cols) { const int t = colt / split_cols; base += (size_t)t * split_stride; colt -= t * split_cols; if (t == 0) sc = scale0; }
        const int col0 = colt + wc * 32 + 8 * fq, bcol0 = u.pn * BM + wc * 32 + 8 * fq;
        f32x4 bv[2][2];
#pragma unroll
        for (int bj = 0; bj < 2; ++bj)
#pragma unroll
            for (int n = 0; n < 2; ++n) bv[bj][n] = bias ? *(const f32x4*)(bias + bcol0 + bj * HALF + 4 * n) : (f32x4){0.f, 0.f, 0.f, 0.f};
#pragma unroll
        for (int ai = 0; ai < 2; ++ai)
#pragma unroll
            for (int m = 0; m < 4; ++m) { bf16_t* rowp = base + (size_t)(row0 + ai * HALF + m * 16) * ldc + col0;
#pragma unroll
                for (int bj = 0; bj < 2; ++bj) { f32x4 v0 = acc[ai][bj][m][0] + bv[bj][0], v1 = acc[ai][bj][m][1] + bv[bj][1];
                    if (ACT == 1) { f32x2 a = gelu_pk((f32x2){v0[0], v0[1]}), b = gelu_pk((f32x2){v0[2], v0[3]}), c = gelu_pk((f32x2){v1[0], v1[1]}), d = gelu_pk((f32x2){v1[2], v1[3]});
                        v0 = (f32x4){a.x, a.y, b.x, b.y}; v1 = (f32x4){c.x, c.y, d.x, d.y}; }
                    v0 = v0 * sc; v1 = v1 * sc; u32x4 w; w.x = cvt_pk_bf16(v0[0], v0[1]); w.y = cvt_pk_bf16(v0[2], v0[3]); w.z = cvt_pk_bf16(v1[0], v1[1]); w.w = cvt_pk_bf16(v1[2], v1[3]);
                    *(__attribute__((address_space(1))) u32x4*)(rowp + bj * HALF) = w; } }
    }
};
template <class Epi, class Sched, bool ALIGN_EPI = false, bool SP2 = false>
__device__ __forceinline__ void gemm_phase(PG8_LAS unsigned char* lds, const Gemm g, const Sched& S, const Epi& E, const int tid) {
    const int wid = __builtin_amdgcn_readfirstlane(tid >> 6), lane = tid & 63, wr = wid >> 2, wc = wid & 3, fr = lane & 15, fq = lane >> 4;
    const int K = g.K, nt = K / BK;
    unsigned voffA[2], voffB[2];
#pragma unroll
    for (int i = 0; i < 2; ++i) { int R, C; stage_rc(tid * 16 + i * 8192, R, C); const int Rb = Epi::PERM ? ((R & ~31) + perm32(R & 31)) : R;
        voffA[i] = (unsigned)(R * g.lda + C) * 2u; voffB[i] = (unsigned)(Rb * g.ldb + C) * 2u; }
    const size_t kstep = (size_t)(BK * 2);
    const size_t hstepA = (size_t)HALF * g.lda * 2, hstepB = (size_t)HALF * g.ldb * 2;
    const size_t tstepA = 2 * hstepA, tstepB = 2 * hstepB;
    const unsigned ldsw = (unsigned)wid * 1024u;
    const int aoff = lds_byte(wr * 64 + fr, fq * 8), boff = lds_byte(wc * 32 + fr, fq * 8);
#define PG8_SA(b, h) (((b) * 2 + (h)) * HTB)
#define PG8_SB(b, h) ((4 + (b) * 2 + (h)) * HTB)
#define PG8_STAGE(bufoff, gbase, voff) do { _Pragma("unroll") for (int _i = 0; _i < 2; ++_i) \
        __builtin_amdgcn_global_load_lds((const unsigned*)((const char*)(gbase) + (voff)[_i]), (PG8_LAS unsigned*)(lds + (bufoff) + ldsw + _i * 8192), 16, 0, 0); } while (0)
#define PG8_LDA(dst, b, h) do { _Pragma("unroll") for (int m = 0; m < 4; ++m) _Pragma("unroll") for (int k = 0; k < 2; ++k) dst[m][k] = *(const PG8_LAS bf16x8*)(lds + PG8_SA(b, h) + aoff + m * 2048 + k * 1024); } while (0)
#define PG8_LDB(dst, b, h) do { _Pragma("unroll") for (int n = 0; n < 2; ++n) _Pragma("unroll") for (int k = 0; k < 2; ++k) dst[n][k] = *(const PG8_LAS bf16x8*)(lds + PG8_SB(b, h) + boff + n * 2048 + k * 1024); } while (0)
#define PG8_MMA(ai, bj, At, Bt) do { __builtin_amdgcn_s_setprio(1); _Pragma("unroll") for (int m = 0; m < 4; ++m) _Pragma("unroll") for (int n = 0; n < 2; ++n) _Pragma("unroll") for (int k = 0; k < 2; ++k) \
        acc[ai][bj][m][n] = __builtin_amdgcn_mfma_f32_16x16x32_bf16(Bt[n][k], At[m][k], acc[ai][bj][m][n], 0, 0, 0); __builtin_amdgcn_s_setprio(0); } while (0)
#define PG8_WAIT_V(n) asm volatile("s_waitcnt vmcnt(" #n ")" ::: "memory")
#define PG8_WAIT_L(n) asm volatile("s_waitcnt lgkmcnt(" #n ")" ::: "memory")
#define PG8_BAR __builtin_amdgcn_s_barrier()
#define PG8_SCHED __builtin_amdgcn_sched_barrier(0)
    Unit cur, nxt; int ui = 0;
    if (!S.next(0, cur)) return;
    f32x4 acc[2][2][4][2];
#pragma unroll
    for (int a = 0; a < 2; ++a)
#pragma unroll
        for (int b = 0; b < 2; ++b)
#pragma unroll
            for (int m = 0; m < 4; ++m)
#pragma unroll
                for (int n = 0; n < 2; ++n) acc[a][b][m][n] = (f32x4){0.f, 0.f, 0.f, 0.f};
    bf16x8 At[4][2], B0[2][2], B1[2][2];
    const char* cA = (const char*)g.A + (size_t)cur.pm * tstepA; const char* cB = (const char*)g.Bt + (size_t)cur.pn * tstepB;
    S.a_ready(cur);
    if constexpr (SP2) {
        PG8_STAGE(PG8_SB(0, 0), cB, voffB); PG8_STAGE(PG8_SB(0, 1), cB + hstepB, voffB); PG8_STAGE(PG8_SA(0, 0), cA, voffA); PG8_STAGE(PG8_SA(0, 1), cA + hstepA, voffA);
        if (wr == 1) PG8_BAR;
        PG8_WAIT_V(2); PG8_BAR;
        PG8_STAGE(PG8_SB(1, 0), cB + kstep, voffB); PG8_STAGE(PG8_SA(1, 0), cA + kstep, voffA); PG8_STAGE(PG8_SB(1, 1), cB + hstepB + kstep, voffB);
        PG8_WAIT_V(6); PG8_BAR;
    } else {
        PG8_STAGE(PG8_SB(0, 0), cB, voffB); PG8_STAGE(PG8_SA(0, 0), cA, voffA); PG8_STAGE(PG8_SB(0, 1), cB + hstepB, voffB); PG8_STAGE(PG8_SA(0, 1), cA + hstepA, voffA);
        if (wr == 1) PG8_BAR;
        PG8_WAIT_V(4); PG8_BAR;
        PG8_STAGE(PG8_SB(1, 0), cB + kstep, voffB); PG8_STAGE(PG8_SA(1, 0), cA + kstep, voffA); PG8_STAGE(PG8_SB(1, 1), cB + hstepB + kstep, voffB);
        PG8_WAIT_V(6); PG8_BAR;
    }
    for (;;) {
        const bool has_next = S.next(ui + 1, nxt);
        const char* nA = has_next ? (const char*)g.A + (size_t)nxt.pm * tstepA : cA; const char* nB = has_next ? (const char*)g.Bt + (size_t)nxt.pn * tstepB : cB;
        for (int t = 0; t < nt; t += 2) {
            const bool last = (t == nt - 2);
            const char* a1 = cA + (size_t)(t + 1) * kstep;
            const char* a2 = last ? nA : cA + (size_t)(t + 2) * kstep; const char* b2 = last ? nB : cB + (size_t)(t + 2) * kstep;
            const char* a3 = a2 + kstep; const char* b3 = b2 + kstep;
            if (last && has_next) S.a_ready(nxt);
            if constexpr (SP2) {
            PG8_LDB(B0, 0, 0); PG8_LDB(B1, 0, 1); PG8_SCHED; PG8_LDA(At, 0, 0); PG8_STAGE(PG8_SA(1, 1), a1 + hstepA, voffA);
            PG8_WAIT_V(8); PG8_WAIT_L(0); PG8_BAR; PG8_MMA(0, 0, At, B0); PG8_MMA(0, 1, At, B1); PG8_BAR; PG8_SCHED;
            PG8_LDA(At, 0, 1); PG8_STAGE(PG8_SB(0, 0), b2, voffB); PG8_STAGE(PG8_SB(0, 1), b2 + hstepB, voffB); PG8_STAGE(PG8_SA(0, 0), a2, voffA);
            PG8_WAIT_V(8); PG8_WAIT_L(0); PG8_BAR; PG8_MMA(1, 0, At, B0); PG8_MMA(1, 1, At, B1); PG8_BAR; PG8_SCHED;
            PG8_LDB(B0, 1, 0); PG8_LDB(B1, 1, 1); PG8_SCHED; PG8_LDA(At, 1, 0); PG8_STAGE(PG8_SA(0, 1), a2 + hstepA, voffA);
            PG8_WAIT_V(8); PG8_WAIT_L(0); PG8_BAR; PG8_MMA(0, 0, At, B0); PG8_MMA(0, 1, At, B1); PG8_BAR; PG8_SCHED;
            PG8_LDA(At, 1, 1); PG8_STAGE(PG8_SB(1, 0), b3, voffB); PG8_STAGE(PG8_SB(1, 1), b3 + hstepB, voffB); PG8_STAGE(PG8_SA(1, 0), a3, voffA);
            PG8_WAIT_V(8); PG8_WAIT_L(0); PG8_BAR; PG8_MMA(1, 0, At, B0); PG8_MMA(1, 1, At, B1); PG8_BAR; PG8_SCHED;
            } else {
            PG8_LDB(B0, 0, 0); PG8_SCHED; PG8_LDA(At, 0, 0); PG8_STAGE(PG8_SA(1, 1), a1 + hstepA, voffA);
            PG8_WAIT_L(8); PG8_BAR; PG8_WAIT_L(0); PG8_MMA(0, 0, At, B0); PG8_BAR; PG8_SCHED;
            PG8_LDB(B1, 0, 1); PG8_STAGE(PG8_SB(0, 0), b2, voffB);
            PG8_BAR; PG8_WAIT_L(0); PG8_MMA(0, 1, At, B1); PG8_BAR;
            PG8_LDA(At, 0, 1); PG8_STAGE(PG8_SA(0, 0), a2, voffA);
            PG8_BAR; PG8_WAIT_L(0); PG8_MMA(1, 0, At, B0); PG8_BAR; PG8_SCHED;
            PG8_STAGE(PG8_SB(0, 1), b2 + hstepB, voffB);
            PG8_WAIT_V(6); PG8_BAR; PG8_MMA(1, 1, At, B1); PG8_BAR;
            PG8_LDB(B0, 1, 0); PG8_SCHED; PG8_LDA(At, 1, 0); PG8_STAGE(PG8_SA(0, 1), a2 + hstepA, voffA);
            PG8_WAIT_L(8); PG8_BAR; PG8_WAIT_L(0); PG8_MMA(0, 0, At, B0); PG8_BAR; PG8_SCHED;
            PG8_LDB(B1, 1, 1); PG8_STAGE(PG8_SB(1, 0), b3, voffB);
            PG8_BAR; PG8_WAIT_L(0); PG8_MMA(0, 1, At, B1); PG8_BAR;
            PG8_LDA(At, 1, 1); PG8_STAGE(PG8_SA(1, 0), a3, voffA);
            PG8_BAR; PG8_WAIT_L(0); PG8_MMA(1, 0, At, B0); PG8_BAR; PG8_SCHED;
            PG8_STAGE(PG8_SB(1, 1), b3 + hstepB, voffB);
            PG8_WAIT_V(6); PG8_BAR; PG8_MMA(1, 1, At, B1); PG8_BAR;
            }
        }
        if constexpr (ALIGN_EPI) { if (wr == 0) PG8_BAR; }
        if constexpr (!Epi::AFTER_DRAIN) { E(acc, cur, wr, wc, fr, fq); S.done(cur); }
        if (!has_next) break;
#pragma unroll
        for (int a = 0; a < 2; ++a)
#pragma unroll
            for (int b = 0; b < 2; ++b)
#pragma unroll
                for (int m = 0; m < 4; ++m)
#pragma unroll
                    for (int n = 0; n < 2; ++n) acc[a][b][m][n] = (f32x4){0.f, 0.f, 0.f, 0.f};
        cur = nxt; cA = nA; cB = nB; ++ui;
        if constexpr (ALIGN_EPI) { if (wr == 1) PG8_BAR; }
    }
    PG8_WAIT_V(0);
    if constexpr (!ALIGN_EPI) { if (wr == 0) PG8_BAR; }
    PG8_BAR;
    if constexpr (Epi::AFTER_DRAIN) { E.fused(acc, cur, wr, wc, fr, fq, lds, wid, lane); S.done(cur); }
#undef PG8_SA
#undef PG8_SB
#undef PG8_STAGE
#undef PG8_LDA
#undef PG8_LDB
#undef PG8_MMA
#undef PG8_WAIT_V
#undef PG8_WAIT_L
#undef PG8_BAR
#undef PG8_SCHED
}
}
#define LAS __attribute__((address_space(3)))
#define GAS __attribute__((address_space(1)))
typedef unsigned short bf16_t;
typedef short bf16x8 __attribute__((ext_vector_type(8)));
typedef short s16x4 __attribute__((ext_vector_type(4)));
typedef float f32x4 __attribute__((ext_vector_type(4)));
typedef float f32x16 __attribute__((ext_vector_type(16)));
typedef unsigned u32x4 __attribute__((ext_vector_type(4)));
typedef unsigned u32x2 __attribute__((ext_vector_type(2)));
typedef float f32x2 __attribute__((ext_vector_type(2)));

constexpr int NB = 8, SEQ = 8192, DM = 1024, CTX = 256, MLAT = NB * SEQ, MCTX = NB * CTX, MALL = MLAT + MCTX;
constexpr int PW = 1536, KVLEN = CTX + SEQ, DFF = 2816, NMOD = 6 * DM;
constexpr int NCH = 32, CHL = 256;
constexpr float EPS = 1e-6f;
constexpr float QSCALE = 0.10206207261596575f * 1.4426950408889634f;
constexpr size_t MiB = 1u << 20;
constexpr size_t WS_CTL = 0, CTL_BYTES = 2 * MiB;
constexpr size_t WS_MOD = 64 * 1024, WS_SSQ = 512 * 1024, WS_SSKV = 1024 * 1024, WS_BAR = 1600 * 1024;
constexpr size_t WS_WIN = 2 * MiB, WS_WQ = 5 * MiB, WS_WKV = 6 * MiB, WS_WG = 7 * MiB, WS_WOUT = 8 * MiB, WS_WUP = 10 * MiB, WS_WDN = 21 * MiB;
constexpr size_t WS_AGG = 27 * MiB, WS_ROPE = 29 * MiB + 512 * 1024;
constexpr size_t WS_R1 = 30 * MiB;
constexpr size_t WS_R2 = 162 * MiB;
constexpr size_t WS_LU = 360 * MiB, WS_K = 624 * MiB, WS_V = 723 * MiB, WS_A2 = 789 * MiB;
constexpr size_t WS_UP = 360 * MiB, WS_G = 712 * MiB, WS_Q = 920 * MiB, WS_END = 1016 * MiB;
constexpr int LDS_BYTES = 139264;
constexpr int LDS_MISC = 131072 + 64;

__device__ __forceinline__ unsigned f2bf(float f) { unsigned u = __builtin_bit_cast(unsigned, f); return (u + 0x7fffu + ((u >> 16) & 1u)) >> 16; }
__device__ __forceinline__ unsigned cvtpk(float lo, float hi) { typedef float f2 __attribute__((ext_vector_type(2))); typedef __bf16 b2 __attribute__((ext_vector_type(2))); f2 v = {lo, hi}; b2 r = __builtin_convertvector(v, b2); return __builtin_bit_cast(unsigned, r); }
__device__ __forceinline__ unsigned pk2(float lo, float hi) { return cvtpk(lo, hi); }
__device__ __forceinline__ float bflo(unsigned w) { return __uint_as_float(w << 16); }
__device__ __forceinline__ float bfhi(unsigned w) { return __uint_as_float(w & 0xffff0000u); }
__device__ __forceinline__ float bf2f(bf16_t v) { return __uint_as_float((unsigned)v << 16); }
__device__ __forceinline__ int crow(int r, int hi) { return (r & 3) + 8 * (r >> 2) + 4 * hi; }
__device__ __forceinline__ float wave_sum(float v) {
#pragma unroll
    for (int o = 1; o < 64; o <<= 1) v += __shfl_xor(v, o);
    return v;
}
__device__ __forceinline__ float sigmoidf_(float x) { return __builtin_amdgcn_rcpf(1.f + __builtin_amdgcn_exp2f(-1.4426950408889634f * x)); }
#define LDS_WAIT() asm volatile("s_waitcnt lgkmcnt(0)" ::: "memory")
#define XB_TMO      128
#define XB_XCNT(j)  (256  + 64 * (j))
#define XB_XSUB(j)  (1280 + 64 * (j))
#define XB_XGEN(j)  (2304 + 64 * (j))
#define XB_TOP      3328
#define XB_TOPGEN   3392
#define XCD_BAR_WORDS 3456
#define XB_SPIN_CAP (1u << 18)

__device__ __forceinline__ unsigned xb_ld(unsigned* p)              { return __hip_atomic_load(p, __ATOMIC_RELAXED, __HIP_MEMORY_SCOPE_AGENT); }
__device__ __forceinline__ unsigned xb_add(unsigned* p, unsigned v) { return __hip_atomic_fetch_add(p, v, __ATOMIC_RELAXED, __HIP_MEMORY_SCOPE_AGENT); }
__device__ __forceinline__ unsigned xb_xcc_id() { return (unsigned)__builtin_amdgcn_s_getreg((3 << 11) | 20) & 0xFu; }
#define XB_SPIN(cond, bar) do { unsigned _sp = 0; while (cond) { __builtin_amdgcn_s_sleep(1); \
    if ((++_sp & 255u) == 0u) { if (xb_ld(&(bar)[XB_TMO])) break; if (_sp > XB_SPIN_CAP) { atomicAdd(&(bar)[XB_TMO], 1u); break; } } } } while (0)

struct XcdBarrier {
    unsigned* bar; unsigned x;
    volatile LAS unsigned* st;
};

__device__ __forceinline__ XcdBarrier xcd_barrier_post(unsigned* bar, volatile LAS unsigned* st) {
    XcdBarrier b; b.bar = bar; b.x = xb_xcc_id(); b.st = st;
    if (threadIdx.x == 0) (void)xb_add(&bar[XB_XCNT(b.x)], 1u);
    return b;
}
__device__ __forceinline__ void xcd_barrier_complete(unsigned* bar, unsigned x, unsigned& nloc, unsigned& nx) {
    const unsigned G = gridDim.x * gridDim.y * gridDim.z;
    unsigned sum, cnt, mine, sp = 0u;
    for (;;) {
        sum = 0u; cnt = 0u; mine = 0u;
#pragma unroll
        for (unsigned j = 0; j < 16; ++j) { const unsigned c = xb_ld(&bar[XB_XCNT(j)]); sum += c; cnt += (c > 0u) ? 1u : 0u; mine = (j == x) ? c : mine; }
        if (sum == G) break;
        __builtin_amdgcn_s_sleep(1);
        if ((++sp & 255u) == 0u) { if (xb_ld(&bar[XB_TMO])) break; if (sp > XB_SPIN_CAP) { atomicAdd(&bar[XB_TMO], 1u); break; } }
    }
    nloc = mine > 0u ? mine : 1u; nx = cnt > 0u ? cnt : 1u;
}

__device__ __forceinline__ void xcd_barrier(const XcdBarrier& b) {
    asm volatile("s_waitcnt vmcnt(0)" ::: "memory");
    __syncthreads();
    if (threadIdx.x == 0) {
        unsigned* bar = b.bar;
        __builtin_amdgcn_s_waitcnt(0);
        unsigned nloc = b.st[0], nx = b.st[1];
        if (nloc == 0u) { xcd_barrier_complete(bar, b.x, nloc, nx); b.st[0] = nloc; b.st[1] = nx; }
        const unsigned old = xb_add(&bar[XB_XSUB(b.x)], 1u);
        const unsigned gen = old / nloc;
        if (old + 1u == (gen + 1u) * nloc) {
            __builtin_amdgcn_fence(__ATOMIC_RELEASE, "agent");
            asm volatile("s_waitcnt vmcnt(0)" ::: "memory");
            const unsigned og = xb_add(&bar[XB_TOP], 1u);
            const unsigned tg = og / nx;
            if (og + 1u == (tg + 1u) * nx) xb_add(&bar[XB_TOPGEN], 1u);
            else XB_SPIN(xb_ld(&bar[XB_TOPGEN]) == tg, bar);
            __builtin_amdgcn_fence(__ATOMIC_ACQUIRE, "agent");
            xb_add(&bar[XB_XGEN(b.x)], 1u);
            asm volatile("s_waitcnt vmcnt(0)" ::: "memory");
        } else {
            XB_SPIN(xb_ld(&bar[XB_XGEN(b.x)]) == gen, bar);
            __builtin_amdgcn_fence(__ATOMIC_ACQUIRE, "agent");
            asm volatile("s_waitcnt vmcnt(0)" ::: "memory");
        }
    }
    __syncthreads();
}


struct Args { const float* in[27]; float* out; unsigned char* ws; int ph_lo, ph_hi; };
__device__ __forceinline__ const GAS float* argp(int i) {
    const __attribute__((address_space(4))) char* kp = (const __attribute__((address_space(4))) char*)__builtin_amdgcn_kernarg_segment_ptr();
    asm volatile("" : "+s"(kp));
    const float* p = *(const float* const __attribute__((address_space(4)))*)(kp + 8 * i);
    return (const GAS float*)p;
}

template <int ID> __device__ __forceinline__ float wsrc(const GAS float* __restrict__ p0, const GAS float* __restrict__ p1, int n, int k) {
    if (ID == 0) return n < 1440 ? p0[(size_t)k * 1440 + n] : 0.f;
    if (ID == 1) return p0[k] * p1[(size_t)k * 768 + n];
    if (ID == 2) return k < 128 ? p0[k] * p1[(size_t)k * 1024 + n] : 0.f;
    if (ID == 3) { const int h = n >> 8, np = n & 255, mat = np >> 6, j = np & 63, dir = mat >> 1; const GAS float* w = (mat & 1) ? p1 : p0; return w[(size_t)((dir * 8 + h) * 64 + k) * 64 + j]; }
    if (ID == 4) return p0[(size_t)k * 1024 + n];
    if (ID == 5) return p0[(size_t)k * 5632 + n];
    return p0[(size_t)k * 1024 + n];
}
template <int ID> __device__ __forceinline__ void prep_mat(const GAS float* __restrict__ p0, const GAS float* __restrict__ p1, GAS bf16_t* __restrict__ dst, int N, int K, int gtid, int NT) {
    const int items = N * (K / 8);
    for (int it = gtid; it < items; it += NT) {
        const int n = it % N, k8 = it / N;
        u32x4 o;
        o.x = pk2(wsrc<ID>(p0, p1, n, 8 * k8 + 0), wsrc<ID>(p0, p1, n, 8 * k8 + 1)); o.y = pk2(wsrc<ID>(p0, p1, n, 8 * k8 + 2), wsrc<ID>(p0, p1, n, 8 * k8 + 3));
        o.z = pk2(wsrc<ID>(p0, p1, n, 8 * k8 + 4), wsrc<ID>(p0, p1, n, 8 * k8 + 5)); o.w = pk2(wsrc<ID>(p0, p1, n, 8 * k8 + 6), wsrc<ID>(p0, p1, n, 8 * k8 + 7));
        *(GAS u32x4*)(dst + (size_t)n * K + 8 * k8) = o;
    }
}
__device__ __forceinline__ void mod_phase(const GAS float* __restrict__ cvec, const GAS float* __restrict__ cctx, const GAS float* __restrict__ wmod, const GAS float* __restrict__ bmod, GAS float* __restrict__ mod, LAS float* scr, int gw, int NGW, int lane) {
    for (int task = gw; task < 96 * 16; task += NGW) {
        const int cgp = task % 96, kc = task / 96, n = cgp * 64 + lane, k0 = kc * 64;
#pragma unroll
        for (int r = 0; r < 9; ++r) { const float cv = r < 8 ? cvec[r * 1024 + k0 + lane] : cctx[k0 + lane]; scr[r * 64 + lane] = cv / (1.f + __expf(-cv)); }
        LDS_WAIT();
        float acc[9];
#pragma unroll
        for (int r = 0; r < 9; ++r) acc[r] = 0.f;
#pragma unroll 8
        for (int kk = 0; kk < 64; ++kk) { const float w = wmod[(size_t)(k0 + kk) * NMOD + n];
#pragma unroll
            for (int r = 0; r < 9; ++r) acc[r] += scr[r * 64 + kk] * w; }
        const float bias = kc == 0 ? bmod[n] : 0.f;
#pragma unroll
        for (int r = 0; r < 9; ++r) atomicAdd((float*)(mod + r * NMOD + n), acc[r] + bias);
        LDS_WAIT();
    }
}
__device__ __forceinline__ void p1_rows(const GAS float* __restrict__ x, const GAS float* __restrict__ ctx, const GAS float* __restrict__ g, const GAS float* __restrict__ mod, GAS bf16_t* __restrict__ H, int gw, int NGW, int lane) {
    for (int m0 = 2 * gw; m0 < MALL; m0 += 2 * NGW) {
        f32x4 v[2][4]; float ss[2];
#pragma unroll
        for (int r = 0; r < 2; ++r) { const int m = m0 + r; const GAS float* src = m < MLAT ? x + (size_t)m * DM : ctx + (size_t)(m - MLAT) * DM; ss[r] = 0.f;
#pragma unroll
            for (int j = 0; j < 4; ++j) { v[r][j] = *(const GAS f32x4*)(src + 4 * lane + 256 * j); ss[r] += v[r][j].x * v[r][j].x + v[r][j].y * v[r][j].y + v[r][j].z * v[r][j].z + v[r][j].w * v[r][j].w; } }
#pragma unroll
        for (int r = 0; r < 2; ++r) { const int m = m0 + r; const GAS float* md = mod + (m < MLAT ? (m >> 13) : 8) * NMOD;
            const float rs = rsqrtf(wave_sum(ss[r]) * (1.f / DM) + EPS);
#pragma unroll
            for (int j = 0; j < 4; ++j) { const int k = 4 * lane + 256 * j;
                const f32x4 gg = *(const GAS f32x4*)(g + k), sh = *(const GAS f32x4*)(md + k), sc = *(const GAS f32x4*)(md + DM + k);
                const f32x4 y = v[r][j] * rs * gg * (sc + 1.f) + sh;
                u32x2 o; o.x = pk2(y.x, y.y); o.y = pk2(y.z, y.w); *(GAS u32x2*)(H + (size_t)m * DM + k) = o; } }
    }
}
__device__ __forceinline__ void ss_phase(const GAS bf16_t* __restrict__ P, GAS float* __restrict__ ssq, GAS float* __restrict__ sskv, int gw, int NGW, int lane) {
#pragma unroll 4
    for (int m = gw; m < MALL; m += NGW) {
        const u32x2 q = *(const GAS u32x2*)(P + (size_t)m * PW + 1024 + 4 * lane); const unsigned k = *(const GAS unsigned*)(P + (size_t)m * PW + 1280 + 2 * lane);
        float a = bflo(q.x) * bflo(q.x) + bfhi(q.x) * bfhi(q.x) + bflo(q.y) * bflo(q.y) + bfhi(q.y) * bfhi(q.y), c = bflo(k) * bflo(k) + bfhi(k) * bfhi(k);
        a = wave_sum(a); c = wave_sum(c);
        if (lane == 0) { ssq[m] = a; sskv[m] = c; }
    }
}
__device__ __forceinline__ void qpost_phase(const GAS bf16_t* __restrict__ QR, const GAS float* __restrict__ ssq, const GAS float* __restrict__ RT, GAS bf16_t* __restrict__ Q, int gtid, int NT) {
#pragma unroll 4
    for (int task = gtid; task < MLAT * 96; task += NT) {
        const int row = task / 96, c8 = task - row * 96, h = c8 / 12, dc = c8 - h * 12, b = row >> 13, s = row & 8191;
        const float sc = rsqrtf(ssq[row] * (1.f / 256.f) + EPS) * QSCALE;
        const u32x4 mine = *(const GAS u32x4*)(QR + (size_t)row * 768 + 8 * c8);
        float v[8];
#pragma unroll
        for (int j = 0; j < 4; ++j) { v[2 * j] = bflo(mine[j]) * sc; v[2 * j + 1] = bfhi(mine[j]) * sc; }
        if (dc >= 8) { const int fq = dc - 8; const u32x4 oth = *(const GAS u32x4*)(QR + (size_t)row * 768 + 8 * (c8 ^ 1));
            const GAS float* rt = RT + (fq < 2 ? (s >> 6) : (s & 63)) * 16;
#pragma unroll
            for (int j = 0; j < 8; ++j) { const float pt = ((j & 1) ? bfhi(oth[j >> 1]) : bflo(oth[j >> 1])) * sc, cs = rt[2 * j], sn = rt[2 * j + 1];
                v[j] = (fq & 1) ? v[j] * cs + pt * sn : v[j] * cs - pt * sn; } }
        u32x4 w; w.x = pk2(v[0], v[1]); w.y = pk2(v[2], v[3]); w.z = pk2(v[4], v[5]); w.w = pk2(v[6], v[7]);
        *(GAS u32x4*)(Q + ((size_t)((b * 8 + h) * SEQ + s)) * 96 + 8 * dc) = w;
    }
}
__device__ __forceinline__ void kvpost_phase(const GAS bf16_t* __restrict__ KVR, const GAS float* __restrict__ sskv, GAS bf16_t* __restrict__ Kb, GAS bf16_t* __restrict__ Vt, int gtid, int NT) {
#pragma unroll 4
    for (int task = gtid; task < MALL * 64; task += NT) {
        const int row = task >> 6, c = task & 63, h = c >> 3, dd = (c & 7) * 8; const bool lat = row < MLAT;
        const int b = lat ? (row >> 13) : ((row - MLAT) >> 8), pos = lat ? (CTX + (row & 8191)) : ((row - MLAT) & 255);
        const float rs = rsqrtf(sskv[row] * (1.f / 128.f) + EPS);
        const u32x4 mine = *(const GAS u32x4*)(KVR + (size_t)row * 1024 + h * 128 + dd);
        u32x4 w;
#pragma unroll
        for (int j = 0; j < 4; ++j) w[j] = pk2(bflo(mine[j]) * rs, bfhi(mine[j]) * rs);
        *(GAS u32x4*)(Kb + ((size_t)(b * 8 + h) * KVLEN + pos) * 96 + dd) = w;
    }
#pragma unroll 2
    for (int task = gtid; task < (MALL / 8) * 128; task += NT) {
        const int pg = task & 7, dq = (task >> 3) & 7, rest = task >> 6, hd32 = rest & 15, rb = rest >> 4, h = hd32 >> 1, d = (hd32 & 1) * 32 + 4 * dq, row0 = rb * 64 + pg * 8; const bool lat = row0 < MLAT;
        const int b = lat ? (row0 >> 13) : ((row0 - MLAT) >> 8), pos0 = lat ? (CTX + (row0 & 8191)) : ((row0 - MLAT) & 255);
        float v[4][8];
#pragma unroll
        for (int i = 0; i < 8; ++i) { const u32x2 w = *(const GAS u32x2*)(KVR + (size_t)(row0 + i) * 1024 + h * 128 + 64 + d); const float rs = rsqrtf(sskv[row0 + i] * (1.f / 128.f) + EPS);
            v[0][i] = bflo(w.x) * rs; v[1][i] = bfhi(w.x) * rs; v[2][i] = bflo(w.y) * rs; v[3][i] = bfhi(w.y) * rs; }
        GAS bf16_t* vp = Vt + ((size_t)((b * 8 + h) * 64 + d)) * KVLEN + pos0;
#pragma unroll
        for (int j = 0; j < 4; ++j) { u32x4 w; w.x = pk2(v[j][0], v[j][1]); w.y = pk2(v[j][2], v[j][3]); w.z = pk2(v[j][4], v[j][5]); w.w = pk2(v[j][6], v[j][7]);
            *(GAS u32x4*)(vp + (size_t)j * KVLEN) = w; }
    }
}
__device__ __forceinline__ void krope_phase(const GAS bf16_t* __restrict__ P, GAS bf16_t* __restrict__ Kb, const GAS float* __restrict__ RT, int gtid, int NT) {
#pragma unroll 2
    for (int task = gtid; task < MALL * 4; task += NT) {
        const int row = task >> 2, fq = task & 3; const bool lat = row < MLAT;
        const int b = lat ? (row >> 13) : ((row - MLAT) >> 8), s = row & 8191, pos = lat ? (CTX + s) : ((row - MLAT) & 255);
        const u32x4 mine = *(const GAS u32x4*)(P + (size_t)row * PW + 1408 + 8 * fq), oth = *(const GAS u32x4*)(P + (size_t)row * PW + 1408 + 8 * (fq ^ 1));
        float v[8], pt[8];
#pragma unroll
        for (int j = 0; j < 4; ++j) { v[2 * j] = bflo(mine[j]); v[2 * j + 1] = bfhi(mine[j]); pt[2 * j] = bflo(oth[j]); pt[2 * j + 1] = bfhi(oth[j]); }
        if (lat) { const GAS float* rt = RT + (fq < 2 ? (s >> 6) : (s & 63)) * 16;
#pragma unroll
            for (int j = 0; j < 8; ++j) { const float cs = rt[2 * j], sn = rt[2 * j + 1]; v[j] = (fq & 1) ? v[j] * cs + pt[j] * sn : v[j] * cs - pt[j] * sn; } }
        u32x4 w; w.x = pk2(v[0], v[1]); w.y = pk2(v[2], v[3]); w.z = pk2(v[4], v[5]); w.w = pk2(v[6], v[7]);
#pragma unroll
        for (int h = 0; h < 8; ++h) *(GAS u32x4*)(Kb + ((size_t)(b * 8 + h) * KVLEN + pos) * 96 + 64 + 8 * fq) = w;
    }
}
#define MFMA32(a, b, c) __builtin_amdgcn_mfma_f32_32x32x16_bf16((a), (b), (c), 0, 0, 0)
__device__ __forceinline__ void gates_phase(const GAS float* __restrict__ cw, const GAS float* __restrict__ cb, const GAS float* __restrict__ b_a, const GAS float* __restrict__ b_x, const GAS float* __restrict__ lam, LAS unsigned char* lds, const GAS bf16_t* __restrict__ P, const GAS bf16_t* __restrict__ Wg, GAS unsigned* __restrict__ LU, GAS f32x2* __restrict__ AGG, int tid, int wave, int lane) {
    LAS bf16_t* xs = (LAS bf16_t*)(lds + wave * 4608);
    LAS f32x2* wagg = (LAS f32x2*)(lds + 8 * 4608);
    const int r32 = lane & 31, hi = lane >> 5;
    for (int unit = blockIdx.x; unit < (MALL / 256) * 8; unit += gridDim.x) {
        const int pm = unit >> 3, h = unit & 7, m0 = pm * 256 + wave * 32;
        const int s0 = m0 < MLAT ? (m0 & ~8191) : (MLAT + ((m0 - MLAT) & ~255)), slen = m0 < MLAT ? SEQ : CTX;
        {
            const int tok = lane >> 1, m = m0 + tok;
#pragma unroll
            for (int c8 = 0; c8 < 4; ++c8) { const int ch = (lane & 1) * 32 + c8 * 8, gch = h * 64 + ch;
                float acc[8];
                { const f32x4 b0 = *(const GAS f32x4*)(cb + gch), b1 = *(const GAS f32x4*)(cb + gch + 4);
                  acc[0] = b0.x; acc[1] = b0.y; acc[2] = b0.z; acc[3] = b0.w; acc[4] = b1.x; acc[5] = b1.y; acc[6] = b1.z; acc[7] = b1.w; }
#pragma unroll
                for (int k = 0; k < 4; ++k) { const int mm = m + k - 2;
                    if (mm >= s0 && mm < s0 + slen) { const u32x4 xv = *(const GAS u32x4*)(P + (size_t)mm * PW + gch);
                        const f32x4 w0 = *(const GAS f32x4*)(cw + k * 512 + gch), w1 = *(const GAS f32x4*)(cw + k * 512 + gch + 4);
                        acc[0] += w0.x * bflo(xv.x); acc[1] += w0.y * bfhi(xv.x); acc[2] += w0.z * bflo(xv.y); acc[3] += w0.w * bfhi(xv.y);
                        acc[4] += w1.x * bflo(xv.z); acc[5] += w1.y * bfhi(xv.z); acc[6] += w1.z * bflo(xv.w); acc[7] += w1.w * bfhi(xv.w); } }
                u32x4 o; o.x = pk2(acc[0], acc[1]); o.y = pk2(acc[2], acc[3]); o.z = pk2(acc[4], acc[5]); o.w = pk2(acc[6], acc[7]);
                *(LAS u32x4*)(xs + tok * 72 + ch) = o; }
        }
        LDS_WAIT();
        bf16x8 afr[4];
#pragma unroll
        for (int ks = 0; ks < 4; ++ks) afr[ks] = *(const LAS bf16x8*)(xs + r32 * 72 + 16 * ks + 8 * hi);
#pragma unroll
        for (int jh = 0; jh < 2; ++jh) {
            f32x16 acc4[4];
#pragma unroll
            for (int q = 0; q < 4; ++q) {
#pragma unroll
                for (int i = 0; i < 16; ++i) acc4[q][i] = 0.f;
                const GAS bf16_t* wrow = Wg + (size_t)(h * 256 + (2 * q + jh) * 32 + r32) * 64 + 8 * hi;
#pragma unroll
                for (int ks = 0; ks < 4; ++ks) { const bf16x8 bfr = *(const GAS bf16x8*)(wrow + 16 * ks); acc4[q] = MFMA32(afr[ks], bfr, acc4[q]); }
            }
            const int ch = jh * 32 + r32, gch = h * 64 + ch;
            float ba[2], bx[2], sp[2];
#pragma unroll
            for (int d = 0; d < 2; ++d) { ba[d] = b_a[d * 512 + gch]; bx[d] = b_x[d * 512 + gch]; sp[d] = lam[d * 512 + gch]; }
            unsigned wv[16][2]; float avs[16][2];
#pragma unroll
            for (int i = 0; i < 16; ++i) { const int row = crow(i, hi); const float xv = bf2f(xs[row * 72 + ch]);
#pragma unroll
                for (int d = 0; d < 2; ++d) { const float r = sigmoidf_(acc4[2 * d][i] + ba[d]), ig = sigmoidf_(acc4[2 * d + 1][i] + bx[d]);
                    const float la2 = bflo(f2bf(-r * sp[d])), av = __builtin_amdgcn_exp2f(la2); avs[i][d] = av;
                    const float uu = __builtin_amdgcn_sqrtf(fmaxf(1.f - av * av, 0.f)) * (ig * xv);
                    wv[i][d] = pk2(la2, uu);
                    LU[((size_t)(m0 + row) * 2 + d) * 512 + gch] = wv[i][d]; } }
#pragma unroll
            for (int d = 0; d < 2; ++d) {
                float Ar[4], Ur[4];
#pragma unroll
                for (int g = 0; g < 4; ++g) { float A = 1.f, U = 0.f;
#pragma unroll
                    for (int jj = 0; jj < 4; ++jj) { const int j = d ? 3 - jj : jj; const unsigned w = wv[4 * g + j][d]; const float av = avs[4 * g + j][d]; A *= av; U = av * U + bfhi(w); }
                    Ar[g] = A; Ur[g] = U; }
                float A = 1.f, U = 0.f;
#pragma unroll
                for (int gg = 0; gg < 4; ++gg) { const int g = d ? 3 - gg : gg;
                    const float Ao = __shfl_xor(Ar[g], 32), Uo = __shfl_xor(Ur[g], 32);
                    if (d == 0) { U = Ar[g] * U + Ur[g]; A *= Ar[g]; U = Ao * U + Uo; A *= Ao; }
                    else        { U = Ao * U + Uo; A *= Ao; U = Ar[g] * U + Ur[g]; A *= Ar[g]; } }
                if (hi == 0) wagg[(wave * 2 + d) * 64 + ch] = (f32x2){A, U};
            }
        }
        LDS_WAIT();
        __syncthreads();
        if (tid < 128) {
            const int d = tid >> 6, ch = tid & 63; float A = 1.f, U = 0.f;
#pragma unroll
            for (int ww = 0; ww < 8; ++ww) { const int w = d ? 7 - ww : ww; const f32x2 g = wagg[(w * 2 + d) * 64 + ch]; U = g.x * U + g.y; A *= g.x; }
            const int b = pm < MLAT / 256 ? (pm >> 5) : (pm - MLAT / 256), c = pm < MLAT / 256 ? (pm & 31) : NCH;
            AGG[(size_t)((b * 2 + d) * (NCH + 1) + c) * 512 + h * 64 + ch] = (f32x2){A, U};
        }
        __syncthreads();
    }
}
__device__ __forceinline__ void scan_agg(const GAS unsigned* __restrict__ LU, GAS f32x2* __restrict__ AGG, int gw, int NGW, int lane) {
    for (int task = gw; task < NB * 2 * (NCH + 1) * 8; task += NGW) {
        const int cgp = task & 7, c = (task >> 3) % (NCH + 1), d = (task / (8 * (NCH + 1))) & 1, b = task / (16 * (NCH + 1));
        const int ch = cgp * 64 + lane, row0 = c < NCH ? b * SEQ + c * CHL : MLAT + b * CTX;
        float A = 1.f, U = 0.f;
#pragma unroll 16
        for (int t = 0; t < CHL; ++t) { const int tt = d ? CHL - 1 - t : t; const unsigned w = LU[((size_t)(row0 + tt) * 2 + d) * 512 + ch];
            const float av = __builtin_amdgcn_exp2f(bflo(w)); A *= av; U = av * U + bfhi(w); }
        AGG[(size_t)((b * 2 + d) * (NCH + 1) + c) * 512 + ch] = (f32x2){A, U};
    }
}
__device__ __forceinline__ float gelu_tanh(float x) { const float z = 0.7978845608028654f * (x + 0.044715f * x * x * x);
    return x * __builtin_amdgcn_rcpf(1.f + __builtin_amdgcn_exp2f(-2.8853900817779268f * z)); }
__device__ __forceinline__ void scan_final(const GAS unsigned* __restrict__ LU, const GAS f32x2* __restrict__ AGG, const GAS bf16_t* __restrict__ P, GAS bf16_t* __restrict__ A2, int gw, int NGW, int lane) {
    constexpr int BT = 16;
    for (int task = gw; task < NB * NCH * 8; task += NGW) {
        const int cgp = task & 7, c = (task >> 3) & (NCH - 1), b = task / (8 * NCH), ch = cgp * 64 + lane, row0 = b * SEQ + c * CHL;
        const GAS f32x2* ag0 = AGG + (size_t)((b * 2 + 0) * (NCH + 1)) * 512 + ch; const GAS f32x2* ag1 = AGG + (size_t)((b * 2 + 1) * (NCH + 1)) * 512 + ch;
        unsigned w[BT], wn[BT];
#pragma unroll
        for (int i = 0; i < BT; ++i) w[i] = LU[((size_t)(row0 + i) * 2 + 0) * 512 + ch];
        float hf = ag0[(size_t)NCH * 512].y;
        for (int cc = 0; cc < c; ++cc) { const f32x2 g = ag0[(size_t)cc * 512]; hf = g.x * hf + g.y; }
        float hb = ag1[(size_t)NCH * 512].y;
        for (int cc = NCH - 1; cc > c; --cc) { const f32x2 g = ag1[(size_t)cc * 512]; hb = g.x * hb + g.y; }
#pragma unroll 1
        for (int t0 = 0; t0 < CHL; t0 += BT) {
            if (t0 + BT < CHL) {
#pragma unroll
                for (int i = 0; i < BT; ++i) wn[i] = LU[((size_t)(row0 + t0 + BT + i) * 2 + 0) * 512 + ch]; }
#pragma unroll
            for (int i = 0; i < BT; ++i) { hf = __builtin_amdgcn_exp2f(bflo(w[i])) * hf + bfhi(w[i]); A2[(size_t)(row0 + t0 + i) * DM + ch] = (bf16_t)f2bf(hf); }
#pragma unroll
            for (int i = 0; i < BT; ++i) w[i] = wn[i]; }
        bf16_t gr[BT], grn[BT];
#pragma unroll
        for (int i = 0; i < BT; ++i) { w[i] = LU[((size_t)(row0 + CHL - BT + i) * 2 + 1) * 512 + ch]; gr[i] = P[(size_t)(row0 + CHL - BT + i) * PW + 512 + ch]; }
#pragma unroll 1
        for (int t0 = CHL - BT; t0 >= 0; t0 -= BT) { bf16_t f[BT];
#pragma unroll
            for (int i = 0; i < BT; ++i) f[i] = A2[(size_t)(row0 + t0 + i) * DM + ch];
            if (t0 >= BT) {
#pragma unroll
                for (int i = 0; i < BT; ++i) { wn[i] = LU[((size_t)(row0 + t0 - BT + i) * 2 + 1) * 512 + ch]; grn[i] = P[(size_t)(row0 + t0 - BT + i) * PW + 512 + ch]; } }
#pragma unroll
            for (int i = BT - 1; i >= 0; --i) { hb = __builtin_amdgcn_exp2f(bflo(w[i])) * hb + bfhi(w[i]);
                A2[(size_t)(row0 + t0 + i) * DM + ch] = (bf16_t)f2bf((bf2f(f[i]) + hb) * gelu_tanh(bf2f(gr[i]))); }
#pragma unroll
            for (int i = 0; i < BT; ++i) { w[i] = wn[i]; gr[i] = grn[i]; } }
    }
}
constexpr int AT_KROW = 208, AT_VROW = 144;
constexpr float AT_THR = 8.f;
#define AT_LMAX(P, MX) do { MX = fmaxf(fmaxf(P[0], P[1]), fmaxf(P[2], P[3])); \
        _Pragma("unroll") for (int i_ = 4; i_ < 16; i_ += 4) MX = fmaxf(fmaxf(MX, P[i_]), fmaxf(fmaxf(P[i_ + 1], P[i_ + 2]), P[i_ + 3])); } while (0)
#define AT_SOFTMAX(P, MX, M, L, O0, O1, PW0, PW1) do { \
        if (__any(MX > M + AT_THR)) { const float mn_ = fmaxf(M, MX), al_ = __builtin_amdgcn_exp2f(M - mn_); M = mn_; L *= al_; \
            _Pragma("unroll") for (int i_ = 0; i_ < 16; ++i_) { O0[i_] *= al_; O1[i_] *= al_; } } \
        float s_ = 0.f; \
        _Pragma("unroll") for (int i_ = 0; i_ < 16; ++i_) { P[i_] = __builtin_amdgcn_exp2f(P[i_] - M); s_ += P[i_]; } \
        L += s_; \
        _Pragma("unroll") for (int j_ = 0; j_ < 4; ++j_) { PW0[j_] = cvtpk(P[2 * j_], P[2 * j_ + 1]); PW1[j_] = cvtpk(P[8 + 2 * j_], P[9 + 2 * j_]); } } while (0)
__device__ __forceinline__ void glds16(const GAS void* gsrc, unsigned lds_dst) {
    unsigned keep;
    asm volatile("s_mov_b32 %0, m0\n\ts_mov_b32 m0, %2\n\ts_nop 0\n\tglobal_load_lds_dwordx4 %1, off\n\ts_mov_b32 m0, %0" : "=&s"(keep) : "v"(gsrc), "s"(lds_dst) : "memory");
}
constexpr int AT_SLOT = 22 * 1024, AT_VOFF = 13 * 1024, AT_NP = 22;
__device__ __forceinline__ void attn_unit(LAS unsigned char* lds, const GAS bf16_t* __restrict__ QR, const GAS float* __restrict__ ssq, const GAS float* __restrict__ RT, const GAS bf16_t* __restrict__ K, const GAS bf16_t* __restrict__ Vt, GAS bf16_t* __restrict__ A2, int b, int h, int qb, int tid, int wave, int lane) {
    const int r32 = lane & 31, hi = lane >> 5, q0 = qb * 512 + wave * 64, r32s = (r32 & ~12) | ((r32 & 4) << 1) | ((r32 & 8) >> 1);
    bf16x8 qa[6], qc[6];
#pragma unroll
    for (int sub = 0; sub < 2; ++sub) {
        const int s = q0 + 32 * sub + r32, row = b * SEQ + s;
        const GAS bf16_t* Qp = QR + (size_t)row * 768 + h * 96 + 8 * hi;
        const float sc = rsqrtf(ssq[row] * (1.f / 256.f) + EPS) * QSCALE;
#pragma unroll
        for (int d0 = 0; d0 < 6; ++d0) {
            const u32x4 raw = *(const GAS u32x4*)(Qp + 16 * d0);
            float v[8];
#pragma unroll
            for (int j = 0; j < 4; ++j) { v[2 * j] = bflo(raw[j]) * sc; v[2 * j + 1] = bfhi(raw[j]) * sc; }
            if (d0 >= 4) { const GAS float* rt = RT + (d0 == 4 ? (s >> 6) : (s & 63)) * 16;
#pragma unroll
                for (int j = 0; j < 8; ++j) { const float pt = __shfl_xor(v[j], 32), cs = rt[2 * j], sn = rt[2 * j + 1]; v[j] = hi ? v[j] * cs + pt * sn : v[j] * cs - pt * sn; } }
            u32x4 w; w.x = pk2(v[0], v[1]); w.y = pk2(v[2], v[3]); w.z = pk2(v[4], v[5]); w.w = pk2(v[6], v[7]);
            if (sub == 0) qa[d0] = __builtin_bit_cast(bf16x8, w); else qc[d0] = __builtin_bit_cast(bf16x8, w);
        }
    }
    const GAS unsigned char* Kg = (const GAS unsigned char*)(K + (size_t)(b * 8 + h) * KVLEN * 96);
    const GAS unsigned char* Vg = (const GAS unsigned char*)(Vt + (size_t)(b * 8 + h) * 64 * KVLEN);
    const unsigned ldsb = (unsigned)(size_t)lds;
    const GAS unsigned char* src[3]; int stride[3]; unsigned dsto[3];
#pragma unroll
    for (int k = 0; k < 3; ++k) { int j = wave + 8 * k; if (j >= AT_NP) j -= 8; const int id = j * 64 + lane;
        if (j < 13) { const int row = id / 13; int col = id - row * 13; if (col == 12) col = 0; src[k] = Kg + row * 192 + col * 16; stride[k] = 12288; }
        else { const int idv = id - 832, d = idv / 9; int c = idv - d * 9; if (c == 8) c = 0; src[k] = Vg + ((size_t)d * KVLEN + c * 8) * 2; stride[k] = 128; }
        dsto[k] = ldsb + j * 1024; }
#define AT_ISSUE(t, slot) do { _Pragma("unroll") for (int k_ = 0; k_ < 3; ++k_) glds16(src[k_] + (size_t)(t) * stride[k_], (unsigned)__builtin_amdgcn_readfirstlane(dsto[k_] + (slot) * AT_SLOT)); } while (0)
    f32x16 oA0, oA1, oB0, oB1;
#pragma unroll
    for (int i = 0; i < 16; ++i) { oA0[i] = 0.f; oA1[i] = 0.f; oB0[i] = 0.f; oB1[i] = 0.f; }
    float mA = -1e30f, mB = -1e30f, lA = 0.f, lB = 0.f;
    constexpr int NT_ = KVLEN / 64;
    AT_ISSUE(0, 0); AT_ISSUE(1, 1);
    int slot = 0, nslot = 2;
#pragma unroll 1
    for (int t = 0; t < NT_; ++t) {
        if (t + 1 < NT_) asm volatile("s_waitcnt vmcnt(3) lgkmcnt(0)\n\ts_barrier" ::: "memory"); else asm volatile("s_waitcnt vmcnt(0) lgkmcnt(0)\n\ts_barrier" ::: "memory");
        if (t + 2 < NT_) AT_ISSUE(t + 2, nslot);
        const LAS unsigned char* sb = lds + slot * AT_SLOT;
#pragma unroll
        for (int hh = 0; hh < 2; ++hh) {
            const LAS unsigned char* kb = sb + (32 * hh + r32s) * AT_KROW + hi * 16;
            f32x16 pA, pB;
#pragma unroll
            for (int i = 0; i < 16; ++i) { pA[i] = 0.f; pB[i] = 0.f; }
#pragma unroll
            for (int d0 = 0; d0 < 6; ++d0) { const bf16x8 a0 = *(const LAS bf16x8*)(kb + d0 * 32); pA = MFMA32(a0, qa[d0], pA); pB = MFMA32(a0, qc[d0], pB); }
            u32x4 pwA0, pwA1, pwB0, pwB1;
            float mxA, mxB; AT_LMAX(pA, mxA); AT_LMAX(pB, mxB);
            { const float oa = __shfl_xor(mxA, 32), ob = __shfl_xor(mxB, 32); mxA = fmaxf(mxA, oa); mxB = fmaxf(mxB, ob); }
            AT_SOFTMAX(pA, mxA, mA, lA, oA0, oA1, pwA0, pwA1);
            AT_SOFTMAX(pB, mxB, mB, lB, oB0, oB1, pwB0, pwB1);
            const LAS unsigned char* vb = sb + AT_VOFF + r32 * AT_VROW + hi * 16 + hh * 64;
#pragma unroll
            for (int ks = 0; ks < 2; ++ks) {
                const bf16x8 va0 = *(const LAS bf16x8*)(vb + ks * 32), va1 = *(const LAS bf16x8*)(vb + 32 * AT_VROW + ks * 32);
                const bf16x8 pa = __builtin_bit_cast(bf16x8, ks ? pwA1 : pwA0), pb = __builtin_bit_cast(bf16x8, ks ? pwB1 : pwB0);
                oA0 = MFMA32(va0, pa, oA0); oA1 = MFMA32(va1, pa, oA1); oB0 = MFMA32(va0, pb, oB0); oB1 = MFMA32(va1, pb, oB1);
            }
        }
        slot = slot == 2 ? 0 : slot + 1; nslot = nslot == 2 ? 0 : nslot + 1;
    }
    asm volatile("s_waitcnt lgkmcnt(0)\n\ts_barrier" ::: "memory");
    {   const float inv = 1.f / (lA + __shfl_xor(lA, 32));
        GAS bf16_t* op = A2 + (size_t)(b * SEQ + q0 + r32) * DM + 512 + h * 64 + 4 * hi;
#pragma unroll
        for (int g = 0; g < 4; ++g) { u32x2 w0, w1; w0.x = pk2(oA0[4 * g] * inv, oA0[4 * g + 1] * inv); w0.y = pk2(oA0[4 * g + 2] * inv, oA0[4 * g + 3] * inv);
            w1.x = pk2(oA1[4 * g] * inv, oA1[4 * g + 1] * inv); w1.y = pk2(oA1[4 * g + 2] * inv, oA1[4 * g + 3] * inv);
            *(GAS u32x2*)(op + 8 * g) = w0; *(GAS u32x2*)(op + 32 + 8 * g) = w1; } }
    {   const float inv = 1.f / (lB + __shfl_xor(lB, 32));
        GAS bf16_t* op = A2 + (size_t)(b * SEQ + q0 + 32 + r32) * DM + 512 + h * 64 + 4 * hi;
#pragma unroll
        for (int g = 0; g < 4; ++g) { u32x2 w0, w1; w0.x = pk2(oB0[4 * g] * inv, oB0[4 * g + 1] * inv); w0.y = pk2(oB0[4 * g + 2] * inv, oB0[4 * g + 3] * inv);
            w1.x = pk2(oB1[4 * g] * inv, oB1[4 * g + 1] * inv); w1.y = pk2(oB1[4 * g + 2] * inv, oB1[4 * g + 3] * inv);
            *(GAS u32x2*)(op + 8 * g) = w0; *(GAS u32x2*)(op + 32 + 8 * g) = w1; } }
#undef AT_ISSUE
}
__device__ __forceinline__ void p7_rows(const GAS float* __restrict__ x, const GAS float* __restrict__ g_post, const GAS float* __restrict__ g_pre, GAS float* __restrict__ out, const GAS float* __restrict__ mod, const GAS bf16_t* __restrict__ Y, GAS bf16_t* __restrict__ H2, int gw, int NGW, int lane) {
    for (int m0 = 2 * gw; m0 < MLAT; m0 += 2 * NGW) {
        const GAS float* md = mod + (m0 >> 13) * NMOD;
        f32x4 y[2][4], xv[2][4]; float ss[2];
#pragma unroll
        for (int r = 0; r < 2; ++r) { ss[r] = 0.f;
#pragma unroll
            for (int j = 0; j < 4; ++j) { const u32x2 w = *(const GAS u32x2*)(Y + (size_t)(m0 + r) * DM + 4 * lane + 256 * j); xv[r][j] = *(const GAS f32x4*)(x + (size_t)(m0 + r) * DM + 4 * lane + 256 * j);
                y[r][j] = (f32x4){bflo(w.x), bfhi(w.x), bflo(w.y), bfhi(w.y)}; ss[r] += y[r][j].x * y[r][j].x + y[r][j].y * y[r][j].y + y[r][j].z * y[r][j].z + y[r][j].w * y[r][j].w; } }
#pragma unroll
        for (int r = 0; r < 2; ++r) { const int m = m0 + r;
            const float rs = rsqrtf(wave_sum(ss[r]) * (1.f / DM) + EPS); float s2 = 0.f;
#pragma unroll
            for (int j = 0; j < 4; ++j) { const int k = 4 * lane + 256 * j;
                const f32x4 gg = *(const GAS f32x4*)(g_post + k), gt = *(const GAS f32x4*)(md + 2 * DM + k);
                xv[r][j] = xv[r][j] + gt * (y[r][j] * rs * gg); *(GAS f32x4*)(out + (size_t)m * DM + k) = xv[r][j];
                s2 += xv[r][j].x * xv[r][j].x + xv[r][j].y * xv[r][j].y + xv[r][j].z * xv[r][j].z + xv[r][j].w * xv[r][j].w; }
            const float rs2 = rsqrtf(wave_sum(s2) * (1.f / DM) + EPS);
#pragma unroll
            for (int j = 0; j < 4; ++j) { const int k = 4 * lane + 256 * j;
                const f32x4 gg = *(const GAS f32x4*)(g_pre + k), sh = *(const GAS f32x4*)(md + 3 * DM + k), sc = *(const GAS f32x4*)(md + 4 * DM + k);
                const f32x4 hh = xv[r][j] * rs2 * gg * (sc + 1.f) + sh;
                u32x2 o; o.x = pk2(hh.x, hh.y); o.y = pk2(hh.z, hh.w); *(GAS u32x2*)(H2 + (size_t)m * DM + k) = o; } }
    }
}
__device__ __forceinline__ void p11_rows(const GAS float* __restrict__ g_post, GAS float* __restrict__ out, const GAS float* __restrict__ mod, const GAS bf16_t* __restrict__ Fb, int gw, int NGW, int lane) {
    for (int m0 = 2 * gw; m0 < MLAT; m0 += 2 * NGW) {
        const GAS float* md = mod + (m0 >> 13) * NMOD;
        f32x4 y[2][4], xv[2][4]; float ss[2];
#pragma unroll
        for (int r = 0; r < 2; ++r) { ss[r] = 0.f;
#pragma unroll
            for (int j = 0; j < 4; ++j) { const u32x2 w = *(const GAS u32x2*)(Fb + (size_t)(m0 + r) * DM + 4 * lane + 256 * j); xv[r][j] = *(const GAS f32x4*)(out + (size_t)(m0 + r) * DM + 4 * lane + 256 * j);
                y[r][j] = (f32x4){bflo(w.x), bfhi(w.x), bflo(w.y), bfhi(w.y)}; ss[r] += y[r][j].x * y[r][j].x + y[r][j].y * y[r][j].y + y[r][j].z * y[r][j].z + y[r][j].w * y[r][j].w; } }
#pragma unroll
        for (int r = 0; r < 2; ++r) { const float rs = rsqrtf(wave_sum(ss[r]) * (1.f / DM) + EPS);
#pragma unroll
            for (int j = 0; j < 4; ++j) { const int k = 4 * lane + 256 * j;
                const f32x4 gg = *(const GAS f32x4*)(g_post + k), gt = *(const GAS f32x4*)(md + 5 * DM + k);
                *(GAS f32x4*)(out + (size_t)(m0 + r) * DM + k) = xv[r][j] + gt * (y[r][j] * rs * gg); } }
    }
}
__device__ __forceinline__ void convgate_phase(const GAS float* __restrict__ cw, const GAS float* __restrict__ cb, const GAS bf16_t* __restrict__ UP, GAS bf16_t* __restrict__ G, int half, int gtid, int NT) {
    constexpr int JG = DFF / 8, RG = 32, NTASK = (MLAT / 2 / RG) * JG;
    for (int task = gtid; task < NTASK; task += NT) {
        const int jg = task % JG, rg = task / JG, j0 = jg * 8, r0 = rg * RG, m0 = half * (MLAT / 2) + r0;
        float wu[3][8], wg[3][8], bu[8], bg[8];
#pragma unroll
        for (int k = 0; k < 3; ++k)
#pragma unroll
            for (int i = 0; i < 8; ++i) { wu[k][i] = cw[k * 2 * DFF + j0 + i]; wg[k][i] = cw[k * 2 * DFF + DFF + j0 + i]; }
#pragma unroll
        for (int i = 0; i < 8; ++i) { bu[i] = cb[j0 + i]; bg[i] = cb[DFF + j0 + i]; }
        const GAS bf16_t* up = UP + (size_t)r0 * (2 * DFF) + j0;
        u32x4 pu = {0u, 0u, 0u, 0u}, pg = {0u, 0u, 0u, 0u}, cu, cg_, nu, ng;
        if ((m0 & 8191) != 0) { pu = *(const GAS u32x4*)(up - 2 * DFF); pg = *(const GAS u32x4*)(up - 2 * DFF + DFF); }
        cu = *(const GAS u32x4*)(up); cg_ = *(const GAS u32x4*)(up + DFF);
#pragma unroll 8
        for (int r = 0; r < RG; ++r) {
            const bool nv = (r + 1 < RG) || (((m0 + RG) & 8191) != 0);
            if (nv) { nu = *(const GAS u32x4*)(up + (size_t)(r + 1) * (2 * DFF)); ng = *(const GAS u32x4*)(up + (size_t)(r + 1) * (2 * DFF) + DFF); } else { nu = (u32x4){0u, 0u, 0u, 0u}; ng = nu; }
            float o[8];
#pragma unroll
            for (int i = 0; i < 8; ++i) { const int w_ = i >> 1;
                const float p_u = (i & 1) ? bfhi(pu[w_]) : bflo(pu[w_]), c_u = (i & 1) ? bfhi(cu[w_]) : bflo(cu[w_]), n_u = (i & 1) ? bfhi(nu[w_]) : bflo(nu[w_]);
                const float p_g = (i & 1) ? bfhi(pg[w_]) : bflo(pg[w_]), c_g = (i & 1) ? bfhi(cg_[w_]) : bflo(cg_[w_]), n_g = (i & 1) ? bfhi(ng[w_]) : bflo(ng[w_]);
                const float uv = bu[i] + wu[0][i] * p_u + wu[1][i] * c_u + wu[2][i] * n_u, gv = bg[i] + wg[0][i] * p_g + wg[1][i] * c_g + wg[2][i] * n_g;
                o[i] = gv * __builtin_amdgcn_rcpf(1.f + __builtin_amdgcn_exp2f(-1.4426950408889634f * gv)) * uv; }
            u32x4 w; w.x = pk2(o[0], o[1]); w.y = pk2(o[2], o[3]); w.z = pk2(o[4], o[5]); w.w = pk2(o[6], o[7]);
            *(GAS u32x4*)(G + (size_t)(r0 + r) * DFF + j0) = w;
            pu = cu; pg = cg_; cu = nu; cg_ = ng;
        }
    }
}
constexpr int NPH = 17;
__global__ void __launch_bounds__(512, 2) fwd_kernel(Args a) {
    extern __shared__ __attribute__((aligned(16))) unsigned char lds_raw[];
    LAS unsigned char* lds = (LAS unsigned char*)lds_raw;
    const int lo = a.ph_lo, hi_ = a.ph_hi;
    {
        volatile LAS unsigned* st0 = (volatile LAS unsigned*)(lds + LDS_MISC);
        if (threadIdx.x < 2) st0[threadIdx.x] = 0u;
        __syncthreads();
        (void)xcd_barrier_post((unsigned*)(a.ws + WS_BAR), st0);
    }
#if MK_COOP
    cg::grid_group grid = cg::this_grid();
#endif
    typedef pg8::EpiBf16<0> EpiB;
    constexpr int MH = MLAT / 2;
#ifndef REPMASK
#define REPMASK 0
#endif
    bool repeated = false;
#pragma unroll 1
    for (int ph = lo; ph < hi_; ++ph) {
        int tid = threadIdx.x; asm volatile("" : "+v"(tid));
        int G = gridDim.x, bx = blockIdx.x; asm volatile("" : "+s"(G), "+s"(bx));
        const int lane = tid & 63, wave = __builtin_amdgcn_readfirstlane(tid >> 6);
        const int vcu = (G % 8 == 0) ? (bx % 8) * (G / 8) + bx / 8 : bx;
        const int gw = vcu * 8 + wave, NGW = G * 8, gtid = bx * 512 + tid, NTH = G * 512;
        unsigned char* ws_ = a.ws; asm volatile("" : "+s"(ws_)); GAS unsigned char* ws = (GAS unsigned char*)ws_;
        GAS float* mod = (GAS float*)(ws + WS_MOD); GAS float* ssq = (GAS float*)(ws + WS_SSQ); GAS float* sskv = (GAS float*)(ws + WS_SSKV);
        GAS bf16_t* Win = (GAS bf16_t*)(ws + WS_WIN); GAS bf16_t* Wq = (GAS bf16_t*)(ws + WS_WQ); GAS bf16_t* Wkv = (GAS bf16_t*)(ws + WS_WKV); GAS bf16_t* Wg = (GAS bf16_t*)(ws + WS_WG);
        GAS bf16_t* Wout = (GAS bf16_t*)(ws + WS_WOUT); GAS bf16_t* Wup = (GAS bf16_t*)(ws + WS_WUP); GAS bf16_t* Wdn = (GAS bf16_t*)(ws + WS_WDN);
        GAS f32x2* AGG = (GAS f32x2*)(ws + WS_AGG); GAS float* RT = (GAS float*)(ws + WS_ROPE);
        GAS bf16_t* H = (GAS bf16_t*)(ws + WS_R1); GAS bf16_t* KVR = H; GAS bf16_t* H2 = H; GAS bf16_t* QR = (GAS bf16_t*)(ws + WS_Q);
        GAS bf16_t* P = (GAS bf16_t*)(ws + WS_R2); GAS bf16_t* Y = P; GAS bf16_t* Fb = P;
        GAS unsigned* LU = (GAS unsigned*)(ws + WS_LU); GAS bf16_t* Kb = (GAS bf16_t*)(ws + WS_K); GAS bf16_t* Vb = (GAS bf16_t*)(ws + WS_V); GAS bf16_t* A2 = (GAS bf16_t*)(ws + WS_A2);
        GAS bf16_t* UP = (GAS bf16_t*)(ws + WS_UP); GAS bf16_t* Gb = (GAS bf16_t*)(ws + WS_G);
        float* outp_ = a.out; asm volatile("" : "+s"(outp_)); GAS float* outp = (GAS float*)outp_;
        pg8::Gemm g{nullptr, nullptr, 0, 0, 0, 0, 0}; GAS bf16_t* O = nullptr; int ldc = 0;
        switch (ph) {
            case 2:  g = pg8::Gemm{(const bf16_t*)(H), (const bf16_t*)(Win), MALL, PW, DM, DM, DM}; O = P; ldc = PW; break;
            case 4:  g = pg8::Gemm{(const bf16_t*)(P + 1024), (const bf16_t*)(Wq), MLAT, 768, 256, PW, 256}; O = QR; ldc = 768; break;
            case 5:  g = pg8::Gemm{(const bf16_t*)(P + 1280), (const bf16_t*)(Wkv), MALL, 1024, 256, PW, 256}; O = KVR; ldc = 1024; break;
            case 8:  g = pg8::Gemm{(const bf16_t*)(A2), (const bf16_t*)(Wout), MLAT, DM, DM, DM, DM}; O = Y; ldc = DM; break;
            case 10: g = pg8::Gemm{(const bf16_t*)(H2), (const bf16_t*)(Wup), MH, 2 * DFF, DM, DM, DM}; O = UP; ldc = 2 * DFF; break;
            case 13: g = pg8::Gemm{(const bf16_t*)(H2 + (size_t)MH * DM), (const bf16_t*)(Wup), MH, 2 * DFF, DM, DM, DM}; O = UP; ldc = 2 * DFF; break;
            case 12: g = pg8::Gemm{(const bf16_t*)(Gb), (const bf16_t*)(Wdn), MH, DM, DFF, DFF, DFF}; O = Fb; ldc = DM; break;
            case 15: g = pg8::Gemm{(const bf16_t*)(Gb), (const bf16_t*)(Wdn), MH, DM, DFF, DFF, DFF}; O = Fb + (size_t)MH * DM; ldc = DM; break;
            default: break;
        }
        if (g.A != nullptr) {
            pg8::StaticOrder S; S.init(g.M, g.N, G, bx); EpiB E{(bf16_t*)O, ldc, nullptr, 0, 0, 1.f};
            pg8::gemm_phase<EpiB, pg8::StaticOrder, true, true>(lds, g, S, E, tid);
        }
#ifndef NGM
#define NGM 0x1ffff
#endif
#define NG(k) ((NGM >> (k)) & 1)
        else if (NG(0) && ph == 0) {
            prep_mat<0>(argp(10), nullptr, Win, 1536, 1024, gtid, NTH); prep_mat<1>(argp(18), argp(19), Wq, 768, 256, gtid, NTH); prep_mat<2>(argp(20), argp(21), Wkv, 1024, 256, gtid, NTH);
            prep_mat<3>(argp(13), argp(15), Wg, 2048, 64, gtid, NTH); prep_mat<4>(argp(22), nullptr, Wout, 1024, 1024, gtid, NTH); prep_mat<5>(argp(23), nullptr, Wup, 5632, 1024, gtid, NTH);
            prep_mat<6>(argp(26), nullptr, Wdn, 1024, 2816, gtid, NTH);
            if (gtid < 1024) { const float nl = -argp(17)[gtid]; RT[2048 + gtid] = 8.f * 1.4426950408889634f * (nl > 20.f ? nl : log1pf(__expf(nl))); }
            if (gtid < 1024) { const int pos = gtid >> 3, j = gtid & 7; const float invf[8] = {1.f, 0.31622776601683794f, 0.1f, 0.031622776601683794f, 0.01f, 0.0031622776601683794f, 0.001f, 0.00031622776601683794f};
                const float ang = (float)pos * invf[j]; RT[2 * gtid] = cosf(ang); RT[2 * gtid + 1] = sinf(ang); }
            mod_phase(argp(1), argp(3), argp(4), argp(5), mod, (LAS float*)(lds + wave * 4096), gw, NGW, lane);
        } else if (NG(1) && ph == 1) {
            p1_rows(argp(0), argp(2), argp(6), mod, H, gw, NGW, lane);
        } else if (NG(3) && ph == 3) {
            gates_phase(argp(11), argp(12), argp(14), argp(16), (const GAS float*)(RT + 2048), lds, P, Wg, LU, AGG, tid, wave, lane);
            ss_phase(P, ssq, sskv, gw, NGW, lane);
        } else if (NG(6) && ph == 6) {
            krope_phase(P, Kb, RT, gtid, NTH); kvpost_phase(KVR, sskv, Kb, Vb, gtid, NTH);
#ifdef REP6
            if (REP6 & 1) { __syncthreads(); scan_agg(LU, AGG, gw, NGW, lane); }
            if (REP6 & 2) { __syncthreads(); krope_phase(P, Kb, RT, gtid, NTH); }
            if (REP6 & 4) { __syncthreads(); }
            if (REP6 & 8) { __syncthreads(); kvpost_phase(KVR, sskv, Kb, Vb, gtid, NTH); }
#endif
        } else if (NG(7) && ph == 7) {
            scan_final(LU, AGG, P, A2, gw, NGW, lane);
#ifdef REP7
            __syncthreads(); scan_final(LU, AGG, P, A2, gw, NGW, lane);
#endif
            const int upb = (NB * 8 * 16 + G - 1) / G, u0 = vcu * upb, u1 = min(NB * 8 * 16, u0 + upb);
            __syncthreads();
            for (int unit = u0; unit < u1; ++unit) { const int bh = unit >> 4, qb = unit & 15; attn_unit(lds, QR, ssq, RT, Kb, Vb, A2, bh >> 3, bh & 7, qb, tid, wave, lane); }
        } else if (NG(9) && ph == 9) {
            p7_rows(argp(0), argp(7), argp(8), outp, mod, Y, H2, gw, NGW, lane);
        } else if (NG(11) && (ph == 11 || ph == 14)) {
            convgate_phase(argp(24), argp(25), UP, Gb, ph == 14 ? 1 : 0, gtid, NTH);
        } else if (NG(16) && ph == 16) {
            p11_rows(argp(9), outp, mod, Fb, gw, NGW, lane);
        }
        __syncthreads();
#if MK_COOP
        if (ph + 1 < hi_ && ph != 3 && ph != 4 && ph != 12) {
            if (ph == 0) grid.sync();
            else { XcdBarrier xb; xb.bar = (unsigned*)(ws_ + WS_BAR); xb.x = xb_xcc_id(); xb.st = (volatile LAS unsigned*)(lds + LDS_MISC); xcd_barrier(xb); }
        }
#endif
        if (REPMASK) { if (((REPMASK >> ph) & 1) && !repeated) { repeated = true; --ph; } else repeated = false; }
    }
}

extern "C" void kernel_launch(void* const* d_in, const int* in_sizes, int n_in, void* d_out, int out_size, void* d_ws, size_t ws_size, hipStream_t stream) {
    static int grid = 0;
    if (grid == 0) {
        if (n_in != 27 || out_size != MLAT * DM || ws_size < WS_END) { fprintf(stderr, "kernel_launch: unexpected shapes (n_in %d, out %d, ws %zu)\n", n_in, out_size, ws_size); grid = -1; return; }
        int dev = 0, cus = 0, per_cu = 0;
        if (hipGetDevice(&dev) != hipSuccess || hipDeviceGetAttribute(&cus, hipDeviceAttributeMultiprocessorCount, dev) != hipSuccess) { grid = -1; return; }
        if (hipFuncSetAttribute((const void*)fwd_kernel, hipFuncAttributeMaxDynamicSharedMemorySize, LDS_BYTES) != hipSuccess) { fprintf(stderr, "kernel_launch: hipFuncSetAttribute failed\n"); grid = -1; return; }
        if (hipOccupancyMaxActiveBlocksPerMultiprocessor(&per_cu, (const void*)fwd_kernel, 512, LDS_BYTES) != hipSuccess || per_cu < 1) { fprintf(stderr, "kernel_launch: occupancy query says %d\n", per_cu); }
        (void)hipGetLastError();
        grid = cus;
    }
    if (grid < 0) return;
    (void)hipMemsetAsync((char*)d_ws + WS_CTL, 0, CTL_BYTES, stream);
    Args a{};
    for (int i = 0; i < 27; ++i) a.in[i] = (const float*)d_in[i];
    a.out = (float*)d_out; a.ws = (unsigned char*)d_ws;
#if MK_COOP
    a.ph_lo = 0; a.ph_hi = NPH;
    void* args[] = {&a};
    hipError_t e = hipLaunchCooperativeKernel((const void*)fwd_kernel, dim3(grid), dim3(512), args, LDS_BYTES, stream);
    if (e != hipSuccess) fprintf(stderr, "kernel_launch: cooperative launch failed: %s (grid %d)\n", hipGetErrorString(e), grid);
#else
    for (int p = 0; p < NPH; ++p) { a.ph_lo = p; a.ph_hi = p + 1; hipLaunchKernelGGL(fwd_kernel, dim3(grid), dim3(512), LDS_BYTES, stream, a); }
#endif
}
```

```cpp
#include <hip/hip_runtime.h>
#include <hip/hip_cooperative_groups.h>
#include <cstdio>
#include <cstdint>
namespace cg = cooperative_groups;
#ifndef MK_COOP
#define MK_COOP 1
#endif
namespace pg8 {
#define PG8_LAS __attribute__((address_space(3)))
typedef unsigned short bf16_t;
typedef short bf16x8 __attribute__((ext_vector_type(8)));
typedef float f32x4 __attribute__((ext_vector_type(4)));
typedef unsigned u32x4 __attribute__((ext_vector_type(4)));
constexpr int BM = 256, BK = 64, HALF = 128, HTB = HALF * BK * 2  , STAGE_BYTES = 8 * HTB, NXCD = 8, WGM = 8;

__host__ __device__ __forceinline__ int lds_byte(int r, int c) { const int st = (r >> 4) * 2 + (c >> 5), rr = r & 15, cc = c & 31, ob = rr * 64 + cc * 2; return st * 1024 + (ob ^ (((ob >> 9) & 1) << 5)); }
__host__ __device__ __forceinline__ void stage_rc(int b, int& R, int& C) { const int st = b / 1024, sb = b % 1024, swz = sb ^ (((sb >> 9) & 1) << 5); R = (st >> 1) * 16 + swz / 64; C = (st & 1) * 32 + (swz % 64) / 2; }
__host__ __device__ __forceinline__ int perm32(int rho) { const int n = rho >> 4, i = rho & 15; return 8 * (i >> 2) + 4 * n + (i & 3); }

struct Unit { int pm, pn; };
struct Gemm { const bf16_t* A; const bf16_t* Bt; int M, N, K, lda, ldb; };

struct StaticOrder {
    int nM, nN, nwg, G, c;
    __host__ __device__ void init(int M, int N, int G_, int c_) { nM = M / BM; nN = N / BM; nwg = nM * nN; G = G_; c = c_; }
    __host__ __device__ bool next(int i, Unit& u) const {
        const long L = (long)i * G + c; if (L >= nwg) return false;
        int wgid = (int)L; { const int q = nwg / NXCD, r = nwg % NXCD, xcd = wgid % NXCD, off = wgid / NXCD; wgid = (xcd < r ? xcd * (q + 1) : r * (q + 1) + (xcd - r) * q) + off; }
        const int nig = WGM * nN, gid = wgid / nig, fm = gid * WGM, gsz = (nM - fm) < WGM ? (nM - fm) : WGM;
        u.pm = fm + ((wgid % nig) % gsz); u.pn = (wgid % nig) / gsz; return true;
    }
    __device__ __forceinline__ void a_ready(const Unit&) const {}
    __device__ __forceinline__ void done(const Unit&) const {}
};

__device__ __forceinline__ unsigned cvt_pk_bf16(float lo, float hi) { unsigned r; asm volatile("v_cvt_pk_bf16_f32 %0, %1, %2" : "=v"(r) : "v"(lo), "v"(hi)); return r; }
typedef float f32x2 __attribute__((ext_vector_type(2)));
__device__ __forceinline__ f32x2 gelu_pk(f32x2 v) {
    const f32x2 av = __builtin_elementwise_abs(v), d = av * 0.2316418882f + 1.0f;
    f32x2 t; t.x = __builtin_amdgcn_rcpf(d.x); t.y = __builtin_amdgcn_rcpf(d.y);
    f32x2 q = t * 0.5307027145f + (-0.7265760135f); q = q * t + 0.7107068705f; q = q * t + (-0.142248368f); q = q * t + 0.127414796f; q = q * t;
    const f32x2 s = (v * v) * (-0.72134752044f);
    f32x2 e; e.x = __builtin_amdgcn_exp2f(s.x); e.y = __builtin_amdgcn_exp2f(s.y);
    const f32x2 m = v * (q * e), r = v - m;
    f32x2 o; o.x = v.x < 0.f ? m.x : r.x; o.y = v.y < 0.f ? m.y : r.y; return o;
}

template <int ACT  > struct EpiBf16 {
    static constexpr bool PERM = true, AFTER_DRAIN = false; static_assert(ACT == 0 || ACT == 1, "EpiBf16: ACT is 0 (none) or 1 (gelu_pk)");
    bf16_t* O; int ldc; const float* bias; int split_cols; size_t split_stride; float scale0;
    __device__ __forceinline__ void operator()(const f32x4 (&acc)[2][2][4][2], const Unit& u, int wr, int wc, int fr, int fq) const {
        const int row0 = u.pm * BM + wr * 64 + fr; int colt = u.pn * BM; bf16_t* base = O;
        float sc = 1.f; if (split_cols) { const int t = colt / split_cols; base += (size_t)t * split_stride; colt -= t * split_cols; if (t == 0) sc = scale0; }
        const int col0 = colt + wc * 32 + 8 * fq, bcol0 = u.pn * BM + wc * 32 + 8 * fq;
        f32x4 bv[2][2];
#pragma unroll
        for (int bj = 0; bj < 2; ++bj)
#pragma unroll
            for (int n = 0; n < 2; ++n) bv[bj][n] = bias ? *(const f32x4*)(bias + bcol0 + bj * HALF + 4 * n) : (f32x4){0.f, 0.f, 0.f, 0.f};
#pragma unroll
        for (int ai = 0; ai < 2; ++ai)
#pragma unroll
            for (int m = 0; m < 4; ++m) { bf16_t* rowp = base + (size_t)(row0 + ai * HALF + m * 16) * ldc + col0;
#pragma unroll
                for (int bj = 0; bj < 2; ++bj) { f32x4 v0 = acc[ai][bj][m][0] + bv[bj][0], v1 = acc[ai][bj][m][1] + bv[bj][1];
                    if (ACT == 1) { f32x2 a = gelu_pk((f32x2){v0[0], v0[1]}), b = gelu_pk((f32x2){v0[2], v0[3]}), c = gelu_pk((f32x2){v1[0], v1[1]}), d = gelu_pk((f32x2){v1[2], v1[3]});
                        v0 = (f32x4){a.x, a.y, b.x, b.y}; v1 = (f32x4){c.x, c.y, d.x, d.y}; }
                    v0 = v0 * sc; v1 = v1 * sc; u32x4 w; w.x = cvt_pk_bf16(v0[0], v0[1]); w.y = cvt_pk_bf16(v0[2], v0[3]); w.z = cvt_pk_bf16(v1[0], v1[1]); w.w = cvt_pk_bf16(v1[2], v1[3]);
                    *(__attribute__((address_space(1))) u32x4*)(rowp + bj * HALF) = w; } }
    }
};
template <class Epi, class Sched, bool ALIGN_EPI = false, bool SP2 = false>
__device__ __forceinline__ void gemm_phase(PG8_LAS unsigned char* lds, const Gemm g, const Sched& S, const Epi& E, const int tid) {
    const int wid = __builtin_amdgcn_readfirstlane(tid >> 6), lane = tid & 63, wr = wid >> 2, wc = wid & 3, fr = lane & 15, fq = lane >> 4;
    const int K = g.K, nt = K / BK;
    unsigned voffA[2], voffB[2];
#pragma unroll
    for (int i = 0; i < 2; ++i) { int R, C; stage_rc(tid * 16 + i * 8192, R, C); const int Rb = Epi::PERM ? ((R & ~31) + perm32(R & 31)) : R;
        voffA[i] = (unsigned)(R * g.lda + C) * 2u; voffB[i] = (unsigned)(Rb * g.ldb + C) * 2u; }
    const size_t kstep = (size_t)(BK * 2);
    const size_t hstepA = (size_t)HALF * g.lda * 2, hstepB = (size_t)HALF * g.ldb * 2;
    const size_t tstepA = 2 * hstepA, tstepB = 2 * hstepB;
    const unsigned ldsw = (unsigned)wid * 1024u;
    const int aoff = lds_byte(wr * 64 + fr, fq * 8), boff = lds_byte(wc * 32 + fr, fq * 8);
#define PG8_SA(b, h) (((b) * 2 + (h)) * HTB)
#define PG8_SB(b, h) ((4 + (b) * 2 + (h)) * HTB)
#define PG8_STAGE(bufoff, gbase, voff) do { _Pragma("unroll") for (int _i = 0; _i < 2; ++_i) \
        __builtin_amdgcn_global_load_lds((const unsigned*)((const char*)(gbase) + (voff)[_i]), (PG8_LAS unsigned*)(lds + (bufoff) + ldsw + _i * 8192), 16, 0, 0); } while (0)
#define PG8_LDA(dst, b, h) do { _Pragma("unroll") for (int m = 0; m < 4; ++m) _Pragma("unroll") for (int k = 0; k < 2; ++k) dst[m][k] = *(const PG8_LAS bf16x8*)(lds + PG8_SA(b, h) + aoff + m * 2048 + k * 1024); } while (0)
#define PG8_LDB(dst, b, h) do { _Pragma("unroll") for (int n = 0; n < 2; ++n) _Pragma("unroll") for (int k = 0; k < 2; ++k) dst[n][k] = *(const PG8_LAS bf16x8*)(lds + PG8_SB(b, h) + boff + n * 2048 + k * 1024); } while (0)
#define PG8_MMA(ai, bj, At, Bt) do { __builtin_amdgcn_s_setprio(1); _Pragma("unroll") for (int m = 0; m < 4; ++m) _Pragma("unroll") for (int n = 0; n < 2; ++n) _Pragma("unroll") for (int k = 0; k < 2; ++k) \
        acc[ai][bj][m][n] = __builtin_amdgcn_mfma_f32_16x16x32_bf16(Bt[n][k], At[m][k], acc[ai][bj][m][n], 0, 0, 0); __builtin_amdgcn_s_setprio(0); } while (0)
#define PG8_WAIT_V(n) asm volatile("s_waitcnt vmcnt(" #n ")" ::: "memory")
#define PG8_WAIT_L(n) asm volatile("s_waitcnt lgkmcnt(" #n ")" ::: "memory")
#define PG8_BAR __builtin_amdgcn_s_barrier()
#define PG8_SCHED __builtin_amdgcn_sched_barrier(0)
    Unit cur, nxt; int ui = 0;
    if (!S.next(0, cur)) return;
    f32x4 acc[2][2][4][2];
#pragma unroll
    for (int a = 0; a < 2; ++a)
#pragma unroll
        for (int b = 0; b < 2; ++b)
#pragma unroll
            for (int m = 0; m < 4; ++m)
#pragma unroll
                for (int n = 0; n < 2; ++n) acc[a][b][m][n] = (f32x4){0.f, 0.f, 0.f, 0.f};
    bf16x8 At[4][2], B0[2][2], B1[2][2];
    const char* cA = (const char*)g.A + (size_t)cur.pm * tstepA; const char* cB = (const char*)g.Bt + (size_t)cur.pn * tstepB;
    S.a_ready(cur);
    if constexpr (SP2) {
        PG8_STAGE(PG8_SB(0, 0), cB, voffB); PG8_STAGE(PG8_SB(0, 1), cB + hstepB, voffB); PG8_STAGE(PG8_SA(0, 0), cA, voffA); PG8_STAGE(PG8_SA(0, 1), cA + hstepA, voffA);
        if (wr == 1) PG8_BAR;
        PG8_WAIT_V(2); PG8_BAR;
        PG8_STAGE(PG8_SB(1, 0), cB + kstep, voffB); PG8_STAGE(PG8_SA(1, 0), cA + kstep, voffA); PG8_STAGE(PG8_SB(1, 1), cB + hstepB + kstep, voffB);
        PG8_WAIT_V(6); PG8_BAR;
    } else {
        PG8_STAGE(PG8_SB(0, 0), cB, voffB); PG8_STAGE(PG8_SA(0, 0), cA, voffA); PG8_STAGE(PG8_SB(0, 1), cB + hstepB, voffB); PG8_STAGE(PG8_SA(0, 1), cA + hstepA, voffA);
        if (wr == 1) PG8_BAR;
        PG8_WAIT_V(4); PG8_BAR;
        PG8_STAGE(PG8_SB(1, 0), cB + kstep, voffB); PG8_STAGE(PG8_SA(1, 0), cA + kstep, voffA); PG8_STAGE(PG8_SB(1, 1), cB + hstepB + kstep, voffB);
        PG8_WAIT_V(6); PG8_BAR;
    }
    for (;;) {
        const bool has_next = S.next(ui + 1, nxt);
        const char* nA = has_next ? (const char*)g.A + (size_t)nxt.pm * tstepA : cA; const char* nB = has_next ? (const char*)g.Bt + (size_t)nxt.pn * tstepB : cB;
        for (int t = 0; t < nt; t += 2) {
            const bool last = (t == nt - 2);
            const char* a1 = cA + (size_t)(t + 1) * kstep;
            const char* a2 = last ? nA : cA + (size_t)(t + 2) * kstep; const char* b2 = last ? nB : cB + (size_t)(t + 2) * kstep;
            const char* a3 = a2 + kstep; const char* b3 = b2 + kstep;
            if (last && has_next) S.a_ready(nxt);
            if constexpr (SP2) {
            PG8_LDB(B0, 0, 0); PG8_LDB(B1, 0, 1); PG8_SCHED; PG8_LDA(At, 0, 0); PG8_STAGE(PG8_SA(1, 1), a1 + hstepA, voffA);
            PG8_WAIT_V(8); PG8_WAIT_L(0); PG8_BAR; PG8_MMA(0, 0, At, B0); PG8_MMA(0, 1, At, B1); PG8_BAR; PG8_SCHED;
            PG8_LDA(At, 0, 1); PG8_STAGE(PG8_SB(0, 0), b2, voffB); PG8_STAGE(PG8_SB(0, 1), b2 + hstepB, voffB); PG8_STAGE(PG8_SA(0, 0), a2, voffA);
            PG8_WAIT_V(8); PG8_WAIT_L(0); PG8_BAR; PG8_MMA(1, 0, At, B0); PG8_MMA(1, 1, At, B1); PG8_BAR; PG8_SCHED;
            PG8_LDB(B0, 1, 0); PG8_LDB(B1, 1, 1); PG8_SCHED; PG8_LDA(At, 1, 0); PG8_STAGE(PG8_SA(0, 1), a2 + hstepA, voffA);
            PG8_WAIT_V(8); PG8_WAIT_L(0); PG8_BAR; PG8_MMA(0, 0, At, B0); PG8_MMA(0, 1, At, B1); PG8_BAR; PG8_SCHED;
            PG8_LDA(At, 1, 1); PG8_STAGE(PG8_SB(1, 0), b3, voffB); PG8_STAGE(PG8_SB(1, 1), b3 + hstepB, voffB); PG8_STAGE(PG8_SA(1, 0), a3, voffA);
            PG8_WAIT_V(8); PG8_WAIT_L(0); PG8_BAR; PG8_MMA(1, 0, At, B0); PG8_MMA(1, 1, At, B1); PG8_BAR; PG8_SCHED;
            } else {
            PG8_LDB(B0, 0, 0); PG8_SCHED; PG8_LDA(At, 0, 0); PG8_STAGE(PG8_SA(1, 1), a1 + hstepA, voffA);
            PG8_WAIT_L(8); PG8_BAR; PG8_WAIT_L(0); PG8_MMA(0, 0, At, B0); PG8_BAR; PG8_SCHED;
            PG8_LDB(B1, 0, 1); PG8_STAGE(PG8_SB(0, 0), b2, voffB);
            PG8_BAR; PG8_WAIT_L(0); PG8_MMA(0, 1, At, B1); PG8_BAR;
            PG8_LDA(At, 0, 1); PG8_STAGE(PG8_SA(0, 0), a2, voffA);
            PG8_BAR; PG8_WAIT_L(0); PG8_MMA(1, 0, At, B0); PG8_BAR; PG8_SCHED;
            PG8_STAGE(PG8_SB(0, 1), b2 + hstepB, voffB);
            PG8_WAIT_V(6); PG8_BAR; PG8_MMA(1, 1, At, B1); PG8_BAR;
            PG8_LDB(B0, 1, 0); PG8_SCHED; PG8_LDA(At, 1, 0); PG8_STAGE(PG8_SA(0, 1), a2 + hstepA, voffA);
            PG8_WAIT_L(8); PG8_BAR; PG8_WAIT_L(0); PG8_MMA(0, 0, At, B0); PG8_BAR; PG8_SCHED;
            PG8_LDB(B1, 1, 1); PG8_STAGE(PG8_SB(1, 0), b3, voffB);
            PG8_BAR; PG8_WAIT_L(0); PG8_MMA(0, 1, At, B1); PG8_BAR;
            PG8_LDA(At, 1, 1); PG8_STAGE(PG8_SA(1, 0), a3, voffA);
            PG8_BAR; PG8_WAIT_L(0); PG8_MMA(1, 0, At, B0); PG8_BAR; PG8_SCHED;
            PG8_STAGE(PG8_SB(1, 1), b3 + hstepB, voffB);
            PG8_WAIT_V(6); PG8_BAR; PG8_MMA(1, 1, At, B1); PG8_BAR;
            }
        }
        if constexpr (ALIGN_EPI) { if (wr == 0) PG8_BAR; }
        if constexpr (!Epi::AFTER_DRAIN) { E(acc, cur, wr, wc, fr, fq); S.done(cur); }
        if (!has_next) break;
#pragma unroll
        for (int a = 0; a < 2; ++a)
#pragma unroll
            for (int b = 0; b < 2; ++b)
#pragma unroll
                for (int m = 0; m < 4; ++m)
#pragma unroll
                    for (int n = 0; n < 2; ++n) acc[a][b][m][n] = (f32x4){0.f, 0.f, 0.f, 0.f};
        cur = nxt; cA = nA; cB = nB; ++ui;
        if constexpr (ALIGN_EPI) { if (wr == 1) PG8_BAR; }
    }
    PG8_WAIT_V(0);
    if constexpr (!ALIGN_EPI) { if (wr == 0) PG8_BAR; }
    PG8_BAR;
    if constexpr (Epi::AFTER_DRAIN) { E.fused(acc, cur, wr, wc, fr, fq, lds, wid, lane); S.done(cur); }
#undef PG8_SA
#undef PG8_SB
#undef PG8_STAGE
#undef PG8_LDA
#undef PG8_LDB
#undef PG8_MMA
#undef PG8_WAIT_V
#undef PG8_WAIT_L
#undef PG8_BAR
#undef PG8_SCHED
}
}
#define LAS __attribute__((address_space(3)))
#define GAS __attribute__((address_space(1)))
typedef unsigned short bf16_t;
typedef short bf16x8 __attribute__((ext_vector_type(8)));
typedef short s16x4 __attribute__((ext_vector_type(4)));
typedef float f32x4 __attribute__((ext_vector_type(4)));
typedef float f32x16 __attribute__((ext_vector_type(16)));
typedef unsigned u32x4 __attribute__((ext_vector_type(4)));
typedef unsigned u32x2 __attribute__((ext_vector_type(2)));
typedef float f32x2 __attribute__((ext_vector_type(2)));

constexpr int NB = 8, SEQ = 8192, DM = 1024, CTX = 256, MLAT = NB * SEQ, MCTX = NB * CTX, MALL = MLAT + MCTX;
constexpr int PW = 1536, KVLEN = CTX + SEQ, DFF = 2816, NMOD = 6 * DM;
constexpr int NCH = 32, CHL = 256;
constexpr float EPS = 1e-6f;
constexpr float QSCALE = 0.10206207261596575f * 1.4426950408889634f;
constexpr size_t MiB = 1u << 20;
constexpr size_t WS_CTL = 0, CTL_BYTES = 2 * MiB;
constexpr size_t WS_MOD = 64 * 1024, WS_SSQ = 512 * 1024, WS_SSKV = 1024 * 1024, WS_BAR = 1600 * 1024;
constexpr size_t WS_WIN = 2 * MiB, WS_WQ = 5 * MiB, WS_WKV = 6 * MiB, WS_WG = 7 * MiB, WS_WOUT = 8 * MiB, WS_WUP = 10 * MiB, WS_WDN = 21 * MiB;
constexpr size_t WS_AGG = 27 * MiB, WS_ROPE = 29 * MiB + 512 * 1024;
constexpr size_t WS_R1 = 30 * MiB;
constexpr size_t WS_R2 = 162 * MiB;
constexpr size_t WS_LU = 360 * MiB, WS_K = 624 * MiB, WS_V = 723 * MiB, WS_A2 = 789 * MiB;
constexpr size_t WS_UP = 360 * MiB, WS_G = 712 * MiB, WS_Q = 920 * MiB, WS_END = 1016 * MiB;
constexpr int LDS_BYTES = 139264;
constexpr int LDS_MISC = 131072 + 64;

__device__ __forceinline__ unsigned f2bf(float f) { unsigned u = __builtin_bit_cast(unsigned, f); return (u + 0x7fffu + ((u >> 16) & 1u)) >> 16; }
__device__ __forceinline__ unsigned cvtpk(float lo, float hi) { typedef float f2 __attribute__((ext_vector_type(2))); typedef __bf16 b2 __attribute__((ext_vector_type(2))); f2 v = {lo, hi}; b2 r = __builtin_convertvector(v, b2); return __builtin_bit_cast(unsigned, r); }
__device__ __forceinline__ unsigned pk2(float lo, float hi) { return cvtpk(lo, hi); }
__device__ __forceinline__ float bflo(unsigned w) { return __uint_as_float(w << 16); }
__device__ __forceinline__ float bfhi(unsigned w) { return __uint_as_float(w & 0xffff0000u); }
__device__ __forceinline__ float bf2f(bf16_t v) { return __uint_as_float((unsigned)v << 16); }
__device__ __forceinline__ int crow(int r, int hi) { return (r & 3) + 8 * (r >> 2) + 4 * hi; }
__device__ __forceinline__ float wave_sum(float v) {
#pragma unroll
    for (int o = 1; o < 64; o <<= 1) v += __shfl_xor(v, o);
    return v;
}
__device__ __forceinline__ float sigmoidf_(float x) { return __builtin_amdgcn_rcpf(1.f + __builtin_amdgcn_exp2f(-1.4426950408889634f * x)); }
#define LDS_WAIT() asm volatile("s_waitcnt lgkmcnt(0)" ::: "memory")
#define XB_TMO      128
#define XB_XCNT(j)  (256  + 64 * (j))
#define XB_XSUB(j)  (1280 + 64 * (j))
#define XB_XGEN(j)  (2304 + 64 * (j))
#define XB_TOP      3328
#define XB_TOPGEN   3392
#define XCD_BAR_WORDS 3456
#define XB_SPIN_CAP (1u << 18)

__device__ __forceinline__ unsigned xb_ld(unsigned* p)              { return __hip_atomic_load(p, __ATOMIC_RELAXED, __HIP_MEMORY_SCOPE_AGENT); }
__device__ __forceinline__ unsigned xb_add(unsigned* p, unsigned v) { return __hip_atomic_fetch_add(p, v, __ATOMIC_RELAXED, __HIP_MEMORY_SCOPE_AGENT); }
__device__ __forceinline__ unsigned xb_xcc_id() { return (unsigned)__builtin_amdgcn_s_getreg((3 << 11) | 20) & 0xFu; }
#define XB_SPIN(cond, bar) do { unsigned _sp = 0; while (cond) { __builtin_amdgcn_s_sleep(1); \
    if ((++_sp & 255u) == 0u) { if (xb_ld(&(bar)[XB_TMO])) break; if (_sp > XB_SPIN_CAP) { atomicAdd(&(bar)[XB_TMO], 1u); break; } } } } while (0)

struct XcdBarrier {
    unsigned* bar; unsigned x;
    volatile LAS unsigned* st;
};

__device__ __forceinline__ XcdBarrier xcd_barrier_post(unsigned* bar, volatile LAS unsigned* st) {
    XcdBarrier b; b.bar = bar; b.x = xb_xcc_id(); b.st = st;
    if (threadIdx.x == 0) (void)xb_add(&bar[XB_XCNT(b.x)], 1u);
    return b;
}
__device__ __forceinline__ void xcd_barrier_complete(unsigned* bar, unsigned x, unsigned& nloc, unsigned& nx) {
    const unsigned G = gridDim.x * gridDim.y * gridDim.z;
    unsigned sum, cnt, mine, sp = 0u;
    for (;;) {
        sum = 0u; cnt = 0u; mine = 0u;
#pragma unroll
        for (unsigned j = 0; j < 16; ++j) { const unsigned c = xb_ld(&bar[XB_XCNT(j)]); sum += c; cnt += (c > 0u) ? 1u : 0u; mine = (j == x) ? c : mine; }
        if (sum == G) break;
        __builtin_amdgcn_s_sleep(1);
        if ((++sp & 255u) == 0u) { if (xb_ld(&bar[XB_TMO])) break; if (sp > XB_SPIN_CAP) { atomicAdd(&bar[XB_TMO], 1u); break; } }
    }
    nloc = mine > 0u ? mine : 1u; nx = cnt > 0u ? cnt : 1u;
}

__device__ __forceinline__ void xcd_barrier(const XcdBarrier& b) {
    asm volatile("s_waitcnt vmcnt(0)" ::: "memory");
    __syncthreads();
    if (threadIdx.x == 0) {
        unsigned* bar = b.bar;
        __builtin_amdgcn_s_waitcnt(0);
        unsigned nloc = b.st[0], nx = b.st[1];
        if (nloc == 0u) { xcd_barrier_complete(bar, b.x, nloc, nx); b.st[0] = nloc; b.st[1] = nx; }
        const unsigned old = xb_add(&bar[XB_XSUB(b.x)], 1u);
        const unsigned gen = old / nloc;
        if (old + 1u == (gen + 1u) * nloc) {
            __builtin_amdgcn_fence(__ATOMIC_RELEASE, "agent");
            asm volatile("s_waitcnt vmcnt(0)" ::: "memory");
            const unsigned og = xb_add(&bar[XB_TOP], 1u);
            const unsigned tg = og / nx;
            if (og + 1u == (tg + 1u) * nx) xb_add(&bar[XB_TOPGEN], 1u);
            else XB_SPIN(xb_ld(&bar[XB_TOPGEN]) == tg, bar);
            __builtin_amdgcn_fence(__ATOMIC_ACQUIRE, "agent");
            xb_add(&bar[XB_XGEN(b.x)], 1u);
            asm volatile("s_waitcnt vmcnt(0)" ::: "memory");
        } else {
            XB_SPIN(xb_ld(&bar[XB_XGEN(b.x)]) == gen, bar);
            __builtin_amdgcn_fence(__ATOMIC_ACQUIRE, "agent");
            asm volatile("s_waitcnt vmcnt(0)" ::: "memory");
        }
    }
    __syncthreads();
}


struct Args { const float* in[27]; float* out; unsigned char* ws; int ph_lo, ph_hi; };
__device__ __forceinline__ const GAS float* argp(int i) {
    const __attribute__((address_space(4))) char* kp = (const __attribute__((address_space(4))) char*)__builtin_amdgcn_kernarg_segment_ptr();
    asm volatile("" : "+s"(kp));
    const float* p = *(const float* const __attribute__((address_space(4)))*)(kp + 8 * i);
    return (const GAS float*)p;
}

template <int ID> __device__ __forceinline__ float wsrc(const GAS float* __restrict__ p0, const GAS float* __restrict__ p1, int n, int k) {
    if (ID == 0) return n < 1440 ? p0[(size_t)k * 1440 + n] : 0.f;
    if (ID == 1) return p0[k] * p1[(size_t)k * 768 + n];
    if (ID == 2) return k < 128 ? p0[k] * p1[(size_t)k * 1024 + n] : 0.f;
    if (ID == 3) { const int h = n >> 8, np = n & 255, mat = np >> 6, j = np & 63, dir = mat >> 1; const GAS float* w = (mat & 1) ? p1 : p0; return w[(size_t)((dir * 8 + h) * 64 + k) * 64 + j]; }
    if (ID == 4) return p0[(size_t)k * 1024 + n];
    if (ID == 5) return p0[(size_t)k * 5632 + n];
    return p0[(size_t)k * 1024 + n];
}
template <int ID> __device__ __forceinline__ void prep_mat(const GAS float* __restrict__ p0, const GAS float* __restrict__ p1, GAS bf16_t* __restrict__ dst, int N, int K, int gtid, int NT) {
    const int items = N * (K / 8);
    for (int it = gtid; it < items; it += NT) {
        const int nl = it & 7, kl = (it >> 3) & 7, rest = it >> 6, nb = rest % (N / 8), kb = rest / (N / 8), n = nb * 8 + nl, k8 = kb * 8 + kl;
        u32x4 o;
        o.x = pk2(wsrc<ID>(p0, p1, n, 8 * k8 + 0), wsrc<ID>(p0, p1, n, 8 * k8 + 1)); o.y = pk2(wsrc<ID>(p0, p1, n, 8 * k8 + 2), wsrc<ID>(p0, p1, n, 8 * k8 + 3));
        o.z = pk2(wsrc<ID>(p0, p1, n, 8 * k8 + 4), wsrc<ID>(p0, p1, n, 8 * k8 + 5)); o.w = pk2(wsrc<ID>(p0, p1, n, 8 * k8 + 6), wsrc<ID>(p0, p1, n, 8 * k8 + 7));
        *(GAS u32x4*)(dst + (size_t)n * K + 8 * k8) = o;
    }
}
__device__ __forceinline__ void mod_phase(const GAS float* __restrict__ cvec, const GAS float* __restrict__ cctx, const GAS float* __restrict__ wmod, const GAS float* __restrict__ bmod, GAS float* __restrict__ mod, LAS float* scr, int gw, int NGW, int lane) {
    for (int task = gw; task < 96 * 16; task += NGW) {
        const int cgp = task % 96, kc = task / 96, n = cgp * 64 + lane, k0 = kc * 64;
#pragma unroll
        for (int r = 0; r < 9; ++r) { const float cv = r < 8 ? cvec[r * 1024 + k0 + lane] : cctx[k0 + lane]; scr[r * 64 + lane] = cv / (1.f + __expf(-cv)); }
        LDS_WAIT();
        float acc[9];
#pragma unroll
        for (int r = 0; r < 9; ++r) acc[r] = 0.f;
#pragma unroll 8
        for (int kk = 0; kk < 64; ++kk) { const float w = wmod[(size_t)(k0 + kk) * NMOD + n];
#pragma unroll
            for (int r = 0; r < 9; ++r) acc[r] += scr[r * 64 + kk] * w; }
        const float bias = kc == 0 ? bmod[n] : 0.f;
#pragma unroll
        for (int r = 0; r < 9; ++r) atomicAdd((float*)(mod + r * NMOD + n), acc[r] + bias);
        LDS_WAIT();
    }
}
__device__ __forceinline__ void p1_rows(const GAS float* __restrict__ x, const GAS float* __restrict__ ctx, const GAS float* __restrict__ g, const GAS float* __restrict__ mod, GAS bf16_t* __restrict__ H, int gw, int NGW, int lane) {
    for (int m0 = 2 * gw; m0 < MALL; m0 += 2 * NGW) {
        f32x4 v[2][4]; float ss[2];
#pragma unroll
        for (int r = 0; r < 2; ++r) { const int m = m0 + r; const GAS float* src = m < MLAT ? x + (size_t)m * DM : ctx + (size_t)(m - MLAT) * DM; ss[r] = 0.f;
#pragma unroll
            for (int j = 0; j < 4; ++j) { v[r][j] = *(const GAS f32x4*)(src + 4 * lane + 256 * j); ss[r] += v[r][j].x * v[r][j].x + v[r][j].y * v[r][j].y + v[r][j].z * v[r][j].z + v[r][j].w * v[r][j].w; } }
#pragma unroll
        for (int r = 0; r < 2; ++r) { const int m = m0 + r; const GAS float* md = mod + (m < MLAT ? (m >> 13) : 8) * NMOD;
            const float rs = rsqrtf(wave_sum(ss[r]) * (1.f / DM) + EPS);
#pragma unroll
            for (int j = 0; j < 4; ++j) { const int k = 4 * lane + 256 * j;
                const f32x4 gg = *(const GAS f32x4*)(g + k), sh = *(const GAS f32x4*)(md + k), sc = *(const GAS f32x4*)(md + DM + k);
                const f32x4 y = v[r][j] * rs * gg * (sc + 1.f) + sh;
                u32x2 o; o.x = pk2(y.x, y.y); o.y = pk2(y.z, y.w); *(GAS u32x2*)(H + (size_t)m * DM + k) = o; } }
    }
}
__device__ __forceinline__ void ss_phase(const GAS bf16_t* __restrict__ P, GAS float* __restrict__ ssq, GAS float* __restrict__ sskv, int gw, int NGW, int lane) {
#pragma unroll 4
    for (int m = gw; m < MALL; m += NGW) {
        const u32x2 q = *(const GAS u32x2*)(P + (size_t)m * PW + 1024 + 4 * lane); const unsigned k = *(const GAS unsigned*)(P + (size_t)m * PW + 1280 + 2 * lane);
        float a = bflo(q.x) * bflo(q.x) + bfhi(q.x) * bfhi(q.x) + bflo(q.y) * bflo(q.y) + bfhi(q.y) * bfhi(q.y), c = bflo(k) * bflo(k) + bfhi(k) * bfhi(k);
        a = wave_sum(a); c = wave_sum(c);
        if (lane == 0) { ssq[m] = a; sskv[m] = c; }
    }
}
__device__ __forceinline__ void qpost_phase(const GAS bf16_t* __restrict__ QR, const GAS float* __restrict__ ssq, const GAS float* __restrict__ RT, GAS bf16_t* __restrict__ Q, int gtid, int NT) {
#pragma unroll 4
    for (int task = gtid; task < MLAT * 96; task += NT) {
        const int row = task / 96, c8 = task - row * 96, h = c8 / 12, dc = c8 - h * 12, b = row >> 13, s = row & 8191;
        const float sc = rsqrtf(ssq[row] * (1.f / 256.f) + EPS) * QSCALE;
        const u32x4 mine = *(const GAS u32x4*)(QR + (size_t)row * 768 + 8 * c8);
        float v[8];
#pragma unroll
        for (int j = 0; j < 4; ++j) { v[2 * j] = bflo(mine[j]) * sc; v[2 * j + 1] = bfhi(mine[j]) * sc; }
        if (dc >= 8) { const int fq = dc - 8; const u32x4 oth = *(const GAS u32x4*)(QR + (size_t)row * 768 + 8 * (c8 ^ 1));
            const GAS float* rt = RT + (fq < 2 ? (s >> 6) : (s & 63)) * 16;
#pragma unroll
            for (int j = 0; j < 8; ++j) { const float pt = ((j & 1) ? bfhi(oth[j >> 1]) : bflo(oth[j >> 1])) * sc, cs = rt[2 * j], sn = rt[2 * j + 1];
                v[j] = (fq & 1) ? v[j] * cs + pt * sn : v[j] * cs - pt * sn; } }
        u32x4 w; w.x = pk2(v[0], v[1]); w.y = pk2(v[2], v[3]); w.z = pk2(v[4], v[5]); w.w = pk2(v[6], v[7]);
        *(GAS u32x4*)(Q + ((size_t)((b * 8 + h) * SEQ + s)) * 96 + 8 * dc) = w;
    }
}
__device__ __forceinline__ void kvpost_phase(const GAS bf16_t* __restrict__ KVR, const GAS float* __restrict__ sskv, GAS bf16_t* __restrict__ Kb, GAS bf16_t* __restrict__ Vt, int gtid, int NT) {
#pragma unroll 4
    for (int task = gtid; task < MALL * 64; task += NT) {
        const int row = task >> 6, c = task & 63, h = c >> 3, dd = (c & 7) * 8; const bool lat = row < MLAT;
        const int b = lat ? (row >> 13) : ((row - MLAT) >> 8), pos = lat ? (CTX + (row & 8191)) : ((row - MLAT) & 255);
        const float rs = rsqrtf(sskv[row] * (1.f / 128.f) + EPS);
        const u32x4 mine = *(const GAS u32x4*)(KVR + (size_t)row * 1024 + h * 128 + dd);
        u32x4 w;
#pragma unroll
        for (int j = 0; j < 4; ++j) w[j] = pk2(bflo(mine[j]) * rs, bfhi(mine[j]) * rs);
        *(GAS u32x4*)(Kb + ((size_t)(b * 8 + h) * KVLEN + pos) * 96 + dd) = w;
    }
#pragma unroll 2
    for (int task = gtid; task < (MALL / 8) * 128; task += NT) {
        const int pg = task & 7, dq = (task >> 3) & 7, rest = task >> 6, hd32 = rest & 15, rb = rest >> 4, h = hd32 >> 1, d = (hd32 & 1) * 32 + 4 * dq, row0 = rb * 64 + pg * 8; const bool lat = row0 < MLAT;
        const int b = lat ? (row0 >> 13) : ((row0 - MLAT) >> 8), pos0 = lat ? (CTX + (row0 & 8191)) : ((row0 - MLAT) & 255);
        float v[4][8];
#pragma unroll
        for (int i = 0; i < 8; ++i) { const u32x2 w = *(const GAS u32x2*)(KVR + (size_t)(row0 + i) * 1024 + h * 128 + 64 + d); const float rs = rsqrtf(sskv[row0 + i] * (1.f / 128.f) + EPS);
            v[0][i] = bflo(w.x) * rs; v[1][i] = bfhi(w.x) * rs; v[2][i] = bflo(w.y) * rs; v[3][i] = bfhi(w.y) * rs; }
        GAS bf16_t* vp = Vt + ((size_t)((b * 8 + h) * 64 + d)) * KVLEN + pos0;
#pragma unroll
        for (int j = 0; j < 4; ++j) { u32x4 w; w.x = pk2(v[j][0], v[j][1]); w.y = pk2(v[j][2], v[j][3]); w.z = pk2(v[j][4], v[j][5]); w.w = pk2(v[j][6], v[j][7]);
            *(GAS u32x4*)(vp + (size_t)j * KVLEN) = w; }
    }
}
__device__ __forceinline__ void krope_phase(const GAS bf16_t* __restrict__ P, GAS bf16_t* __restrict__ Kb, const GAS float* __restrict__ RT, int gtid, int NT) {
#pragma unroll 2
    for (int task = gtid; task < MALL * 4; task += NT) {
        const int row = task >> 2, fq = task & 3; const bool lat = row < MLAT;
        const int b = lat ? (row >> 13) : ((row - MLAT) >> 8), s = row & 8191, pos = lat ? (CTX + s) : ((row - MLAT) & 255);
        const u32x4 mine = *(const GAS u32x4*)(P + (size_t)row * PW + 1408 + 8 * fq), oth = *(const GAS u32x4*)(P + (size_t)row * PW + 1408 + 8 * (fq ^ 1));
        float v[8], pt[8];
#pragma unroll
        for (int j = 0; j < 4; ++j) { v[2 * j] = bflo(mine[j]); v[2 * j + 1] = bfhi(mine[j]); pt[2 * j] = bflo(oth[j]); pt[2 * j + 1] = bfhi(oth[j]); }
        if (lat) { const GAS float* rt = RT + (fq < 2 ? (s >> 6) : (s & 63)) * 16;
#pragma unroll
            for (int j = 0; j < 8; ++j) { const float cs = rt[2 * j], sn = rt[2 * j + 1]; v[j] = (fq & 1) ? v[j] * cs + pt[j] * sn : v[j] * cs - pt[j] * sn; } }
        u32x4 w; w.x = pk2(v[0], v[1]); w.y = pk2(v[2], v[3]); w.z = pk2(v[4], v[5]); w.w = pk2(v[6], v[7]);
#pragma unroll
        for (int h = 0; h < 8; ++h) *(GAS u32x4*)(Kb + ((size_t)(b * 8 + h) * KVLEN + pos) * 96 + 64 + 8 * fq) = w;
    }
}
#define MFMA32(a, b, c) __builtin_amdgcn_mfma_f32_32x32x16_bf16((a), (b), (c), 0, 0, 0)
__device__ __forceinline__ void gates_phase(const GAS float* __restrict__ cw, const GAS float* __restrict__ cb, const GAS float* __restrict__ b_a, const GAS float* __restrict__ b_x, const GAS float* __restrict__ lam, LAS unsigned char* lds, const GAS bf16_t* __restrict__ P, const GAS bf16_t* __restrict__ Wg, GAS unsigned* __restrict__ LU, GAS f32x2* __restrict__ AGG, int tid, int wave, int lane) {
    LAS bf16_t* xs = (LAS bf16_t*)(lds + wave * 4608);
    LAS f32x2* wagg = (LAS f32x2*)(lds + 8 * 4608);
    const int r32 = lane & 31, hi = lane >> 5;
    for (int unit = blockIdx.x; unit < (MALL / 256) * 8; unit += gridDim.x) {
        const int pm = unit >> 3, h = unit & 7, m0 = pm * 256 + wave * 32;
        const int s0 = m0 < MLAT ? (m0 & ~8191) : (MLAT + ((m0 - MLAT) & ~255)), slen = m0 < MLAT ? SEQ : CTX;
        {
            const int tok = lane >> 1, m = m0 + tok;
#pragma unroll
            for (int c8 = 0; c8 < 4; ++c8) { const int ch = (lane & 1) * 32 + c8 * 8, gch = h * 64 + ch;
                float acc[8];
                { const f32x4 b0 = *(const GAS f32x4*)(cb + gch), b1 = *(const GAS f32x4*)(cb + gch + 4);
                  acc[0] = b0.x; acc[1] = b0.y; acc[2] = b0.z; acc[3] = b0.w; acc[4] = b1.x; acc[5] = b1.y; acc[6] = b1.z; acc[7] = b1.w; }
#pragma unroll
                for (int k = 0; k < 4; ++k) { const int mm = m + k - 2;
                    if (mm >= s0 && mm < s0 + slen) { const u32x4 xv = *(const GAS u32x4*)(P + (size_t)mm * PW + gch);
                        const f32x4 w0 = *(const GAS f32x4*)(cw + k * 512 + gch), w1 = *(const GAS f32x4*)(cw + k * 512 + gch + 4);
                        acc[0] += w0.x * bflo(xv.x); acc[1] += w0.y * bfhi(xv.x); acc[2] += w0.z * bflo(xv.y); acc[3] += w0.w * bfhi(xv.y);
                        acc[4] += w1.x * bflo(xv.z); acc[5] += w1.y * bfhi(xv.z); acc[6] += w1.z * bflo(xv.w); acc[7] += w1.w * bfhi(xv.w); } }
                u32x4 o; o.x = pk2(acc[0], acc[1]); o.y = pk2(acc[2], acc[3]); o.z = pk2(acc[4], acc[5]); o.w = pk2(acc[6], acc[7]);
                *(LAS u32x4*)(xs + tok * 72 + ch) = o; }
        }
        LDS_WAIT();
        bf16x8 afr[4];
#pragma unroll
        for (int ks = 0; ks < 4; ++ks) afr[ks] = *(const LAS bf16x8*)(xs + r32 * 72 + 16 * ks + 8 * hi);
#pragma unroll
        for (int jh = 0; jh < 2; ++jh) {
            f32x16 acc4[4];
#pragma unroll
            for (int q = 0; q < 4; ++q) {
#pragma unroll
                for (int i = 0; i < 16; ++i) acc4[q][i] = 0.f;
                const GAS bf16_t* wrow = Wg + (size_t)(h * 256 + (2 * q + jh) * 32 + r32) * 64 + 8 * hi;
#pragma unroll
                for (int ks = 0; ks < 4; ++ks) { const bf16x8 bfr = *(const GAS bf16x8*)(wrow + 16 * ks); acc4[q] = MFMA32(afr[ks], bfr, acc4[q]); }
            }
            const int ch = jh * 32 + r32, gch = h * 64 + ch;
            float ba[2], bx[2], sp[2];
#pragma unroll
            for (int d = 0; d < 2; ++d) { ba[d] = b_a[d * 512 + gch]; bx[d] = b_x[d * 512 + gch]; sp[d] = lam[d * 512 + gch]; }
            unsigned wv[16][2]; float avs[16][2];
#pragma unroll
            for (int i = 0; i < 16; ++i) { const int row = crow(i, hi); const float xv = bf2f(xs[row * 72 + ch]);
#pragma unroll
                for (int d = 0; d < 2; ++d) { const float r = sigmoidf_(acc4[2 * d][i] + ba[d]), ig = sigmoidf_(acc4[2 * d + 1][i] + bx[d]);
                    const float la2 = bflo(f2bf(-r * sp[d])), av = __builtin_amdgcn_exp2f(la2); avs[i][d] = av;
                    const float uu = __builtin_amdgcn_sqrtf(fmaxf(1.f - av * av, 0.f)) * (ig * xv);
                    wv[i][d] = pk2(la2, uu);
                    LU[((size_t)(m0 + row) * 2 + d) * 512 + gch] = wv[i][d]; } }
#pragma unroll
            for (int d = 0; d < 2; ++d) {
                float Ar[4], Ur[4];
#pragma unroll
                for (int g = 0; g < 4; ++g) { float A = 1.f, U = 0.f;
#pragma unroll
                    for (int jj = 0; jj < 4; ++jj) { const int j = d ? 3 - jj : jj; const unsigned w = wv[4 * g + j][d]; const float av = avs[4 * g + j][d]; A *= av; U = av * U + bfhi(w); }
                    Ar[g] = A; Ur[g] = U; }
                float A = 1.f, U = 0.f;
#pragma unroll
                for (int gg = 0; gg < 4; ++gg) { const int g = d ? 3 - gg : gg;
                    const float Ao = __shfl_xor(Ar[g], 32), Uo = __shfl_xor(Ur[g], 32);
                    if (d == 0) { U = Ar[g] * U + Ur[g]; A *= Ar[g]; U = Ao * U + Uo; A *= Ao; }
                    else        { U = Ao * U + Uo; A *= Ao; U = Ar[g] * U + Ur[g]; A *= Ar[g]; } }
                if (hi == 0) wagg[(wave * 2 + d) * 64 + ch] = (f32x2){A, U};
            }
        }
        LDS_WAIT();
        __syncthreads();
        if (tid < 128) {
            const int d = tid >> 6, ch = tid & 63; float A = 1.f, U = 0.f;
#pragma unroll
            for (int ww = 0; ww < 8; ++ww) { const int w = d ? 7 - ww : ww; const f32x2 g = wagg[(w * 2 + d) * 64 + ch]; U = g.x * U + g.y; A *= g.x; }
            const int b = pm < MLAT / 256 ? (pm >> 5) : (pm - MLAT / 256), c = pm < MLAT / 256 ? (pm & 31) : NCH;
            AGG[(size_t)((b * 2 + d) * (NCH + 1) + c) * 512 + h * 64 + ch] = (f32x2){A, U};
        }
        __syncthreads();
    }
}
__device__ __forceinline__ void scan_agg(const GAS unsigned* __restrict__ LU, GAS f32x2* __restrict__ AGG, int gw, int NGW, int lane) {
    for (int task = gw; task < NB * 2 * (NCH + 1) * 8; task += NGW) {
        const int cgp = task & 7, c = (task >> 3) % (NCH + 1), d = (task / (8 * (NCH + 1))) & 1, b = task / (16 * (NCH + 1));
        const int ch = cgp * 64 + lane, row0 = c < NCH ? b * SEQ + c * CHL : MLAT + b * CTX;
        float A = 1.f, U = 0.f;
#pragma unroll 16
        for (int t = 0; t < CHL; ++t) { const int tt = d ? CHL - 1 - t : t; const unsigned w = LU[((size_t)(row0 + tt) * 2 + d) * 512 + ch];
            const float av = __builtin_amdgcn_exp2f(bflo(w)); A *= av; U = av * U + bfhi(w); }
        AGG[(size_t)((b * 2 + d) * (NCH + 1) + c) * 512 + ch] = (f32x2){A, U};
    }
}
__device__ __forceinline__ float gelu_tanh(float x) { const float z = 0.7978845608028654f * (x + 0.044715f * x * x * x);
    return x * __builtin_amdgcn_rcpf(1.f + __builtin_amdgcn_exp2f(-2.8853900817779268f * z)); }
__device__ __forceinline__ void scan_final(const GAS unsigned* __restrict__ LU, const GAS f32x2* __restrict__ AGG, const GAS bf16_t* __restrict__ P, GAS bf16_t* __restrict__ A2, int gw, int NGW, int lane) {
    constexpr int BT = 16;
    for (int task = gw; task < NB * NCH * 8; task += NGW) {
        const int cgp = task & 7, c = (task >> 3) & (NCH - 1), b = task / (8 * NCH), ch = cgp * 64 + lane, row0 = b * SEQ + c * CHL;
        const GAS f32x2* ag0 = AGG + (size_t)((b * 2 + 0) * (NCH + 1)) * 512 + ch; const GAS f32x2* ag1 = AGG + (size_t)((b * 2 + 1) * (NCH + 1)) * 512 + ch;
        unsigned w[BT], wn[BT];
#pragma unroll
        for (int i = 0; i < BT; ++i) w[i] = LU[((size_t)(row0 + i) * 2 + 0) * 512 + ch];
        float hf = ag0[(size_t)NCH * 512].y;
        for (int cc = 0; cc < c; ++cc) { const f32x2 g = ag0[(size_t)cc * 512]; hf = g.x * hf + g.y; }
        float hb = ag1[(size_t)NCH * 512].y;
        for (int cc = NCH - 1; cc > c; --cc) { const f32x2 g = ag1[(size_t)cc * 512]; hb = g.x * hb + g.y; }
#pragma unroll 1
        for (int t0 = 0; t0 < CHL; t0 += BT) {
            if (t0 + BT < CHL) {
#pragma unroll
                for (int i = 0; i < BT; ++i) wn[i] = LU[((size_t)(row0 + t0 + BT + i) * 2 + 0) * 512 + ch]; }
#pragma unroll
            for (int i = 0; i < BT; ++i) { hf = __builtin_amdgcn_exp2f(bflo(w[i])) * hf + bfhi(w[i]); A2[(size_t)(row0 + t0 + i) * DM + ch] = (bf16_t)f2bf(hf); }
#pragma unroll
            for (int i = 0; i < BT; ++i) w[i] = wn[i]; }
        bf16_t gr[BT], grn[BT];
#pragma unroll
        for (int i = 0; i < BT; ++i) { w[i] = LU[((size_t)(row0 + CHL - BT + i) * 2 + 1) * 512 + ch]; gr[i] = P[(size_t)(row0 + CHL - BT + i) * PW + 512 + ch]; }
#pragma unroll 1
        for (int t0 = CHL - BT; t0 >= 0; t0 -= BT) { bf16_t f[BT];
#pragma unroll
            for (int i = 0; i < BT; ++i) f[i] = A2[(size_t)(row0 + t0 + i) * DM + ch];
            if (t0 >= BT) {
#pragma unroll
                for (int i = 0; i < BT; ++i) { wn[i] = LU[((size_t)(row0 + t0 - BT + i) * 2 + 1) * 512 + ch]; grn[i] = P[(size_t)(row0 + t0 - BT + i) * PW + 512 + ch]; } }
#pragma unroll
            for (int i = BT - 1; i >= 0; --i) { hb = __builtin_amdgcn_exp2f(bflo(w[i])) * hb + bfhi(w[i]);
                A2[(size_t)(row0 + t0 + i) * DM + ch] = (bf16_t)f2bf((bf2f(f[i]) + hb) * gelu_tanh(bf2f(gr[i]))); }
#pragma unroll
            for (int i = 0; i < BT; ++i) { w[i] = wn[i]; gr[i] = grn[i]; } }
    }
}
constexpr int AT_KROW = 208, AT_VROW = 144;
constexpr float AT_THR = 8.f;
#define AT_LMAX(P, MX) do { MX = fmaxf(fmaxf(P[0], P[1]), fmaxf(P[2], P[3])); \
        _Pragma("unroll") for (int i_ = 4; i_ < 16; i_ += 4) MX = fmaxf(fmaxf(MX, P[i_]), fmaxf(fmaxf(P[i_ + 1], P[i_ + 2]), P[i_ + 3])); } while (0)
#define AT_SOFTMAX(P, MX, M, L, O0, O1, PW0, PW1) do { \
        if (__any(MX > M + AT_THR)) { const float mn_ = fmaxf(M, MX), al_ = __builtin_amdgcn_exp2f(M - mn_); M = mn_; L *= al_; \
            _Pragma("unroll") for (int i_ = 0; i_ < 16; ++i_) { O0[i_] *= al_; O1[i_] *= al_; } } \
        float s_ = 0.f; \
        _Pragma("unroll") for (int i_ = 0; i_ < 16; ++i_) { P[i_] = __builtin_amdgcn_exp2f(P[i_] - M); s_ += P[i_]; } \
        L += s_; \
        _Pragma("unroll") for (int j_ = 0; j_ < 4; ++j_) { PW0[j_] = cvtpk(P[2 * j_], P[2 * j_ + 1]); PW1[j_] = cvtpk(P[8 + 2 * j_], P[9 + 2 * j_]); } } while (0)
__device__ __forceinline__ void glds16(const GAS void* gsrc, unsigned lds_dst) {
    unsigned keep;
    asm volatile("s_mov_b32 %0, m0\n\ts_mov_b32 m0, %2\n\ts_nop 0\n\tglobal_load_lds_dwordx4 %1, off\n\ts_mov_b32 m0, %0" : "=&s"(keep) : "v"(gsrc), "s"(lds_dst) : "memory");
}
constexpr int AT_SLOT = 22 * 1024, AT_VOFF = 13 * 1024, AT_NP = 22;
__device__ __forceinline__ void attn_unit(LAS unsigned char* lds, const GAS bf16_t* __restrict__ QR, const GAS float* __restrict__ ssq, const GAS float* __restrict__ RT, const GAS bf16_t* __restrict__ K, const GAS bf16_t* __restrict__ Vt, GAS bf16_t* __restrict__ A2, int b, int h, int qb, int tid, int wave, int lane) {
    const int r32 = lane & 31, hi = lane >> 5, q0 = qb * 512 + wave * 64, r32s = (r32 & ~12) | ((r32 & 4) << 1) | ((r32 & 8) >> 1);
    bf16x8 qa[6], qc[6];
#pragma unroll
    for (int sub = 0; sub < 2; ++sub) {
        const int s = q0 + 32 * sub + r32, row = b * SEQ + s;
        const GAS bf16_t* Qp = QR + (size_t)row * 768 + h * 96 + 8 * hi;
        const float sc = rsqrtf(ssq[row] * (1.f / 256.f) + EPS) * QSCALE;
#pragma unroll
        for (int d0 = 0; d0 < 6; ++d0) {
            const u32x4 raw = *(const GAS u32x4*)(Qp + 16 * d0);
            float v[8];
#pragma unroll
            for (int j = 0; j < 4; ++j) { v[2 * j] = bflo(raw[j]) * sc; v[2 * j + 1] = bfhi(raw[j]) * sc; }
            if (d0 >= 4) { const GAS float* rt = RT + (d0 == 4 ? (s >> 6) : (s & 63)) * 16;
#pragma unroll
                for (int j = 0; j < 8; ++j) { const float pt = __shfl_xor(v[j], 32), cs = rt[2 * j], sn = rt[2 * j + 1]; v[j] = hi ? v[j] * cs + pt * sn : v[j] * cs - pt * sn; } }
            u32x4 w; w.x = pk2(v[0], v[1]); w.y = pk2(v[2], v[3]); w.z = pk2(v[4], v[5]); w.w = pk2(v[6], v[7]);
            if (sub == 0) qa[d0] = __builtin_bit_cast(bf16x8, w); else qc[d0] = __builtin_bit_cast(bf16x8, w);
        }
    }
    const GAS unsigned char* Kg = (const GAS unsigned char*)(K + (size_t)(b * 8 + h) * KVLEN * 96);
    const GAS unsigned char* Vg = (const GAS unsigned char*)(Vt + (size_t)(b * 8 + h) * 64 * KVLEN);
    const unsigned ldsb = (unsigned)(size_t)lds;
    const GAS unsigned char* src[3]; int stride[3]; unsigned dsto[3];
#pragma unroll
    for (int k = 0; k < 3; ++k) { int j = wave + 8 * k; if (j >= AT_NP) j -= 8; const int id = j * 64 + lane;
        if (j < 13) { const int row = id / 13; int col = id - row * 13; if (col == 12) col = 0; src[k] = Kg + row * 192 + col * 16; stride[k] = 12288; }
        else { const int idv = id - 832, d = idv / 9; int c = idv - d * 9; if (c == 8) c = 0; src[k] = Vg + ((size_t)d * KVLEN + c * 8) * 2; stride[k] = 128; }
        dsto[k] = ldsb + j * 1024; }
#define AT_ISSUE(t, slot) do { _Pragma("unroll") for (int k_ = 0; k_ < 3; ++k_) glds16(src[k_] + (size_t)(t) * stride[k_], (unsigned)__builtin_amdgcn_readfirstlane(dsto[k_] + (slot) * AT_SLOT)); } while (0)
    f32x16 oA0, oA1, oB0, oB1;
#pragma unroll
    for (int i = 0; i < 16; ++i) { oA0[i] = 0.f; oA1[i] = 0.f; oB0[i] = 0.f; oB1[i] = 0.f; }
    float mA = -1e30f, mB = -1e30f, lA = 0.f, lB = 0.f;
    constexpr int NT_ = KVLEN / 64;
    AT_ISSUE(0, 0); AT_ISSUE(1, 1);
    int slot = 0, nslot = 2;
#pragma unroll 1
    for (int t = 0; t < NT_; ++t) {
        if (t + 1 < NT_) asm volatile("s_waitcnt vmcnt(3) lgkmcnt(0)\n\ts_barrier" ::: "memory"); else asm volatile("s_waitcnt vmcnt(0) lgkmcnt(0)\n\ts_barrier" ::: "memory");
        if (t + 2 < NT_) AT_ISSUE(t + 2, nslot);
        const LAS unsigned char* sb = lds + slot * AT_SLOT;
#pragma unroll
        for (int hh = 0; hh < 2; ++hh) {
            const LAS unsigned char* kb = sb + (32 * hh + r32s) * AT_KROW + hi * 16;
            f32x16 pA, pB;
#pragma unroll
            for (int i = 0; i < 16; ++i) { pA[i] = 0.f; pB[i] = 0.f; }
#pragma unroll
            for (int d0 = 0; d0 < 6; ++d0) { const bf16x8 a0 = *(const LAS bf16x8*)(kb + d0 * 32); pA = MFMA32(a0, qa[d0], pA); pB = MFMA32(a0, qc[d0], pB); }
            u32x4 pwA0, pwA1, pwB0, pwB1;
            float mxA, mxB; AT_LMAX(pA, mxA); AT_LMAX(pB, mxB);
            { const float oa = __shfl_xor(mxA, 32), ob = __shfl_xor(mxB, 32); mxA = fmaxf(mxA, oa); mxB = fmaxf(mxB, ob); }
            AT_SOFTMAX(pA, mxA, mA, lA, oA0, oA1, pwA0, pwA1);
            AT_SOFTMAX(pB, mxB, mB, lB, oB0, oB1, pwB0, pwB1);
            const LAS unsigned char* vb = sb + AT_VOFF + r32 * AT_VROW + hi * 16 + hh * 64;
#pragma unroll
            for (int ks = 0; ks < 2; ++ks) {
                const bf16x8 va0 = *(const LAS bf16x8*)(vb + ks * 32), va1 = *(const LAS bf16x8*)(vb + 32 * AT_VROW + ks * 32);
                const bf16x8 pa = __builtin_bit_cast(bf16x8, ks ? pwA1 : pwA0), pb = __builtin_bit_cast(bf16x8, ks ? pwB1 : pwB0);
                oA0 = MFMA32(va0, pa, oA0); oA1 = MFMA32(va1, pa, oA1); oB0 = MFMA32(va0, pb, oB0); oB1 = MFMA32(va1, pb, oB1);
            }
        }
        slot = slot == 2 ? 0 : slot + 1; nslot = nslot == 2 ? 0 : nslot + 1;
    }
    asm volatile("s_waitcnt lgkmcnt(0)\n\ts_barrier" ::: "memory");
    {   const float inv = 1.f / (lA + __shfl_xor(lA, 32));
        GAS bf16_t* op = A2 + (size_t)(b * SEQ + q0 + r32) * DM + 512 + h * 64 + 4 * hi;
#pragma unroll
        for (int g = 0; g < 4; ++g) { u32x2 w0, w1; w0.x = pk2(oA0[4 * g] * inv, oA0[4 * g + 1] * inv); w0.y = pk2(oA0[4 * g + 2] * inv, oA0[4 * g + 3] * inv);
            w1.x = pk2(oA1[4 * g] * inv, oA1[4 * g + 1] * inv); w1.y = pk2(oA1[4 * g + 2] * inv, oA1[4 * g + 3] * inv);
            *(GAS u32x2*)(op + 8 * g) = w0; *(GAS u32x2*)(op + 32 + 8 * g) = w1; } }
    {   const float inv = 1.f / (lB + __shfl_xor(lB, 32));
        GAS bf16_t* op = A2 + (size_t)(b * SEQ + q0 + 32 + r32) * DM + 512 + h * 64 + 4 * hi;
#pragma unroll
        for (int g = 0; g < 4; ++g) { u32x2 w0, w1; w0.x = pk2(oB0[4 * g] * inv, oB0[4 * g + 1] * inv); w0.y = pk2(oB0[4 * g + 2] * inv, oB0[4 * g + 3] * inv);
            w1.x = pk2(oB1[4 * g] * inv, oB1[4 * g + 1] * inv); w1.y = pk2(oB1[4 * g + 2] * inv, oB1[4 * g + 3] * inv);
            *(GAS u32x2*)(op + 8 * g) = w0; *(GAS u32x2*)(op + 32 + 8 * g) = w1; } }
#undef AT_ISSUE
}
__device__ __forceinline__ void p7_rows(const GAS float* __restrict__ x, const GAS float* __restrict__ g_post, const GAS float* __restrict__ g_pre, GAS float* __restrict__ out, const GAS float* __restrict__ mod, const GAS bf16_t* __restrict__ Y, GAS bf16_t* __restrict__ H2, int gw, int NGW, int lane) {
    for (int m0 = 2 * gw; m0 < MLAT; m0 += 2 * NGW) {
        const GAS float* md = mod + (m0 >> 13) * NMOD;
        f32x4 y[2][4], xv[2][4]; float ss[2];
#pragma unroll
        for (int r = 0; r < 2; ++r) { ss[r] = 0.f;
#pragma unroll
            for (int j = 0; j < 4; ++j) { const u32x2 w = *(const GAS u32x2*)(Y + (size_t)(m0 + r) * DM + 4 * lane + 256 * j); xv[r][j] = *(const GAS f32x4*)(x + (size_t)(m0 + r) * DM + 4 * lane + 256 * j);
                y[r][j] = (f32x4){bflo(w.x), bfhi(w.x), bflo(w.y), bfhi(w.y)}; ss[r] += y[r][j].x * y[r][j].x + y[r][j].y * y[r][j].y + y[r][j].z * y[r][j].z + y[r][j].w * y[r][j].w; } }
#pragma unroll
        for (int r = 0; r < 2; ++r) { const int m = m0 + r;
            const float rs = rsqrtf(wave_sum(ss[r]) * (1.f / DM) + EPS); float s2 = 0.f;
#pragma unroll
            for (int j = 0; j < 4; ++j) { const int k = 4 * lane + 256 * j;
                const f32x4 gg = *(const GAS f32x4*)(g_post + k), gt = *(const GAS f32x4*)(md + 2 * DM + k);
                xv[r][j] = xv[r][j] + gt * (y[r][j] * rs * gg); *(GAS f32x4*)(out + (size_t)m * DM + k) = xv[r][j];
                s2 += xv[r][j].x * xv[r][j].x + xv[r][j].y * xv[r][j].y + xv[r][j].z * xv[r][j].z + xv[r][j].w * xv[r][j].w; }
            const float rs2 = rsqrtf(wave_sum(s2) * (1.f / DM) + EPS);
#pragma unroll
            for (int j = 0; j < 4; ++j) { const int k = 4 * lane + 256 * j;
                const f32x4 gg = *(const GAS f32x4*)(g_pre + k), sh = *(const GAS f32x4*)(md + 3 * DM + k), sc = *(const GAS f32x4*)(md + 4 * DM + k);
                const f32x4 hh = xv[r][j] * rs2 * gg * (sc + 1.f) + sh;
                u32x2 o; o.x = pk2(hh.x, hh.y); o.y = pk2(hh.z, hh.w); *(GAS u32x2*)(H2 + (size_t)m * DM + k) = o; } }
    }
}
__device__ __forceinline__ void p11_rows(const GAS float* __restrict__ g_post, GAS float* __restrict__ out, const GAS float* __restrict__ mod, const GAS bf16_t* __restrict__ Fb, int gw, int NGW, int lane) {
    for (int m0 = 2 * gw; m0 < MLAT; m0 += 2 * NGW) {
        const GAS float* md = mod + (m0 >> 13) * NMOD;
        f32x4 y[2][4], xv[2][4]; float ss[2];
#pragma unroll
        for (int r = 0; r < 2; ++r) { ss[r] = 0.f;
#pragma unroll
            for (int j = 0; j < 4; ++j) { const u32x2 w = *(const GAS u32x2*)(Fb + (size_t)(m0 + r) * DM + 4 * lane + 256 * j); xv[r][j] = *(const GAS f32x4*)(out + (size_t)(m0 + r) * DM + 4 * lane + 256 * j);
                y[r][j] = (f32x4){bflo(w.x), bfhi(w.x), bflo(w.y), bfhi(w.y)}; ss[r] += y[r][j].x * y[r][j].x + y[r][j].y * y[r][j].y + y[r][j].z * y[r][j].z + y[r][j].w * y[r][j].w; } }
#pragma unroll
        for (int r = 0; r < 2; ++r) { const float rs = rsqrtf(wave_sum(ss[r]) * (1.f / DM) + EPS);
#pragma unroll
            for (int j = 0; j < 4; ++j) { const int k = 4 * lane + 256 * j;
                const f32x4 gg = *(const GAS f32x4*)(g_post + k), gt = *(const GAS f32x4*)(md + 5 * DM + k);
                *(GAS f32x4*)(out + (size_t)(m0 + r) * DM + k) = xv[r][j] + gt * (y[r][j] * rs * gg); } }
    }
}
__device__ __forceinline__ void convgate_phase(const GAS float* __restrict__ cw, const GAS float* __restrict__ cb, const GAS bf16_t* __restrict__ UP, GAS bf16_t* __restrict__ G, int half, int gtid, int NT) {
    constexpr int JG = DFF / 8, RG = 32, NTASK = (MLAT / 2 / RG) * JG;
    for (int task = gtid; task < NTASK; task += NT) {
        const int jg = task % JG, rg = task / JG, j0 = jg * 8, r0 = rg * RG, m0 = half * (MLAT / 2) + r0;
        float wu[3][8], wg[3][8], bu[8], bg[8];
#pragma unroll
        for (int k = 0; k < 3; ++k)
#pragma unroll
            for (int i = 0; i < 8; ++i) { wu[k][i] = cw[k * 2 * DFF + j0 + i]; wg[k][i] = cw[k * 2 * DFF + DFF + j0 + i]; }
#pragma unroll
        for (int i = 0; i < 8; ++i) { bu[i] = cb[j0 + i]; bg[i] = cb[DFF + j0 + i]; }
        const GAS bf16_t* up = UP + (size_t)r0 * (2 * DFF) + j0;
        u32x4 pu = {0u, 0u, 0u, 0u}, pg = {0u, 0u, 0u, 0u}, cu, cg_, nu, ng;
        if ((m0 & 8191) != 0) { pu = *(const GAS u32x4*)(up - 2 * DFF); pg = *(const GAS u32x4*)(up - 2 * DFF + DFF); }
        cu = *(const GAS u32x4*)(up); cg_ = *(const GAS u32x4*)(up + DFF);
#pragma unroll 8
        for (int r = 0; r < RG; ++r) {
            const bool nv = (r + 1 < RG) || (((m0 + RG) & 8191) != 0);
            if (nv) { nu = *(const GAS u32x4*)(up + (size_t)(r + 1) * (2 * DFF)); ng = *(const GAS u32x4*)(up + (size_t)(r + 1) * (2 * DFF) + DFF); } else { nu = (u32x4){0u, 0u, 0u, 0u}; ng = nu; }
            float o[8];
#pragma unroll
            for (int i = 0; i < 8; ++i) { const int w_ = i >> 1;
                const float p_u = (i & 1) ? bfhi(pu[w_]) : bflo(pu[w_]), c_u = (i & 1) ? bfhi(cu[w_]) : bflo(cu[w_]), n_u = (i & 1) ? bfhi(nu[w_]) : bflo(nu[w_]);
                const float p_g = (i & 1) ? bfhi(pg[w_]) : bflo(pg[w_]), c_g = (i & 1) ? bfhi(cg_[w_]) : bflo(cg_[w_]), n_g = (i & 1) ? bfhi(ng[w_]) : bflo(ng[w_]);
                const float uv = bu[i] + wu[0][i] * p_u + wu[1][i] * c_u + wu[2][i] * n_u, gv = bg[i] + wg[0][i] * p_g + wg[1][i] * c_g + wg[2][i] * n_g;
                o[i] = gv * __builtin_amdgcn_rcpf(1.f + __builtin_amdgcn_exp2f(-1.4426950408889634f * gv)) * uv; }
            u32x4 w; w.x = pk2(o[0], o[1]); w.y = pk2(o[2], o[3]); w.z = pk2(o[4], o[5]); w.w = pk2(o[6], o[7]);
            *(GAS u32x4*)(G + (size_t)(r0 + r) * DFF + j0) = w;
            pu = cu; pg = cg_; cu = nu; cg_ = ng;
        }
    }
}
constexpr int NPH = 17;
__global__ void __launch_bounds__(512, 2) fwd_kernel(Args a) {
    extern __shared__ __attribute__((aligned(16))) unsigned char lds_raw[];
    LAS unsigned char* lds = (LAS unsigned char*)lds_raw;
    const int lo = a.ph_lo, hi_ = a.ph_hi;
    {
        volatile LAS unsigned* st0 = (volatile LAS unsigned*)(lds + LDS_MISC);
        if (threadIdx.x < 2) st0[threadIdx.x] = 0u;
        __syncthreads();
        (void)xcd_barrier_post((unsigned*)(a.ws + WS_BAR), st0);
    }
#if MK_COOP
    cg::grid_group grid = cg::this_grid();
#endif
    typedef pg8::EpiBf16<0> EpiB;
    constexpr int MH = MLAT / 2;
#ifndef REPMASK
#define REPMASK 0
#endif
    bool repeated = false;
#pragma unroll 1
    for (int ph = lo; ph < hi_; ++ph) {
        int tid = threadIdx.x; asm volatile("" : "+v"(tid));
        int G = gridDim.x, bx = blockIdx.x; asm volatile("" : "+s"(G), "+s"(bx));
        const int lane = tid & 63, wave = __builtin_amdgcn_readfirstlane(tid >> 6);
        const int vcu = (G % 8 == 0) ? (bx % 8) * (G / 8) + bx / 8 : bx;
        const int gw = vcu * 8 + wave, NGW = G * 8, gtid = bx * 512 + tid, NTH = G * 512;
        unsigned char* ws_ = a.ws; asm volatile("" : "+s"(ws_)); GAS unsigned char* ws = (GAS unsigned char*)ws_;
        GAS float* mod = (GAS float*)(ws + WS_MOD); GAS float* ssq = (GAS float*)(ws + WS_SSQ); GAS float* sskv = (GAS float*)(ws + WS_SSKV);
        GAS bf16_t* Win = (GAS bf16_t*)(ws + WS_WIN); GAS bf16_t* Wq = (GAS bf16_t*)(ws + WS_WQ); GAS bf16_t* Wkv = (GAS bf16_t*)(ws + WS_WKV); GAS bf16_t* Wg = (GAS bf16_t*)(ws + WS_WG);
        GAS bf16_t* Wout = (GAS bf16_t*)(ws + WS_WOUT); GAS bf16_t* Wup = (GAS bf16_t*)(ws + WS_WUP); GAS bf16_t* Wdn = (GAS bf16_t*)(ws + WS_WDN);
        GAS f32x2* AGG = (GAS f32x2*)(ws + WS_AGG); GAS float* RT = (GAS float*)(ws + WS_ROPE);
        GAS bf16_t* H = (GAS bf16_t*)(ws + WS_R1); GAS bf16_t* KVR = H; GAS bf16_t* H2 = H; GAS bf16_t* QR = (GAS bf16_t*)(ws + WS_Q);
        GAS bf16_t* P = (GAS bf16_t*)(ws + WS_R2); GAS bf16_t* Y = P; GAS bf16_t* Fb = P;
        GAS unsigned* LU = (GAS unsigned*)(ws + WS_LU); GAS bf16_t* Kb = (GAS bf16_t*)(ws + WS_K); GAS bf16_t* Vb = (GAS bf16_t*)(ws + WS_V); GAS bf16_t* A2 = (GAS bf16_t*)(ws + WS_A2);
        GAS bf16_t* UP = (GAS bf16_t*)(ws + WS_UP); GAS bf16_t* Gb = (GAS bf16_t*)(ws + WS_G);
        float* outp_ = a.out; asm volatile("" : "+s"(outp_)); GAS float* outp = (GAS float*)outp_;
        pg8::Gemm g{nullptr, nullptr, 0, 0, 0, 0, 0}; GAS bf16_t* O = nullptr; int ldc = 0;
        switch (ph) {
            case 2:  g = pg8::Gemm{(const bf16_t*)(H), (const bf16_t*)(Win), MALL, PW, DM, DM, DM}; O = P; ldc = PW; break;
            case 4:  g = pg8::Gemm{(const bf16_t*)(P + 1024), (const bf16_t*)(Wq), MLAT, 768, 256, PW, 256}; O = QR; ldc = 768; break;
            case 5:  g = pg8::Gemm{(const bf16_t*)(P + 1280), (const bf16_t*)(Wkv), MALL, 1024, 256, PW, 256}; O = KVR; ldc = 1024; break;
            case 8:  g = pg8::Gemm{(const bf16_t*)(A2), (const bf16_t*)(Wout), MLAT, DM, DM, DM, DM}; O = Y; ldc = DM; break;
            case 10: g = pg8::Gemm{(const bf16_t*)(H2), (const bf16_t*)(Wup), MH, 2 * DFF, DM, DM, DM}; O = UP; ldc = 2 * DFF; break;
            case 13: g = pg8::Gemm{(const bf16_t*)(H2 + (size_t)MH * DM), (const bf16_t*)(Wup), MH, 2 * DFF, DM, DM, DM}; O = UP; ldc = 2 * DFF; break;
            case 12: g = pg8::Gemm{(const bf16_t*)(Gb), (const bf16_t*)(Wdn), MH, DM, DFF, DFF, DFF}; O = Fb; ldc = DM; break;
            case 15: g = pg8::Gemm{(const bf16_t*)(Gb), (const bf16_t*)(Wdn), MH, DM, DFF, DFF, DFF}; O = Fb + (size_t)MH * DM; ldc = DM; break;
            default: break;
        }
        if (g.A != nullptr) {
            pg8::StaticOrder S; S.init(g.M, g.N, G, bx); EpiB E{(bf16_t*)O, ldc, nullptr, 0, 0, 1.f};
            pg8::gemm_phase<EpiB, pg8::StaticOrder, true, true>(lds, g, S, E, tid);
        }
#ifndef NGM
#define NGM 0x1ffff
#endif
#define NG(k) ((NGM >> (k)) & 1)
        else if (NG(0) && ph == 0) {
            prep_mat<0>(argp(10), nullptr, Win, 1536, 1024, gtid, NTH); prep_mat<1>(argp(18), argp(19), Wq, 768, 256, gtid, NTH); prep_mat<2>(argp(20), argp(21), Wkv, 1024, 256, gtid, NTH);
            prep_mat<3>(argp(13), argp(15), Wg, 2048, 64, gtid, NTH); prep_mat<4>(argp(22), nullptr, Wout, 1024, 1024, gtid, NTH); prep_mat<5>(argp(23), nullptr, Wup, 5632, 1024, gtid, NTH);
            prep_mat<6>(argp(26), nullptr, Wdn, 1024, 2816, gtid, NTH);
            if (gtid < 1024) { const float nl = -argp(17)[gtid]; RT[2048 + gtid] = 8.f * 1.4426950408889634f * (nl > 20.f ? nl : log1pf(__expf(nl))); }
            if (gtid < 1024) { const int pos = gtid >> 3, j = gtid & 7; const float invf[8] = {1.f, 0.31622776601683794f, 0.1f, 0.031622776601683794f, 0.01f, 0.0031622776601683794f, 0.001f, 0.00031622776601683794f};
                const float ang = (float)pos * invf[j]; RT[2 * gtid] = cosf(ang); RT[2 * gtid + 1] = sinf(ang); }
            mod_phase(argp(1), argp(3), argp(4), argp(5), mod, (LAS float*)(lds + wave * 4096), gw, NGW, lane);
        } else if (NG(1) && ph == 1) {
            p1_rows(argp(0), argp(2), argp(6), mod, H, gw, NGW, lane);
        } else if (NG(3) && ph == 3) {
            gates_phase(argp(11), argp(12), argp(14), argp(16), (const GAS float*)(RT + 2048), lds, P, Wg, LU, AGG, tid, wave, lane);
            ss_phase(P, ssq, sskv, gw, NGW, lane);
        } else if (NG(6) && ph == 6) {
            krope_phase(P, Kb, RT, gtid, NTH); kvpost_phase(KVR, sskv, Kb, Vb, gtid, NTH);
#ifdef REP6
            if (REP6 & 1) { __syncthreads(); scan_agg(LU, AGG, gw, NGW, lane); }
            if (REP6 & 2) { __syncthreads(); krope_phase(P, Kb, RT, gtid, NTH); }
            if (REP6 & 4) { __syncthreads(); }
            if (REP6 & 8) { __syncthreads(); kvpost_phase(KVR, sskv, Kb, Vb, gtid, NTH); }
#endif
        } else if (NG(7) && ph == 7) {
            scan_final(LU, AGG, P, A2, gw, NGW, lane);
#ifdef REP7
            __syncthreads(); scan_final(LU, AGG, P, A2, gw, NGW, lane);
#endif
            const int upb = (NB * 8 * 16 + G - 1) / G, u0 = vcu * upb, u1 = min(NB * 8 * 16, u0 + upb);
            __syncthreads();
            for (int unit = u0; unit < u1; ++unit) { const int bh = unit >> 4, qb = unit & 15; attn_unit(lds, QR, ssq, RT, Kb, Vb, A2, bh >> 3, bh & 7, qb, tid, wave, lane); }
        } else if (NG(9) && ph == 9) {
            p7_rows(argp(0), argp(7), argp(8), outp, mod, Y, H2, gw, NGW, lane);
        } else if (NG(11) && (ph == 11 || ph == 14)) {
            convgate_phase(argp(24), argp(25), UP, Gb, ph == 14 ? 1 : 0, gtid, NTH);
        } else if (NG(16) && ph == 16) {
            p11_rows(argp(9), outp, mod, Fb, gw, NGW, lane);
        }
        __syncthreads();
#if MK_COOP
        if (ph + 1 < hi_ && ph != 3 && ph != 4 && ph != 12) {
            if (ph == 0) grid.sync();
            else { XcdBarrier xb; xb.bar = (unsigned*)(ws_ + WS_BAR); xb.x = xb_xcc_id(); xb.st = (volatile LAS unsigned*)(lds + LDS_MISC); xcd_barrier(xb); }
        }
#endif
        if (REPMASK) { if (((REPMASK >> ph) & 1) && !repeated) { repeated = true; --ph; } else repeated = false; }
    }
}

extern "C" void kernel_launch(void* const* d_in, const int* in_sizes, int n_in, void* d_out, int out_size, void* d_ws, size_t ws_size, hipStream_t stream) {
    static int grid = 0;
    if (grid == 0) {
        if (n_in != 27 || out_size != MLAT * DM || ws_size < WS_END) { fprintf(stderr, "kernel_launch: unexpected shapes (n_in %d, out %d, ws %zu)\n", n_in, out_size, ws_size); grid = -1; return; }
        int dev = 0, cus = 0, per_cu = 0;
        if (hipGetDevice(&dev) != hipSuccess || hipDeviceGetAttribute(&cus, hipDeviceAttributeMultiprocessorCount, dev) != hipSuccess) { grid = -1; return; }
        if (hipFuncSetAttribute((const void*)fwd_kernel, hipFuncAttributeMaxDynamicSharedMemorySize, LDS_BYTES) != hipSuccess) { fprintf(stderr, "kernel_launch: hipFuncSetAttribute failed\n"); grid = -1; return; }
        if (hipOccupancyMaxActiveBlocksPerMultiprocessor(&per_cu, (const void*)fwd_kernel, 512, LDS_BYTES) != hipSuccess || per_cu < 1) { fprintf(stderr, "kernel_launch: occupancy query says %d\n", per_cu); }
        (void)hipGetLastError();
        grid = cus;
    }
    if (grid < 0) return;
    (void)hipMemsetAsync((char*)d_ws + WS_CTL, 0, CTL_BYTES, stream);
    Args a{};
    for (int i = 0; i < 27; ++i) a.in[i] = (const float*)d_in[i];
    a.out = (float*)d_out; a.ws = (unsigned char*)d_ws;
#if MK_COOP
    a.ph_lo = 0; a.ph_hi = NPH;
    void* args[] = {&a};
    hipError_t e = hipLaunchCooperativeKernel((const void*)fwd_kernel, dim3(grid), dim3(512), args, LDS_BYTES, stream);
    if (e != hipSuccess) fprintf(stderr, "kernel_launch: cooperative launch failed: %s (grid %d)\n", hipGetErrorString(e), grid);
#else
    for (int p = 0; p < NPH; ++p) { a.ph_lo = p; a.ph_hi = p + 1; hipLaunchKernelGGL(fwd_kernel, dim3(grid), dim3(512), LDS_BYTES, stream, a); }
#endif
}
```

```cpp
#include <hip/hip_runtime.h>
#include <hip/hip_cooperative_groups.h>
#include <cstdio>
#include <cstdint>
namespace cg = cooperative_groups;
#ifndef MK_COOP
#define MK_COOP 1
#endif
namespace pg8 {
#define PG8_LAS __attribute__((address_space(3)))
typedef unsigned short bf16_t;
typedef short bf16x8 __attribute__((ext_vector_type(8)));
typedef float f32x4 __attribute__((ext_vector_type(4)));
typedef unsigned u32x4 __attribute__((ext_vector_type(4)));
constexpr int BM = 256, BK = 64, HALF = 128, HTB = HALF * BK * 2  , STAGE_BYTES = 8 * HTB, NXCD = 8, WGM = 8;

__host__ __device__ __forceinline__ int lds_byte(int r, int c) { const int st = (r >> 4) * 2 + (c >> 5), rr = r & 15, cc = c & 31, ob = rr * 64 + cc * 2; return st * 1024 + (ob ^ (((ob >> 9) & 1) << 5)); }
__host__ __device__ __forceinline__ void stage_rc(int b, int& R, int& C) { const int st = b / 1024, sb = b % 1024, swz = sb ^ (((sb >> 9) & 1) << 5); R = (st >> 1) * 16 + swz / 64; C = (st & 1) * 32 + (swz % 64) / 2; }
__host__ __device__ __forceinline__ int perm32(int rho) { const int n = rho >> 4, i = rho & 15; return 8 * (i >> 2) + 4 * n + (i & 3); }

struct Unit { int pm, pn; };
struct Gemm { const bf16_t* A; const bf16_t* Bt; int M, N, K, lda, ldb; };

struct StaticOrder {
    int nM, nN, nwg, G, c;
    __host__ __device__ void init(int M, int N, int G_, int c_) { nM = M / BM; nN = N / BM; nwg = nM * nN; G = G_; c = c_; }
    __host__ __device__ bool next(int i, Unit& u) const {
        const long L = (long)i * G + c; if (L >= nwg) return false;
        int wgid = (int)L; { const int q = nwg / NXCD, r = nwg % NXCD, xcd = wgid % NXCD, off = wgid / NXCD; wgid = (xcd < r ? xcd * (q + 1) : r * (q + 1) + (xcd - r) * q) + off; }
        const int nig = WGM * nN, gid = wgid / nig, fm = gid * WGM, gsz = (nM - fm) < WGM ? (nM - fm) : WGM;
        u.pm = fm + ((wgid % nig) % gsz); u.pn = (wgid % nig) / gsz; return true;
    }
    __device__ __forceinline__ void a_ready(const Unit&) const {}
    __device__ __forceinline__ void done(const Unit&) const {}
};

__device__ __forceinline__ unsigned cvt_pk_bf16(float lo, float hi) { unsigned r; asm volatile("v_cvt_pk_bf16_f32 %0, %1, %2" : "=v"(r) : "v"(lo), "v"(hi)); return r; }
typedef float f32x2 __attribute__((ext_vector_type(2)));
__device__ __forceinline__ f32x2 gelu_pk(f32x2 v) {
    const f32x2 av = __builtin_elementwise_abs(v), d = av * 0.2316418882f + 1.0f;
    f32x2 t; t.x = __builtin_amdgcn_rcpf(d.x); t.y = __builtin_amdgcn_rcpf(d.y);
    f32x2 q = t * 0.5307027145f + (-0.7265760135f); q = q * t + 0.7107068705f; q = q * t + (-0.142248368f); q = q * t + 0.127414796f; q = q * t;
    const f32x2 s = (v * v) * (-0.72134752044f);
    f32x2 e; e.x = __builtin_amdgcn_exp2f(s.x); e.y = __builtin_amdgcn_exp2f(s.y);
    const f32x2 m = v * (q * e), r = v - m;
    f32x2 o; o.x = v.x < 0.f ? m.x : r.x; o.y = v.y < 0.f ? m.y : r.y; return o;
}

template <int ACT  > struct EpiBf16 {
    static constexpr bool PERM = true, AFTER_DRAIN = false; static_assert(ACT == 0 || ACT == 1, "EpiBf16: ACT is 0 (none) or 1 (gelu_pk)");
    bf16_t* O; int ldc; const float* bias; int split_cols; size_t split_stride; float scale0;
    __device__ __forceinline__ void operator()(const f32x4 (&acc)[2][2][4][2], const Unit& u, int wr, int wc, int fr, int fq) const {
        const int row0 = u.pm * BM + wr * 64 + fr; int colt = u.pn * BM; bf16_t* base = O;
        float sc = 1.f; if (split_cols) { const int t = colt / split_cols; base += (size_t)t * split_stride; colt -= t * split_cols; if (t == 0) sc = scale0; }
        const int col0 = colt + wc * 32 + 8 * fq, bcol0 = u.pn * BM + wc * 32 + 8 * fq;
        f32x4 bv[2][2];
#pragma unroll
        for (int bj = 0; bj < 2; ++bj)
#pragma unroll
            for (int n = 0; n < 2; ++n) bv[bj][n] = bias ? *(const f32x4*)(bias + bcol0 + bj * HALF + 4 * n) : (f32x4){0.f, 0.f, 0.f, 0.f};
#pragma unroll
        for (int ai = 0; ai < 2; ++ai)
#pragma unroll
            for (int m = 0; m < 4; ++m) { bf16_t* rowp = base + (size_t)(row0 + ai * HALF + m * 16) * ldc + col0;
#pragma unroll
                for (int bj = 0; bj < 2; ++bj) { f32x4 v0 = acc[ai][bj][m][0] + bv[bj][0], v1 = acc[ai][bj][m][1] + bv[bj][1];
                    if (ACT == 1) { f32x2 a = gelu_pk((f32x2){v0[0], v0[1]}), b = gelu_pk((f32x2){v0[2], v0[3]}), c = gelu_pk((f32x2){v1[0], v1[1]}), d = gelu_pk((f32x2){v1[2], v1[3]});
                        v0 = (f32x4){a.x, a.y, b.x, b.y}; v1 = (f32x4){c.x, c.y, d.x, d.y}; }
                    v0 = v0 * sc; v1 = v1 * sc; u32x4 w; w.x = cvt_pk_bf16(v0[0], v0[1]); w.y = cvt_pk_bf16(v0[2], v0[3]); w.z = cvt_pk_bf16(v1[0], v1[1]); w.w = cvt_pk_bf16(v1[2], v1[3]);
                    *(__attribute__((address_space(1))) u32x4*)(rowp + bj * HALF) = w; } }
    }
};
template <class Epi, class Sched, bool ALIGN_EPI = false, bool SP2 = false>
__device__ __forceinline__ void gemm_phase(PG8_LAS unsigned char* lds, const Gemm g, const Sched& S, const Epi& E, const int tid) {
    const int wid = __builtin_amdgcn_readfirstlane(tid >> 6), lane = tid & 63, wr = wid >> 2, wc = wid & 3, fr = lane & 15, fq = lane >> 4;
    const int K = g.K, nt = K / BK;
    unsigned voffA[2], voffB[2];
#pragma unroll
    for (int i = 0; i < 2; ++i) { int R, C; stage_rc(tid * 16 + i * 8192, R, C); const int Rb = Epi::PERM ? ((R & ~31) + perm32(R & 31)) : R;
        voffA[i] = (unsigned)(R * g.lda + C) * 2u; voffB[i] = (unsigned)(Rb * g.ldb + C) * 2u; }
    const size_t kstep = (size_t)(BK * 2);
    const size_t hstepA = (size_t)HALF * g.lda * 2, hstepB = (size_t)HALF * g.ldb * 2;
    const size_t tstepA = 2 * hstepA, tstepB = 2 * hstepB;
    const unsigned ldsw = (unsigned)wid * 1024u;
    const int aoff = lds_byte(wr * 64 + fr, fq * 8), boff = lds_byte(wc * 32 + fr, fq * 8);
#define PG8_SA(b, h) (((b) * 2 + (h)) * HTB)
#define PG8_SB(b, h) ((4 + (b) * 2 + (h)) * HTB)
#define PG8_STAGE(bufoff, gbase, voff) do { _Pragma("unroll") for (int _i = 0; _i < 2; ++_i) \
        __builtin_amdgcn_global_load_lds((const unsigned*)((const char*)(gbase) + (voff)[_i]), (PG8_LAS unsigned*)(lds + (bufoff) + ldsw + _i * 8192), 16, 0, 0); } while (0)
#define PG8_LDA(dst, b, h) do { _Pragma("unroll") for (int m = 0; m < 4; ++m) _Pragma("unroll") for (int k = 0; k < 2; ++k) dst[m][k] = *(const PG8_LAS bf16x8*)(lds + PG8_SA(b, h) + aoff + m * 2048 + k * 1024); } while (0)
#define PG8_LDB(dst, b, h) do { _Pragma("unroll") for (int n = 0; n < 2; ++n) _Pragma("unroll") for (int k = 0; k < 2; ++k) dst[n][k] = *(const PG8_LAS bf16x8*)(lds + PG8_SB(b, h) + boff + n * 2048 + k * 1024); } while (0)
#define PG8_MMA(ai, bj, At, Bt) do { __builtin_amdgcn_s_setprio(1); _Pragma("unroll") for (int m = 0; m < 4; ++m) _Pragma("unroll") for (int n = 0; n < 2; ++n) _Pragma("unroll") for (int k = 0; k < 2; ++k) \
        acc[ai][bj][m][n] = __builtin_amdgcn_mfma_f32_16x16x32_bf16(Bt[n][k], At[m][k], acc[ai][bj][m][n], 0, 0, 0); __builtin_amdgcn_s_setprio(0); } while (0)
#define PG8_WAIT_V(n) asm volatile("s_waitcnt vmcnt(" #n ")" ::: "memory")
#define PG8_WAIT_L(n) asm volatile("s_waitcnt lgkmcnt(" #n ")" ::: "memory")
#define PG8_BAR __builtin_amdgcn_s_barrier()
#define PG8_SCHED __builtin_amdgcn_sched_barrier(0)
    Unit cur, nxt; int ui = 0;
    if (!S.next(0, cur)) return;
    f32x4 acc[2][2][4][2];
#pragma unroll
    for (int a = 0; a < 2; ++a)
#pragma unroll
        for (int b = 0; b < 2; ++b)
#pragma unroll
            for (int m = 0; m < 4; ++m)
#pragma unroll
                for (int n = 0; n < 2; ++n) acc[a][b][m][n] = (f32x4){0.f, 0.f, 0.f, 0.f};
    bf16x8 At[4][2], B0[2][2], B1[2][2];
    const char* cA = (const char*)g.A + (size_t)cur.pm * tstepA; const char* cB = (const char*)g.Bt + (size_t)cur.pn * tstepB;
    S.a_ready(cur);
    if constexpr (SP2) {
        PG8_STAGE(PG8_SB(0, 0), cB, voffB); PG8_STAGE(PG8_SB(0, 1), cB + hstepB, voffB); PG8_STAGE(PG8_SA(0, 0), cA, voffA); PG8_STAGE(PG8_SA(0, 1), cA + hstepA, voffA);
        if (wr == 1) PG8_BAR;
        PG8_WAIT_V(2); PG8_BAR;
        PG8_STAGE(PG8_SB(1, 0), cB + kstep, voffB); PG8_STAGE(PG8_SA(1, 0), cA + kstep, voffA); PG8_STAGE(PG8_SB(1, 1), cB + hstepB + kstep, voffB);
        PG8_WAIT_V(6); PG8_BAR;
    } else {
        PG8_STAGE(PG8_SB(0, 0), cB, voffB); PG8_STAGE(PG8_SA(0, 0), cA, voffA); PG8_STAGE(PG8_SB(0, 1), cB + hstepB, voffB); PG8_STAGE(PG8_SA(0, 1), cA + hstepA, voffA);
        if (wr == 1) PG8_BAR;
        PG8_WAIT_V(4); PG8_BAR;
        PG8_STAGE(PG8_SB(1, 0), cB + kstep, voffB); PG8_STAGE(PG8_SA(1, 0), cA + kstep, voffA); PG8_STAGE(PG8_SB(1, 1), cB + hstepB + kstep, voffB);
        PG8_WAIT_V(6); PG8_BAR;
    }
    for (;;) {
        const bool has_next = S.next(ui + 1, nxt);
        const char* nA = has_next ? (const char*)g.A + (size_t)nxt.pm * tstepA : cA; const char* nB = has_next ? (const char*)g.Bt + (size_t)nxt.pn * tstepB : cB;
        for (int t = 0; t < nt; t += 2) {
            const bool last = (t == nt - 2);
            const char* a1 = cA + (size_t)(t + 1) * kstep;
            const char* a2 = last ? nA : cA + (size_t)(t + 2) * kstep; const char* b2 = last ? nB : cB + (size_t)(t + 2) * kstep;
            const char* a3 = a2 + kstep; const char* b3 = b2 + kstep;
            if (last && has_next) S.a_ready(nxt);
            if constexpr (SP2) {
            PG8_LDB(B0, 0, 0); PG8_LDB(B1, 0, 1); PG8_SCHED; PG8_LDA(At, 0, 0); PG8_STAGE(PG8_SA(1, 1), a1 + hstepA, voffA);
            PG8_WAIT_V(8); PG8_WAIT_L(0); PG8_BAR; PG8_MMA(0, 0, At, B0); PG8_MMA(0, 1, At, B1); PG8_BAR; PG8_SCHED;
            PG8_LDA(At, 0, 1); PG8_STAGE(PG8_SB(0, 0), b2, voffB); PG8_STAGE(PG8_SB(0, 1), b2 + hstepB, voffB); PG8_STAGE(PG8_SA(0, 0), a2, voffA);
            PG8_WAIT_V(8); PG8_WAIT_L(0); PG8_BAR; PG8_MMA(1, 0, At, B0); PG8_MMA(1, 1, At, B1); PG8_BAR; PG8_SCHED;
            PG8_LDB(B0, 1, 0); PG8_LDB(B1, 1, 1); PG8_SCHED; PG8_LDA(At, 1, 0); PG8_STAGE(PG8_SA(0, 1), a2 + hstepA, voffA);
            PG8_WAIT_V(8); PG8_WAIT_L(0); PG8_BAR; PG8_MMA(0, 0, At, B0); PG8_MMA(0, 1, At, B1); PG8_BAR; PG8_SCHED;
            PG8_LDA(At, 1, 1); PG8_STAGE(PG8_SB(1, 0), b3, voffB); PG8_STAGE(PG8_SB(1, 1), b3 + hstepB, voffB); PG8_STAGE(PG8_SA(1, 0), a3, voffA);
            PG8_WAIT_V(8); PG8_WAIT_L(0); PG8_BAR; PG8_MMA(1, 0, At, B0); PG8_MMA(1, 1, At, B1); PG8_BAR; PG8_SCHED;
            } else {
            PG8_LDB(B0, 0, 0); PG8_SCHED; PG8_LDA(At, 0, 0); PG8_STAGE(PG8_SA(1, 1), a1 + hstepA, voffA);
            PG8_WAIT_L(8); PG8_BAR; PG8_WAIT_L(0); PG8_MMA(0, 0, At, B0); PG8_BAR; PG8_SCHED;
            PG8_LDB(B1, 0, 1); PG8_STAGE(PG8_SB(0, 0), b2, voffB);
            PG8_BAR; PG8_WAIT_L(0); PG8_MMA(0, 1, At, B1); PG8_BAR;
            PG8_LDA(At, 0, 1); PG8_STAGE(PG8_SA(0, 0), a2, voffA);
            PG8_BAR; PG8_WAIT_L(0); PG8_MMA(1, 0, At, B0); PG8_BAR; PG8_SCHED;
            PG8_STAGE(PG8_SB(0, 1), b2 + hstepB, voffB);
            PG8_WAIT_V(6); PG8_BAR; PG8_MMA(1, 1, At, B1); PG8_BAR;
            PG8_LDB(B0, 1, 0); PG8_SCHED; PG8_LDA(At, 1, 0); PG8_STAGE(PG8_SA(0, 1), a2 + hstepA, voffA);
            PG8_WAIT_L(8); PG8_BAR; PG8_WAIT_L(0); PG8_MMA(0, 0, At, B0); PG8_BAR; PG8_SCHED;
            PG8_LDB(B1, 1, 1); PG8_STAGE(PG8_SB(1, 0), b3, voffB);
            PG8_BAR; PG8_WAIT_L(0); PG8_MMA(0, 1, At, B1); PG8_BAR;
            PG8_LDA(At, 1, 1); PG8_STAGE(PG8_SA(1, 0), a3, voffA);
            PG8_BAR; PG8_WAIT_L(0); PG8_MMA(1, 0, At, B0); PG8_BAR; PG8_SCHED;
            PG8_STAGE(PG8_SB(1, 1), b3 + hstepB, voffB);
            PG8_WAIT_V(6); PG8_BAR; PG8_MMA(1, 1, At, B1); PG8_BAR;
            }
        }
        if constexpr (ALIGN_EPI) { if (wr == 0) PG8_BAR; }
        if constexpr (!Epi::AFTER_DRAIN) { E(acc, cur, wr, wc, fr, fq); S.done(cur); }
        if (!has_next) break;
#pragma unroll
        for (int a = 0; a < 2; ++a)
#pragma unroll
            for (int b = 0; b < 2; ++b)
#pragma unroll
                for (int m = 0; m < 4; ++m)
#pragma unroll
                    for (int n = 0; n < 2; ++n) acc[a][b][m][n] = (f32x4){0.f, 0.f, 0.f, 0.f};
        cur = nxt; cA = nA; cB = nB; ++ui;
        if constexpr (ALIGN_EPI) { if (wr == 1) PG8_BAR; }
    }
    PG8_WAIT_V(0);
    if constexpr (!ALIGN_EPI) { if (wr == 0) PG8_BAR; }
    PG8_BAR;
    if constexpr (Epi::AFTER_DRAIN) { E.fused(acc, cur, wr, wc, fr, fq, lds, wid, lane); S.done(cur); }
#undef PG8_SA
#undef PG8_SB
#undef PG8_STAGE
#undef PG8_LDA
#undef PG8_LDB
#undef PG8_MMA
#undef PG8_WAIT_V
#undef PG8_WAIT_L
#undef PG8_BAR
#undef PG8_SCHED
}
}
#define LAS __attribute__((address_space(3)))
#define GAS __attribute__((address_space(1)))
typedef unsigned short bf16_t;
typedef short bf16x8 __attribute__((ext_vector_type(8)));
typedef short s16x4 __attribute__((ext_vector_type(4)));
typedef float f32x4 __attribute__((ext_vector_type(4)));
typedef float f32x16 __attribute__((ext_vector_type(16)));
typedef unsigned u32x4 __attribute__((ext_vector_type(4)));
typedef unsigned u32x2 __attribute__((ext_vector_type(2)));
typedef float f32x2 __attribute__((ext_vector_type(2)));

constexpr int NB = 8, SEQ = 8192, DM = 1024, CTX = 256, MLAT = NB * SEQ, MCTX = NB * CTX, MALL = MLAT + MCTX;
constexpr int PW = 1536, KVLEN = CTX + SEQ, DFF = 2816, NMOD = 6 * DM;
constexpr int NCH = 32, CHL = 256;
constexpr float EPS = 1e-6f;
constexpr float QSCALE = 0.10206207261596575f * 1.4426950408889634f;
constexpr size_t MiB = 1u << 20;
constexpr size_t WS_CTL = 0, CTL_BYTES = 2 * MiB;
constexpr size_t WS_MOD = 64 * 1024, WS_SSQ = 512 * 1024, WS_SSKV = 1024 * 1024, WS_BAR = 1600 * 1024;
constexpr size_t WS_WIN = 2 * MiB, WS_WQ = 5 * MiB, WS_WKV = 6 * MiB, WS_WG = 7 * MiB, WS_WOUT = 8 * MiB, WS_WUP = 10 * MiB, WS_WDN = 21 * MiB;
constexpr size_t WS_AGG = 27 * MiB, WS_ROPE = 29 * MiB + 512 * 1024;
constexpr size_t WS_R1 = 30 * MiB;
constexpr size_t WS_R2 = 162 * MiB;
constexpr size_t WS_LU = 360 * MiB, WS_K = 624 * MiB, WS_V = 723 * MiB, WS_A2 = 789 * MiB;
constexpr size_t WS_UP = 360 * MiB, WS_G = 712 * MiB, WS_Q = 920 * MiB, WS_X1 = 888 * MiB, WS_END = 1016 * MiB;
constexpr int LDS_BYTES = 139264;
constexpr int LDS_MISC = 131072 + 64;

__device__ __forceinline__ unsigned f2bf(float f) { unsigned u = __builtin_bit_cast(unsigned, f); return (u + 0x7fffu + ((u >> 16) & 1u)) >> 16; }
__device__ __forceinline__ unsigned cvtpk(float lo, float hi) { typedef float f2 __attribute__((ext_vector_type(2))); typedef __bf16 b2 __attribute__((ext_vector_type(2))); f2 v = {lo, hi}; b2 r = __builtin_convertvector(v, b2); return __builtin_bit_cast(unsigned, r); }
__device__ __forceinline__ unsigned pk2(float lo, float hi) { return cvtpk(lo, hi); }
__device__ __forceinline__ float bflo(unsigned w) { return __uint_as_float(w << 16); }
__device__ __forceinline__ float bfhi(unsigned w) { return __uint_as_float(w & 0xffff0000u); }
__device__ __forceinline__ float bf2f(bf16_t v) { return __uint_as_float((unsigned)v << 16); }
__device__ __forceinline__ int crow(int r, int hi) { return (r & 3) + 8 * (r >> 2) + 4 * hi; }
__device__ __forceinline__ float wave_sum(float v) {
#pragma unroll
    for (int o = 1; o < 64; o <<= 1) v += __shfl_xor(v, o);
    return v;
}
__device__ __forceinline__ float sigmoidf_(float x) { return __builtin_amdgcn_rcpf(1.f + __builtin_amdgcn_exp2f(-1.4426950408889634f * x)); }
#define LDS_WAIT() asm volatile("s_waitcnt lgkmcnt(0)" ::: "memory")
#define XB_TMO      128
#define XB_XCNT(j)  (256  + 64 * (j))
#define XB_XSUB(j)  (1280 + 64 * (j))
#define XB_XGEN(j)  (2304 + 64 * (j))
#define XB_TOP      3328
#define XB_TOPGEN   3392
#define XCD_BAR_WORDS 3456
#define XB_SPIN_CAP (1u << 18)

__device__ __forceinline__ unsigned xb_ld(unsigned* p)              { return __hip_atomic_load(p, __ATOMIC_RELAXED, __HIP_MEMORY_SCOPE_AGENT); }
__device__ __forceinline__ unsigned xb_add(unsigned* p, unsigned v) { return __hip_atomic_fetch_add(p, v, __ATOMIC_RELAXED, __HIP_MEMORY_SCOPE_AGENT); }
__device__ __forceinline__ unsigned xb_xcc_id() { return (unsigned)__builtin_amdgcn_s_getreg((3 << 11) | 20) & 0xFu; }
#define XB_SPIN(cond, bar) do { unsigned _sp = 0; while (cond) { __builtin_amdgcn_s_sleep(1); \
    if ((++_sp & 255u) == 0u) { if (xb_ld(&(bar)[XB_TMO])) break; if (_sp > XB_SPIN_CAP) { atomicAdd(&(bar)[XB_TMO], 1u); break; } } } } while (0)

struct XcdBarrier {
    unsigned* bar; unsigned x;
    volatile LAS unsigned* st;
};

__device__ __forceinline__ XcdBarrier xcd_barrier_post(unsigned* bar, volatile LAS unsigned* st) {
    XcdBarrier b; b.bar = bar; b.x = xb_xcc_id(); b.st = st;
    if (threadIdx.x == 0) (void)xb_add(&bar[XB_XCNT(b.x)], 1u);
    return b;
}
__device__ __forceinline__ void xcd_barrier_complete(unsigned* bar, unsigned x, unsigned& nloc, unsigned& nx) {
    const unsigned G = gridDim.x * gridDim.y * gridDim.z;
    unsigned sum, cnt, mine, sp = 0u;
    for (;;) {
        sum = 0u; cnt = 0u; mine = 0u;
#pragma unroll
        for (unsigned j = 0; j < 16; ++j) { const unsigned c = xb_ld(&bar[XB_XCNT(j)]); sum += c; cnt += (c > 0u) ? 1u : 0u; mine = (j == x) ? c : mine; }
        if (sum == G) break;
        __builtin_amdgcn_s_sleep(1);
        if ((++sp & 255u) == 0u) { if (xb_ld(&bar[XB_TMO])) break; if (sp > XB_SPIN_CAP) { atomicAdd(&bar[XB_TMO], 1u); break; } }
    }
    nloc = mine > 0u ? mine : 1u; nx = cnt > 0u ? cnt : 1u;
}

__device__ __forceinline__ void xcd_barrier(const XcdBarrier& b) {
    asm volatile("s_waitcnt vmcnt(0)" ::: "memory");
    __syncthreads();
    if (threadIdx.x == 0) {
        unsigned* bar = b.bar;
        __builtin_amdgcn_s_waitcnt(0);
        unsigned nloc = b.st[0], nx = b.st[1];
        if (nloc == 0u) { xcd_barrier_complete(bar, b.x, nloc, nx); b.st[0] = nloc; b.st[1] = nx; }
        const unsigned old = xb_add(&bar[XB_XSUB(b.x)], 1u);
        const unsigned gen = old / nloc;
        if (old + 1u == (gen + 1u) * nloc) {
            __builtin_amdgcn_fence(__ATOMIC_RELEASE, "agent");
            asm volatile("s_waitcnt vmcnt(0)" ::: "memory");
            const unsigned og = xb_add(&bar[XB_TOP], 1u);
            const unsigned tg = og / nx;
            if (og + 1u == (tg + 1u) * nx) xb_add(&bar[XB_TOPGEN], 1u);
            else XB_SPIN(xb_ld(&bar[XB_TOPGEN]) == tg, bar);
            __builtin_amdgcn_fence(__ATOMIC_ACQUIRE, "agent");
            xb_add(&bar[XB_XGEN(b.x)], 1u);
            asm volatile("s_waitcnt vmcnt(0)" ::: "memory");
        } else {
            XB_SPIN(xb_ld(&bar[XB_XGEN(b.x)]) == gen, bar);
            __builtin_amdgcn_fence(__ATOMIC_ACQUIRE, "agent");
            asm volatile("s_waitcnt vmcnt(0)" ::: "memory");
        }
    }
    __syncthreads();
}


struct Args { const float* in[27]; float* out; unsigned char* ws; int ph_lo, ph_hi; };
__device__ __forceinline__ const GAS float* argp(int i) {
    const __attribute__((address_space(4))) char* kp = (const __attribute__((address_space(4))) char*)__builtin_amdgcn_kernarg_segment_ptr();
    asm volatile("" : "+s"(kp));
    const float* p = *(const float* const __attribute__((address_space(4)))*)(kp + 8 * i);
    return (const GAS float*)p;
}

template <int ID> __device__ __forceinline__ float wsrc(const GAS float* __restrict__ p0, const GAS float* __restrict__ p1, int n, int k) {
    if (ID == 0) return n < 1440 ? p0[(size_t)k * 1440 + n] : 0.f;
    if (ID == 1) return p0[k] * p1[(size_t)k * 768 + n];
    if (ID == 2) return k < 128 ? p0[k] * p1[(size_t)k * 1024 + n] : 0.f;
    if (ID == 3) { const int h = n >> 8, np = n & 255, mat = np >> 6, j = np & 63, dir = mat >> 1; const GAS float* w = (mat & 1) ? p1 : p0; return w[(size_t)((dir * 8 + h) * 64 + k) * 64 + j]; }
    if (ID == 4) return p0[(size_t)k * 1024 + n];
    if (ID == 5) return p0[(size_t)k * 5632 + n];
    return p0[(size_t)k * 1024 + n];
}
template <int ID> __device__ __forceinline__ void prep_mat(const GAS float* __restrict__ p0, const GAS float* __restrict__ p1, GAS bf16_t* __restrict__ dst, int N, int K, int gtid, int NT) {
    const int items = N * (K / 8);
    for (int it = gtid; it < items; it += NT) {
        const int nl = it & 7, kl = (it >> 3) & 7, rest = it >> 6, nb = rest % (N / 8), kb = rest / (N / 8), n = nb * 8 + nl, k8 = kb * 8 + kl;
        u32x4 o;
        o.x = pk2(wsrc<ID>(p0, p1, n, 8 * k8 + 0), wsrc<ID>(p0, p1, n, 8 * k8 + 1)); o.y = pk2(wsrc<ID>(p0, p1, n, 8 * k8 + 2), wsrc<ID>(p0, p1, n, 8 * k8 + 3));
        o.z = pk2(wsrc<ID>(p0, p1, n, 8 * k8 + 4), wsrc<ID>(p0, p1, n, 8 * k8 + 5)); o.w = pk2(wsrc<ID>(p0, p1, n, 8 * k8 + 6), wsrc<ID>(p0, p1, n, 8 * k8 + 7));
        *(GAS u32x4*)(dst + (size_t)n * K + 8 * k8) = o;
    }
}
__device__ __forceinline__ void mod_phase(const GAS float* __restrict__ cvec, const GAS float* __restrict__ cctx, const GAS float* __restrict__ wmod, const GAS float* __restrict__ bmod, GAS float* __restrict__ mod, LAS float* scr, int gw, int NGW, int lane) {
    for (int task = gw; task < 96 * 16; task += NGW) {
        const int cgp = task % 96, kc = task / 96, n = cgp * 64 + lane, k0 = kc * 64;
#pragma unroll
        for (int r = 0; r < 9; ++r) { const float cv = r < 8 ? cvec[r * 1024 + k0 + lane] : cctx[k0 + lane]; scr[r * 64 + lane] = cv / (1.f + __expf(-cv)); }
        LDS_WAIT();
        float acc[9];
#pragma unroll
        for (int r = 0; r < 9; ++r) acc[r] = 0.f;
#pragma unroll 8
        for (int kk = 0; kk < 64; ++kk) { const float w = wmod[(size_t)(k0 + kk) * NMOD + n];
#pragma unroll
            for (int r = 0; r < 9; ++r) acc[r] += scr[r * 64 + kk] * w; }
        const float bias = kc == 0 ? bmod[n] : 0.f;
#pragma unroll
        for (int r = 0; r < 9; ++r) atomicAdd((float*)(mod + r * NMOD + n), acc[r] + bias);
        LDS_WAIT();
    }
}
__device__ __forceinline__ void p1_rows(const GAS float* __restrict__ x, const GAS float* __restrict__ ctx, const GAS float* __restrict__ g, const GAS float* __restrict__ mod, GAS bf16_t* __restrict__ H, int gw, int NGW, int lane) {
    for (int m0 = 2 * gw; m0 < MALL; m0 += 2 * NGW) {
        f32x4 v[2][4]; float ss[2];
#pragma unroll
        for (int r = 0; r < 2; ++r) { const int m = m0 + r; const GAS float* src = m < MLAT ? x + (size_t)m * DM : ctx + (size_t)(m - MLAT) * DM; ss[r] = 0.f;
#pragma unroll
            for (int j = 0; j < 4; ++j) { v[r][j] = *(const GAS f32x4*)(src + 4 * lane + 256 * j); ss[r] += v[r][j].x * v[r][j].x + v[r][j].y * v[r][j].y + v[r][j].z * v[r][j].z + v[r][j].w * v[r][j].w; } }
#pragma unroll
        for (int r = 0; r < 2; ++r) { const int m = m0 + r; const GAS float* md = mod + (m < MLAT ? (m >> 13) : 8) * NMOD;
            const float rs = rsqrtf(wave_sum(ss[r]) * (1.f / DM) + EPS);
#pragma unroll
            for (int j = 0; j < 4; ++j) { const int k = 4 * lane + 256 * j;
                const f32x4 gg = *(const GAS f32x4*)(g + k), sh = *(const GAS f32x4*)(md + k), sc = *(const GAS f32x4*)(md + DM + k);
                const f32x4 y = v[r][j] * rs * gg * (sc + 1.f) + sh;
                u32x2 o; o.x = pk2(y.x, y.y); o.y = pk2(y.z, y.w); *(GAS u32x2*)(H + (size_t)m * DM + k) = o; } }
    }
}
__device__ __forceinline__ void ss_phase(const GAS bf16_t* __restrict__ P, GAS float* __restrict__ ssq, GAS float* __restrict__ sskv, int gw, int NGW, int lane) {
#pragma unroll 4
    for (int m = gw; m < MALL; m += NGW) {
        const u32x2 q = *(const GAS u32x2*)(P + (size_t)m * PW + 1024 + 4 * lane); const unsigned k = *(const GAS unsigned*)(P + (size_t)m * PW + 1280 + 2 * lane);
        float a = bflo(q.x) * bflo(q.x) + bfhi(q.x) * bfhi(q.x) + bflo(q.y) * bflo(q.y) + bfhi(q.y) * bfhi(q.y), c = bflo(k) * bflo(k) + bfhi(k) * bfhi(k);
        a = wave_sum(a); c = wave_sum(c);
        if (lane == 0) { ssq[m] = a; sskv[m] = c; }
    }
}
__device__ __forceinline__ void qpost_phase(const GAS bf16_t* __restrict__ QR, const GAS float* __restrict__ ssq, const GAS float* __restrict__ RT, GAS bf16_t* __restrict__ Q, int gtid, int NT) {
#pragma unroll 4
    for (int task = gtid; task < MLAT * 96; task += NT) {
        const int row = task / 96, c8 = task - row * 96, h = c8 / 12, dc = c8 - h * 12, b = row >> 13, s = row & 8191;
        const float sc = rsqrtf(ssq[row] * (1.f / 256.f) + EPS) * QSCALE;
        const u32x4 mine = *(const GAS u32x4*)(QR + (size_t)row * 768 + 8 * c8);
        float v[8];
#pragma unroll
        for (int j = 0; j < 4; ++j) { v[2 * j] = bflo(mine[j]) * sc; v[2 * j + 1] = bfhi(mine[j]) * sc; }
        if (dc >= 8) { const int fq = dc - 8; const u32x4 oth = *(const GAS u32x4*)(QR + (size_t)row * 768 + 8 * (c8 ^ 1));
            const GAS float* rt = RT + (fq < 2 ? (s >> 6) : (s & 63)) * 16;
#pragma unroll
            for (int j = 0; j < 8; ++j) { const float pt = ((j & 1) ? bfhi(oth[j >> 1]) : bflo(oth[j >> 1])) * sc, cs = rt[2 * j], sn = rt[2 * j + 1];
                v[j] = (fq & 1) ? v[j] * cs + pt * sn : v[j] * cs - pt * sn; } }
        u32x4 w; w.x = pk2(v[0], v[1]); w.y = pk2(v[2], v[3]); w.z = pk2(v[4], v[5]); w.w = pk2(v[6], v[7]);
        *(GAS u32x4*)(Q + ((size_t)((b * 8 + h) * SEQ + s)) * 96 + 8 * dc) = w;
    }
}
__device__ __forceinline__ void kvpost_phase(const GAS bf16_t* __restrict__ KVR, const GAS float* __restrict__ sskv, GAS bf16_t* __restrict__ Kb, GAS bf16_t* __restrict__ Vt, int gtid, int NT) {
#pragma unroll 4
    for (int task = gtid; task < MALL * 64; task += NT) {
        const int row = task >> 6, c = task & 63, h = c >> 3, dd = (c & 7) * 8; const bool lat = row < MLAT;
        const int b = lat ? (row >> 13) : ((row - MLAT) >> 8), pos = lat ? (CTX + (row & 8191)) : ((row - MLAT) & 255);
        const float rs = rsqrtf(sskv[row] * (1.f / 128.f) + EPS);
        const u32x4 mine = *(const GAS u32x4*)(KVR + (size_t)row * 1024 + h * 128 + dd);
        u32x4 w;
#pragma unroll
        for (int j = 0; j < 4; ++j) w[j] = pk2(bflo(mine[j]) * rs, bfhi(mine[j]) * rs);
        *(GAS u32x4*)(Kb + ((size_t)(b * 8 + h) * KVLEN + pos) * 96 + dd) = w;
    }
#pragma unroll 2
    for (int task = gtid; task < (MALL / 8) * 128; task += NT) {
        const int pg = task & 7, dq = (task >> 3) & 7, rest = task >> 6, hd32 = rest & 15, rb = rest >> 4, h = hd32 >> 1, d = (hd32 & 1) * 32 + 4 * dq, row0 = rb * 64 + pg * 8; const bool lat = row0 < MLAT;
        const int b = lat ? (row0 >> 13) : ((row0 - MLAT) >> 8), pos0 = lat ? (CTX + (row0 & 8191)) : ((row0 - MLAT) & 255);
        float v[4][8];
#pragma unroll
        for (int i = 0; i < 8; ++i) { const u32x2 w = *(const GAS u32x2*)(KVR + (size_t)(row0 + i) * 1024 + h * 128 + 64 + d); const float rs = rsqrtf(sskv[row0 + i] * (1.f / 128.f) + EPS);
            v[0][i] = bflo(w.x) * rs; v[1][i] = bfhi(w.x) * rs; v[2][i] = bflo(w.y) * rs; v[3][i] = bfhi(w.y) * rs; }
        GAS bf16_t* vp = Vt + ((size_t)((b * 8 + h) * 64 + d)) * KVLEN + pos0;
#pragma unroll
        for (int j = 0; j < 4; ++j) { u32x4 w; w.x = pk2(v[j][0], v[j][1]); w.y = pk2(v[j][2], v[j][3]); w.z = pk2(v[j][4], v[j][5]); w.w = pk2(v[j][6], v[j][7]);
            *(GAS u32x4*)(vp + (size_t)j * KVLEN) = w; }
    }
}
__device__ __forceinline__ void krope_phase(const GAS bf16_t* __restrict__ P, GAS bf16_t* __restrict__ Kb, const GAS float* __restrict__ RT, int gtid, int NT) {
#pragma unroll 2
    for (int task = gtid; task < MALL * 4; task += NT) {
        const int row = task >> 2, fq = task & 3; const bool lat = row < MLAT;
        const int b = lat ? (row >> 13) : ((row - MLAT) >> 8), s = row & 8191, pos = lat ? (CTX + s) : ((row - MLAT) & 255);
        const u32x4 mine = *(const GAS u32x4*)(P + (size_t)row * PW + 1408 + 8 * fq), oth = *(const GAS u32x4*)(P + (size_t)row * PW + 1408 + 8 * (fq ^ 1));
        float v[8], pt[8];
#pragma unroll
        for (int j = 0; j < 4; ++j) { v[2 * j] = bflo(mine[j]); v[2 * j + 1] = bfhi(mine[j]); pt[2 * j] = bflo(oth[j]); pt[2 * j + 1] = bfhi(oth[j]); }
        if (lat) { const GAS float* rt = RT + (fq < 2 ? (s >> 6) : (s & 63)) * 16;
#pragma unroll
            for (int j = 0; j < 8; ++j) { const float cs = rt[2 * j], sn = rt[2 * j + 1]; v[j] = (fq & 1) ? v[j] * cs + pt[j] * sn : v[j] * cs - pt[j] * sn; } }
        u32x4 w; w.x = pk2(v[0], v[1]); w.y = pk2(v[2], v[3]); w.z = pk2(v[4], v[5]); w.w = pk2(v[6], v[7]);
#pragma unroll
        for (int h = 0; h < 8; ++h) *(GAS u32x4*)(Kb + ((size_t)(b * 8 + h) * KVLEN + pos) * 96 + 64 + 8 * fq) = w;
    }
}
#define MFMA32(a, b, c) __builtin_amdgcn_mfma_f32_32x32x16_bf16((a), (b), (c), 0, 0, 0)
__device__ __forceinline__ void gates_phase(const GAS float* __restrict__ cw, const GAS float* __restrict__ cb, const GAS float* __restrict__ b_a, const GAS float* __restrict__ b_x, const GAS float* __restrict__ lam, LAS unsigned char* lds, const GAS bf16_t* __restrict__ P, const GAS bf16_t* __restrict__ Wg, GAS unsigned* __restrict__ LU, GAS f32x2* __restrict__ AGG, int tid, int wave, int lane) {
    LAS bf16_t* xs = (LAS bf16_t*)(lds + wave * 4608);
    LAS f32x2* wagg = (LAS f32x2*)(lds + 8 * 4608);
    const int r32 = lane & 31, hi = lane >> 5;
    for (int unit = blockIdx.x; unit < (MALL / 256) * 8; unit += gridDim.x) {
        const int pm = unit >> 3, h = unit & 7, m0 = pm * 256 + wave * 32;
        const int s0 = m0 < MLAT ? (m0 & ~8191) : (MLAT + ((m0 - MLAT) & ~255)), slen = m0 < MLAT ? SEQ : CTX;
        {
            const int tok = lane >> 1, m = m0 + tok;
#pragma unroll
            for (int c8 = 0; c8 < 4; ++c8) { const int ch = (lane & 1) * 32 + c8 * 8, gch = h * 64 + ch;
                float acc[8];
                { const f32x4 b0 = *(const GAS f32x4*)(cb + gch), b1 = *(const GAS f32x4*)(cb + gch + 4);
                  acc[0] = b0.x; acc[1] = b0.y; acc[2] = b0.z; acc[3] = b0.w; acc[4] = b1.x; acc[5] = b1.y; acc[6] = b1.z; acc[7] = b1.w; }
#pragma unroll
                for (int k = 0; k < 4; ++k) { const int mm = m + k - 2;
                    if (mm >= s0 && mm < s0 + slen) { const u32x4 xv = *(const GAS u32x4*)(P + (size_t)mm * PW + gch);
                        const f32x4 w0 = *(const GAS f32x4*)(cw + k * 512 + gch), w1 = *(const GAS f32x4*)(cw + k * 512 + gch + 4);
                        acc[0] += w0.x * bflo(xv.x); acc[1] += w0.y * bfhi(xv.x); acc[2] += w0.z * bflo(xv.y); acc[3] += w0.w * bfhi(xv.y);
                        acc[4] += w1.x * bflo(xv.z); acc[5] += w1.y * bfhi(xv.z); acc[6] += w1.z * bflo(xv.w); acc[7] += w1.w * bfhi(xv.w); } }
                u32x4 o; o.x = pk2(acc[0], acc[1]); o.y = pk2(acc[2], acc[3]); o.z = pk2(acc[4], acc[5]); o.w = pk2(acc[6], acc[7]);
                *(LAS u32x4*)(xs + tok * 72 + ch) = o; }
        }
        LDS_WAIT();
        bf16x8 afr[4];
#pragma unroll
        for (int ks = 0; ks < 4; ++ks) afr[ks] = *(const LAS bf16x8*)(xs + r32 * 72 + 16 * ks + 8 * hi);
#pragma unroll
        for (int jh = 0; jh < 2; ++jh) {
            f32x16 acc4[4];
#pragma unroll
            for (int q = 0; q < 4; ++q) {
#pragma unroll
                for (int i = 0; i < 16; ++i) acc4[q][i] = 0.f;
                const GAS bf16_t* wrow = Wg + (size_t)(h * 256 + (2 * q + jh) * 32 + r32) * 64 + 8 * hi;
#pragma unroll
                for (int ks = 0; ks < 4; ++ks) { const bf16x8 bfr = *(const GAS bf16x8*)(wrow + 16 * ks); acc4[q] = MFMA32(afr[ks], bfr, acc4[q]); }
            }
            const int ch = jh * 32 + r32, gch = h * 64 + ch;
            float ba[2], bx[2], sp[2];
#pragma unroll
            for (int d = 0; d < 2; ++d) { ba[d] = b_a[d * 512 + gch]; bx[d] = b_x[d * 512 + gch]; sp[d] = lam[d * 512 + gch]; }
            unsigned wv[16][2]; float avs[16][2];
#pragma unroll
            for (int i = 0; i < 16; ++i) { const int row = crow(i, hi); const float xv = bf2f(xs[row * 72 + ch]);
#pragma unroll
                for (int d = 0; d < 2; ++d) { const float r = sigmoidf_(acc4[2 * d][i] + ba[d]), ig = sigmoidf_(acc4[2 * d + 1][i] + bx[d]);
                    const float la2 = bflo(f2bf(-r * sp[d])), av = __builtin_amdgcn_exp2f(la2); avs[i][d] = av;
                    const float uu = __builtin_amdgcn_sqrtf(fmaxf(1.f - av * av, 0.f)) * (ig * xv);
                    wv[i][d] = pk2(la2, uu);
                    LU[((size_t)(m0 + row) * 2 + d) * 512 + gch] = wv[i][d]; } }
#pragma unroll
            for (int d = 0; d < 2; ++d) {
                float Ar[4], Ur[4];
#pragma unroll
                for (int g = 0; g < 4; ++g) { float A = 1.f, U = 0.f;
#pragma unroll
                    for (int jj = 0; jj < 4; ++jj) { const int j = d ? 3 - jj : jj; const unsigned w = wv[4 * g + j][d]; const float av = avs[4 * g + j][d]; A *= av; U = av * U + bfhi(w); }
                    Ar[g] = A; Ur[g] = U; }
                float A = 1.f, U = 0.f;
#pragma unroll
                for (int gg = 0; gg < 4; ++gg) { const int g = d ? 3 - gg : gg;
                    const float Ao = __shfl_xor(Ar[g], 32), Uo = __shfl_xor(Ur[g], 32);
                    if (d == 0) { U = Ar[g] * U + Ur[g]; A *= Ar[g]; U = Ao * U + Uo; A *= Ao; }
                    else        { U = Ao * U + Uo; A *= Ao; U = Ar[g] * U + Ur[g]; A *= Ar[g]; } }
                if (hi == 0) wagg[(wave * 2 + d) * 64 + ch] = (f32x2){A, U};
            }
        }
        LDS_WAIT();
        __syncthreads();
        if (tid < 128) {
            const int d = tid >> 6, ch = tid & 63; float A = 1.f, U = 0.f;
#pragma unroll
            for (int ww = 0; ww < 8; ++ww) { const int w = d ? 7 - ww : ww; const f32x2 g = wagg[(w * 2 + d) * 64 + ch]; U = g.x * U + g.y; A *= g.x; }
            const int b = pm < MLAT / 256 ? (pm >> 5) : (pm - MLAT / 256), c = pm < MLAT / 256 ? (pm & 31) : NCH;
            AGG[(size_t)((b * 2 + d) * (NCH + 1) + c) * 512 + h * 64 + ch] = (f32x2){A, U};
        }
        __syncthreads();
    }
}
__device__ __forceinline__ void scan_agg(const GAS unsigned* __restrict__ LU, GAS f32x2* __restrict__ AGG, int gw, int NGW, int lane) {
    for (int task = gw; task < NB * 2 * (NCH + 1) * 8; task += NGW) {
        const int cgp = task & 7, c = (task >> 3) % (NCH + 1), d = (task / (8 * (NCH + 1))) & 1, b = task / (16 * (NCH + 1));
        const int ch = cgp * 64 + lane, row0 = c < NCH ? b * SEQ + c * CHL : MLAT + b * CTX;
        float A = 1.f, U = 0.f;
#pragma unroll 16
        for (int t = 0; t < CHL; ++t) { const int tt = d ? CHL - 1 - t : t; const unsigned w = LU[((size_t)(row0 + tt) * 2 + d) * 512 + ch];
            const float av = __builtin_amdgcn_exp2f(bflo(w)); A *= av; U = av * U + bfhi(w); }
        AGG[(size_t)((b * 2 + d) * (NCH + 1) + c) * 512 + ch] = (f32x2){A, U};
    }
}
__device__ __forceinline__ float gelu_tanh(float x) { const float z = 0.7978845608028654f * (x + 0.044715f * x * x * x);
    return x * __builtin_amdgcn_rcpf(1.f + __builtin_amdgcn_exp2f(-2.8853900817779268f * z)); }
__device__ __forceinline__ void scan_final(const GAS unsigned* __restrict__ LU, const GAS f32x2* __restrict__ AGG, const GAS bf16_t* __restrict__ P, GAS bf16_t* __restrict__ A2, int gw, int NGW, int lane) {
    constexpr int BT = 16;
    for (int task = gw; task < NB * NCH * 8; task += NGW) {
        const int cgp = task & 7, c = (task >> 3) & (NCH - 1), b = task / (8 * NCH), ch = cgp * 64 + lane, row0 = b * SEQ + c * CHL;
        const GAS f32x2* ag0 = AGG + (size_t)((b * 2 + 0) * (NCH + 1)) * 512 + ch; const GAS f32x2* ag1 = AGG + (size_t)((b * 2 + 1) * (NCH + 1)) * 512 + ch;
        unsigned w[BT], wn[BT];
#pragma unroll
        for (int i = 0; i < BT; ++i) w[i] = LU[((size_t)(row0 + i) * 2 + 0) * 512 + ch];
        float hf = ag0[(size_t)NCH * 512].y;
        for (int cc = 0; cc < c; ++cc) { const f32x2 g = ag0[(size_t)cc * 512]; hf = g.x * hf + g.y; }
        float hb = ag1[(size_t)NCH * 512].y;
        for (int cc = NCH - 1; cc > c; --cc) { const f32x2 g = ag1[(size_t)cc * 512]; hb = g.x * hb + g.y; }
#pragma unroll 1
        for (int t0 = 0; t0 < CHL; t0 += BT) {
            if (t0 + BT < CHL) {
#pragma unroll
                for (int i = 0; i < BT; ++i) wn[i] = LU[((size_t)(row0 + t0 + BT + i) * 2 + 0) * 512 + ch]; }
#pragma unroll
            for (int i = 0; i < BT; ++i) { hf = __builtin_amdgcn_exp2f(bflo(w[i])) * hf + bfhi(w[i]); A2[(size_t)(row0 + t0 + i) * DM + ch] = (bf16_t)f2bf(hf); }
#pragma unroll
            for (int i = 0; i < BT; ++i) w[i] = wn[i]; }
        bf16_t gr[BT], grn[BT];
#pragma unroll
        for (int i = 0; i < BT; ++i) { w[i] = LU[((size_t)(row0 + CHL - BT + i) * 2 + 1) * 512 + ch]; gr[i] = P[(size_t)(row0 + CHL - BT + i) * PW + 512 + ch]; }
#pragma unroll 1
        for (int t0 = CHL - BT; t0 >= 0; t0 -= BT) { bf16_t f[BT];
#pragma unroll
            for (int i = 0; i < BT; ++i) f[i] = A2[(size_t)(row0 + t0 + i) * DM + ch];
            if (t0 >= BT) {
#pragma unroll
                for (int i = 0; i < BT; ++i) { wn[i] = LU[((size_t)(row0 + t0 - BT + i) * 2 + 1) * 512 + ch]; grn[i] = P[(size_t)(row0 + t0 - BT + i) * PW + 512 + ch]; } }
#pragma unroll
            for (int i = BT - 1; i >= 0; --i) { hb = __builtin_amdgcn_exp2f(bflo(w[i])) * hb + bfhi(w[i]);
                A2[(size_t)(row0 + t0 + i) * DM + ch] = (bf16_t)f2bf((bf2f(f[i]) + hb) * gelu_tanh(bf2f(gr[i]))); }
#pragma unroll
            for (int i = 0; i < BT; ++i) { w[i] = wn[i]; gr[i] = grn[i]; } }
    }
}
constexpr int AT_KROW = 208, AT_VROW = 144;
constexpr float AT_THR = 8.f;
#define AT_LMAX(P, MX) do { MX = fmaxf(fmaxf(P[0], P[1]), fmaxf(P[2], P[3])); \
        _Pragma("unroll") for (int i_ = 4; i_ < 16; i_ += 4) MX = fmaxf(fmaxf(MX, P[i_]), fmaxf(fmaxf(P[i_ + 1], P[i_ + 2]), P[i_ + 3])); } while (0)
#define AT_SOFTMAX(P, MX, M, L, O0, O1, PW0, PW1) do { \
        if (__any(MX > M + AT_THR)) { const float mn_ = fmaxf(M, MX), al_ = __builtin_amdgcn_exp2f(M - mn_); M = mn_; L *= al_; \
            _Pragma("unroll") for (int i_ = 0; i_ < 16; ++i_) { O0[i_] *= al_; O1[i_] *= al_; } } \
        float s_ = 0.f; \
        _Pragma("unroll") for (int i_ = 0; i_ < 16; ++i_) { P[i_] = __builtin_amdgcn_exp2f(P[i_] - M); s_ += P[i_]; } \
        L += s_; \
        _Pragma("unroll") for (int j_ = 0; j_ < 4; ++j_) { PW0[j_] = cvtpk(P[2 * j_], P[2 * j_ + 1]); PW1[j_] = cvtpk(P[8 + 2 * j_], P[9 + 2 * j_]); } } while (0)
__device__ __forceinline__ void glds16(const GAS void* gsrc, unsigned lds_dst) {
    unsigned keep;
    asm volatile("s_mov_b32 %0, m0\n\ts_mov_b32 m0, %2\n\ts_nop 0\n\tglobal_load_lds_dwordx4 %1, off\n\ts_mov_b32 m0, %0" : "=&s"(keep) : "v"(gsrc), "s"(lds_dst) : "memory");
}
constexpr int AT_SLOT = 22 * 1024, AT_VOFF = 13 * 1024, AT_NP = 22;
__device__ __forceinline__ void attn_unit(LAS unsigned char* lds, const GAS bf16_t* __restrict__ QR, const GAS float* __restrict__ ssq, const GAS float* __restrict__ RT, const GAS bf16_t* __restrict__ K, const GAS bf16_t* __restrict__ Vt, GAS bf16_t* __restrict__ A2, int b, int h, int qb, int tid, int wave, int lane) {
    const int r32 = lane & 31, hi = lane >> 5, q0 = qb * 512 + wave * 64, r32s = (r32 & ~12) | ((r32 & 4) << 1) | ((r32 & 8) >> 1);
    bf16x8 qa[6], qc[6];
#pragma unroll
    for (int sub = 0; sub < 2; ++sub) {
        const int s = q0 + 32 * sub + r32, row = b * SEQ + s;
        const GAS bf16_t* Qp = QR + (size_t)row * 768 + h * 96 + 8 * hi;
        const float sc = rsqrtf(ssq[row] * (1.f / 256.f) + EPS) * QSCALE;
#pragma unroll
        for (int d0 = 0; d0 < 6; ++d0) {
            const u32x4 raw = *(const GAS u32x4*)(Qp + 16 * d0);
            float v[8];
#pragma unroll
            for (int j = 0; j < 4; ++j) { v[2 * j] = bflo(raw[j]) * sc; v[2 * j + 1] = bfhi(raw[j]) * sc; }
            if (d0 >= 4) { const GAS float* rt = RT + (d0 == 4 ? (s >> 6) : (s & 63)) * 16;
#pragma unroll
                for (int j = 0; j < 8; ++j) { const float pt = __shfl_xor(v[j], 32), cs = rt[2 * j], sn = rt[2 * j + 1]; v[j] = hi ? v[j] * cs + pt * sn : v[j] * cs - pt * sn; } }
            u32x4 w; w.x = pk2(v[0], v[1]); w.y = pk2(v[2], v[3]); w.z = pk2(v[4], v[5]); w.w = pk2(v[6], v[7]);
            if (sub == 0) qa[d0] = __builtin_bit_cast(bf16x8, w); else qc[d0] = __builtin_bit_cast(bf16x8, w);
        }
    }
    const GAS unsigned char* Kg = (const GAS unsigned char*)(K + (size_t)(b * 8 + h) * KVLEN * 96);
    const GAS unsigned char* Vg = (const GAS unsigned char*)(Vt + (size_t)(b * 8 + h) * 64 * KVLEN);
    const unsigned ldsb = (unsigned)(size_t)lds;
    const GAS unsigned char* src[3]; int stride[3]; unsigned dsto[3];
#pragma unroll
    for (int k = 0; k < 3; ++k) { int j = wave + 8 * k; if (j >= AT_NP) j -= 8; const int id = j * 64 + lane;
        if (j < 13) { const int row = id / 13; int col = id - row * 13; if (col == 12) col = 0; src[k] = Kg + row * 192 + col * 16; stride[k] = 12288; }
        else { const int idv = id - 832, d = idv / 9; int c = idv - d * 9; if (c == 8) c = 0; src[k] = Vg + ((size_t)d * KVLEN + c * 8) * 2; stride[k] = 128; }
        dsto[k] = ldsb + j * 1024; }
#define AT_ISSUE(t, slot) do { _Pragma("unroll") for (int k_ = 0; k_ < 3; ++k_) glds16(src[k_] + (size_t)(t) * stride[k_], (unsigned)__builtin_amdgcn_readfirstlane(dsto[k_] + (slot) * AT_SLOT)); } while (0)
    f32x16 oA0, oA1, oB0, oB1;
#pragma unroll
    for (int i = 0; i < 16; ++i) { oA0[i] = 0.f; oA1[i] = 0.f; oB0[i] = 0.f; oB1[i] = 0.f; }
    float mA = -1e30f, mB = -1e30f, lA = 0.f, lB = 0.f;
    constexpr int NT_ = KVLEN / 64;
    AT_ISSUE(0, 0); AT_ISSUE(1, 1);
    int slot = 0, nslot = 2;
#pragma unroll 1
    for (int t = 0; t < NT_; ++t) {
        if (t + 1 < NT_) asm volatile("s_waitcnt vmcnt(3) lgkmcnt(0)\n\ts_barrier" ::: "memory"); else asm volatile("s_waitcnt vmcnt(0) lgkmcnt(0)\n\ts_barrier" ::: "memory");
        if (t + 2 < NT_) AT_ISSUE(t + 2, nslot);
        const LAS unsigned char* sb = lds + slot * AT_SLOT;
#pragma unroll
        for (int hh = 0; hh < 2; ++hh) {
            const LAS unsigned char* kb = sb + (32 * hh + r32s) * AT_KROW + hi * 16;
            f32x16 pA, pB;
#pragma unroll
            for (int i = 0; i < 16; ++i) { pA[i] = 0.f; pB[i] = 0.f; }
#pragma unroll
            for (int d0 = 0; d0 < 6; ++d0) { const bf16x8 a0 = *(const LAS bf16x8*)(kb + d0 * 32); pA = MFMA32(a0, qa[d0], pA); pB = MFMA32(a0, qc[d0], pB); }
            u32x4 pwA0, pwA1, pwB0, pwB1;
            float mxA, mxB; AT_LMAX(pA, mxA); AT_LMAX(pB, mxB);
            { const float oa = __shfl_xor(mxA, 32), ob = __shfl_xor(mxB, 32); mxA = fmaxf(mxA, oa); mxB = fmaxf(mxB, ob); }
            AT_SOFTMAX(pA, mxA, mA, lA, oA0, oA1, pwA0, pwA1);
            AT_SOFTMAX(pB, mxB, mB, lB, oB0, oB1, pwB0, pwB1);
            const LAS unsigned char* vb = sb + AT_VOFF + r32 * AT_VROW + hi * 16 + hh * 64;
#pragma unroll
            for (int ks = 0; ks < 2; ++ks) {
                const bf16x8 va0 = *(const LAS bf16x8*)(vb + ks * 32), va1 = *(const LAS bf16x8*)(vb + 32 * AT_VROW + ks * 32);
                const bf16x8 pa = __builtin_bit_cast(bf16x8, ks ? pwA1 : pwA0), pb = __builtin_bit_cast(bf16x8, ks ? pwB1 : pwB0);
                oA0 = MFMA32(va0, pa, oA0); oA1 = MFMA32(va1, pa, oA1); oB0 = MFMA32(va0, pb, oB0); oB1 = MFMA32(va1, pb, oB1);
            }
        }
        slot = slot == 2 ? 0 : slot + 1; nslot = nslot == 2 ? 0 : nslot + 1;
    }
    asm volatile("s_waitcnt lgkmcnt(0)\n\ts_barrier" ::: "memory");
    {   const float inv = 1.f / (lA + __shfl_xor(lA, 32));
        GAS bf16_t* op = A2 + (size_t)(b * SEQ + q0 + r32) * DM + 512 + h * 64 + 4 * hi;
#pragma unroll
        for (int g = 0; g < 4; ++g) { u32x2 w0, w1; w0.x = pk2(oA0[4 * g] * inv, oA0[4 * g + 1] * inv); w0.y = pk2(oA0[4 * g + 2] * inv, oA0[4 * g + 3] * inv);
            w1.x = pk2(oA1[4 * g] * inv, oA1[4 * g + 1] * inv); w1.y = pk2(oA1[4 * g + 2] * inv, oA1[4 * g + 3] * inv);
            *(GAS u32x2*)(op + 8 * g) = w0; *(GAS u32x2*)(op + 32 + 8 * g) = w1; } }
    {   const float inv = 1.f / (lB + __shfl_xor(lB, 32));
        GAS bf16_t* op = A2 + (size_t)(b * SEQ + q0 + 32 + r32) * DM + 512 + h * 64 + 4 * hi;
#pragma unroll
        for (int g = 0; g < 4; ++g) { u32x2 w0, w1; w0.x = pk2(oB0[4 * g] * inv, oB0[4 * g + 1] * inv); w0.y = pk2(oB0[4 * g + 2] * inv, oB0[4 * g + 3] * inv);
            w1.x = pk2(oB1[4 * g] * inv, oB1[4 * g + 1] * inv); w1.y = pk2(oB1[4 * g + 2] * inv, oB1[4 * g + 3] * inv);
            *(GAS u32x2*)(op + 8 * g) = w0; *(GAS u32x2*)(op + 32 + 8 * g) = w1; } }
#undef AT_ISSUE
}
__device__ __forceinline__ void p7_rows(const GAS float* __restrict__ x, const GAS float* __restrict__ g_post, const GAS float* __restrict__ g_pre, GAS bf16_t* __restrict__ X1b, const GAS float* __restrict__ mod, const GAS bf16_t* __restrict__ Y, GAS bf16_t* __restrict__ H2, int gw, int NGW, int lane) {
    for (int m0 = 2 * gw; m0 < MLAT; m0 += 2 * NGW) {
        const GAS float* md = mod + (m0 >> 13) * NMOD;
        f32x4 y[2][4], xv[2][4]; float ss[2];
#pragma unroll
        for (int r = 0; r < 2; ++r) { ss[r] = 0.f;
#pragma unroll
            for (int j = 0; j < 4; ++j) { const u32x2 w = *(const GAS u32x2*)(Y + (size_t)(m0 + r) * DM + 4 * lane + 256 * j); xv[r][j] = *(const GAS f32x4*)(x + (size_t)(m0 + r) * DM + 4 * lane + 256 * j);
                y[r][j] = (f32x4){bflo(w.x), bfhi(w.x), bflo(w.y), bfhi(w.y)}; ss[r] += y[r][j].x * y[r][j].x + y[r][j].y * y[r][j].y + y[r][j].z * y[r][j].z + y[r][j].w * y[r][j].w; } }
#pragma unroll
        for (int r = 0; r < 2; ++r) { const int m = m0 + r;
            const float rs = rsqrtf(wave_sum(ss[r]) * (1.f / DM) + EPS); float s2 = 0.f;
#pragma unroll
            for (int j = 0; j < 4; ++j) { const int k = 4 * lane + 256 * j;
                const f32x4 gg = *(const GAS f32x4*)(g_post + k), gt = *(const GAS f32x4*)(md + 2 * DM + k);
                xv[r][j] = xv[r][j] + gt * (y[r][j] * rs * gg); { u32x2 o1; o1.x = pk2(xv[r][j].x, xv[r][j].y); o1.y = pk2(xv[r][j].z, xv[r][j].w); *(GAS u32x2*)(X1b + (size_t)m * DM + k) = o1; }
                s2 += xv[r][j].x * xv[r][j].x + xv[r][j].y * xv[r][j].y + xv[r][j].z * xv[r][j].z + xv[r][j].w * xv[r][j].w; }
            const float rs2 = rsqrtf(wave_sum(s2) * (1.f / DM) + EPS);
#pragma unroll
            for (int j = 0; j < 4; ++j) { const int k = 4 * lane + 256 * j;
                const f32x4 gg = *(const GAS f32x4*)(g_pre + k), sh = *(const GAS f32x4*)(md + 3 * DM + k), sc = *(const GAS f32x4*)(md + 4 * DM + k);
                const f32x4 hh = xv[r][j] * rs2 * gg * (sc + 1.f) + sh;
                u32x2 o; o.x = pk2(hh.x, hh.y); o.y = pk2(hh.z, hh.w); *(GAS u32x2*)(H2 + (size_t)m * DM + k) = o; } }
    }
}
__device__ __forceinline__ void p11_rows(const GAS float* __restrict__ g_post, GAS float* __restrict__ out, const GAS bf16_t* __restrict__ X1b, const GAS float* __restrict__ mod, const GAS bf16_t* __restrict__ Fb, int gw, int NGW, int lane) {
    for (int m0 = 2 * gw; m0 < MLAT; m0 += 2 * NGW) {
        const GAS float* md = mod + (m0 >> 13) * NMOD;
        f32x4 y[2][4], xv[2][4]; float ss[2];
#pragma unroll
        for (int r = 0; r < 2; ++r) { ss[r] = 0.f;
#pragma unroll
            for (int j = 0; j < 4; ++j) { const u32x2 w = *(const GAS u32x2*)(Fb + (size_t)(m0 + r) * DM + 4 * lane + 256 * j); { const u32x2 w1 = *(const GAS u32x2*)(X1b + (size_t)(m0 + r) * DM + 4 * lane + 256 * j); xv[r][j] = (f32x4){bflo(w1.x), bfhi(w1.x), bflo(w1.y), bfhi(w1.y)}; }
                y[r][j] = (f32x4){bflo(w.x), bfhi(w.x), bflo(w.y), bfhi(w.y)}; ss[r] += y[r][j].x * y[r][j].x + y[r][j].y * y[r][j].y + y[r][j].z * y[r][j].z + y[r][j].w * y[r][j].w; } }
#pragma unroll
        for (int r = 0; r < 2; ++r) { const float rs = rsqrtf(wave_sum(ss[r]) * (1.f / DM) + EPS);
#pragma unroll
            for (int j = 0; j < 4; ++j) { const int k = 4 * lane + 256 * j;
                const f32x4 gg = *(const GAS f32x4*)(g_post + k), gt = *(const GAS f32x4*)(md + 5 * DM + k);
                *(GAS f32x4*)(out + (size_t)(m0 + r) * DM + k) = xv[r][j] + gt * (y[r][j] * rs * gg); } }
    }
}
__device__ __forceinline__ void convgate_phase(const GAS float* __restrict__ cw, const GAS float* __restrict__ cb, const GAS bf16_t* __restrict__ UP, GAS bf16_t* __restrict__ G, int half, int gtid, int NT) {
    constexpr int JG = DFF / 8, RG = 32, NTASK = (MLAT / 2 / RG) * JG;
    for (int task = gtid; task < NTASK; task += NT) {
        const int jg = task % JG, rg = task / JG, j0 = jg * 8, r0 = rg * RG, m0 = half * (MLAT / 2) + r0;
        float wu[3][8], wg[3][8], bu[8], bg[8];
#pragma unroll
        for (int k = 0; k < 3; ++k)
#pragma unroll
            for (int i = 0; i < 8; ++i) { wu[k][i] = cw[k * 2 * DFF + j0 + i]; wg[k][i] = cw[k * 2 * DFF + DFF + j0 + i]; }
#pragma unroll
        for (int i = 0; i < 8; ++i) { bu[i] = cb[j0 + i]; bg[i] = cb[DFF + j0 + i]; }
        const GAS bf16_t* up = UP + (size_t)r0 * (2 * DFF) + j0;
        u32x4 pu = {0u, 0u, 0u, 0u}, pg = {0u, 0u, 0u, 0u}, cu, cg_, nu, ng;
        if ((m0 & 8191) != 0) { pu = *(const GAS u32x4*)(up - 2 * DFF); pg = *(const GAS u32x4*)(up - 2 * DFF + DFF); }
        cu = *(const GAS u32x4*)(up); cg_ = *(const GAS u32x4*)(up + DFF);
#pragma unroll 8
        for (int r = 0; r < RG; ++r) {
            const bool nv = (r + 1 < RG) || (((m0 + RG) & 8191) != 0);
            if (nv) { nu = *(const GAS u32x4*)(up + (size_t)(r + 1) * (2 * DFF)); ng = *(const GAS u32x4*)(up + (size_t)(r + 1) * (2 * DFF) + DFF); } else { nu = (u32x4){0u, 0u, 0u, 0u}; ng = nu; }
            float o[8];
#pragma unroll
            for (int i = 0; i < 8; ++i) { const int w_ = i >> 1;
                const float p_u = (i & 1) ? bfhi(pu[w_]) : bflo(pu[w_]), c_u = (i & 1) ? bfhi(cu[w_]) : bflo(cu[w_]), n_u = (i & 1) ? bfhi(nu[w_]) : bflo(nu[w_]);
                const float p_g = (i & 1) ? bfhi(pg[w_]) : bflo(pg[w_]), c_g = (i & 1) ? bfhi(cg_[w_]) : bflo(cg_[w_]), n_g = (i & 1) ? bfhi(ng[w_]) : bflo(ng[w_]);
                const float uv = bu[i] + wu[0][i] * p_u + wu[1][i] * c_u + wu[2][i] * n_u, gv = bg[i] + wg[0][i] * p_g + wg[1][i] * c_g + wg[2][i] * n_g;
                o[i] = gv * __builtin_amdgcn_rcpf(1.f + __builtin_amdgcn_exp2f(-1.4426950408889634f * gv)) * uv; }
            u32x4 w; w.x = pk2(o[0], o[1]); w.y = pk2(o[2], o[3]); w.z = pk2(o[4], o[5]); w.w = pk2(o[6], o[7]);
            *(GAS u32x4*)(G + (size_t)(r0 + r) * DFF + j0) = w;
            pu = cu; pg = cg_; cu = nu; cg_ = ng;
        }
    }
}
constexpr int NPH = 17;
__global__ void __launch_bounds__(512, 2) fwd_kernel(Args a) {
    extern __shared__ __attribute__((aligned(16))) unsigned char lds_raw[];
    LAS unsigned char* lds = (LAS unsigned char*)lds_raw;
    const int lo = a.ph_lo, hi_ = a.ph_hi;
    {
        volatile LAS unsigned* st0 = (volatile LAS unsigned*)(lds + LDS_MISC);
        if (threadIdx.x < 2) st0[threadIdx.x] = 0u;
        __syncthreads();
        (void)xcd_barrier_post((unsigned*)(a.ws + WS_BAR), st0);
    }
#if MK_COOP
    cg::grid_group grid = cg::this_grid();
#endif
    typedef pg8::EpiBf16<0> EpiB;
    constexpr int MH = MLAT / 2;
#ifndef REPMASK
#define REPMASK 0
#endif
    bool repeated = false;
#pragma unroll 1
    for (int ph = lo; ph < hi_; ++ph) {
        int tid = threadIdx.x; asm volatile("" : "+v"(tid));
        int G = gridDim.x, bx = blockIdx.x; asm volatile("" : "+s"(G), "+s"(bx));
        const int lane = tid & 63, wave = __builtin_amdgcn_readfirstlane(tid >> 6);
        const int vcu = (G % 8 == 0) ? (bx % 8) * (G / 8) + bx / 8 : bx;
        const int gw = vcu * 8 + wave, NGW = G * 8, gtid = bx * 512 + tid, NTH = G * 512;
        unsigned char* ws_ = a.ws; asm volatile("" : "+s"(ws_)); GAS unsigned char* ws = (GAS unsigned char*)ws_;
        GAS float* mod = (GAS float*)(ws + WS_MOD); GAS float* ssq = (GAS float*)(ws + WS_SSQ); GAS float* sskv = (GAS float*)(ws + WS_SSKV);
        GAS bf16_t* Win = (GAS bf16_t*)(ws + WS_WIN); GAS bf16_t* Wq = (GAS bf16_t*)(ws + WS_WQ); GAS bf16_t* Wkv = (GAS bf16_t*)(ws + WS_WKV); GAS bf16_t* Wg = (GAS bf16_t*)(ws + WS_WG);
        GAS bf16_t* Wout = (GAS bf16_t*)(ws + WS_WOUT); GAS bf16_t* Wup = (GAS bf16_t*)(ws + WS_WUP); GAS bf16_t* Wdn = (GAS bf16_t*)(ws + WS_WDN);
        GAS f32x2* AGG = (GAS f32x2*)(ws + WS_AGG); GAS float* RT = (GAS float*)(ws + WS_ROPE);
        GAS bf16_t* H = (GAS bf16_t*)(ws + WS_R1); GAS bf16_t* KVR = H; GAS bf16_t* H2 = H; GAS bf16_t* QR = (GAS bf16_t*)(ws + WS_Q);
        GAS bf16_t* P = (GAS bf16_t*)(ws + WS_R2); GAS bf16_t* Y = P; GAS bf16_t* Fb = P;
        GAS unsigned* LU = (GAS unsigned*)(ws + WS_LU); GAS bf16_t* Kb = (GAS bf16_t*)(ws + WS_K); GAS bf16_t* Vb = (GAS bf16_t*)(ws + WS_V); GAS bf16_t* A2 = (GAS bf16_t*)(ws + WS_A2);
        GAS bf16_t* UP = (GAS bf16_t*)(ws + WS_UP); GAS bf16_t* Gb = (GAS bf16_t*)(ws + WS_G);
        float* outp_ = a.out; asm volatile("" : "+s"(outp_)); GAS float* outp = (GAS float*)outp_;
        pg8::Gemm g{nullptr, nullptr, 0, 0, 0, 0, 0}; GAS bf16_t* O = nullptr; int ldc = 0;
        switch (ph) {
            case 2:  g = pg8::Gemm{(const bf16_t*)(H), (const bf16_t*)(Win), MALL, PW, DM, DM, DM}; O = P; ldc = PW; break;
            case 4:  g = pg8::Gemm{(const bf16_t*)(P + 1024), (const bf16_t*)(Wq), MLAT, 768, 256, PW, 256}; O = QR; ldc = 768; break;
            case 5:  g = pg8::Gemm{(const bf16_t*)(P + 1280), (const bf16_t*)(Wkv), MALL, 1024, 256, PW, 256}; O = KVR; ldc = 1024; break;
            case 8:  g = pg8::Gemm{(const bf16_t*)(A2), (const bf16_t*)(Wout), MLAT, DM, DM, DM, DM}; O = Y; ldc = DM; break;
            case 10: g = pg8::Gemm{(const bf16_t*)(H2), (const bf16_t*)(Wup), MH, 2 * DFF, DM, DM, DM}; O = UP; ldc = 2 * DFF; break;
            case 13: g = pg8::Gemm{(const bf16_t*)(H2 + (size_t)MH * DM), (const bf16_t*)(Wup), MH, 2 * DFF, DM, DM, DM}; O = UP; ldc = 2 * DFF; break;
            case 12: g = pg8::Gemm{(const bf16_t*)(Gb), (const bf16_t*)(Wdn), MH, DM, DFF, DFF, DFF}; O = Fb; ldc = DM; break;
            case 15: g = pg8::Gemm{(const bf16_t*)(Gb), (const bf16_t*)(Wdn), MH, DM, DFF, DFF, DFF}; O = Fb + (size_t)MH * DM; ldc = DM; break;
            default: break;
        }
        if (g.A != nullptr) {
            pg8::StaticOrder S; S.init(g.M, g.N, G, bx); EpiB E{(bf16_t*)O, ldc, nullptr, 0, 0, 1.f};
            pg8::gemm_phase<EpiB, pg8::StaticOrder, true, true>(lds, g, S, E, tid);
        }
#ifndef NGM
#define NGM 0x1ffff
#endif
#define NG(k) ((NGM >> (k)) & 1)
        else if (NG(0) && ph == 0) {
            prep_mat<0>(argp(10), nullptr, Win, 1536, 1024, gtid, NTH); prep_mat<1>(argp(18), argp(19), Wq, 768, 256, gtid, NTH); prep_mat<2>(argp(20), argp(21), Wkv, 1024, 256, gtid, NTH);
            prep_mat<3>(argp(13), argp(15), Wg, 2048, 64, gtid, NTH); prep_mat<4>(argp(22), nullptr, Wout, 1024, 1024, gtid, NTH); prep_mat<5>(argp(23), nullptr, Wup, 5632, 1024, gtid, NTH);
            prep_mat<6>(argp(26), nullptr, Wdn, 1024, 2816, gtid, NTH);
            if (gtid < 1024) { const float nl = -argp(17)[gtid]; RT[2048 + gtid] = 8.f * 1.4426950408889634f * (nl > 20.f ? nl : log1pf(__expf(nl))); }
            if (gtid < 1024) { const int pos = gtid >> 3, j = gtid & 7; const float invf[8] = {1.f, 0.31622776601683794f, 0.1f, 0.031622776601683794f, 0.01f, 0.0031622776601683794f, 0.001f, 0.00031622776601683794f};
                const float ang = (float)pos * invf[j]; RT[2 * gtid] = cosf(ang); RT[2 * gtid + 1] = sinf(ang); }
            mod_phase(argp(1), argp(3), argp(4), argp(5), mod, (LAS float*)(lds + wave * 4096), gw, NGW, lane);
        } else if (NG(1) && ph == 1) {
            p1_rows(argp(0), argp(2), argp(6), mod, H, gw, NGW, lane);
        } else if (NG(3) && ph == 3) {
            gates_phase(argp(11), argp(12), argp(14), argp(16), (const GAS float*)(RT + 2048), lds, P, Wg, LU, AGG, tid, wave, lane);
            ss_phase(P, ssq, sskv, gw, NGW, lane);
        } else if (NG(6) && ph == 6) {
            krope_phase(P, Kb, RT, gtid, NTH); kvpost_phase(KVR, sskv, Kb, Vb, gtid, NTH);
#ifdef REP6
            if (REP6 & 1) { __syncthreads(); scan_agg(LU, AGG, gw, NGW, lane); }
            if (REP6 & 2) { __syncthreads(); krope_phase(P, Kb, RT, gtid, NTH); }
            if (REP6 & 4) { __syncthreads(); }
            if (REP6 & 8) { __syncthreads(); kvpost_phase(KVR, sskv, Kb, Vb, gtid, NTH); }
#endif
        } else if (NG(7) && ph == 7) {
            scan_final(LU, AGG, P, A2, gw, NGW, lane);
#ifdef REP7
            __syncthreads(); scan_final(LU, AGG, P, A2, gw, NGW, lane);
#endif
            const int upb = (NB * 8 * 16 + G - 1) / G, u0 = vcu * upb, u1 = min(NB * 8 * 16, u0 + upb);
            __syncthreads();
            for (int unit = u0; unit < u1; ++unit) { const int bh = unit >> 4, qb = unit & 15; attn_unit(lds, QR, ssq, RT, Kb, Vb, A2, bh >> 3, bh & 7, qb, tid, wave, lane); }
        } else if (NG(9) && ph == 9) {
            p7_rows(argp(0), argp(7), argp(8), (GAS bf16_t*)(ws + WS_X1), mod, Y, H2, gw, NGW, lane);
        } else if (NG(11) && (ph == 11 || ph == 14)) {
            convgate_phase(argp(24), argp(25), UP, Gb, ph == 14 ? 1 : 0, gtid, NTH);
        } else if (NG(16) && ph == 16) {
            p11_rows(argp(9), outp, (const GAS bf16_t*)(ws + WS_X1), mod, Fb, gw, NGW, lane);
        }
        __syncthreads();
#if MK_COOP
        if (ph + 1 < hi_ && ph != 3 && ph != 4 && ph != 12) {
            if (ph == 0) grid.sync();
            else { XcdBarrier xb; xb.bar = (unsigned*)(ws_ + WS_BAR); xb.x = xb_xcc_id(); xb.st = (volatile LAS unsigned*)(lds + LDS_MISC); xcd_barrier(xb); }
        }
#endif
        if (REPMASK) { if (((REPMASK >> ph) & 1) && !repeated) { repeated = true; --ph; } else repeated = false; }
    }
}

extern "C" void kernel_launch(void* const* d_in, const int* in_sizes, int n_in, void* d_out, int out_size, void* d_ws, size_t ws_size, hipStream_t stream) {
    static int grid = 0;
    if (grid == 0) {
        if (n_in != 27 || out_size != MLAT * DM || ws_size < WS_END) { fprintf(stderr, "kernel_launch: unexpected shapes (n_in %d, out %d, ws %zu)\n", n_in, out_size, ws_size); grid = -1; return; }
        int dev = 0, cus = 0, per_cu = 0;
        if (hipGetDevice(&dev) != hipSuccess || hipDeviceGetAttribute(&cus, hipDeviceAttributeMultiprocessorCount, dev) != hipSuccess) { grid = -1; return; }
        if (hipFuncSetAttribute((const void*)fwd_kernel, hipFuncAttributeMaxDynamicSharedMemorySize, LDS_BYTES) != hipSuccess) { fprintf(stderr, "kernel_launch: hipFuncSetAttribute failed\n"); grid = -1; return; }
        if (hipOccupancyMaxActiveBlocksPerMultiprocessor(&per_cu, (const void*)fwd_kernel, 512, LDS_BYTES) != hipSuccess || per_cu < 1) { fprintf(stderr, "kernel_launch: occupancy query says %d\n", per_cu); }
        (void)hipGetLastError();
        grid = cus;
    }
    if (grid < 0) return;
    (void)hipMemsetAsync((char*)d_ws + WS_CTL, 0, CTL_BYTES, stream);
    Args a{};
    for (int i = 0; i < 27; ++i) a.in[i] = (const float*)d_in[i];
    a.out = (float*)d_out; a.ws = (unsigned char*)d_ws;
#if MK_COOP
    a.ph_lo = 0; a.ph_hi = NPH;
    void* args[] = {&a};
    hipError_t e = hipLaunchCooperativeKernel((const void*)fwd_kernel, dim3(grid), dim3(512), args, LDS_BYTES, stream);
    if (e != hipSuccess) fprintf(stderr, "kernel_launch: cooperative launch failed: %s (grid %d)\n", hipGetErrorString(e), grid);
#else
    for (int p = 0; p < NPH; ++p) { a.ph_lo = p; a.ph_hi = p + 1; hipLaunchKernelGGL(fwd_kernel, dim3(grid), dim3(512), LDS_BYTES, stream, a); }
#endif
}
```

```cpp
#include <hip/hip_runtime.h>
#include <hip/hip_cooperative_groups.h>
#include <cstdio>
#include <cstdint>
namespace cg = cooperative_groups;
#ifndef MK_COOP
#define MK_COOP 1
#endif
namespace pg8 {
#define PG8_LAS __attribute__((address_space(3)))
typedef unsigned short bf16_t;
typedef short bf16x8 __attribute__((ext_vector_type(8)));
typedef float f32x4 __attribute__((ext_vector_type(4)));
typedef unsigned u32x4 __attribute__((ext_vector_type(4)));
constexpr int BM = 256, BK = 64, HALF = 128, HTB = HALF * BK * 2  , STAGE_BYTES = 8 * HTB, NXCD = 8, WGM = 8;

__host__ __device__ __forceinline__ int lds_byte(int r, int c) { const int st = (r >> 4) * 2 + (c >> 5), rr = r & 15, cc = c & 31, ob = rr * 64 + cc * 2; return st * 1024 + (ob ^ (((ob >> 9) & 1) << 5)); }
__host__ __device__ __forceinline__ void stage_rc(int b, int& R, int& C) { const int st = b / 1024, sb = b % 1024, swz = sb ^ (((sb >> 9) & 1) << 5); R = (st >> 1) * 16 + swz / 64; C = (st & 1) * 32 + (swz % 64) / 2; }
__host__ __device__ __forceinline__ int perm32(int rho) { const int n = rho >> 4, i = rho & 15; return 8 * (i >> 2) + 4 * n + (i & 3); }

struct Unit { int pm, pn; };
struct Gemm { const bf16_t* A; const bf16_t* Bt; int M, N, K, lda, ldb; };

struct StaticOrder {
    int nM, nN, nwg, G, c;
    __host__ __device__ void init(int M, int N, int G_, int c_) { nM = M / BM; nN = N / BM; nwg = nM * nN; G = G_; c = c_; }
    __host__ __device__ bool next(int i, Unit& u) const {
        const long L = (long)i * G + c; if (L >= nwg) return false;
        int wgid = (int)L; { const int q = nwg / NXCD, r = nwg % NXCD, xcd = wgid % NXCD, off = wgid / NXCD; wgid = (xcd < r ? xcd * (q + 1) : r * (q + 1) + (xcd - r) * q) + off; }
        const int nig = WGM * nN, gid = wgid / nig, fm = gid * WGM, gsz = (nM - fm) < WGM ? (nM - fm) : WGM;
        u.pm = fm + ((wgid % nig) % gsz); u.pn = (wgid % nig) / gsz; return true;
    }
    __device__ __forceinline__ void a_ready(const Unit&) const {}
    __device__ __forceinline__ void done(const Unit&) const {}
};

__device__ __forceinline__ unsigned cvt_pk_bf16(float lo, float hi) { unsigned r; asm volatile("v_cvt_pk_bf16_f32 %0, %1, %2" : "=v"(r) : "v"(lo), "v"(hi)); return r; }
typedef float f32x2 __attribute__((ext_vector_type(2)));
__device__ __forceinline__ f32x2 gelu_pk(f32x2 v) {
    const f32x2 av = __builtin_elementwise_abs(v), d = av * 0.2316418882f + 1.0f;
    f32x2 t; t.x = __builtin_amdgcn_rcpf(d.x); t.y = __builtin_amdgcn_rcpf(d.y);
    f32x2 q = t * 0.5307027145f + (-0.7265760135f); q = q * t + 0.7107068705f; q = q * t + (-0.142248368f); q = q * t + 0.127414796f; q = q * t;
    const f32x2 s = (v * v) * (-0.72134752044f);
    f32x2 e; e.x = __builtin_amdgcn_exp2f(s.x); e.y = __builtin_amdgcn_exp2f(s.y);
    const f32x2 m = v * (q * e), r = v - m;
    f32x2 o; o.x = v.x < 0.f ? m.x : r.x; o.y = v.y < 0.f ? m.y : r.y; return o;
}

template <int ACT  > struct EpiBf16 {
    static constexpr bool PERM = true, AFTER_DRAIN = false; static_assert(ACT == 0 || ACT == 1, "EpiBf16: ACT is 0 (none) or 1 (gelu_pk)");
    bf16_t* O; int ldc; const float* bias; int split_cols; size_t split_stride; float scale0;
    __device__ __forceinline__ void operator()(const f32x4 (&acc)[2][2][4][2], const Unit& u, int wr, int wc, int fr, int fq) const {
        const int row0 = u.pm * BM + wr * 64 + fr; int colt = u.pn * BM; bf16_t* base = O;
        float sc = 1.f; if (split_cols) { const int t = colt / split_cols; base += (size_t)t * split_stride; colt -= t * split_cols; if (t == 0) sc = scale0; }
        const int col0 = colt + wc * 32 + 8 * fq, bcol0 = u.pn * BM + wc * 32 + 8 * fq;
        f32x4 bv[2][2];
#pragma unroll
        for (int bj = 0; bj < 2; ++bj)
#pragma unroll
            for (int n = 0; n < 2; ++n) bv[bj][n] = bias ? *(const f32x4*)(bias + bcol0 + bj * HALF + 4 * n) : (f32x4){0.f, 0.f, 0.f, 0.f};
#pragma unroll
        for (int ai = 0; ai < 2; ++ai)
#pragma unroll
            for (int m = 0; m < 4; ++m) { bf16_t* rowp = base + (size_t)(row0 + ai * HALF + m * 16) * ldc + col0;
#pragma unroll
                for (int bj = 0; bj < 2; ++bj) { f32x4 v0 = acc[ai][bj][m][0] + bv[bj][0], v1 = acc[ai][bj][m][1] + bv[bj][1];
                    if (ACT == 1) { f32x2 a = gelu_pk((f32x2){v0[0], v0[1]}), b = gelu_pk((f32x2){v0[2], v0[3]}), c = gelu_pk((f32x2){v1[0], v1[1]}), d = gelu_pk((f32x2){v1[2], v1[3]});
                        v0 = (f32x4){a.x, a.y, b.x, b.y}; v1 = (f32x4){c.x, c.y, d.x, d.y}; }
                    v0 = v0 * sc; v1 = v1 * sc; u32x4 w; w.x = cvt_pk_bf16(v0[0], v0[1]); w.y = cvt_pk_bf16(v0[2], v0[3]); w.z = cvt_pk_bf16(v1[0], v1[1]); w.w = cvt_pk_bf16(v1[2], v1[3]);
                    *(__attribute__((address_space(1))) u32x4*)(rowp + bj * HALF) = w; } }
    }
};
template <class Epi, class Sched, bool ALIGN_EPI = false, bool SP2 = false>
__device__ __forceinline__ void gemm_phase(PG8_LAS unsigned char* lds, const Gemm g, const Sched& S, const Epi& E, const int tid) {
    const int wid = __builtin_amdgcn_readfirstlane(tid >> 6), lane = tid & 63, wr = wid >> 2, wc = wid & 3, fr = lane & 15, fq = lane >> 4;
    const int K = g.K, nt = K / BK;
    unsigned voffA[2], voffB[2];
#pragma unroll
    for (int i = 0; i < 2; ++i) { int R, C; stage_rc(tid * 16 + i * 8192, R, C); const int Rb = Epi::PERM ? ((R & ~31) + perm32(R & 31)) : R;
        voffA[i] = (unsigned)(R * g.lda + C) * 2u; voffB[i] = (unsigned)(Rb * g.ldb + C) * 2u; }
    const size_t kstep = (size_t)(BK * 2);
    const size_t hstepA = (size_t)HALF * g.lda * 2, hstepB = (size_t)HALF * g.ldb * 2;
    const size_t tstepA = 2 * hstepA, tstepB = 2 * hstepB;
    const unsigned ldsw = (unsigned)wid * 1024u;
    const int aoff = lds_byte(wr * 64 + fr, fq * 8), boff = lds_byte(wc * 32 + fr, fq * 8);
#define PG8_SA(b, h) (((b) * 2 + (h)) * HTB)
#define PG8_SB(b, h) ((4 + (b) * 2 + (h)) * HTB)
#define PG8_STAGE(bufoff, gbase, voff) do { _Pragma("unroll") for (int _i = 0; _i < 2; ++_i) \
        __builtin_amdgcn_global_load_lds((const unsigned*)((const char*)(gbase) + (voff)[_i]), (PG8_LAS unsigned*)(lds + (bufoff) + ldsw + _i * 8192), 16, 0, 0); } while (0)
#define PG8_LDA(dst, b, h) do { _Pragma("unroll") for (int m = 0; m < 4; ++m) _Pragma("unroll") for (int k = 0; k < 2; ++k) dst[m][k] = *(const PG8_LAS bf16x8*)(lds + PG8_SA(b, h) + aoff + m * 2048 + k * 1024); } while (0)
#define PG8_LDB(dst, b, h) do { _Pragma("unroll") for (int n = 0; n < 2; ++n) _Pragma("unroll") for (int k = 0; k < 2; ++k) dst[n][k] = *(const PG8_LAS bf16x8*)(lds + PG8_SB(b, h) + boff + n * 2048 + k * 1024); } while (0)
#define PG8_MMA(ai, bj, At, Bt) do { __builtin_amdgcn_s_setprio(1); _Pragma("unroll") for (int m = 0; m < 4; ++m) _Pragma("unroll") for (int n = 0; n < 2; ++n) _Pragma("unroll") for (int k = 0; k < 2; ++k) \
        acc[ai][bj][m][n] = __builtin_amdgcn_mfma_f32_16x16x32_bf16(Bt[n][k], At[m][k], acc[ai][bj][m][n], 0, 0, 0); __builtin_amdgcn_s_setprio(0); } while (0)
#define PG8_WAIT_V(n) asm volatile("s_waitcnt vmcnt(" #n ")" ::: "memory")
#define PG8_WAIT_L(n) asm volatile("s_waitcnt lgkmcnt(" #n ")" ::: "memory")
#define PG8_BAR __builtin_amdgcn_s_barrier()
#define PG8_SCHED __builtin_amdgcn_sched_barrier(0)
    Unit cur, nxt; int ui = 0;
    if (!S.next(0, cur)) return;
    f32x4 acc[2][2][4][2];
#pragma unroll
    for (int a = 0; a < 2; ++a)
#pragma unroll
        for (int b = 0; b < 2; ++b)
#pragma unroll
            for (int m = 0; m < 4; ++m)
#pragma unroll
                for (int n = 0; n < 2; ++n) acc[a][b][m][n] = (f32x4){0.f, 0.f, 0.f, 0.f};
    bf16x8 At[4][2], B0[2][2], B1[2][2];
    const char* cA = (const char*)g.A + (size_t)cur.pm * tstepA; const char* cB = (const char*)g.Bt + (size_t)cur.pn * tstepB;
    S.a_ready(cur);
    if constexpr (SP2) {
        PG8_STAGE(PG8_SB(0, 0), cB, voffB); PG8_STAGE(PG8_SB(0, 1), cB + hstepB, voffB); PG8_STAGE(PG8_SA(0, 0), cA, voffA); PG8_STAGE(PG8_SA(0, 1), cA + hstepA, voffA);
        if (wr == 1) PG8_BAR;
        PG8_WAIT_V(2); PG8_BAR;
        PG8_STAGE(PG8_SB(1, 0), cB + kstep, voffB); PG8_STAGE(PG8_SA(1, 0), cA + kstep, voffA); PG8_STAGE(PG8_SB(1, 1), cB + hstepB + kstep, voffB);
        PG8_WAIT_V(6); PG8_BAR;
    } else {
        PG8_STAGE(PG8_SB(0, 0), cB, voffB); PG8_STAGE(PG8_SA(0, 0), cA, voffA); PG8_STAGE(PG8_SB(0, 1), cB + hstepB, voffB); PG8_STAGE(PG8_SA(0, 1), cA + hstepA, voffA);
        if (wr == 1) PG8_BAR;
        PG8_WAIT_V(4); PG8_BAR;
        PG8_STAGE(PG8_SB(1, 0), cB + kstep, voffB); PG8_STAGE(PG8_SA(1, 0), cA + kstep, voffA); PG8_STAGE(PG8_SB(1, 1), cB + hstepB + kstep, voffB);
        PG8_WAIT_V(6); PG8_BAR;
    }
    for (;;) {
        const bool has_next = S.next(ui + 1, nxt);
        const char* nA = has_next ? (const char*)g.A + (size_t)nxt.pm * tstepA : cA; const char* nB = has_next ? (const char*)g.Bt + (size_t)nxt.pn * tstepB : cB;
        for (int t = 0; t < nt; t += 2) {
            const bool last = (t == nt - 2);
            const char* a1 = cA + (size_t)(t + 1) * kstep;
            const char* a2 = last ? nA : cA + (size_t)(t + 2) * kstep; const char* b2 = last ? nB : cB + (size_t)(t + 2) * kstep;
            const char* a3 = a2 + kstep; const char* b3 = b2 + kstep;
            if (last && has_next) S.a_ready(nxt);
            if constexpr (SP2) {
            PG8_LDB(B0, 0, 0); PG8_LDB(B1, 0, 1); PG8_SCHED; PG8_LDA(At, 0, 0); PG8_STAGE(PG8_SA(1, 1), a1 + hstepA, voffA);
            PG8_WAIT_V(8); PG8_WAIT_L(0); PG8_BAR; PG8_MMA(0, 0, At, B0); PG8_MMA(0, 1, At, B1); PG8_BAR; PG8_SCHED;
            PG8_LDA(At, 0, 1); PG8_STAGE(PG8_SB(0, 0), b2, voffB); PG8_STAGE(PG8_SB(0, 1), b2 + hstepB, voffB); PG8_STAGE(PG8_SA(0, 0), a2, voffA);
            PG8_WAIT_V(8); PG8_WAIT_L(0); PG8_BAR; PG8_MMA(1, 0, At, B0); PG8_MMA(1, 1, At, B1); PG8_BAR; PG8_SCHED;
            PG8_LDB(B0, 1, 0); PG8_LDB(B1, 1, 1); PG8_SCHED; PG8_LDA(At, 1, 0); PG8_STAGE(PG8_SA(0, 1), a2 + hstepA, voffA);
            PG8_WAIT_V(8); PG8_WAIT_L(0); PG8_BAR; PG8_MMA(0, 0, At, B0); PG8_MMA(0, 1, At, B1); PG8_BAR; PG8_SCHED;
            PG8_LDA(At, 1, 1); PG8_STAGE(PG8_SB(1, 0), b3, voffB); PG8_STAGE(PG8_SB(1, 1), b3 + hstepB, voffB); PG8_STAGE(PG8_SA(1, 0), a3, voffA);
            PG8_WAIT_V(8); PG8_WAIT_L(0); PG8_BAR; PG8_MMA(1, 0, At, B0); PG8_MMA(1, 1, At, B1); PG8_BAR; PG8_SCHED;
            } else {
            PG8_LDB(B0, 0, 0); PG8_SCHED; PG8_LDA(At, 0, 0); PG8_STAGE(PG8_SA(1, 1), a1 + hstepA, voffA);
            PG8_WAIT_L(8); PG8_BAR; PG8_WAIT_L(0); PG8_MMA(0, 0, At, B0); PG8_BAR; PG8_SCHED;
            PG8_LDB(B1, 0, 1); PG8_STAGE(PG8_SB(0, 0), b2, voffB);
            PG8_BAR; PG8_WAIT_L(0); PG8_MMA(0, 1, At, B1); PG8_BAR;
            PG8_LDA(At, 0, 1); PG8_STAGE(PG8_SA(0, 0), a2, voffA);
            PG8_BAR; PG8_WAIT_L(0); PG8_MMA(1, 0, At, B0); PG8_BAR; PG8_SCHED;
            PG8_STAGE(PG8_SB(0, 1), b2 + hstepB, voffB);
            PG8_WAIT_V(6); PG8_BAR; PG8_MMA(1, 1, At, B1); PG8_BAR;
            PG8_LDB(B0, 1, 0); PG8_SCHED; PG8_LDA(At, 1, 0); PG8_STAGE(PG8_SA(0, 1), a2 + hstepA, voffA);
            PG8_WAIT_L(8); PG8_BAR; PG8_WAIT_L(0); PG8_MMA(0, 0, At, B0); PG8_BAR; PG8_SCHED;
            PG8_LDB(B1, 1, 1); PG8_STAGE(PG8_SB(1, 0), b3, voffB);
            PG8_BAR; PG8_WAIT_L(0); PG8_MMA(0, 1, At, B1); PG8_BAR;
            PG8_LDA(At, 1, 1); PG8_STAGE(PG8_SA(1, 0), a3, voffA);
            PG8_BAR; PG8_WAIT_L(0); PG8_MMA(1, 0, At, B0); PG8_BAR; PG8_SCHED;
            PG8_STAGE(PG8_SB(1, 1), b3 + hstepB, voffB);
            PG8_WAIT_V(6); PG8_BAR; PG8_MMA(1, 1, At, B1); PG8_BAR;
            }
        }
        if constexpr (ALIGN_EPI) { if (wr == 0) PG8_BAR; }
        if constexpr (!Epi::AFTER_DRAIN) { E(acc, cur, wr, wc, fr, fq); S.done(cur); }
        if (!has_next) break;
#pragma unroll
        for (int a = 0; a < 2; ++a)
#pragma unroll
            for (int b = 0; b < 2; ++b)
#pragma unroll
                for (int m = 0; m < 4; ++m)
#pragma unroll
                    for (int n = 0; n < 2; ++n) acc[a][b][m][n] = (f32x4){0.f, 0.f, 0.f, 0.f};
        cur = nxt; cA = nA; cB = nB; ++ui;
        if constexpr (ALIGN_EPI) { if (wr == 1) PG8_BAR; }
    }
    PG8_WAIT_V(0);
    if constexpr (!ALIGN_EPI) { if (wr == 0) PG8_BAR; }
    PG8_BAR;
    if constexpr (Epi::AFTER_DRAIN) { E.fused(acc, cur, wr, wc, fr, fq, lds, wid, lane); S.done(cur); }
#undef PG8_SA
#undef PG8_SB
#undef PG8_STAGE
#undef PG8_LDA
#undef PG8_LDB
#undef PG8_MMA
#undef PG8_WAIT_V
#undef PG8_WAIT_L
#undef PG8_BAR
#undef PG8_SCHED
}
}
#define LAS __attribute__((address_space(3)))
#define GAS __attribute__((address_space(1)))
typedef unsigned short bf16_t;
typedef short bf16x8 __attribute__((ext_vector_type(8)));
typedef short s16x4 __attribute__((ext_vector_type(4)));
typedef float f32x4 __attribute__((ext_vector_type(4)));
typedef float f32x16 __attribute__((ext_vector_type(16)));
typedef unsigned u32x4 __attribute__((ext_vector_type(4)));
typedef unsigned u32x2 __attribute__((ext_vector_type(2)));
typedef float f32x2 __attribute__((ext_vector_type(2)));

constexpr int NB = 8, SEQ = 8192, DM = 1024, CTX = 256, MLAT = NB * SEQ, MCTX = NB * CTX, MALL = MLAT + MCTX;
constexpr int PW = 1536, KVLEN = CTX + SEQ, DFF = 2816, NMOD = 6 * DM;
constexpr int NCH = 32, CHL = 256;
constexpr float EPS = 1e-6f;
constexpr float QSCALE = 0.10206207261596575f * 1.4426950408889634f;
constexpr size_t MiB = 1u << 20;
constexpr size_t WS_CTL = 0, CTL_BYTES = 2 * MiB;
constexpr size_t WS_MOD = 64 * 1024, WS_SSQ = 512 * 1024, WS_SSKV = 1024 * 1024, WS_BAR = 1600 * 1024;
constexpr size_t WS_WIN = 2 * MiB, WS_WQ = 5 * MiB, WS_WKV = 6 * MiB, WS_WG = 7 * MiB, WS_WOUT = 8 * MiB, WS_WUP = 10 * MiB, WS_WDN = 21 * MiB;
constexpr size_t WS_AGG = 27 * MiB, WS_ROPE = 29 * MiB + 512 * 1024;
constexpr size_t WS_R1 = 30 * MiB;
constexpr size_t WS_R2 = 162 * MiB;
constexpr size_t WS_LU = 360 * MiB, WS_K = 624 * MiB, WS_V = 723 * MiB, WS_A2 = 789 * MiB;
constexpr size_t WS_UP = 360 * MiB, WS_G = 712 * MiB, WS_Q = 920 * MiB, WS_X1 = 888 * MiB, WS_END = 1016 * MiB;
constexpr int LDS_BYTES = 139264;
constexpr int LDS_MISC = 131072 + 64;

__device__ __forceinline__ unsigned f2bf(float f) { unsigned u = __builtin_bit_cast(unsigned, f); return (u + 0x7fffu + ((u >> 16) & 1u)) >> 16; }
__device__ __forceinline__ unsigned cvtpk(float lo, float hi) { typedef float f2 __attribute__((ext_vector_type(2))); typedef __bf16 b2 __attribute__((ext_vector_type(2))); f2 v = {lo, hi}; b2 r = __builtin_convertvector(v, b2); return __builtin_bit_cast(unsigned, r); }
__device__ __forceinline__ unsigned pk2(float lo, float hi) { return cvtpk(lo, hi); }
__device__ __forceinline__ float bflo(unsigned w) { return __uint_as_float(w << 16); }
__device__ __forceinline__ float bfhi(unsigned w) { return __uint_as_float(w & 0xffff0000u); }
__device__ __forceinline__ float bf2f(bf16_t v) { return __uint_as_float((unsigned)v << 16); }
__device__ __forceinline__ int crow(int r, int hi) { return (r & 3) + 8 * (r >> 2) + 4 * hi; }
__device__ __forceinline__ float wave_sum(float v) {
#pragma unroll
    for (int o = 1; o < 64; o <<= 1) v += __shfl_xor(v, o);
    return v;
}
__device__ __forceinline__ float sigmoidf_(float x) { return __builtin_amdgcn_rcpf(1.f + __builtin_amdgcn_exp2f(-1.4426950408889634f * x)); }
#define LDS_WAIT() asm volatile("s_waitcnt lgkmcnt(0)" ::: "memory")
#define XB_TMO      128
#define XB_XCNT(j)  (256  + 64 * (j))
#define XB_XSUB(j)  (1280 + 64 * (j))
#define XB_XGEN(j)  (2304 + 64 * (j))
#define XB_TOP      3328
#define XB_TOPGEN   3392
#define XCD_BAR_WORDS 3456
#define XB_SPIN_CAP (1u << 18)

__device__ __forceinline__ unsigned xb_ld(unsigned* p)              { return __hip_atomic_load(p, __ATOMIC_RELAXED, __HIP_MEMORY_SCOPE_AGENT); }
__device__ __forceinline__ unsigned xb_add(unsigned* p, unsigned v) { return __hip_atomic_fetch_add(p, v, __ATOMIC_RELAXED, __HIP_MEMORY_SCOPE_AGENT); }
__device__ __forceinline__ unsigned xb_xcc_id() { return (unsigned)__builtin_amdgcn_s_getreg((3 << 11) | 20) & 0xFu; }
#define XB_SPIN(cond, bar) do { unsigned _sp = 0; while (cond) { __builtin_amdgcn_s_sleep(1); \
    if ((++_sp & 255u) == 0u) { if (xb_ld(&(bar)[XB_TMO])) break; if (_sp > XB_SPIN_CAP) { atomicAdd(&(bar)[XB_TMO], 1u); break; } } } } while (0)

struct XcdBarrier {
    unsigned* bar; unsigned x;
    volatile LAS unsigned* st;
};

__device__ __forceinline__ XcdBarrier xcd_barrier_post(unsigned* bar, volatile LAS unsigned* st) {
    XcdBarrier b; b.bar = bar; b.x = xb_xcc_id(); b.st = st;
    if (threadIdx.x == 0) (void)xb_add(&bar[XB_XCNT(b.x)], 1u);
    return b;
}
__device__ __forceinline__ void xcd_barrier_complete(unsigned* bar, unsigned x, unsigned& nloc, unsigned& nx) {
    const unsigned G = gridDim.x * gridDim.y * gridDim.z;
    unsigned sum, cnt, mine, sp = 0u;
    for (;;) {
        sum = 0u; cnt = 0u; mine = 0u;
#pragma unroll
        for (unsigned j = 0; j < 16; ++j) { const unsigned c = xb_ld(&bar[XB_XCNT(j)]); sum += c; cnt += (c > 0u) ? 1u : 0u; mine = (j == x) ? c : mine; }
        if (sum == G) break;
        __builtin_amdgcn_s_sleep(1);
        if ((++sp & 255u) == 0u) { if (xb_ld(&bar[XB_TMO])) break; if (sp > XB_SPIN_CAP) { atomicAdd(&bar[XB_TMO], 1u); break; } }
    }
    nloc = mine > 0u ? mine : 1u; nx = cnt > 0u ? cnt : 1u;
}

__device__ __forceinline__ void xcd_barrier(const XcdBarrier& b) {
    asm volatile("s_waitcnt vmcnt(0)" ::: "memory");
    __syncthreads();
    if (threadIdx.x == 0) {
        unsigned* bar = b.bar;
        __builtin_amdgcn_s_waitcnt(0);
        unsigned nloc = b.st[0], nx = b.st[1];
        if (nloc == 0u) { xcd_barrier_complete(bar, b.x, nloc, nx); b.st[0] = nloc; b.st[1] = nx; }
        const unsigned old = xb_add(&bar[XB_XSUB(b.x)], 1u);
        const unsigned gen = old / nloc;
        if (old + 1u == (gen + 1u) * nloc) {
            __builtin_amdgcn_fence(__ATOMIC_RELEASE, "agent");
            asm volatile("s_waitcnt vmcnt(0)" ::: "memory");
            const unsigned og = xb_add(&bar[XB_TOP], 1u);
            const unsigned tg = og / nx;
            if (og + 1u == (tg + 1u) * nx) xb_add(&bar[XB_TOPGEN], 1u);
            else XB_SPIN(xb_ld(&bar[XB_TOPGEN]) == tg, bar);
            __builtin_amdgcn_fence(__ATOMIC_ACQUIRE, "agent");
            xb_add(&bar[XB_XGEN(b.x)], 1u);
            asm volatile("s_waitcnt vmcnt(0)" ::: "memory");
        } else {
            XB_SPIN(xb_ld(&bar[XB_XGEN(b.x)]) == gen, bar);
            __builtin_amdgcn_fence(__ATOMIC_ACQUIRE, "agent");
            asm volatile("s_waitcnt vmcnt(0)" ::: "memory");
        }
    }
    __syncthreads();
}


struct Args { const float* in[27]; float* out; unsigned char* ws; int ph_lo, ph_hi; };
__device__ __forceinline__ const GAS float* argp(int i) {
    const __attribute__((address_space(4))) char* kp = (const __attribute__((address_space(4))) char*)__builtin_amdgcn_kernarg_segment_ptr();
    asm volatile("" : "+s"(kp));
    const float* p = *(const float* const __attribute__((address_space(4)))*)(kp + 8 * i);
    return (const GAS float*)p;
}

template <int ID> __device__ __forceinline__ float wsrc(const GAS float* __restrict__ p0, const GAS float* __restrict__ p1, int n, int k) {
    if (ID == 0) return n < 1440 ? p0[(size_t)k * 1440 + n] : 0.f;
    if (ID == 1) return p0[k] * p1[(size_t)k * 768 + n];
    if (ID == 2) return k < 128 ? p0[k] * p1[(size_t)k * 1024 + n] : 0.f;
    if (ID == 3) { const int h = n >> 8, np = n & 255, mat = np >> 6, j = np & 63, dir = mat >> 1; const GAS float* w = (mat & 1) ? p1 : p0; return w[(size_t)((dir * 8 + h) * 64 + k) * 64 + j]; }
    if (ID == 4) return p0[(size_t)k * 1024 + n];
    if (ID == 5) return p0[(size_t)k * 5632 + n];
    return p0[(size_t)k * 1024 + n];
}
template <int ID> __device__ __forceinline__ void prep_mat(const GAS float* __restrict__ p0, const GAS float* __restrict__ p1, GAS bf16_t* __restrict__ dst, int N, int K, int gtid, int NT) {
    const int items = N * (K / 8);
    for (int it = gtid; it < items; it += NT) {
        const int nl = it & 7, kl = (it >> 3) & 7, rest = it >> 6, nb = rest % (N / 8), kb = rest / (N / 8), n = nb * 8 + nl, k8 = kb * 8 + kl;
        u32x4 o;
        o.x = pk2(wsrc<ID>(p0, p1, n, 8 * k8 + 0), wsrc<ID>(p0, p1, n, 8 * k8 + 1)); o.y = pk2(wsrc<ID>(p0, p1, n, 8 * k8 + 2), wsrc<ID>(p0, p1, n, 8 * k8 + 3));
        o.z = pk2(wsrc<ID>(p0, p1, n, 8 * k8 + 4), wsrc<ID>(p0, p1, n, 8 * k8 + 5)); o.w = pk2(wsrc<ID>(p0, p1, n, 8 * k8 + 6), wsrc<ID>(p0, p1, n, 8 * k8 + 7));
        *(GAS u32x4*)(dst + (size_t)n * K + 8 * k8) = o;
    }
}
__device__ __forceinline__ void mod_phase(const GAS float* __restrict__ cvec, const GAS float* __restrict__ cctx, const GAS float* __restrict__ wmod, const GAS float* __restrict__ bmod, GAS float* __restrict__ mod, LAS float* scr, int gw, int NGW, int lane) {
    for (int task = gw; task < 96 * 16; task += NGW) {
        const int cgp = task % 96, kc = task / 96, n = cgp * 64 + lane, k0 = kc * 64;
#pragma unroll
        for (int r = 0; r < 9; ++r) { const float cv = r < 8 ? cvec[r * 1024 + k0 + lane] : cctx[k0 + lane]; scr[r * 64 + lane] = cv / (1.f + __expf(-cv)); }
        LDS_WAIT();
        float acc[9];
#pragma unroll
        for (int r = 0; r < 9; ++r) acc[r] = 0.f;
#pragma unroll 8
        for (int kk = 0; kk < 64; ++kk) { const float w = wmod[(size_t)(k0 + kk) * NMOD + n];
#pragma unroll
            for (int r = 0; r < 9; ++r) acc[r] += scr[r * 64 + kk] * w; }
        const float bias = kc == 0 ? bmod[n] : 0.f;
#pragma unroll
        for (int r = 0; r < 9; ++r) atomicAdd((float*)(mod + r * NMOD + n), acc[r] + bias);
        LDS_WAIT();
    }
}
__device__ __forceinline__ void p1_rows(const GAS float* __restrict__ x, const GAS float* __restrict__ ctx, const GAS float* __restrict__ g, const GAS float* __restrict__ mod, GAS bf16_t* __restrict__ H, int gw, int NGW, int lane) {
    for (int m0 = 2 * gw; m0 < MALL; m0 += 2 * NGW) {
        f32x4 v[2][4]; float ss[2];
#pragma unroll
        for (int r = 0; r < 2; ++r) { const int m = m0 + r; const GAS float* src = m < MLAT ? x + (size_t)m * DM : ctx + (size_t)(m - MLAT) * DM; ss[r] = 0.f;
#pragma unroll
            for (int j = 0; j < 4; ++j) { v[r][j] = __builtin_nontemporal_load((const GAS f32x4*)(src + 4 * lane + 256 * j)); ss[r] += v[r][j].x * v[r][j].x + v[r][j].y * v[r][j].y + v[r][j].z * v[r][j].z + v[r][j].w * v[r][j].w; } }
#pragma unroll
        for (int r = 0; r < 2; ++r) { const int m = m0 + r; const GAS float* md = mod + (m < MLAT ? (m >> 13) : 8) * NMOD;
            const float rs = rsqrtf(wave_sum(ss[r]) * (1.f / DM) + EPS);
#pragma unroll
            for (int j = 0; j < 4; ++j) { const int k = 4 * lane + 256 * j;
                const f32x4 gg = *(const GAS f32x4*)(g + k), sh = *(const GAS f32x4*)(md + k), sc = *(const GAS f32x4*)(md + DM + k);
                const f32x4 y = v[r][j] * rs * gg * (sc + 1.f) + sh;
                u32x2 o; o.x = pk2(y.x, y.y); o.y = pk2(y.z, y.w); *(GAS u32x2*)(H + (size_t)m * DM + k) = o; } }
    }
}
__device__ __forceinline__ void ss_phase(const GAS bf16_t* __restrict__ P, GAS float* __restrict__ ssq, GAS float* __restrict__ sskv, int gw, int NGW, int lane) {
#pragma unroll 4
    for (int m = gw; m < MALL; m += NGW) {
        const u32x2 q = *(const GAS u32x2*)(P + (size_t)m * PW + 1024 + 4 * lane); const unsigned k = *(const GAS unsigned*)(P + (size_t)m * PW + 1280 + 2 * lane);
        float a = bflo(q.x) * bflo(q.x) + bfhi(q.x) * bfhi(q.x) + bflo(q.y) * bflo(q.y) + bfhi(q.y) * bfhi(q.y), c = bflo(k) * bflo(k) + bfhi(k) * bfhi(k);
        a = wave_sum(a); c = wave_sum(c);
        if (lane == 0) { ssq[m] = a; sskv[m] = c; }
    }
}
__device__ __forceinline__ void qpost_phase(const GAS bf16_t* __restrict__ QR, const GAS float* __restrict__ ssq, const GAS float* __restrict__ RT, GAS bf16_t* __restrict__ Q, int gtid, int NT) {
#pragma unroll 4
    for (int task = gtid; task < MLAT * 96; task += NT) {
        const int row = task / 96, c8 = task - row * 96, h = c8 / 12, dc = c8 - h * 12, b = row >> 13, s = row & 8191;
        const float sc = rsqrtf(ssq[row] * (1.f / 256.f) + EPS) * QSCALE;
        const u32x4 mine = *(const GAS u32x4*)(QR + (size_t)row * 768 + 8 * c8);
        float v[8];
#pragma unroll
        for (int j = 0; j < 4; ++j) { v[2 * j] = bflo(mine[j]) * sc; v[2 * j + 1] = bfhi(mine[j]) * sc; }
        if (dc >= 8) { const int fq = dc - 8; const u32x4 oth = *(const GAS u32x4*)(QR + (size_t)row * 768 + 8 * (c8 ^ 1));
            const GAS float* rt = RT + (fq < 2 ? (s >> 6) : (s & 63)) * 16;
#pragma unroll
            for (int j = 0; j < 8; ++j) { const float pt = ((j & 1) ? bfhi(oth[j >> 1]) : bflo(oth[j >> 1])) * sc, cs = rt[2 * j], sn = rt[2 * j + 1];
                v[j] = (fq & 1) ? v[j] * cs + pt * sn : v[j] * cs - pt * sn; } }
        u32x4 w; w.x = pk2(v[0], v[1]); w.y = pk2(v[2], v[3]); w.z = pk2(v[4], v[5]); w.w = pk2(v[6], v[7]);
        *(GAS u32x4*)(Q + ((size_t)((b * 8 + h) * SEQ + s)) * 96 + 8 * dc) = w;
    }
}
__device__ __forceinline__ void kvpost_phase(const GAS bf16_t* __restrict__ KVR, const GAS float* __restrict__ sskv, GAS bf16_t* __restrict__ Kb, GAS bf16_t* __restrict__ Vt, int gtid, int NT) {
#pragma unroll 4
    for (int task = gtid; task < MALL * 64; task += NT) {
        const int row = task >> 6, c = task & 63, h = c >> 3, dd = (c & 7) * 8; const bool lat = row < MLAT;
        const int b = lat ? (row >> 13) : ((row - MLAT) >> 8), pos = lat ? (CTX + (row & 8191)) : ((row - MLAT) & 255);
        const float rs = rsqrtf(sskv[row] * (1.f / 128.f) + EPS);
        const u32x4 mine = *(const GAS u32x4*)(KVR + (size_t)row * 1024 + h * 128 + dd);
        u32x4 w;
#pragma unroll
        for (int j = 0; j < 4; ++j) w[j] = pk2(bflo(mine[j]) * rs, bfhi(mine[j]) * rs);
        *(GAS u32x4*)(Kb + ((size_t)(b * 8 + h) * KVLEN + pos) * 96 + dd) = w;
    }
#pragma unroll 2
    for (int task = gtid; task < (MALL / 8) * 128; task += NT) {
        const int pg = task & 7, dq = (task >> 3) & 7, rest = task >> 6, hd32 = rest & 15, rb = rest >> 4, h = hd32 >> 1, d = (hd32 & 1) * 32 + 4 * dq, row0 = rb * 64 + pg * 8; const bool lat = row0 < MLAT;
        const int b = lat ? (row0 >> 13) : ((row0 - MLAT) >> 8), pos0 = lat ? (CTX + (row0 & 8191)) : ((row0 - MLAT) & 255);
        float v[4][8];
#pragma unroll
        for (int i = 0; i < 8; ++i) { const u32x2 w = *(const GAS u32x2*)(KVR + (size_t)(row0 + i) * 1024 + h * 128 + 64 + d); const float rs = rsqrtf(sskv[row0 + i] * (1.f / 128.f) + EPS);
            v[0][i] = bflo(w.x) * rs; v[1][i] = bfhi(w.x) * rs; v[2][i] = bflo(w.y) * rs; v[3][i] = bfhi(w.y) * rs; }
        GAS bf16_t* vp = Vt + ((size_t)((b * 8 + h) * 64 + d)) * KVLEN + pos0;
#pragma unroll
        for (int j = 0; j < 4; ++j) { u32x4 w; w.x = pk2(v[j][0], v[j][1]); w.y = pk2(v[j][2], v[j][3]); w.z = pk2(v[j][4], v[j][5]); w.w = pk2(v[j][6], v[j][7]);
            *(GAS u32x4*)(vp + (size_t)j * KVLEN) = w; }
    }
}
__device__ __forceinline__ void krope_phase(const GAS bf16_t* __restrict__ P, GAS bf16_t* __restrict__ Kb, const GAS float* __restrict__ RT, int gtid, int NT) {
#pragma unroll 2
    for (int task = gtid; task < MALL * 4; task += NT) {
        const int row = task >> 2, fq = task & 3; const bool lat = row < MLAT;
        const int b = lat ? (row >> 13) : ((row - MLAT) >> 8), s = row & 8191, pos = lat ? (CTX + s) : ((row - MLAT) & 255);
        const u32x4 mine = *(const GAS u32x4*)(P + (size_t)row * PW + 1408 + 8 * fq), oth = *(const GAS u32x4*)(P + (size_t)row * PW + 1408 + 8 * (fq ^ 1));
        float v[8], pt[8];
#pragma unroll
        for (int j = 0; j < 4; ++j) { v[2 * j] = bflo(mine[j]); v[2 * j + 1] = bfhi(mine[j]); pt[2 * j] = bflo(oth[j]); pt[2 * j + 1] = bfhi(oth[j]); }
        if (lat) { const GAS float* rt = RT + (fq < 2 ? (s >> 6) : (s & 63)) * 16;
#pragma unroll
            for (int j = 0; j < 8; ++j) { const float cs = rt[2 * j], sn = rt[2 * j + 1]; v[j] = (fq & 1) ? v[j] * cs + pt[j] * sn : v[j] * cs - pt[j] * sn; } }
        u32x4 w; w.x = pk2(v[0], v[1]); w.y = pk2(v[2], v[3]); w.z = pk2(v[4], v[5]); w.w = pk2(v[6], v[7]);
#pragma unroll
        for (int h = 0; h < 8; ++h) *(GAS u32x4*)(Kb + ((size_t)(b * 8 + h) * KVLEN + pos) * 96 + 64 + 8 * fq) = w;
    }
}
#define MFMA32(a, b, c) __builtin_amdgcn_mfma_f32_32x32x16_bf16((a), (b), (c), 0, 0, 0)
__device__ __forceinline__ void gates_phase(const GAS float* __restrict__ cw, const GAS float* __restrict__ cb, const GAS float* __restrict__ b_a, const GAS float* __restrict__ b_x, const GAS float* __restrict__ lam, LAS unsigned char* lds, const GAS bf16_t* __restrict__ P, const GAS bf16_t* __restrict__ Wg, GAS unsigned* __restrict__ LU, GAS f32x2* __restrict__ AGG, int tid, int wave, int lane) {
    LAS bf16_t* xs = (LAS bf16_t*)(lds + wave * 4608);
    LAS f32x2* wagg = (LAS f32x2*)(lds + 8 * 4608);
    const int r32 = lane & 31, hi = lane >> 5;
    for (int unit = blockIdx.x; unit < (MALL / 256) * 8; unit += gridDim.x) {
        const int pm = unit >> 3, h = unit & 7, m0 = pm * 256 + wave * 32;
        const int s0 = m0 < MLAT ? (m0 & ~8191) : (MLAT + ((m0 - MLAT) & ~255)), slen = m0 < MLAT ? SEQ : CTX;
        {
            const int tok = lane >> 1, m = m0 + tok;
#pragma unroll
            for (int c8 = 0; c8 < 4; ++c8) { const int ch = (lane & 1) * 32 + c8 * 8, gch = h * 64 + ch;
                float acc[8];
                { const f32x4 b0 = *(const GAS f32x4*)(cb + gch), b1 = *(const GAS f32x4*)(cb + gch + 4);
                  acc[0] = b0.x; acc[1] = b0.y; acc[2] = b0.z; acc[3] = b0.w; acc[4] = b1.x; acc[5] = b1.y; acc[6] = b1.z; acc[7] = b1.w; }
#pragma unroll
                for (int k = 0; k < 4; ++k) { const int mm = m + k - 2;
                    if (mm >= s0 && mm < s0 + slen) { const u32x4 xv = *(const GAS u32x4*)(P + (size_t)mm * PW + gch);
                        const f32x4 w0 = *(const GAS f32x4*)(cw + k * 512 + gch), w1 = *(const GAS f32x4*)(cw + k * 512 + gch + 4);
                        acc[0] += w0.x * bflo(xv.x); acc[1] += w0.y * bfhi(xv.x); acc[2] += w0.z * bflo(xv.y); acc[3] += w0.w * bfhi(xv.y);
                        acc[4] += w1.x * bflo(xv.z); acc[5] += w1.y * bfhi(xv.z); acc[6] += w1.z * bflo(xv.w); acc[7] += w1.w * bfhi(xv.w); } }
                u32x4 o; o.x = pk2(acc[0], acc[1]); o.y = pk2(acc[2], acc[3]); o.z = pk2(acc[4], acc[5]); o.w = pk2(acc[6], acc[7]);
                *(LAS u32x4*)(xs + tok * 72 + ch) = o; }
        }
        LDS_WAIT();
        bf16x8 afr[4];
#pragma unroll
        for (int ks = 0; ks < 4; ++ks) afr[ks] = *(const LAS bf16x8*)(xs + r32 * 72 + 16 * ks + 8 * hi);
#pragma unroll
        for (int jh = 0; jh < 2; ++jh) {
            f32x16 acc4[4];
#pragma unroll
            for (int q = 0; q < 4; ++q) {
#pragma unroll
                for (int i = 0; i < 16; ++i) acc4[q][i] = 0.f;
                const GAS bf16_t* wrow = Wg + (size_t)(h * 256 + (2 * q + jh) * 32 + r32) * 64 + 8 * hi;
#pragma unroll
                for (int ks = 0; ks < 4; ++ks) { const bf16x8 bfr = *(const GAS bf16x8*)(wrow + 16 * ks); acc4[q] = MFMA32(afr[ks], bfr, acc4[q]); }
            }
            const int ch = jh * 32 + r32, gch = h * 64 + ch;
            float ba[2], bx[2], sp[2];
#pragma unroll
            for (int d = 0; d < 2; ++d) { ba[d] = b_a[d * 512 + gch]; bx[d] = b_x[d * 512 + gch]; sp[d] = lam[d * 512 + gch]; }
            unsigned wv[16][2]; float avs[16][2];
#pragma unroll
            for (int i = 0; i < 16; ++i) { const int row = crow(i, hi); const float xv = bf2f(xs[row * 72 + ch]);
#pragma unroll
                for (int d = 0; d < 2; ++d) { const float r = sigmoidf_(acc4[2 * d][i] + ba[d]), ig = sigmoidf_(acc4[2 * d + 1][i] + bx[d]);
                    const float la2 = bflo(f2bf(-r * sp[d])), av = __builtin_amdgcn_exp2f(la2); avs[i][d] = av;
                    const float uu = __builtin_amdgcn_sqrtf(fmaxf(1.f - av * av, 0.f)) * (ig * xv);
                    wv[i][d] = pk2(la2, uu);
                    LU[((size_t)(m0 + row) * 2 + d) * 512 + gch] = wv[i][d]; } }
#pragma unroll
            for (int d = 0; d < 2; ++d) {
                float Ar[4], Ur[4];
#pragma unroll
                for (int g = 0; g < 4; ++g) { float A = 1.f, U = 0.f;
#pragma unroll
                    for (int jj = 0; jj < 4; ++jj) { const int j = d ? 3 - jj : jj; const unsigned w = wv[4 * g + j][d]; const float av = avs[4 * g + j][d]; A *= av; U = av * U + bfhi(w); }
                    Ar[g] = A; Ur[g] = U; }
                float A = 1.f, U = 0.f;
#pragma unroll
                for (int gg = 0; gg < 4; ++gg) { const int g = d ? 3 - gg : gg;
                    const float Ao = __shfl_xor(Ar[g], 32), Uo = __shfl_xor(Ur[g], 32);
                    if (d == 0) { U = Ar[g] * U + Ur[g]; A *= Ar[g]; U = Ao * U + Uo; A *= Ao; }
                    else        { U = Ao * U + Uo; A *= Ao; U = Ar[g] * U + Ur[g]; A *= Ar[g]; } }
                if (hi == 0) wagg[(wave * 2 + d) * 64 + ch] = (f32x2){A, U};
            }
        }
        LDS_WAIT();
        __syncthreads();
        if (tid < 128) {
            const int d = tid >> 6, ch = tid & 63; float A = 1.f, U = 0.f;
#pragma unroll
            for (int ww = 0; ww < 8; ++ww) { const int w = d ? 7 - ww : ww; const f32x2 g = wagg[(w * 2 + d) * 64 + ch]; U = g.x * U + g.y; A *= g.x; }
            const int b = pm < MLAT / 256 ? (pm >> 5) : (pm - MLAT / 256), c = pm < MLAT / 256 ? (pm & 31) : NCH;
            AGG[(size_t)((b * 2 + d) * (NCH + 1) + c) * 512 + h * 64 + ch] = (f32x2){A, U};
        }
        __syncthreads();
    }
}
__device__ __forceinline__ void scan_agg(const GAS unsigned* __restrict__ LU, GAS f32x2* __restrict__ AGG, int gw, int NGW, int lane) {
    for (int task = gw; task < NB * 2 * (NCH + 1) * 8; task += NGW) {
        const int cgp = task & 7, c = (task >> 3) % (NCH + 1), d = (task / (8 * (NCH + 1))) & 1, b = task / (16 * (NCH + 1));
        const int ch = cgp * 64 + lane, row0 = c < NCH ? b * SEQ + c * CHL : MLAT + b * CTX;
        float A = 1.f, U = 0.f;
#pragma unroll 16
        for (int t = 0; t < CHL; ++t) { const int tt = d ? CHL - 1 - t : t; const unsigned w = LU[((size_t)(row0 + tt) * 2 + d) * 512 + ch];
            const float av = __builtin_amdgcn_exp2f(bflo(w)); A *= av; U = av * U + bfhi(w); }
        AGG[(size_t)((b * 2 + d) * (NCH + 1) + c) * 512 + ch] = (f32x2){A, U};
    }
}
__device__ __forceinline__ float gelu_tanh(float x) { const float z = 0.7978845608028654f * (x + 0.044715f * x * x * x);
    return x * __builtin_amdgcn_rcpf(1.f + __builtin_amdgcn_exp2f(-2.8853900817779268f * z)); }
__device__ __forceinline__ void scan_final(const GAS unsigned* __restrict__ LU, const GAS f32x2* __restrict__ AGG, const GAS bf16_t* __restrict__ P, GAS bf16_t* __restrict__ A2, int gw, int NGW, int lane) {
    constexpr int BT = 16;
    for (int task = gw; task < NB * NCH * 8; task += NGW) {
        const int cgp = task & 7, c = (task >> 3) & (NCH - 1), b = task / (8 * NCH), ch = cgp * 64 + lane, row0 = b * SEQ + c * CHL;
        const GAS f32x2* ag0 = AGG + (size_t)((b * 2 + 0) * (NCH + 1)) * 512 + ch; const GAS f32x2* ag1 = AGG + (size_t)((b * 2 + 1) * (NCH + 1)) * 512 + ch;
        unsigned w[BT], wn[BT];
#pragma unroll
        for (int i = 0; i < BT; ++i) w[i] = LU[((size_t)(row0 + i) * 2 + 0) * 512 + ch];
        float hf = ag0[(size_t)NCH * 512].y;
        for (int cc = 0; cc < c; ++cc) { const f32x2 g = ag0[(size_t)cc * 512]; hf = g.x * hf + g.y; }
        float hb = ag1[(size_t)NCH * 512].y;
        for (int cc = NCH - 1; cc > c; --cc) { const f32x2 g = ag1[(size_t)cc * 512]; hb = g.x * hb + g.y; }
#pragma unroll 1
        for (int t0 = 0; t0 < CHL; t0 += BT) {
            if (t0 + BT < CHL) {
#pragma unroll
                for (int i = 0; i < BT; ++i) wn[i] = LU[((size_t)(row0 + t0 + BT + i) * 2 + 0) * 512 + ch]; }
#pragma unroll
            for (int i = 0; i < BT; ++i) { hf = __builtin_amdgcn_exp2f(bflo(w[i])) * hf + bfhi(w[i]); A2[(size_t)(row0 + t0 + i) * DM + ch] = (bf16_t)f2bf(hf); }
#pragma unroll
            for (int i = 0; i < BT; ++i) w[i] = wn[i]; }
        bf16_t gr[BT], grn[BT];
#pragma unroll
        for (int i = 0; i < BT; ++i) { w[i] = LU[((size_t)(row0 + CHL - BT + i) * 2 + 1) * 512 + ch]; gr[i] = P[(size_t)(row0 + CHL - BT + i) * PW + 512 + ch]; }
#pragma unroll 1
        for (int t0 = CHL - BT; t0 >= 0; t0 -= BT) { bf16_t f[BT];
#pragma unroll
            for (int i = 0; i < BT; ++i) f[i] = A2[(size_t)(row0 + t0 + i) * DM + ch];
            if (t0 >= BT) {
#pragma unroll
                for (int i = 0; i < BT; ++i) { wn[i] = LU[((size_t)(row0 + t0 - BT + i) * 2 + 1) * 512 + ch]; grn[i] = P[(size_t)(row0 + t0 - BT + i) * PW + 512 + ch]; } }
#pragma unroll
            for (int i = BT - 1; i >= 0; --i) { hb = __builtin_amdgcn_exp2f(bflo(w[i])) * hb + bfhi(w[i]);
                A2[(size_t)(row0 + t0 + i) * DM + ch] = (bf16_t)f2bf((bf2f(f[i]) + hb) * gelu_tanh(bf2f(gr[i]))); }
#pragma unroll
            for (int i = 0; i < BT; ++i) { w[i] = wn[i]; gr[i] = grn[i]; } }
    }
}
constexpr int AT_KROW = 208, AT_VROW = 144;
constexpr float AT_THR = 8.f;
#define AT_LMAX(P, MX) do { MX = fmaxf(fmaxf(P[0], P[1]), fmaxf(P[2], P[3])); \
        _Pragma("unroll") for (int i_ = 4; i_ < 16; i_ += 4) MX = fmaxf(fmaxf(MX, P[i_]), fmaxf(fmaxf(P[i_ + 1], P[i_ + 2]), P[i_ + 3])); } while (0)
#define AT_SOFTMAX(P, MX, M, L, O0, O1, PW0, PW1) do { \
        if (__any(MX > M + AT_THR)) { const float mn_ = fmaxf(M, MX), al_ = __builtin_amdgcn_exp2f(M - mn_); M = mn_; L *= al_; \
            _Pragma("unroll") for (int i_ = 0; i_ < 16; ++i_) { O0[i_] *= al_; O1[i_] *= al_; } } \
        float s_ = 0.f; \
        _Pragma("unroll") for (int i_ = 0; i_ < 16; ++i_) { P[i_] = __builtin_amdgcn_exp2f(P[i_] - M); s_ += P[i_]; } \
        L += s_; \
        _Pragma("unroll") for (int j_ = 0; j_ < 4; ++j_) { PW0[j_] = cvtpk(P[2 * j_], P[2 * j_ + 1]); PW1[j_] = cvtpk(P[8 + 2 * j_], P[9 + 2 * j_]); } } while (0)
__device__ __forceinline__ void glds16(const GAS void* gsrc, unsigned lds_dst) {
    unsigned keep;
    asm volatile("s_mov_b32 %0, m0\n\ts_mov_b32 m0, %2\n\ts_nop 0\n\tglobal_load_lds_dwordx4 %1, off\n\ts_mov_b32 m0, %0" : "=&s"(keep) : "v"(gsrc), "s"(lds_dst) : "memory");
}
constexpr int AT_SLOT = 22 * 1024, AT_VOFF = 13 * 1024, AT_NP = 22;
__device__ __forceinline__ void attn_unit(LAS unsigned char* lds, const GAS bf16_t* __restrict__ QR, const GAS float* __restrict__ ssq, const GAS float* __restrict__ RT, const GAS bf16_t* __restrict__ K, const GAS bf16_t* __restrict__ Vt, GAS bf16_t* __restrict__ A2, int b, int h, int qb, int tid, int wave, int lane) {
    const int r32 = lane & 31, hi = lane >> 5, q0 = qb * 512 + wave * 64, r32s = (r32 & ~12) | ((r32 & 4) << 1) | ((r32 & 8) >> 1);
    bf16x8 qa[6], qc[6];
#pragma unroll
    for (int sub = 0; sub < 2; ++sub) {
        const int s = q0 + 32 * sub + r32, row = b * SEQ + s;
        const GAS bf16_t* Qp = QR + (size_t)row * 768 + h * 96 + 8 * hi;
        const float sc = rsqrtf(ssq[row] * (1.f / 256.f) + EPS) * QSCALE;
#pragma unroll
        for (int d0 = 0; d0 < 6; ++d0) {
            const u32x4 raw = *(const GAS u32x4*)(Qp + 16 * d0);
            float v[8];
#pragma unroll
            for (int j = 0; j < 4; ++j) { v[2 * j] = bflo(raw[j]) * sc; v[2 * j + 1] = bfhi(raw[j]) * sc; }
            if (d0 >= 4) { const GAS float* rt = RT + (d0 == 4 ? (s >> 6) : (s & 63)) * 16;
#pragma unroll
                for (int j = 0; j < 8; ++j) { const float pt = __shfl_xor(v[j], 32), cs = rt[2 * j], sn = rt[2 * j + 1]; v[j] = hi ? v[j] * cs + pt * sn : v[j] * cs - pt * sn; } }
            u32x4 w; w.x = pk2(v[0], v[1]); w.y = pk2(v[2], v[3]); w.z = pk2(v[4], v[5]); w.w = pk2(v[6], v[7]);
            if (sub == 0) qa[d0] = __builtin_bit_cast(bf16x8, w); else qc[d0] = __builtin_bit_cast(bf16x8, w);
        }
    }
    const GAS unsigned char* Kg = (const GAS unsigned char*)(K + (size_t)(b * 8 + h) * KVLEN * 96);
    const GAS unsigned char* Vg = (const GAS unsigned char*)(Vt + (size_t)(b * 8 + h) * 64 * KVLEN);
    const unsigned ldsb = (unsigned)(size_t)lds;
    const GAS unsigned char* src[3]; int stride[3]; unsigned dsto[3];
#pragma unroll
    for (int k = 0; k < 3; ++k) { int j = wave + 8 * k; if (j >= AT_NP) j -= 8; const int id = j * 64 + lane;
        if (j < 13) { const int row = id / 13; int col = id - row * 13; if (col == 12) col = 0; src[k] = Kg + row * 192 + col * 16; stride[k] = 12288; }
        else { const int idv = id - 832, d = idv / 9; int c = idv - d * 9; if (c == 8) c = 0; src[k] = Vg + ((size_t)d * KVLEN + c * 8) * 2; stride[k] = 128; }
        dsto[k] = ldsb + j * 1024; }
#define AT_ISSUE(t, slot) do { _Pragma("unroll") for (int k_ = 0; k_ < 3; ++k_) glds16(src[k_] + (size_t)(t) * stride[k_], (unsigned)__builtin_amdgcn_readfirstlane(dsto[k_] + (slot) * AT_SLOT)); } while (0)
    f32x16 oA0, oA1, oB0, oB1;
#pragma unroll
    for (int i = 0; i < 16; ++i) { oA0[i] = 0.f; oA1[i] = 0.f; oB0[i] = 0.f; oB1[i] = 0.f; }
    float mA = -1e30f, mB = -1e30f, lA = 0.f, lB = 0.f;
    constexpr int NT_ = KVLEN / 64;
    AT_ISSUE(0, 0); AT_ISSUE(1, 1);
    int slot = 0, nslot = 2;
#pragma unroll 1
    for (int t = 0; t < NT_; ++t) {
        if (t + 1 < NT_) asm volatile("s_waitcnt vmcnt(3) lgkmcnt(0)\n\ts_barrier" ::: "memory"); else asm volatile("s_waitcnt vmcnt(0) lgkmcnt(0)\n\ts_barrier" ::: "memory");
        if (t + 2 < NT_) AT_ISSUE(t + 2, nslot);
        const LAS unsigned char* sb = lds + slot * AT_SLOT;
#pragma unroll
        for (int hh = 0; hh < 2; ++hh) {
            const LAS unsigned char* kb = sb + (32 * hh + r32s) * AT_KROW + hi * 16;
            f32x16 pA, pB;
#pragma unroll
            for (int i = 0; i < 16; ++i) { pA[i] = 0.f; pB[i] = 0.f; }
#pragma unroll
            for (int d0 = 0; d0 < 6; ++d0) { const bf16x8 a0 = *(const LAS bf16x8*)(kb + d0 * 32); pA = MFMA32(a0, qa[d0], pA); pB = MFMA32(a0, qc[d0], pB); }
            u32x4 pwA0, pwA1, pwB0, pwB1;
            float mxA, mxB; AT_LMAX(pA, mxA); AT_LMAX(pB, mxB);
            { const float oa = __shfl_xor(mxA, 32), ob = __shfl_xor(mxB, 32); mxA = fmaxf(mxA, oa); mxB = fmaxf(mxB, ob); }
            AT_SOFTMAX(pA, mxA, mA, lA, oA0, oA1, pwA0, pwA1);
            AT_SOFTMAX(pB, mxB, mB, lB, oB0, oB1, pwB0, pwB1);
            const LAS unsigned char* vb = sb + AT_VOFF + r32 * AT_VROW + hi * 16 + hh * 64;
#pragma unroll
            for (int ks = 0; ks < 2; ++ks) {
                const bf16x8 va0 = *(const LAS bf16x8*)(vb + ks * 32), va1 = *(const LAS bf16x8*)(vb + 32 * AT_VROW + ks * 32);
                const bf16x8 pa = __builtin_bit_cast(bf16x8, ks ? pwA1 : pwA0), pb = __builtin_bit_cast(bf16x8, ks ? pwB1 : pwB0);
                oA0 = MFMA32(va0, pa, oA0); oA1 = MFMA32(va1, pa, oA1); oB0 = MFMA32(va0, pb, oB0); oB1 = MFMA32(va1, pb, oB1);
            }
        }
        slot = slot == 2 ? 0 : slot + 1; nslot = nslot == 2 ? 0 : nslot + 1;
    }
    asm volatile("s_waitcnt lgkmcnt(0)\n\ts_barrier" ::: "memory");
    {   const float inv = 1.f / (lA + __shfl_xor(lA, 32));
        GAS bf16_t* op = A2 + (size_t)(b * SEQ + q0 + r32) * DM + 512 + h * 64 + 4 * hi;
#pragma unroll
        for (int g = 0; g < 4; ++g) { u32x2 w0, w1; w0.x = pk2(oA0[4 * g] * inv, oA0[4 * g + 1] * inv); w0.y = pk2(oA0[4 * g + 2] * inv, oA0[4 * g + 3] * inv);
            w1.x = pk2(oA1[4 * g] * inv, oA1[4 * g + 1] * inv); w1.y = pk2(oA1[4 * g + 2] * inv, oA1[4 * g + 3] * inv);
            *(GAS u32x2*)(op + 8 * g) = w0; *(GAS u32x2*)(op + 32 + 8 * g) = w1; } }
    {   const float inv = 1.f / (lB + __shfl_xor(lB, 32));
        GAS bf16_t* op = A2 + (size_t)(b * SEQ + q0 + 32 + r32) * DM + 512 + h * 64 + 4 * hi;
#pragma unroll
        for (int g = 0; g < 4; ++g) { u32x2 w0, w1; w0.x = pk2(oB0[4 * g] * inv, oB0[4 * g + 1] * inv); w0.y = pk2(oB0[4 * g + 2] * inv, oB0[4 * g + 3] * inv);
            w1.x = pk2(oB1[4 * g] * inv, oB1[4 * g + 1] * inv); w1.y = pk2(oB1[4 * g + 2] * inv, oB1[4 * g + 3] * inv);
            *(GAS u32x2*)(op + 8 * g) = w0; *(GAS u32x2*)(op + 32 + 8 * g) = w1; } }
#undef AT_ISSUE
}
__device__ __forceinline__ void p7_rows(const GAS float* __restrict__ x, const GAS float* __restrict__ g_post, const GAS float* __restrict__ g_pre, GAS bf16_t* __restrict__ X1b, const GAS float* __restrict__ mod, const GAS bf16_t* __restrict__ Y, GAS bf16_t* __restrict__ H2, int gw, int NGW, int lane) {
    for (int m0 = 2 * gw; m0 < MLAT; m0 += 2 * NGW) {
        const GAS float* md = mod + (m0 >> 13) * NMOD;
        f32x4 y[2][4], xv[2][4]; float ss[2];
#pragma unroll
        for (int r = 0; r < 2; ++r) { ss[r] = 0.f;
#pragma unroll
            for (int j = 0; j < 4; ++j) { const u32x2 w = __builtin_nontemporal_load((const GAS u32x2*)(Y + (size_t)(m0 + r) * DM + 4 * lane + 256 * j)); xv[r][j] = __builtin_nontemporal_load((const GAS f32x4*)(x + (size_t)(m0 + r) * DM + 4 * lane + 256 * j));
                y[r][j] = (f32x4){bflo(w.x), bfhi(w.x), bflo(w.y), bfhi(w.y)}; ss[r] += y[r][j].x * y[r][j].x + y[r][j].y * y[r][j].y + y[r][j].z * y[r][j].z + y[r][j].w * y[r][j].w; } }
#pragma unroll
        for (int r = 0; r < 2; ++r) { const int m = m0 + r;
            const float rs = rsqrtf(wave_sum(ss[r]) * (1.f / DM) + EPS); float s2 = 0.f;
#pragma unroll
            for (int j = 0; j < 4; ++j) { const int k = 4 * lane + 256 * j;
                const f32x4 gg = *(const GAS f32x4*)(g_post + k), gt = *(const GAS f32x4*)(md + 2 * DM + k);
                xv[r][j] = xv[r][j] + gt * (y[r][j] * rs * gg); { u32x2 o1; o1.x = pk2(xv[r][j].x, xv[r][j].y); o1.y = pk2(xv[r][j].z, xv[r][j].w); *(GAS u32x2*)(X1b + (size_t)m * DM + k) = o1; }
                s2 += xv[r][j].x * xv[r][j].x + xv[r][j].y * xv[r][j].y + xv[r][j].z * xv[r][j].z + xv[r][j].w * xv[r][j].w; }
            const float rs2 = rsqrtf(wave_sum(s2) * (1.f / DM) + EPS);
#pragma unroll
            for (int j = 0; j < 4; ++j) { const int k = 4 * lane + 256 * j;
                const f32x4 gg = *(const GAS f32x4*)(g_pre + k), sh = *(const GAS f32x4*)(md + 3 * DM + k), sc = *(const GAS f32x4*)(md + 4 * DM + k);
                const f32x4 hh = xv[r][j] * rs2 * gg * (sc + 1.f) + sh;
                u32x2 o; o.x = pk2(hh.x, hh.y); o.y = pk2(hh.z, hh.w); *(GAS u32x2*)(H2 + (size_t)m * DM + k) = o; } }
    }
}
__device__ __forceinline__ void p11_rows(const GAS float* __restrict__ g_post, GAS float* __restrict__ out, const GAS bf16_t* __restrict__ X1b, const GAS float* __restrict__ mod, const GAS bf16_t* __restrict__ Fb, int gw, int NGW, int lane) {
    for (int m0 = 2 * gw; m0 < MLAT; m0 += 2 * NGW) {
        const GAS float* md = mod + (m0 >> 13) * NMOD;
        f32x4 y[2][4], xv[2][4]; float ss[2];
#pragma unroll
        for (int r = 0; r < 2; ++r) { ss[r] = 0.f;
#pragma unroll
            for (int j = 0; j < 4; ++j) { const u32x2 w = __builtin_nontemporal_load((const GAS u32x2*)(Fb + (size_t)(m0 + r) * DM + 4 * lane + 256 * j)); { const u32x2 w1 = __builtin_nontemporal_load((const GAS u32x2*)(X1b + (size_t)(m0 + r) * DM + 4 * lane + 256 * j)); xv[r][j] = (f32x4){bflo(w1.x), bfhi(w1.x), bflo(w1.y), bfhi(w1.y)}; }
                y[r][j] = (f32x4){bflo(w.x), bfhi(w.x), bflo(w.y), bfhi(w.y)}; ss[r] += y[r][j].x * y[r][j].x + y[r][j].y * y[r][j].y + y[r][j].z * y[r][j].z + y[r][j].w * y[r][j].w; } }
#pragma unroll
        for (int r = 0; r < 2; ++r) { const float rs = rsqrtf(wave_sum(ss[r]) * (1.f / DM) + EPS);
#pragma unroll
            for (int j = 0; j < 4; ++j) { const int k = 4 * lane + 256 * j;
                const f32x4 gg = *(const GAS f32x4*)(g_post + k), gt = *(const GAS f32x4*)(md + 5 * DM + k);
                __builtin_nontemporal_store(xv[r][j] + gt * (y[r][j] * rs * gg), (GAS f32x4*)(out + (size_t)(m0 + r) * DM + k)); } }
    }
}
__device__ __forceinline__ void convgate_phase(const GAS float* __restrict__ cw, const GAS float* __restrict__ cb, const GAS bf16_t* __restrict__ UP, GAS bf16_t* __restrict__ G, int half, int gtid, int NT) {
    constexpr int JG = DFF / 8, RG = 32, NTASK = (MLAT / 2 / RG) * JG;
    for (int task = gtid; task < NTASK; task += NT) {
        const int jg = task % JG, rg = task / JG, j0 = jg * 8, r0 = rg * RG, m0 = half * (MLAT / 2) + r0;
        float wu[3][8], wg[3][8], bu[8], bg[8];
#pragma unroll
        for (int k = 0; k < 3; ++k)
#pragma unroll
            for (int i = 0; i < 8; ++i) { wu[k][i] = cw[k * 2 * DFF + j0 + i]; wg[k][i] = cw[k * 2 * DFF + DFF + j0 + i]; }
#pragma unroll
        for (int i = 0; i < 8; ++i) { bu[i] = cb[j0 + i]; bg[i] = cb[DFF + j0 + i]; }
        const GAS bf16_t* up = UP + (size_t)r0 * (2 * DFF) + j0;
        u32x4 pu = {0u, 0u, 0u, 0u}, pg = {0u, 0u, 0u, 0u}, cu, cg_, nu, ng;
        if ((m0 & 8191) != 0) { pu = __builtin_nontemporal_load((const GAS u32x4*)(up - 2 * DFF)); pg = __builtin_nontemporal_load((const GAS u32x4*)(up - 2 * DFF + DFF)); }
        cu = __builtin_nontemporal_load((const GAS u32x4*)(up)); cg_ = __builtin_nontemporal_load((const GAS u32x4*)(up + DFF));
#pragma unroll 8
        for (int r = 0; r < RG; ++r) {
            const bool nv = (r + 1 < RG) || (((m0 + RG) & 8191) != 0);
            if (nv) { nu = __builtin_nontemporal_load((const GAS u32x4*)(up + (size_t)(r + 1) * (2 * DFF))); ng = __builtin_nontemporal_load((const GAS u32x4*)(up + (size_t)(r + 1) * (2 * DFF) + DFF)); } else { nu = (u32x4){0u, 0u, 0u, 0u}; ng = nu; }
            float o[8];
#pragma unroll
            for (int i = 0; i < 8; ++i) { const int w_ = i >> 1;
                const float p_u = (i & 1) ? bfhi(pu[w_]) : bflo(pu[w_]), c_u = (i & 1) ? bfhi(cu[w_]) : bflo(cu[w_]), n_u = (i & 1) ? bfhi(nu[w_]) : bflo(nu[w_]);
                const float p_g = (i & 1) ? bfhi(pg[w_]) : bflo(pg[w_]), c_g = (i & 1) ? bfhi(cg_[w_]) : bflo(cg_[w_]), n_g = (i & 1) ? bfhi(ng[w_]) : bflo(ng[w_]);
                const float uv = bu[i] + wu[0][i] * p_u + wu[1][i] * c_u + wu[2][i] * n_u, gv = bg[i] + wg[0][i] * p_g + wg[1][i] * c_g + wg[2][i] * n_g;
                o[i] = gv * __builtin_amdgcn_rcpf(1.f + __builtin_amdgcn_exp2f(-1.4426950408889634f * gv)) * uv; }
            u32x4 w; w.x = pk2(o[0], o[1]); w.y = pk2(o[2], o[3]); w.z = pk2(o[4], o[5]); w.w = pk2(o[6], o[7]);
            *(GAS u32x4*)(G + (size_t)(r0 + r) * DFF + j0) = w;
            pu = cu; pg = cg_; cu = nu; cg_ = ng;
        }
    }
}
constexpr int NPH = 17;
__global__ void __launch_bounds__(512, 2) fwd_kernel(Args a) {
    extern __shared__ __attribute__((aligned(16))) unsigned char lds_raw[];
    LAS unsigned char* lds = (LAS unsigned char*)lds_raw;
    const int lo = a.ph_lo, hi_ = a.ph_hi;
    {
        volatile LAS unsigned* st0 = (volatile LAS unsigned*)(lds + LDS_MISC);
        if (threadIdx.x < 2) st0[threadIdx.x] = 0u;
        __syncthreads();
        (void)xcd_barrier_post((unsigned*)(a.ws + WS_BAR), st0);
    }
#if MK_COOP
    cg::grid_group grid = cg::this_grid();
#endif
    typedef pg8::EpiBf16<0> EpiB;
    constexpr int MH = MLAT / 2;
#ifndef REPMASK
#define REPMASK 0
#endif
    bool repeated = false;
#pragma unroll 1
    for (int ph = lo; ph < hi_; ++ph) {
        int tid = threadIdx.x; asm volatile("" : "+v"(tid));
        int G = gridDim.x, bx = blockIdx.x; asm volatile("" : "+s"(G), "+s"(bx));
        const int lane = tid & 63, wave = __builtin_amdgcn_readfirstlane(tid >> 6);
        const int vcu = (G % 8 == 0) ? (bx % 8) * (G / 8) + bx / 8 : bx;
        const int gw = vcu * 8 + wave, NGW = G * 8, gtid = bx * 512 + tid, NTH = G * 512;
        unsigned char* ws_ = a.ws; asm volatile("" : "+s"(ws_)); GAS unsigned char* ws = (GAS unsigned char*)ws_;
        GAS float* mod = (GAS float*)(ws + WS_MOD); GAS float* ssq = (GAS float*)(ws + WS_SSQ); GAS float* sskv = (GAS float*)(ws + WS_SSKV);
        GAS bf16_t* Win = (GAS bf16_t*)(ws + WS_WIN); GAS bf16_t* Wq = (GAS bf16_t*)(ws + WS_WQ); GAS bf16_t* Wkv = (GAS bf16_t*)(ws + WS_WKV); GAS bf16_t* Wg = (GAS bf16_t*)(ws + WS_WG);
        GAS bf16_t* Wout = (GAS bf16_t*)(ws + WS_WOUT); GAS bf16_t* Wup = (GAS bf16_t*)(ws + WS_WUP); GAS bf16_t* Wdn = (GAS bf16_t*)(ws + WS_WDN);
        GAS f32x2* AGG = (GAS f32x2*)(ws + WS_AGG); GAS float* RT = (GAS float*)(ws + WS_ROPE);
        GAS bf16_t* H = (GAS bf16_t*)(ws + WS_R1); GAS bf16_t* KVR = H; GAS bf16_t* H2 = H; GAS bf16_t* QR = (GAS bf16_t*)(ws + WS_Q);
        GAS bf16_t* P = (GAS bf16_t*)(ws + WS_R2); GAS bf16_t* Y = P; GAS bf16_t* Fb = P;
        GAS unsigned* LU = (GAS unsigned*)(ws + WS_LU); GAS bf16_t* Kb = (GAS bf16_t*)(ws + WS_K); GAS bf16_t* Vb = (GAS bf16_t*)(ws + WS_V); GAS bf16_t* A2 = (GAS bf16_t*)(ws + WS_A2);
        GAS bf16_t* UP = (GAS bf16_t*)(ws + WS_UP); GAS bf16_t* Gb = (GAS bf16_t*)(ws + WS_G);
        float* outp_ = a.out; asm volatile("" : "+s"(outp_)); GAS float* outp = (GAS float*)outp_;
        pg8::Gemm g{nullptr, nullptr, 0, 0, 0, 0, 0}; GAS bf16_t* O = nullptr; int ldc = 0;
        switch (ph) {
            case 2:  g = pg8::Gemm{(const bf16_t*)(H), (const bf16_t*)(Win), MALL, PW, DM, DM, DM}; O = P; ldc = PW; break;
            case 4:  g = pg8::Gemm{(const bf16_t*)(P + 1024), (const bf16_t*)(Wq), MLAT, 768, 256, PW, 256}; O = QR; ldc = 768; break;
            case 5:  g = pg8::Gemm{(const bf16_t*)(P + 1280), (const bf16_t*)(Wkv), MALL, 1024, 256, PW, 256}; O = KVR; ldc = 1024; break;
            case 8:  g = pg8::Gemm{(const bf16_t*)(A2), (const bf16_t*)(Wout), MLAT, DM, DM, DM, DM}; O = Y; ldc = DM; break;
            case 10: g = pg8::Gemm{(const bf16_t*)(H2), (const bf16_t*)(Wup), MH, 2 * DFF, DM, DM, DM}; O = UP; ldc = 2 * DFF; break;
            case 13: g = pg8::Gemm{(const bf16_t*)(H2 + (size_t)MH * DM), (const bf16_t*)(Wup), MH, 2 * DFF, DM, DM, DM}; O = UP; ldc = 2 * DFF; break;
            case 12: g = pg8::Gemm{(const bf16_t*)(Gb), (const bf16_t*)(Wdn), MH, DM, DFF, DFF, DFF}; O = Fb; ldc = DM; break;
            case 15: g = pg8::Gemm{(const bf16_t*)(Gb), (const bf16_t*)(Wdn), MH, DM, DFF, DFF, DFF}; O = Fb + (size_t)MH * DM; ldc = DM; break;
            default: break;
        }
        if (g.A != nullptr) {
            pg8::StaticOrder S; S.init(g.M, g.N, G, bx); EpiB E{(bf16_t*)O, ldc, nullptr, 0, 0, 1.f};
            pg8::gemm_phase<EpiB, pg8::StaticOrder, true, true>(lds, g, S, E, tid);
        }
#ifndef NGM
#define NGM 0x1ffff
#endif
#define NG(k) ((NGM >> (k)) & 1)
        else if (NG(0) && ph == 0) {
            prep_mat<0>(argp(10), nullptr, Win, 1536, 1024, gtid, NTH); prep_mat<1>(argp(18), argp(19), Wq, 768, 256, gtid, NTH); prep_mat<2>(argp(20), argp(21), Wkv, 1024, 256, gtid, NTH);
            prep_mat<3>(argp(13), argp(15), Wg, 2048, 64, gtid, NTH); prep_mat<4>(argp(22), nullptr, Wout, 1024, 1024, gtid, NTH); prep_mat<5>(argp(23), nullptr, Wup, 5632, 1024, gtid, NTH);
            prep_mat<6>(argp(26), nullptr, Wdn, 1024, 2816, gtid, NTH);
            if (gtid < 1024) { const float nl = -argp(17)[gtid]; RT[2048 + gtid] = 8.f * 1.4426950408889634f * (nl > 20.f ? nl : log1pf(__expf(nl))); }
            if (gtid < 1024) { const int pos = gtid >> 3, j = gtid & 7; const float invf[8] = {1.f, 0.31622776601683794f, 0.1f, 0.031622776601683794f, 0.01f, 0.0031622776601683794f, 0.001f, 0.00031622776601683794f};
                const float ang = (float)pos * invf[j]; RT[2 * gtid] = cosf(ang); RT[2 * gtid + 1] = sinf(ang); }
            mod_phase(argp(1), argp(3), argp(4), argp(5), mod, (LAS float*)(lds + wave * 4096), gw, NGW, lane);
        } else if (NG(1) && ph == 1) {
            p1_rows(argp(0), argp(2), argp(6), mod, H, gw, NGW, lane);
        } else if (NG(3) && ph == 3) {
            gates_phase(argp(11), argp(12), argp(14), argp(16), (const GAS float*)(RT + 2048), lds, P, Wg, LU, AGG, tid, wave, lane);
            ss_phase(P, ssq, sskv, gw, NGW, lane);
        } else if (NG(6) && ph == 6) {
            krope_phase(P, Kb, RT, gtid, NTH); kvpost_phase(KVR, sskv, Kb, Vb, gtid, NTH);
#ifdef REP6
            if (REP6 & 1) { __syncthreads(); scan_agg(LU, AGG, gw, NGW, lane); }
            if (REP6 & 2) { __syncthreads(); krope_phase(P, Kb, RT, gtid, NTH); }
            if (REP6 & 4) { __syncthreads(); }
            if (REP6 & 8) { __syncthreads(); kvpost_phase(KVR, sskv, Kb, Vb, gtid, NTH); }
#endif
        } else if (NG(7) && ph == 7) {
            scan_final(LU, AGG, P, A2, gw, NGW, lane);
#ifdef REP7
            __syncthreads(); scan_final(LU, AGG, P, A2, gw, NGW, lane);
#endif
            const int upb = (NB * 8 * 16 + G - 1) / G, u0 = vcu * upb, u1 = min(NB * 8 * 16, u0 + upb);
            __syncthreads();
            for (int unit = u0; unit < u1; ++unit) { const int bh = unit >> 4, qb = unit & 15; attn_unit(lds, QR, ssq, RT, Kb, Vb, A2, bh >> 3, bh & 7, qb, tid, wave, lane); }
        } else if (NG(9) && ph == 9) {
            p7_rows(argp(0), argp(7), argp(8), (GAS bf16_t*)(ws + WS_X1), mod, Y, H2, gw, NGW, lane);
        } else if (NG(11) && (ph == 11 || ph == 14)) {
            convgate_phase(argp(24), argp(25), UP, Gb, ph == 14 ? 1 : 0, gtid, NTH);
        } else if (NG(16) && ph == 16) {
            p11_rows(argp(9), outp, (const GAS bf16_t*)(ws + WS_X1), mod, Fb, gw, NGW, lane);
        }
        __syncthreads();
#if MK_COOP
        if (ph + 1 < hi_ && ph != 3 && ph != 4 && ph != 12) {
            if (ph == 0) grid.sync();
            else { XcdBarrier xb; xb.bar = (unsigned*)(ws_ + WS_BAR); xb.x = xb_xcc_id(); xb.st = (volatile LAS unsigned*)(lds + LDS_MISC); xcd_barrier(xb); }
        }
#endif
        if (REPMASK) { if (((REPMASK >> ph) & 1) && !repeated) { repeated = true; --ph; } else repeated = false; }
    }
}

extern "C" void kernel_launch(void* const* d_in, const int* in_sizes, int n_in, void* d_out, int out_size, void* d_ws, size_t ws_size, hipStream_t stream) {
    static int grid = 0;
    if (grid == 0) {
        if (n_in != 27 || out_size != MLAT * DM || ws_size < WS_END) { fprintf(stderr, "kernel_launch: unexpected shapes (n_in %d, out %d, ws %zu)\n", n_in, out_size, ws_size); grid = -1; return; }
        int dev = 0, cus = 0, per_cu = 0;
        if (hipGetDevice(&dev) != hipSuccess || hipDeviceGetAttribute(&cus, hipDeviceAttributeMultiprocessorCount, dev) != hipSuccess) { grid = -1; return; }
        if (hipFuncSetAttribute((const void*)fwd_kernel, hipFuncAttributeMaxDynamicSharedMemorySize, LDS_BYTES) != hipSuccess) { fprintf(stderr, "kernel_launch: hipFuncSetAttribute failed\n"); grid = -1; return; }
        if (hipOccupancyMaxActiveBlocksPerMultiprocessor(&per_cu, (const void*)fwd_kernel, 512, LDS_BYTES) != hipSuccess || per_cu < 1) { fprintf(stderr, "kernel_launch: occupancy query says %d\n", per_cu); }
        (void)hipGetLastError();
        grid = cus;
    }
    if (grid < 0) return;
    (void)hipMemsetAsync((char*)d_ws + WS_CTL, 0, CTL_BYTES, stream);
    Args a{};
    for (int i = 0; i < 27; ++i) a.in[i] = (const float*)d_in[i];
    a.out = (float*)d_out; a.ws = (unsigned char*)d_ws;
#if MK_COOP
    a.ph_lo = 0; a.ph_hi = NPH;
    void* args[] = {&a};
    hipError_t e = hipLaunchCooperativeKernel((const void*)fwd_kernel, dim3(grid), dim3(512), args, LDS_BYTES, stream);
    if (e != hipSuccess) fprintf(stderr, "kernel_launch: cooperative launch failed: %s (grid %d)\n", hipGetErrorString(e), grid);
#else
    for (int p = 0; p < NPH; ++p) { a.ph_lo = p; a.ph_hi = p + 1; hipLaunchKernelGGL(fwd_kernel, dim3(grid), dim3(512), LDS_BYTES, stream, a); }
#endif
}
```

```cpp
#include <hip/hip_runtime.h>
#include <hip/hip_cooperative_groups.h>
#include <cstdio>
#include <cstdint>
namespace cg = cooperative_groups;
#ifndef MK_COOP
#define MK_COOP 1
#endif
namespace pg8 {
#define PG8_LAS __attribute__((address_space(3)))
typedef unsigned short bf16_t;
typedef short bf16x8 __attribute__((ext_vector_type(8)));
typedef float f32x4 __attribute__((ext_vector_type(4)));
typedef unsigned u32x4 __attribute__((ext_vector_type(4)));
constexpr int BM = 256, BK = 64, HALF = 128, HTB = HALF * BK * 2  , STAGE_BYTES = 8 * HTB, NXCD = 8, WGM = 8;

__host__ __device__ __forceinline__ int lds_byte(int r, int c) { const int st = (r >> 4) * 2 + (c >> 5), rr = r & 15, cc = c & 31, ob = rr * 64 + cc * 2; return st * 1024 + (ob ^ (((ob >> 9) & 1) << 5)); }
__host__ __device__ __forceinline__ void stage_rc(int b, int& R, int& C) { const int st = b / 1024, sb = b % 1024, swz = sb ^ (((sb >> 9) & 1) << 5); R = (st >> 1) * 16 + swz / 64; C = (st & 1) * 32 + (swz % 64) / 2; }
__host__ __device__ __forceinline__ int perm32(int rho) { const int n = rho >> 4, i = rho & 15; return 8 * (i >> 2) + 4 * n + (i & 3); }

struct Unit { int pm, pn; };
struct Gemm { const bf16_t* A; const bf16_t* Bt; int M, N, K, lda, ldb; };

struct StaticOrder {
    int nM, nN, nwg, G, c;
    __host__ __device__ void init(int M, int N, int G_, int c_) { nM = M / BM; nN = N / BM; nwg = nM * nN; G = G_; c = c_; }
    __host__ __device__ bool next(int i, Unit& u) const {
        const long L = (long)i * G + c; if (L >= nwg) return false;
        int wgid = (int)L; { const int q = nwg / NXCD, r = nwg % NXCD, xcd = wgid % NXCD, off = wgid / NXCD; wgid = (xcd < r ? xcd * (q + 1) : r * (q + 1) + (xcd - r) * q) + off; }
        const int nig = WGM * nN, gid = wgid / nig, fm = gid * WGM, gsz = (nM - fm) < WGM ? (nM - fm) : WGM;
        u.pm = fm + ((wgid % nig) % gsz); u.pn = (wgid % nig) / gsz; return true;
    }
    __device__ __forceinline__ void a_ready(const Unit&) const {}
    __device__ __forceinline__ void done(const Unit&) const {}
};

__device__ __forceinline__ unsigned cvt_pk_bf16(float lo, float hi) { unsigned r; asm volatile("v_cvt_pk_bf16_f32 %0, %1, %2" : "=v"(r) : "v"(lo), "v"(hi)); return r; }
typedef float f32x2 __attribute__((ext_vector_type(2)));
__device__ __forceinline__ f32x2 gelu_pk(f32x2 v) {
    const f32x2 av = __builtin_elementwise_abs(v), d = av * 0.2316418882f + 1.0f;
    f32x2 t; t.x = __builtin_amdgcn_rcpf(d.x); t.y = __builtin_amdgcn_rcpf(d.y);
    f32x2 q = t * 0.5307027145f + (-0.7265760135f); q = q * t + 0.7107068705f; q = q * t + (-0.142248368f); q = q * t + 0.127414796f; q = q * t;
    const f32x2 s = (v * v) * (-0.72134752044f);
    f32x2 e; e.x = __builtin_amdgcn_exp2f(s.x); e.y = __builtin_amdgcn_exp2f(s.y);
    const f32x2 m = v * (q * e), r = v - m;
    f32x2 o; o.x = v.x < 0.f ? m.x : r.x; o.y = v.y < 0.f ? m.y : r.y; return o;
}

template <int ACT  > struct EpiBf16 {
    static constexpr bool PERM = true, AFTER_DRAIN = false; static_assert(ACT == 0 || ACT == 1, "EpiBf16: ACT is 0 (none) or 1 (gelu_pk)");
    bf16_t* O; int ldc; const float* bias; int split_cols; size_t split_stride; float scale0;
    __device__ __forceinline__ void operator()(const f32x4 (&acc)[2][2][4][2], const Unit& u, int wr, int wc, int fr, int fq) const {
        const int row0 = u.pm * BM + wr * 64 + fr; int colt = u.pn * BM; bf16_t* base = O;
        float sc = 1.f; if (split_cols) { const int t = colt / split_cols; base += (size_t)t * split_stride; colt -= t * split_cols; if (t == 0) sc = scale0; }
        const int col0 = colt + wc * 32 + 8 * fq, bcol0 = u.pn * BM + wc * 32 + 8 * fq;
        f32x4 bv[2][2];
#pragma unroll
        for (int bj = 0; bj < 2; ++bj)
#pragma unroll
            for (int n = 0; n < 2; ++n) bv[bj][n] = bias ? *(const f32x4*)(bias + bcol0 + bj * HALF + 4 * n) : (f32x4){0.f, 0.f, 0.f, 0.f};
#pragma unroll
        for (int ai = 0; ai < 2; ++ai)
#pragma unroll
            for (int m = 0; m < 4; ++m) { bf16_t* rowp = base + (size_t)(row0 + ai * HALF + m * 16) * ldc + col0;
#pragma unroll
                for (int bj = 0; bj < 2; ++bj) { f32x4 v0 = acc[ai][bj][m][0] + bv[bj][0], v1 = acc[ai][bj][m][1] + bv[bj][1];
                    if (ACT == 1) { f32x2 a = gelu_pk((f32x2){v0[0], v0[1]}), b = gelu_pk((f32x2){v0[2], v0[3]}), c = gelu_pk((f32x2){v1[0], v1[1]}), d = gelu_pk((f32x2){v1[2], v1[3]});
                        v0 = (f32x4){a.x, a.y, b.x, b.y}; v1 = (f32x4){c.x, c.y, d.x, d.y}; }
                    v0 = v0 * sc; v1 = v1 * sc; u32x4 w; w.x = cvt_pk_bf16(v0[0], v0[1]); w.y = cvt_pk_bf16(v0[2], v0[3]); w.z = cvt_pk_bf16(v1[0], v1[1]); w.w = cvt_pk_bf16(v1[2], v1[3]);
                    *(__attribute__((address_space(1))) u32x4*)(rowp + bj * HALF) = w; } }
    }
};
template <class Epi, class Sched, bool ALIGN_EPI = false, bool SP2 = false>
__device__ __forceinline__ void gemm_phase(PG8_LAS unsigned char* lds, const Gemm g, const Sched& S, const Epi& E, const int tid) {
    const int wid = __builtin_amdgcn_readfirstlane(tid >> 6), lane = tid & 63, wr = wid >> 2, wc = wid & 3, fr = lane & 15, fq = lane >> 4;
    const int K = g.K, nt = K / BK;
    unsigned voffA[2], voffB[2];
#pragma unroll
    for (int i = 0; i < 2; ++i) { int R, C; stage_rc(tid * 16 + i * 8192, R, C); const int Rb = Epi::PERM ? ((R & ~31) + perm32(R & 31)) : R;
        voffA[i] = (unsigned)(R * g.lda + C) * 2u; voffB[i] = (unsigned)(Rb * g.ldb + C) * 2u; }
    const size_t kstep = (size_t)(BK * 2);
    const size_t hstepA = (size_t)HALF * g.lda * 2, hstepB = (size_t)HALF * g.ldb * 2;
    const size_t tstepA = 2 * hstepA, tstepB = 2 * hstepB;
    const unsigned ldsw = (unsigned)wid * 1024u;
    const int aoff = lds_byte(wr * 64 + fr, fq * 8), boff = lds_byte(wc * 32 + fr, fq * 8);
#define PG8_SA(b, h) (((b) * 2 + (h)) * HTB)
#define PG8_SB(b, h) ((4 + (b) * 2 + (h)) * HTB)
#define PG8_STAGE(bufoff, gbase, voff) do { _Pragma("unroll") for (int _i = 0; _i < 2; ++_i) \
        __builtin_amdgcn_global_load_lds((const unsigned*)((const char*)(gbase) + (voff)[_i]), (PG8_LAS unsigned*)(lds + (bufoff) + ldsw + _i * 8192), 16, 0, 0); } while (0)
#define PG8_LDA(dst, b, h) do { _Pragma("unroll") for (int m = 0; m < 4; ++m) _Pragma("unroll") for (int k = 0; k < 2; ++k) dst[m][k] = *(const PG8_LAS bf16x8*)(lds + PG8_SA(b, h) + aoff + m * 2048 + k * 1024); } while (0)
#define PG8_LDB(dst, b, h) do { _Pragma("unroll") for (int n = 0; n < 2; ++n) _Pragma("unroll") for (int k = 0; k < 2; ++k) dst[n][k] = *(const PG8_LAS bf16x8*)(lds + PG8_SB(b, h) + boff + n * 2048 + k * 1024); } while (0)
#define PG8_MMA(ai, bj, At, Bt) do { __builtin_amdgcn_s_setprio(1); _Pragma("unroll") for (int m = 0; m < 4; ++m) _Pragma("unroll") for (int n = 0; n < 2; ++n) _Pragma("unroll") for (int k = 0; k < 2; ++k) \
        acc[ai][bj][m][n] = __builtin_amdgcn_mfma_f32_16x16x32_bf16(Bt[n][k], At[m][k], acc[ai][bj][m][n], 0, 0, 0); __builtin_amdgcn_s_setprio(0); } while (0)
#define PG8_WAIT_V(n) asm volatile("s_waitcnt vmcnt(" #n ")" ::: "memory")
#define PG8_WAIT_L(n) asm volatile("s_waitcnt lgkmcnt(" #n ")" ::: "memory")
#define PG8_BAR __builtin_amdgcn_s_barrier()
#define PG8_SCHED __builtin_amdgcn_sched_barrier(0)
    Unit cur, nxt; int ui = 0;
    if (!S.next(0, cur)) return;
    f32x4 acc[2][2][4][2];
#pragma unroll
    for (int a = 0; a < 2; ++a)
#pragma unroll
        for (int b = 0; b < 2; ++b)
#pragma unroll
            for (int m = 0; m < 4; ++m)
#pragma unroll
                for (int n = 0; n < 2; ++n) acc[a][b][m][n] = (f32x4){0.f, 0.f, 0.f, 0.f};
    bf16x8 At[4][2], B0[2][2], B1[2][2];
    const char* cA = (const char*)g.A + (size_t)cur.pm * tstepA; const char* cB = (const char*)g.Bt + (size_t)cur.pn * tstepB;
    S.a_ready(cur);
    if constexpr (SP2) {
        PG8_STAGE(PG8_SB(0, 0), cB, voffB); PG8_STAGE(PG8_SB(0, 1), cB + hstepB, voffB); PG8_STAGE(PG8_SA(0, 0), cA, voffA); PG8_STAGE(PG8_SA(0, 1), cA + hstepA, voffA);
        if (wr == 1) PG8_BAR;
        PG8_WAIT_V(2); PG8_BAR;
        PG8_STAGE(PG8_SB(1, 0), cB + kstep, voffB); PG8_STAGE(PG8_SA(1, 0), cA + kstep, voffA); PG8_STAGE(PG8_SB(1, 1), cB + hstepB + kstep, voffB);
        PG8_WAIT_V(6); PG8_BAR;
    } else {
        PG8_STAGE(PG8_SB(0, 0), cB, voffB); PG8_STAGE(PG8_SA(0, 0), cA, voffA); PG8_STAGE(PG8_SB(0, 1), cB + hstepB, voffB); PG8_STAGE(PG8_SA(0, 1), cA + hstepA, voffA);
        if (wr == 1) PG8_BAR;
        PG8_WAIT_V(4); PG8_BAR;
        PG8_STAGE(PG8_SB(1, 0), cB + kstep, voffB); PG8_STAGE(PG8_SA(1, 0), cA + kstep, voffA); PG8_STAGE(PG8_SB(1, 1), cB + hstepB + kstep, voffB);
        PG8_WAIT_V(6); PG8_BAR;
    }
    for (;;) {
        const bool has_next = S.next(ui + 1, nxt);
        const char* nA = has_next ? (const char*)g.A + (size_t)nxt.pm * tstepA : cA; const char* nB = has_next ? (const char*)g.Bt + (size_t)nxt.pn * tstepB : cB;
        for (int t = 0; t < nt; t += 2) {
            const bool last = (t == nt - 2);
            const char* a1 = cA + (size_t)(t + 1) * kstep;
            const char* a2 = last ? nA : cA + (size_t)(t + 2) * kstep; const char* b2 = last ? nB : cB + (size_t)(t + 2) * kstep;
            const char* a3 = a2 + kstep; const char* b3 = b2 + kstep;
            if (last && has_next) S.a_ready(nxt);
            if constexpr (SP2) {
            PG8_LDB(B0, 0, 0); PG8_LDB(B1, 0, 1); PG8_SCHED; PG8_LDA(At, 0, 0); PG8_STAGE(PG8_SA(1, 1), a1 + hstepA, voffA);
            PG8_WAIT_V(8); PG8_WAIT_L(0); PG8_BAR; PG8_MMA(0, 0, At, B0); PG8_MMA(0, 1, At, B1); PG8_BAR; PG8_SCHED;
            PG8_LDA(At, 0, 1); PG8_STAGE(PG8_SB(0, 0), b2, voffB); PG8_STAGE(PG8_SB(0, 1), b2 + hstepB, voffB); PG8_STAGE(PG8_SA(0, 0), a2, voffA);
            PG8_WAIT_V(8); PG8_WAIT_L(0); PG8_BAR; PG8_MMA(1, 0, At, B0); PG8_MMA(1, 1, At, B1); PG8_BAR; PG8_SCHED;
            PG8_LDB(B0, 1, 0); PG8_LDB(B1, 1, 1); PG8_SCHED; PG8_LDA(At, 1, 0); PG8_STAGE(PG8_SA(0, 1), a2 + hstepA, voffA);
            PG8_WAIT_V(8); PG8_WAIT_L(0); PG8_BAR; PG8_MMA(0, 0, At, B0); PG8_MMA(0, 1, At, B1); PG8_BAR; PG8_SCHED;
            PG8_LDA(At, 1, 1); PG8_STAGE(PG8_SB(1, 0), b3, voffB); PG8_STAGE(PG8_SB(1, 1), b3 + hstepB, voffB); PG8_STAGE(PG8_SA(1, 0), a3, voffA);
            PG8_WAIT_V(8); PG8_WAIT_L(0); PG8_BAR; PG8_MMA(1, 0, At, B0); PG8_MMA(1, 1, At, B1); PG8_BAR; PG8_SCHED;
            } else {
            PG8_LDB(B0, 0, 0); PG8_SCHED; PG8_LDA(At, 0, 0); PG8_STAGE(PG8_SA(1, 1), a1 + hstepA, voffA);
            PG8_WAIT_L(8); PG8_BAR; PG8_WAIT_L(0); PG8_MMA(0, 0, At, B0); PG8_BAR; PG8_SCHED;
            PG8_LDB(B1, 0, 1); PG8_STAGE(PG8_SB(0, 0), b2, voffB);
            PG8_BAR; PG8_WAIT_L(0); PG8_MMA(0, 1, At, B1); PG8_BAR;
            PG8_LDA(At, 0, 1); PG8_STAGE(PG8_SA(0, 0), a2, voffA);
            PG8_BAR; PG8_WAIT_L(0); PG8_MMA(1, 0, At, B0); PG8_BAR; PG8_SCHED;
            PG8_STAGE(PG8_SB(0, 1), b2 + hstepB, voffB);
            PG8_WAIT_V(6); PG8_BAR; PG8_MMA(1, 1, At, B1); PG8_BAR;
            PG8_LDB(B0, 1, 0); PG8_SCHED; PG8_LDA(At, 1, 0); PG8_STAGE(PG8_SA(0, 1), a2 + hstepA, voffA);
            PG8_WAIT_L(8); PG8_BAR; PG8_WAIT_L(0); PG8_MMA(0, 0, At, B0); PG8_BAR; PG8_SCHED;
            PG8_LDB(B1, 1, 1); PG8_STAGE(PG8_SB(1, 0), b3, voffB);
            PG8_BAR; PG8_WAIT_L(0); PG8_MMA(0, 1, At, B1); PG8_BAR;
            PG8_LDA(At, 1, 1); PG8_STAGE(PG8_SA(1, 0), a3, voffA);
            PG8_BAR; PG8_WAIT_L(0); PG8_MMA(1, 0, At, B0); PG8_BAR; PG8_SCHED;
            PG8_STAGE(PG8_SB(1, 1), b3 + hstepB, voffB);
            PG8_WAIT_V(6); PG8_BAR; PG8_MMA(1, 1, At, B1); PG8_BAR;
            }
        }
        if constexpr (ALIGN_EPI) { if (wr == 0) PG8_BAR; }
        if constexpr (!Epi::AFTER_DRAIN) { E(acc, cur, wr, wc, fr, fq); S.done(cur); }
        if (!has_next) break;
#pragma unroll
        for (int a = 0; a < 2; ++a)
#pragma unroll
            for (int b = 0; b < 2; ++b)
#pragma unroll
                for (int m = 0; m < 4; ++m)
#pragma unroll
                    for (int n = 0; n < 2; ++n) acc[a][b][m][n] = (f32x4){0.f, 0.f, 0.f, 0.f};
        cur = nxt; cA = nA; cB = nB; ++ui;
        if constexpr (ALIGN_EPI) { if (wr == 1) PG8_BAR; }
    }
    PG8_WAIT_V(0);
    if constexpr (!ALIGN_EPI) { if (wr == 0) PG8_BAR; }
    PG8_BAR;
    if constexpr (Epi::AFTER_DRAIN) { E.fused(acc, cur, wr, wc, fr, fq, lds, wid, lane); S.done(cur); }
#undef PG8_SA
#undef PG8_SB
#undef PG8_STAGE
#undef PG8_LDA
#undef PG8_LDB
#undef PG8_MMA
#undef PG8_WAIT_V
#undef PG8_WAIT_L
#undef PG8_BAR
#undef PG8_SCHED
}
}
#define LAS __attribute__((address_space(3)))
#define GAS __attribute__((address_space(1)))
typedef unsigned short bf16_t;
typedef short bf16x8 __attribute__((ext_vector_type(8)));
typedef short s16x4 __attribute__((ext_vector_type(4)));
typedef float f32x4 __attribute__((ext_vector_type(4)));
typedef float f32x16 __attribute__((ext_vector_type(16)));
typedef unsigned u32x4 __attribute__((ext_vector_type(4)));
typedef unsigned u32x2 __attribute__((ext_vector_type(2)));
typedef float f32x2 __attribute__((ext_vector_type(2)));

constexpr int NB = 8, SEQ = 8192, DM = 1024, CTX = 256, MLAT = NB * SEQ, MCTX = NB * CTX, MALL = MLAT + MCTX;
constexpr int PW = 1536, KVLEN = CTX + SEQ, DFF = 2816, NMOD = 6 * DM;
constexpr int NCH = 32, CHL = 256;
constexpr float EPS = 1e-6f;
constexpr float QSCALE = 0.10206207261596575f * 1.4426950408889634f;
constexpr size_t MiB = 1u << 20;
constexpr size_t WS_CTL = 0, CTL_BYTES = 2 * MiB;
constexpr size_t WS_MOD = 64 * 1024, WS_SSQ = 512 * 1024, WS_SSKV = 1024 * 1024, WS_BAR = 1600 * 1024;
constexpr size_t WS_WIN = 2 * MiB, WS_WQ = 5 * MiB, WS_WKV = 6 * MiB, WS_WG = 7 * MiB, WS_WOUT = 8 * MiB, WS_WUP = 10 * MiB, WS_WDN = 21 * MiB;
constexpr size_t WS_AGG = 27 * MiB, WS_ROPE = 29 * MiB + 512 * 1024;
constexpr size_t WS_R1 = 30 * MiB;
constexpr size_t WS_R2 = 162 * MiB;
constexpr size_t WS_LU = 360 * MiB, WS_K = 624 * MiB, WS_V = 723 * MiB, WS_A2 = 789 * MiB;
constexpr size_t WS_UP = 360 * MiB, WS_G = 712 * MiB, WS_Q = 920 * MiB, WS_X1 = 888 * MiB, WS_END = 1016 * MiB;
constexpr int LDS_BYTES = 139264;
constexpr int LDS_MISC = 131072 + 64;

__device__ __forceinline__ unsigned f2bf(float f) { unsigned u = __builtin_bit_cast(unsigned, f); return (u + 0x7fffu + ((u >> 16) & 1u)) >> 16; }
__device__ __forceinline__ unsigned cvtpk(float lo, float hi) { typedef float f2 __attribute__((ext_vector_type(2))); typedef __bf16 b2 __attribute__((ext_vector_type(2))); f2 v = {lo, hi}; b2 r = __builtin_convertvector(v, b2); return __builtin_bit_cast(unsigned, r); }
__device__ __forceinline__ unsigned pk2(float lo, float hi) { return cvtpk(lo, hi); }
__device__ __forceinline__ float bflo(unsigned w) { return __uint_as_float(w << 16); }
__device__ __forceinline__ float bfhi(unsigned w) { return __uint_as_float(w & 0xffff0000u); }
__device__ __forceinline__ float bf2f(bf16_t v) { return __uint_as_float((unsigned)v << 16); }
__device__ __forceinline__ int crow(int r, int hi) { return (r & 3) + 8 * (r >> 2) + 4 * hi; }
__device__ __forceinline__ float wave_sum(float v) {
#pragma unroll
    for (int o = 1; o < 64; o <<= 1) v += __shfl_xor(v, o);
    return v;
}
__device__ __forceinline__ float sigmoidf_(float x) { return __builtin_amdgcn_rcpf(1.f + __builtin_amdgcn_exp2f(-1.4426950408889634f * x)); }
#define LDS_WAIT() asm volatile("s_waitcnt lgkmcnt(0)" ::: "memory")
#define XB_TMO      128
#define XB_XCNT(j)  (256  + 64 * (j))
#define XB_XSUB(j)  (1280 + 64 * (j))
#define XB_XGEN(j)  (2304 + 64 * (j))
#define XB_TOP      3328
#define XB_TOPGEN   3392
#define XCD_BAR_WORDS 3456
#define XB_SPIN_CAP (1u << 18)

__device__ __forceinline__ unsigned xb_ld(unsigned* p)              { return __hip_atomic_load(p, __ATOMIC_RELAXED, __HIP_MEMORY_SCOPE_AGENT); }
__device__ __forceinline__ unsigned xb_add(unsigned* p, unsigned v) { return __hip_atomic_fetch_add(p, v, __ATOMIC_RELAXED, __HIP_MEMORY_SCOPE_AGENT); }
__device__ __forceinline__ unsigned xb_xcc_id() { return (unsigned)__builtin_amdgcn_s_getreg((3 << 11) | 20) & 0xFu; }
#define XB_SPIN(cond, bar) do { unsigned _sp = 0; while (cond) { __builtin_amdgcn_s_sleep(1); \
    if ((++_sp & 255u) == 0u) { if (xb_ld(&(bar)[XB_TMO])) break; if (_sp > XB_SPIN_CAP) { atomicAdd(&(bar)[XB_TMO], 1u); break; } } } } while (0)

struct XcdBarrier {
    unsigned* bar; unsigned x;
    volatile LAS unsigned* st;
};

__device__ __forceinline__ XcdBarrier xcd_barrier_post(unsigned* bar, volatile LAS unsigned* st) {
    XcdBarrier b; b.bar = bar; b.x = xb_xcc_id(); b.st = st;
    if (threadIdx.x == 0) (void)xb_add(&bar[XB_XCNT(b.x)], 1u);
    return b;
}
__device__ __forceinline__ void xcd_barrier_complete(unsigned* bar, unsigned x, unsigned& nloc, unsigned& nx) {
    const unsigned G = gridDim.x * gridDim.y * gridDim.z;
    unsigned sum, cnt, mine, sp = 0u;
    for (;;) {
        sum = 0u; cnt = 0u; mine = 0u;
#pragma unroll
        for (unsigned j = 0; j < 16; ++j) { const unsigned c = xb_ld(&bar[XB_XCNT(j)]); sum += c; cnt += (c > 0u) ? 1u : 0u; mine = (j == x) ? c : mine; }
        if (sum == G) break;
        __builtin_amdgcn_s_sleep(1);
        if ((++sp & 255u) == 0u) { if (xb_ld(&bar[XB_TMO])) break; if (sp > XB_SPIN_CAP) { atomicAdd(&bar[XB_TMO], 1u); break; } }
    }
    nloc = mine > 0u ? mine : 1u; nx = cnt > 0u ? cnt : 1u;
}

__device__ __forceinline__ void xcd_barrier(const XcdBarrier& b) {
    asm volatile("s_waitcnt vmcnt(0)" ::: "memory");
    __syncthreads();
    if (threadIdx.x == 0) {
        unsigned* bar = b.bar;
        __builtin_amdgcn_s_waitcnt(0);
        unsigned nloc = b.st[0], nx = b.st[1];
        if (nloc == 0u) { xcd_barrier_complete(bar, b.x, nloc, nx); b.st[0] = nloc; b.st[1] = nx; }
        const unsigned old = xb_add(&bar[XB_XSUB(b.x)], 1u);
        const unsigned gen = old / nloc;
        if (old + 1u == (gen + 1u) * nloc) {
            __builtin_amdgcn_fence(__ATOMIC_RELEASE, "agent");
            asm volatile("s_waitcnt vmcnt(0)" ::: "memory");
            const unsigned og = xb_add(&bar[XB_TOP], 1u);
            const unsigned tg = og / nx;
            if (og + 1u == (tg + 1u) * nx) xb_add(&bar[XB_TOPGEN], 1u);
            else XB_SPIN(xb_ld(&bar[XB_TOPGEN]) == tg, bar);
            __builtin_amdgcn_fence(__ATOMIC_ACQUIRE, "agent");
            xb_add(&bar[XB_XGEN(b.x)], 1u);
            asm volatile("s_waitcnt vmcnt(0)" ::: "memory");
        } else {
            XB_SPIN(xb_ld(&bar[XB_XGEN(b.x)]) == gen, bar);
            __builtin_amdgcn_fence(__ATOMIC_ACQUIRE, "agent");
            asm volatile("s_waitcnt vmcnt(0)" ::: "memory");
        }
    }
    __syncthreads();
}


struct Args { const float* in[27]; float* out; unsigned char* ws; int ph_lo, ph_hi; };
__device__ __forceinline__ const GAS float* argp(int i) {
    const __attribute__((address_space(4))) char* kp = (const __attribute__((address_space(4))) char*)__builtin_amdgcn_kernarg_segment_ptr();
    asm volatile("" : "+s"(kp));
    const float* p = *(const float* const __attribute__((address_space(4)))*)(kp + 8 * i);
    return (const GAS float*)p;
}

template <int ID> __device__ __forceinline__ float wsrc(const GAS float* __restrict__ p0, const GAS float* __restrict__ p1, int n, int k) {
    if (ID == 0) return n < 1440 ? p0[(size_t)k * 1440 + n] : 0.f;
    if (ID == 1) return p0[k] * p1[(size_t)k * 768 + n];
    if (ID == 2) return k < 128 ? p0[k] * p1[(size_t)k * 1024 + n] : 0.f;
    if (ID == 3) { const int h = n >> 8, np = n & 255, mat = np >> 6, j = np & 63, dir = mat >> 1; const GAS float* w = (mat & 1) ? p1 : p0; return w[(size_t)((dir * 8 + h) * 64 + k) * 64 + j]; }
    if (ID == 4) return p0[(size_t)k * 1024 + n];
    if (ID == 5) return p0[(size_t)k * 5632 + n];
    return p0[(size_t)k * 1024 + n];
}
template <int ID> __device__ __forceinline__ void prep_mat(const GAS float* __restrict__ p0, const GAS float* __restrict__ p1, GAS bf16_t* __restrict__ dst, int N, int K, int gtid, int NT) {
    const int items = N * (K / 8);
    for (int it = gtid; it < items; it += NT) {
        const int nl = it & 7, kl = (it >> 3) & 7, rest = it >> 6, nb = rest % (N / 8), kb = rest / (N / 8), n = nb * 8 + nl, k8 = kb * 8 + kl;
        u32x4 o;
        o.x = pk2(wsrc<ID>(p0, p1, n, 8 * k8 + 0), wsrc<ID>(p0, p1, n, 8 * k8 + 1)); o.y = pk2(wsrc<ID>(p0, p1, n, 8 * k8 + 2), wsrc<ID>(p0, p1, n, 8 * k8 + 3));
        o.z = pk2(wsrc<ID>(p0, p1, n, 8 * k8 + 4), wsrc<ID>(p0, p1, n, 8 * k8 + 5)); o.w = pk2(wsrc<ID>(p0, p1, n, 8 * k8 + 6), wsrc<ID>(p0, p1, n, 8 * k8 + 7));
        *(GAS u32x4*)(dst + (size_t)n * K + 8 * k8) = o;
    }
}
__device__ __forceinline__ void mod_phase(const GAS float* __restrict__ cvec, const GAS float* __restrict__ cctx, const GAS float* __restrict__ wmod, const GAS float* __restrict__ bmod, GAS float* __restrict__ mod, LAS float* scr, int gw, int NGW, int lane) {
    for (int task = gw; task < 96 * 16; task += NGW) {
        const int cgp = task % 96, kc = task / 96, n = cgp * 64 + lane, k0 = kc * 64;
#pragma unroll
        for (int r = 0; r < 9; ++r) { const float cv = r < 8 ? cvec[r * 1024 + k0 + lane] : cctx[k0 + lane]; scr[r * 64 + lane] = cv / (1.f + __expf(-cv)); }
        LDS_WAIT();
        float acc[9];
#pragma unroll
        for (int r = 0; r < 9; ++r) acc[r] = 0.f;
#pragma unroll 8
        for (int kk = 0; kk < 64; ++kk) { const float w = wmod[(size_t)(k0 + kk) * NMOD + n];
#pragma unroll
            for (int r = 0; r < 9; ++r) acc[r] += scr[r * 64 + kk] * w; }
        const float bias = kc == 0 ? bmod[n] : 0.f;
#pragma unroll
        for (int r = 0; r < 9; ++r) atomicAdd((float*)(mod + r * NMOD + n), acc[r] + bias);
        LDS_WAIT();
    }
}
__device__ __forceinline__ void p1_rows(const GAS float* __restrict__ x, const GAS float* __restrict__ ctx, const GAS float* __restrict__ g, const GAS float* __restrict__ mod, GAS bf16_t* __restrict__ H, int gw, int NGW, int lane) {
    for (int m0 = 2 * gw; m0 < MALL; m0 += 2 * NGW) {
        f32x4 v[2][4]; float ss[2];
#pragma unroll
        for (int r = 0; r < 2; ++r) { const int m = m0 + r; const GAS float* src = m < MLAT ? x + (size_t)m * DM : ctx + (size_t)(m - MLAT) * DM; ss[r] = 0.f;
#pragma unroll
            for (int j = 0; j < 4; ++j) { v[r][j] = __builtin_nontemporal_load((const GAS f32x4*)(src + 4 * lane + 256 * j)); ss[r] += v[r][j].x * v[r][j].x + v[r][j].y * v[r][j].y + v[r][j].z * v[r][j].z + v[r][j].w * v[r][j].w; } }
#pragma unroll
        for (int r = 0; r < 2; ++r) { const int m = m0 + r; const GAS float* md = mod + (m < MLAT ? (m >> 13) : 8) * NMOD;
            const float rs = rsqrtf(wave_sum(ss[r]) * (1.f / DM) + EPS);
#pragma unroll
            for (int j = 0; j < 4; ++j) { const int k = 4 * lane + 256 * j;
                const f32x4 gg = *(const GAS f32x4*)(g + k), sh = *(const GAS f32x4*)(md + k), sc = *(const GAS f32x4*)(md + DM + k);
                const f32x4 y = v[r][j] * rs * gg * (sc + 1.f) + sh;
                u32x2 o; o.x = pk2(y.x, y.y); o.y = pk2(y.z, y.w); *(GAS u32x2*)(H + (size_t)m * DM + k) = o; } }
    }
}
__device__ __forceinline__ void ss_phase(const GAS bf16_t* __restrict__ P, GAS float* __restrict__ ssq, GAS float* __restrict__ sskv, int gw, int NGW, int lane) {
#pragma unroll 4
    for (int m = gw; m < MALL; m += NGW) {
        const u32x2 q = *(const GAS u32x2*)(P + (size_t)m * PW + 1024 + 4 * lane); const unsigned k = *(const GAS unsigned*)(P + (size_t)m * PW + 1280 + 2 * lane);
        float a = bflo(q.x) * bflo(q.x) + bfhi(q.x) * bfhi(q.x) + bflo(q.y) * bflo(q.y) + bfhi(q.y) * bfhi(q.y), c = bflo(k) * bflo(k) + bfhi(k) * bfhi(k);
        a = wave_sum(a); c = wave_sum(c);
        if (lane == 0) { ssq[m] = a; sskv[m] = c; }
    }
}
__device__ __forceinline__ void qpost_phase(const GAS bf16_t* __restrict__ QR, const GAS float* __restrict__ ssq, const GAS float* __restrict__ RT, GAS bf16_t* __restrict__ Q, int gtid, int NT) {
#pragma unroll 4
    for (int task = gtid; task < MLAT * 96; task += NT) {
        const int row = task / 96, c8 = task - row * 96, h = c8 / 12, dc = c8 - h * 12, b = row >> 13, s = row & 8191;
        const float sc = rsqrtf(ssq[row] * (1.f / 256.f) + EPS) * QSCALE;
        const u32x4 mine = *(const GAS u32x4*)(QR + (size_t)row * 768 + 8 * c8);
        float v[8];
#pragma unroll
        for (int j = 0; j < 4; ++j) { v[2 * j] = bflo(mine[j]) * sc; v[2 * j + 1] = bfhi(mine[j]) * sc; }
        if (dc >= 8) { const int fq = dc - 8; const u32x4 oth = *(const GAS u32x4*)(QR + (size_t)row * 768 + 8 * (c8 ^ 1));
            const GAS float* rt = RT + (fq < 2 ? (s >> 6) : (s & 63)) * 16;
#pragma unroll
            for (int j = 0; j < 8; ++j) { const float pt = ((j & 1) ? bfhi(oth[j >> 1]) : bflo(oth[j >> 1])) * sc, cs = rt[2 * j], sn = rt[2 * j + 1];
                v[j] = (fq & 1) ? v[j] * cs + pt * sn : v[j] * cs - pt * sn; } }
        u32x4 w; w.x = pk2(v[0], v[1]); w.y = pk2(v[2], v[3]); w.z = pk2(v[4], v[5]); w.w = pk2(v[6], v[7]);
        *(GAS u32x4*)(Q + ((size_t)((b * 8 + h) * SEQ + s)) * 96 + 8 * dc) = w;
    }
}
__device__ __forceinline__ void kvpost_phase(const GAS bf16_t* __restrict__ KVR, const GAS float* __restrict__ sskv, GAS bf16_t* __restrict__ Kb, GAS bf16_t* __restrict__ Vt, int gtid, int NT) {
#pragma unroll 4
    for (int task = gtid; task < MALL * 64; task += NT) {
        const int row = task >> 6, c = task & 63, h = c >> 3, dd = (c & 7) * 8; const bool lat = row < MLAT;
        const int b = lat ? (row >> 13) : ((row - MLAT) >> 8), pos = lat ? (CTX + (row & 8191)) : ((row - MLAT) & 255);
        const float rs = rsqrtf(sskv[row] * (1.f / 128.f) + EPS);
        const u32x4 mine = __builtin_nontemporal_load((const GAS u32x4*)(KVR + (size_t)row * 1024 + h * 128 + dd));
        u32x4 w;
#pragma unroll
        for (int j = 0; j < 4; ++j) w[j] = pk2(bflo(mine[j]) * rs, bfhi(mine[j]) * rs);
        *(GAS u32x4*)(Kb + ((size_t)(b * 8 + h) * KVLEN + pos) * 96 + dd) = w;
    }
#pragma unroll 2
    for (int task = gtid; task < (MALL / 8) * 128; task += NT) {
        const int pg = task & 7, dq = (task >> 3) & 7, rest = task >> 6, hd32 = rest & 15, rb = rest >> 4, h = hd32 >> 1, d = (hd32 & 1) * 32 + 4 * dq, row0 = rb * 64 + pg * 8; const bool lat = row0 < MLAT;
        const int b = lat ? (row0 >> 13) : ((row0 - MLAT) >> 8), pos0 = lat ? (CTX + (row0 & 8191)) : ((row0 - MLAT) & 255);
        float v[4][8];
#pragma unroll
        for (int i = 0; i < 8; ++i) { const u32x2 w = __builtin_nontemporal_load((const GAS u32x2*)(KVR + (size_t)(row0 + i) * 1024 + h * 128 + 64 + d)); const float rs = rsqrtf(sskv[row0 + i] * (1.f / 128.f) + EPS);
            v[0][i] = bflo(w.x) * rs; v[1][i] = bfhi(w.x) * rs; v[2][i] = bflo(w.y) * rs; v[3][i] = bfhi(w.y) * rs; }
        GAS bf16_t* vp = Vt + ((size_t)((b * 8 + h) * 64 + d)) * KVLEN + pos0;
#pragma unroll
        for (int j = 0; j < 4; ++j) { u32x4 w; w.x = pk2(v[j][0], v[j][1]); w.y = pk2(v[j][2], v[j][3]); w.z = pk2(v[j][4], v[j][5]); w.w = pk2(v[j][6], v[j][7]);
            *(GAS u32x4*)(vp + (size_t)j * KVLEN) = w; }
    }
}
__device__ __forceinline__ void krope_phase(const GAS bf16_t* __restrict__ P, GAS bf16_t* __restrict__ Kb, const GAS float* __restrict__ RT, int gtid, int NT) {
#pragma unroll 2
    for (int task = gtid; task < MALL * 4; task += NT) {
        const int row = task >> 2, fq = task & 3; const bool lat = row < MLAT;
        const int b = lat ? (row >> 13) : ((row - MLAT) >> 8), s = row & 8191, pos = lat ? (CTX + s) : ((row - MLAT) & 255);
        const u32x4 mine = *(const GAS u32x4*)(P + (size_t)row * PW + 1408 + 8 * fq), oth = *(const GAS u32x4*)(P + (size_t)row * PW + 1408 + 8 * (fq ^ 1));
        float v[8], pt[8];
#pragma unroll
        for (int j = 0; j < 4; ++j) { v[2 * j] = bflo(mine[j]); v[2 * j + 1] = bfhi(mine[j]); pt[2 * j] = bflo(oth[j]); pt[2 * j + 1] = bfhi(oth[j]); }
        if (lat) { const GAS float* rt = RT + (fq < 2 ? (s >> 6) : (s & 63)) * 16;
#pragma unroll
            for (int j = 0; j < 8; ++j) { const float cs = rt[2 * j], sn = rt[2 * j + 1]; v[j] = (fq & 1) ? v[j] * cs + pt[j] * sn : v[j] * cs - pt[j] * sn; } }
        u32x4 w; w.x = pk2(v[0], v[1]); w.y = pk2(v[2], v[3]); w.z = pk2(v[4], v[5]); w.w = pk2(v[6], v[7]);
#pragma unroll
        for (int h = 0; h < 8; ++h) *(GAS u32x4*)(Kb + ((size_t)(b * 8 + h) * KVLEN + pos) * 96 + 64 + 8 * fq) = w;
    }
}
#define MFMA32(a, b, c) __builtin_amdgcn_mfma_f32_32x32x16_bf16((a), (b), (c), 0, 0, 0)
__device__ __forceinline__ void gates_phase(const GAS float* __restrict__ cw, const GAS float* __restrict__ cb, const GAS float* __restrict__ b_a, const GAS float* __restrict__ b_x, const GAS float* __restrict__ lam, LAS unsigned char* lds, const GAS bf16_t* __restrict__ P, const GAS bf16_t* __restrict__ Wg, GAS unsigned* __restrict__ LU, GAS f32x2* __restrict__ AGG, int tid, int wave, int lane) {
    LAS bf16_t* xs = (LAS bf16_t*)(lds + wave * 4608);
    LAS f32x2* wagg = (LAS f32x2*)(lds + 8 * 4608);
    const int r32 = lane & 31, hi = lane >> 5;
    for (int unit = blockIdx.x; unit < (MALL / 256) * 8; unit += gridDim.x) {
        const int pm = unit >> 3, h = unit & 7, m0 = pm * 256 + wave * 32;
        const int s0 = m0 < MLAT ? (m0 & ~8191) : (MLAT + ((m0 - MLAT) & ~255)), slen = m0 < MLAT ? SEQ : CTX;
        {
            const int tok = lane >> 1, m = m0 + tok;
#pragma unroll
            for (int c8 = 0; c8 < 4; ++c8) { const int ch = (lane & 1) * 32 + c8 * 8, gch = h * 64 + ch;
                float acc[8];
                { const f32x4 b0 = *(const GAS f32x4*)(cb + gch), b1 = *(const GAS f32x4*)(cb + gch + 4);
                  acc[0] = b0.x; acc[1] = b0.y; acc[2] = b0.z; acc[3] = b0.w; acc[4] = b1.x; acc[5] = b1.y; acc[6] = b1.z; acc[7] = b1.w; }
#pragma unroll
                for (int k = 0; k < 4; ++k) { const int mm = m + k - 2;
                    if (mm >= s0 && mm < s0 + slen) { const u32x4 xv = *(const GAS u32x4*)(P + (size_t)mm * PW + gch);
                        const f32x4 w0 = *(const GAS f32x4*)(cw + k * 512 + gch), w1 = *(const GAS f32x4*)(cw + k * 512 + gch + 4);
                        acc[0] += w0.x * bflo(xv.x); acc[1] += w0.y * bfhi(xv.x); acc[2] += w0.z * bflo(xv.y); acc[3] += w0.w * bfhi(xv.y);
                        acc[4] += w1.x * bflo(xv.z); acc[5] += w1.y * bfhi(xv.z); acc[6] += w1.z * bflo(xv.w); acc[7] += w1.w * bfhi(xv.w); } }
                u32x4 o; o.x = pk2(acc[0], acc[1]); o.y = pk2(acc[2], acc[3]); o.z = pk2(acc[4], acc[5]); o.w = pk2(acc[6], acc[7]);
                *(LAS u32x4*)(xs + tok * 72 + ch) = o; }
        }
        LDS_WAIT();
        bf16x8 afr[4];
#pragma unroll
        for (int ks = 0; ks < 4; ++ks) afr[ks] = *(const LAS bf16x8*)(xs + r32 * 72 + 16 * ks + 8 * hi);
#pragma unroll
        for (int jh = 0; jh < 2; ++jh) {
            f32x16 acc4[4];
#pragma unroll
            for (int q = 0; q < 4; ++q) {
#pragma unroll
                for (int i = 0; i < 16; ++i) acc4[q][i] = 0.f;
                const GAS bf16_t* wrow = Wg + (size_t)(h * 256 + (2 * q + jh) * 32 + r32) * 64 + 8 * hi;
#pragma unroll
                for (int ks = 0; ks < 4; ++ks) { const bf16x8 bfr = *(const GAS bf16x8*)(wrow + 16 * ks); acc4[q] = MFMA32(afr[ks], bfr, acc4[q]); }
            }
            const int ch = jh * 32 + r32, gch = h * 64 + ch;
            float ba[2], bx[2], sp[2];
#pragma unroll
            for (int d = 0; d < 2; ++d) { ba[d] = b_a[d * 512 + gch]; bx[d] = b_x[d * 512 + gch]; sp[d] = lam[d * 512 + gch]; }
            unsigned wv[16][2]; float avs[16][2];
#pragma unroll
            for (int i = 0; i < 16; ++i) { const int row = crow(i, hi); const float xv = bf2f(xs[row * 72 + ch]);
#pragma unroll
                for (int d = 0; d < 2; ++d) { const float r = sigmoidf_(acc4[2 * d][i] + ba[d]), ig = sigmoidf_(acc4[2 * d + 1][i] + bx[d]);
                    const float la2 = bflo(f2bf(-r * sp[d])), av = __builtin_amdgcn_exp2f(la2); avs[i][d] = av;
                    const float uu = __builtin_amdgcn_sqrtf(fmaxf(1.f - av * av, 0.f)) * (ig * xv);
                    wv[i][d] = pk2(la2, uu);
                    __builtin_nontemporal_store(wv[i][d], LU + ((size_t)(m0 + row) * 2 + d) * 512 + gch); } }
#pragma unroll
            for (int d = 0; d < 2; ++d) {
                float Ar[4], Ur[4];
#pragma unroll
                for (int g = 0; g < 4; ++g) { float A = 1.f, U = 0.f;
#pragma unroll
                    for (int jj = 0; jj < 4; ++jj) { const int j = d ? 3 - jj : jj; const unsigned w = wv[4 * g + j][d]; const float av = avs[4 * g + j][d]; A *= av; U = av * U + bfhi(w); }
                    Ar[g] = A; Ur[g] = U; }
                float A = 1.f, U = 0.f;
#pragma unroll
                for (int gg = 0; gg < 4; ++gg) { const int g = d ? 3 - gg : gg;
                    const float Ao = __shfl_xor(Ar[g], 32), Uo = __shfl_xor(Ur[g], 32);
                    if (d == 0) { U = Ar[g] * U + Ur[g]; A *= Ar[g]; U = Ao * U + Uo; A *= Ao; }
                    else        { U = Ao * U + Uo; A *= Ao; U = Ar[g] * U + Ur[g]; A *= Ar[g]; } }
                if (hi == 0) wagg[(wave * 2 + d) * 64 + ch] = (f32x2){A, U};
            }
        }
        LDS_WAIT();
        __syncthreads();
        if (tid < 128) {
            const int d = tid >> 6, ch = tid & 63; float A = 1.f, U = 0.f;
#pragma unroll
            for (int ww = 0; ww < 8; ++ww) { const int w = d ? 7 - ww : ww; const f32x2 g = wagg[(w * 2 + d) * 64 + ch]; U = g.x * U + g.y; A *= g.x; }
            const int b = pm < MLAT / 256 ? (pm >> 5) : (pm - MLAT / 256), c = pm < MLAT / 256 ? (pm & 31) : NCH;
            AGG[(size_t)((b * 2 + d) * (NCH + 1) + c) * 512 + h * 64 + ch] = (f32x2){A, U};
        }
        __syncthreads();
    }
}
__device__ __forceinline__ void scan_agg(const GAS unsigned* __restrict__ LU, GAS f32x2* __restrict__ AGG, int gw, int NGW, int lane) {
    for (int task = gw; task < NB * 2 * (NCH + 1) * 8; task += NGW) {
        const int cgp = task & 7, c = (task >> 3) % (NCH + 1), d = (task / (8 * (NCH + 1))) & 1, b = task / (16 * (NCH + 1));
        const int ch = cgp * 64 + lane, row0 = c < NCH ? b * SEQ + c * CHL : MLAT + b * CTX;
        float A = 1.f, U = 0.f;
#pragma unroll 16
        for (int t = 0; t < CHL; ++t) { const int tt = d ? CHL - 1 - t : t; const unsigned w = LU[((size_t)(row0 + tt) * 2 + d) * 512 + ch];
            const float av = __builtin_amdgcn_exp2f(bflo(w)); A *= av; U = av * U + bfhi(w); }
        AGG[(size_t)((b * 2 + d) * (NCH + 1) + c) * 512 + ch] = (f32x2){A, U};
    }
}
__device__ __forceinline__ float gelu_tanh(float x) { const float z = 0.7978845608028654f * (x + 0.044715f * x * x * x);
    return x * __builtin_amdgcn_rcpf(1.f + __builtin_amdgcn_exp2f(-2.8853900817779268f * z)); }
__device__ __forceinline__ void scan_final(const GAS unsigned* __restrict__ LU, const GAS f32x2* __restrict__ AGG, const GAS bf16_t* __restrict__ P, GAS bf16_t* __restrict__ A2, int gw, int NGW, int lane) {
    constexpr int BT = 16;
    for (int task = gw; task < NB * NCH * 8; task += NGW) {
        const int cgp = task & 7, c = (task >> 3) & (NCH - 1), b = task / (8 * NCH), ch = cgp * 64 + lane, row0 = b * SEQ + c * CHL;
        const GAS f32x2* ag0 = AGG + (size_t)((b * 2 + 0) * (NCH + 1)) * 512 + ch; const GAS f32x2* ag1 = AGG + (size_t)((b * 2 + 1) * (NCH + 1)) * 512 + ch;
        unsigned w[BT], wn[BT];
#pragma unroll
        for (int i = 0; i < BT; ++i) w[i] = __builtin_nontemporal_load(LU + ((size_t)(row0 + i) * 2 + 0) * 512 + ch);
        float hf = ag0[(size_t)NCH * 512].y;
        for (int cc = 0; cc < c; ++cc) { const f32x2 g = ag0[(size_t)cc * 512]; hf = g.x * hf + g.y; }
        float hb = ag1[(size_t)NCH * 512].y;
        for (int cc = NCH - 1; cc > c; --cc) { const f32x2 g = ag1[(size_t)cc * 512]; hb = g.x * hb + g.y; }
#pragma unroll 1
        for (int t0 = 0; t0 < CHL; t0 += BT) {
            if (t0 + BT < CHL) {
#pragma unroll
                for (int i = 0; i < BT; ++i) wn[i] = __builtin_nontemporal_load(LU + ((size_t)(row0 + t0 + BT + i) * 2 + 0) * 512 + ch); }
#pragma unroll
            for (int i = 0; i < BT; ++i) { hf = __builtin_amdgcn_exp2f(bflo(w[i])) * hf + bfhi(w[i]); A2[(size_t)(row0 + t0 + i) * DM + ch] = (bf16_t)f2bf(hf); }
#pragma unroll
            for (int i = 0; i < BT; ++i) w[i] = wn[i]; }
        bf16_t gr[BT], grn[BT];
#pragma unroll
        for (int i = 0; i < BT; ++i) { w[i] = __builtin_nontemporal_load(LU + ((size_t)(row0 + CHL - BT + i) * 2 + 1) * 512 + ch); gr[i] = P[(size_t)(row0 + CHL - BT + i) * PW + 512 + ch]; }
#pragma unroll 1
        for (int t0 = CHL - BT; t0 >= 0; t0 -= BT) { bf16_t f[BT];
#pragma unroll
            for (int i = 0; i < BT; ++i) f[i] = A2[(size_t)(row0 + t0 + i) * DM + ch];
            if (t0 >= BT) {
#pragma unroll
                for (int i = 0; i < BT; ++i) { wn[i] = __builtin_nontemporal_load(LU + ((size_t)(row0 + t0 - BT + i) * 2 + 1) * 512 + ch); grn[i] = P[(size_t)(row0 + t0 - BT + i) * PW + 512 + ch]; } }
#pragma unroll
            for (int i = BT - 1; i >= 0; --i) { hb = __builtin_amdgcn_exp2f(bflo(w[i])) * hb + bfhi(w[i]);
                A2[(size_t)(row0 + t0 + i) * DM + ch] = (bf16_t)f2bf((bf2f(f[i]) + hb) * gelu_tanh(bf2f(gr[i]))); }
#pragma unroll
            for (int i = 0; i < BT; ++i) { w[i] = wn[i]; gr[i] = grn[i]; } }
    }
}
constexpr int AT_KROW = 208, AT_VROW = 144;
constexpr float AT_THR = 8.f;
#define AT_LMAX(P, MX) do { MX = fmaxf(fmaxf(P[0], P[1]), fmaxf(P[2], P[3])); \
        _Pragma("unroll") for (int i_ = 4; i_ < 16; i_ += 4) MX = fmaxf(fmaxf(MX, P[i_]), fmaxf(fmaxf(P[i_ + 1], P[i_ + 2]), P[i_ + 3])); } while (0)
#define AT_SOFTMAX(P, MX, M, L, O0, O1, PW0, PW1) do { \
        if (__any(MX > M + AT_THR)) { const float mn_ = fmaxf(M, MX), al_ = __builtin_amdgcn_exp2f(M - mn_); M = mn_; L *= al_; \
            _Pragma("unroll") for (int i_ = 0; i_ < 16; ++i_) { O0[i_] *= al_; O1[i_] *= al_; } } \
        float s_ = 0.f; \
        _Pragma("unroll") for (int i_ = 0; i_ < 16; ++i_) { P[i_] = __builtin_amdgcn_exp2f(P[i_] - M); s_ += P[i_]; } \
        L += s_; \
        _Pragma("unroll") for (int j_ = 0; j_ < 4; ++j_) { PW0[j_] = cvtpk(P[2 * j_], P[2 * j_ + 1]); PW1[j_] = cvtpk(P[8 + 2 * j_], P[9 + 2 * j_]); } } while (0)
__device__ __forceinline__ void glds16(const GAS void* gsrc, unsigned lds_dst) {
    unsigned keep;
    asm volatile("s_mov_b32 %0, m0\n\ts_mov_b32 m0, %2\n\ts_nop 0\n\tglobal_load_lds_dwordx4 %1, off\n\ts_mov_b32 m0, %0" : "=&s"(keep) : "v"(gsrc), "s"(lds_dst) : "memory");
}
constexpr int AT_SLOT = 22 * 1024, AT_VOFF = 13 * 1024, AT_NP = 22;
__device__ __forceinline__ void attn_unit(LAS unsigned char* lds, const GAS bf16_t* __restrict__ QR, const GAS float* __restrict__ ssq, const GAS float* __restrict__ RT, const GAS bf16_t* __restrict__ K, const GAS bf16_t* __restrict__ Vt, GAS bf16_t* __restrict__ A2, int b, int h, int qb, int tid, int wave, int lane) {
    const int r32 = lane & 31, hi = lane >> 5, q0 = qb * 512 + wave * 64, r32s = (r32 & ~12) | ((r32 & 4) << 1) | ((r32 & 8) >> 1);
    bf16x8 qa[6], qc[6];
#pragma unroll
    for (int sub = 0; sub < 2; ++sub) {
        const int s = q0 + 32 * sub + r32, row = b * SEQ + s;
        const GAS bf16_t* Qp = QR + (size_t)row * 768 + h * 96 + 8 * hi;
        const float sc = rsqrtf(ssq[row] * (1.f / 256.f) + EPS) * QSCALE;
#pragma unroll
        for (int d0 = 0; d0 < 6; ++d0) {
            const u32x4 raw = *(const GAS u32x4*)(Qp + 16 * d0);
            float v[8];
#pragma unroll
            for (int j = 0; j < 4; ++j) { v[2 * j] = bflo(raw[j]) * sc; v[2 * j + 1] = bfhi(raw[j]) * sc; }
            if (d0 >= 4) { const GAS float* rt = RT + (d0 == 4 ? (s >> 6) : (s & 63)) * 16;
#pragma unroll
                for (int j = 0; j < 8; ++j) { const float pt = __shfl_xor(v[j], 32), cs = rt[2 * j], sn = rt[2 * j + 1]; v[j] = hi ? v[j] * cs + pt * sn : v[j] * cs - pt * sn; } }
            u32x4 w; w.x = pk2(v[0], v[1]); w.y = pk2(v[2], v[3]); w.z = pk2(v[4], v[5]); w.w = pk2(v[6], v[7]);
            if (sub == 0) qa[d0] = __builtin_bit_cast(bf16x8, w); else qc[d0] = __builtin_bit_cast(bf16x8, w);
        }
    }
    const GAS unsigned char* Kg = (const GAS unsigned char*)(K + (size_t)(b * 8 + h) * KVLEN * 96);
    const GAS unsigned char* Vg = (const GAS unsigned char*)(Vt + (size_t)(b * 8 + h) * 64 * KVLEN);
    const unsigned ldsb = (unsigned)(size_t)lds;
    const GAS unsigned char* src[3]; int stride[3]; unsigned dsto[3];
#pragma unroll
    for (int k = 0; k < 3; ++k) { int j = wave + 8 * k; if (j >= AT_NP) j -= 8; const int id = j * 64 + lane;
        if (j < 13) { const int row = id / 13; int col = id - row * 13; if (col == 12) col = 0; src[k] = Kg + row * 192 + col * 16; stride[k] = 12288; }
        else { const int idv = id - 832, d = idv / 9; int c = idv - d * 9; if (c == 8) c = 0; src[k] = Vg + ((size_t)d * KVLEN + c * 8) * 2; stride[k] = 128; }
        dsto[k] = ldsb + j * 1024; }
#define AT_ISSUE(t, slot) do { _Pragma("unroll") for (int k_ = 0; k_ < 3; ++k_) glds16(src[k_] + (size_t)(t) * stride[k_], (unsigned)__builtin_amdgcn_readfirstlane(dsto[k_] + (slot) * AT_SLOT)); } while (0)
    f32x16 oA0, oA1, oB0, oB1;
#pragma unroll
    for (int i = 0; i < 16; ++i) { oA0[i] = 0.f; oA1[i] = 0.f; oB0[i] = 0.f; oB1[i] = 0.f; }
    float mA = -1e30f, mB = -1e30f, lA = 0.f, lB = 0.f;
    constexpr int NT_ = KVLEN / 64;
    AT_ISSUE(0, 0); AT_ISSUE(1, 1);
    int slot = 0, nslot = 2;
#pragma unroll 1
    for (int t = 0; t < NT_; ++t) {
        if (t + 1 < NT_) asm volatile("s_waitcnt vmcnt(3) lgkmcnt(0)\n\ts_barrier" ::: "memory"); else asm volatile("s_waitcnt vmcnt(0) lgkmcnt(0)\n\ts_barrier" ::: "memory");
        if (t + 2 < NT_) AT_ISSUE(t + 2, nslot);
        const LAS unsigned char* sb = lds + slot * AT_SLOT;
#pragma unroll
        for (int hh = 0; hh < 2; ++hh) {
            const LAS unsigned char* kb = sb + (32 * hh + r32s) * AT_KROW + hi * 16;
            f32x16 pA, pB;
#pragma unroll
            for (int i = 0; i < 16; ++i) { pA[i] = 0.f; pB[i] = 0.f; }
#pragma unroll
            for (int d0 = 0; d0 < 6; ++d0) { const bf16x8 a0 = *(const LAS bf16x8*)(kb + d0 * 32); pA = MFMA32(a0, qa[d0], pA); pB = MFMA32(a0, qc[d0], pB); }
            u32x4 pwA0, pwA1, pwB0, pwB1;
            float mxA, mxB; AT_LMAX(pA, mxA); AT_LMAX(pB, mxB);
            { const float oa = __shfl_xor(mxA, 32), ob = __shfl_xor(mxB, 32); mxA = fmaxf(mxA, oa); mxB = fmaxf(mxB, ob); }
            AT_SOFTMAX(pA, mxA, mA, lA, oA0, oA1, pwA0, pwA1);
            AT_SOFTMAX(pB, mxB, mB, lB, oB0, oB1, pwB0, pwB1);
            const LAS unsigned char* vb = sb + AT_VOFF + r32 * AT_VROW + hi * 16 + hh * 64;
#pragma unroll
            for (int ks = 0; ks < 2; ++ks) {
                const bf16x8 va0 = *(const LAS bf16x8*)(vb + ks * 32), va1 = *(const LAS bf16x8*)(vb + 32 * AT_VROW + ks * 32);
                const bf16x8 pa = __builtin_bit_cast(bf16x8, ks ? pwA1 : pwA0), pb = __builtin_bit_cast(bf16x8, ks ? pwB1 : pwB0);
                oA0 = MFMA32(va0, pa, oA0); oA1 = MFMA32(va1, pa, oA1); oB0 = MFMA32(va0, pb, oB0); oB1 = MFMA32(va1, pb, oB1);
            }
        }
        slot = slot == 2 ? 0 : slot + 1; nslot = nslot == 2 ? 0 : nslot + 1;
    }
    asm volatile("s_waitcnt lgkmcnt(0)\n\ts_barrier" ::: "memory");
    {   const float inv = 1.f / (lA + __shfl_xor(lA, 32));
        GAS bf16_t* op = A2 + (size_t)(b * SEQ + q0 + r32) * DM + 512 + h * 64 + 4 * hi;
#pragma unroll
        for (int g = 0; g < 4; ++g) { u32x2 w0, w1; w0.x = pk2(oA0[4 * g] * inv, oA0[4 * g + 1] * inv); w0.y = pk2(oA0[4 * g + 2] * inv, oA0[4 * g + 3] * inv);
            w1.x = pk2(oA1[4 * g] * inv, oA1[4 * g + 1] * inv); w1.y = pk2(oA1[4 * g + 2] * inv, oA1[4 * g + 3] * inv);
            *(GAS u32x2*)(op + 8 * g) = w0; *(GAS u32x2*)(op + 32 + 8 * g) = w1; } }
    {   const float inv = 1.f / (lB + __shfl_xor(lB, 32));
        GAS bf16_t* op = A2 + (size_t)(b * SEQ + q0 + 32 + r32) * DM + 512 + h * 64 + 4 * hi;
#pragma unroll
        for (int g = 0; g < 4; ++g) { u32x2 w0, w1; w0.x = pk2(oB0[4 * g] * inv, oB0[4 * g + 1] * inv); w0.y = pk2(oB0[4 * g + 2] * inv, oB0[4 * g + 3] * inv);
            w1.x = pk2(oB1[4 * g] * inv, oB1[4 * g + 1] * inv); w1.y = pk2(oB1[4 * g + 2] * inv, oB1[4 * g + 3] * inv);
            *(GAS u32x2*)(op + 8 * g) = w0; *(GAS u32x2*)(op + 32 + 8 * g) = w1; } }
#undef AT_ISSUE
}
__device__ __forceinline__ void p7_rows(const GAS float* __restrict__ x, const GAS float* __restrict__ g_post, const GAS float* __restrict__ g_pre, GAS bf16_t* __restrict__ X1b, const GAS float* __restrict__ mod, const GAS bf16_t* __restrict__ Y, GAS bf16_t* __restrict__ H2, int gw, int NGW, int lane) {
    for (int m0 = 2 * gw; m0 < MLAT; m0 += 2 * NGW) {
        const GAS float* md = mod + (m0 >> 13) * NMOD;
        f32x4 y[2][4], xv[2][4]; float ss[2];
#pragma unroll
        for (int r = 0; r < 2; ++r) { ss[r] = 0.f;
#pragma unroll
            for (int j = 0; j < 4; ++j) { const u32x2 w = __builtin_nontemporal_load((const GAS u32x2*)(Y + (size_t)(m0 + r) * DM + 4 * lane + 256 * j)); xv[r][j] = __builtin_nontemporal_load((const GAS f32x4*)(x + (size_t)(m0 + r) * DM + 4 * lane + 256 * j));
                y[r][j] = (f32x4){bflo(w.x), bfhi(w.x), bflo(w.y), bfhi(w.y)}; ss[r] += y[r][j].x * y[r][j].x + y[r][j].y * y[r][j].y + y[r][j].z * y[r][j].z + y[r][j].w * y[r][j].w; } }
#pragma unroll
        for (int r = 0; r < 2; ++r) { const int m = m0 + r;
            const float rs = rsqrtf(wave_sum(ss[r]) * (1.f / DM) + EPS); float s2 = 0.f;
#pragma unroll
            for (int j = 0; j < 4; ++j) { const int k = 4 * lane + 256 * j;
                const f32x4 gg = *(const GAS f32x4*)(g_post + k), gt = *(const GAS f32x4*)(md + 2 * DM + k);
                xv[r][j] = xv[r][j] + gt * (y[r][j] * rs * gg); { u32x2 o1; o1.x = pk2(xv[r][j].x, xv[r][j].y); o1.y = pk2(xv[r][j].z, xv[r][j].w); __builtin_nontemporal_store(o1, (GAS u32x2*)(X1b + (size_t)m * DM + k)); }
                s2 += xv[r][j].x * xv[r][j].x + xv[r][j].y * xv[r][j].y + xv[r][j].z * xv[r][j].z + xv[r][j].w * xv[r][j].w; }
            const float rs2 = rsqrtf(wave_sum(s2) * (1.f / DM) + EPS);
#pragma unroll
            for (int j = 0; j < 4; ++j) { const int k = 4 * lane + 256 * j;
                const f32x4 gg = *(const GAS f32x4*)(g_pre + k), sh = *(const GAS f32x4*)(md + 3 * DM + k), sc = *(const GAS f32x4*)(md + 4 * DM + k);
                const f32x4 hh = xv[r][j] * rs2 * gg * (sc + 1.f) + sh;
                u32x2 o; o.x = pk2(hh.x, hh.y); o.y = pk2(hh.z, hh.w); *(GAS u32x2*)(H2 + (size_t)m * DM + k) = o; } }
    }
}
__device__ __forceinline__ void p11_rows(const GAS float* __restrict__ g_post, GAS float* __restrict__ out, const GAS bf16_t* __restrict__ X1b, const GAS float* __restrict__ mod, const GAS bf16_t* __restrict__ Fb, int gw, int NGW, int lane) {
    for (int m0 = 2 * gw; m0 < MLAT; m0 += 2 * NGW) {
        const GAS float* md = mod + (m0 >> 13) * NMOD;
        f32x4 y[2][4], xv[2][4]; float ss[2];
#pragma unroll
        for (int r = 0; r < 2; ++r) { ss[r] = 0.f;
#pragma unroll
            for (int j = 0; j < 4; ++j) { const u32x2 w = __builtin_nontemporal_load((const GAS u32x2*)(Fb + (size_t)(m0 + r) * DM + 4 * lane + 256 * j)); { const u32x2 w1 = __builtin_nontemporal_load((const GAS u32x2*)(X1b + (size_t)(m0 + r) * DM + 4 * lane + 256 * j)); xv[r][j] = (f32x4){bflo(w1.x), bfhi(w1.x), bflo(w1.y), bfhi(w1.y)}; }
                y[r][j] = (f32x4){bflo(w.x), bfhi(w.x), bflo(w.y), bfhi(w.y)}; ss[r] += y[r][j].x * y[r][j].x + y[r][j].y * y[r][j].y + y[r][j].z * y[r][j].z + y[r][j].w * y[r][j].w; } }
#pragma unroll
        for (int r = 0; r < 2; ++r) { const float rs = rsqrtf(wave_sum(ss[r]) * (1.f / DM) + EPS);
#pragma unroll
            for (int j = 0; j < 4; ++j) { const int k = 4 * lane + 256 * j;
                const f32x4 gg = *(const GAS f32x4*)(g_post + k), gt = *(const GAS f32x4*)(md + 5 * DM + k);
                __builtin_nontemporal_store(xv[r][j] + gt * (y[r][j] * rs * gg), (GAS f32x4*)(out + (size_t)(m0 + r) * DM + k)); } }
    }
}
__device__ __forceinline__ void convgate_phase(const GAS float* __restrict__ cw, const GAS float* __restrict__ cb, const GAS bf16_t* __restrict__ UP, GAS bf16_t* __restrict__ G, int half, int gtid, int NT) {
    constexpr int JG = DFF / 8, RG = 32, NTASK = (MLAT / 2 / RG) * JG;
    for (int task = gtid; task < NTASK; task += NT) {
        const int jg = task % JG, rg = task / JG, j0 = jg * 8, r0 = rg * RG, m0 = half * (MLAT / 2) + r0;
        float wu[3][8], wg[3][8], bu[8], bg[8];
#pragma unroll
        for (int k = 0; k < 3; ++k)
#pragma unroll
            for (int i = 0; i < 8; ++i) { wu[k][i] = cw[k * 2 * DFF + j0 + i]; wg[k][i] = cw[k * 2 * DFF + DFF + j0 + i]; }
#pragma unroll
        for (int i = 0; i < 8; ++i) { bu[i] = cb[j0 + i]; bg[i] = cb[DFF + j0 + i]; }
        const GAS bf16_t* up = UP + (size_t)r0 * (2 * DFF) + j0;
        u32x4 pu = {0u, 0u, 0u, 0u}, pg = {0u, 0u, 0u, 0u}, cu, cg_, nu, ng;
        if ((m0 & 8191) != 0) { pu = __builtin_nontemporal_load((const GAS u32x4*)(up - 2 * DFF)); pg = __builtin_nontemporal_load((const GAS u32x4*)(up - 2 * DFF + DFF)); }
        cu = __builtin_nontemporal_load((const GAS u32x4*)(up)); cg_ = __builtin_nontemporal_load((const GAS u32x4*)(up + DFF));
#pragma unroll 8
        for (int r = 0; r < RG; ++r) {
            const bool nv = (r + 1 < RG) || (((m0 + RG) & 8191) != 0);
            if (nv) { nu = __builtin_nontemporal_load((const GAS u32x4*)(up + (size_t)(r + 1) * (2 * DFF))); ng = __builtin_nontemporal_load((const GAS u32x4*)(up + (size_t)(r + 1) * (2 * DFF) + DFF)); } else { nu = (u32x4){0u, 0u, 0u, 0u}; ng = nu; }
            float o[8];
#pragma unroll
            for (int i = 0; i < 8; ++i) { const int w_ = i >> 1;
                const float p_u = (i & 1) ? bfhi(pu[w_]) : bflo(pu[w_]), c_u = (i & 1) ? bfhi(cu[w_]) : bflo(cu[w_]), n_u = (i & 1) ? bfhi(nu[w_]) : bflo(nu[w_]);
                const float p_g = (i & 1) ? bfhi(pg[w_]) : bflo(pg[w_]), c_g = (i & 1) ? bfhi(cg_[w_]) : bflo(cg_[w_]), n_g = (i & 1) ? bfhi(ng[w_]) : bflo(ng[w_]);
                const float uv = bu[i] + wu[0][i] * p_u + wu[1][i] * c_u + wu[2][i] * n_u, gv = bg[i] + wg[0][i] * p_g + wg[1][i] * c_g + wg[2][i] * n_g;
                o[i] = gv * __builtin_amdgcn_rcpf(1.f + __builtin_amdgcn_exp2f(-1.4426950408889634f * gv)) * uv; }
            u32x4 w; w.x = pk2(o[0], o[1]); w.y = pk2(o[2], o[3]); w.z = pk2(o[4], o[5]); w.w = pk2(o[6], o[7]);
            *(GAS u32x4*)(G + (size_t)(r0 + r) * DFF + j0) = w;
            pu = cu; pg = cg_; cu = nu; cg_ = ng;
        }
    }
}
constexpr int NPH = 17;
__global__ void __launch_bounds__(512, 2) fwd_kernel(Args a) {
    extern __shared__ __attribute__((aligned(16))) unsigned char lds_raw[];
    LAS unsigned char* lds = (LAS unsigned char*)lds_raw;
    const int lo = a.ph_lo, hi_ = a.ph_hi;
    {
        volatile LAS unsigned* st0 = (volatile LAS unsigned*)(lds + LDS_MISC);
        if (threadIdx.x < 2) st0[threadIdx.x] = 0u;
        __syncthreads();
        (void)xcd_barrier_post((unsigned*)(a.ws + WS_BAR), st0);
    }
#if MK_COOP
    cg::grid_group grid = cg::this_grid();
#endif
    typedef pg8::EpiBf16<0> EpiB;
    constexpr int MH = MLAT / 2;
#ifndef REPMASK
#define REPMASK 0
#endif
    bool repeated = false;
#pragma unroll 1
    for (int ph = lo; ph < hi_; ++ph) {
        int tid = threadIdx.x; asm volatile("" : "+v"(tid));
        int G = gridDim.x, bx = blockIdx.x; asm volatile("" : "+s"(G), "+s"(bx));
        const int lane = tid & 63, wave = __builtin_amdgcn_readfirstlane(tid >> 6);
        const int vcu = (G % 8 == 0) ? (bx % 8) * (G / 8) + bx / 8 : bx;
        const int gw = vcu * 8 + wave, NGW = G * 8, gtid = bx * 512 + tid, NTH = G * 512;
        unsigned char* ws_ = a.ws; asm volatile("" : "+s"(ws_)); GAS unsigned char* ws = (GAS unsigned char*)ws_;
        GAS float* mod = (GAS float*)(ws + WS_MOD); GAS float* ssq = (GAS float*)(ws + WS_SSQ); GAS float* sskv = (GAS float*)(ws + WS_SSKV);
        GAS bf16_t* Win = (GAS bf16_t*)(ws + WS_WIN); GAS bf16_t* Wq = (GAS bf16_t*)(ws + WS_WQ); GAS bf16_t* Wkv = (GAS bf16_t*)(ws + WS_WKV); GAS bf16_t* Wg = (GAS bf16_t*)(ws + WS_WG);
        GAS bf16_t* Wout = (GAS bf16_t*)(ws + WS_WOUT); GAS bf16_t* Wup = (GAS bf16_t*)(ws + WS_WUP); GAS bf16_t* Wdn = (GAS bf16_t*)(ws + WS_WDN);
        GAS f32x2* AGG = (GAS f32x2*)(ws + WS_AGG); GAS float* RT = (GAS float*)(ws + WS_ROPE);
        GAS bf16_t* H = (GAS bf16_t*)(ws + WS_R1); GAS bf16_t* KVR = H; GAS bf16_t* H2 = H; GAS bf16_t* QR = (GAS bf16_t*)(ws + WS_Q);
        GAS bf16_t* P = (GAS bf16_t*)(ws + WS_R2); GAS bf16_t* Y = P; GAS bf16_t* Fb = P;
        GAS unsigned* LU = (GAS unsigned*)(ws + WS_LU); GAS bf16_t* Kb = (GAS bf16_t*)(ws + WS_K); GAS bf16_t* Vb = (GAS bf16_t*)(ws + WS_V); GAS bf16_t* A2 = (GAS bf16_t*)(ws + WS_A2);
        GAS bf16_t* UP = (GAS bf16_t*)(ws + WS_UP); GAS bf16_t* Gb = (GAS bf16_t*)(ws + WS_G);
        float* outp_ = a.out; asm volatile("" : "+s"(outp_)); GAS float* outp = (GAS float*)outp_;
        pg8::Gemm g{nullptr, nullptr, 0, 0, 0, 0, 0}; GAS bf16_t* O = nullptr; int ldc = 0;
        switch (ph) {
            case 2:  g = pg8::Gemm{(const bf16_t*)(H), (const bf16_t*)(Win), MALL, PW, DM, DM, DM}; O = P; ldc = PW; break;
            case 4:  g = pg8::Gemm{(const bf16_t*)(P + 1024), (const bf16_t*)(Wq), MLAT, 768, 256, PW, 256}; O = QR; ldc = 768; break;
            case 5:  g = pg8::Gemm{(const bf16_t*)(P + 1280), (const bf16_t*)(Wkv), MALL, 1024, 256, PW, 256}; O = KVR; ldc = 1024; break;
            case 8:  g = pg8::Gemm{(const bf16_t*)(A2), (const bf16_t*)(Wout), MLAT, DM, DM, DM, DM}; O = Y; ldc = DM; break;
            case 10: g = pg8::Gemm{(const bf16_t*)(H2), (const bf16_t*)(Wup), MH, 2 * DFF, DM, DM, DM}; O = UP; ldc = 2 * DFF; break;
            case 13: g = pg8::Gemm{(const bf16_t*)(H2 + (size_t)MH * DM), (const bf16_t*)(Wup), MH, 2 * DFF, DM, DM, DM}; O = UP; ldc = 2 * DFF; break;
            case 12: g = pg8::Gemm{(const bf16_t*)(Gb), (const bf16_t*)(Wdn), MH, DM, DFF, DFF, DFF}; O = Fb; ldc = DM; break;
            case 15: g = pg8::Gemm{(const bf16_t*)(Gb), (const bf16_t*)(Wdn), MH, DM, DFF, DFF, DFF}; O = Fb + (size_t)MH * DM; ldc = DM; break;
            default: break;
        }
        if (g.A != nullptr) {
            pg8::StaticOrder S; S.init(g.M, g.N, G, bx); EpiB E{(bf16_t*)O, ldc, nullptr, 0, 0, 1.f};
            pg8::gemm_phase<EpiB, pg8::StaticOrder, true, true>(lds, g, S, E, tid);
        }
#ifndef NGM
#define NGM 0x1ffff
#endif
#define NG(k) ((NGM >> (k)) & 1)
        else if (NG(0) && ph == 0) {
            prep_mat<0>(argp(10), nullptr, Win, 1536, 1024, gtid, NTH); prep_mat<1>(argp(18), argp(19), Wq, 768, 256, gtid, NTH); prep_mat<2>(argp(20), argp(21), Wkv, 1024, 256, gtid, NTH);
            prep_mat<3>(argp(13), argp(15), Wg, 2048, 64, gtid, NTH); prep_mat<4>(argp(22), nullptr, Wout, 1024, 1024, gtid, NTH); prep_mat<5>(argp(23), nullptr, Wup, 5632, 1024, gtid, NTH);
            prep_mat<6>(argp(26), nullptr, Wdn, 1024, 2816, gtid, NTH);
            if (gtid < 1024) { const float nl = -argp(17)[gtid]; RT[2048 + gtid] = 8.f * 1.4426950408889634f * (nl > 20.f ? nl : log1pf(__expf(nl))); }
            if (gtid < 1024) { const int pos = gtid >> 3, j = gtid & 7; const float invf[8] = {1.f, 0.31622776601683794f, 0.1f, 0.031622776601683794f, 0.01f, 0.0031622776601683794f, 0.001f, 0.00031622776601683794f};
                const float ang = (float)pos * invf[j]; RT[2 * gtid] = cosf(ang); RT[2 * gtid + 1] = sinf(ang); }
            mod_phase(argp(1), argp(3), argp(4), argp(5), mod, (LAS float*)(lds + wave * 4096), gw, NGW, lane);
        } else if (NG(1) && ph == 1) {
            p1_rows(argp(0), argp(2), argp(6), mod, H, gw, NGW, lane);
        } else if (NG(3) && ph == 3) {
            gates_phase(argp(11), argp(12), argp(14), argp(16), (const GAS float*)(RT + 2048), lds, P, Wg, LU, AGG, tid, wave, lane);
            ss_phase(P, ssq, sskv, gw, NGW, lane);
        } else if (NG(6) && ph == 6) {
            krope_phase(P, Kb, RT, gtid, NTH); kvpost_phase(KVR, sskv, Kb, Vb, gtid, NTH);
#ifdef REP6
            if (REP6 & 1) { __syncthreads(); scan_agg(LU, AGG, gw, NGW, lane); }
            if (REP6 & 2) { __syncthreads(); krope_phase(P, Kb, RT, gtid, NTH); }
            if (REP6 & 4) { __syncthreads(); }
            if (REP6 & 8) { __syncthreads(); kvpost_phase(KVR, sskv, Kb, Vb, gtid, NTH); }
#endif
        } else if (NG(7) && ph == 7) {
            scan_final(LU, AGG, P, A2, gw, NGW, lane);
#ifdef REP7
            __syncthreads(); scan_final(LU, AGG, P, A2, gw, NGW, lane);
#endif
            const int upb = (NB * 8 * 16 + G - 1) / G, u0 = vcu * upb, u1 = min(NB * 8 * 16, u0 + upb);
            __syncthreads();
            for (int unit = u0; unit < u1; ++unit) { const int bh = unit >> 4, qb = unit & 15; attn_unit(lds, QR, ssq, RT, Kb, Vb, A2, bh >> 3, bh & 7, qb, tid, wave, lane); }
        } else if (NG(9) && ph == 9) {
            p7_rows(argp(0), argp(7), argp(8), (GAS bf16_t*)(ws + WS_X1), mod, Y, H2, gw, NGW, lane);
        } else if (NG(11) && (ph == 11 || ph == 14)) {
            convgate_phase(argp(24), argp(25), UP, Gb, ph == 14 ? 1 : 0, gtid, NTH);
        } else if (NG(16) && ph == 16) {
            p11_rows(argp(9), outp, (const GAS bf16_t*)(ws + WS_X1), mod, Fb, gw, NGW, lane);
        }
        __syncthreads();
#if MK_COOP
        if (ph + 1 < hi_ && ph != 3 && ph != 4 && ph != 12) {
            if (ph == 0) grid.sync();
            else { XcdBarrier xb; xb.bar = (unsigned*)(ws_ + WS_BAR); xb.x = xb_xcc_id(); xb.st = (volatile LAS unsigned*)(lds + LDS_MISC); xcd_barrier(xb); }
        }
#endif
        if (REPMASK) { if (((REPMASK >> ph) & 1) && !repeated) { repeated = true; --ph; } else repeated = false; }
    }
}

extern "C" void kernel_launch(void* const* d_in, const int* in_sizes, int n_in, void* d_out, int out_size, void* d_ws, size_t ws_size, hipStream_t stream) {
    static int grid = 0;
    if (grid == 0) {
        if (n_in != 27 || out_size != MLAT * DM || ws_size < WS_END) { fprintf(stderr, "kernel_launch: unexpected shapes (n_in %d, out %d, ws %zu)\n", n_in, out_size, ws_size); grid = -1; return; }
        int dev = 0, cus = 0, per_cu = 0;
        if (hipGetDevice(&dev) != hipSuccess || hipDeviceGetAttribute(&cus, hipDeviceAttributeMultiprocessorCount, dev) != hipSuccess) { grid = -1; return; }
        if (hipFuncSetAttribute((const void*)fwd_kernel, hipFuncAttributeMaxDynamicSharedMemorySize, LDS_BYTES) != hipSuccess) { fprintf(stderr, "kernel_launch: hipFuncSetAttribute failed\n"); grid = -1; return; }
        if (hipOccupancyMaxActiveBlocksPerMultiprocessor(&per_cu, (const void*)fwd_kernel, 512, LDS_BYTES) != hipSuccess || per_cu < 1) { fprintf(stderr, "kernel_launch: occupancy query says %d\n", per_cu); }
        (void)hipGetLastError();
        grid = cus;
    }
    if (grid < 0) return;
    (void)hipMemsetAsync((char*)d_ws + WS_CTL, 0, CTL_BYTES, stream);
    Args a{};
    for (int i = 0; i < 27; ++i) a.in[i] = (const float*)d_in[i];
    a.out = (float*)d_out; a.ws = (unsigned char*)d_ws;
#if MK_COOP
    a.ph_lo = 0; a.ph_hi = NPH;
    void* args[] = {&a};
    hipError_t e = hipLaunchCooperativeKernel((const void*)fwd_kernel, dim3(grid), dim3(512), args, LDS_BYTES, stream);
    if (e != hipSuccess) fprintf(stderr, "kernel_launch: cooperative launch failed: %s (grid %d)\n", hipGetErrorString(e), grid);
#else
    for (int p = 0; p < NPH; ++p) { a.ph_lo = p; a.ph_hi = p + 1; hipLaunchKernelGGL(fwd_kernel, dim3(grid), dim3(512), LDS_BYTES, stream, a); }
#endif
}
```

```cpp
#include <hip/hip_runtime.h>
#include <hip/hip_cooperative_groups.h>
#include <cstdio>
#include <cstdint>
namespace cg = cooperative_groups;
#ifndef MK_COOP
#define MK_COOP 1
#endif
namespace pg8 {
#define PG8_LAS __attribute__((address_space(3)))
typedef unsigned short bf16_t;
typedef short bf16x8 __attribute__((ext_vector_type(8)));
typedef float f32x4 __attribute__((ext_vector_type(4)));
typedef unsigned u32x4 __attribute__((ext_vector_type(4)));
constexpr int BM = 256, BK = 64, HALF = 128, HTB = HALF * BK * 2  , STAGE_BYTES = 8 * HTB, NXCD = 8, WGM = 8;

__host__ __device__ __forceinline__ int lds_byte(int r, int c) { const int st = (r >> 4) * 2 + (c >> 5), rr = r & 15, cc = c & 31, ob = rr * 64 + cc * 2; return st * 1024 + (ob ^ (((ob >> 9) & 1) << 5)); }
__host__ __device__ __forceinline__ void stage_rc(int b, int& R, int& C) { const int st = b / 1024, sb = b % 1024, swz = sb ^ (((sb >> 9) & 1) << 5); R = (st >> 1) * 16 + swz / 64; C = (st & 1) * 32 + (swz % 64) / 2; }
__host__ __device__ __forceinline__ int perm32(int rho) { const int n = rho >> 4, i = rho & 15; return 8 * (i >> 2) + 4 * n + (i & 3); }

struct Unit { int pm, pn; };
struct Gemm { const bf16_t* A; const bf16_t* Bt; int M, N, K, lda, ldb; };

struct StaticOrder {
    int nM, nN, nwg, G, c;
    __host__ __device__ void init(int M, int N, int G_, int c_) { nM = M / BM; nN = N / BM; nwg = nM * nN; G = G_; c = c_; }
    __host__ __device__ bool next(int i, Unit& u) const {
        const long L = (long)i * G + c; if (L >= nwg) return false;
        int wgid = (int)L; { const int q = nwg / NXCD, r = nwg % NXCD, xcd = wgid % NXCD, off = wgid / NXCD; wgid = (xcd < r ? xcd * (q + 1) : r * (q + 1) + (xcd - r) * q) + off; }
        const int nig = WGM * nN, gid = wgid / nig, fm = gid * WGM, gsz = (nM - fm) < WGM ? (nM - fm) : WGM;
        u.pm = fm + ((wgid % nig) % gsz); u.pn = (wgid % nig) / gsz; return true;
    }
    __device__ __forceinline__ void a_ready(const Unit&) const {}
    __device__ __forceinline__ void done(const Unit&) const {}
};

__device__ __forceinline__ unsigned cvt_pk_bf16(float lo, float hi) { unsigned r; asm volatile("v_cvt_pk_bf16_f32 %0, %1, %2" : "=v"(r) : "v"(lo), "v"(hi)); return r; }
typedef float f32x2 __attribute__((ext_vector_type(2)));
__device__ __forceinline__ f32x2 gelu_pk(f32x2 v) {
    const f32x2 av = __builtin_elementwise_abs(v), d = av * 0.2316418882f + 1.0f;
    f32x2 t; t.x = __builtin_amdgcn_rcpf(d.x); t.y = __builtin_amdgcn_rcpf(d.y);
    f32x2 q = t * 0.5307027145f + (-0.7265760135f); q = q * t + 0.7107068705f; q = q * t + (-0.142248368f); q = q * t + 0.127414796f; q = q * t;
    const f32x2 s = (v * v) * (-0.72134752044f);
    f32x2 e; e.x = __builtin_amdgcn_exp2f(s.x); e.y = __builtin_amdgcn_exp2f(s.y);
    const f32x2 m = v * (q * e), r = v - m;
    f32x2 o; o.x = v.x < 0.f ? m.x : r.x; o.y = v.y < 0.f ? m.y : r.y; return o;
}

template <int ACT  > struct EpiBf16 {
    static constexpr bool PERM = true, AFTER_DRAIN = false; static_assert(ACT == 0 || ACT == 1, "EpiBf16: ACT is 0 (none) or 1 (gelu_pk)");
    bf16_t* O; int ldc; const float* bias; int split_cols; size_t split_stride; float scale0;
    __device__ __forceinline__ void operator()(const f32x4 (&acc)[2][2][4][2], const Unit& u, int wr, int wc, int fr, int fq) const {
        const int row0 = u.pm * BM + wr * 64 + fr; int colt = u.pn * BM; bf16_t* base = O;
        float sc = 1.f; if (split_cols) { const int t = colt / split_cols; base += (size_t)t * split_stride; colt -= t * split_cols; if (t == 0) sc = scale0; }
        const int col0 = colt + wc * 32 + 8 * fq, bcol0 = u.pn * BM + wc * 32 + 8 * fq;
        f32x4 bv[2][2];
#pragma unroll
        for (int bj = 0; bj < 2; ++bj)
#pragma unroll
            for (int n = 0; n < 2; ++n) bv[bj][n] = bias ? *(const f32x4*)(bias + bcol0 + bj * HALF + 4 * n) : (f32x4){0.f, 0.f, 0.f, 0.f};
#pragma unroll
        for (int ai = 0; ai < 2; ++ai)
#pragma unroll
            for (int m = 0; m < 4; ++m) { bf16_t* rowp = base + (size_t)(row0 + ai * HALF + m * 16) * ldc + col0;
#pragma unroll
                for (int bj = 0; bj < 2; ++bj) { f32x4 v0 = acc[ai][bj][m][0] + bv[bj][0], v1 = acc[ai][bj][m][1] + bv[bj][1];
                    if (ACT == 1) { f32x2 a = gelu_pk((f32x2){v0[0], v0[1]}), b = gelu_pk((f32x2){v0[2], v0[3]}), c = gelu_pk((f32x2){v1[0], v1[1]}), d = gelu_pk((f32x2){v1[2], v1[3]});
                        v0 = (f32x4){a.x, a.y, b.x, b.y}; v1 = (f32x4){c.x, c.y, d.x, d.y}; }
                    v0 = v0 * sc; v1 = v1 * sc; u32x4 w; w.x = cvt_pk_bf16(v0[0], v0[1]); w.y = cvt_pk_bf16(v0[2], v0[3]); w.z = cvt_pk_bf16(v1[0], v1[1]); w.w = cvt_pk_bf16(v1[2], v1[3]);
                    *(__attribute__((address_space(1))) u32x4*)(rowp + bj * HALF) = w; } }
    }
};
template <class Epi, class Sched, bool ALIGN_EPI = false, bool SP2 = false>
__device__ __forceinline__ void gemm_phase(PG8_LAS unsigned char* lds, const Gemm g, const Sched& S, const Epi& E, const int tid) {
    const int wid = __builtin_amdgcn_readfirstlane(tid >> 6), lane = tid & 63, wr = wid >> 2, wc = wid & 3, fr = lane & 15, fq = lane >> 4;
    const int K = g.K, nt = K / BK;
    unsigned voffA[2], voffB[2];
#pragma unroll
    for (int i = 0; i < 2; ++i) { int R, C; stage_rc(tid * 16 + i * 8192, R, C); const int Rb = Epi::PERM ? ((R & ~31) + perm32(R & 31)) : R;
        voffA[i] = (unsigned)(R * g.lda + C) * 2u; voffB[i] = (unsigned)(Rb * g.ldb + C) * 2u; }
    const size_t kstep = (size_t)(BK * 2);
    const size_t hstepA = (size_t)HALF * g.lda * 2, hstepB = (size_t)HALF * g.ldb * 2;
    const size_t tstepA = 2 * hstepA, tstepB = 2 * hstepB;
    const unsigned ldsw = (unsigned)wid * 1024u;
    const int aoff = lds_byte(wr * 64 + fr, fq * 8), boff = lds_byte(wc * 32 + fr, fq * 8);
#define PG8_SA(b, h) (((b) * 2 + (h)) * HTB)
#define PG8_SB(b, h) ((4 + (b) * 2 + (h)) * HTB)
#define PG8_STAGE(bufoff, gbase, voff) do { _Pragma("unroll") for (int _i = 0; _i < 2; ++_i) \
        __builtin_amdgcn_global_load_lds((const unsigned*)((const char*)(gbase) + (voff)[_i]), (PG8_LAS unsigned*)(lds + (bufoff) + ldsw + _i * 8192), 16, 0, 0); } while (0)
#define PG8_LDA(dst, b, h) do { _Pragma("unroll") for (int m = 0; m < 4; ++m) _Pragma("unroll") for (int k = 0; k < 2; ++k) dst[m][k] = *(const PG8_LAS bf16x8*)(lds + PG8_SA(b, h) + aoff + m * 2048 + k * 1024); } while (0)
#define PG8_LDB(dst, b, h) do { _Pragma("unroll") for (int n = 0; n < 2; ++n) _Pragma("unroll") for (int k = 0; k < 2; ++k) dst[n][k] = *(const PG8_LAS bf16x8*)(lds + PG8_SB(b, h) + boff + n * 2048 + k * 1024); } while (0)
#define PG8_MMA(ai, bj, At, Bt) do { __builtin_amdgcn_s_setprio(1); _Pragma("unroll") for (int m = 0; m < 4; ++m) _Pragma("unroll") for (int n = 0; n < 2; ++n) _Pragma("unroll") for (int k = 0; k < 2; ++k) \
        acc[ai][bj][m][n] = __builtin_amdgcn_mfma_f32_16x16x32_bf16(Bt[n][k], At[m][k], acc[ai][bj][m][n], 0, 0, 0); __builtin_amdgcn_s_setprio(0); } while (0)
#define PG8_WAIT_V(n) asm volatile("s_waitcnt vmcnt(" #n ")" ::: "memory")
#define PG8_WAIT_L(n) asm volatile("s_waitcnt lgkmcnt(" #n ")" ::: "memory")
#define PG8_BAR __builtin_amdgcn_s_barrier()
#define PG8_SCHED __builtin_amdgcn_sched_barrier(0)
    Unit cur, nxt; int ui = 0;
    if (!S.next(0, cur)) return;
    f32x4 acc[2][2][4][2];
#pragma unroll
    for (int a = 0; a < 2; ++a)
#pragma unroll
        for (int b = 0; b < 2; ++b)
#pragma unroll
            for (int m = 0; m < 4; ++m)
#pragma unroll
                for (int n = 0; n < 2; ++n) acc[a][b][m][n] = (f32x4){0.f, 0.f, 0.f, 0.f};
    bf16x8 At[4][2], B0[2][2], B1[2][2];
    const char* cA = (const char*)g.A + (size_t)cur.pm * tstepA; const char* cB = (const char*)g.Bt + (size_t)cur.pn * tstepB;
    S.a_ready(cur);
    if constexpr (SP2) {
        PG8_STAGE(PG8_SB(0, 0), cB, voffB); PG8_STAGE(PG8_SB(0, 1), cB + hstepB, voffB); PG8_STAGE(PG8_SA(0, 0), cA, voffA); PG8_STAGE(PG8_SA(0, 1), cA + hstepA, voffA);
        if (wr == 1) PG8_BAR;
        PG8_WAIT_V(2); PG8_BAR;
        PG8_STAGE(PG8_SB(1, 0), cB + kstep, voffB); PG8_STAGE(PG8_SA(1, 0), cA + kstep, voffA); PG8_STAGE(PG8_SB(1, 1), cB + hstepB + kstep, voffB);
        PG8_WAIT_V(6); PG8_BAR;
    } else {
        PG8_STAGE(PG8_SB(0, 0), cB, voffB); PG8_STAGE(PG8_SA(0, 0), cA, voffA); PG8_STAGE(PG8_SB(0, 1), cB + hstepB, voffB); PG8_STAGE(PG8_SA(0, 1), cA + hstepA, voffA);
        if (wr == 1) PG8_BAR;
        PG8_WAIT_V(4); PG8_BAR;
        PG8_STAGE(PG8_SB(1, 0), cB + kstep, voffB); PG8_STAGE(PG8_SA(1, 0), cA + kstep, voffA); PG8_STAGE(PG8_SB(1, 1), cB + hstepB + kstep, voffB);
        PG8_WAIT_V(6); PG8_BAR;
    }
    for (;;) {
        const bool has_next = S.next(ui + 1, nxt);
        const char* nA = has_next ? (const char*)g.A + (size_t)nxt.pm * tstepA : cA; const char* nB = has_next ? (const char*)g.Bt + (size_t)nxt.pn * tstepB : cB;
        for (int t = 0; t < nt; t += 2) {
            const bool last = (t == nt - 2);
            const char* a1 = cA + (size_t)(t + 1) * kstep;
            const char* a2 = last ? nA : cA + (size_t)(t + 2) * kstep; const char* b2 = last ? nB : cB + (size_t)(t + 2) * kstep;
            const char* a3 = a2 + kstep; const char* b3 = b2 + kstep;
            if (last && has_next) S.a_ready(nxt);
            if constexpr (SP2) {
            PG8_LDB(B0, 0, 0); PG8_LDB(B1, 0, 1); PG8_SCHED; PG8_LDA(At, 0, 0); PG8_STAGE(PG8_SA(1, 1), a1 + hstepA, voffA);
            PG8_WAIT_V(8); PG8_WAIT_L(0); PG8_BAR; PG8_MMA(0, 0, At, B0); PG8_MMA(0, 1, At, B1); PG8_BAR; PG8_SCHED;
            PG8_LDA(At, 0, 1); PG8_STAGE(PG8_SB(0, 0), b2, voffB); PG8_STAGE(PG8_SB(0, 1), b2 + hstepB, voffB); PG8_STAGE(PG8_SA(0, 0), a2, voffA);
            PG8_WAIT_V(8); PG8_WAIT_L(0); PG8_BAR; PG8_MMA(1, 0, At, B0); PG8_MMA(1, 1, At, B1); PG8_BAR; PG8_SCHED;
            PG8_LDB(B0, 1, 0); PG8_LDB(B1, 1, 1); PG8_SCHED; PG8_LDA(At, 1, 0); PG8_STAGE(PG8_SA(0, 1), a2 + hstepA, voffA);
            PG8_WAIT_V(8); PG8_WAIT_L(0); PG8_BAR; PG8_MMA(0, 0, At, B0); PG8_MMA(0, 1, At, B1); PG8_BAR; PG8_SCHED;
            PG8_LDA(At, 1, 1); PG8_STAGE(PG8_SB(1, 0), b3, voffB); PG8_STAGE(PG8_SB(1, 1), b3 + hstepB, voffB); PG8_STAGE(PG8_SA(1, 0), a3, voffA);
            PG8_WAIT_V(8); PG8_WAIT_L(0); PG8_BAR; PG8_MMA(1, 0, At, B0); PG8_MMA(1, 1, At, B1); PG8_BAR; PG8_SCHED;
            } else {
            PG8_LDB(B0, 0, 0); PG8_SCHED; PG8_LDA(At, 0, 0); PG8_STAGE(PG8_SA(1, 1), a1 + hstepA, voffA);
            PG8_WAIT_L(8); PG8_BAR; PG8_WAIT_L(0); PG8_MMA(0, 0, At, B0); PG8_BAR; PG8_SCHED;
            PG8_LDB(B1, 0, 1); PG8_STAGE(PG8_SB(0, 0), b2, voffB);
            PG8_BAR; PG8_WAIT_L(0); PG8_MMA(0, 1, At, B1); PG8_BAR;
            PG8_LDA(At, 0, 1); PG8_STAGE(PG8_SA(0, 0), a2, voffA);
            PG8_BAR; PG8_WAIT_L(0); PG8_MMA(1, 0, At, B0); PG8_BAR; PG8_SCHED;
            PG8_STAGE(PG8_SB(0, 1), b2 + hstepB, voffB);
            PG8_WAIT_V(6); PG8_BAR; PG8_MMA(1, 1, At, B1); PG8_BAR;
            PG8_LDB(B0, 1, 0); PG8_SCHED; PG8_LDA(At, 1, 0); PG8_STAGE(PG8_SA(0, 1), a2 + hstepA, voffA);
            PG8_WAIT_L(8); PG8_BAR; PG8_WAIT_L(0); PG8_MMA(0, 0, At, B0); PG8_BAR; PG8_SCHED;
            PG8_LDB(B1, 1, 1); PG8_STAGE(PG8_SB(1, 0), b3, voffB);
            PG8_BAR; PG8_WAIT_L(0); PG8_MMA(0, 1, At, B1); PG8_BAR;
            PG8_LDA(At, 1, 1); PG8_STAGE(PG8_SA(1, 0), a3, voffA);
            PG8_BAR; PG8_WAIT_L(0); PG8_MMA(1, 0, At, B0); PG8_BAR; PG8_SCHED;
            PG8_STAGE(PG8_SB(1, 1), b3 + hstepB, voffB);
            PG8_WAIT_V(6); PG8_BAR; PG8_MMA(1, 1, At, B1); PG8_BAR;
            }
        }
        if constexpr (ALIGN_EPI) { if (wr == 0) PG8_BAR; }
        if constexpr (!Epi::AFTER_DRAIN) { E(acc, cur, wr, wc, fr, fq); S.done(cur); }
        if (!has_next) break;
#pragma unroll
        for (int a = 0; a < 2; ++a)
#pragma unroll
            for (int b = 0; b < 2; ++b)
#pragma unroll
                for (int m = 0; m < 4; ++m)
#pragma unroll
                    for (int n = 0; n < 2; ++n) acc[a][b][m][n] = (f32x4){0.f, 0.f, 0.f, 0.f};
        cur = nxt; cA = nA; cB = nB; ++ui;
        if constexpr (ALIGN_EPI) { if (wr == 1) PG8_BAR; }
    }
    PG8_WAIT_V(0);
    if constexpr (!ALIGN_EPI) { if (wr == 0) PG8_BAR; }
    PG8_BAR;
    if constexpr (Epi::AFTER_DRAIN) { E.fused(acc, cur, wr, wc, fr, fq, lds, wid, lane); S.done(cur); }
#undef PG8_SA
#undef PG8_SB
#undef PG8_STAGE
#undef PG8_LDA
#undef PG8_LDB
#undef PG8_MMA
#undef PG8_WAIT_V
#undef PG8_WAIT_L
#undef PG8_BAR
#undef PG8_SCHED
}
}
#define LAS __attribute__((address_space(3)))
#define GAS __attribute__((address_space(1)))
typedef unsigned short bf16_t;
typedef short bf16x8 __attribute__((ext_vector_type(8)));
typedef short s16x4 __attribute__((ext_vector_type(4)));
typedef float f32x4 __attribute__((ext_vector_type(4)));
typedef float f32x16 __attribute__((ext_vector_type(16)));
typedef unsigned u32x4 __attribute__((ext_vector_type(4)));
typedef unsigned u32x2 __attribute__((ext_vector_type(2)));
typedef float f32x2 __attribute__((ext_vector_type(2)));

constexpr int NB = 8, SEQ = 8192, DM = 1024, CTX = 256, MLAT = NB * SEQ, MCTX = NB * CTX, MALL = MLAT + MCTX;
constexpr int PW = 1536, KVLEN = CTX + SEQ, DFF = 2816, NMOD = 6 * DM;
constexpr int NCH = 32, CHL = 256;
constexpr float EPS = 1e-6f;
constexpr float QSCALE = 0.10206207261596575f * 1.4426950408889634f;
constexpr size_t MiB = 1u << 20;
constexpr size_t WS_CTL = 0, CTL_BYTES = 2 * MiB;
constexpr size_t WS_MOD = 64 * 1024, WS_SSQ = 512 * 1024, WS_SSKV = 1024 * 1024, WS_BAR = 1600 * 1024;
constexpr size_t WS_WIN = 2 * MiB, WS_WQ = 5 * MiB, WS_WKV = 6 * MiB, WS_WG = 7 * MiB, WS_WOUT = 8 * MiB, WS_WUP = 10 * MiB, WS_WDN = 21 * MiB;
constexpr size_t WS_AGG = 27 * MiB, WS_ROPE = 29 * MiB + 512 * 1024;
constexpr size_t WS_R1 = 30 * MiB;
constexpr size_t WS_R2 = 162 * MiB;
constexpr size_t WS_LU = 360 * MiB, WS_K = 624 * MiB, WS_V = 723 * MiB, WS_A2 = 789 * MiB;
constexpr size_t WS_UP = 360 * MiB, WS_G = 712 * MiB, WS_Q = 920 * MiB, WS_X1 = 888 * MiB, WS_END = 1016 * MiB;
constexpr int LDS_BYTES = 139264;
constexpr int LDS_MISC = 131072 + 64;

__device__ __forceinline__ unsigned f2bf(float f) { unsigned u = __builtin_bit_cast(unsigned, f); return (u + 0x7fffu + ((u >> 16) & 1u)) >> 16; }
__device__ __forceinline__ unsigned cvtpk(float lo, float hi) { typedef float f2 __attribute__((ext_vector_type(2))); typedef __bf16 b2 __attribute__((ext_vector_type(2))); f2 v = {lo, hi}; b2 r = __builtin_convertvector(v, b2); return __builtin_bit_cast(unsigned, r); }
__device__ __forceinline__ unsigned pk2(float lo, float hi) { return cvtpk(lo, hi); }
__device__ __forceinline__ float bflo(unsigned w) { return __uint_as_float(w << 16); }
__device__ __forceinline__ float bfhi(unsigned w) { return __uint_as_float(w & 0xffff0000u); }
__device__ __forceinline__ float bf2f(bf16_t v) { return __uint_as_float((unsigned)v << 16); }
__device__ __forceinline__ int crow(int r, int hi) { return (r & 3) + 8 * (r >> 2) + 4 * hi; }
__device__ __forceinline__ float wave_sum(float v) {
#pragma unroll
    for (int o = 1; o < 64; o <<= 1) v += __shfl_xor(v, o);
    return v;
}
__device__ __forceinline__ float sigmoidf_(float x) { return __builtin_amdgcn_rcpf(1.f + __builtin_amdgcn_exp2f(-1.4426950408889634f * x)); }
#define LDS_WAIT() asm volatile("s_waitcnt lgkmcnt(0)" ::: "memory")
#define XB_TMO      128
#define XB_XCNT(j)  (256  + 64 * (j))
#define XB_XSUB(j)  (1280 + 64 * (j))
#define XB_XGEN(j)  (2304 + 64 * (j))
#define XB_TOP      3328
#define XB_TOPGEN   3392
#define XCD_BAR_WORDS 3456
#define XB_SPIN_CAP (1u << 18)

__device__ __forceinline__ unsigned xb_ld(unsigned* p)              { return __hip_atomic_load(p, __ATOMIC_RELAXED, __HIP_MEMORY_SCOPE_AGENT); }
__device__ __forceinline__ unsigned xb_add(unsigned* p, unsigned v) { return __hip_atomic_fetch_add(p, v, __ATOMIC_RELAXED, __HIP_MEMORY_SCOPE_AGENT); }
__device__ __forceinline__ unsigned xb_xcc_id() { return (unsigned)__builtin_amdgcn_s_getreg((3 << 11) | 20) & 0xFu; }
#define XB_SPIN(cond, bar) do { unsigned _sp = 0; while (cond) { __builtin_amdgcn_s_sleep(1); \
    if ((++_sp & 255u) == 0u) { if (xb_ld(&(bar)[XB_TMO])) break; if (_sp > XB_SPIN_CAP) { atomicAdd(&(bar)[XB_TMO], 1u); break; } } } } while (0)

struct XcdBarrier {
    unsigned* bar; unsigned x;
    volatile LAS unsigned* st;
};

__device__ __forceinline__ XcdBarrier xcd_barrier_post(unsigned* bar, volatile LAS unsigned* st) {
    XcdBarrier b; b.bar = bar; b.x = xb_xcc_id(); b.st = st;
    if (threadIdx.x == 0) (void)xb_add(&bar[XB_XCNT(b.x)], 1u);
    return b;
}
__device__ __forceinline__ void xcd_barrier_complete(unsigned* bar, unsigned x, unsigned& nloc, unsigned& nx) {
    const unsigned G = gridDim.x * gridDim.y * gridDim.z;
    unsigned sum, cnt, mine, sp = 0u;
    for (;;) {
        sum = 0u; cnt = 0u; mine = 0u;
#pragma unroll
        for (unsigned j = 0; j < 16; ++j) { const unsigned c = xb_ld(&bar[XB_XCNT(j)]); sum += c; cnt += (c > 0u) ? 1u : 0u; mine = (j == x) ? c : mine; }
        if (sum == G) break;
        __builtin_amdgcn_s_sleep(1);
        if ((++sp & 255u) == 0u) { if (xb_ld(&bar[XB_TMO])) break; if (sp > XB_SPIN_CAP) { atomicAdd(&bar[XB_TMO], 1u); break; } }
    }
    nloc = mine > 0u ? mine : 1u; nx = cnt > 0u ? cnt : 1u;
}

__device__ __forceinline__ void xcd_barrier(const XcdBarrier& b) {
    asm volatile("s_waitcnt vmcnt(0)" ::: "memory");
    __syncthreads();
    if (threadIdx.x == 0) {
        unsigned* bar = b.bar;
        __builtin_amdgcn_s_waitcnt(0);
        unsigned nloc = b.st[0], nx = b.st[1];
        if (nloc == 0u) { xcd_barrier_complete(bar, b.x, nloc, nx); b.st[0] = nloc; b.st[1] = nx; }
        const unsigned old = xb_add(&bar[XB_XSUB(b.x)], 1u);
        const unsigned gen = old / nloc;
        if (old + 1u == (gen + 1u) * nloc) {
            __builtin_amdgcn_fence(__ATOMIC_RELEASE, "agent");
            asm volatile("s_waitcnt vmcnt(0)" ::: "memory");
            const unsigned og = xb_add(&bar[XB_TOP], 1u);
            const unsigned tg = og / nx;
            if (og + 1u == (tg + 1u) * nx) xb_add(&bar[XB_TOPGEN], 1u);
            else XB_SPIN(xb_ld(&bar[XB_TOPGEN]) == tg, bar);
            __builtin_amdgcn_fence(__ATOMIC_ACQUIRE, "agent");
            xb_add(&bar[XB_XGEN(b.x)], 1u);
            asm volatile("s_waitcnt vmcnt(0)" ::: "memory");
        } else {
            XB_SPIN(xb_ld(&bar[XB_XGEN(b.x)]) == gen, bar);
            __builtin_amdgcn_fence(__ATOMIC_ACQUIRE, "agent");
            asm volatile("s_waitcnt vmcnt(0)" ::: "memory");
        }
    }
    __syncthreads();
}


struct Args { const float* in[27]; float* out; unsigned char* ws; int ph_lo, ph_hi; };
__device__ __forceinline__ const GAS float* argp(int i) {
    const __attribute__((address_space(4))) char* kp = (const __attribute__((address_space(4))) char*)__builtin_amdgcn_kernarg_segment_ptr();
    asm volatile("" : "+s"(kp));
    const float* p = *(const float* const __attribute__((address_space(4)))*)(kp + 8 * i);
    return (const GAS float*)p;
}

template <int ID> __device__ __forceinline__ float wsrc(const GAS float* __restrict__ p0, const GAS float* __restrict__ p1, int n, int k) {
    if (ID == 0) return n < 1440 ? p0[(size_t)k * 1440 + n] : 0.f;
    if (ID == 1) return p0[k] * p1[(size_t)k * 768 + n];
    if (ID == 2) return k < 128 ? p0[k] * p1[(size_t)k * 1024 + n] : 0.f;
    if (ID == 3) { const int h = n >> 8, np = n & 255, mat = np >> 6, j = np & 63, dir = mat >> 1; const GAS float* w = (mat & 1) ? p1 : p0; return w[(size_t)((dir * 8 + h) * 64 + k) * 64 + j]; }
    if (ID == 4) return p0[(size_t)k * 1024 + n];
    if (ID == 5) return p0[(size_t)k * 5632 + n];
    return p0[(size_t)k * 1024 + n];
}
template <int ID> __device__ __forceinline__ void prep_mat(const GAS float* __restrict__ p0, const GAS float* __restrict__ p1, GAS bf16_t* __restrict__ dst, int N, int K, int gtid, int NT) {
    const int items = N * (K / 8);
    for (int it = gtid; it < items; it += NT) {
        const int nl = it & 7, kl = (it >> 3) & 7, rest = it >> 6, nb = rest % (N / 8), kb = rest / (N / 8), n = nb * 8 + nl, k8 = kb * 8 + kl;
        u32x4 o;
        o.x = pk2(wsrc<ID>(p0, p1, n, 8 * k8 + 0), wsrc<ID>(p0, p1, n, 8 * k8 + 1)); o.y = pk2(wsrc<ID>(p0, p1, n, 8 * k8 + 2), wsrc<ID>(p0, p1, n, 8 * k8 + 3));
        o.z = pk2(wsrc<ID>(p0, p1, n, 8 * k8 + 4), wsrc<ID>(p0, p1, n, 8 * k8 + 5)); o.w = pk2(wsrc<ID>(p0, p1, n, 8 * k8 + 6), wsrc<ID>(p0, p1, n, 8 * k8 + 7));
        *(GAS u32x4*)(dst + (size_t)n * K + 8 * k8) = o;
    }
}
__device__ __forceinline__ void mod_phase(const GAS float* __restrict__ cvec, const GAS float* __restrict__ cctx, const GAS float* __restrict__ wmod, const GAS float* __restrict__ bmod, GAS float* __restrict__ mod, LAS float* scr, int gw, int NGW, int lane) {
    for (int task = gw; task < 96 * 16; task += NGW) {
        const int cgp = task % 96, kc = task / 96, n = cgp * 64 + lane, k0 = kc * 64;
#pragma unroll
        for (int r = 0; r < 9; ++r) { const float cv = r < 8 ? cvec[r * 1024 + k0 + lane] : cctx[k0 + lane]; scr[r * 64 + lane] = cv / (1.f + __expf(-cv)); }
        LDS_WAIT();
        float acc[9];
#pragma unroll
        for (int r = 0; r < 9; ++r) acc[r] = 0.f;
#pragma unroll 8
        for (int kk = 0; kk < 64; ++kk) { const float w = wmod[(size_t)(k0 + kk) * NMOD + n];
#pragma unroll
            for (int r = 0; r < 9; ++r) acc[r] += scr[r * 64 + kk] * w; }
        const float bias = kc == 0 ? bmod[n] : 0.f;
#pragma unroll
        for (int r = 0; r < 9; ++r) atomicAdd((float*)(mod + r * NMOD + n), acc[r] + bias);
        LDS_WAIT();
    }
}
__device__ __forceinline__ void p1_rows(const GAS float* __restrict__ x, const GAS float* __restrict__ ctx, const GAS float* __restrict__ g, const GAS float* __restrict__ mod, GAS bf16_t* __restrict__ H, int gw, int NGW, int lane) {
    for (int m0 = 2 * gw; m0 < MALL; m0 += 2 * NGW) {
        f32x4 v[2][4]; float ss[2];
#pragma unroll
        for (int r = 0; r < 2; ++r) { const int m = m0 + r; const GAS float* src = m < MLAT ? x + (size_t)m * DM : ctx + (size_t)(m - MLAT) * DM; ss[r] = 0.f;
#pragma unroll
            for (int j = 0; j < 4; ++j) { v[r][j] = __builtin_nontemporal_load((const GAS f32x4*)(src + 4 * lane + 256 * j)); ss[r] += v[r][j].x * v[r][j].x + v[r][j].y * v[r][j].y + v[r][j].z * v[r][j].z + v[r][j].w * v[r][j].w; } }
#pragma unroll
        for (int r = 0; r < 2; ++r) { const int m = m0 + r; const GAS float* md = mod + (m < MLAT ? (m >> 13) : 8) * NMOD;
            const float rs = rsqrtf(wave_sum(ss[r]) * (1.f / DM) + EPS);
#pragma unroll
            for (int j = 0; j < 4; ++j) { const int k = 4 * lane + 256 * j;
                const f32x4 gg = *(const GAS f32x4*)(g + k), sh = *(const GAS f32x4*)(md + k), sc = *(const GAS f32x4*)(md + DM + k);
                const f32x4 y = v[r][j] * rs * gg * (sc + 1.f) + sh;
                u32x2 o; o.x = pk2(y.x, y.y); o.y = pk2(y.z, y.w); *(GAS u32x2*)(H + (size_t)m * DM + k) = o; } }
    }
}
__device__ __forceinline__ void ss_phase(const GAS bf16_t* __restrict__ P, GAS float* __restrict__ ssq, GAS float* __restrict__ sskv, int gw, int NGW, int lane) {
#pragma unroll 4
    for (int m = gw; m < MALL; m += NGW) {
        const u32x2 q = *(const GAS u32x2*)(P + (size_t)m * PW + 1024 + 4 * lane); const unsigned k = *(const GAS unsigned*)(P + (size_t)m * PW + 1280 + 2 * lane);
        float a = bflo(q.x) * bflo(q.x) + bfhi(q.x) * bfhi(q.x) + bflo(q.y) * bflo(q.y) + bfhi(q.y) * bfhi(q.y), c = bflo(k) * bflo(k) + bfhi(k) * bfhi(k);
        a = wave_sum(a); c = wave_sum(c);
        if (lane == 0) { ssq[m] = a; sskv[m] = c; }
    }
}
__device__ __forceinline__ void qpost_phase(const GAS bf16_t* __restrict__ QR, const GAS float* __restrict__ ssq, const GAS float* __restrict__ RT, GAS bf16_t* __restrict__ Q, int gtid, int NT) {
#pragma unroll 4
    for (int task = gtid; task < MLAT * 96; task += NT) {
        const int row = task / 96, c8 = task - row * 96, h = c8 / 12, dc = c8 - h * 12, b = row >> 13, s = row & 8191;
        const float sc = rsqrtf(ssq[row] * (1.f / 256.f) + EPS) * QSCALE;
        const u32x4 mine = *(const GAS u32x4*)(QR + (size_t)row * 768 + 8 * c8);
        float v[8];
#pragma unroll
        for (int j = 0; j < 4; ++j) { v[2 * j] = bflo(mine[j]) * sc; v[2 * j + 1] = bfhi(mine[j]) * sc; }
        if (dc >= 8) { const int fq = dc - 8; const u32x4 oth = *(const GAS u32x4*)(QR + (size_t)row * 768 + 8 * (c8 ^ 1));
            const GAS float* rt = RT + (fq < 2 ? (s >> 6) : (s & 63)) * 16;
#pragma unroll
            for (int j = 0; j < 8; ++j) { const float pt = ((j & 1) ? bfhi(oth[j >> 1]) : bflo(oth[j >> 1])) * sc, cs = rt[2 * j], sn = rt[2 * j + 1];
                v[j] = (fq & 1) ? v[j] * cs + pt * sn : v[j] * cs - pt * sn; } }
        u32x4 w; w.x = pk2(v[0], v[1]); w.y = pk2(v[2], v[3]); w.z = pk2(v[4], v[5]); w.w = pk2(v[6], v[7]);
        *(GAS u32x4*)(Q + ((size_t)((b * 8 + h) * SEQ + s)) * 96 + 8 * dc) = w;
    }
}
__device__ __forceinline__ void kvpost_phase(const GAS bf16_t* __restrict__ KVR, const GAS float* __restrict__ sskv, GAS bf16_t* __restrict__ Kb, GAS bf16_t* __restrict__ Vt, int gtid, int NT) {
#pragma unroll 4
    for (int task = gtid; task < MALL * 64; task += NT) {
        const int row = task >> 6, c = task & 63, h = c >> 3, dd = (c & 7) * 8; const bool lat = row < MLAT;
        const int b = lat ? (row >> 13) : ((row - MLAT) >> 8), pos = lat ? (CTX + (row & 8191)) : ((row - MLAT) & 255);
        const float rs = rsqrtf(sskv[row] * (1.f / 128.f) + EPS);
        const u32x4 mine = __builtin_nontemporal_load((const GAS u32x4*)(KVR + (size_t)row * 1024 + h * 128 + dd));
        u32x4 w;
#pragma unroll
        for (int j = 0; j < 4; ++j) w[j] = pk2(bflo(mine[j]) * rs, bfhi(mine[j]) * rs);
        *(GAS u32x4*)(Kb + ((size_t)(b * 8 + h) * KVLEN + pos) * 96 + dd) = w;
    }
#pragma unroll 2
    for (int task = gtid; task < (MALL / 8) * 128; task += NT) {
        const int pg = task & 7, dq = (task >> 3) & 7, rest = task >> 6, hd32 = rest & 15, rb = rest >> 4, h = hd32 >> 1, d = (hd32 & 1) * 32 + 4 * dq, row0 = rb * 64 + pg * 8; const bool lat = row0 < MLAT;
        const int b = lat ? (row0 >> 13) : ((row0 - MLAT) >> 8), pos0 = lat ? (CTX + (row0 & 8191)) : ((row0 - MLAT) & 255);
        float v[4][8];
#pragma unroll
        for (int i = 0; i < 8; ++i) { const u32x2 w = __builtin_nontemporal_load((const GAS u32x2*)(KVR + (size_t)(row0 + i) * 1024 + h * 128 + 64 + d)); const float rs = rsqrtf(sskv[row0 + i] * (1.f / 128.f) + EPS);
            v[0][i] = bflo(w.x) * rs; v[1][i] = bfhi(w.x) * rs; v[2][i] = bflo(w.y) * rs; v[3][i] = bfhi(w.y) * rs; }
        GAS bf16_t* vp = Vt + ((size_t)((b * 8 + h) * 64 + d)) * KVLEN + pos0;
#pragma unroll
        for (int j = 0; j < 4; ++j) { u32x4 w; w.x = pk2(v[j][0], v[j][1]); w.y = pk2(v[j][2], v[j][3]); w.z = pk2(v[j][4], v[j][5]); w.w = pk2(v[j][6], v[j][7]);
            *(GAS u32x4*)(vp + (size_t)j * KVLEN) = w; }
    }
}
__device__ __forceinline__ void krope_phase(const GAS bf16_t* __restrict__ P, GAS bf16_t* __restrict__ Kb, const GAS float* __restrict__ RT, int gtid, int NT) {
#pragma unroll 2
    for (int task = gtid; task < MALL * 4; task += NT) {
        const int row = task >> 2, fq = task & 3; const bool lat = row < MLAT;
        const int b = lat ? (row >> 13) : ((row - MLAT) >> 8), s = row & 8191, pos = lat ? (CTX + s) : ((row - MLAT) & 255);
        const u32x4 mine = *(const GAS u32x4*)(P + (size_t)row * PW + 1408 + 8 * fq), oth = *(const GAS u32x4*)(P + (size_t)row * PW + 1408 + 8 * (fq ^ 1));
        float v[8], pt[8];
#pragma unroll
        for (int j = 0; j < 4; ++j) { v[2 * j] = bflo(mine[j]); v[2 * j + 1] = bfhi(mine[j]); pt[2 * j] = bflo(oth[j]); pt[2 * j + 1] = bfhi(oth[j]); }
        if (lat) { const GAS float* rt = RT + (fq < 2 ? (s >> 6) : (s & 63)) * 16;
#pragma unroll
            for (int j = 0; j < 8; ++j) { const float cs = rt[2 * j], sn = rt[2 * j + 1]; v[j] = (fq & 1) ? v[j] * cs + pt[j] * sn : v[j] * cs - pt[j] * sn; } }
        u32x4 w; w.x = pk2(v[0], v[1]); w.y = pk2(v[2], v[3]); w.z = pk2(v[4], v[5]); w.w = pk2(v[6], v[7]);
#pragma unroll
        for (int h = 0; h < 8; ++h) *(GAS u32x4*)(Kb + ((size_t)(b * 8 + h) * KVLEN + pos) * 96 + 64 + 8 * fq) = w;
    }
}
#define MFMA32(a, b, c) __builtin_amdgcn_mfma_f32_32x32x16_bf16((a), (b), (c), 0, 0, 0)
__device__ __forceinline__ void gates_phase(const GAS float* __restrict__ cw, const GAS float* __restrict__ cb, const GAS float* __restrict__ b_a, const GAS float* __restrict__ b_x, const GAS float* __restrict__ lam, LAS unsigned char* lds, const GAS bf16_t* __restrict__ P, const GAS bf16_t* __restrict__ Wg, GAS unsigned* __restrict__ LU, GAS f32x2* __restrict__ AGG, int tid, int wave, int lane) {
    LAS bf16_t* xs = (LAS bf16_t*)(lds + wave * 4608);
    LAS f32x2* wagg = (LAS f32x2*)(lds + 8 * 4608);
    const int r32 = lane & 31, hi = lane >> 5;
    for (int unit = blockIdx.x; unit < (MALL / 256) * 8; unit += gridDim.x) {
        const int pm = unit >> 3, h = unit & 7, m0 = pm * 256 + wave * 32;
        const int s0 = m0 < MLAT ? (m0 & ~8191) : (MLAT + ((m0 - MLAT) & ~255)), slen = m0 < MLAT ? SEQ : CTX;
        {
            const int tok = lane >> 1, m = m0 + tok;
#pragma unroll
            for (int c8 = 0; c8 < 4; ++c8) { const int ch = (lane & 1) * 32 + c8 * 8, gch = h * 64 + ch;
                float acc[8];
                { const f32x4 b0 = *(const GAS f32x4*)(cb + gch), b1 = *(const GAS f32x4*)(cb + gch + 4);
                  acc[0] = b0.x; acc[1] = b0.y; acc[2] = b0.z; acc[3] = b0.w; acc[4] = b1.x; acc[5] = b1.y; acc[6] = b1.z; acc[7] = b1.w; }
#pragma unroll
                for (int k = 0; k < 4; ++k) { const int mm = m + k - 2;
                    if (mm >= s0 && mm < s0 + slen) { const u32x4 xv = *(const GAS u32x4*)(P + (size_t)mm * PW + gch);
                        const f32x4 w0 = *(const GAS f32x4*)(cw + k * 512 + gch), w1 = *(const GAS f32x4*)(cw + k * 512 + gch + 4);
                        acc[0] += w0.x * bflo(xv.x); acc[1] += w0.y * bfhi(xv.x); acc[2] += w0.z * bflo(xv.y); acc[3] += w0.w * bfhi(xv.y);
                        acc[4] += w1.x * bflo(xv.z); acc[5] += w1.y * bfhi(xv.z); acc[6] += w1.z * bflo(xv.w); acc[7] += w1.w * bfhi(xv.w); } }
                u32x4 o; o.x = pk2(acc[0], acc[1]); o.y = pk2(acc[2], acc[3]); o.z = pk2(acc[4], acc[5]); o.w = pk2(acc[6], acc[7]);
                *(LAS u32x4*)(xs + tok * 72 + ch) = o; }
        }
        LDS_WAIT();
        bf16x8 afr[4];
#pragma unroll
        for (int ks = 0; ks < 4; ++ks) afr[ks] = *(const LAS bf16x8*)(xs + r32 * 72 + 16 * ks + 8 * hi);
#pragma unroll
        for (int jh = 0; jh < 2; ++jh) {
            f32x16 acc4[4];
#pragma unroll
            for (int q = 0; q < 4; ++q) {
#pragma unroll
                for (int i = 0; i < 16; ++i) acc4[q][i] = 0.f;
                const GAS bf16_t* wrow = Wg + (size_t)(h * 256 + (2 * q + jh) * 32 + r32) * 64 + 8 * hi;
#pragma unroll
                for (int ks = 0; ks < 4; ++ks) { const bf16x8 bfr = *(const GAS bf16x8*)(wrow + 16 * ks); acc4[q] = MFMA32(afr[ks], bfr, acc4[q]); }
            }
            const int ch = jh * 32 + r32, gch = h * 64 + ch;
            float ba[2], bx[2], sp[2];
#pragma unroll
            for (int d = 0; d < 2; ++d) { ba[d] = b_a[d * 512 + gch]; bx[d] = b_x[d * 512 + gch]; sp[d] = lam[d * 512 + gch]; }
            unsigned wv[16][2]; float avs[16][2];
#pragma unroll
            for (int i = 0; i < 16; ++i) { const int row = crow(i, hi); const float xv = bf2f(xs[row * 72 + ch]);
#pragma unroll
                for (int d = 0; d < 2; ++d) { const float r = sigmoidf_(acc4[2 * d][i] + ba[d]), ig = sigmoidf_(acc4[2 * d + 1][i] + bx[d]);
                    const float la2 = bflo(f2bf(-r * sp[d])), av = __builtin_amdgcn_exp2f(la2); avs[i][d] = av;
                    const float uu = __builtin_amdgcn_sqrtf(fmaxf(1.f - av * av, 0.f)) * (ig * xv);
                    wv[i][d] = pk2(la2, uu);
                    __builtin_nontemporal_store(wv[i][d], LU + ((size_t)(m0 + row) * 2 + d) * 512 + gch); } }
#pragma unroll
            for (int d = 0; d < 2; ++d) {
                float Ar[4], Ur[4];
#pragma unroll
                for (int g = 0; g < 4; ++g) { float A = 1.f, U = 0.f;
#pragma unroll
                    for (int jj = 0; jj < 4; ++jj) { const int j = d ? 3 - jj : jj; const unsigned w = wv[4 * g + j][d]; const float av = avs[4 * g + j][d]; A *= av; U = av * U + bfhi(w); }
                    Ar[g] = A; Ur[g] = U; }
                float A = 1.f, U = 0.f;
#pragma unroll
                for (int gg = 0; gg < 4; ++gg) { const int g = d ? 3 - gg : gg;
                    const float Ao = __shfl_xor(Ar[g], 32), Uo = __shfl_xor(Ur[g], 32);
                    if (d == 0) { U = Ar[g] * U + Ur[g]; A *= Ar[g]; U = Ao * U + Uo; A *= Ao; }
                    else        { U = Ao * U + Uo; A *= Ao; U = Ar[g] * U + Ur[g]; A *= Ar[g]; } }
                if (hi == 0) wagg[(wave * 2 + d) * 64 + ch] = (f32x2){A, U};
            }
        }
        LDS_WAIT();
        __syncthreads();
        if (tid < 128) {
            const int d = tid >> 6, ch = tid & 63; float A = 1.f, U = 0.f;
#pragma unroll
            for (int ww = 0; ww < 8; ++ww) { const int w = d ? 7 - ww : ww; const f32x2 g = wagg[(w * 2 + d) * 64 + ch]; U = g.x * U + g.y; A *= g.x; }
            const int b = pm < MLAT / 256 ? (pm >> 5) : (pm - MLAT / 256), c = pm < MLAT / 256 ? (pm & 31) : NCH;
            AGG[(size_t)((b * 2 + d) * (NCH + 1) + c) * 512 + h * 64 + ch] = (f32x2){A, U};
        }
        __syncthreads();
    }
}
__device__ __forceinline__ void scan_agg(const GAS unsigned* __restrict__ LU, GAS f32x2* __restrict__ AGG, int gw, int NGW, int lane) {
    for (int task = gw; task < NB * 2 * (NCH + 1) * 8; task += NGW) {
        const int cgp = task & 7, c = (task >> 3) % (NCH + 1), d = (task / (8 * (NCH + 1))) & 1, b = task / (16 * (NCH + 1));
        const int ch = cgp * 64 + lane, row0 = c < NCH ? b * SEQ + c * CHL : MLAT + b * CTX;
        float A = 1.f, U = 0.f;
#pragma unroll 16
        for (int t = 0; t < CHL; ++t) { const int tt = d ? CHL - 1 - t : t; const unsigned w = LU[((size_t)(row0 + tt) * 2 + d) * 512 + ch];
            const float av = __builtin_amdgcn_exp2f(bflo(w)); A *= av; U = av * U + bfhi(w); }
        AGG[(size_t)((b * 2 + d) * (NCH + 1) + c) * 512 + ch] = (f32x2){A, U};
    }
}
__device__ __forceinline__ float gelu_tanh(float x) { const float z = 0.7978845608028654f * (x + 0.044715f * x * x * x);
    return x * __builtin_amdgcn_rcpf(1.f + __builtin_amdgcn_exp2f(-2.8853900817779268f * z)); }
__device__ __forceinline__ void scan_final(const GAS unsigned* __restrict__ LU, const GAS f32x2* __restrict__ AGG, const GAS bf16_t* __restrict__ P, GAS bf16_t* __restrict__ A2, int gw, int NGW, int lane) {
    constexpr int BT = 16;
    for (int task = gw; task < NB * NCH * 8; task += NGW) {
        const int cgp = task & 7, c = (task >> 3) & (NCH - 1), b = task / (8 * NCH), ch = cgp * 64 + lane, row0 = b * SEQ + c * CHL;
        const GAS f32x2* ag0 = AGG + (size_t)((b * 2 + 0) * (NCH + 1)) * 512 + ch; const GAS f32x2* ag1 = AGG + (size_t)((b * 2 + 1) * (NCH + 1)) * 512 + ch;
        unsigned w[BT], wn[BT];
#pragma unroll
        for (int i = 0; i < BT; ++i) w[i] = __builtin_nontemporal_load(LU + ((size_t)(row0 + i) * 2 + 0) * 512 + ch);
        float hf = ag0[(size_t)NCH * 512].y;
        for (int cc = 0; cc < c; ++cc) { const f32x2 g = ag0[(size_t)cc * 512]; hf = g.x * hf + g.y; }
        float hb = ag1[(size_t)NCH * 512].y;
        for (int cc = NCH - 1; cc > c; --cc) { const f32x2 g = ag1[(size_t)cc * 512]; hb = g.x * hb + g.y; }
#pragma unroll 1
        for (int t0 = 0; t0 < CHL; t0 += BT) {
            if (t0 + BT < CHL) {
#pragma unroll
                for (int i = 0; i < BT; ++i) wn[i] = __builtin_nontemporal_load(LU + ((size_t)(row0 + t0 + BT + i) * 2 + 0) * 512 + ch); }
#pragma unroll
            for (int i = 0; i < BT; ++i) { hf = __builtin_amdgcn_exp2f(bflo(w[i])) * hf + bfhi(w[i]); A2[(size_t)(row0 + t0 + i) * DM + ch] = (bf16_t)f2bf(hf); }
#pragma unroll
            for (int i = 0; i < BT; ++i) w[i] = wn[i]; }
        bf16_t gr[BT], grn[BT];
#pragma unroll
        for (int i = 0; i < BT; ++i) { w[i] = __builtin_nontemporal_load(LU + ((size_t)(row0 + CHL - BT + i) * 2 + 1) * 512 + ch); gr[i] = P[(size_t)(row0 + CHL - BT + i) * PW + 512 + ch]; }
#pragma unroll 1
        for (int t0 = CHL - BT; t0 >= 0; t0 -= BT) { bf16_t f[BT];
#pragma unroll
            for (int i = 0; i < BT; ++i) f[i] = A2[(size_t)(row0 + t0 + i) * DM + ch];
            if (t0 >= BT) {
#pragma unroll
                for (int i = 0; i < BT; ++i) { wn[i] = __builtin_nontemporal_load(LU + ((size_t)(row0 + t0 - BT + i) * 2 + 1) * 512 + ch); grn[i] = P[(size_t)(row0 + t0 - BT + i) * PW + 512 + ch]; } }
#pragma unroll
            for (int i = BT - 1; i >= 0; --i) { hb = __builtin_amdgcn_exp2f(bflo(w[i])) * hb + bfhi(w[i]);
                A2[(size_t)(row0 + t0 + i) * DM + ch] = (bf16_t)f2bf((bf2f(f[i]) + hb) * gelu_tanh(bf2f(gr[i]))); }
#pragma unroll
            for (int i = 0; i < BT; ++i) { w[i] = wn[i]; gr[i] = grn[i]; } }
    }
}
constexpr int AT_KROW = 208, AT_VROW = 144;
constexpr float AT_THR = 8.f;
#define AT_LMAX(P, MX) do { MX = fmaxf(fmaxf(P[0], P[1]), fmaxf(P[2], P[3])); \
        _Pragma("unroll") for (int i_ = 4; i_ < 16; i_ += 4) MX = fmaxf(fmaxf(MX, P[i_]), fmaxf(fmaxf(P[i_ + 1], P[i_ + 2]), P[i_ + 3])); } while (0)
#define AT_SOFTMAX(P, MX, M, L, O0, O1, PW0, PW1) do { \
        if (__any(MX > M + AT_THR)) { const float mn_ = fmaxf(M, MX), al_ = __builtin_amdgcn_exp2f(M - mn_); M = mn_; L *= al_; \
            _Pragma("unroll") for (int i_ = 0; i_ < 16; ++i_) { O0[i_] *= al_; O1[i_] *= al_; } } \
        float s_ = 0.f; \
        _Pragma("unroll") for (int i_ = 0; i_ < 16; ++i_) { P[i_] = __builtin_amdgcn_exp2f(P[i_] - M); s_ += P[i_]; } \
        L += s_; \
        _Pragma("unroll") for (int j_ = 0; j_ < 4; ++j_) { PW0[j_] = cvtpk(P[2 * j_], P[2 * j_ + 1]); PW1[j_] = cvtpk(P[8 + 2 * j_], P[9 + 2 * j_]); } } while (0)
__device__ __forceinline__ void glds16(const GAS void* gsrc, unsigned lds_dst) {
    unsigned keep;
    asm volatile("s_mov_b32 %0, m0\n\ts_mov_b32 m0, %2\n\ts_nop 0\n\tglobal_load_lds_dwordx4 %1, off\n\ts_mov_b32 m0, %0" : "=&s"(keep) : "v"(gsrc), "s"(lds_dst) : "memory");
}
constexpr int AT_SLOT = 22 * 1024, AT_VOFF = 13 * 1024, AT_NP = 22;
__device__ __forceinline__ void attn_unit(LAS unsigned char* lds, const GAS bf16_t* __restrict__ QR, const GAS float* __restrict__ ssq, const GAS float* __restrict__ RT, const GAS bf16_t* __restrict__ K, const GAS bf16_t* __restrict__ Vt, GAS bf16_t* __restrict__ A2, int b, int h, int qb, int tid, int wave, int lane) {
    const int r32 = lane & 31, hi = lane >> 5, q0 = qb * 512 + wave * 64, r32s = (r32 & ~12) | ((r32 & 4) << 1) | ((r32 & 8) >> 1);
    bf16x8 qa[6], qc[6];
#pragma unroll
    for (int sub = 0; sub < 2; ++sub) {
        const int s = q0 + 32 * sub + r32, row = b * SEQ + s;
        const GAS bf16_t* Qp = QR + (size_t)row * 768 + h * 96 + 8 * hi;
        const float sc = rsqrtf(ssq[row] * (1.f / 256.f) + EPS) * QSCALE;
#pragma unroll
        for (int d0 = 0; d0 < 6; ++d0) {
            const u32x4 raw = *(const GAS u32x4*)(Qp + 16 * d0);
            float v[8];
#pragma unroll
            for (int j = 0; j < 4; ++j) { v[2 * j] = bflo(raw[j]) * sc; v[2 * j + 1] = bfhi(raw[j]) * sc; }
            if (d0 >= 4) { const GAS float* rt = RT + (d0 == 4 ? (s >> 6) : (s & 63)) * 16;
#pragma unroll
                for (int j = 0; j < 8; ++j) { const float pt = __shfl_xor(v[j], 32), cs = rt[2 * j], sn = rt[2 * j + 1]; v[j] = hi ? v[j] * cs + pt * sn : v[j] * cs - pt * sn; } }
            u32x4 w; w.x = pk2(v[0], v[1]); w.y = pk2(v[2], v[3]); w.z = pk2(v[4], v[5]); w.w = pk2(v[6], v[7]);
            if (sub == 0) qa[d0] = __builtin_bit_cast(bf16x8, w); else qc[d0] = __builtin_bit_cast(bf16x8, w);
        }
    }
    const GAS unsigned char* Kg = (const GAS unsigned char*)(K + (size_t)(b * 8 + h) * KVLEN * 96);
    const GAS unsigned char* Vg = (const GAS unsigned char*)(Vt + (size_t)(b * 8 + h) * 64 * KVLEN);
    const unsigned ldsb = (unsigned)(size_t)lds;
    const GAS unsigned char* src[3]; int stride[3]; unsigned dsto[3];
#pragma unroll
    for (int k = 0; k < 3; ++k) { int j = wave + 8 * k; if (j >= AT_NP) j -= 8; const int id = j * 64 + lane;
        if (j < 13) { const int row = id / 13; int col = id - row * 13; if (col == 12) col = 0; src[k] = Kg + row * 192 + col * 16; stride[k] = 12288; }
        else { const int idv = id - 832, d = idv / 9; int c = idv - d * 9; if (c == 8) c = 0; src[k] = Vg + ((size_t)d * KVLEN + c * 8) * 2; stride[k] = 128; }
        dsto[k] = ldsb + j * 1024; }
#define AT_ISSUE(t, slot) do { _Pragma("unroll") for (int k_ = 0; k_ < 3; ++k_) glds16(src[k_] + (size_t)(t) * stride[k_], (unsigned)__builtin_amdgcn_readfirstlane(dsto[k_] + (slot) * AT_SLOT)); } while (0)
    f32x16 oA0, oA1, oB0, oB1;
#pragma unroll
    for (int i = 0; i < 16; ++i) { oA0[i] = 0.f; oA1[i] = 0.f; oB0[i] = 0.f; oB1[i] = 0.f; }
    float mA = -1e30f, mB = -1e30f, lA = 0.f, lB = 0.f;
    constexpr int NT_ = KVLEN / 64;
    AT_ISSUE(0, 0); AT_ISSUE(1, 1);
    int slot = 0, nslot = 2;
#pragma unroll 1
    for (int t = 0; t < NT_; ++t) {
        if (t + 1 < NT_) asm volatile("s_waitcnt vmcnt(3) lgkmcnt(0)\n\ts_barrier" ::: "memory"); else asm volatile("s_waitcnt vmcnt(0) lgkmcnt(0)\n\ts_barrier" ::: "memory");
        if (t + 2 < NT_) AT_ISSUE(t + 2, nslot);
        const LAS unsigned char* sb = lds + slot * AT_SLOT;
#pragma unroll
        for (int hh = 0; hh < 2; ++hh) {
            const LAS unsigned char* kb = sb + (32 * hh + r32s) * AT_KROW + hi * 16;
            f32x16 pA, pB;
#pragma unroll
            for (int i = 0; i < 16; ++i) { pA[i] = 0.f; pB[i] = 0.f; }
#pragma unroll
            for (int d0 = 0; d0 < 6; ++d0) { const bf16x8 a0 = *(const LAS bf16x8*)(kb + d0 * 32); pA = MFMA32(a0, qa[d0], pA); pB = MFMA32(a0, qc[d0], pB); }
            u32x4 pwA0, pwA1, pwB0, pwB1;
            float mxA, mxB; AT_LMAX(pA, mxA); AT_LMAX(pB, mxB);
            { const float oa = __shfl_xor(mxA, 32), ob = __shfl_xor(mxB, 32); mxA = fmaxf(mxA, oa); mxB = fmaxf(mxB, ob); }
            AT_SOFTMAX(pA, mxA, mA, lA, oA0, oA1, pwA0, pwA1);
            AT_SOFTMAX(pB, mxB, mB, lB, oB0, oB1, pwB0, pwB1);
            const LAS unsigned char* vb = sb + AT_VOFF + r32 * AT_VROW + hi * 16 + hh * 64;
#pragma unroll
            for (int ks = 0; ks < 2; ++ks) {
                const bf16x8 va0 = *(const LAS bf16x8*)(vb + ks * 32), va1 = *(const LAS bf16x8*)(vb + 32 * AT_VROW + ks * 32);
                const bf16x8 pa = __builtin_bit_cast(bf16x8, ks ? pwA1 : pwA0), pb = __builtin_bit_cast(bf16x8, ks ? pwB1 : pwB0);
                oA0 = MFMA32(va0, pa, oA0); oA1 = MFMA32(va1, pa, oA1); oB0 = MFMA32(va0, pb, oB0); oB1 = MFMA32(va1, pb, oB1);
            }
        }
        slot = slot == 2 ? 0 : slot + 1; nslot = nslot == 2 ? 0 : nslot + 1;
    }
    asm volatile("s_waitcnt lgkmcnt(0)\n\ts_barrier" ::: "memory");
    {   const float inv = 1.f / (lA + __shfl_xor(lA, 32));
        GAS bf16_t* op = A2 + (size_t)(b * SEQ + q0 + r32) * DM + 512 + h * 64 + 4 * hi;
#pragma unroll
        for (int g = 0; g < 4; ++g) { u32x2 w0, w1; w0.x = pk2(oA0[4 * g] * inv, oA0[4 * g + 1] * inv); w0.y = pk2(oA0[4 * g + 2] * inv, oA0[4 * g + 3] * inv);
            w1.x = pk2(oA1[4 * g] * inv, oA1[4 * g + 1] * inv); w1.y = pk2(oA1[4 * g + 2] * inv, oA1[4 * g + 3] * inv);
            *(GAS u32x2*)(op + 8 * g) = w0; *(GAS u32x2*)(op + 32 + 8 * g) = w1; } }
    {   const float inv = 1.f / (lB + __shfl_xor(lB, 32));
        GAS bf16_t* op = A2 + (size_t)(b * SEQ + q0 + 32 + r32) * DM + 512 + h * 64 + 4 * hi;
#pragma unroll
        for (int g = 0; g < 4; ++g) { u32x2 w0, w1; w0.x = pk2(oB0[4 * g] * inv, oB0[4 * g + 1] * inv); w0.y = pk2(oB0[4 * g + 2] * inv, oB0[4 * g + 3] * inv);
            w1.x = pk2(oB1[4 * g] * inv, oB1[4 * g + 1] * inv); w1.y = pk2(oB1[4 * g + 2] * inv, oB1[4 * g + 3] * inv);
            *(GAS u32x2*)(op + 8 * g) = w0; *(GAS u32x2*)(op + 32 + 8 * g) = w1; } }
#undef AT_ISSUE
}
__device__ __forceinline__ void p7_rows(const GAS float* __restrict__ x, const GAS float* __restrict__ g_post, const GAS float* __restrict__ g_pre, GAS bf16_t* __restrict__ X1b, const GAS float* __restrict__ mod, const GAS bf16_t* __restrict__ Y, GAS bf16_t* __restrict__ H2, int gw, int NGW, int lane) {
    for (int m0 = 2 * gw; m0 < MLAT; m0 += 2 * NGW) {
        const GAS float* md = mod + (m0 >> 13) * NMOD;
        f32x4 y[2][4], xv[2][4]; float ss[2];
#pragma unroll
        for (int r = 0; r < 2; ++r) { ss[r] = 0.f;
#pragma unroll
            for (int j = 0; j < 4; ++j) { const u32x2 w = __builtin_nontemporal_load((const GAS u32x2*)(Y + (size_t)(m0 + r) * DM + 4 * lane + 256 * j)); xv[r][j] = __builtin_nontemporal_load((const GAS f32x4*)(x + (size_t)(m0 + r) * DM + 4 * lane + 256 * j));
                y[r][j] = (f32x4){bflo(w.x), bfhi(w.x), bflo(w.y), bfhi(w.y)}; ss[r] += y[r][j].x * y[r][j].x + y[r][j].y * y[r][j].y + y[r][j].z * y[r][j].z + y[r][j].w * y[r][j].w; } }
#pragma unroll
        for (int r = 0; r < 2; ++r) { const int m = m0 + r;
            const float rs = rsqrtf(wave_sum(ss[r]) * (1.f / DM) + EPS); float s2 = 0.f;
#pragma unroll
            for (int j = 0; j < 4; ++j) { const int k = 4 * lane + 256 * j;
                const f32x4 gg = *(const GAS f32x4*)(g_post + k), gt = *(const GAS f32x4*)(md + 2 * DM + k);
                xv[r][j] = xv[r][j] + gt * (y[r][j] * rs * gg); { u32x2 o1; o1.x = pk2(xv[r][j].x, xv[r][j].y); o1.y = pk2(xv[r][j].z, xv[r][j].w); __builtin_nontemporal_store(o1, (GAS u32x2*)(X1b + (size_t)m * DM + k)); }
                s2 += xv[r][j].x * xv[r][j].x + xv[r][j].y * xv[r][j].y + xv[r][j].z * xv[r][j].z + xv[r][j].w * xv[r][j].w; }
            const float rs2 = rsqrtf(wave_sum(s2) * (1.f / DM) + EPS);
#pragma unroll
            for (int j = 0; j < 4; ++j) { const int k = 4 * lane + 256 * j;
                const f32x4 gg = *(const GAS f32x4*)(g_pre + k), sh = *(const GAS f32x4*)(md + 3 * DM + k), sc = *(const GAS f32x4*)(md + 4 * DM + k);
                const f32x4 hh = xv[r][j] * rs2 * gg * (sc + 1.f) + sh;
                u32x2 o; o.x = pk2(hh.x, hh.y); o.y = pk2(hh.z, hh.w); *(GAS u32x2*)(H2 + (size_t)m * DM + k) = o; } }
    }
}
__device__ __forceinline__ void p11_rows(const GAS float* __restrict__ g_post, GAS float* __restrict__ out, const GAS bf16_t* __restrict__ X1b, const GAS float* __restrict__ mod, const GAS bf16_t* __restrict__ Fb, int gw, int NGW, int lane) {
    for (int m0 = 2 * gw; m0 < MLAT; m0 += 2 * NGW) {
        const GAS float* md = mod + (m0 >> 13) * NMOD;
        f32x4 y[2][4], xv[2][4]; float ss[2];
#pragma unroll
        for (int r = 0; r < 2; ++r) { ss[r] = 0.f;
#pragma unroll
            for (int j = 0; j < 4; ++j) { const u32x2 w = __builtin_nontemporal_load((const GAS u32x2*)(Fb + (size_t)(m0 + r) * DM + 4 * lane + 256 * j)); { const u32x2 w1 = __builtin_nontemporal_load((const GAS u32x2*)(X1b + (size_t)(m0 + r) * DM + 4 * lane + 256 * j)); xv[r][j] = (f32x4){bflo(w1.x), bfhi(w1.x), bflo(w1.y), bfhi(w1.y)}; }
                y[r][j] = (f32x4){bflo(w.x), bfhi(w.x), bflo(w.y), bfhi(w.y)}; ss[r] += y[r][j].x * y[r][j].x + y[r][j].y * y[r][j].y + y[r][j].z * y[r][j].z + y[r][j].w * y[r][j].w; } }
#pragma unroll
        for (int r = 0; r < 2; ++r) { const float rs = rsqrtf(wave_sum(ss[r]) * (1.f / DM) + EPS);
#pragma unroll
            for (int j = 0; j < 4; ++j) { const int k = 4 * lane + 256 * j;
                const f32x4 gg = *(const GAS f32x4*)(g_post + k), gt = *(const GAS f32x4*)(md + 5 * DM + k);
                __builtin_nontemporal_store(xv[r][j] + gt * (y[r][j] * rs * gg), (GAS f32x4*)(out + (size_t)(m0 + r) * DM + k)); } }
    }
}
__device__ __forceinline__ void convgate_phase(const GAS float* __restrict__ cw, const GAS float* __restrict__ cb, const GAS bf16_t* __restrict__ UP, GAS bf16_t* __restrict__ G, int half, int gtid, int NT) {
    constexpr int JG = DFF / 8, RG = 32, NTASK = (MLAT / 2 / RG) * JG;
    for (int task = gtid; task < NTASK; task += NT) {
        const int jg = task % JG, rg = task / JG, j0 = jg * 8, r0 = rg * RG, m0 = half * (MLAT / 2) + r0;
        float wu[3][8], wg[3][8], bu[8], bg[8];
#pragma unroll
        for (int k = 0; k < 3; ++k)
#pragma unroll
            for (int i = 0; i < 8; ++i) { wu[k][i] = cw[k * 2 * DFF + j0 + i]; wg[k][i] = cw[k * 2 * DFF + DFF + j0 + i]; }
#pragma unroll
        for (int i = 0; i < 8; ++i) { bu[i] = cb[j0 + i]; bg[i] = cb[DFF + j0 + i]; }
        const GAS bf16_t* up = UP + (size_t)r0 * (2 * DFF) + j0;
        u32x4 pu = {0u, 0u, 0u, 0u}, pg = {0u, 0u, 0u, 0u}, cu, cg_, nu, ng;
        if ((m0 & 8191) != 0) { pu = __builtin_nontemporal_load((const GAS u32x4*)(up - 2 * DFF)); pg = __builtin_nontemporal_load((const GAS u32x4*)(up - 2 * DFF + DFF)); }
        cu = __builtin_nontemporal_load((const GAS u32x4*)(up)); cg_ = __builtin_nontemporal_load((const GAS u32x4*)(up + DFF));
#pragma unroll 8
        for (int r = 0; r < RG; ++r) {
            const bool nv = (r + 1 < RG) || (((m0 + RG) & 8191) != 0);
            if (nv) { nu = __builtin_nontemporal_load((const GAS u32x4*)(up + (size_t)(r + 1) * (2 * DFF))); ng = __builtin_nontemporal_load((const GAS u32x4*)(up + (size_t)(r + 1) * (2 * DFF) + DFF)); } else { nu = (u32x4){0u, 0u, 0u, 0u}; ng = nu; }
            float o[8];
#pragma unroll
            for (int i = 0; i < 8; ++i) { const int w_ = i >> 1;
                const float p_u = (i & 1) ? bfhi(pu[w_]) : bflo(pu[w_]), c_u = (i & 1) ? bfhi(cu[w_]) : bflo(cu[w_]), n_u = (i & 1) ? bfhi(nu[w_]) : bflo(nu[w_]);
                const float p_g = (i & 1) ? bfhi(pg[w_]) : bflo(pg[w_]), c_g = (i & 1) ? bfhi(cg_[w_]) : bflo(cg_[w_]), n_g = (i & 1) ? bfhi(ng[w_]) : bflo(ng[w_]);
                const float uv = bu[i] + wu[0][i] * p_u + wu[1][i] * c_u + wu[2][i] * n_u, gv = bg[i] + wg[0][i] * p_g + wg[1][i] * c_g + wg[2][i] * n_g;
                o[i] = gv * __builtin_amdgcn_rcpf(1.f + __builtin_amdgcn_exp2f(-1.4426950408889634f * gv)) * uv; }
            u32x4 w; w.x = pk2(o[0], o[1]); w.y = pk2(o[2], o[3]); w.z = pk2(o[4], o[5]); w.w = pk2(o[6], o[7]);
            *(GAS u32x4*)(G + (size_t)(r0 + r) * DFF + j0) = w;
            pu = cu; pg = cg_; cu = nu; cg_ = ng;
        }
    }
}
constexpr int NPH = 17;
__global__ void __launch_bounds__(512, 2) fwd_kernel(Args a) {
    extern __shared__ __attribute__((aligned(16))) unsigned char lds_raw[];
    LAS unsigned char* lds = (LAS unsigned char*)lds_raw;
    const int lo = a.ph_lo, hi_ = a.ph_hi;
    {
        volatile LAS unsigned* st0 = (volatile LAS unsigned*)(lds + LDS_MISC);
        if (threadIdx.x < 2) st0[threadIdx.x] = 0u;
        __syncthreads();
        (void)xcd_barrier_post((unsigned*)(a.ws + WS_BAR), st0);
    }
#if MK_COOP
    cg::grid_group grid = cg::this_grid();
#endif
    typedef pg8::EpiBf16<0> EpiB;
    constexpr int MH = MLAT / 2;
#ifndef REPMASK
#define REPMASK 0
#endif
    bool repeated = false;
#pragma unroll 1
    for (int ph = lo; ph < hi_; ++ph) {
        int tid = threadIdx.x; asm volatile("" : "+v"(tid));
        int G = gridDim.x, bx = blockIdx.x; asm volatile("" : "+s"(G), "+s"(bx));
        const int lane = tid & 63, wave = __builtin_amdgcn_readfirstlane(tid >> 6);
        const int vcu = (G % 8 == 0) ? (bx % 8) * (G / 8) + bx / 8 : bx;
        const int gw = vcu * 8 + wave, NGW = G * 8, gtid = bx * 512 + tid, NTH = G * 512;
        unsigned char* ws_ = a.ws; asm volatile("" : "+s"(ws_)); GAS unsigned char* ws = (GAS unsigned char*)ws_;
        GAS float* mod = (GAS float*)(ws + WS_MOD); GAS float* ssq = (GAS float*)(ws + WS_SSQ); GAS float* sskv = (GAS float*)(ws + WS_SSKV);
        GAS bf16_t* Win = (GAS bf16_t*)(ws + WS_WIN); GAS bf16_t* Wq = (GAS bf16_t*)(ws + WS_WQ); GAS bf16_t* Wkv = (GAS bf16_t*)(ws + WS_WKV); GAS bf16_t* Wg = (GAS bf16_t*)(ws + WS_WG);
        GAS bf16_t* Wout = (GAS bf16_t*)(ws + WS_WOUT); GAS bf16_t* Wup = (GAS bf16_t*)(ws + WS_WUP); GAS bf16_t* Wdn = (GAS bf16_t*)(ws + WS_WDN);
        GAS f32x2* AGG = (GAS f32x2*)(ws + WS_AGG); GAS float* RT = (GAS float*)(ws + WS_ROPE);
        GAS bf16_t* H = (GAS bf16_t*)(ws + WS_R1); GAS bf16_t* KVR = H; GAS bf16_t* H2 = H; GAS bf16_t* QR = (GAS bf16_t*)(ws + WS_Q);
        GAS bf16_t* P = (GAS bf16_t*)(ws + WS_R2); GAS bf16_t* Y = P; GAS bf16_t* Fb = P;
        GAS unsigned* LU = (GAS unsigned*)(ws + WS_LU); GAS bf16_t* Kb = (GAS bf16_t*)(ws + WS_K); GAS bf16_t* Vb = (GAS bf16_t*)(ws + WS_V); GAS bf16_t* A2 = (GAS bf16_t*)(ws + WS_A2);
        GAS bf16_t* UP = (GAS bf16_t*)(ws + WS_UP); GAS bf16_t* Gb = (GAS bf16_t*)(ws + WS_G);
        float* outp_ = a.out; asm volatile("" : "+s"(outp_)); GAS float* outp = (GAS float*)outp_;
        pg8::Gemm g{nullptr, nullptr, 0, 0, 0, 0, 0}; GAS bf16_t* O = nullptr; int ldc = 0;
        switch (ph) {
            case 2:  g = pg8::Gemm{(const bf16_t*)(H), (const bf16_t*)(Win), MALL, PW, DM, DM, DM}; O = P; ldc = PW; break;
            case 4:  g = pg8::Gemm{(const bf16_t*)(P + 1024), (const bf16_t*)(Wq), MLAT, 768, 256, PW, 256}; O = QR; ldc = 768; break;
            case 5:  g = pg8::Gemm{(const bf16_t*)(P + 1280), (const bf16_t*)(Wkv), MALL, 1024, 128, PW, 128}; O = KVR; ldc = 1024; break;
            case 8:  g = pg8::Gemm{(const bf16_t*)(A2), (const bf16_t*)(Wout), MLAT, DM, DM, DM, DM}; O = Y; ldc = DM; break;
            case 10: g = pg8::Gemm{(const bf16_t*)(H2), (const bf16_t*)(Wup), MH, 2 * DFF, DM, DM, DM}; O = UP; ldc = 2 * DFF; break;
            case 13: g = pg8::Gemm{(const bf16_t*)(H2 + (size_t)MH * DM), (const bf16_t*)(Wup), MH, 2 * DFF, DM, DM, DM}; O = UP; ldc = 2 * DFF; break;
            case 12: g = pg8::Gemm{(const bf16_t*)(Gb), (const bf16_t*)(Wdn), MH, DM, DFF, DFF, DFF}; O = Fb; ldc = DM; break;
            case 15: g = pg8::Gemm{(const bf16_t*)(Gb), (const bf16_t*)(Wdn), MH, DM, DFF, DFF, DFF}; O = Fb + (size_t)MH * DM; ldc = DM; break;
            default: break;
        }
        if (g.A != nullptr) {
            pg8::StaticOrder S; S.init(g.M, g.N, G, bx); EpiB E{(bf16_t*)O, ldc, nullptr, 0, 0, 1.f};
            pg8::gemm_phase<EpiB, pg8::StaticOrder, true, true>(lds, g, S, E, tid);
        }
#ifndef NGM
#define NGM 0x1ffff
#endif
#define NG(k) ((NGM >> (k)) & 1)
        else if (NG(0) && ph == 0) {
            prep_mat<0>(argp(10), nullptr, Win, 1536, 1024, gtid, NTH); prep_mat<1>(argp(18), argp(19), Wq, 768, 256, gtid, NTH); prep_mat<2>(argp(20), argp(21), Wkv, 1024, 128, gtid, NTH);
            prep_mat<3>(argp(13), argp(15), Wg, 2048, 64, gtid, NTH); prep_mat<4>(argp(22), nullptr, Wout, 1024, 1024, gtid, NTH); prep_mat<5>(argp(23), nullptr, Wup, 5632, 1024, gtid, NTH);
            prep_mat<6>(argp(26), nullptr, Wdn, 1024, 2816, gtid, NTH);
            if (gtid < 1024) { const float nl = -argp(17)[gtid]; RT[2048 + gtid] = 8.f * 1.4426950408889634f * (nl > 20.f ? nl : log1pf(__expf(nl))); }
            if (gtid < 1024) { const int pos = gtid >> 3, j = gtid & 7; const float invf[8] = {1.f, 0.31622776601683794f, 0.1f, 0.031622776601683794f, 0.01f, 0.0031622776601683794f, 0.001f, 0.00031622776601683794f};
                const float ang = (float)pos * invf[j]; RT[2 * gtid] = cosf(ang); RT[2 * gtid + 1] = sinf(ang); }
            mod_phase(argp(1), argp(3), argp(4), argp(5), mod, (LAS float*)(lds + wave * 4096), gw, NGW, lane);
        } else if (NG(1) && ph == 1) {
            p1_rows(argp(0), argp(2), argp(6), mod, H, gw, NGW, lane);
        } else if (NG(3) && ph == 3) {
            gates_phase(argp(11), argp(12), argp(14), argp(16), (const GAS float*)(RT + 2048), lds, P, Wg, LU, AGG, tid, wave, lane);
            ss_phase(P, ssq, sskv, gw, NGW, lane);
        } else if (NG(6) && ph == 6) {
            krope_phase(P, Kb, RT, gtid, NTH); kvpost_phase(KVR, sskv, Kb, Vb, gtid, NTH);
#ifdef REP6
            if (REP6 & 1) { __syncthreads(); scan_agg(LU, AGG, gw, NGW, lane); }
            if (REP6 & 2) { __syncthreads(); krope_phase(P, Kb, RT, gtid, NTH); }
            if (REP6 & 4) { __syncthreads(); }
            if (REP6 & 8) { __syncthreads(); kvpost_phase(KVR, sskv, Kb, Vb, gtid, NTH); }
#endif
        } else if (NG(7) && ph == 7) {
            scan_final(LU, AGG, P, A2, gw, NGW, lane);
#ifdef REP7
            __syncthreads(); scan_final(LU, AGG, P, A2, gw, NGW, lane);
#endif
            const int upb = (NB * 8 * 16 + G - 1) / G, u0 = vcu * upb, u1 = min(NB * 8 * 16, u0 + upb);
            __syncthreads();
            for (int unit = u0; unit < u1; ++unit) { const int bh = unit >> 4, qb = unit & 15; attn_unit(lds, QR, ssq, RT, Kb, Vb, A2, bh >> 3, bh & 7, qb, tid, wave, lane); }
        } else if (NG(9) && ph == 9) {
            p7_rows(argp(0), argp(7), argp(8), (GAS bf16_t*)(ws + WS_X1), mod, Y, H2, gw, NGW, lane);
        } else if (NG(11) && (ph == 11 || ph == 14)) {
            convgate_phase(argp(24), argp(25), UP, Gb, ph == 14 ? 1 : 0, gtid, NTH);
        } else if (NG(16) && ph == 16) {
            p11_rows(argp(9), outp, (const GAS bf16_t*)(ws + WS_X1), mod, Fb, gw, NGW, lane);
        }
        __syncthreads();
#if MK_COOP
        if (ph + 1 < hi_ && ph != 3 && ph != 4 && ph != 12) {
            if (ph == 0) grid.sync();
            else { XcdBarrier xb; xb.bar = (unsigned*)(ws_ + WS_BAR); xb.x = xb_xcc_id(); xb.st = (volatile LAS unsigned*)(lds + LDS_MISC); xcd_barrier(xb); }
        }
#endif
        if (REPMASK) { if (((REPMASK >> ph) & 1) && !repeated) { repeated = true; --ph; } else repeated = false; }
    }
}

extern "C" void kernel_launch(void* const* d_in, const int* in_sizes, int n_in, void* d_out, int out_size, void* d_ws, size_t ws_size, hipStream_t stream) {
    static int grid = 0;
    if (grid == 0) {
        if (n_in != 27 || out_size != MLAT * DM || ws_size < WS_END) { fprintf(stderr, "kernel_launch: unexpected shapes (n_in %d, out %d, ws %zu)\n", n_in, out_size, ws_size); grid = -1; return; }
        int dev = 0, cus = 0, per_cu = 0;
        if (hipGetDevice(&dev) != hipSuccess || hipDeviceGetAttribute(&cus, hipDeviceAttributeMultiprocessorCount, dev) != hipSuccess) { grid = -1; return; }
        if (hipFuncSetAttribute((const void*)fwd_kernel, hipFuncAttributeMaxDynamicSharedMemorySize, LDS_BYTES) != hipSuccess) { fprintf(stderr, "kernel_launch: hipFuncSetAttribute failed\n"); grid = -1; return; }
        if (hipOccupancyMaxActiveBlocksPerMultiprocessor(&per_cu, (const void*)fwd_kernel, 512, LDS_BYTES) != hipSuccess || per_cu < 1) { fprintf(stderr, "kernel_launch: occupancy query says %d\n", per_cu); }
        (void)hipGetLastError();
        grid = cus;
    }
    if (grid < 0) return;
    (void)hipMemsetAsync((char*)d_ws + WS_CTL, 0, CTL_BYTES, stream);
    Args a{};
    for (int i = 0; i < 27; ++i) a.in[i] = (const float*)d_in[i];
    a.out = (float*)d_out; a.ws = (unsigned char*)d_ws;
#if MK_COOP
    a.ph_lo = 0; a.ph_hi = NPH;
    void* args[] = {&a};
    hipError_t e = hipLaunchCooperativeKernel((const void*)fwd_kernel, dim3(grid), dim3(512), args, LDS_BYTES, stream);
    if (e != hipSuccess) fprintf(stderr, "kernel_launch: cooperative launch failed: %s (grid %d)\n", hipGetErrorString(e), grid);
#else
    for (int p = 0; p < NPH; ++p) { a.ph_lo = p; a.ph_hi = p + 1; hipLaunchKernelGGL(fwd_kernel, dim3(grid), dim3(512), LDS_BYTES, stream, a); }
#endif
}
```
